# Optimizing an MI355X kernel written in HIP

```python
import math
import jax
import jax.numpy as jnp
from jax import lax
import numpy as np

D_MODEL = 1024
BATCH = 16
SEQ = 2048
DEPTH = 4

GRID_W = 64
CTX_LEN = 256
N_MIXERS = 2
DA_HEADS = 8
DA_HEAD_DIM = 64
DA_V_DIM = 2 * DA_HEAD_DIM
ROPE_BASE = 10000.0
Q_BLOCK = 128
CONV_WIDTH = 3
N_EXPERTS = 32
TOP_K = 4
D_FF = D_MODEL
SWIGLU_LIMIT = 7.0
SWIGLU_ALPHA = 1.702
MOE_BLOCK = 128
N_MOD = 6
EPS = 1e-5

kernel_name = 'hybrid_diffattn_shortconv_moe_dit'


def rmsnorm(x, g):
    xf = x.astype(jnp.float32)
    xf = xf * lax.rsqrt(jnp.mean(xf * xf, axis=-1, keepdims=True) + EPS)
    return xf.astype(x.dtype) * g


def modulate(h, shift, scale):
    return h * (1 + scale) + shift


def axial_rope_tables(n_tokens):
    rows = n_tokens // GRID_W
    row_pos = jnp.repeat(jnp.arange(rows, dtype=jnp.float32), GRID_W)
    col_pos = jnp.tile(jnp.arange(GRID_W, dtype=jnp.float32), rows)
    axis_dims = DA_HEAD_DIM // 2
    inv_freq = ROPE_BASE ** (-jnp.arange(0, axis_dims, 2, dtype=jnp.float32) / axis_dims)
    ang = jnp.concatenate([row_pos[:, None] * inv_freq, col_pos[:, None] * inv_freq], axis=-1)
    return jnp.cos(ang), jnp.sin(ang)


def apply_rope(x, cos, sin):
    cos = cos.astype(x.dtype)
    sin = sin.astype(x.dtype)
    x1, x2 = jnp.split(x, 2, axis=-1)
    return jnp.concatenate([x1 * cos - x2 * sin, x2 * cos + x1 * sin], axis=-1)


def diff_attention(h_lat, h_ctx, w_qkv, w_o, lam_params, subln_g, lam_init, ctx_out):
    B, N, _ = h_lat.shape
    H, d = DA_HEADS, DA_HEAD_DIM

    def project(h):
        n = h.shape[1]
        q, k, v = jnp.split(h @ w_qkv, 3, axis=-1)
        return (q.reshape(B, n, H, 2, d), k.reshape(B, n, H, 2, d), v.reshape(B, n, H, DA_V_DIM))

    lp = lam_params.astype(jnp.float32)
    lam = jnp.exp(jnp.sum(lp[0] * lp[1])) - jnp.exp(jnp.sum(lp[2] * lp[3])) + lam_init

    def attend(q, k, v):
        s = jnp.einsum('bqhcd,bkhcd->bhcqk', q.astype(jnp.float32), k.astype(jnp.float32)) * (d ** -0.5)
        p = jax.nn.softmax(s, axis=-1)
        a = p[:, :, 0] - lam * p[:, :, 1]
        return jnp.einsum('bhqk,bkhe->bqhe', a.astype(v.dtype), v)

    def head_out(o):
        o = rmsnorm(o, subln_g) * (1.0 - lam_init)
        return o.reshape(o.shape[0], o.shape[1], H * DA_V_DIM) @ w_o

    q_l, k_l, v_l = project(h_lat)
    q_c, k_c, v_c = project(h_ctx)
    cos, sin = axial_rope_tables(N)
    cos, sin = cos[:, None, None, :], sin[:, None, None, :]
    q_l = apply_rope(q_l, cos, sin)
    k_l = apply_rope(k_l, cos, sin)
    k_all = jnp.concatenate([k_c, k_l], axis=1)
    v_all = jnp.concatenate([v_c, v_l], axis=1)
    nb = N // Q_BLOCK
    q_blocks = q_l.reshape(B, nb, Q_BLOCK, H, 2, d).swapaxes(0, 1)
    o_l = lax.map(lambda qb: attend(qb, k_all, v_all), q_blocks)
    o_l = o_l.swapaxes(0, 1).reshape(B, N, H, DA_V_DIM)
    y_lat = head_out(o_l)
    y_ctx = head_out(attend(q_c, k_c, v_c)) if ctx_out else None
    return y_lat, y_ctx


def short_conv(h, w_in, conv_w, w_out):
    gate_b, gate_c, xt = jnp.split(h @ w_in, 3, axis=-1)
    u = gate_c * xt
    u = lax.conv_general_dilated(u, conv_w[:, None, :].astype(u.dtype), window_strides=(1,),
                                 padding=((CONV_WIDTH // 2, CONV_WIDTH // 2),),
                                 dimension_numbers=('NWC', 'WIO', 'NWC'),
                                 feature_group_count=u.shape[-1])
    return (gate_b * u) @ w_out


def moe_ffn(h, router_w, router_b, w_gu, b_gu, w_down, b_down):
    T, D = h.shape
    logits = (h @ router_w + router_b).astype(jnp.float32)
    top_logits, top_idx = lax.top_k(logits, TOP_K)
    gates = jax.nn.softmax(top_logits, axis=-1).astype(h.dtype)
    n_assign = T * TOP_K
    flat_e = top_idx.reshape(-1).astype(jnp.int32)
    order = jnp.argsort(flat_e)
    sorted_e = flat_e[order]
    counts = jnp.bincount(flat_e, length=N_EXPERTS).astype(jnp.int32)
    padded = (counts + MOE_BLOCK - 1) // MOE_BLOCK * MOE_BLOCK
    pad_end = jnp.cumsum(padded)
    pad_start = pad_end - padded
    start = jnp.cumsum(counts) - counts
    dest_sorted = pad_start[sorted_e] + jnp.arange(n_assign, dtype=jnp.int32) - start[sorted_e]
    n_blocks = -(-(n_assign + N_EXPERTS * (MOE_BLOCK - 1)) // MOE_BLOCK)
    n_rows = n_blocks * MOE_BLOCK
    row_token = jnp.zeros((n_rows,), jnp.int32).at[dest_sorted].set((order // TOP_K).astype(jnp.int32))
    block_start = jnp.arange(n_blocks, dtype=jnp.int32) * MOE_BLOCK
    block_expert = jnp.minimum(jnp.searchsorted(pad_end, block_start, side='right'), N_EXPERTS - 1)
    xb = h[row_token].reshape(n_blocks, MOE_BLOCK, D)

    def expert_block(args):
        xe, e = args
        gu = xe @ w_gu[e] + b_gu[e]
        x_glu = jnp.minimum(gu[:, ::2], SWIGLU_LIMIT)
        x_lin = jnp.clip(gu[:, 1::2], -SWIGLU_LIMIT, SWIGLU_LIMIT)
        act = x_glu * jax.nn.sigmoid(SWIGLU_ALPHA * x_glu) * (x_lin + 1)
        return act @ w_down[e] + b_down[e]

    yb = lax.map(expert_block, (xb, block_expert)).reshape(n_rows, D)
    dest = jnp.zeros((n_assign,), jnp.int32).at[order].set(dest_sorted)
    y = yb[dest].reshape(T, TOP_K, D)
    return jnp.einsum('tk,tkd->td', gates, y)


def setup_inputs(seed: int = 0) -> dict:
    key = jax.random.key(seed)
    ks = jax.random.split(key, 24)
    D, E, F = D_MODEL, N_EXPERTS, D_FF
    na = len(range(0, DEPTH, N_MIXERS))
    nc = DEPTH - na

    def nrm(k, shape, s):
        return jax.random.normal(k, shape, jnp.float32) * s

    return {
        'x': nrm(ks[0], (BATCH, SEQ, D), 1.0),
        'c': nrm(ks[1], (BATCH, D), 1.0),
        'ctx': nrm(ks[2], (BATCH, CTX_LEN, D), 1.0),
        'c_ctx': nrm(ks[3], (D,), 1.0),
        'mod_w': nrm(ks[4], (DEPTH, D, N_MOD * D), 0.02),
        'mod_b': nrm(ks[5], (DEPTH, N_MOD * D), 0.02),
        'norm_g': 1.0 + nrm(ks[6], (DEPTH, 2, D), 0.02),
        'attn_w_qkv': nrm(ks[7], (na, D, 3 * D), D ** -0.5),
        'attn_w_o': nrm(ks[8], (na, DA_HEADS * DA_V_DIM, D), (DA_HEADS * DA_V_DIM) ** -0.5),
        'attn_lambda': nrm(ks[9], (na, 4, DA_HEAD_DIM), 0.1),
        'attn_subln_g': 1.0 + nrm(ks[10], (na, DA_V_DIM), 0.02),
        'conv_w_in': nrm(ks[11], (nc, D, 3 * D), D ** -0.5),
        'conv_w': nrm(ks[12], (nc, CONV_WIDTH, D), CONV_WIDTH ** -0.5),
        'conv_w_out': nrm(ks[13], (nc, D, D), D ** -0.5),
        'router_w': nrm(ks[14], (DEPTH, D, E), D ** -0.5),
        'router_b': nrm(ks[15], (DEPTH, E), 0.01),
        'moe_w_gu': nrm(ks[16], (DEPTH, E, D, 2 * F), D ** -0.5),
        'moe_b_gu': nrm(ks[17], (DEPTH, E, 2 * F), 0.02),
        'moe_w_down': nrm(ks[18], (DEPTH, E, F, D), F ** -0.5),
        'moe_b_down': nrm(ks[19], (DEPTH, E, D), 0.02),
        'final_g': 1.0 + nrm(ks[20], (D,), 0.02),
    }


def reference(x, c, ctx, c_ctx, mod_w, mod_b, norm_g, attn_w_qkv, attn_w_o, attn_lambda, attn_subln_g,
              conv_w_in, conv_w, conv_w_out, router_w, router_b, moe_w_gu, moe_b_gu, moe_w_down, moe_b_down,
              final_g):
    B, N, D = x.shape
    for i in range(DEPTH):
        update_ctx = i < DEPTH - 1
        attn_layer = i % N_MIXERS == 0
        j = i // N_MIXERS
        mod_lat = (jax.nn.silu(c) @ mod_w[i] + mod_b[i])[:, None, :]
        sh1, sc1, g1, sh2, sc2, g2 = jnp.split(mod_lat, N_MOD, axis=-1)
        if update_ctx or attn_layer:
            mod_ctx = jax.nn.silu(c_ctx) @ mod_w[i] + mod_b[i]
            csh1, csc1, cg1, csh2, csc2, cg2 = jnp.split(mod_ctx, N_MOD, axis=-1)
            h_ctx = modulate(rmsnorm(ctx, norm_g[i, 0]), csh1, csc1)
        h_lat = modulate(rmsnorm(x, norm_g[i, 0]), sh1, sc1)
        if attn_layer:
            lam_init = 0.8 - 0.6 * math.exp(-0.3 * i)
            y_lat, y_ctx = diff_attention(h_lat, h_ctx, attn_w_qkv[j], attn_w_o[j], attn_lambda[j],
                                          attn_subln_g[j], lam_init, update_ctx)
        else:
            y_lat = short_conv(h_lat, conv_w_in[j], conv_w[j], conv_w_out[j])
            y_ctx = short_conv(h_ctx, conv_w_in[j], conv_w[j], conv_w_out[j]) if update_ctx else None
        x = x + g1 * y_lat
        h_lat = modulate(rmsnorm(x, norm_g[i, 1]), sh2, sc2).reshape(B * N, D)
        if update_ctx:
            ctx = ctx + cg1 * y_ctx
            h_ctx = modulate(rmsnorm(ctx, norm_g[i, 1]), csh2, csc2).reshape(-1, D)
            out = moe_ffn(jnp.concatenate([h_lat, h_ctx], axis=0), router_w[i], router_b[i], moe_w_gu[i],
                          moe_b_gu[i], moe_w_down[i], moe_b_down[i])
            x = x + g2 * out[:B * N].reshape(B, N, D)
            ctx = ctx + cg2 * out[B * N:].reshape(ctx.shape)
        else:
            out = moe_ffn(h_lat, router_w[i], router_b[i], moe_w_gu[i], moe_b_gu[i], moe_w_down[i], moe_b_down[i])
            x = x + g2 * out.reshape(B, N, D)
    return rmsnorm(x, final_g)
```

```cpp
#include <hip/hip_runtime.h>
#include <cstdio>
#include <cstdint>

#ifndef MK_PER_PHASE
#define MK_PER_PHASE 1
#endif

#ifndef PHSEL
#define PHSEL 0xffff
#endif
#define PS(k) ((PHSEL >> (k)) & 1)
#define GAS __attribute__((address_space(1)))
#define LAS __attribute__((address_space(3)))
typedef unsigned short bf16;
typedef short bf16x8 __attribute__((ext_vector_type(8)));
typedef float f32x4 __attribute__((ext_vector_type(4)));
typedef float f32x2 __attribute__((ext_vector_type(2)));
typedef float f32x16 __attribute__((ext_vector_type(16)));
typedef unsigned u32x4 __attribute__((ext_vector_type(4)));
typedef unsigned u32x2 __attribute__((ext_vector_type(2)));
typedef GAS unsigned gu32;

constexpr int D = 1024, NB = 16, SEQ = 2048, CTXL = 256, RPB = SEQ + CTXL, M = NB * RPB, DEPTH = 4;
constexpr int NE = 32, TOPK = 4, NMOD = 6;
constexpr int CAP = M;
constexpr int ACT_ROWS = M * TOPK + NE * 256;
constexpr float EPS = 1e-5f;
constexpr float C2 = 0.125f * 1.4426950408889634f;
constexpr int NPHASE = 2 + 7 * DEPTH;

constexpr size_t MiB = 1u << 20;
constexpr size_t WS_CTL = 0, CTL_ZERO_BYTES = 1 * MiB;
constexpr size_t WS_MODV = 1 * MiB;
constexpr size_t WS_ROPE = 3 * MiB;
constexpr size_t WS_RW = 4 * MiB;
constexpr size_t WS_MISC = 5 * MiB;
constexpr size_t WS_TOPE = 6 * MiB;
constexpr size_t WS_TOPG = 7 * MiB;
constexpr size_t WS_TOPP = 8 * MiB;
constexpr size_t WS_LIST = 9 * MiB;
constexpr size_t WS_WQKV = 16 * MiB;
constexpr size_t WS_WIN = 28 * MiB;
constexpr size_t WS_WO = 40 * MiB;
constexpr size_t WS_WOUT = 44 * MiB;
constexpr size_t WS_WGU = 48 * MiB;
constexpr size_t WS_WD = 560 * MiB;
constexpr size_t WS_X = 816 * MiB;
constexpr size_t WS_H = 960 * MiB;
constexpr size_t WS_Q = 1032 * MiB;
constexpr size_t WS_K = 1104 * MiB;
constexpr size_t WS_VT = 1176 * MiB;
constexpr size_t WS_BCO = WS_Q;
constexpr size_t WS_O = 1248 * MiB;
constexpr size_t WS_ACT = 1320 * MiB;
constexpr size_t WS_Y = 1624 * MiB;
constexpr size_t WS_END = 1928 * MiB;
static_assert((size_t)M * 3072 * 2 == 216 * MiB && (size_t)ACT_ROWS * 2048 == 304 * MiB && (size_t)M * 4096 == 144 * MiB, "ws map");

constexpr int CW_TMO = 0;
constexpr int CW_BAR = 4096;
constexpr int CW_CNT = 16384;

constexpr int RING_BYTES = 131072;
constexpr int LX = RING_BYTES;
constexpr int LX_MISC = LX + 0;
constexpr int LX_TSTART = LX + 256;
constexpr int LX_ECNT = LX + 512;
constexpr int LX_LCNT = LX + 640;
constexpr int LX_LBASE = LX + 768;
constexpr int LX_TILEE = LX + 1024;
constexpr int LX_WSC = LX + 4096;
constexpr int LX_ASG = LX + 12288;
constexpr int LDS_BYTES = LX + 16384;
constexpr int NWAVES = 8, NTHREADS = 512;

#define RLX_AGENT __ATOMIC_RELAXED, __HIP_MEMORY_SCOPE_AGENT
__device__ __forceinline__ unsigned f2bf(float f) { unsigned u = __builtin_bit_cast(unsigned, f); return (u + 0x7fffu + ((u >> 16) & 1u)) >> 16; }
__device__ __forceinline__ unsigned cvt_pk_bf16(float lo, float hi) { unsigned r; asm volatile("v_cvt_pk_bf16_f32 %0, %1, %2" : "=v"(r) : "v"(lo), "v"(hi)); return r; }
__device__ __forceinline__ float bf2f(unsigned short b) { return __builtin_bit_cast(float, (unsigned)b << 16); }
__device__ __forceinline__ float wave_sum(float v) {
#pragma unroll
    for (int o = 1; o < 64; o <<= 1) v += __shfl_xor(v, o);
    return v;
}

#define XB_TMO      128
#define XB_XCNT(j)  (256  + 64 * (j))
#define XB_XSUB(j)  (1280 + 64 * (j))
#define XB_XGEN(j)  (2304 + 64 * (j))
#define XB_TOP      3328
#define XB_TOPGEN   3392
#define XCD_BAR_WORDS 3456
#define XB_SPIN_CAP (1u << 18)
__device__ __forceinline__ unsigned xb_ld(unsigned* p)              { return __hip_atomic_load(p, __ATOMIC_RELAXED, __HIP_MEMORY_SCOPE_AGENT); }
__device__ __forceinline__ unsigned xb_add(unsigned* p, unsigned v) { return __hip_atomic_fetch_add(p, v, __ATOMIC_RELAXED, __HIP_MEMORY_SCOPE_AGENT); }
__device__ __forceinline__ unsigned xb_xcc_id() { return (unsigned)__builtin_amdgcn_s_getreg((3 << 11) | 20) & 0xFu; }
#define XB_SPIN(cond, bar) do { unsigned _sp = 0; while (cond) { __builtin_amdgcn_s_sleep(1); \
    if ((++_sp & 255u) == 0u) { if (xb_ld(&(bar)[XB_TMO])) break; if (_sp > XB_SPIN_CAP) { atomicAdd(&(bar)[XB_TMO], 1u); break; } } } } while (0)
struct XcdBarrier { unsigned* bar; unsigned x; volatile LAS unsigned* st; };
__device__ __forceinline__ XcdBarrier xcd_barrier_post(unsigned* bar, volatile LAS unsigned* st) {
    XcdBarrier b; b.bar = bar; b.x = xb_xcc_id(); b.st = st;
    if (threadIdx.x == 0) (void)xb_add(&bar[XB_XCNT(b.x)], 1u);
    return b;
}
__device__ __forceinline__ void xcd_barrier_complete(unsigned* bar, unsigned x, unsigned& nloc, unsigned& nx) {
    const unsigned G = gridDim.x * gridDim.y * gridDim.z;
    unsigned sum, cnt, mine, sp = 0u;
    for (;;) {
        sum = 0u; cnt = 0u; mine = 0u;
#pragma unroll
        for (unsigned j = 0; j < 16; ++j) { const unsigned c = xb_ld(&bar[XB_XCNT(j)]); sum += c; cnt += (c > 0u) ? 1u : 0u; mine = (j == x) ? c : mine; }
        if (sum == G) break;
        __builtin_amdgcn_s_sleep(1);
        if ((++sp & 255u) == 0u) { if (xb_ld(&bar[XB_TMO])) break; if (sp > XB_SPIN_CAP) { atomicAdd(&bar[XB_TMO], 1u); break; } }
    }
    nloc = mine > 0u ? mine : 1u; nx = cnt > 0u ? cnt : 1u;
}
__device__ __forceinline__ void xcd_barrier(const XcdBarrier& b) {
    asm volatile("s_waitcnt vmcnt(0)" ::: "memory");
    __syncthreads();
    if (threadIdx.x == 0) {
        unsigned* bar = b.bar; unsigned bx = b.x;
        asm volatile("" : "+s"(bar), "+s"(bx));
        __builtin_amdgcn_s_waitcnt(0);
        unsigned nloc = b.st[0], nx = b.st[1];
        if (nloc == 0u) { xcd_barrier_complete(bar, bx, nloc, nx); b.st[0] = nloc; b.st[1] = nx; }
        const unsigned old = xb_add(&bar[XB_XSUB(bx)], 1u);
        const unsigned gen = old / nloc;
        if (old + 1u == (gen + 1u) * nloc) {
            __builtin_amdgcn_fence(__ATOMIC_RELEASE, "agent");
            asm volatile("s_waitcnt vmcnt(0)" ::: "memory");
            const unsigned og = xb_add(&bar[XB_TOP], 1u);
            const unsigned tg = og / nx;
            if (og + 1u == (tg + 1u) * nx) xb_add(&bar[XB_TOPGEN], 1u);
            else XB_SPIN(xb_ld(&bar[XB_TOPGEN]) == tg, bar);
            __builtin_amdgcn_fence(__ATOMIC_ACQUIRE, "agent");
            xb_add(&bar[XB_XGEN(bx)], 1u);
            asm volatile("s_waitcnt vmcnt(0)" ::: "memory");
        } else {
            XB_SPIN(xb_ld(&bar[XB_XGEN(bx)]) == gen, bar);
            __builtin_amdgcn_fence(__ATOMIC_ACQUIRE, "agent");
            asm volatile("s_waitcnt vmcnt(0)" ::: "memory");
        }
    }
    __syncthreads();
}

namespace pg8 {
constexpr int BM = 256, BK = 64, HALF = 128, HTB = HALF * BK * 2, STAGE_BYTES = 8 * HTB, KD = 1024;
__host__ __device__ __forceinline__ int lds_byte(int r, int c) { const int st = (r >> 4) * 2 + (c >> 5), rr = r & 15, cc = c & 31, ob = rr * 64 + cc * 2; return st * 1024 + (ob ^ (((ob >> 9) & 1) << 5)); }
__host__ __device__ __forceinline__ void stage_rc(int b, int& R, int& C) { const int st = b / 1024, sb = b % 1024, swz = sb ^ (((sb >> 9) & 1) << 5); R = (st >> 1) * 16 + swz / 64; C = (st & 1) * 32 + (swz % 64) / 2; }
__host__ __device__ __forceinline__ int perm32(int rho) { const int n = rho >> 4, i = rho & 15; return 8 * (i >> 2) + 4 * n + (i & 3); }

struct Unit { int pm, pn, e, kind; };

__device__ __forceinline__ bool deal(int i, int npu, int ntiles, int& mt, int& r) {
    const int G = gridDim.x, c = blockIdx.x;
    if ((G & 7) == 0) { const int x = c & 7, q = i * (G >> 3) + (c >> 3); mt = (q / npu) * 8 + x; r = q % npu; }
    else { const int L = i * G + c; mt = L / npu; r = L % npu; }
    return mt < ntiles;
}

template <class Epi, class Sched>
__device__ __forceinline__ void gemm_phase(LAS unsigned char* lds, const Sched& S, const Epi& E, const int tid) {
    const int wid = __builtin_amdgcn_readfirstlane(tid >> 6), lane = tid & 63, wr = wid >> 2, wc = wid & 3, fr = lane & 15, fq = lane >> 4;
    constexpr int K = KD, nt = K / BK;
    unsigned voffB[2];
#pragma unroll
    for (int i = 0; i < 2; ++i) { int R_, C_; stage_rc(tid * 16 + i * 8192, R_, C_); const int Rb = (R_ & ~31) + perm32(R_ & 31); voffB[i] = (unsigned)(Rb * K + C_) * 2u; }
    constexpr bool GA = Sched::GATHER;
    constexpr int NH = GA ? 2 : 1;
    constexpr size_t kstep = (size_t)(BK * 2);
    constexpr size_t hstep = (size_t)HALF * K * 2;
    const unsigned ldsw = (unsigned)wid * 1024u;
    const int aoff = lds_byte(wr * 64 + fr, fq * 8), boff = lds_byte(wc * 32 + fr, fq * 8);
#define PG8_SA(b, h) (((b) * 2 + (h)) * HTB)
#define PG8_SB(b, h) ((4 + (b) * 2 + (h)) * HTB)
#define PG8_STAGE(bufoff, gbase, voff) do { _Pragma("unroll") for (int _i = 0; _i < 2; ++_i) \
        __builtin_amdgcn_global_load_lds((const unsigned*)((const char*)(gbase) + (voff)[_i]), (LAS unsigned*)(lds + (bufoff) + ldsw + _i * 8192), 16, 0, 0); } while (0)
#define PG8_LDA(dst, b, h) do { _Pragma("unroll") for (int m = 0; m < 4; ++m) _Pragma("unroll") for (int k = 0; k < 2; ++k) dst[m][k] = *(const LAS bf16x8*)(lds + PG8_SA(b, h) + aoff + m * 2048 + k * 1024); } while (0)
#define PG8_LDB(dst, b, h) do { _Pragma("unroll") for (int n = 0; n < 2; ++n) _Pragma("unroll") for (int k = 0; k < 2; ++k) dst[n][k] = *(const LAS bf16x8*)(lds + PG8_SB(b, h) + boff + n * 2048 + k * 1024); } while (0)
#define PG8_MMA(ai, bj, At, Bt) do { __builtin_amdgcn_s_setprio(1); _Pragma("unroll") for (int m = 0; m < 4; ++m) _Pragma("unroll") for (int n = 0; n < 2; ++n) _Pragma("unroll") for (int k = 0; k < 2; ++k) \
        acc[ai][bj][m][n] = __builtin_amdgcn_mfma_f32_16x16x32_bf16(Bt[n][k], At[m][k], acc[ai][bj][m][n], 0, 0, 0); __builtin_amdgcn_s_setprio(0); } while (0)
#define PG8_WAIT_V(n) asm volatile("s_waitcnt vmcnt(" #n ")" ::: "memory")
#define PG8_WAIT_L(n) asm volatile("s_waitcnt lgkmcnt(" #n ")" ::: "memory")
#define PG8_BAR __builtin_amdgcn_s_barrier()
#define PG8_SCHED __builtin_amdgcn_sched_barrier(0)
    Unit cur, nxt; int ui = 0;
    if (!S.next(0, cur)) return;
    f32x4 acc[2][2][4][2];
#pragma unroll
    for (int a = 0; a < 2; ++a)
#pragma unroll
        for (int b = 0; b < 2; ++b)
#pragma unroll
            for (int m = 0; m < 4; ++m)
#pragma unroll
                for (int n = 0; n < 2; ++n) acc[a][b][m][n] = (f32x4){0.f, 0.f, 0.f, 0.f};
    bf16x8 At[4][2], B0[2][2], B1[2][2];
    unsigned vC[NH][2], vN[NH][2];
    S.a_offs(cur, tid, vC);
#define PG8_HA(h) (GA ? 0 : (h) * hstep)
#define PG8_VH(v, h) (v)[GA ? (h) : 0]
    const char* cA = S.a_base(cur); const char* cB = S.b_base(cur);
    PG8_STAGE(PG8_SB(0, 0), cB, voffB); PG8_STAGE(PG8_SB(0, 1), cB + hstep, voffB); PG8_STAGE(PG8_SA(0, 0), cA, vC[0]); PG8_STAGE(PG8_SA(0, 1), cA + PG8_HA(1), PG8_VH(vC, 1));
    if (wr == 1) PG8_BAR;
    PG8_WAIT_V(2); PG8_BAR;
    PG8_STAGE(PG8_SB(1, 0), cB + kstep, voffB); PG8_STAGE(PG8_SA(1, 0), cA + kstep, vC[0]); PG8_STAGE(PG8_SB(1, 1), cB + hstep + kstep, voffB);
    PG8_WAIT_V(6); PG8_BAR;
    for (;;) {
        const bool has_next = S.next(ui + 1, nxt);
        const char* nA = cA; const char* nB = cB;
#pragma unroll
        for (int h = 0; h < NH; ++h)
#pragma unroll
            for (int i = 0; i < 2; ++i) vN[h][i] = vC[h][i];
        if (has_next) { S.a_offs(nxt, tid, vN); nA = S.a_base(nxt); nB = S.b_base(nxt); }
        for (int t = 0; t < nt; t += 2) {
            const bool last = (t == nt - 2);
            const char* a1 = cA + (size_t)(t + 1) * kstep;
            const char* a2 = last ? nA : cA + (size_t)(t + 2) * kstep; const char* b2 = last ? nB : cB + (size_t)(t + 2) * kstep;
            const char* a3 = a2 + kstep; const char* b3 = b2 + kstep;
            unsigned w0[2], w1[2];
#pragma unroll
            for (int i = 0; i < 2; ++i) { w0[i] = last ? vN[0][i] : vC[0][i]; w1[i] = last ? PG8_VH(vN, 1)[i] : PG8_VH(vC, 1)[i]; }
            PG8_LDB(B0, 0, 0); PG8_LDB(B1, 0, 1); PG8_SCHED; PG8_LDA(At, 0, 0); PG8_STAGE(PG8_SA(1, 1), a1 + PG8_HA(1), PG8_VH(vC, 1));
            PG8_WAIT_V(8); PG8_WAIT_L(0); PG8_BAR; PG8_MMA(0, 0, At, B0); PG8_MMA(0, 1, At, B1); PG8_BAR; PG8_SCHED;
            PG8_LDA(At, 0, 1); PG8_STAGE(PG8_SB(0, 0), b2, voffB); PG8_STAGE(PG8_SB(0, 1), b2 + hstep, voffB); PG8_STAGE(PG8_SA(0, 0), a2, w0);
            PG8_WAIT_V(8); PG8_WAIT_L(0); PG8_BAR; PG8_MMA(1, 0, At, B0); PG8_MMA(1, 1, At, B1); PG8_BAR; PG8_SCHED;
            PG8_LDB(B0, 1, 0); PG8_LDB(B1, 1, 1); PG8_SCHED; PG8_LDA(At, 1, 0); PG8_STAGE(PG8_SA(0, 1), a2 + PG8_HA(1), w1);
            PG8_WAIT_V(8); PG8_WAIT_L(0); PG8_BAR; PG8_MMA(0, 0, At, B0); PG8_MMA(0, 1, At, B1); PG8_BAR; PG8_SCHED;
            PG8_LDA(At, 1, 1); PG8_STAGE(PG8_SB(1, 0), b3, voffB); PG8_STAGE(PG8_SB(1, 1), b3 + hstep, voffB); PG8_STAGE(PG8_SA(1, 0), a3, w0);
            PG8_WAIT_V(8); PG8_WAIT_L(0); PG8_BAR; PG8_MMA(1, 0, At, B0); PG8_MMA(1, 1, At, B1); PG8_BAR; PG8_SCHED;
        }
        if (wr == 0) PG8_BAR;
        E(acc, cur, wr, wc, fr, fq);
        if (!has_next) break;
#pragma unroll
        for (int a = 0; a < 2; ++a)
#pragma unroll
            for (int b = 0; b < 2; ++b)
#pragma unroll
                for (int m = 0; m < 4; ++m)
#pragma unroll
                    for (int n = 0; n < 2; ++n) acc[a][b][m][n] = (f32x4){0.f, 0.f, 0.f, 0.f};
        cur = nxt; cA = nA; cB = nB; ++ui;
#pragma unroll
        for (int h = 0; h < NH; ++h)
#pragma unroll
            for (int i = 0; i < 2; ++i) vC[h][i] = vN[h][i];
        if (wr == 1) PG8_BAR;
    }
    PG8_WAIT_V(0);
    PG8_BAR;
#undef PG8_SA
#undef PG8_HA
#undef PG8_VH
#undef PG8_SB
#undef PG8_STAGE
#undef PG8_LDA
#undef PG8_LDB
#undef PG8_MMA
#undef PG8_WAIT_V
#undef PG8_WAIT_L
#undef PG8_BAR
#undef PG8_SCHED
}
}
using pg8::Unit;

__device__ __forceinline__ int tile_row0(int mt, bool lat_only) { return lat_only ? ((mt >> 3) * 9 + 1 + (mt & 7)) * 256 : mt * 256; }

struct SchedQKV {
    const char* H; const char* Wt;
    __device__ __forceinline__ bool next(int i, Unit& u) const { int mt, r; if (!pg8::deal(i, 12, M / 256, mt, r)) return false;
        if (r < 8) { u.kind = 0; u.pm = mt; u.pn = r; } else { u.kind = 1; u.pm = r - 8; u.pn = mt; } u.e = 0; return true; }
    static constexpr bool GATHER = false;
    __device__ __forceinline__ void a_offs(const Unit& u, int tid, unsigned (&v)[1][2]) const {
#pragma unroll
        for (int i = 0; i < 2; ++i) { int R, C; pg8::stage_rc(tid * 16 + i * 8192, R, C); v[0][i] = (unsigned)((u.pm * 256 + R) * 1024 + C) * 2u; } }
    __device__ __forceinline__ const char* a_base(const Unit& u) const { return u.kind == 0 ? H : Wt + (size_t)2048 * 2048; }
    __device__ __forceinline__ const char* b_base(const Unit& u) const { return (u.kind == 0 ? Wt : H) + (size_t)u.pn * 256 * 2048; }
};
struct SchedPlain {
    const char* A; const char* Bt; int npu; bool lat_only;
    __device__ __forceinline__ bool next(int i, Unit& u) const { int mt, r; if (!pg8::deal(i, npu, lat_only ? 128 : 144, mt, r)) return false;
        u.pm = tile_row0(mt, lat_only) >> 8; u.pn = r; u.e = 0; u.kind = 0; return true; }
    static constexpr bool GATHER = false;
    __device__ __forceinline__ void a_offs(const Unit& u, int tid, unsigned (&v)[1][2]) const {
#pragma unroll
        for (int i = 0; i < 2; ++i) { int R, C; pg8::stage_rc(tid * 16 + i * 8192, R, C); v[0][i] = (unsigned)((u.pm * 256 + R) * 1024 + C) * 2u; } }
    __device__ __forceinline__ const char* a_base(const Unit&) const { return A; }
    __device__ __forceinline__ const char* b_base(const Unit& u) const { return Bt + (size_t)u.pn * 256 * 2048; }
};
template <bool GATHER_> struct SchedMoe {
    static constexpr bool GATHER = GATHER_;
    const char* A; const char* Wt; const int* list; int npu; size_t estride;
    LAS const int* tstart; LAS const int* ecnt; LAS const int* tile_e;
    __device__ __forceinline__ bool next(int i, Unit& u) const { int mt, r; const int ntl = __builtin_amdgcn_readfirstlane(tstart[32]);
        if (!pg8::deal(i, npu, ntl, mt, r)) return false; u.pm = mt; u.pn = r; u.e = __builtin_amdgcn_readfirstlane(tile_e[mt]); u.kind = 0; return true; }
    __device__ __forceinline__ void a_offs(const Unit& u, int tid, unsigned (&v)[GATHER_ ? 2 : 1][2]) const {
        if constexpr (GATHER_) { const int j0 = (u.pm - __builtin_amdgcn_readfirstlane(tstart[u.e])) * 256, cnt = __builtin_amdgcn_readfirstlane(ecnt[u.e]); const int* lp = list + (size_t)u.e * CAP;
#pragma unroll
            for (int h = 0; h < 2; ++h)
#pragma unroll
                for (int i = 0; i < 2; ++i) { int R, C; pg8::stage_rc(tid * 16 + i * 8192, R, C); const int idx = j0 + h * 128 + R; const int tok = idx < cnt ? lp[idx] : 0; v[h][i] = (unsigned)(tok * 1024 + C) * 2u; }
        } else {
#pragma unroll
            for (int i = 0; i < 2; ++i) { int R, C; pg8::stage_rc(tid * 16 + i * 8192, R, C); v[0][i] = (unsigned)((u.pm * 256 + R) * 1024 + C) * 2u; } }
    }
    __device__ __forceinline__ const char* a_base(const Unit&) const { return A; }
    __device__ __forceinline__ const char* b_base(const Unit& u) const { return Wt + (size_t)u.e * estride + (size_t)u.pn * 256 * 2048; }
};

#define EPI_LOOP_ROWS for (int ai = 0; ai < 2; ++ai) _Pragma("unroll") for (int m = 0; m < 4; ++m)
__device__ __forceinline__ u32x4 pack8(const f32x4& v0, const f32x4& v1) { u32x4 w; w.x = cvt_pk_bf16(v0[0], v0[1]); w.y = cvt_pk_bf16(v0[2], v0[3]); w.z = cvt_pk_bf16(v1[0], v1[1]); w.w = cvt_pk_bf16(v1[2], v1[3]); return w; }

struct EpiQKV {
    bf16* Q; bf16* Kb; bf16* Vt; const float* cosT; const float* sinT;
    __device__ __forceinline__ void operator()(const f32x4 (&acc)[2][2][4][2], const Unit& u, int wr, int wc, int fr, int fq) const {
        if (u.kind == 0) {
            const bool isq = u.pn < 4; bf16* base = isq ? Q : Kb; const float sc = isq ? C2 : 1.f;
            const bool lat = (u.pm % 9) != 0; const int jp0 = 16 * (wc & 1) + 4 * fq;
#pragma unroll
            EPI_LOOP_ROWS { const int row = u.pm * 256 + ai * 128 + wr * 64 + m * 16 + fr; const int t = (row % RPB) - CTXL;
                f32x4 cs = {1.f, 1.f, 1.f, 1.f}, sn = {0.f, 0.f, 0.f, 0.f};
                if (lat) { cs = *(const f32x4*)(cosT + t * 32 + jp0); sn = *(const f32x4*)(sinT + t * 32 + jp0); }
#pragma unroll
                for (int bj = 0; bj < 2; ++bj) { const f32x4 a = acc[ai][bj][m][0], b = acc[ai][bj][m][1]; f32x4 o0, o1;
                    o0[0] = (a[0] * cs[0] - a[1] * sn[0]) * sc; o0[1] = (a[1] * cs[0] + a[0] * sn[0]) * sc; o0[2] = (a[2] * cs[1] - a[3] * sn[1]) * sc; o0[3] = (a[3] * cs[1] + a[2] * sn[1]) * sc;
                    o1[0] = (b[0] * cs[2] - b[1] * sn[2]) * sc; o1[1] = (b[1] * cs[2] + b[0] * sn[2]) * sc; o1[2] = (b[2] * cs[3] - b[3] * sn[3]) * sc; o1[3] = (b[3] * cs[3] + b[2] * sn[3]) * sc;
                    const int col = (u.pn & 3) * 256 + bj * 128 + wc * 32 + fq * 8;
                    *(u32x4*)(base + (size_t)row * 1024 + col) = pack8(o0, o1); } }
        } else {
#pragma unroll
            EPI_LOOP_ROWS { const int row = u.pm * 256 + ai * 128 + wr * 64 + m * 16 + fr;
#pragma unroll
                for (int bj = 0; bj < 2; ++bj) { const int col = u.pn * 256 + bj * 128 + wc * 32 + fq * 8;
                    *(u32x4*)(Vt + (size_t)row * M + col) = pack8(acc[ai][bj][m][0], acc[ai][bj][m][1]); } }
        }
    }
};
struct EpiPlain {
    bf16* O; int ldc;
    __device__ __forceinline__ void operator()(const f32x4 (&acc)[2][2][4][2], const Unit& u, int wr, int wc, int fr, int fq) const {
#pragma unroll
        EPI_LOOP_ROWS { const int row = u.pm * 256 + ai * 128 + wr * 64 + m * 16 + fr;
#pragma unroll
            for (int bj = 0; bj < 2; ++bj) { const int col = u.pn * 256 + bj * 128 + wc * 32 + fq * 8;
                *(u32x4*)(O + (size_t)row * ldc + col) = pack8(acc[ai][bj][m][0], acc[ai][bj][m][1]); } }
    }
};
struct EpiResid {
    const float* Xin; float* X; const float* gate;
    __device__ __forceinline__ void operator()(const f32x4 (&acc)[2][2][4][2], const Unit& u, int wr, int wc, int fr, int fq) const {
        const int rb = (u.pm % 9) == 0 ? 16 : u.pm / 9; const float* gp = gate + rb * 6144;
        f32x4 gv[2][2];
#pragma unroll
        for (int bj = 0; bj < 2; ++bj) { const int col = u.pn * 256 + bj * 128 + wc * 32 + fq * 8; gv[bj][0] = *(const f32x4*)(gp + col); gv[bj][1] = *(const f32x4*)(gp + col + 4); }
#pragma unroll
        EPI_LOOP_ROWS { const int row = u.pm * 256 + ai * 128 + wr * 64 + m * 16 + fr;
#pragma unroll
            for (int bj = 0; bj < 2; ++bj) { const int col = u.pn * 256 + bj * 128 + wc * 32 + fq * 8; const size_t o = (size_t)row * 1024 + col;
                const f32x4 x0 = *(const f32x4*)(Xin + o), x1 = *(const f32x4*)(Xin + o + 4);
                *(f32x4*)(X + o) = x0 + gv[bj][0] * acc[ai][bj][m][0]; *(f32x4*)(X + o + 4) = x1 + gv[bj][1] * acc[ai][bj][m][1]; } }
    }
};
__device__ __forceinline__ float swiglu1(float g, float l) {
    g = fminf(g, 7.f); l = fminf(fmaxf(l, -7.f), 7.f);
    const float s = __builtin_amdgcn_rcpf(1.f + __builtin_amdgcn_exp2f(-1.702f * 1.4426950408889634f * g));
    return g * s * (l + 1.f);
}
struct EpiSwiglu {
    bf16* ACT; const float* bgu;
    __device__ __forceinline__ void operator()(const f32x4 (&acc)[2][2][4][2], const Unit& u, int wr, int wc, int fr, int fq) const {
        const float* bp = bgu + u.e * 2048; f32x4 bv[2][2];
#pragma unroll
        for (int bj = 0; bj < 2; ++bj) { const int col = u.pn * 256 + bj * 128 + wc * 32 + fq * 8; bv[bj][0] = *(const f32x4*)(bp + col); bv[bj][1] = *(const f32x4*)(bp + col + 4); }
#pragma unroll
        EPI_LOOP_ROWS { const int row = u.pm * 256 + ai * 128 + wr * 64 + m * 16 + fr;
#pragma unroll
            for (int bj = 0; bj < 2; ++bj) { const f32x4 a = acc[ai][bj][m][0] + bv[bj][0], b = acc[ai][bj][m][1] + bv[bj][1];
                const int col = u.pn * 128 + bj * 64 + wc * 16 + fq * 4;
                u32x2 w; w.x = cvt_pk_bf16(swiglu1(a[0], a[1]), swiglu1(a[2], a[3])); w.y = cvt_pk_bf16(swiglu1(b[0], b[1]), swiglu1(b[2], b[3]));
                *(u32x2*)(ACT + (size_t)row * 1024 + col) = w; } }
    }
};
struct EpiDown {
    bf16* Y; const float* bd;
    __device__ __forceinline__ void operator()(const f32x4 (&acc)[2][2][4][2], const Unit& u, int wr, int wc, int fr, int fq) const {
        const float* bp = bd + u.e * 1024; f32x4 bv[2][2];
#pragma unroll
        for (int bj = 0; bj < 2; ++bj) { const int col = u.pn * 256 + bj * 128 + wc * 32 + fq * 8; bv[bj][0] = *(const f32x4*)(bp + col); bv[bj][1] = *(const f32x4*)(bp + col + 4); }
#pragma unroll
        EPI_LOOP_ROWS { const int row = u.pm * 256 + ai * 128 + wr * 64 + m * 16 + fr;
#pragma unroll
            for (int bj = 0; bj < 2; ++bj) { const int col = u.pn * 256 + bj * 128 + wc * 32 + fq * 8;
                *(u32x4*)(Y + (size_t)row * 1024 + col) = pack8(acc[ai][bj][m][0] + bv[bj][0], acc[ai][bj][m][1] + bv[bj][1]); } }
    }
};

namespace att {
constexpr int SLOT = 32768, VOFF = 16384;
__device__ __forceinline__ void glds16(const void* gsrc, unsigned lds_dst) { unsigned keep;
    asm volatile("s_mov_b32 %0, m0\n\ts_mov_b32 m0, %2\n\ts_nop 0\n\tglobal_load_lds_dwordx4 %1, off\n\ts_mov_b32 m0, %0" : "=&s"(keep) : "v"(gsrc), "s"(lds_dst) : "memory"); }
#define ATT_WAIT_BAR(N) asm volatile("s_waitcnt vmcnt(" #N ") lgkmcnt(0)\n\ts_barrier" ::: "memory")
__device__ __forceinline__ float half_swap_max(float m) { auto rr = __builtin_amdgcn_permlane32_swap(__float_as_uint(m), __float_as_uint(m), false, false); return fmaxf(__uint_as_float(rr[0]), __uint_as_float(rr[1])); }
__device__ __forceinline__ float half_swap_sum(float m) { auto rr = __builtin_amdgcn_permlane32_swap(__float_as_uint(m), __float_as_uint(m), false, false); return __uint_as_float(rr[0]) + __uint_as_float(rr[1]); }
__device__ __forceinline__ int crow(int r, int hi) { return (r & 3) + 8 * (r >> 2) + 4 * hi; }

__device__ __forceinline__ void attn_unit(LAS unsigned char* lds, LAS float* wsc  , const bf16* Q, const bf16* Kb, const bf16* Vt, bf16* O,
                                          int krow0, int h, int qrow0, int NT, float lam, float osc, const float* subg, const int tid) {
    const int lane = tid & 63, r32 = lane & 31, hi = lane >> 5; const int wid = __builtin_amdgcn_readfirstlane(tid >> 6);
    const int qg = wid >> 1, c = wid & 1;
    const unsigned lds0 = (unsigned)(uintptr_t)lds;
    const bf16* ksrc[2]; const bf16* vsrc[2];
#pragma unroll
    for (int i = 0; i < 2; ++i) { const int p = 2 * wid + i;
        { const int row = 4 * p + (lane >> 4), ch = (lane & 15) ^ (row & 15); ksrc[i] = Kb + (size_t)(krow0 + row) * 1024 + h * 128 + ch * 8; }
        { const int row = 8 * p + (lane >> 3), ch = (lane & 7) ^ ((row >> 1) & 7); vsrc[i] = Vt + (size_t)(h * 128 + row) * M + krow0 + ch * 8; } }
    const unsigned kdst = lds0 + (unsigned)wid * 2048u, vdst = lds0 + VOFF + (unsigned)wid * 2048u;
#define ATT_DMA(t, slot) do { const unsigned so_ = (unsigned)(slot) * SLOT; \
        glds16(ksrc[0] + (size_t)(t) * 64 * 1024, (unsigned)__builtin_amdgcn_readfirstlane(kdst + so_)); glds16(ksrc[1] + (size_t)(t) * 64 * 1024, (unsigned)__builtin_amdgcn_readfirstlane(kdst + so_ + 1024u)); \
        glds16(vsrc[0] + (size_t)(t) * 64, (unsigned)__builtin_amdgcn_readfirstlane(vdst + so_)); glds16(vsrc[1] + (size_t)(t) * 64, (unsigned)__builtin_amdgcn_readfirstlane(vdst + so_ + 1024u)); } while (0)
    const int key0 = (r32 & 0x13) | ((r32 & 4) << 1) | ((r32 & 8) >> 1);
    const int kx = key0 & 15, vx = (r32 >> 1) & 7;
    bf16x8 qf[4];
    { const bf16* qp = Q + (size_t)(qrow0 + qg * 32 + r32) * 1024 + h * 128 + c * 64 + hi * 8;
#pragma unroll
      for (int d0 = 0; d0 < 4; ++d0) qf[d0] = *(const bf16x8*)(qp + d0 * 16); }
    f32x16 o[4];
#pragma unroll
    for (int d0 = 0; d0 < 4; ++d0) o[d0] = f32x16{};
    float mref = 0.f, lsum = 0.f;
    asm volatile("s_waitcnt vmcnt(0)" ::: "memory");
    ATT_DMA(0, 0);
    if (NT > 1) ATT_DMA(1, 1);
    int slot = 0;
    for (int t = 0; t < NT; ++t) {
        if (t + 1 < NT) { ATT_WAIT_BAR(4); } else { ATT_WAIT_BAR(0); }
        if (t + 2 < NT) { const int s2 = slot == 0 ? 2 : slot - 1; ATT_DMA(t + 2, s2); }
        const LAS unsigned char* kb_ = lds + slot * SLOT; const LAS unsigned char* vb_ = kb_ + VOFF;
        f32x16 s0, s1;
#pragma unroll
        for (int r = 0; r < 16; ++r) { s0[r] = -mref; s1[r] = -mref; }
#pragma unroll
        for (int d0 = 0; d0 < 4; ++d0) { const int ch = (c * 8 + d0 * 2 + hi) ^ kx;
            const bf16x8 k0 = *(const LAS bf16x8*)(kb_ + key0 * 256 + ch * 16), k1 = *(const LAS bf16x8*)(kb_ + (key0 + 32) * 256 + ch * 16);
            s0 = __builtin_amdgcn_mfma_f32_32x32x16_bf16(k0, qf[d0], s0, 0, 0, 0); s1 = __builtin_amdgcn_mfma_f32_32x32x16_bf16(k1, qf[d0], s1, 0, 0, 0); }
        float rm = fmaxf(s0[0], s1[0]);
#pragma unroll
        for (int r = 1; r < 16; ++r) rm = fmaxf(rm, fmaxf(s0[r], s1[r]));
        rm = half_swap_max(rm);
        const bool need = (t == 0) || (rm > 8.f);
        if (__any(need)) {
            const float dl = need ? rm : 0.f; mref += dl;
#pragma unroll
            for (int r = 0; r < 16; ++r) { s0[r] -= dl; s1[r] -= dl; }
            const float f = (t == 0) ? 1.f : __builtin_amdgcn_exp2f(-dl); lsum *= f;
            if (hi == 0) wsc[r32] = f;
            asm volatile("s_waitcnt lgkmcnt(0)" ::: "memory");
#pragma unroll
            for (int r = 0; r < 16; ++r) { const float fr_ = wsc[crow(r, hi)];
#pragma unroll
                for (int d0 = 0; d0 < 4; ++d0) o[d0][r] *= fr_; }
            asm volatile("s_waitcnt lgkmcnt(0)" ::: "memory");
        }
        float sa = 0.f;
#pragma unroll
        for (int r = 0; r < 16; ++r) { s0[r] = __builtin_amdgcn_exp2f(s0[r]); s1[r] = __builtin_amdgcn_exp2f(s1[r]); sa += s0[r] + s1[r]; }
        lsum += sa;
        bf16x8 pa[4];
#pragma unroll
        for (int s = 0; s < 2; ++s) { u32x4 w0, w1;
            w0.x = cvt_pk_bf16(s0[8 * s + 0], s0[8 * s + 1]); w0.y = cvt_pk_bf16(s0[8 * s + 2], s0[8 * s + 3]); w0.z = cvt_pk_bf16(s0[8 * s + 4], s0[8 * s + 5]); w0.w = cvt_pk_bf16(s0[8 * s + 6], s0[8 * s + 7]);
            w1.x = cvt_pk_bf16(s1[8 * s + 0], s1[8 * s + 1]); w1.y = cvt_pk_bf16(s1[8 * s + 2], s1[8 * s + 3]); w1.z = cvt_pk_bf16(s1[8 * s + 4], s1[8 * s + 5]); w1.w = cvt_pk_bf16(s1[8 * s + 6], s1[8 * s + 7]);
            pa[s] = __builtin_bit_cast(bf16x8, w0); pa[2 + s] = __builtin_bit_cast(bf16x8, w1); }
#pragma unroll
        for (int ks = 0; ks < 4; ++ks) { const int ch = (2 * ks + hi) ^ vx;
#pragma unroll
            for (int d0 = 0; d0 < 4; ++d0) { const bf16x8 vf = *(const LAS bf16x8*)(vb_ + (d0 * 32 + r32) * 128 + ch * 16);
                o[d0] = __builtin_amdgcn_mfma_f32_32x32x16_bf16(pa[ks], vf, o[d0], 0, 0, 0); } }
        slot = slot == 2 ? 0 : slot + 1;
    }
    const float lt = half_swap_sum(lsum);
    if (hi == 0) wsc[64 + r32] = (c ? -lam : 1.f) * __builtin_amdgcn_rcpf(lt);
    asm volatile("s_waitcnt lgkmcnt(0)\n\ts_barrier" ::: "memory");
    LAS float* xch = (LAS float*)(lds + qg * 16384);
#pragma unroll
    for (int r = 0; r < 16; ++r) { const float a = wsc[64 + crow(r, hi)];
#pragma unroll
        for (int d0 = 0; d0 < 4; ++d0) o[d0][r] *= a; }
    if (c == 1) {
#pragma unroll
        for (int d0 = 0; d0 < 4; ++d0)
#pragma unroll
            for (int r = 0; r < 16; ++r) xch[(d0 * 16 + r) * 64 + lane] = o[d0][r];
    }
    asm volatile("s_waitcnt lgkmcnt(0)\n\ts_barrier" ::: "memory");
    if (c == 0) {
        float sg[4];
#pragma unroll
        for (int d0 = 0; d0 < 4; ++d0) sg[d0] = subg[d0 * 32 + r32] * osc;
        bf16* Ow = O + (size_t)(qrow0 + qg * 32) * 1024 + h * 128 + r32;
#pragma unroll
        for (int r = 0; r < 16; ++r) { const int qr = crow(r, hi);
            float v[4], ss = 0.f;
#pragma unroll
            for (int d0 = 0; d0 < 4; ++d0) { v[d0] = o[d0][r] + xch[(d0 * 16 + r) * 64 + lane]; ss += v[d0] * v[d0]; }
#pragma unroll
            for (int of = 1; of < 32; of <<= 1) ss += __shfl_xor(ss, of);
            const float rn = __builtin_amdgcn_rsqf(ss * (1.f / 128.f) + EPS);
#pragma unroll
            for (int d0 = 0; d0 < 4; ++d0) Ow[(size_t)qr * 1024 + d0 * 32] = (bf16)f2bf(v[d0] * rn * sg[d0]); }
    }
    asm volatile("s_waitcnt lgkmcnt(0)\n\ts_barrier" ::: "memory");
#undef ATT_DMA
}
}

__device__ __forceinline__ void load_row_f32(const float* p, int lane, f32x4 (&v)[4]) {
#pragma unroll
    for (int j = 0; j < 4; ++j) v[j] = *(const f32x4*)(p + 256 * j + 4 * lane);
}
__device__ __forceinline__ float row_rstd(const f32x4 (&v)[4]) {
    float s = 0.f;
#pragma unroll
    for (int j = 0; j < 4; ++j) s += (v[j][0] * v[j][0] + v[j][1] * v[j][1]) + (v[j][2] * v[j][2] + v[j][3] * v[j][3]);
    return 1.0f / sqrtf(wave_sum(s) * (1.f / D) + EPS);
}
__device__ __forceinline__ void norm_mod_store(f32x4 (&v)[4], const float* g, const float* sc, const float* sh, int lane, bf16* hrow) {
    const float rstd = row_rstd(v);
#pragma unroll
    for (int j = 0; j < 4; ++j) { const int c = 256 * j + 4 * lane; const f32x4 gg = *(const f32x4*)(g + c), ss = *(const f32x4*)(sc + c), hh = *(const f32x4*)(sh + c);
        v[j] = (v[j] * rstd) * gg * (ss + 1.f) + hh;
        u32x2 w; w.x = cvt_pk_bf16(v[j][0], v[j][1]); w.y = cvt_pk_bf16(v[j][2], v[j][3]); *(u32x2*)(hrow + c) = w; }
}
__device__ __forceinline__ int row_batch(int row) { return row / RPB; }
__device__ __forceinline__ bool row_is_ctx(int row) { return (row % RPB) < CTXL; }
__device__ __forceinline__ int act_row(int ai, bool lat_only) { return lat_only ? (ai >> 11) * RPB + CTXL + (ai & 2047) : ai; }

template <int MODE>
__device__ __forceinline__ void transpose_item(const float* W, int K, int N, bf16* WT, LAS float* scr, int item, int lane) {
    const int nblk = N / 32, kb = item / nblk, nb = item % nblk, k0 = 64 * kb, n0 = 32 * nb;
#pragma unroll 8
    for (int i = 0; i < 32; ++i) { const int kk = 2 * i + (lane >> 5); scr[kk * 33 + (lane & 31)] = W[(size_t)(k0 + kk) * N + n0 + (lane & 31)]; }
    asm volatile("s_waitcnt lgkmcnt(0)" ::: "memory");
    const int c = lane & 7;
#pragma unroll
    for (int j = 0; j < 4; ++j) { const int n = (lane >> 3) + 8 * j; const LAS float* s = scr + (8 * c) * 33 + n;
        u32x4 o; o.x = cvt_pk_bf16(s[0 * 33], s[1 * 33]); o.y = cvt_pk_bf16(s[2 * 33], s[3 * 33]); o.z = cvt_pk_bf16(s[4 * 33], s[5 * 33]); o.w = cvt_pk_bf16(s[6 * 33], s[7 * 33]);
        int nn = n0 + n;
        if (MODE == 1 && nn < 2048) { const int i6 = nn & 63; nn = (nn & ~63) + (i6 < 32 ? 2 * i6 : 2 * (i6 - 32) + 1); }
        *(u32x4*)(WT + (size_t)nn * K + k0 + 8 * c) = o; }
    asm volatile("s_waitcnt lgkmcnt(0)" ::: "memory");
}

struct Args { const float* in[21]; float* out; unsigned char* ws; int ph_lo, ph_hi; };
enum { I_X = 0, I_C, I_CTX, I_CCTX, I_MODW, I_MODB, I_NORMG, I_WQKV, I_WO, I_LAM, I_SUBG, I_WIN, I_CONVW, I_WOUT, I_RW, I_RB, I_WGU, I_BGU, I_WD, I_BD, I_FINALG };

__device__ __forceinline__ void moe_table(LAS unsigned char* lds, const unsigned* gcnt, int tid) {
    LAS int* ecnt = (LAS int*)(lds + LX_ECNT); LAS int* tstart = (LAS int*)(lds + LX_TSTART); LAS int* tile_e = (LAS int*)(lds + LX_TILEE);
    __syncthreads();
    if (tid < 32) ecnt[tid] = (int)__hip_atomic_load(gcnt + tid, RLX_AGENT);
    __syncthreads();
    if (tid == 0) { int ts = 0; for (int e = 0; e < 32; ++e) { tstart[e] = ts; ts += (ecnt[e] + 255) >> 8; } tstart[32] = ts; }
    __syncthreads();
    { const int e = tid >> 4, l16 = tid & 15; const int t0 = tstart[e], n = tstart[e + 1] - t0; for (int j = l16; j < n; j += 16) tile_e[t0 + j] = e; }
    __syncthreads();
}

typedef const __attribute__((address_space(4))) unsigned char* kptr_t;
__device__ __forceinline__ kptr_t kargs() { kptr_t p = (kptr_t)__builtin_amdgcn_kernarg_segment_ptr(); asm volatile("" : "+s"(p)); return p; }
#define INP(k) (*(const float* const __attribute__((address_space(4)))*)(kargs() + 8 * (k)))
#define OUTP() (*(float* const __attribute__((address_space(4)))*)(kargs() + 168))
#define WSB() (*(unsigned char* const __attribute__((address_space(4)))*)(kargs() + 176))
#define WSP(T, off) ((T*)(WSB() + (off)))
static_assert(sizeof(Args) == 192, "kernarg layout");
__global__ void __launch_bounds__(NTHREADS, 2) fwd(Args args) {
    extern __shared__ __attribute__((aligned(16))) unsigned char lds_raw[];
    LAS unsigned char* lds = (LAS unsigned char*)lds_raw;
    const int tid = threadIdx.x, lane = tid & 63, wave = __builtin_amdgcn_readfirstlane(tid >> 6);
    const int G = gridDim.x, bid = blockIdx.x;
    const int gw = bid * NWAVES + wave, NGW = G * NWAVES;
    gu32* ctl = (gu32*)WSP(unsigned, WS_CTL);
    for (int u = tid; u < (LDS_BYTES - LX) / 4; u += NTHREADS) ((LAS unsigned*)(lds + LX))[u] = 0u;
    __syncthreads();
    volatile LAS unsigned* MISC = (volatile LAS unsigned*)(lds + LX_MISC);
    XcdBarrier bar; bar.bar = (unsigned*)(ctl + CW_BAR); bar.x = 0; bar.st = nullptr;
    if (!MK_PER_PHASE) bar = xcd_barrier_post((unsigned*)(ctl + CW_BAR), MISC + 8);
    (void)args;
    const int lo = *(const int __attribute__((address_space(4)))*)(kargs() + 184), hi = *(const int __attribute__((address_space(4)))*)(kargs() + 188);
#define IN(k) (lo <= (k) && (k) < hi)
#define PHASE_IDS int tid = threadIdx.x; asm volatile("" : "+v"(tid)); const int lane = tid & 63, wave = __builtin_amdgcn_readfirstlane(tid >> 6); const int gw = bid * NWAVES + wave; (void)lane; (void)gw;
#define SEAM(k) do { if (IN(k) && IN((k) + 1)) { if (MK_PER_PHASE) { if (tid == 0) __hip_atomic_store(ctl + CW_TMO, 0xBADu, RLX_AGENT); } else xcd_barrier(bar); } } while (0)

    if (PS(0) && IN(0)) { PHASE_IDS
        float* modv = WSP(float, WS_MODV);
        { LAS float* sil = (LAS float*)lds;
          LAS float* red = (LAS float*)(lds + 69632);
          for (int i = tid; i < 17 * 1024; i += NTHREADS) { const int r = i >> 10, k = i & 1023; const float cv = r < 16 ? INP(I_C)[r * 1024 + k] : INP(I_CCTX)[k]; sil[i] = cv / (1.f + __expf(-cv)); }
          __syncthreads();
          for (int it = bid; it < 4 * 96; it += G) { const int l = it / 96, nb = it % 96; const float* W = INP(I_MODW) + (size_t)l * 1024 * 6144 + nb * 64 + lane;
            float a[17];
#pragma unroll
            for (int r = 0; r < 17; ++r) a[r] = 0.f;
            for (int k = wave * 128; k < wave * 128 + 128; k += 4) { float w[4];
#pragma unroll
                for (int q = 0; q < 4; ++q) w[q] = W[(size_t)(k + q) * 6144];
#pragma unroll
                for (int r = 0; r < 17; ++r) { const f32x4 s = *(const LAS f32x4*)(sil + r * 1024 + k); a[r] += s[0] * w[0] + s[1] * w[1] + s[2] * w[2] + s[3] * w[3]; } }
#pragma unroll
            for (int r = 0; r < 17; ++r) red[(wave * 17 + r) * 64 + lane] = a[r];
            __syncthreads();
            for (int i = tid; i < 17 * 64; i += NTHREADS) { const int r = i >> 6, n = i & 63; float s = INP(I_MODB)[l * 6144 + nb * 64 + n];
#pragma unroll
                for (int w8 = 0; w8 < 8; ++w8) s += red[(w8 * 17 + r) * 64 + n];
                modv[((size_t)l * 17 + r) * 6144 + nb * 64 + n] = s; }
            __syncthreads(); }
        }
        { float* cosT = WSP(float, WS_ROPE); float* sinT = cosT + 2048 * 32; float* rwT = WSP(float, WS_RW); float* lamv = WSP(float, WS_MISC);
        for (int i = bid * NTHREADS + tid; i < 2048 * 32; i += G * NTHREADS) { const int t = i >> 5, j = i & 31; const float pos = (float)(j < 16 ? (t >> 6) : (t & 63));
            const float inv = powf(10000.f, -(float)(2 * (j & 15)) / 32.f); const float ang = pos * inv; cosT[i] = cosf(ang); sinT[i] = sinf(ang); }
        if (bid == 0 && tid < 2) { const float* lp = INP(I_LAM) + tid * 256; float s1 = 0.f, s2 = 0.f; for (int d = 0; d < 64; ++d) { s1 += lp[d] * lp[64 + d]; s2 += lp[128 + d] * lp[192 + d]; }
            const float lam_init = 0.8f - 0.6f * expf(-0.3f * (float)(2 * tid)); lamv[tid] = expf(s1) - expf(s2) + lam_init; lamv[2 + tid] = 1.f - lam_init; }
        for (int i = bid * NTHREADS + tid; i < 4 * 32 * 1024; i += G * NTHREADS) { const int l = i >> 15, e = (i >> 10) & 31, k = i & 1023; rwT[i] = INP(I_RW)[((size_t)l * 1024 + k) * 32 + e]; } }
        { LAS float* scr = (LAS float*)(lds + wave * 8704);
          bf16* Wqkv_t = WSP(bf16, WS_WQKV); bf16* Win_t = WSP(bf16, WS_WIN); bf16* Wo_t = WSP(bf16, WS_WO); bf16* Wout_t = WSP(bf16, WS_WOUT); bf16* Wgu_t = WSP(bf16, WS_WGU); bf16* Wd_t = WSP(bf16, WS_WD);
          constexpr int I_QKV = 16 * 96, I_SQ = 16 * 32, I_GU = 16 * 64, I_D = 16 * 32;
          constexpr int T0 = 2 * I_QKV, T1 = T0 + 2 * I_QKV, T2 = T1 + 2 * I_SQ, T3 = T2 + 2 * I_SQ, T4 = T3 + 128 * I_GU, T5 = T4 + 128 * I_D;
          for (int it = gw; it < T5; it += NGW) {
            if (it < T0) { const int j = it / I_QKV; transpose_item<1>(INP(I_WQKV) + (size_t)j * 1024 * 3072, 1024, 3072, Wqkv_t + (size_t)j * 3072 * 1024, scr, it % I_QKV, lane); }
            else if (it < T1) { const int r = it - T0, j = r / I_QKV; transpose_item<0>(INP(I_WIN) + (size_t)j * 1024 * 3072, 1024, 3072, Win_t + (size_t)j * 3072 * 1024, scr, r % I_QKV, lane); }
            else if (it < T2) { const int r = it - T1, j = r / I_SQ; transpose_item<0>(INP(I_WO) + (size_t)j * 1024 * 1024, 1024, 1024, Wo_t + (size_t)j * 1024 * 1024, scr, r % I_SQ, lane); }
            else if (it < T3) { const int r = it - T2, j = r / I_SQ; transpose_item<0>(INP(I_WOUT) + (size_t)j * 1024 * 1024, 1024, 1024, Wout_t + (size_t)j * 1024 * 1024, scr, r % I_SQ, lane); }
            else if (it < T4) { const int r = it - T3, j = r / I_GU; transpose_item<0>(INP(I_WGU) + (size_t)j * 1024 * 2048, 1024, 2048, Wgu_t + (size_t)j * 2048 * 1024, scr, r % I_GU, lane); }
            else { const int r = it - T4, j = r / I_D; transpose_item<0>(INP(I_WD) + (size_t)j * 1024 * 1024, 1024, 1024, Wd_t + (size_t)j * 1024 * 1024, scr, r % I_D, lane); }
          }
        }
        __syncthreads();
    }
    SEAM(0);

    if (PS(1) && IN(1)) { PHASE_IDS
        const float* g = INP(I_NORMG); const float* modv = WSP(float, WS_MODV); float* X = WSP(float, WS_X); bf16* H = WSP(bf16, WS_H);
        for (int row = gw; row < M; row += NGW) { const int b = row_batch(row), jj = row % RPB; const bool cx = jj < CTXL; const int rb = cx ? 16 : b;
            const float* src = cx ? INP(I_CTX) + ((size_t)b * CTXL + jj) * D : INP(I_X) + ((size_t)b * SEQ + (jj - CTXL)) * D;
            f32x4 v[4]; load_row_f32(src, lane, v);
#pragma unroll
            for (int j = 0; j < 4; ++j) *(f32x4*)(X + (size_t)row * D + 256 * j + 4 * lane) = v[j];
            norm_mod_store(v, g, modv + rb * 6144 + 1024, modv + rb * 6144, lane, H + (size_t)row * D); }
    }
    SEAM(1);

    for (int l = 0; l < DEPTH; ++l) {
        const int pb = 2 + 7 * l; const bool attn = (l & 1) == 0; const int j2 = l >> 1; const bool lat_only = (l == DEPTH - 1);
#define MV() (WSP(float, WS_MODV) + (size_t)l * 17 * 6144)
        const unsigned* gcnt = (const unsigned*)(ctl + CW_CNT) + l * 32;

        if (IN(pb)) { PHASE_IDS
            if (PS(2) && attn) {
                SchedQKV S{(const char*)WSP(bf16, WS_H), (const char*)(WSP(bf16, WS_WQKV) + (size_t)j2 * 3072 * 1024)};
                EpiQKV E{WSP(bf16, WS_Q), WSP(bf16, WS_K), WSP(bf16, WS_VT), WSP(float, WS_ROPE), WSP(float, WS_ROPE) + 2048 * 32};
                pg8::gemm_phase<EpiQKV, SchedQKV>(lds, S, E, tid);
            } else if (PS(3)) {
                SchedPlain S{(const char*)WSP(bf16, WS_H), (const char*)(WSP(bf16, WS_WIN) + (size_t)j2 * 3072 * 1024), 12, lat_only};
                EpiPlain E{WSP(bf16, WS_BCO), 3072};
                pg8::gemm_phase<EpiPlain, SchedPlain>(lds, S, E, tid);
            }
        }
        SEAM(pb);

        if (IN(pb + 1)) { PHASE_IDS
            if (PS(4) && attn) {
                const float* lamv = WSP(float, WS_MISC); const float lam = lamv[j2], osc = lamv[2 + j2]; const float* subg = INP(I_SUBG) + j2 * 128;
                const bf16* Qb = WSP(bf16, WS_Q); const bf16* Kb = WSP(bf16, WS_K); const bf16* Vt = WSP(bf16, WS_VT); bf16* Ob = WSP(bf16, WS_O);
                LAS float* wsc = (LAS float*)(lds + LX_WSC + wave * 1024);
                const int vcu = (G % 8 == 0) ? (bid % 8) * (G / 8) + bid / 8 : bid;
                if (G == 256) {
                    const int bh = vcu >> 1, half = vcu & 1, b = bh >> 3, h = bh & 7;
                    for (int i = 0; i < 8; ++i) att::attn_unit(lds, wsc, Qb, Kb, Vt, Ob, b * RPB, h, b * RPB + CTXL + (8 * half + i) * 128, 36, lam, osc, subg, tid);
                    att::attn_unit(lds, wsc, Qb, Kb, Vt, Ob, b * RPB, h, b * RPB + half * 128, 4, lam, osc, subg, tid);
                } else {
                    for (int u = bid; u < 128 * 18; u += G) { const int bh = u / 18, k = u % 18, b = bh >> 3, h = bh & 7;
                        att::attn_unit(lds, wsc, Qb, Kb, Vt, Ob, b * RPB, h, k < 16 ? b * RPB + CTXL + k * 128 : b * RPB + (k - 16) * 128, k < 16 ? 36 : 4, lam, osc, subg, tid); }
                }
            } else if (PS(5)) {
                const float* cw = INP(I_CONVW) + (size_t)j2 * 3 * 1024; const bf16* BCO = WSP(bf16, WS_BCO); bf16* Ob = WSP(bf16, WS_O);
                const int nact = lat_only ? 32768 : M; const int nitems = (nact / 16) * 2;
                for (int it = gw; it < nitems; it += NGW) { const int strip = it >> 1, ch = (it & 1) * 512 + lane * 8; const int row0 = act_row(strip * 16, lat_only);
                    const int jj = row0 % RPB; const int seq_lo = jj < CTXL ? row0 - jj : row0 - jj + CTXL, seq_hi = jj < CTXL ? row0 - jj + CTXL : row0 - jj + RPB;
                    float w0[8], w1[8], w2[8];
#pragma unroll
                    for (int q = 0; q < 8; ++q) { w0[q] = cw[ch + q]; w1[q] = cw[1024 + ch + q]; w2[q] = cw[2048 + ch + q]; }
                    float up[8], uc[8], un[8];
                    auto load_u = [&](int row, float (&u)[8]) {
                        if (row < seq_lo || row >= seq_hi) {
#pragma unroll
                            for (int q = 0; q < 8; ++q) u[q] = 0.f;
                        } else { const bf16* p = BCO + (size_t)row * 3072; const u32x4 gc = *(const u32x4*)(p + 1024 + ch), xt = *(const u32x4*)(p + 2048 + ch);
#pragma unroll
                            for (int q = 0; q < 4; ++q) { u[2 * q] = bf2f((unsigned short)(gc[q] & 0xffffu)) * bf2f((unsigned short)(xt[q] & 0xffffu)); u[2 * q + 1] = bf2f((unsigned short)(gc[q] >> 16)) * bf2f((unsigned short)(xt[q] >> 16)); } } };
                    load_u(row0 - 1, up); load_u(row0, uc);
                    for (int r = 0; r < 16; ++r) { const int row = row0 + r; load_u(row + 1, un);
                        const u32x4 gb = *(const u32x4*)(BCO + (size_t)row * 3072 + ch); float z[8];
#pragma unroll
                        for (int q = 0; q < 8; ++q) { const float gbv = bf2f((unsigned short)((q & 1) ? (gb[q >> 1] >> 16) : (gb[q >> 1] & 0xffffu))); z[q] = gbv * (w0[q] * up[q] + w1[q] * uc[q] + w2[q] * un[q]); }
                        u32x4 o; o.x = cvt_pk_bf16(z[0], z[1]); o.y = cvt_pk_bf16(z[2], z[3]); o.z = cvt_pk_bf16(z[4], z[5]); o.w = cvt_pk_bf16(z[6], z[7]);
                        *(u32x4*)(Ob + (size_t)row * 1024 + ch) = o;
#pragma unroll
                        for (int q = 0; q < 8; ++q) { up[q] = uc[q]; uc[q] = un[q]; } } }
            }
        }
        SEAM(pb + 1);

        if (PS(6) && IN(pb + 2)) { PHASE_IDS
            SchedPlain S{(const char*)WSP(bf16, WS_O), (const char*)(WSP(bf16, attn ? WS_WO : WS_WOUT) + (size_t)j2 * 1024 * 1024), 4, lat_only};
            float* X = WSP(float, WS_X);
            EpiResid E{X, X, MV() + 2 * 1024};
            pg8::gemm_phase<EpiResid, SchedPlain>(lds, S, E, tid);
        }
        SEAM(pb + 2);

        if (PS(7) && IN(pb + 3)) { PHASE_IDS
            LAS int* lcnt = (LAS int*)(lds + LX_LCNT); LAS int* lbase = (LAS int*)(lds + LX_LBASE); LAS int* asg = (LAS int*)(lds + LX_ASG);
            LAS float* wsc = (LAS float*)(lds + LX_WSC + wave * 1024);
            __syncthreads();
            float* X = WSP(float, WS_X); bf16* H = WSP(bf16, WS_H); const float* mv = MV(); int* topE = WSP(int, WS_TOPE); float* topG = WSP(float, WS_TOPG); int* topP = WSP(int, WS_TOPP); int* list = WSP(int, WS_LIST);
            { const float* rw = WSP(float, WS_RW) + (size_t)l * 32 * 1024; for (int i = tid; i < 32 * 1024 / 4; i += NTHREADS) ((LAS f32x4*)lds)[i] = ((const f32x4*)rw)[i]; }
            if (tid < 32) lcnt[tid] = 0;
            __syncthreads();
            const int nact = lat_only ? 32768 : M; const int rpb = (nact + G - 1) / G; const int a0 = bid * rpb; int nr = nact - a0; nr = nr < 0 ? 0 : (nr > rpb ? rpb : nr);
            const float* g = INP(I_NORMG) + ((size_t)l * 2 + 1) * 1024; const float* rb_ = INP(I_RB) + l * 32;
            for (int i = wave; i < nr; i += NWAVES) { const int row = act_row(a0 + i, lat_only); const int rb = row_is_ctx(row) ? 16 : row_batch(row);
                f32x4 v[4]; load_row_f32(X + (size_t)row * D, lane, v);
                norm_mod_store(v, g, mv + rb * 6144 + 4 * 1024, mv + rb * 6144 + 3 * 1024, lane, H + (size_t)row * D);
                float a[32];
#pragma unroll
                for (int e = 0; e < 32; ++e) { float s = 0.f;
#pragma unroll
                    for (int j = 0; j < 4; ++j) { const f32x4 w = *(const LAS f32x4*)(lds + ((e * 1024 + 256 * j + 4 * lane) << 2)); s += v[j][0] * w[0] + v[j][1] * w[1] + v[j][2] * w[2] + v[j][3] * w[3]; }
                    a[e] = s; }
#define RS_STEP(NIN, MASK) { const bool bit_ = (lane & (MASK)) != 0; _Pragma("unroll") for (int q = 0; q < (NIN) / 2; ++q) { const float keep_ = bit_ ? a[q + (NIN) / 2] : a[q]; const float send_ = bit_ ? a[q] : a[q + (NIN) / 2]; a[q] = keep_ + __shfl_xor(send_, (MASK)); } }
                RS_STEP(32, 32) RS_STEP(16, 16) RS_STEP(8, 8) RS_STEP(4, 4) RS_STEP(2, 2)
#undef RS_STEP
                const int my_e = lane >> 1; const float lg = a[0] + __shfl_xor(a[0], 1) + rb_[my_e];
                if ((lane & 1) == 0) wsc[my_e] = lg;
                asm volatile("s_waitcnt lgkmcnt(0)" ::: "memory");
                int rank = 0;
#pragma unroll
                for (int e = 0; e < 32; ++e) { const float o = wsc[e]; rank += (o > lg || (o == lg && e < my_e)) ? 1 : 0; }
                asm volatile("s_waitcnt lgkmcnt(0)" ::: "memory");
                if ((lane & 1) == 0 && rank < 4) { wsc[64 + rank] = lg; ((LAS int*)wsc)[72 + rank] = my_e; }
                asm volatile("s_waitcnt lgkmcnt(0)" ::: "memory");
                const float t0 = wsc[64], t1 = wsc[65], t2 = wsc[66], t3 = wsc[67];
                const float p0 = 1.f, p1 = __expf(t1 - t0), p2 = __expf(t2 - t0), p3 = __expf(t3 - t0); const float inv = 1.f / (p0 + p1 + p2 + p3);
                if (lane < 4) { const int e = ((LAS int*)wsc)[72 + lane]; const float p = lane == 0 ? p0 : lane == 1 ? p1 : lane == 2 ? p2 : p3;
                    const int lp = __hip_atomic_fetch_add(lcnt + e, 1, __ATOMIC_RELAXED, __HIP_MEMORY_SCOPE_WORKGROUP);
                    topE[row * 4 + lane] = e; topG[row * 4 + lane] = p * inv; asg[i * 4 + lane] = (lp << 5) | e; }
                asm volatile("s_waitcnt lgkmcnt(0)" ::: "memory");
            }
            __syncthreads();
            if (tid < 32) lbase[tid] = (int)__hip_atomic_fetch_add((unsigned*)gcnt + tid, (unsigned)lcnt[tid], RLX_AGENT);
            __syncthreads();
            for (int i = tid; i < nr * 4; i += NTHREADS) { const int av = asg[i], e = av & 31, pos = lbase[e] + (av >> 5); const int row = act_row(a0 + (i >> 2), lat_only);
                list[(size_t)e * CAP + pos] = row; topP[row * 4 + (i & 3)] = pos; }
            __syncthreads();
        }
        SEAM(pb + 3);

        if (PS(8) && IN(pb + 4)) { PHASE_IDS
            moe_table(lds, gcnt, tid);
            SchedMoe<true> S{(const char*)WSP(bf16, WS_H), (const char*)(WSP(bf16, WS_WGU) + (size_t)l * 32 * 2048 * 1024), WSP(int, WS_LIST), 8, (size_t)2048 * 2048,
                             (LAS const int*)(lds + LX_TSTART), (LAS const int*)(lds + LX_ECNT), (LAS const int*)(lds + LX_TILEE)};
            EpiSwiglu E{WSP(bf16, WS_ACT), INP(I_BGU) + (size_t)l * 32 * 2048};
            pg8::gemm_phase<EpiSwiglu, SchedMoe<true>>(lds, S, E, tid);
        }
        SEAM(pb + 4);

        if (PS(9) && IN(pb + 5)) { PHASE_IDS
            moe_table(lds, gcnt, tid);
            SchedMoe<false> S{(const char*)WSP(bf16, WS_ACT), (const char*)(WSP(bf16, WS_WD) + (size_t)l * 32 * 1024 * 1024), WSP(int, WS_LIST), 4, (size_t)1024 * 2048,
                              (LAS const int*)(lds + LX_TSTART), (LAS const int*)(lds + LX_ECNT), (LAS const int*)(lds + LX_TILEE)};
            EpiDown E{WSP(bf16, WS_Y), INP(I_BD) + (size_t)l * 32 * 1024};
            pg8::gemm_phase<EpiDown, SchedMoe<false>>(lds, S, E, tid);
        }
        SEAM(pb + 5);

        if (PS(10) && IN(pb + 6)) { PHASE_IDS
            moe_table(lds, gcnt, tid);
            LAS const int* tstart = (LAS const int*)(lds + LX_TSTART);
            const int nact = lat_only ? 32768 : M;
            const float* gn = (l + 1 < DEPTH) ? INP(I_NORMG) + (size_t)(l + 1) * 2 * 1024 : INP(I_FINALG);
            const float* mv = MV(); const float* mvn = mv + 17 * 6144; float* X = WSP(float, WS_X); bf16* H = WSP(bf16, WS_H); const bf16* Yb = WSP(bf16, WS_Y);
            const int* topE = WSP(int, WS_TOPE); const float* topG = WSP(float, WS_TOPG); const int* topP = WSP(int, WS_TOPP);
            for (int ai = gw; ai < nact; ai += NGW) { const int row = act_row(ai, lat_only); const bool cx = row_is_ctx(row); const int rb = cx ? 16 : row_batch(row);
                f32x4 v[4]; load_row_f32(X + (size_t)row * D, lane, v);
                const int4 ev = *(const int4*)(topE + row * 4), pv = *(const int4*)(topP + row * 4); const f32x4 gv = *(const f32x4*)(topG + row * 4);
                const int ee[4] = {ev.x, ev.y, ev.z, ev.w}, pp[4] = {pv.x, pv.y, pv.z, pv.w};
                f32x4 acc4[4];
#pragma unroll
                for (int j = 0; j < 4; ++j) acc4[j] = (f32x4){0.f, 0.f, 0.f, 0.f};
#pragma unroll
                for (int k = 0; k < 4; ++k) { const bf16* yr = Yb + (size_t)(tstart[ee[k]] * 256 + pp[k]) * 1024; const float gk = gv[k];
#pragma unroll
                    for (int j = 0; j < 4; ++j) { const u32x2 w = *(const u32x2*)(yr + 256 * j + 4 * lane);
                        acc4[j][0] += gk * bf2f((unsigned short)(w.x & 0xffffu)); acc4[j][1] += gk * bf2f((unsigned short)(w.x >> 16)); acc4[j][2] += gk * bf2f((unsigned short)(w.y & 0xffffu)); acc4[j][3] += gk * bf2f((unsigned short)(w.y >> 16)); } }
                const float* g2 = mv + rb * 6144 + 5 * 1024;
#pragma unroll
                for (int j = 0; j < 4; ++j) { const f32x4 gg = *(const f32x4*)(g2 + 256 * j + 4 * lane); v[j] = v[j] + gg * acc4[j]; }
                if (l + 1 < DEPTH) {
#pragma unroll
                    for (int j = 0; j < 4; ++j) *(f32x4*)(X + (size_t)row * D + 256 * j + 4 * lane) = v[j];
                    if (!(l + 1 == DEPTH - 1 && cx))
                        norm_mod_store(v, gn, mvn + rb * 6144 + 1024, mvn + rb * 6144, lane, H + (size_t)row * D);
                } else {
                    const float rstd = row_rstd(v); float* op = OUTP() + ((size_t)row_batch(row) * SEQ + (row % RPB - CTXL)) * D;
#pragma unroll
                    for (int j = 0; j < 4; ++j) { const f32x4 gg = *(const f32x4*)(gn + 256 * j + 4 * lane); *(f32x4*)(op + 256 * j + 4 * lane) = (v[j] * rstd) * gg; }
                }
            }
        }
        if (l + 1 < DEPTH) SEAM(pb + 6);
    }
#undef IN
#undef SEAM
#undef MV
}

extern "C" void kernel_launch(void* const* d_in, const int* in_sizes, int n_in, void* d_out, int out_size, void* d_ws, size_t ws_size, hipStream_t stream) {
    static int grid = 0;
    if (grid == 0) {
        if (n_in != 21 || out_size != NB * SEQ * D || ws_size < WS_END) { fprintf(stderr, "kernel_launch: unexpected shapes (n_in %d, out %d, ws %zu)\n", n_in, out_size, ws_size); grid = -1; return; }
        int dev = 0, cus = 0, per_cu = 0;
        if (hipGetDevice(&dev) != hipSuccess || hipDeviceGetAttribute(&cus, hipDeviceAttributeMultiprocessorCount, dev) != hipSuccess) { grid = -1; return; }
        if (hipFuncSetAttribute((const void*)fwd, hipFuncAttributeMaxDynamicSharedMemorySize, LDS_BYTES) != hipSuccess) { fprintf(stderr, "kernel_launch: hipFuncSetAttribute failed\n"); grid = -1; return; }
        if (hipOccupancyMaxActiveBlocksPerMultiprocessor(&per_cu, (const void*)fwd, NTHREADS, LDS_BYTES) != hipSuccess || per_cu < 1) { fprintf(stderr, "kernel_launch: occupancy query says %d\n", per_cu); }
        (void)hipGetLastError();
        if (cus < 160) { fprintf(stderr, "kernel_launch: needs >= 160 CUs\n"); grid = -1; return; }
        grid = cus;
    }
    if (grid < 0) return;
    if (hipMemsetAsync((char*)d_ws + WS_CTL, 0, CTL_ZERO_BYTES, stream) != hipSuccess) return;
    Args a{};
    for (int i = 0; i < 21; ++i) a.in[i] = (const float*)d_in[i];
    a.out = (float*)d_out; a.ws = (unsigned char*)d_ws;
#if MK_PER_PHASE
    for (int p = 0; p < NPHASE; ++p) { a.ph_lo = p; a.ph_hi = p + 1; hipLaunchKernelGGL(fwd, dim3(grid), dim3(NTHREADS), LDS_BYTES, stream, a); }
#else
    a.ph_lo = 0; a.ph_hi = NPHASE;
    hipLaunchKernelGGL(fwd, dim3(grid), dim3(NTHREADS), LDS_BYTES, stream, a);
#endif
    const hipError_t le = hipPeekAtLastError();
    if (le != hipSuccess) fprintf(stderr, "kernel_launch: launch failed: %s\n", hipGetErrorName(le));
}
```

```cpp
#include <hip/hip_runtime.h>
#include <cstdio>
#include <cstdint>

#ifndef MK_PER_PHASE
#define MK_PER_PHASE 0
#endif

#ifndef PHSEL
#define PHSEL 0xffff
#endif
#define PS(k) ((PHSEL >> (k)) & 1)
#define GAS __attribute__((address_space(1)))
#define LAS __attribute__((address_space(3)))
typedef unsigned short bf16;
typedef short bf16x8 __attribute__((ext_vector_type(8)));
typedef float f32x4 __attribute__((ext_vector_type(4)));
typedef float f32x2 __attribute__((ext_vector_type(2)));
typedef float f32x16 __attribute__((ext_vector_type(16)));
typedef unsigned u32x4 __attribute__((ext_vector_type(4)));
typedef unsigned u32x2 __attribute__((ext_vector_type(2)));
typedef GAS unsigned gu32;

constexpr int D = 1024, NB = 16, SEQ = 2048, CTXL = 256, RPB = SEQ + CTXL, M = NB * RPB, DEPTH = 4;
constexpr int NE = 32, TOPK = 4, NMOD = 6;
constexpr int CAP = M;
constexpr int ACT_ROWS = M * TOPK + NE * 256;
constexpr float EPS = 1e-5f;
constexpr float C2 = 0.125f * 1.4426950408889634f;
constexpr int NPHASE = 2 + 7 * DEPTH;

constexpr size_t MiB = 1u << 20;
constexpr size_t WS_CTL = 0, CTL_ZERO_BYTES = 1 * MiB;
constexpr size_t WS_MODV = 1 * MiB;
constexpr size_t WS_ROPE = 3 * MiB;
constexpr size_t WS_RW = 4 * MiB;
constexpr size_t WS_MISC = 5 * MiB;
constexpr size_t WS_TOPE = 6 * MiB;
constexpr size_t WS_TOPG = 7 * MiB;
constexpr size_t WS_TOPP = 8 * MiB;
constexpr size_t WS_LIST = 9 * MiB;
constexpr size_t WS_WQKV = 16 * MiB;
constexpr size_t WS_WIN = 28 * MiB;
constexpr size_t WS_WO = 40 * MiB;
constexpr size_t WS_WOUT = 44 * MiB;
constexpr size_t WS_WGU = 48 * MiB;
constexpr size_t WS_WD = 560 * MiB;
constexpr size_t WS_X = 816 * MiB;
constexpr size_t WS_H = 960 * MiB;
constexpr size_t WS_Q = 1032 * MiB;
constexpr size_t WS_K = 1104 * MiB;
constexpr size_t WS_VT = 1176 * MiB;
constexpr size_t WS_BCO = WS_Q;
constexpr size_t WS_O = 1248 * MiB;
constexpr size_t WS_ACT = 1320 * MiB;
constexpr size_t WS_Y = 1624 * MiB;
constexpr size_t WS_END = 1928 * MiB;
static_assert((size_t)M * 3072 * 2 == 216 * MiB && (size_t)ACT_ROWS * 2048 == 304 * MiB && (size_t)M * 4096 == 144 * MiB, "ws map");

constexpr int CW_TMO = 0;
constexpr int CW_BAR = 4096;
constexpr int CW_CNT = 16384;

constexpr int RING_BYTES = 131072;
constexpr int LX = RING_BYTES;
constexpr int LX_MISC = LX + 0;
constexpr int LX_TSTART = LX + 256;
constexpr int LX_ECNT = LX + 512;
constexpr int LX_LCNT = LX + 640;
constexpr int LX_LBASE = LX + 768;
constexpr int LX_TILEE = LX + 1024;
constexpr int LX_WSC = LX + 4096;
constexpr int LX_ASG = LX + 12288;
constexpr int LDS_BYTES = LX + 16384;
constexpr int NWAVES = 8, NTHREADS = 512;

#define RLX_AGENT __ATOMIC_RELAXED, __HIP_MEMORY_SCOPE_AGENT
__device__ __forceinline__ unsigned f2bf(float f) { unsigned u = __builtin_bit_cast(unsigned, f); return (u + 0x7fffu + ((u >> 16) & 1u)) >> 16; }
__device__ __forceinline__ unsigned cvt_pk_bf16(float lo, float hi) { unsigned r; asm volatile("v_cvt_pk_bf16_f32 %0, %1, %2" : "=v"(r) : "v"(lo), "v"(hi)); return r; }
__device__ __forceinline__ float bf2f(unsigned short b) { return __builtin_bit_cast(float, (unsigned)b << 16); }
__device__ __forceinline__ float wave_sum(float v) {
#pragma unroll
    for (int o = 1; o < 64; o <<= 1) v += __shfl_xor(v, o);
    return v;
}

#define XB_TMO      128
#define XB_XCNT(j)  (256  + 64 * (j))
#define XB_XSUB(j)  (1280 + 64 * (j))
#define XB_XGEN(j)  (2304 + 64 * (j))
#define XB_TOP      3328
#define XB_TOPGEN   3392
#define XCD_BAR_WORDS 3456
#define XB_SPIN_CAP (1u << 18)
__device__ __forceinline__ unsigned xb_ld(unsigned* p)              { return __hip_atomic_load(p, __ATOMIC_RELAXED, __HIP_MEMORY_SCOPE_AGENT); }
__device__ __forceinline__ unsigned xb_add(unsigned* p, unsigned v) { return __hip_atomic_fetch_add(p, v, __ATOMIC_RELAXED, __HIP_MEMORY_SCOPE_AGENT); }
__device__ __forceinline__ unsigned xb_xcc_id() { return (unsigned)__builtin_amdgcn_s_getreg((3 << 11) | 20) & 0xFu; }
#define XB_SPIN(cond, bar) do { unsigned _sp = 0; while (cond) { __builtin_amdgcn_s_sleep(1); \
    if ((++_sp & 255u) == 0u) { if (xb_ld(&(bar)[XB_TMO])) break; if (_sp > XB_SPIN_CAP) { atomicAdd(&(bar)[XB_TMO], 1u); break; } } } } while (0)
struct XcdBarrier { unsigned* bar; unsigned x; volatile LAS unsigned* st; };
__device__ __forceinline__ XcdBarrier xcd_barrier_post(unsigned* bar, volatile LAS unsigned* st) {
    XcdBarrier b; b.bar = bar; b.x = xb_xcc_id(); b.st = st;
    if (threadIdx.x == 0) (void)xb_add(&bar[XB_XCNT(b.x)], 1u);
    return b;
}
__device__ __forceinline__ void xcd_barrier_complete(unsigned* bar, unsigned x, unsigned& nloc, unsigned& nx) {
    const unsigned G = gridDim.x * gridDim.y * gridDim.z;
    unsigned sum, cnt, mine, sp = 0u;
    for (;;) {
        sum = 0u; cnt = 0u; mine = 0u;
#pragma unroll
        for (unsigned j = 0; j < 16; ++j) { const unsigned c = xb_ld(&bar[XB_XCNT(j)]); sum += c; cnt += (c > 0u) ? 1u : 0u; mine = (j == x) ? c : mine; }
        if (sum == G) break;
        __builtin_amdgcn_s_sleep(1);
        if ((++sp & 255u) == 0u) { if (xb_ld(&bar[XB_TMO])) break; if (sp > XB_SPIN_CAP) { atomicAdd(&bar[XB_TMO], 1u); break; } }
    }
    nloc = mine > 0u ? mine : 1u; nx = cnt > 0u ? cnt : 1u;
}
__device__ __forceinline__ void xcd_barrier(const XcdBarrier& b) {
    asm volatile("s_waitcnt vmcnt(0)" ::: "memory");
    __syncthreads();
    if (threadIdx.x == 0) {
        unsigned* bar = b.bar; unsigned bx = b.x;
        asm volatile("" : "+s"(bar), "+s"(bx));
        __builtin_amdgcn_s_waitcnt(0);
        unsigned nloc = b.st[0], nx = b.st[1];
        if (nloc == 0u) { xcd_barrier_complete(bar, bx, nloc, nx); b.st[0] = nloc; b.st[1] = nx; }
        const unsigned old = xb_add(&bar[XB_XSUB(bx)], 1u);
        const unsigned gen = old / nloc;
        if (old + 1u == (gen + 1u) * nloc) {
            __builtin_amdgcn_fence(__ATOMIC_RELEASE, "agent");
            asm volatile("s_waitcnt vmcnt(0)" ::: "memory");
            const unsigned og = xb_add(&bar[XB_TOP], 1u);
            const unsigned tg = og / nx;
            if (og + 1u == (tg + 1u) * nx) xb_add(&bar[XB_TOPGEN], 1u);
            else XB_SPIN(xb_ld(&bar[XB_TOPGEN]) == tg, bar);
            __builtin_amdgcn_fence(__ATOMIC_ACQUIRE, "agent");
            xb_add(&bar[XB_XGEN(bx)], 1u);
            asm volatile("s_waitcnt vmcnt(0)" ::: "memory");
        } else {
            XB_SPIN(xb_ld(&bar[XB_XGEN(bx)]) == gen, bar);
            __builtin_amdgcn_fence(__ATOMIC_ACQUIRE, "agent");
            asm volatile("s_waitcnt vmcnt(0)" ::: "memory");
        }
    }
    __syncthreads();
}

namespace pg8 {
constexpr int BM = 256, BK = 64, HALF = 128, HTB = HALF * BK * 2, STAGE_BYTES = 8 * HTB, KD = 1024;
__host__ __device__ __forceinline__ int lds_byte(int r, int c) { const int st = (r >> 4) * 2 + (c >> 5), rr = r & 15, cc = c & 31, ob = rr * 64 + cc * 2; return st * 1024 + (ob ^ (((ob >> 9) & 1) << 5)); }
__host__ __device__ __forceinline__ void stage_rc(int b, int& R, int& C) { const int st = b / 1024, sb = b % 1024, swz = sb ^ (((sb >> 9) & 1) << 5); R = (st >> 1) * 16 + swz / 64; C = (st & 1) * 32 + (swz % 64) / 2; }
__host__ __device__ __forceinline__ int perm32(int rho) { const int n = rho >> 4, i = rho & 15; return 8 * (i >> 2) + 4 * n + (i & 3); }

struct Unit { int pm, pn, e, kind; };

__device__ __forceinline__ bool deal(int i, int npu, int ntiles, int& mt, int& r) {
    const int G = gridDim.x, c = blockIdx.x;
    if ((G & 7) == 0) { const int x = c & 7, q = i * (G >> 3) + (c >> 3); mt = (q / npu) * 8 + x; r = q % npu; }
    else { const int L = i * G + c; mt = L / npu; r = L % npu; }
    return mt < ntiles;
}

template <class Epi, class Sched>
__device__ __forceinline__ void gemm_phase(LAS unsigned char* lds, const Sched& S, const Epi& E, const int tid) {
    const int wid = __builtin_amdgcn_readfirstlane(tid >> 6), lane = tid & 63, wr = wid >> 2, wc = wid & 3, fr = lane & 15, fq = lane >> 4;
    constexpr int K = KD, nt = K / BK;
    unsigned voffB[2];
#pragma unroll
    for (int i = 0; i < 2; ++i) { int R_, C_; stage_rc(tid * 16 + i * 8192, R_, C_); const int Rb = (R_ & ~31) + perm32(R_ & 31); voffB[i] = (unsigned)(Rb * K + C_) * 2u; }
    constexpr bool GA = Sched::GATHER;
    constexpr int NH = GA ? 2 : 1;
    constexpr size_t kstep = (size_t)(BK * 2);
    constexpr size_t hstep = (size_t)HALF * K * 2;
    const unsigned ldsw = (unsigned)wid * 1024u;
    const int aoff = lds_byte(wr * 64 + fr, fq * 8), boff = lds_byte(wc * 32 + fr, fq * 8);
#define PG8_SA(b, h) (((b) * 2 + (h)) * HTB)
#define PG8_SB(b, h) ((4 + (b) * 2 + (h)) * HTB)
#define PG8_STAGE(bufoff, gbase, voff) do { _Pragma("unroll") for (int _i = 0; _i < 2; ++_i) \
        __builtin_amdgcn_global_load_lds((const unsigned*)((const char*)(gbase) + (voff)[_i]), (LAS unsigned*)(lds + (bufoff) + ldsw + _i * 8192), 16, 0, 0); } while (0)
#define PG8_LDA(dst, b, h) do { _Pragma("unroll") for (int m = 0; m < 4; ++m) _Pragma("unroll") for (int k = 0; k < 2; ++k) dst[m][k] = *(const LAS bf16x8*)(lds + PG8_SA(b, h) + aoff + m * 2048 + k * 1024); } while (0)
#define PG8_LDB(dst, b, h) do { _Pragma("unroll") for (int n = 0; n < 2; ++n) _Pragma("unroll") for (int k = 0; k < 2; ++k) dst[n][k] = *(const LAS bf16x8*)(lds + PG8_SB(b, h) + boff + n * 2048 + k * 1024); } while (0)
#define PG8_MMA(ai, bj, At, Bt) do { __builtin_amdgcn_s_setprio(1); _Pragma("unroll") for (int m = 0; m < 4; ++m) _Pragma("unroll") for (int n = 0; n < 2; ++n) _Pragma("unroll") for (int k = 0; k < 2; ++k) \
        acc[ai][bj][m][n] = __builtin_amdgcn_mfma_f32_16x16x32_bf16(Bt[n][k], At[m][k], acc[ai][bj][m][n], 0, 0, 0); __builtin_amdgcn_s_setprio(0); } while (0)
#define PG8_WAIT_V(n) asm volatile("s_waitcnt vmcnt(" #n ")" ::: "memory")
#define PG8_WAIT_L(n) asm volatile("s_waitcnt lgkmcnt(" #n ")" ::: "memory")
#define PG8_BAR __builtin_amdgcn_s_barrier()
#define PG8_SCHED __builtin_amdgcn_sched_barrier(0)
    Unit cur, nxt; int ui = 0;
    if (!S.next(0, cur)) return;
    f32x4 acc[2][2][4][2];
#pragma unroll
    for (int a = 0; a < 2; ++a)
#pragma unroll
        for (int b = 0; b < 2; ++b)
#pragma unroll
            for (int m = 0; m < 4; ++m)
#pragma unroll
                for (int n = 0; n < 2; ++n) acc[a][b][m][n] = (f32x4){0.f, 0.f, 0.f, 0.f};
    bf16x8 At[4][2], B0[2][2], B1[2][2];
    unsigned vC[NH][2], vN[NH][2];
    S.a_offs(cur, tid, vC);
#define PG8_HA(h) (GA ? 0 : (h) * hstep)
#define PG8_VH(v, h) (v)[GA ? (h) : 0]
    const char* cA = S.a_base(cur); const char* cB = S.b_base(cur);
    PG8_STAGE(PG8_SB(0, 0), cB, voffB); PG8_STAGE(PG8_SB(0, 1), cB + hstep, voffB); PG8_STAGE(PG8_SA(0, 0), cA, vC[0]); PG8_STAGE(PG8_SA(0, 1), cA + PG8_HA(1), PG8_VH(vC, 1));
    if (wr == 1) PG8_BAR;
    PG8_WAIT_V(2); PG8_BAR;
    PG8_STAGE(PG8_SB(1, 0), cB + kstep, voffB); PG8_STAGE(PG8_SA(1, 0), cA + kstep, vC[0]); PG8_STAGE(PG8_SB(1, 1), cB + hstep + kstep, voffB);
    PG8_WAIT_V(6); PG8_BAR;
    for (;;) {
        const bool has_next = S.next(ui + 1, nxt);
        const char* nA = cA; const char* nB = cB;
#pragma unroll
        for (int h = 0; h < NH; ++h)
#pragma unroll
            for (int i = 0; i < 2; ++i) vN[h][i] = vC[h][i];
        if (has_next) { S.a_offs(nxt, tid, vN); nA = S.a_base(nxt); nB = S.b_base(nxt); }
        for (int t = 0; t < nt; t += 2) {
            const bool last = (t == nt - 2);
            const char* a1 = cA + (size_t)(t + 1) * kstep;
            const char* a2 = last ? nA : cA + (size_t)(t + 2) * kstep; const char* b2 = last ? nB : cB + (size_t)(t + 2) * kstep;
            const char* a3 = a2 + kstep; const char* b3 = b2 + kstep;
            unsigned w0[2], w1[2];
#pragma unroll
            for (int i = 0; i < 2; ++i) { w0[i] = last ? vN[0][i] : vC[0][i]; w1[i] = last ? PG8_VH(vN, 1)[i] : PG8_VH(vC, 1)[i]; }
            PG8_LDB(B0, 0, 0); PG8_LDB(B1, 0, 1); PG8_SCHED; PG8_LDA(At, 0, 0); PG8_STAGE(PG8_SA(1, 1), a1 + PG8_HA(1), PG8_VH(vC, 1));
            PG8_WAIT_V(8); PG8_WAIT_L(0); PG8_BAR; PG8_MMA(0, 0, At, B0); PG8_MMA(0, 1, At, B1); PG8_BAR; PG8_SCHED;
            PG8_LDA(At, 0, 1); PG8_STAGE(PG8_SB(0, 0), b2, voffB); PG8_STAGE(PG8_SB(0, 1), b2 + hstep, voffB); PG8_STAGE(PG8_SA(0, 0), a2, w0);
            PG8_WAIT_V(8); PG8_WAIT_L(0); PG8_BAR; PG8_MMA(1, 0, At, B0); PG8_MMA(1, 1, At, B1); PG8_BAR; PG8_SCHED;
            PG8_LDB(B0, 1, 0); PG8_LDB(B1, 1, 1); PG8_SCHED; PG8_LDA(At, 1, 0); PG8_STAGE(PG8_SA(0, 1), a2 + PG8_HA(1), w1);
            PG8_WAIT_V(8); PG8_WAIT_L(0); PG8_BAR; PG8_MMA(0, 0, At, B0); PG8_MMA(0, 1, At, B1); PG8_BAR; PG8_SCHED;
            PG8_LDA(At, 1, 1); PG8_STAGE(PG8_SB(1, 0), b3, voffB); PG8_STAGE(PG8_SB(1, 1), b3 + hstep, voffB); PG8_STAGE(PG8_SA(1, 0), a3, w0);
            PG8_WAIT_V(8); PG8_WAIT_L(0); PG8_BAR; PG8_MMA(1, 0, At, B0); PG8_MMA(1, 1, At, B1); PG8_BAR; PG8_SCHED;
        }
        if (wr == 0) PG8_BAR;
        E(acc, cur, wr, wc, fr, fq);
        if (!has_next) break;
#pragma unroll
        for (int a = 0; a < 2; ++a)
#pragma unroll
            for (int b = 0; b < 2; ++b)
#pragma unroll
                for (int m = 0; m < 4; ++m)
#pragma unroll
                    for (int n = 0; n < 2; ++n) acc[a][b][m][n] = (f32x4){0.f, 0.f, 0.f, 0.f};
        cur = nxt; cA = nA; cB = nB; ++ui;
#pragma unroll
        for (int h = 0; h < NH; ++h)
#pragma unroll
            for (int i = 0; i < 2; ++i) vC[h][i] = vN[h][i];
        if (wr == 1) PG8_BAR;
    }
    PG8_WAIT_V(0);
    PG8_BAR;
#undef PG8_SA
#undef PG8_HA
#undef PG8_VH
#undef PG8_SB
#undef PG8_STAGE
#undef PG8_LDA
#undef PG8_LDB
#undef PG8_MMA
#undef PG8_WAIT_V
#undef PG8_WAIT_L
#undef PG8_BAR
#undef PG8_SCHED
}
}
using pg8::Unit;

__device__ __forceinline__ int tile_row0(int mt, bool lat_only) { return lat_only ? ((mt >> 3) * 9 + 1 + (mt & 7)) * 256 : mt * 256; }

struct SchedQKV {
    const char* H; const char* Wt;
    __device__ __forceinline__ bool next(int i, Unit& u) const { int mt, r; if (!pg8::deal(i, 12, M / 256, mt, r)) return false;
        if (r < 8) { u.kind = 0; u.pm = mt; u.pn = r; } else { u.kind = 1; u.pm = r - 8; u.pn = mt; } u.e = 0; return true; }
    static constexpr bool GATHER = false;
    __device__ __forceinline__ void a_offs(const Unit& u, int tid, unsigned (&v)[1][2]) const {
#pragma unroll
        for (int i = 0; i < 2; ++i) { int R, C; pg8::stage_rc(tid * 16 + i * 8192, R, C); v[0][i] = (unsigned)((u.pm * 256 + R) * 1024 + C) * 2u; } }
    __device__ __forceinline__ const char* a_base(const Unit& u) const { return u.kind == 0 ? H : Wt + (size_t)2048 * 2048; }
    __device__ __forceinline__ const char* b_base(const Unit& u) const { return (u.kind == 0 ? Wt : H) + (size_t)u.pn * 256 * 2048; }
};
struct SchedPlain {
    const char* A; const char* Bt; int npu; bool lat_only;
    __device__ __forceinline__ bool next(int i, Unit& u) const { int mt, r; if (!pg8::deal(i, npu, lat_only ? 128 : 144, mt, r)) return false;
        u.pm = tile_row0(mt, lat_only) >> 8; u.pn = r; u.e = 0; u.kind = 0; return true; }
    static constexpr bool GATHER = false;
    __device__ __forceinline__ void a_offs(const Unit& u, int tid, unsigned (&v)[1][2]) const {
#pragma unroll
        for (int i = 0; i < 2; ++i) { int R, C; pg8::stage_rc(tid * 16 + i * 8192, R, C); v[0][i] = (unsigned)((u.pm * 256 + R) * 1024 + C) * 2u; } }
    __device__ __forceinline__ const char* a_base(const Unit&) const { return A; }
    __device__ __forceinline__ const char* b_base(const Unit& u) const { return Bt + (size_t)u.pn * 256 * 2048; }
};
template <bool GATHER_> struct SchedMoe {
    static constexpr bool GATHER = GATHER_;
    const char* A; const char* Wt; const int* list; int npu; size_t estride;
    LAS const int* tstart; LAS const int* ecnt; LAS const int* tile_e;
    __device__ __forceinline__ bool next(int i, Unit& u) const { int mt, r; const int ntl = __builtin_amdgcn_readfirstlane(tstart[32]);
        if (!pg8::deal(i, npu, ntl, mt, r)) return false; u.pm = mt; u.pn = r; u.e = __builtin_amdgcn_readfirstlane(tile_e[mt]); u.kind = 0; return true; }
    __device__ __forceinline__ void a_offs(const Unit& u, int tid, unsigned (&v)[GATHER_ ? 2 : 1][2]) const {
        if constexpr (GATHER_) { const int j0 = (u.pm - __builtin_amdgcn_readfirstlane(tstart[u.e])) * 256, cnt = __builtin_amdgcn_readfirstlane(ecnt[u.e]); const int* lp = list + (size_t)u.e * CAP;
#pragma unroll
            for (int h = 0; h < 2; ++h)
#pragma unroll
                for (int i = 0; i < 2; ++i) { int R, C; pg8::stage_rc(tid * 16 + i * 8192, R, C); const int idx = j0 + h * 128 + R; const int tok = idx < cnt ? lp[idx] : 0; v[h][i] = (unsigned)(tok * 1024 + C) * 2u; }
        } else {
#pragma unroll
            for (int i = 0; i < 2; ++i) { int R, C; pg8::stage_rc(tid * 16 + i * 8192, R, C); v[0][i] = (unsigned)((u.pm * 256 + R) * 1024 + C) * 2u; } }
    }
    __device__ __forceinline__ const char* a_base(const Unit&) const { return A; }
    __device__ __forceinline__ const char* b_base(const Unit& u) const { return Wt + (size_t)u.e * estride + (size_t)u.pn * 256 * 2048; }
};

#define EPI_LOOP_ROWS for (int ai = 0; ai < 2; ++ai) _Pragma("unroll") for (int m = 0; m < 4; ++m)
__device__ __forceinline__ u32x4 pack8(const f32x4& v0, const f32x4& v1) { u32x4 w; w.x = cvt_pk_bf16(v0[0], v0[1]); w.y = cvt_pk_bf16(v0[2], v0[3]); w.z = cvt_pk_bf16(v1[0], v1[1]); w.w = cvt_pk_bf16(v1[2], v1[3]); return w; }

struct EpiQKV {
    bf16* Q; bf16* Kb; bf16* Vt; const float* cosT; const float* sinT;
    __device__ __forceinline__ void operator()(const f32x4 (&acc)[2][2][4][2], const Unit& u, int wr, int wc, int fr, int fq) const {
        if (u.kind == 0) {
            const bool isq = u.pn < 4; bf16* base = isq ? Q : Kb; const float sc = isq ? C2 : 1.f;
            const bool lat = (u.pm % 9) != 0; const int jp0 = 16 * (wc & 1) + 4 * fq;
#pragma unroll
            EPI_LOOP_ROWS { const int row = u.pm * 256 + ai * 128 + wr * 64 + m * 16 + fr; const int t = (row % RPB) - CTXL;
                f32x4 cs = {1.f, 1.f, 1.f, 1.f}, sn = {0.f, 0.f, 0.f, 0.f};
                if (lat) { cs = *(const f32x4*)(cosT + t * 32 + jp0); sn = *(const f32x4*)(sinT + t * 32 + jp0); }
#pragma unroll
                for (int bj = 0; bj < 2; ++bj) { const f32x4 a = acc[ai][bj][m][0], b = acc[ai][bj][m][1]; f32x4 o0, o1;
                    o0[0] = (a[0] * cs[0] - a[1] * sn[0]) * sc; o0[1] = (a[1] * cs[0] + a[0] * sn[0]) * sc; o0[2] = (a[2] * cs[1] - a[3] * sn[1]) * sc; o0[3] = (a[3] * cs[1] + a[2] * sn[1]) * sc;
                    o1[0] = (b[0] * cs[2] - b[1] * sn[2]) * sc; o1[1] = (b[1] * cs[2] + b[0] * sn[2]) * sc; o1[2] = (b[2] * cs[3] - b[3] * sn[3]) * sc; o1[3] = (b[3] * cs[3] + b[2] * sn[3]) * sc;
                    const int col = (u.pn & 3) * 256 + bj * 128 + wc * 32 + fq * 8;
                    *(u32x4*)(base + (size_t)row * 1024 + col) = pack8(o0, o1); } }
        } else {
#pragma unroll
            EPI_LOOP_ROWS { const int row = u.pm * 256 + ai * 128 + wr * 64 + m * 16 + fr;
#pragma unroll
                for (int bj = 0; bj < 2; ++bj) { const int col = u.pn * 256 + bj * 128 + wc * 32 + fq * 8;
                    *(u32x4*)(Vt + (size_t)row * M + col) = pack8(acc[ai][bj][m][0], acc[ai][bj][m][1]); } }
        }
    }
};
struct EpiPlain {
    bf16* O; int ldc;
    __device__ __forceinline__ void operator()(const f32x4 (&acc)[2][2][4][2], const Unit& u, int wr, int wc, int fr, int fq) const {
#pragma unroll
        EPI_LOOP_ROWS { const int row = u.pm * 256 + ai * 128 + wr * 64 + m * 16 + fr;
#pragma unroll
            for (int bj = 0; bj < 2; ++bj) { const int col = u.pn * 256 + bj * 128 + wc * 32 + fq * 8;
                *(u32x4*)(O + (size_t)row * ldc + col) = pack8(acc[ai][bj][m][0], acc[ai][bj][m][1]); } }
    }
};
struct EpiResid {
    const float* Xin; float* X; const float* gate;
    __device__ __forceinline__ void operator()(const f32x4 (&acc)[2][2][4][2], const Unit& u, int wr, int wc, int fr, int fq) const {
        const int rb = (u.pm % 9) == 0 ? 16 : u.pm / 9; const float* gp = gate + rb * 6144;
        f32x4 gv[2][2];
#pragma unroll
        for (int bj = 0; bj < 2; ++bj) { const int col = u.pn * 256 + bj * 128 + wc * 32 + fq * 8; gv[bj][0] = *(const f32x4*)(gp + col); gv[bj][1] = *(const f32x4*)(gp + col + 4); }
#pragma unroll
        EPI_LOOP_ROWS { const int row = u.pm * 256 + ai * 128 + wr * 64 + m * 16 + fr;
#pragma unroll
            for (int bj = 0; bj < 2; ++bj) { const int col = u.pn * 256 + bj * 128 + wc * 32 + fq * 8; const size_t o = (size_t)row * 1024 + col;
                const f32x4 x0 = *(const f32x4*)(Xin + o), x1 = *(const f32x4*)(Xin + o + 4);
                *(f32x4*)(X + o) = x0 + gv[bj][0] * acc[ai][bj][m][0]; *(f32x4*)(X + o + 4) = x1 + gv[bj][1] * acc[ai][bj][m][1]; } }
    }
};
__device__ __forceinline__ float swiglu1(float g, float l) {
    g = fminf(g, 7.f); l = fminf(fmaxf(l, -7.f), 7.f);
    const float s = __builtin_amdgcn_rcpf(1.f + __builtin_amdgcn_exp2f(-1.702f * 1.4426950408889634f * g));
    return g * s * (l + 1.f);
}
struct EpiSwiglu {
    bf16* ACT; const float* bgu;
    __device__ __forceinline__ void operator()(const f32x4 (&acc)[2][2][4][2], const Unit& u, int wr, int wc, int fr, int fq) const {
        const float* bp = bgu + u.e * 2048; f32x4 bv[2][2];
#pragma unroll
        for (int bj = 0; bj < 2; ++bj) { const int col = u.pn * 256 + bj * 128 + wc * 32 + fq * 8; bv[bj][0] = *(const f32x4*)(bp + col); bv[bj][1] = *(const f32x4*)(bp + col + 4); }
#pragma unroll
        EPI_LOOP_ROWS { const int row = u.pm * 256 + ai * 128 + wr * 64 + m * 16 + fr;
#pragma unroll
            for (int bj = 0; bj < 2; ++bj) { const f32x4 a = acc[ai][bj][m][0] + bv[bj][0], b = acc[ai][bj][m][1] + bv[bj][1];
                const int col = u.pn * 128 + bj * 64 + wc * 16 + fq * 4;
                u32x2 w; w.x = cvt_pk_bf16(swiglu1(a[0], a[1]), swiglu1(a[2], a[3])); w.y = cvt_pk_bf16(swiglu1(b[0], b[1]), swiglu1(b[2], b[3]));
                *(u32x2*)(ACT + (size_t)row * 1024 + col) = w; } }
    }
};
struct EpiDown {
    bf16* Y; const float* bd;
    __device__ __forceinline__ void operator()(const f32x4 (&acc)[2][2][4][2], const Unit& u, int wr, int wc, int fr, int fq) const {
        const float* bp = bd + u.e * 1024; f32x4 bv[2][2];
#pragma unroll
        for (int bj = 0; bj < 2; ++bj) { const int col = u.pn * 256 + bj * 128 + wc * 32 + fq * 8; bv[bj][0] = *(const f32x4*)(bp + col); bv[bj][1] = *(const f32x4*)(bp + col + 4); }
#pragma unroll
        EPI_LOOP_ROWS { const int row = u.pm * 256 + ai * 128 + wr * 64 + m * 16 + fr;
#pragma unroll
            for (int bj = 0; bj < 2; ++bj) { const int col = u.pn * 256 + bj * 128 + wc * 32 + fq * 8;
                *(u32x4*)(Y + (size_t)row * 1024 + col) = pack8(acc[ai][bj][m][0] + bv[bj][0], acc[ai][bj][m][1] + bv[bj][1]); } }
    }
};

namespace att {
constexpr int SLOT = 32768, VOFF = 16384;
__device__ __forceinline__ void glds16(const void* gsrc, unsigned lds_dst) { unsigned keep;
    asm volatile("s_mov_b32 %0, m0\n\ts_mov_b32 m0, %2\n\ts_nop 0\n\tglobal_load_lds_dwordx4 %1, off\n\ts_mov_b32 m0, %0" : "=&s"(keep) : "v"(gsrc), "s"(lds_dst) : "memory"); }
#define ATT_WAIT_BAR(N) asm volatile("s_waitcnt vmcnt(" #N ") lgkmcnt(0)\n\ts_barrier" ::: "memory")
__device__ __forceinline__ float half_swap_max(float m) { auto rr = __builtin_amdgcn_permlane32_swap(__float_as_uint(m), __float_as_uint(m), false, false); return fmaxf(__uint_as_float(rr[0]), __uint_as_float(rr[1])); }
__device__ __forceinline__ float half_swap_sum(float m) { auto rr = __builtin_amdgcn_permlane32_swap(__float_as_uint(m), __float_as_uint(m), false, false); return __uint_as_float(rr[0]) + __uint_as_float(rr[1]); }
__device__ __forceinline__ int crow(int r, int hi) { return (r & 3) + 8 * (r >> 2) + 4 * hi; }

__device__ __forceinline__ void attn_unit(LAS unsigned char* lds, LAS float* wsc  , const bf16* Q, const bf16* Kb, const bf16* Vt, bf16* O,
                                          int krow0, int h, int qrow0, int NT, float lam, float osc, const float* subg, const int tid) {
    const int lane = tid & 63, r32 = lane & 31, hi = lane >> 5; const int wid = __builtin_amdgcn_readfirstlane(tid >> 6);
    const int qg = wid >> 1, c = wid & 1;
    const unsigned lds0 = (unsigned)(uintptr_t)lds;
    const bf16* ksrc[2]; const bf16* vsrc[2];
#pragma unroll
    for (int i = 0; i < 2; ++i) { const int p = 2 * wid + i;
        { const int row = 4 * p + (lane >> 4), ch = (lane & 15) ^ (row & 15); ksrc[i] = Kb + (size_t)(krow0 + row) * 1024 + h * 128 + ch * 8; }
        { const int row = 8 * p + (lane >> 3), ch = (lane & 7) ^ ((row >> 1) & 7); vsrc[i] = Vt + (size_t)(h * 128 + row) * M + krow0 + ch * 8; } }
    const unsigned kdst = lds0 + (unsigned)wid * 2048u, vdst = lds0 + VOFF + (unsigned)wid * 2048u;
#define ATT_DMA(t, slot) do { const unsigned so_ = (unsigned)(slot) * SLOT; \
        glds16(ksrc[0] + (size_t)(t) * 64 * 1024, (unsigned)__builtin_amdgcn_readfirstlane(kdst + so_)); glds16(ksrc[1] + (size_t)(t) * 64 * 1024, (unsigned)__builtin_amdgcn_readfirstlane(kdst + so_ + 1024u)); \
        glds16(vsrc[0] + (size_t)(t) * 64, (unsigned)__builtin_amdgcn_readfirstlane(vdst + so_)); glds16(vsrc[1] + (size_t)(t) * 64, (unsigned)__builtin_amdgcn_readfirstlane(vdst + so_ + 1024u)); } while (0)
    const int key0 = (r32 & 0x13) | ((r32 & 4) << 1) | ((r32 & 8) >> 1);
    const int kx = key0 & 15, vx = (r32 >> 1) & 7;
    bf16x8 qf[4];
    { const bf16* qp = Q + (size_t)(qrow0 + qg * 32 + r32) * 1024 + h * 128 + c * 64 + hi * 8;
#pragma unroll
      for (int d0 = 0; d0 < 4; ++d0) qf[d0] = *(const bf16x8*)(qp + d0 * 16); }
    f32x16 o[4];
#pragma unroll
    for (int d0 = 0; d0 < 4; ++d0) o[d0] = f32x16{};
    float mref = 0.f, lsum = 0.f;
    asm volatile("s_waitcnt vmcnt(0)" ::: "memory");
    ATT_DMA(0, 0);
    if (NT > 1) ATT_DMA(1, 1);
    int slot = 0;
    for (int t = 0; t < NT; ++t) {
        if (t + 1 < NT) { ATT_WAIT_BAR(4); } else { ATT_WAIT_BAR(0); }
        if (t + 2 < NT) { const int s2 = slot == 0 ? 2 : slot - 1; ATT_DMA(t + 2, s2); }
        const LAS unsigned char* kb_ = lds + slot * SLOT; const LAS unsigned char* vb_ = kb_ + VOFF;
        f32x16 s0, s1;
#pragma unroll
        for (int r = 0; r < 16; ++r) { s0[r] = -mref; s1[r] = -mref; }
#pragma unroll
        for (int d0 = 0; d0 < 4; ++d0) { const int ch = (c * 8 + d0 * 2 + hi) ^ kx;
            const bf16x8 k0 = *(const LAS bf16x8*)(kb_ + key0 * 256 + ch * 16), k1 = *(const LAS bf16x8*)(kb_ + (key0 + 32) * 256 + ch * 16);
            s0 = __builtin_amdgcn_mfma_f32_32x32x16_bf16(k0, qf[d0], s0, 0, 0, 0); s1 = __builtin_amdgcn_mfma_f32_32x32x16_bf16(k1, qf[d0], s1, 0, 0, 0); }
        float rm = fmaxf(s0[0], s1[0]);
#pragma unroll
        for (int r = 1; r < 16; ++r) rm = fmaxf(rm, fmaxf(s0[r], s1[r]));
        rm = half_swap_max(rm);
        const bool need = (t == 0) || (rm > 8.f);
        if (__any(need)) {
            const float dl = need ? rm : 0.f; mref += dl;
#pragma unroll
            for (int r = 0; r < 16; ++r) { s0[r] -= dl; s1[r] -= dl; }
            const float f = (t == 0) ? 1.f : __builtin_amdgcn_exp2f(-dl); lsum *= f;
            if (hi == 0) wsc[r32] = f;
            asm volatile("s_waitcnt lgkmcnt(0)" ::: "memory");
#pragma unroll
            for (int r = 0; r < 16; ++r) { const float fr_ = wsc[crow(r, hi)];
#pragma unroll
                for (int d0 = 0; d0 < 4; ++d0) o[d0][r] *= fr_; }
            asm volatile("s_waitcnt lgkmcnt(0)" ::: "memory");
        }
        float sa = 0.f;
#pragma unroll
        for (int r = 0; r < 16; ++r) { s0[r] = __builtin_amdgcn_exp2f(s0[r]); s1[r] = __builtin_amdgcn_exp2f(s1[r]); sa += s0[r] + s1[r]; }
        lsum += sa;
        bf16x8 pa[4];
#pragma unroll
        for (int s = 0; s < 2; ++s) { u32x4 w0, w1;
            w0.x = cvt_pk_bf16(s0[8 * s + 0], s0[8 * s + 1]); w0.y = cvt_pk_bf16(s0[8 * s + 2], s0[8 * s + 3]); w0.z = cvt_pk_bf16(s0[8 * s + 4], s0[8 * s + 5]); w0.w = cvt_pk_bf16(s0[8 * s + 6], s0[8 * s + 7]);
            w1.x = cvt_pk_bf16(s1[8 * s + 0], s1[8 * s + 1]); w1.y = cvt_pk_bf16(s1[8 * s + 2], s1[8 * s + 3]); w1.z = cvt_pk_bf16(s1[8 * s + 4], s1[8 * s + 5]); w1.w = cvt_pk_bf16(s1[8 * s + 6], s1[8 * s + 7]);
            pa[s] = __builtin_bit_cast(bf16x8, w0); pa[2 + s] = __builtin_bit_cast(bf16x8, w1); }
#pragma unroll
        for (int ks = 0; ks < 4; ++ks) { const int ch = (2 * ks + hi) ^ vx;
#pragma unroll
            for (int d0 = 0; d0 < 4; ++d0) { const bf16x8 vf = *(const LAS bf16x8*)(vb_ + (d0 * 32 + r32) * 128 + ch * 16);
                o[d0] = __builtin_amdgcn_mfma_f32_32x32x16_bf16(pa[ks], vf, o[d0], 0, 0, 0); } }
        slot = slot == 2 ? 0 : slot + 1;
    }
    const float lt = half_swap_sum(lsum);
    if (hi == 0) wsc[64 + r32] = (c ? -lam : 1.f) * __builtin_amdgcn_rcpf(lt);
    asm volatile("s_waitcnt lgkmcnt(0)\n\ts_barrier" ::: "memory");
    LAS float* xch = (LAS float*)(lds + qg * 16384);
#pragma unroll
    for (int r = 0; r < 16; ++r) { const float a = wsc[64 + crow(r, hi)];
#pragma unroll
        for (int d0 = 0; d0 < 4; ++d0) o[d0][r] *= a; }
    if (c == 1) {
#pragma unroll
        for (int d0 = 0; d0 < 4; ++d0)
#pragma unroll
            for (int r = 0; r < 16; ++r) xch[(d0 * 16 + r) * 64 + lane] = o[d0][r];
    }
    asm volatile("s_waitcnt lgkmcnt(0)\n\ts_barrier" ::: "memory");
    if (c == 0) {
        float sg[4];
#pragma unroll
        for (int d0 = 0; d0 < 4; ++d0) sg[d0] = subg[d0 * 32 + r32] * osc;
        bf16* Ow = O + (size_t)(qrow0 + qg * 32) * 1024 + h * 128 + r32;
#pragma unroll
        for (int r = 0; r < 16; ++r) { const int qr = crow(r, hi);
            float v[4], ss = 0.f;
#pragma unroll
            for (int d0 = 0; d0 < 4; ++d0) { v[d0] = o[d0][r] + xch[(d0 * 16 + r) * 64 + lane]; ss += v[d0] * v[d0]; }
#pragma unroll
            for (int of = 1; of < 32; of <<= 1) ss += __shfl_xor(ss, of);
            const float rn = __builtin_amdgcn_rsqf(ss * (1.f / 128.f) + EPS);
#pragma unroll
            for (int d0 = 0; d0 < 4; ++d0) Ow[(size_t)qr * 1024 + d0 * 32] = (bf16)f2bf(v[d0] * rn * sg[d0]); }
    }
    asm volatile("s_waitcnt lgkmcnt(0)\n\ts_barrier" ::: "memory");
#undef ATT_DMA
}
}

__device__ __forceinline__ void load_row_f32(const float* p, int lane, f32x4 (&v)[4]) {
#pragma unroll
    for (int j = 0; j < 4; ++j) v[j] = *(const f32x4*)(p + 256 * j + 4 * lane);
}
__device__ __forceinline__ float row_rstd(const f32x4 (&v)[4]) {
    float s = 0.f;
#pragma unroll
    for (int j = 0; j < 4; ++j) s += (v[j][0] * v[j][0] + v[j][1] * v[j][1]) + (v[j][2] * v[j][2] + v[j][3] * v[j][3]);
    return 1.0f / sqrtf(wave_sum(s) * (1.f / D) + EPS);
}
__device__ __forceinline__ void norm_mod_store(f32x4 (&v)[4], const float* g, const float* sc, const float* sh, int lane, bf16* hrow) {
    const float rstd = row_rstd(v);
#pragma unroll
    for (int j = 0; j < 4; ++j) { const int c = 256 * j + 4 * lane; const f32x4 gg = *(const f32x4*)(g + c), ss = *(const f32x4*)(sc + c), hh = *(const f32x4*)(sh + c);
        v[j] = (v[j] * rstd) * gg * (ss + 1.f) + hh;
        u32x2 w; w.x = cvt_pk_bf16(v[j][0], v[j][1]); w.y = cvt_pk_bf16(v[j][2], v[j][3]); *(u32x2*)(hrow + c) = w; }
}
__device__ __forceinline__ int row_batch(int row) { return row / RPB; }
__device__ __forceinline__ bool row_is_ctx(int row) { return (row % RPB) < CTXL; }
__device__ __forceinline__ int act_row(int ai, bool lat_only) { return lat_only ? (ai >> 11) * RPB + CTXL + (ai & 2047) : ai; }

template <int MODE>
__device__ __forceinline__ void transpose_item(const float* W, int K, int N, bf16* WT, LAS float* scr, int item, int lane) {
    const int nblk = N / 32, kb = item / nblk, nb = item % nblk, k0 = 64 * kb, n0 = 32 * nb;
#pragma unroll 8
    for (int i = 0; i < 32; ++i) { const int kk = 2 * i + (lane >> 5); scr[kk * 33 + (lane & 31)] = W[(size_t)(k0 + kk) * N + n0 + (lane & 31)]; }
    asm volatile("s_waitcnt lgkmcnt(0)" ::: "memory");
    const int c = lane & 7;
#pragma unroll
    for (int j = 0; j < 4; ++j) { const int n = (lane >> 3) + 8 * j; const LAS float* s = scr + (8 * c) * 33 + n;
        u32x4 o; o.x = cvt_pk_bf16(s[0 * 33], s[1 * 33]); o.y = cvt_pk_bf16(s[2 * 33], s[3 * 33]); o.z = cvt_pk_bf16(s[4 * 33], s[5 * 33]); o.w = cvt_pk_bf16(s[6 * 33], s[7 * 33]);
        int nn = n0 + n;
        if (MODE == 1 && nn < 2048) { const int i6 = nn & 63; nn = (nn & ~63) + (i6 < 32 ? 2 * i6 : 2 * (i6 - 32) + 1); }
        *(u32x4*)(WT + (size_t)nn * K + k0 + 8 * c) = o; }
    asm volatile("s_waitcnt lgkmcnt(0)" ::: "memory");
}

struct Args { const float* in[21]; float* out; unsigned char* ws; int ph_lo, ph_hi; };
enum { I_X = 0, I_C, I_CTX, I_CCTX, I_MODW, I_MODB, I_NORMG, I_WQKV, I_WO, I_LAM, I_SUBG, I_WIN, I_CONVW, I_WOUT, I_RW, I_RB, I_WGU, I_BGU, I_WD, I_BD, I_FINALG };

__device__ __forceinline__ void moe_table(LAS unsigned char* lds, const unsigned* gcnt, int tid) {
    LAS int* ecnt = (LAS int*)(lds + LX_ECNT); LAS int* tstart = (LAS int*)(lds + LX_TSTART); LAS int* tile_e = (LAS int*)(lds + LX_TILEE);
    __syncthreads();
    if (tid < 32) ecnt[tid] = (int)__hip_atomic_load(gcnt + tid, RLX_AGENT);
    __syncthreads();
    if (tid == 0) { int ts = 0; for (int e = 0; e < 32; ++e) { tstart[e] = ts; ts += (ecnt[e] + 255) >> 8; } tstart[32] = ts; }
    __syncthreads();
    { const int e = tid >> 4, l16 = tid & 15; const int t0 = tstart[e], n = tstart[e + 1] - t0; for (int j = l16; j < n; j += 16) tile_e[t0 + j] = e; }
    __syncthreads();
}

typedef const __attribute__((address_space(4))) unsigned char* kptr_t;
__device__ __forceinline__ kptr_t kargs() { kptr_t p = (kptr_t)__builtin_amdgcn_kernarg_segment_ptr(); asm volatile("" : "+s"(p)); return p; }
#define INP(k) (*(const float* const __attribute__((address_space(4)))*)(kargs() + 8 * (k)))
#define OUTP() (*(float* const __attribute__((address_space(4)))*)(kargs() + 168))
#define WSB() (*(unsigned char* const __attribute__((address_space(4)))*)(kargs() + 176))
#define WSP(T, off) ((T*)(WSB() + (off)))
static_assert(sizeof(Args) == 192, "kernarg layout");
__global__ void __launch_bounds__(NTHREADS, 2) fwd(Args args) {
    extern __shared__ __attribute__((aligned(16))) unsigned char lds_raw[];
    LAS unsigned char* lds = (LAS unsigned char*)lds_raw;
    const int tid = threadIdx.x, lane = tid & 63, wave = __builtin_amdgcn_readfirstlane(tid >> 6);
    const int G = gridDim.x, bid = blockIdx.x;
    const int gw = bid * NWAVES + wave, NGW = G * NWAVES;
    gu32* ctl = (gu32*)WSP(unsigned, WS_CTL);
    for (int u = tid; u < (LDS_BYTES - LX) / 4; u += NTHREADS) ((LAS unsigned*)(lds + LX))[u] = 0u;
    __syncthreads();
    volatile LAS unsigned* MISC = (volatile LAS unsigned*)(lds + LX_MISC);
    XcdBarrier bar; bar.bar = (unsigned*)(ctl + CW_BAR); bar.x = 0; bar.st = nullptr;
    if (!MK_PER_PHASE) bar = xcd_barrier_post((unsigned*)(ctl + CW_BAR), MISC + 8);
    (void)args;
    const int lo = *(const int __attribute__((address_space(4)))*)(kargs() + 184), hi = *(const int __attribute__((address_space(4)))*)(kargs() + 188);
#define IN(k) (lo <= (k) && (k) < hi)
#define PHASE_IDS int tid = threadIdx.x; asm volatile("" : "+v"(tid)); const int lane = tid & 63, wave = __builtin_amdgcn_readfirstlane(tid >> 6); const int gw = bid * NWAVES + wave; (void)lane; (void)gw;
#define SEAM(k) do { if (IN(k) && IN((k) + 1)) { if (MK_PER_PHASE) { if (tid == 0) __hip_atomic_store(ctl + CW_TMO, 0xBADu, RLX_AGENT); } else xcd_barrier(bar); } } while (0)

    if (PS(0) && IN(0)) { PHASE_IDS
        float* modv = WSP(float, WS_MODV);
        { LAS float* sil = (LAS float*)lds;
          LAS float* red = (LAS float*)(lds + 69632);
          for (int i = tid; i < 17 * 1024; i += NTHREADS) { const int r = i >> 10, k = i & 1023; const float cv = r < 16 ? INP(I_C)[r * 1024 + k] : INP(I_CCTX)[k]; sil[i] = cv / (1.f + __expf(-cv)); }
          __syncthreads();
          for (int it = bid; it < 4 * 96; it += G) { const int l = it / 96, nb = it % 96; const float* W = INP(I_MODW) + (size_t)l * 1024 * 6144 + nb * 64 + lane;
            float a[17];
#pragma unroll
            for (int r = 0; r < 17; ++r) a[r] = 0.f;
            for (int k = wave * 128; k < wave * 128 + 128; k += 4) { float w[4];
#pragma unroll
                for (int q = 0; q < 4; ++q) w[q] = W[(size_t)(k + q) * 6144];
#pragma unroll
                for (int r = 0; r < 17; ++r) { const f32x4 s = *(const LAS f32x4*)(sil + r * 1024 + k); a[r] += s[0] * w[0] + s[1] * w[1] + s[2] * w[2] + s[3] * w[3]; } }
#pragma unroll
            for (int r = 0; r < 17; ++r) red[(wave * 17 + r) * 64 + lane] = a[r];
            __syncthreads();
            for (int i = tid; i < 17 * 64; i += NTHREADS) { const int r = i >> 6, n = i & 63; float s = INP(I_MODB)[l * 6144 + nb * 64 + n];
#pragma unroll
                for (int w8 = 0; w8 < 8; ++w8) s += red[(w8 * 17 + r) * 64 + n];
                modv[((size_t)l * 17 + r) * 6144 + nb * 64 + n] = s; }
            __syncthreads(); }
        }
        { float* cosT = WSP(float, WS_ROPE); float* sinT = cosT + 2048 * 32; float* rwT = WSP(float, WS_RW); float* lamv = WSP(float, WS_MISC);
        for (int i = bid * NTHREADS + tid; i < 2048 * 32; i += G * NTHREADS) { const int t = i >> 5, j = i & 31; const float pos = (float)(j < 16 ? (t >> 6) : (t & 63));
            const float inv = powf(10000.f, -(float)(2 * (j & 15)) / 32.f); const float ang = pos * inv; cosT[i] = cosf(ang); sinT[i] = sinf(ang); }
        if (bid == 0 && tid < 2) { const float* lp = INP(I_LAM) + tid * 256; float s1 = 0.f, s2 = 0.f; for (int d = 0; d < 64; ++d) { s1 += lp[d] * lp[64 + d]; s2 += lp[128 + d] * lp[192 + d]; }
            const float lam_init = 0.8f - 0.6f * expf(-0.3f * (float)(2 * tid)); lamv[tid] = expf(s1) - expf(s2) + lam_init; lamv[2 + tid] = 1.f - lam_init; }
        for (int i = bid * NTHREADS + tid; i < 4 * 32 * 1024; i += G * NTHREADS) { const int l = i >> 15, e = (i >> 10) & 31, k = i & 1023; rwT[i] = INP(I_RW)[((size_t)l * 1024 + k) * 32 + e]; } }
        { LAS float* scr = (LAS float*)(lds + wave * 8704);
          bf16* Wqkv_t = WSP(bf16, WS_WQKV); bf16* Win_t = WSP(bf16, WS_WIN); bf16* Wo_t = WSP(bf16, WS_WO); bf16* Wout_t = WSP(bf16, WS_WOUT); bf16* Wgu_t = WSP(bf16, WS_WGU); bf16* Wd_t = WSP(bf16, WS_WD);
          constexpr int I_QKV = 16 * 96, I_SQ = 16 * 32, I_GU = 16 * 64, I_D = 16 * 32;
          constexpr int T0 = 2 * I_QKV, T1 = T0 + 2 * I_QKV, T2 = T1 + 2 * I_SQ, T3 = T2 + 2 * I_SQ, T4 = T3 + 128 * I_GU, T5 = T4 + 128 * I_D;
          for (int it = gw; it < T5; it += NGW) {
            if (it < T0) { const int j = it / I_QKV; transpose_item<1>(INP(I_WQKV) + (size_t)j * 1024 * 3072, 1024, 3072, Wqkv_t + (size_t)j * 3072 * 1024, scr, it % I_QKV, lane); }
            else if (it < T1) { const int r = it - T0, j = r / I_QKV; transpose_item<0>(INP(I_WIN) + (size_t)j * 1024 * 3072, 1024, 3072, Win_t + (size_t)j * 3072 * 1024, scr, r % I_QKV, lane); }
            else if (it < T2) { const int r = it - T1, j = r / I_SQ; transpose_item<0>(INP(I_WO) + (size_t)j * 1024 * 1024, 1024, 1024, Wo_t + (size_t)j * 1024 * 1024, scr, r % I_SQ, lane); }
            else if (it < T3) { const int r = it - T2, j = r / I_SQ; transpose_item<0>(INP(I_WOUT) + (size_t)j * 1024 * 1024, 1024, 1024, Wout_t + (size_t)j * 1024 * 1024, scr, r % I_SQ, lane); }
            else if (it < T4) { const int r = it - T3, j = r / I_GU; transpose_item<0>(INP(I_WGU) + (size_t)j * 1024 * 2048, 1024, 2048, Wgu_t + (size_t)j * 2048 * 1024, scr, r % I_GU, lane); }
            else { const int r = it - T4, j = r / I_D; transpose_item<0>(INP(I_WD) + (size_t)j * 1024 * 1024, 1024, 1024, Wd_t + (size_t)j * 1024 * 1024, scr, r % I_D, lane); }
          }
        }
        __syncthreads();
    }
    SEAM(0);

    if (PS(1) && IN(1)) { PHASE_IDS
        const float* g = INP(I_NORMG); const float* modv = WSP(float, WS_MODV); float* X = WSP(float, WS_X); bf16* H = WSP(bf16, WS_H);
        for (int row = gw; row < M; row += NGW) { const int b = row_batch(row), jj = row % RPB; const bool cx = jj < CTXL; const int rb = cx ? 16 : b;
            const float* src = cx ? INP(I_CTX) + ((size_t)b * CTXL + jj) * D : INP(I_X) + ((size_t)b * SEQ + (jj - CTXL)) * D;
            f32x4 v[4]; load_row_f32(src, lane, v);
#pragma unroll
            for (int j = 0; j < 4; ++j) *(f32x4*)(X + (size_t)row * D + 256 * j + 4 * lane) = v[j];
            norm_mod_store(v, g, modv + rb * 6144 + 1024, modv + rb * 6144, lane, H + (size_t)row * D); }
    }
    SEAM(1);

    for (int l = 0; l < DEPTH; ++l) {
        const int pb = 2 + 7 * l; const bool attn = (l & 1) == 0; const int j2 = l >> 1; const bool lat_only = (l == DEPTH - 1);
#define MV() (WSP(float, WS_MODV) + (size_t)l * 17 * 6144)
        const unsigned* gcnt = (const unsigned*)(ctl + CW_CNT) + l * 32;

        if (IN(pb)) { PHASE_IDS
            if (PS(2) && attn) {
                SchedQKV S{(const char*)WSP(bf16, WS_H), (const char*)(WSP(bf16, WS_WQKV) + (size_t)j2 * 3072 * 1024)};
                EpiQKV E{WSP(bf16, WS_Q), WSP(bf16, WS_K), WSP(bf16, WS_VT), WSP(float, WS_ROPE), WSP(float, WS_ROPE) + 2048 * 32};
                pg8::gemm_phase<EpiQKV, SchedQKV>(lds, S, E, tid);
            } else if (PS(3)) {
                SchedPlain S{(const char*)WSP(bf16, WS_H), (const char*)(WSP(bf16, WS_WIN) + (size_t)j2 * 3072 * 1024), 12, lat_only};
                EpiPlain E{WSP(bf16, WS_BCO), 3072};
                pg8::gemm_phase<EpiPlain, SchedPlain>(lds, S, E, tid);
            }
        }
        SEAM(pb);

        if (IN(pb + 1)) { PHASE_IDS
            if (PS(4) && attn) {
                const float* lamv = WSP(float, WS_MISC); const float lam = lamv[j2], osc = lamv[2 + j2]; const float* subg = INP(I_SUBG) + j2 * 128;
                const bf16* Qb = WSP(bf16, WS_Q); const bf16* Kb = WSP(bf16, WS_K); const bf16* Vt = WSP(bf16, WS_VT); bf16* Ob = WSP(bf16, WS_O);
                LAS float* wsc = (LAS float*)(lds + LX_WSC + wave * 1024);
                const int vcu = (G % 8 == 0) ? (bid % 8) * (G / 8) + bid / 8 : bid;
                if (G == 256) {
                    const int bh = vcu >> 1, half = vcu & 1, b = bh >> 3, h = bh & 7;
                    for (int i = 0; i < 8; ++i) att::attn_unit(lds, wsc, Qb, Kb, Vt, Ob, b * RPB, h, b * RPB + CTXL + (8 * half + i) * 128, 36, lam, osc, subg, tid);
                    att::attn_unit(lds, wsc, Qb, Kb, Vt, Ob, b * RPB, h, b * RPB + half * 128, 4, lam, osc, subg, tid);
                } else {
                    for (int u = bid; u < 128 * 18; u += G) { const int bh = u / 18, k = u % 18, b = bh >> 3, h = bh & 7;
                        att::attn_unit(lds, wsc, Qb, Kb, Vt, Ob, b * RPB, h, k < 16 ? b * RPB + CTXL + k * 128 : b * RPB + (k - 16) * 128, k < 16 ? 36 : 4, lam, osc, subg, tid); }
                }
            } else if (PS(5)) {
                const float* cw = INP(I_CONVW) + (size_t)j2 * 3 * 1024; const bf16* BCO = WSP(bf16, WS_BCO); bf16* Ob = WSP(bf16, WS_O);
                const int nact = lat_only ? 32768 : M; const int nitems = (nact / 16) * 2;
                for (int it = gw; it < nitems; it += NGW) { const int strip = it >> 1, ch = (it & 1) * 512 + lane * 8; const int row0 = act_row(strip * 16, lat_only);
                    const int jj = row0 % RPB; const int seq_lo = jj < CTXL ? row0 - jj : row0 - jj + CTXL, seq_hi = jj < CTXL ? row0 - jj + CTXL : row0 - jj + RPB;
                    float w0[8], w1[8], w2[8];
#pragma unroll
                    for (int q = 0; q < 8; ++q) { w0[q] = cw[ch + q]; w1[q] = cw[1024 + ch + q]; w2[q] = cw[2048 + ch + q]; }
                    float up[8], uc[8], un[8];
                    auto load_u = [&](int row, float (&u)[8]) {
                        if (row < seq_lo || row >= seq_hi) {
#pragma unroll
                            for (int q = 0; q < 8; ++q) u[q] = 0.f;
                        } else { const bf16* p = BCO + (size_t)row * 3072; const u32x4 gc = *(const u32x4*)(p + 1024 + ch), xt = *(const u32x4*)(p + 2048 + ch);
#pragma unroll
                            for (int q = 0; q < 4; ++q) { u[2 * q] = bf2f((unsigned short)(gc[q] & 0xffffu)) * bf2f((unsigned short)(xt[q] & 0xffffu)); u[2 * q + 1] = bf2f((unsigned short)(gc[q] >> 16)) * bf2f((unsigned short)(xt[q] >> 16)); } } };
                    load_u(row0 - 1, up); load_u(row0, uc);
                    for (int r = 0; r < 16; ++r) { const int row = row0 + r; load_u(row + 1, un);
                        const u32x4 gb = *(const u32x4*)(BCO + (size_t)row * 3072 + ch); float z[8];
#pragma unroll
                        for (int q = 0; q < 8; ++q) { const float gbv = bf2f((unsigned short)((q & 1) ? (gb[q >> 1] >> 16) : (gb[q >> 1] & 0xffffu))); z[q] = gbv * (w0[q] * up[q] + w1[q] * uc[q] + w2[q] * un[q]); }
                        u32x4 o; o.x = cvt_pk_bf16(z[0], z[1]); o.y = cvt_pk_bf16(z[2], z[3]); o.z = cvt_pk_bf16(z[4], z[5]); o.w = cvt_pk_bf16(z[6], z[7]);
                        *(u32x4*)(Ob + (size_t)row * 1024 + ch) = o;
#pragma unroll
                        for (int q = 0; q < 8; ++q) { up[q] = uc[q]; uc[q] = un[q]; } } }
            }
        }
        SEAM(pb + 1);

        if (PS(6) && IN(pb + 2)) { PHASE_IDS
            SchedPlain S{(const char*)WSP(bf16, WS_O), (const char*)(WSP(bf16, attn ? WS_WO : WS_WOUT) + (size_t)j2 * 1024 * 1024), 4, lat_only};
            float* X = WSP(float, WS_X);
            EpiResid E{X, X, MV() + 2 * 1024};
            pg8::gemm_phase<EpiResid, SchedPlain>(lds, S, E, tid);
        }
        SEAM(pb + 2);

        if (PS(7) && IN(pb + 3)) { PHASE_IDS
            LAS int* lcnt = (LAS int*)(lds + LX_LCNT); LAS int* lbase = (LAS int*)(lds + LX_LBASE); LAS int* asg = (LAS int*)(lds + LX_ASG);
            LAS float* wsc = (LAS float*)(lds + LX_WSC + wave * 1024);
            __syncthreads();
            float* X = WSP(float, WS_X); bf16* H = WSP(bf16, WS_H); const float* mv = MV(); int* topE = WSP(int, WS_TOPE); float* topG = WSP(float, WS_TOPG); int* topP = WSP(int, WS_TOPP); int* list = WSP(int, WS_LIST);
            { const float* rw = WSP(float, WS_RW) + (size_t)l * 32 * 1024; for (int i = tid; i < 32 * 1024 / 4; i += NTHREADS) ((LAS f32x4*)lds)[i] = ((const f32x4*)rw)[i]; }
            if (tid < 32) lcnt[tid] = 0;
            __syncthreads();
            const int nact = lat_only ? 32768 : M; const int rpb = (nact + G - 1) / G; const int a0 = bid * rpb; int nr = nact - a0; nr = nr < 0 ? 0 : (nr > rpb ? rpb : nr);
            const float* g = INP(I_NORMG) + ((size_t)l * 2 + 1) * 1024; const float* rb_ = INP(I_RB) + l * 32;
            for (int i = wave; i < nr; i += NWAVES) { const int row = act_row(a0 + i, lat_only); const int rb = row_is_ctx(row) ? 16 : row_batch(row);
                f32x4 v[4]; load_row_f32(X + (size_t)row * D, lane, v);
                norm_mod_store(v, g, mv + rb * 6144 + 4 * 1024, mv + rb * 6144 + 3 * 1024, lane, H + (size_t)row * D);
                float a[32];
#pragma unroll
                for (int e = 0; e < 32; ++e) { float s = 0.f;
#pragma unroll
                    for (int j = 0; j < 4; ++j) { const f32x4 w = *(const LAS f32x4*)(lds + ((e * 1024 + 256 * j + 4 * lane) << 2)); s += v[j][0] * w[0] + v[j][1] * w[1] + v[j][2] * w[2] + v[j][3] * w[3]; }
                    a[e] = s; }
#define RS_STEP(NIN, MASK) { const bool bit_ = (lane & (MASK)) != 0; _Pragma("unroll") for (int q = 0; q < (NIN) / 2; ++q) { const float keep_ = bit_ ? a[q + (NIN) / 2] : a[q]; const float send_ = bit_ ? a[q] : a[q + (NIN) / 2]; a[q] = keep_ + __shfl_xor(send_, (MASK)); } }
                RS_STEP(32, 32) RS_STEP(16, 16) RS_STEP(8, 8) RS_STEP(4, 4) RS_STEP(2, 2)
#undef RS_STEP
                const int my_e = lane >> 1; const float lg = a[0] + __shfl_xor(a[0], 1) + rb_[my_e];
                if ((lane & 1) == 0) wsc[my_e] = lg;
                asm volatile("s_waitcnt lgkmcnt(0)" ::: "memory");
                int rank = 0;
#pragma unroll
                for (int e = 0; e < 32; ++e) { const float o = wsc[e]; rank += (o > lg || (o == lg && e < my_e)) ? 1 : 0; }
                asm volatile("s_waitcnt lgkmcnt(0)" ::: "memory");
                if ((lane & 1) == 0 && rank < 4) { wsc[64 + rank] = lg; ((LAS int*)wsc)[72 + rank] = my_e; }
                asm volatile("s_waitcnt lgkmcnt(0)" ::: "memory");
                const float t0 = wsc[64], t1 = wsc[65], t2 = wsc[66], t3 = wsc[67];
                const float p0 = 1.f, p1 = __expf(t1 - t0), p2 = __expf(t2 - t0), p3 = __expf(t3 - t0); const float inv = 1.f / (p0 + p1 + p2 + p3);
                if (lane < 4) { const int e = ((LAS int*)wsc)[72 + lane]; const float p = lane == 0 ? p0 : lane == 1 ? p1 : lane == 2 ? p2 : p3;
                    const int lp = __hip_atomic_fetch_add(lcnt + e, 1, __ATOMIC_RELAXED, __HIP_MEMORY_SCOPE_WORKGROUP);
                    topE[row * 4 + lane] = e; topG[row * 4 + lane] = p * inv; asg[i * 4 + lane] = (lp << 5) | e; }
                asm volatile("s_waitcnt lgkmcnt(0)" ::: "memory");
            }
            __syncthreads();
            if (tid < 32) lbase[tid] = (int)__hip_atomic_fetch_add((unsigned*)gcnt + tid, (unsigned)lcnt[tid], RLX_AGENT);
            __syncthreads();
            for (int i = tid; i < nr * 4; i += NTHREADS) { const int av = asg[i], e = av & 31, pos = lbase[e] + (av >> 5); const int row = act_row(a0 + (i >> 2), lat_only);
                list[(size_t)e * CAP + pos] = row; topP[row * 4 + (i & 3)] = pos; }
            __syncthreads();
        }
        SEAM(pb + 3);

        if (PS(8) && IN(pb + 4)) { PHASE_IDS
            moe_table(lds, gcnt, tid);
            SchedMoe<true> S{(const char*)WSP(bf16, WS_H), (const char*)(WSP(bf16, WS_WGU) + (size_t)l * 32 * 2048 * 1024), WSP(int, WS_LIST), 8, (size_t)2048 * 2048,
                             (LAS const int*)(lds + LX_TSTART), (LAS const int*)(lds + LX_ECNT), (LAS const int*)(lds + LX_TILEE)};
            EpiSwiglu E{WSP(bf16, WS_ACT), INP(I_BGU) + (size_t)l * 32 * 2048};
            pg8::gemm_phase<EpiSwiglu, SchedMoe<true>>(lds, S, E, tid);
        }
        SEAM(pb + 4);

        if (PS(9) && IN(pb + 5)) { PHASE_IDS
            moe_table(lds, gcnt, tid);
            SchedMoe<false> S{(const char*)WSP(bf16, WS_ACT), (const char*)(WSP(bf16, WS_WD) + (size_t)l * 32 * 1024 * 1024), WSP(int, WS_LIST), 4, (size_t)1024 * 2048,
                              (LAS const int*)(lds + LX_TSTART), (LAS const int*)(lds + LX_ECNT), (LAS const int*)(lds + LX_TILEE)};
            EpiDown E{WSP(bf16, WS_Y), INP(I_BD) + (size_t)l * 32 * 1024};
            pg8::gemm_phase<EpiDown, SchedMoe<false>>(lds, S, E, tid);
        }
        SEAM(pb + 5);

        if (PS(10) && IN(pb + 6)) { PHASE_IDS
            moe_table(lds, gcnt, tid);
            LAS const int* tstart = (LAS const int*)(lds + LX_TSTART);
            const int nact = lat_only ? 32768 : M;
            const float* gn = (l + 1 < DEPTH) ? INP(I_NORMG) + (size_t)(l + 1) * 2 * 1024 : INP(I_FINALG);
            const float* mv = MV(); const float* mvn = mv + 17 * 6144; float* X = WSP(float, WS_X); bf16* H = WSP(bf16, WS_H); const bf16* Yb = WSP(bf16, WS_Y);
            const int* topE = WSP(int, WS_TOPE); const float* topG = WSP(float, WS_TOPG); const int* topP = WSP(int, WS_TOPP);
            for (int ai = gw; ai < nact; ai += NGW) { const int row = act_row(ai, lat_only); const bool cx = row_is_ctx(row); const int rb = cx ? 16 : row_batch(row);
                f32x4 v[4]; load_row_f32(X + (size_t)row * D, lane, v);
                const int4 ev = *(const int4*)(topE + row * 4), pv = *(const int4*)(topP + row * 4); const f32x4 gv = *(const f32x4*)(topG + row * 4);
                const int ee[4] = {ev.x, ev.y, ev.z, ev.w}, pp[4] = {pv.x, pv.y, pv.z, pv.w};
                f32x4 acc4[4];
#pragma unroll
                for (int j = 0; j < 4; ++j) acc4[j] = (f32x4){0.f, 0.f, 0.f, 0.f};
#pragma unroll
                for (int k = 0; k < 4; ++k) { const bf16* yr = Yb + (size_t)(tstart[ee[k]] * 256 + pp[k]) * 1024; const float gk = gv[k];
#pragma unroll
                    for (int j = 0; j < 4; ++j) { const u32x2 w = *(const u32x2*)(yr + 256 * j + 4 * lane);
                        acc4[j][0] += gk * bf2f((unsigned short)(w.x & 0xffffu)); acc4[j][1] += gk * bf2f((unsigned short)(w.x >> 16)); acc4[j][2] += gk * bf2f((unsigned short)(w.y & 0xffffu)); acc4[j][3] += gk * bf2f((unsigned short)(w.y >> 16)); } }
                const float* g2 = mv + rb * 6144 + 5 * 1024;
#pragma unroll
                for (int j = 0; j < 4; ++j) { const f32x4 gg = *(const f32x4*)(g2 + 256 * j + 4 * lane); v[j] = v[j] + gg * acc4[j]; }
                if (l + 1 < DEPTH) {
#pragma unroll
                    for (int j = 0; j < 4; ++j) *(f32x4*)(X + (size_t)row * D + 256 * j + 4 * lane) = v[j];
                    if (!(l + 1 == DEPTH - 1 && cx))
                        norm_mod_store(v, gn, mvn + rb * 6144 + 1024, mvn + rb * 6144, lane, H + (size_t)row * D);
                } else {
                    const float rstd = row_rstd(v); float* op = OUTP() + ((size_t)row_batch(row) * SEQ + (row % RPB - CTXL)) * D;
#pragma unroll
                    for (int j = 0; j < 4; ++j) { const f32x4 gg = *(const f32x4*)(gn + 256 * j + 4 * lane); *(f32x4*)(op + 256 * j + 4 * lane) = (v[j] * rstd) * gg; }
                }
            }
        }
        if (l + 1 < DEPTH) SEAM(pb + 6);
    }
#undef IN
#undef SEAM
#undef MV
}

extern "C" void kernel_launch(void* const* d_in, const int* in_sizes, int n_in, void* d_out, int out_size, void* d_ws, size_t ws_size, hipStream_t stream) {
    static int grid = 0;
    if (grid == 0) {
        if (n_in != 21 || out_size != NB * SEQ * D || ws_size < WS_END) { fprintf(stderr, "kernel_launch: unexpected shapes (n_in %d, out %d, ws %zu)\n", n_in, out_size, ws_size); grid = -1; return; }
        int dev = 0, cus = 0, per_cu = 0;
        if (hipGetDevice(&dev) != hipSuccess || hipDeviceGetAttribute(&cus, hipDeviceAttributeMultiprocessorCount, dev) != hipSuccess) { grid = -1; return; }
        if (hipFuncSetAttribute((const void*)fwd, hipFuncAttributeMaxDynamicSharedMemorySize, LDS_BYTES) != hipSuccess) { fprintf(stderr, "kernel_launch: hipFuncSetAttribute failed\n"); grid = -1; return; }
        if (hipOccupancyMaxActiveBlocksPerMultiprocessor(&per_cu, (const void*)fwd, NTHREADS, LDS_BYTES) != hipSuccess || per_cu < 1) { fprintf(stderr, "kernel_launch: occupancy query says %d\n", per_cu); }
        (void)hipGetLastError();
        if (cus < 160) { fprintf(stderr, "kernel_launch: needs >= 160 CUs\n"); grid = -1; return; }
        grid = cus;
    }
    if (grid < 0) return;
    if (hipMemsetAsync((char*)d_ws + WS_CTL, 0, CTL_ZERO_BYTES, stream) != hipSuccess) return;
    Args a{};
    for (int i = 0; i < 21; ++i) a.in[i] = (const float*)d_in[i];
    a.out = (float*)d_out; a.ws = (unsigned char*)d_ws;
#if MK_PER_PHASE
    for (int p = 0; p < NPHASE; ++p) { a.ph_lo = p; a.ph_hi = p + 1; hipLaunchKernelGGL(fwd, dim3(grid), dim3(NTHREADS), LDS_BYTES, stream, a); }
#else
    a.ph_lo = 0; a.ph_hi = NPHASE;
    hipLaunchKernelGGL(fwd, dim3(grid), dim3(NTHREADS), LDS_BYTES, stream, a);
#endif
    const hipError_t le = hipPeekAtLastError();
    if (le != hipSuccess) fprintf(stderr, "kernel_launch: launch failed: %s\n", hipGetErrorName(le));
}
```

```cpp
#include <hip/hip_runtime.h>
#include <cstdio>
#include <cstdint>

#ifndef MK_PER_PHASE
#define MK_PER_PHASE 0
#endif

#ifndef MOE_FP8
#define MOE_FP8 1
#endif
#ifndef PHSEL
#define PHSEL 0xffff
#endif
#define PS(k) ((PHSEL >> (k)) & 1)
#ifndef PROBE_REP
#define PROBE_REP 0
#endif
#define NREP(k) (1 + ((PROBE_REP >> (k)) & 1))
#define GAS __attribute__((address_space(1)))
#define LAS __attribute__((address_space(3)))
typedef unsigned short bf16;
typedef short bf16x8 __attribute__((ext_vector_type(8)));
typedef float f32x4 __attribute__((ext_vector_type(4)));
typedef float f32x2 __attribute__((ext_vector_type(2)));
typedef float f32x16 __attribute__((ext_vector_type(16)));
typedef unsigned u32x4 __attribute__((ext_vector_type(4)));
typedef unsigned u32x2 __attribute__((ext_vector_type(2)));
typedef GAS unsigned gu32;

constexpr int D = 1024, NB = 16, SEQ = 2048, CTXL = 256, RPB = SEQ + CTXL, M = NB * RPB, DEPTH = 4;
constexpr int NE = 32, TOPK = 4, NMOD = 6;
constexpr int CAP = M;
constexpr int ACT_ROWS = M * TOPK + NE * 256;
constexpr float EPS = 1e-5f;
constexpr float C2 = 0.125f * 1.4426950408889634f;
constexpr int NPHASE = 2 + 7 * DEPTH;

constexpr size_t MiB = 1u << 20;
constexpr size_t WS_CTL = 0, CTL_ZERO_BYTES = 1 * MiB;
constexpr size_t WS_MODV = 1 * MiB;
constexpr size_t WS_ROPE = 3 * MiB;
constexpr size_t WS_RW = 4 * MiB;
constexpr size_t WS_MISC = 5 * MiB;
constexpr size_t WS_TOPE = 6 * MiB;
constexpr size_t WS_TOPG = 7 * MiB;
constexpr size_t WS_TOPP = 8 * MiB;
constexpr size_t WS_LIST = 9 * MiB;
constexpr size_t WS_WQKV = 16 * MiB;
constexpr size_t WS_WIN = 28 * MiB;
constexpr size_t WS_WO = 40 * MiB;
constexpr size_t WS_WOUT = 44 * MiB;
constexpr size_t WS_WGU = 48 * MiB;
constexpr size_t WS_WD = 560 * MiB;
constexpr size_t WS_X = 816 * MiB;
constexpr size_t WS_H = 960 * MiB;
constexpr size_t WS_Q = 1032 * MiB;
constexpr size_t WS_K = 1104 * MiB;
constexpr size_t WS_VT = 1176 * MiB;
constexpr size_t WS_BCO = WS_Q;
constexpr size_t WS_O = 1248 * MiB;
constexpr size_t WS_ACT = 1320 * MiB;
constexpr size_t WS_Y = 1624 * MiB;
constexpr size_t WS_H8 = 1928 * MiB;
constexpr size_t WS_END = 1964 * MiB;
static_assert((size_t)M * 3072 * 2 == 216 * MiB && (size_t)ACT_ROWS * 2048 == 304 * MiB && (size_t)M * 4096 == 144 * MiB, "ws map");

constexpr int CW_TMO = 0;
constexpr int CW_BAR = 4096;
constexpr int CW_CNT = 16384;

constexpr int RING_BYTES = 131072;
constexpr int LX = RING_BYTES;
constexpr int LX_MISC = LX + 0;
constexpr int LX_TSTART = LX + 256;
constexpr int LX_ECNT = LX + 512;
constexpr int LX_LCNT = LX + 640;
constexpr int LX_LBASE = LX + 768;
constexpr int LX_TILEE = LX + 1024;
constexpr int LX_WSC = LX + 4096;
constexpr int LX_ASG = LX + 12288;
constexpr int LDS_BYTES = LX + 16384;
constexpr int NWAVES = 8, NTHREADS = 512;

#define RLX_AGENT __ATOMIC_RELAXED, __HIP_MEMORY_SCOPE_AGENT
__device__ __forceinline__ unsigned f2bf(float f) { unsigned u = __builtin_bit_cast(unsigned, f); return (u + 0x7fffu + ((u >> 16) & 1u)) >> 16; }
__device__ __forceinline__ unsigned cvt_pk_bf16(float lo, float hi) { unsigned r; asm volatile("v_cvt_pk_bf16_f32 %0, %1, %2" : "=v"(r) : "v"(lo), "v"(hi)); return r; }
__device__ __forceinline__ float bf2f(unsigned short b) { return __builtin_bit_cast(float, (unsigned)b << 16); }
__device__ __forceinline__ float wave_sum(float v) {
#pragma unroll
    for (int o = 1; o < 64; o <<= 1) v += __shfl_xor(v, o);
    return v;
}

#define XB_TMO      128
#define XB_XCNT(j)  (256  + 64 * (j))
#define XB_XSUB(j)  (1280 + 64 * (j))
#define XB_XGEN(j)  (2304 + 64 * (j))
#define XB_TOP      3328
#define XB_TOPGEN   3392
#define XCD_BAR_WORDS 3456
#define XB_SPIN_CAP (1u << 18)
__device__ __forceinline__ unsigned xb_ld(unsigned* p)              { return __hip_atomic_load(p, __ATOMIC_RELAXED, __HIP_MEMORY_SCOPE_AGENT); }
__device__ __forceinline__ unsigned xb_add(unsigned* p, unsigned v) { return __hip_atomic_fetch_add(p, v, __ATOMIC_RELAXED, __HIP_MEMORY_SCOPE_AGENT); }
__device__ __forceinline__ unsigned xb_xcc_id() { return (unsigned)__builtin_amdgcn_s_getreg((3 << 11) | 20) & 0xFu; }
#define XB_SPIN(cond, bar) do { unsigned _sp = 0; while (cond) { __builtin_amdgcn_s_sleep(1); \
    if ((++_sp & 255u) == 0u) { if (xb_ld(&(bar)[XB_TMO])) break; if (_sp > XB_SPIN_CAP) { atomicAdd(&(bar)[XB_TMO], 1u); break; } } } } while (0)
struct XcdBarrier { unsigned* bar; unsigned x; volatile LAS unsigned* st; };
__device__ __forceinline__ XcdBarrier xcd_barrier_post(unsigned* bar, volatile LAS unsigned* st) {
    XcdBarrier b; b.bar = bar; b.x = xb_xcc_id(); b.st = st;
    if (threadIdx.x == 0) (void)xb_add(&bar[XB_XCNT(b.x)], 1u);
    return b;
}
__device__ __forceinline__ void xcd_barrier_complete(unsigned* bar, unsigned x, unsigned& nloc, unsigned& nx) {
    const unsigned G = gridDim.x * gridDim.y * gridDim.z;
    unsigned sum, cnt, mine, sp = 0u;
    for (;;) {
        sum = 0u; cnt = 0u; mine = 0u;
#pragma unroll
        for (unsigned j = 0; j < 16; ++j) { const unsigned c = xb_ld(&bar[XB_XCNT(j)]); sum += c; cnt += (c > 0u) ? 1u : 0u; mine = (j == x) ? c : mine; }
        if (sum == G) break;
        __builtin_amdgcn_s_sleep(1);
        if ((++sp & 255u) == 0u) { if (xb_ld(&bar[XB_TMO])) break; if (sp > XB_SPIN_CAP) { atomicAdd(&bar[XB_TMO], 1u); break; } }
    }
    nloc = mine > 0u ? mine : 1u; nx = cnt > 0u ? cnt : 1u;
}
__device__ __forceinline__ void xcd_barrier(const XcdBarrier& b) {
    asm volatile("s_waitcnt vmcnt(0)" ::: "memory");
    __syncthreads();
    if (threadIdx.x == 0) {
        unsigned* bar = b.bar; unsigned bx = b.x;
        asm volatile("" : "+s"(bar), "+s"(bx));
        __builtin_amdgcn_s_waitcnt(0);
        unsigned nloc = b.st[0], nx = b.st[1];
        if (nloc == 0u) { xcd_barrier_complete(bar, bx, nloc, nx); b.st[0] = nloc; b.st[1] = nx; }
        const unsigned old = xb_add(&bar[XB_XSUB(bx)], 1u);
        const unsigned gen = old / nloc;
        if (old + 1u == (gen + 1u) * nloc) {
            __builtin_amdgcn_fence(__ATOMIC_RELEASE, "agent");
            asm volatile("s_waitcnt vmcnt(0)" ::: "memory");
            const unsigned og = xb_add(&bar[XB_TOP], 1u);
            const unsigned tg = og / nx;
            if (og + 1u == (tg + 1u) * nx) xb_add(&bar[XB_TOPGEN], 1u);
            else XB_SPIN(xb_ld(&bar[XB_TOPGEN]) == tg, bar);
            __builtin_amdgcn_fence(__ATOMIC_ACQUIRE, "agent");
            xb_add(&bar[XB_XGEN(bx)], 1u);
            asm volatile("s_waitcnt vmcnt(0)" ::: "memory");
        } else {
            XB_SPIN(xb_ld(&bar[XB_XGEN(bx)]) == gen, bar);
            __builtin_amdgcn_fence(__ATOMIC_ACQUIRE, "agent");
            asm volatile("s_waitcnt vmcnt(0)" ::: "memory");
        }
    }
    __syncthreads();
}

namespace pg8 {
constexpr int BM = 256, BK = 64, HALF = 128, HTB = HALF * BK * 2, STAGE_BYTES = 8 * HTB, KD = 1024;
__host__ __device__ __forceinline__ int lds_byte(int r, int c) { const int st = (r >> 4) * 2 + (c >> 5), rr = r & 15, cc = c & 31, ob = rr * 64 + cc * 2; return st * 1024 + (ob ^ (((ob >> 9) & 1) << 5)); }
__host__ __device__ __forceinline__ void stage_rc(int b, int& R, int& C) { const int st = b / 1024, sb = b % 1024, swz = sb ^ (((sb >> 9) & 1) << 5); R = (st >> 1) * 16 + swz / 64; C = (st & 1) * 32 + (swz % 64) / 2; }
__host__ __device__ __forceinline__ int perm32(int rho) { const int n = rho >> 4, i = rho & 15; return 8 * (i >> 2) + 4 * n + (i & 3); }

struct Unit { int pm, pn, e, kind; };
typedef int v8i __attribute__((ext_vector_type(8)));
typedef int v4i __attribute__((ext_vector_type(4)));
__device__ __forceinline__ v8i cat8(bf16x8 lo, bf16x8 hi) { const v4i a = __builtin_bit_cast(v4i, lo), b = __builtin_bit_cast(v4i, hi); return __builtin_shufflevector(a, b, 0, 1, 2, 3, 4, 5, 6, 7); }

__device__ __forceinline__ bool deal(int i, int npu, int ntiles, int& mt, int& r) {
    const int G = gridDim.x, c = blockIdx.x;
    if ((G & 7) == 0) { const int x = c & 7, q = i * (G >> 3) + (c >> 3); mt = (q / npu) * 8 + x; r = q % npu; }
    else { const int L = i * G + c; mt = L / npu; r = L % npu; }
    return mt < ntiles;
}

__device__ __forceinline__ void mfma8(f32x4& acc, const v8i a, const v8i b, int sc) {
    asm volatile("v_mfma_scale_f32_16x16x128_f8f6f4 %0, %1, %2, %0, %3, %3 op_sel_hi:[0,0,0]" : "+v"(acc) : "v"(a), "v"(b), "v"(sc)); }
__device__ __forceinline__ void glds16s(const char* sbase, unsigned voff, unsigned lds_dst) { unsigned keep;
    asm volatile("s_mov_b32 %0, m0\n\ts_mov_b32 m0, %3\n\ts_nop 0\n\tglobal_load_lds_dwordx4 %1, %2\n\ts_mov_b32 m0, %0" : "=&s"(keep) : "v"(voff), "s"(sbase), "s"(lds_dst) : "memory"); }
template <class Epi, class Sched>
__device__ __forceinline__ void gemm_phase(LAS unsigned char* lds, const Sched& S, const Epi& E, const int tid) {
    const int wid = __builtin_amdgcn_readfirstlane(tid >> 6), lane = tid & 63, wr = wid >> 2, wc = wid & 3, fr = lane & 15, fq = lane >> 4;
    constexpr int RB = Sched::RB, nt = RB / 128;
    constexpr bool F8 = (RB == 1024);
    unsigned voffB[2];
#pragma unroll
    for (int i = 0; i < 2; ++i) { int R_, C_; stage_rc(tid * 16 + i * 8192, R_, C_); const int Rb = (R_ & ~31) + perm32(R_ & 31); voffB[i] = (unsigned)(Rb * RB + C_ * 2); }
    constexpr bool GA = Sched::GATHER;
    constexpr int NH = GA ? 2 : 1;
    constexpr size_t kstep = (size_t)(BK * 2);
    constexpr size_t hstep = (size_t)HALF * RB;
    const unsigned ldsw = (unsigned)wid * 1024u, lds0 = (unsigned)(uintptr_t)lds;
    const int aoff = lds_byte(wr * 64 + fr, fq * 8), boff = lds_byte(wc * 32 + fr, fq * 8);
#define PG8_SA(b, h) (((b) * 2 + (h)) * HTB)
#define PG8_SB(b, h) ((4 + (b) * 2 + (h)) * HTB)
#define PG8_STAGE(bufoff, gbase, voff) do { _Pragma("unroll") for (int _i = 0; _i < 2; ++_i) \
        glds16s((const char*)(gbase), (voff)[_i], (unsigned)__builtin_amdgcn_readfirstlane(lds0 + (unsigned)(bufoff) + ldsw + _i * 8192u)); } while (0)
#define PG8_LDA(dst, b, h) do { _Pragma("unroll") for (int m = 0; m < 4; ++m) _Pragma("unroll") for (int k = 0; k < 2; ++k) dst[m][k] = *(const LAS bf16x8*)(lds + PG8_SA(b, h) + aoff + m * 2048 + k * 1024); } while (0)
#define PG8_LDB(dst, b, h) do { _Pragma("unroll") for (int n = 0; n < 2; ++n) _Pragma("unroll") for (int k = 0; k < 2; ++k) dst[n][k] = *(const LAS bf16x8*)(lds + PG8_SB(b, h) + boff + n * 2048 + k * 1024); } while (0)
#define PG8_MMA(ai, bj, At, Bt) do { __builtin_amdgcn_s_setprio(1); _Pragma("unroll") for (int m = 0; m < 4; ++m) _Pragma("unroll") for (int n = 0; n < 2; ++n) { \
        if constexpr (F8) mfma8(acc[ai][bj][m][n], cat8(Bt[n][0], Bt[n][1]), cat8(At[m][0], At[m][1]), sc8); \
        else { _Pragma("unroll") for (int k = 0; k < 2; ++k) acc[ai][bj][m][n] = __builtin_amdgcn_mfma_f32_16x16x32_bf16(Bt[n][k], At[m][k], acc[ai][bj][m][n], 0, 0, 0); } } __builtin_amdgcn_s_setprio(0); } while (0)
#define PG8_WAIT_V(n) asm volatile("s_waitcnt vmcnt(" #n ")" ::: "memory")
#define PG8_WAIT_L(n) asm volatile("s_waitcnt lgkmcnt(" #n ")" ::: "memory")
#define PG8_BAR __builtin_amdgcn_s_barrier()
#define PG8_SCHED __builtin_amdgcn_sched_barrier(0)
    Unit cur, nxt; int ui = 0;
    if (!S.next(0, cur)) return;
    static_assert(Sched::SCALE_A == Sched::SCALE_B, "one scale register");
    int sc8 = Sched::SCALE_A; asm volatile("" : "+v"(sc8));
    f32x4 acc[2][2][4][2];
#pragma unroll
    for (int a = 0; a < 2; ++a)
#pragma unroll
        for (int b = 0; b < 2; ++b)
#pragma unroll
            for (int m = 0; m < 4; ++m)
#pragma unroll
                for (int n = 0; n < 2; ++n) acc[a][b][m][n] = (f32x4){0.f, 0.f, 0.f, 0.f};
    bf16x8 At[4][2], B0[2][2], B1[2][2];
    constexpr int NI = GA ? 1 : 2;
    unsigned vC[NH][NI], vN[NH][NI];
    unsigned cb2[2];
#pragma unroll
    for (int i = 0; i < 2; ++i) { int R_, C_; stage_rc(tid * 16 + i * 8192, R_, C_); cb2[i] = (unsigned)(C_ * 2); }
    S.a_offs(cur, tid, vC);
#define PG8_HA(h) (GA ? 0 : (h) * hstep)
#define PG8_VH(v, h) (v)[GA ? (h) : 0]
#define PG8_STAGE_A(bufoff, gbase, vv) do { _Pragma("unroll") for (int _i = 0; _i < 2; ++_i) { unsigned o_; if constexpr (GA) o_ = (((vv)[0] >> (16 * _i)) & 0xffffu) * (unsigned)RB + cb2[_i]; else o_ = (vv)[NI - 2 + _i]; \
        glds16s((const char*)(gbase), o_, (unsigned)__builtin_amdgcn_readfirstlane(lds0 + (unsigned)(bufoff) + ldsw + _i * 8192u)); } } while (0)
    const char* cA = S.a_base(cur); const char* cB = S.b_base(cur);
    PG8_STAGE(PG8_SB(0, 0), cB, voffB); PG8_STAGE(PG8_SB(0, 1), cB + hstep, voffB); PG8_STAGE_A(PG8_SA(0, 0), cA, vC[0]); PG8_STAGE_A(PG8_SA(0, 1), cA + PG8_HA(1), PG8_VH(vC, 1));
    if (wr == 1) PG8_BAR;
    PG8_WAIT_V(2); PG8_BAR;
    PG8_STAGE(PG8_SB(1, 0), cB + kstep, voffB); PG8_STAGE_A(PG8_SA(1, 0), cA + kstep, vC[0]); PG8_STAGE(PG8_SB(1, 1), cB + hstep + kstep, voffB);
    PG8_WAIT_V(6); PG8_BAR;
    for (;;) {
        const bool has_next = S.next(ui + 1, nxt);
        const char* nA = cA; const char* nB = cB;
#pragma unroll
        for (int h = 0; h < NH; ++h)
#pragma unroll
            for (int i = 0; i < NI; ++i) vN[h][i] = vC[h][i];
        if (has_next) { S.a_offs(nxt, tid, vN); nA = S.a_base(nxt); nB = S.b_base(nxt); }
#pragma unroll 1
        for (int t = 0; t < nt; t += 2) {
            const bool last = (t == nt - 2);
            const char* a1 = cA + (size_t)(t + 1) * kstep;
            const char* a2 = last ? nA : cA + (size_t)(t + 2) * kstep; const char* b2 = last ? nB : cB + (size_t)(t + 2) * kstep;
            const char* a3 = a2 + kstep; const char* b3 = b2 + kstep;
            unsigned w0[NI], w1[NI];
#pragma unroll
            for (int i = 0; i < NI; ++i) { w0[i] = last ? vN[0][i] : vC[0][i]; w1[i] = last ? PG8_VH(vN, 1)[i] : PG8_VH(vC, 1)[i]; }
            PG8_LDB(B0, 0, 0); PG8_LDB(B1, 0, 1); PG8_SCHED; PG8_LDA(At, 0, 0); PG8_STAGE_A(PG8_SA(1, 1), a1 + PG8_HA(1), PG8_VH(vC, 1));
            PG8_WAIT_V(8); PG8_WAIT_L(0); PG8_BAR; PG8_MMA(0, 0, At, B0); PG8_MMA(0, 1, At, B1); PG8_BAR; PG8_SCHED;
            PG8_LDA(At, 0, 1); PG8_STAGE(PG8_SB(0, 0), b2, voffB); PG8_STAGE(PG8_SB(0, 1), b2 + hstep, voffB); PG8_STAGE_A(PG8_SA(0, 0), a2, w0);
            PG8_WAIT_V(8); PG8_WAIT_L(0); PG8_BAR; PG8_MMA(1, 0, At, B0); PG8_MMA(1, 1, At, B1); PG8_BAR; PG8_SCHED;
            PG8_LDB(B0, 1, 0); PG8_LDB(B1, 1, 1); PG8_SCHED; PG8_LDA(At, 1, 0); PG8_STAGE_A(PG8_SA(0, 1), a2 + PG8_HA(1), w1);
            PG8_WAIT_V(8); PG8_WAIT_L(0); PG8_BAR; PG8_MMA(0, 0, At, B0); PG8_MMA(0, 1, At, B1); PG8_BAR; PG8_SCHED;
            PG8_LDA(At, 1, 1); PG8_STAGE(PG8_SB(1, 0), b3, voffB); PG8_STAGE(PG8_SB(1, 1), b3 + hstep, voffB); PG8_STAGE_A(PG8_SA(1, 0), a3, w0);
            PG8_WAIT_V(8); PG8_WAIT_L(0); PG8_BAR; PG8_MMA(1, 0, At, B0); PG8_MMA(1, 1, At, B1); PG8_BAR; PG8_SCHED;
        }
        if (wr == 0) PG8_BAR;
        E(acc, cur, wr, wc, fr, fq);
        if (!has_next) break;
#pragma unroll
        for (int a = 0; a < 2; ++a)
#pragma unroll
            for (int b = 0; b < 2; ++b)
#pragma unroll
                for (int m = 0; m < 4; ++m)
#pragma unroll
                    for (int n = 0; n < 2; ++n) acc[a][b][m][n] = (f32x4){0.f, 0.f, 0.f, 0.f};
        cur = nxt; cA = nA; cB = nB; ++ui;
#pragma unroll
        for (int h = 0; h < NH; ++h)
#pragma unroll
            for (int i = 0; i < NI; ++i) vC[h][i] = vN[h][i];
        if (wr == 1) PG8_BAR;
    }
    PG8_WAIT_V(0);
    PG8_BAR;
#undef PG8_SA
#undef PG8_HA
#undef PG8_VH
#undef PG8_SB
#undef PG8_STAGE
#undef PG8_STAGE_A
#undef PG8_LDA
#undef PG8_LDB
#undef PG8_MMA
#undef PG8_WAIT_V
#undef PG8_WAIT_L
#undef PG8_BAR
#undef PG8_SCHED
}
}
using pg8::Unit;

__device__ __forceinline__ int tile_row0(int mt, bool lat_only) { return lat_only ? ((mt >> 3) * 9 + 1 + (mt & 7)) * 256 : mt * 256; }

struct SchedQKV {
    static constexpr int RB = 2048, SCALE_A = 0, SCALE_B = 0;
    const char* H; const char* Wt;
    __device__ __forceinline__ bool next(int i, Unit& u) const { int mt, r; if (!pg8::deal(i, 12, M / 256, mt, r)) return false;
        if (r < 8) { u.kind = 0; u.pm = mt; u.pn = r; } else { u.kind = 1; u.pm = r - 8; u.pn = mt; } u.e = 0; return true; }
    static constexpr bool GATHER = false;
    __device__ __forceinline__ void a_offs(const Unit& u, int tid, unsigned (&v)[1][2]) const {
#pragma unroll
        for (int i = 0; i < 2; ++i) { int R, C; pg8::stage_rc(tid * 16 + i * 8192, R, C); v[0][i] = (unsigned)((u.pm * 256 + R) * 1024 + C) * 2u; } }
    __device__ __forceinline__ const char* a_base(const Unit& u) const { return u.kind == 0 ? H : Wt + (size_t)2048 * 2048; }
    __device__ __forceinline__ const char* b_base(const Unit& u) const { return (u.kind == 0 ? Wt : H) + (size_t)u.pn * 256 * 2048; }
};
struct SchedPlain {
    static constexpr int RB = 2048, SCALE_A = 0, SCALE_B = 0;
    const char* A; const char* Bt; int npu; bool lat_only;
    __device__ __forceinline__ bool next(int i, Unit& u) const { int mt, r; if (!pg8::deal(i, npu, lat_only ? 128 : 144, mt, r)) return false;
        u.pm = tile_row0(mt, lat_only) >> 8; u.pn = r; u.e = 0; u.kind = 0; return true; }
    static constexpr bool GATHER = false;
    __device__ __forceinline__ void a_offs(const Unit& u, int tid, unsigned (&v)[1][2]) const {
#pragma unroll
        for (int i = 0; i < 2; ++i) { int R, C; pg8::stage_rc(tid * 16 + i * 8192, R, C); v[0][i] = (unsigned)((u.pm * 256 + R) * 1024 + C) * 2u; } }
    __device__ __forceinline__ const char* a_base(const Unit&) const { return A; }
    __device__ __forceinline__ const char* b_base(const Unit& u) const { return Bt + (size_t)u.pn * 256 * 2048; }
};
template <bool GATHER_, int RB_, int SA_, int SB_> struct SchedMoe {
    static constexpr bool GATHER = GATHER_;
    static constexpr int RB = RB_, SCALE_A = SA_, SCALE_B = SB_;
    const char* A; const char* Wt; const int* list; int npu; size_t estride;
    LAS const int* tstart; LAS const int* ecnt; LAS const int* tile_e;
    __device__ __forceinline__ bool next(int i, Unit& u) const { int mt, r; const int ntl = __builtin_amdgcn_readfirstlane(tstart[32]);
        if (!pg8::deal(i, npu, ntl, mt, r)) { if (!(PROBE_REP & (GATHER_ ? 0x100 : 0x200))) return false; int n_i = 0; while (pg8::deal(n_i, npu, ntl, mt, r)) ++n_i; if (i >= 2 * n_i || !pg8::deal(i - n_i, npu, ntl, mt, r)) return false; }
        u.pm = mt; u.pn = r; u.e = __builtin_amdgcn_readfirstlane(tile_e[mt]); u.kind = 0; return true; }
    __device__ __forceinline__ void a_offs(const Unit& u, int tid, unsigned (&v)[GATHER_ ? 2 : 1][GATHER_ ? 1 : 2]) const {
        if constexpr (GATHER_) { const int j0 = (u.pm - __builtin_amdgcn_readfirstlane(tstart[u.e])) * 256, cnt = __builtin_amdgcn_readfirstlane(ecnt[u.e]); const int* lp = list + (size_t)u.e * CAP;
#pragma unroll
            for (int h = 0; h < 2; ++h) { unsigned pk = 0;
#pragma unroll
                for (int i = 0; i < 2; ++i) { int R, C; pg8::stage_rc(tid * 16 + i * 8192, R, C); const int idx = j0 + h * 128 + R; const unsigned tok = idx < cnt ? (unsigned)lp[idx] : 0u; pk |= tok << (16 * i); }
                v[h][0] = pk; }
        } else {
#pragma unroll
            for (int i = 0; i < 2; ++i) { int R, C; pg8::stage_rc(tid * 16 + i * 8192, R, C); v[0][i] = (unsigned)((u.pm * 256 + R) * RB + C * 2); } }
    }
    __device__ __forceinline__ const char* a_base(const Unit&) const { return A; }
    __device__ __forceinline__ const char* b_base(const Unit& u) const { return Wt + (size_t)u.e * estride + (size_t)u.pn * 256 * RB; }
};

#define EPI_LOOP_ROWS for (int ai = 0; ai < 2; ++ai) _Pragma("unroll") for (int m = 0; m < 4; ++m)
__device__ __forceinline__ u32x4 pack8(const f32x4& v0, const f32x4& v1) { u32x4 w; w.x = cvt_pk_bf16(v0[0], v0[1]); w.y = cvt_pk_bf16(v0[2], v0[3]); w.z = cvt_pk_bf16(v1[0], v1[1]); w.w = cvt_pk_bf16(v1[2], v1[3]); return w; }

struct EpiQKV {
    bf16* Q; bf16* Kb; bf16* Vt; const float* cosT; const float* sinT;
    __device__ __forceinline__ void operator()(const f32x4 (&acc)[2][2][4][2], const Unit& u, int wr, int wc, int fr, int fq) const {
        asm volatile("" : "+v"(fr), "+v"(fq));
        if (u.kind == 0) {
            const bool isq = u.pn < 4; bf16* base = isq ? Q : Kb; const float sc = isq ? C2 : 1.f;
            const bool lat = (u.pm % 9) != 0; const int jp0 = 16 * (wc & 1) + 4 * fq;
#pragma unroll
            EPI_LOOP_ROWS { const int row = u.pm * 256 + ai * 128 + wr * 64 + m * 16 + fr; const int t = (row % RPB) - CTXL;
                f32x4 cs = {1.f, 1.f, 1.f, 1.f}, sn = {0.f, 0.f, 0.f, 0.f};
                if (lat) { cs = *(const f32x4*)(cosT + t * 32 + jp0); sn = *(const f32x4*)(sinT + t * 32 + jp0); }
#pragma unroll
                for (int bj = 0; bj < 2; ++bj) { const f32x4 a = acc[ai][bj][m][0], b = acc[ai][bj][m][1]; f32x4 o0, o1;
                    o0[0] = (a[0] * cs[0] - a[1] * sn[0]) * sc; o0[1] = (a[1] * cs[0] + a[0] * sn[0]) * sc; o0[2] = (a[2] * cs[1] - a[3] * sn[1]) * sc; o0[3] = (a[3] * cs[1] + a[2] * sn[1]) * sc;
                    o1[0] = (b[0] * cs[2] - b[1] * sn[2]) * sc; o1[1] = (b[1] * cs[2] + b[0] * sn[2]) * sc; o1[2] = (b[2] * cs[3] - b[3] * sn[3]) * sc; o1[3] = (b[3] * cs[3] + b[2] * sn[3]) * sc;
                    const int col = (u.pn & 3) * 256 + bj * 128 + wc * 32 + fq * 8;
                    *(u32x4*)(base + (size_t)row * 1024 + col) = pack8(o0, o1); } }
        } else {
#pragma unroll
            EPI_LOOP_ROWS { const int row = u.pm * 256 + ai * 128 + wr * 64 + m * 16 + fr;
#pragma unroll
                for (int bj = 0; bj < 2; ++bj) { const int col = u.pn * 256 + bj * 128 + wc * 32 + fq * 8;
                    *(u32x4*)(Vt + (size_t)row * M + col) = pack8(acc[ai][bj][m][0], acc[ai][bj][m][1]); } }
        }
    }
};
struct EpiPlain {
    bf16* O; int ldc;
    __device__ __forceinline__ void operator()(const f32x4 (&acc)[2][2][4][2], const Unit& u, int wr, int wc, int fr, int fq) const {
        asm volatile("" : "+v"(fr), "+v"(fq));
#pragma unroll
        EPI_LOOP_ROWS { const int row = u.pm * 256 + ai * 128 + wr * 64 + m * 16 + fr;
#pragma unroll
            for (int bj = 0; bj < 2; ++bj) { const int col = u.pn * 256 + bj * 128 + wc * 32 + fq * 8;
                *(u32x4*)(O + (size_t)row * ldc + col) = pack8(acc[ai][bj][m][0], acc[ai][bj][m][1]); } }
    }
};
struct EpiResid {
    const float* Xin; float* X; const float* gate;
    __device__ __forceinline__ void operator()(const f32x4 (&acc)[2][2][4][2], const Unit& u, int wr, int wc, int fr, int fq) const {
        asm volatile("" : "+v"(fr), "+v"(fq));
        const int rb = (u.pm % 9) == 0 ? 16 : u.pm / 9; const float* gp = gate + rb * 6144;
        f32x4 gv[2][2];
#pragma unroll
        for (int bj = 0; bj < 2; ++bj) { const int col = u.pn * 256 + bj * 128 + wc * 32 + fq * 8; gv[bj][0] = *(const f32x4*)(gp + col); gv[bj][1] = *(const f32x4*)(gp + col + 4); }
#pragma unroll
        EPI_LOOP_ROWS { const int row = u.pm * 256 + ai * 128 + wr * 64 + m * 16 + fr;
#pragma unroll
            for (int bj = 0; bj < 2; ++bj) { const int col = u.pn * 256 + bj * 128 + wc * 32 + fq * 8; const size_t o = (size_t)row * 1024 + col;
                const f32x4 x0 = *(const f32x4*)(Xin + o), x1 = *(const f32x4*)(Xin + o + 4);
                *(f32x4*)(X + o) = x0 + gv[bj][0] * acc[ai][bj][m][0]; *(f32x4*)(X + o + 4) = x1 + gv[bj][1] * acc[ai][bj][m][1]; } }
    }
};
__device__ __forceinline__ float clamp8(float v) { return fminf(fmaxf(v, -448.f), 448.f); }
__device__ __forceinline__ unsigned pack_fp8x4(float a, float b, float c, float d) {
    int w = 0; w = __builtin_amdgcn_cvt_pk_fp8_f32(clamp8(a), clamp8(b), w, false); w = __builtin_amdgcn_cvt_pk_fp8_f32(clamp8(c), clamp8(d), w, true); return (unsigned)w; }
__device__ __forceinline__ float swiglu1(float g, float l) {
    g = fminf(g, 7.f); l = fminf(fmaxf(l, -7.f), 7.f);
    const float s = __builtin_amdgcn_rcpf(1.f + __builtin_amdgcn_exp2f(-1.702f * 1.4426950408889634f * g));
    return g * s * (l + 1.f);
}
template <bool F8> struct EpiSwiglu {
    bf16* ACT; const float* bgu;
    __device__ __forceinline__ void operator()(const f32x4 (&acc)[2][2][4][2], const Unit& u, int wr, int wc, int fr, int fq) const {
        asm volatile("" : "+v"(fr), "+v"(fq));
        const float* bp = bgu + u.e * 2048; f32x4 bv[2][2];
#pragma unroll
        for (int bj = 0; bj < 2; ++bj) { const int col = u.pn * 256 + bj * 128 + wc * 32 + fq * 8; bv[bj][0] = *(const f32x4*)(bp + col); bv[bj][1] = *(const f32x4*)(bp + col + 4); }
#pragma unroll
        EPI_LOOP_ROWS { const int row = u.pm * 256 + ai * 128 + wr * 64 + m * 16 + fr;
#pragma unroll
            for (int bj = 0; bj < 2; ++bj) { const f32x4 a = acc[ai][bj][m][0] + bv[bj][0], b = acc[ai][bj][m][1] + bv[bj][1];
                const int col = u.pn * 128 + bj * 64 + wc * 16 + fq * 4;
                if constexpr (F8) { *(unsigned*)((unsigned char*)ACT + (size_t)row * 1024 + col) = pack_fp8x4(4.f * swiglu1(a[0], a[1]), 4.f * swiglu1(a[2], a[3]), 4.f * swiglu1(b[0], b[1]), 4.f * swiglu1(b[2], b[3])); }
                else { u32x2 w; w.x = cvt_pk_bf16(swiglu1(a[0], a[1]), swiglu1(a[2], a[3])); w.y = cvt_pk_bf16(swiglu1(b[0], b[1]), swiglu1(b[2], b[3]));
                    *(u32x2*)(ACT + (size_t)row * 1024 + col) = w; } } }
    }
};
struct EpiDown {
    bf16* Y; const float* bd;
    __device__ __forceinline__ void operator()(const f32x4 (&acc)[2][2][4][2], const Unit& u, int wr, int wc, int fr, int fq) const {
        asm volatile("" : "+v"(fr), "+v"(fq));
        const float* bp = bd + u.e * 1024; f32x4 bv[2][2];
#pragma unroll
        for (int bj = 0; bj < 2; ++bj) { const int col = u.pn * 256 + bj * 128 + wc * 32 + fq * 8; bv[bj][0] = *(const f32x4*)(bp + col); bv[bj][1] = *(const f32x4*)(bp + col + 4); }
#pragma unroll
        EPI_LOOP_ROWS { const int row = u.pm * 256 + ai * 128 + wr * 64 + m * 16 + fr;
#pragma unroll
            for (int bj = 0; bj < 2; ++bj) { const int col = u.pn * 256 + bj * 128 + wc * 32 + fq * 8;
                *(u32x4*)(Y + (size_t)row * 1024 + col) = pack8(acc[ai][bj][m][0] + bv[bj][0], acc[ai][bj][m][1] + bv[bj][1]); } }
    }
};

namespace att {
constexpr int SLOT = 32768, VOFF = 16384;
__device__ __forceinline__ void glds16(const void* gsrc, unsigned lds_dst) { unsigned keep;
    asm volatile("s_mov_b32 %0, m0\n\ts_mov_b32 m0, %2\n\ts_nop 0\n\tglobal_load_lds_dwordx4 %1, off\n\ts_mov_b32 m0, %0" : "=&s"(keep) : "v"(gsrc), "s"(lds_dst) : "memory"); }
#define ATT_WAIT_BAR(N) asm volatile("s_waitcnt vmcnt(" #N ") lgkmcnt(0)\n\ts_barrier" ::: "memory")
__device__ __forceinline__ float half_swap_max(float m) { auto rr = __builtin_amdgcn_permlane32_swap(__float_as_uint(m), __float_as_uint(m), false, false); return fmaxf(__uint_as_float(rr[0]), __uint_as_float(rr[1])); }
__device__ __forceinline__ float half_swap_sum(float m) { auto rr = __builtin_amdgcn_permlane32_swap(__float_as_uint(m), __float_as_uint(m), false, false); return __uint_as_float(rr[0]) + __uint_as_float(rr[1]); }
__device__ __forceinline__ int crow(int r, int hi) { return (r & 3) + 8 * (r >> 2) + 4 * hi; }

__device__ __forceinline__ void attn_unit(LAS unsigned char* lds, LAS float* wsc  , const bf16* Q, const bf16* Kb, const bf16* Vt, bf16* O,
                                          int krow0, int h, int qrow0, int NT, float lam, float osc, const float* subg, const int tid) {
    const int lane = tid & 63, r32 = lane & 31, hi = lane >> 5; const int wid = __builtin_amdgcn_readfirstlane(tid >> 6);
    const int qg = wid >> 1, c = wid & 1;
    const unsigned lds0 = (unsigned)(uintptr_t)lds;
    const bf16* ksrc[2]; const bf16* vsrc[2];
#pragma unroll
    for (int i = 0; i < 2; ++i) { const int p = 2 * wid + i;
        { const int row = 4 * p + (lane >> 4), ch = (lane & 15) ^ (row & 15); ksrc[i] = Kb + (size_t)(krow0 + row) * 1024 + h * 128 + ch * 8; }
        { const int row = 8 * p + (lane >> 3), ch = (lane & 7) ^ ((row >> 1) & 7); vsrc[i] = Vt + (size_t)(h * 128 + row) * M + krow0 + ch * 8; } }
    const unsigned kdst = lds0 + (unsigned)wid * 2048u, vdst = lds0 + VOFF + (unsigned)wid * 2048u;
#define ATT_DMA(t, slot) do { const unsigned so_ = (unsigned)(slot) * SLOT; \
        glds16(ksrc[0] + (size_t)(t) * 64 * 1024, (unsigned)__builtin_amdgcn_readfirstlane(kdst + so_)); glds16(ksrc[1] + (size_t)(t) * 64 * 1024, (unsigned)__builtin_amdgcn_readfirstlane(kdst + so_ + 1024u)); \
        glds16(vsrc[0] + (size_t)(t) * 64, (unsigned)__builtin_amdgcn_readfirstlane(vdst + so_)); glds16(vsrc[1] + (size_t)(t) * 64, (unsigned)__builtin_amdgcn_readfirstlane(vdst + so_ + 1024u)); } while (0)
    const int key0 = (r32 & 0x13) | ((r32 & 4) << 1) | ((r32 & 8) >> 1);
    const int kx = key0 & 15, vx = (r32 >> 1) & 7;
    bf16x8 qf[4];
    { const bf16* qp = Q + (size_t)(qrow0 + qg * 32 + r32) * 1024 + h * 128 + c * 64 + hi * 8;
#pragma unroll
      for (int d0 = 0; d0 < 4; ++d0) qf[d0] = *(const bf16x8*)(qp + d0 * 16); }
    f32x16 o[4];
#pragma unroll
    for (int d0 = 0; d0 < 4; ++d0) o[d0] = f32x16{};
    float mref = 0.f, lsum = 0.f;
    asm volatile("s_waitcnt vmcnt(0)" ::: "memory");
    const int grp = wid >> 2;
    ATT_DMA(0, 0);
    if (NT > 1) ATT_DMA(1, 1);
    for (int t = 0; t < NT; ++t) {
        const int slot = t & 3;
        if (grp == 0 || t == 0) {
            if (t + 1 < NT) { ATT_WAIT_BAR(4); } else { ATT_WAIT_BAR(0); }
            if (t + 2 < NT) ATT_DMA(t + 2, (t + 2) & 3);
        }
        const LAS unsigned char* kb_ = lds + slot * SLOT; const LAS unsigned char* vb_ = kb_ + VOFF;
        f32x16 s0, s1;
#pragma unroll
        for (int r = 0; r < 16; ++r) { s0[r] = -mref; s1[r] = -mref; }
        bf16x8 kf[8];
#pragma unroll
        for (int d0 = 0; d0 < 4; ++d0) { const int ch = (c * 8 + d0 * 2 + hi) ^ kx;
            kf[2 * d0] = *(const LAS bf16x8*)(kb_ + key0 * 256 + ch * 16); kf[2 * d0 + 1] = *(const LAS bf16x8*)(kb_ + (key0 + 32) * 256 + ch * 16); }
        __builtin_amdgcn_sched_barrier(0);
#pragma unroll
        for (int d0 = 0; d0 < 4; ++d0) { s0 = __builtin_amdgcn_mfma_f32_32x32x16_bf16(kf[2 * d0], qf[d0], s0, 0, 0, 0); s1 = __builtin_amdgcn_mfma_f32_32x32x16_bf16(kf[2 * d0 + 1], qf[d0], s1, 0, 0, 0); }
        bf16x8 vA[8], vB[8];
#pragma unroll
        for (int ks = 0; ks < 2; ++ks) { const int ch = (2 * ks + hi) ^ vx;
#pragma unroll
            for (int d0 = 0; d0 < 4; ++d0) vA[ks * 4 + d0] = *(const LAS bf16x8*)(vb_ + (d0 * 32 + r32) * 128 + ch * 16); }
        __builtin_amdgcn_sched_barrier(0);
        float rm = fmaxf(s0[0], s1[0]);
#pragma unroll
        for (int r = 1; r < 16; ++r) rm = fmaxf(rm, fmaxf(s0[r], s1[r]));
        rm = half_swap_max(rm);
        const bool need = (t == 0) || (rm > 8.f);
        if (__any(need)) {
            const float dl = need ? rm : 0.f; mref += dl;
#pragma unroll
            for (int r = 0; r < 16; ++r) { s0[r] -= dl; s1[r] -= dl; }
            const float f = (t == 0) ? 1.f : __builtin_amdgcn_exp2f(-dl); lsum *= f;
            if (hi == 0) wsc[r32] = f;
            asm volatile("s_waitcnt lgkmcnt(0)" ::: "memory");
#pragma unroll
            for (int r = 0; r < 16; ++r) { const float fr_ = wsc[crow(r, hi)];
#pragma unroll
                for (int d0 = 0; d0 < 4; ++d0) o[d0][r] *= fr_; }
            asm volatile("s_waitcnt lgkmcnt(0)" ::: "memory");
        }
        float sa = 0.f;
#pragma unroll
        for (int r = 0; r < 16; ++r) { s0[r] = __builtin_amdgcn_exp2f(s0[r]); s1[r] = __builtin_amdgcn_exp2f(s1[r]); sa += s0[r] + s1[r]; }
        lsum += sa;
        bf16x8 pa[4];
#pragma unroll
        for (int s = 0; s < 2; ++s) { u32x4 w0, w1;
            w0.x = cvt_pk_bf16(s0[8 * s + 0], s0[8 * s + 1]); w0.y = cvt_pk_bf16(s0[8 * s + 2], s0[8 * s + 3]); w0.z = cvt_pk_bf16(s0[8 * s + 4], s0[8 * s + 5]); w0.w = cvt_pk_bf16(s0[8 * s + 6], s0[8 * s + 7]);
            w1.x = cvt_pk_bf16(s1[8 * s + 0], s1[8 * s + 1]); w1.y = cvt_pk_bf16(s1[8 * s + 2], s1[8 * s + 3]); w1.z = cvt_pk_bf16(s1[8 * s + 4], s1[8 * s + 5]); w1.w = cvt_pk_bf16(s1[8 * s + 6], s1[8 * s + 7]);
            pa[s] = __builtin_bit_cast(bf16x8, w0); pa[2 + s] = __builtin_bit_cast(bf16x8, w1); }
        if (grp == 1 && t + 1 < NT) {
            if (t + 2 < NT) { ATT_WAIT_BAR(4); } else { ATT_WAIT_BAR(0); }
            if (t + 3 < NT) ATT_DMA(t + 3, (t + 3) & 3);
        }
        __builtin_amdgcn_sched_barrier(0);
#pragma unroll
        for (int ks = 2; ks < 4; ++ks) { const int ch = (2 * ks + hi) ^ vx;
#pragma unroll
            for (int d0 = 0; d0 < 4; ++d0) vB[(ks - 2) * 4 + d0] = *(const LAS bf16x8*)(vb_ + (d0 * 32 + r32) * 128 + ch * 16); }
        __builtin_amdgcn_sched_barrier(0);
#pragma unroll
        for (int ks = 0; ks < 2; ++ks)
#pragma unroll
            for (int d0 = 0; d0 < 4; ++d0) o[d0] = __builtin_amdgcn_mfma_f32_32x32x16_bf16(pa[ks], vA[ks * 4 + d0], o[d0], 0, 0, 0);
        __builtin_amdgcn_sched_barrier(0);
#pragma unroll
        for (int ks = 2; ks < 4; ++ks)
#pragma unroll
            for (int d0 = 0; d0 < 4; ++d0) o[d0] = __builtin_amdgcn_mfma_f32_32x32x16_bf16(pa[ks], vB[(ks - 2) * 4 + d0], o[d0], 0, 0, 0);
    }
    const float lt = half_swap_sum(lsum);
    if (hi == 0) wsc[64 + r32] = (c ? -lam : 1.f) * __builtin_amdgcn_rcpf(lt);
    asm volatile("s_waitcnt lgkmcnt(0)\n\ts_barrier" ::: "memory");
    LAS float* xch = (LAS float*)(lds + qg * 16384);
#pragma unroll
    for (int r = 0; r < 16; ++r) { const float a = wsc[64 + crow(r, hi)];
#pragma unroll
        for (int d0 = 0; d0 < 4; ++d0) o[d0][r] *= a; }
    if (c == 1) {
#pragma unroll
        for (int d0 = 0; d0 < 4; ++d0)
#pragma unroll
            for (int r = 0; r < 16; ++r) xch[(d0 * 16 + r) * 64 + lane] = o[d0][r];
    }
    asm volatile("s_waitcnt lgkmcnt(0)\n\ts_barrier" ::: "memory");
    if (c == 0) {
        float sg[4];
#pragma unroll
        for (int d0 = 0; d0 < 4; ++d0) sg[d0] = subg[d0 * 32 + r32] * osc;
        bf16* Ow = O + (size_t)(qrow0 + qg * 32) * 1024 + h * 128 + r32;
#pragma unroll
        for (int r = 0; r < 16; ++r) { const int qr = crow(r, hi);
            float v[4], ss = 0.f;
#pragma unroll
            for (int d0 = 0; d0 < 4; ++d0) { v[d0] = o[d0][r] + xch[(d0 * 16 + r) * 64 + lane]; ss += v[d0] * v[d0]; }
#pragma unroll
            for (int of = 1; of < 32; of <<= 1) ss += __shfl_xor(ss, of);
            const float rn = __builtin_amdgcn_rsqf(ss * (1.f / 128.f) + EPS);
#pragma unroll
            for (int d0 = 0; d0 < 4; ++d0) Ow[(size_t)qr * 1024 + d0 * 32] = (bf16)f2bf(v[d0] * rn * sg[d0]); }
    }
    asm volatile("s_waitcnt lgkmcnt(0)\n\ts_barrier" ::: "memory");
#undef ATT_DMA
}
}

__device__ __forceinline__ void load_row_f32(const float* p, int lane, f32x4 (&v)[4]) {
#pragma unroll
    for (int j = 0; j < 4; ++j) v[j] = *(const f32x4*)(p + 256 * j + 4 * lane);
}
__device__ __forceinline__ float row_rstd(const f32x4 (&v)[4]) {
    float s = 0.f;
#pragma unroll
    for (int j = 0; j < 4; ++j) s += (v[j][0] * v[j][0] + v[j][1] * v[j][1]) + (v[j][2] * v[j][2] + v[j][3] * v[j][3]);
    return 1.0f / sqrtf(wave_sum(s) * (1.f / D) + EPS);
}
__device__ __forceinline__ void norm_mod_store(f32x4 (&v)[4], const float* g, const float* sc, const float* sh, int lane, bf16* hrow) {
    const float rstd = row_rstd(v);
#pragma unroll
    for (int j = 0; j < 4; ++j) { const int c = 256 * j + 4 * lane; const f32x4 gg = *(const f32x4*)(g + c), ss = *(const f32x4*)(sc + c), hh = *(const f32x4*)(sh + c);
        v[j] = (v[j] * rstd) * gg * (ss + 1.f) + hh;
        u32x2 w; w.x = cvt_pk_bf16(v[j][0], v[j][1]); w.y = cvt_pk_bf16(v[j][2], v[j][3]); *(u32x2*)(hrow + c) = w; }
}
__device__ __forceinline__ void norm_mod_f32(f32x4 (&v)[4], const float* g, const float* sc, const float* sh, int lane) {
    const float rstd = row_rstd(v);
#pragma unroll
    for (int j = 0; j < 4; ++j) { const int c = 256 * j + 4 * lane; const f32x4 gg = *(const f32x4*)(g + c), ss = *(const f32x4*)(sc + c), hh = *(const f32x4*)(sh + c);
        v[j] = (v[j] * rstd) * gg * (ss + 1.f) + hh; }
}
__device__ __forceinline__ int row_batch(int row) { return row / RPB; }
__device__ __forceinline__ bool row_is_ctx(int row) { return (row % RPB) < CTXL; }
__device__ __forceinline__ int act_row(int ai, bool lat_only) { return lat_only ? (ai >> 11) * RPB + CTXL + (ai & 2047) : ai; }

template <int MODE>
__device__ __forceinline__ void transpose_item(const float* W, int K, int N, bf16* WT, LAS float* scr, int item, int lane) {
    const int nblk = N / 32, kb = item / nblk, nb = item % nblk, k0 = 64 * kb, n0 = 32 * nb;
#pragma unroll 8
    for (int i = 0; i < 32; ++i) { const int kk = 2 * i + (lane >> 5); scr[kk * 33 + (lane & 31)] = W[(size_t)(k0 + kk) * N + n0 + (lane & 31)]; }
    asm volatile("s_waitcnt lgkmcnt(0)" ::: "memory");
    const int c = lane & 7;
#pragma unroll
    for (int j = 0; j < 4; ++j) { const int n = (lane >> 3) + 8 * j; const LAS float* s = scr + (8 * c) * 33 + n;
        u32x4 o; o.x = cvt_pk_bf16(s[0 * 33], s[1 * 33]); o.y = cvt_pk_bf16(s[2 * 33], s[3 * 33]); o.z = cvt_pk_bf16(s[4 * 33], s[5 * 33]); o.w = cvt_pk_bf16(s[6 * 33], s[7 * 33]);
        int nn = n0 + n;
        if (MODE == 1 && nn < 2048) { const int i6 = nn & 63; nn = (nn & ~63) + (i6 < 32 ? 2 * i6 : 2 * (i6 - 32) + 1); }
        *(u32x4*)(WT + (size_t)nn * K + k0 + 8 * c) = o; }
    asm volatile("s_waitcnt lgkmcnt(0)" ::: "memory");
}

__device__ __forceinline__ void transpose_item8(const float* W, int K, int N, unsigned char* WT, LAS float* scr, int item, int lane) {
    const int nblk = N / 32, kb = item / nblk, nb = item % nblk, k0 = 64 * kb, n0 = 32 * nb;
#pragma unroll 8
    for (int i = 0; i < 32; ++i) { const int kk = 2 * i + (lane >> 5); scr[kk * 33 + (lane & 31)] = W[(size_t)(k0 + kk) * N + n0 + (lane & 31)]; }
    asm volatile("s_waitcnt lgkmcnt(0)" ::: "memory");
    const int c = lane & 7;
#pragma unroll
    for (int j = 0; j < 4; ++j) { const int n = (lane >> 3) + 8 * j; const LAS float* s = scr + (8 * c) * 33 + n;
        u32x2 o; o.x = pack_fp8x4(1024.f * s[0 * 33], 1024.f * s[1 * 33], 1024.f * s[2 * 33], 1024.f * s[3 * 33]); o.y = pack_fp8x4(1024.f * s[4 * 33], 1024.f * s[5 * 33], 1024.f * s[6 * 33], 1024.f * s[7 * 33]);
        *(u32x2*)(WT + (size_t)(n0 + n) * K + k0 + 8 * c) = o; }
    asm volatile("s_waitcnt lgkmcnt(0)" ::: "memory");
}

struct Args { const float* in[21]; float* out; unsigned char* ws; int ph_lo, ph_hi; };
enum { I_X = 0, I_C, I_CTX, I_CCTX, I_MODW, I_MODB, I_NORMG, I_WQKV, I_WO, I_LAM, I_SUBG, I_WIN, I_CONVW, I_WOUT, I_RW, I_RB, I_WGU, I_BGU, I_WD, I_BD, I_FINALG };

__device__ __forceinline__ void moe_table(LAS unsigned char* lds, const unsigned* gcnt, int tid) {
    LAS int* ecnt = (LAS int*)(lds + LX_ECNT); LAS int* tstart = (LAS int*)(lds + LX_TSTART); LAS int* tile_e = (LAS int*)(lds + LX_TILEE);
    __syncthreads();
    if (tid < 32) ecnt[tid] = (int)__hip_atomic_load(gcnt + tid, RLX_AGENT);
    __syncthreads();
    if (tid == 0) { int ts = 0; for (int e = 0; e < 32; ++e) { tstart[e] = ts; ts += (ecnt[e] + 255) >> 8; } tstart[32] = ts; }
    __syncthreads();
    { const int e = tid >> 4, l16 = tid & 15; const int t0 = tstart[e], n = tstart[e + 1] - t0; for (int j = l16; j < n; j += 16) tile_e[t0 + j] = e; }
    __syncthreads();
}

typedef const __attribute__((address_space(4))) unsigned char* kptr_t;
__device__ __forceinline__ kptr_t kargs() { kptr_t p = (kptr_t)__builtin_amdgcn_kernarg_segment_ptr(); asm volatile("" : "+s"(p)); return p; }
#define INP(k) (*(const float* const __attribute__((address_space(4)))*)(kargs() + 8 * (k)))
#define OUTP() (*(float* const __attribute__((address_space(4)))*)(kargs() + 168))
#define WSB() (*(unsigned char* const __attribute__((address_space(4)))*)(kargs() + 176))
#define WSP(T, off) ((T*)(WSB() + (off)))
static_assert(sizeof(Args) == 192, "kernarg layout");
__global__ void __launch_bounds__(NTHREADS, 2) fwd(Args args) {
    extern __shared__ __attribute__((aligned(16))) unsigned char lds_raw[];
    LAS unsigned char* lds = (LAS unsigned char*)lds_raw;
    const int tid = threadIdx.x, lane = tid & 63, wave = __builtin_amdgcn_readfirstlane(tid >> 6);
    const int G = gridDim.x, bid = blockIdx.x;
    const int gw = bid * NWAVES + wave, NGW = G * NWAVES;
    gu32* ctl = (gu32*)WSP(unsigned, WS_CTL);
    for (int u = tid; u < (LDS_BYTES - LX) / 4; u += NTHREADS) ((LAS unsigned*)(lds + LX))[u] = 0u;
    __syncthreads();
    volatile LAS unsigned* MISC = (volatile LAS unsigned*)(lds + LX_MISC);
    XcdBarrier bar; bar.bar = (unsigned*)(ctl + CW_BAR); bar.x = 0; bar.st = nullptr;
    if (!MK_PER_PHASE) bar = xcd_barrier_post((unsigned*)(ctl + CW_BAR), MISC + 8);
    (void)args;
    const int lo = *(const int __attribute__((address_space(4)))*)(kargs() + 184), hi = *(const int __attribute__((address_space(4)))*)(kargs() + 188);
#define IN(k) (lo <= (k) && (k) < hi)
#define PHASE_IDS int tid = threadIdx.x; asm volatile("" : "+v"(tid)); const int lane = tid & 63, wave = __builtin_amdgcn_readfirstlane(tid >> 6); const int gw = bid * NWAVES + wave; (void)lane; (void)gw;
#define SEAM(k) do { if (IN(k) && IN((k) + 1)) { if (MK_PER_PHASE) { if (tid == 0) __hip_atomic_store(ctl + CW_TMO, 0xBADu, RLX_AGENT); } else xcd_barrier(bar); } } while (0)

    if (PS(0) && IN(0)) { PHASE_IDS
        float* modv = WSP(float, WS_MODV);
        { LAS float* sil = (LAS float*)lds;
          LAS float* red = (LAS float*)(lds + 69632);
          for (int i = tid; i < 17 * 1024; i += NTHREADS) { const int r = i >> 10, k = i & 1023; const float cv = r < 16 ? INP(I_C)[r * 1024 + k] : INP(I_CCTX)[k]; sil[i] = cv / (1.f + __expf(-cv)); }
          __syncthreads();
          for (int it = bid; it < 4 * 96; it += G) { const int l = it / 96, nb = it % 96; const float* W = INP(I_MODW) + (size_t)l * 1024 * 6144 + nb * 64 + lane;
            float a[17];
#pragma unroll
            for (int r = 0; r < 17; ++r) a[r] = 0.f;
            for (int k = wave * 128; k < wave * 128 + 128; k += 4) { float w[4];
#pragma unroll
                for (int q = 0; q < 4; ++q) w[q] = W[(size_t)(k + q) * 6144];
#pragma unroll
                for (int r = 0; r < 17; ++r) { const f32x4 s = *(const LAS f32x4*)(sil + r * 1024 + k); a[r] += s[0] * w[0] + s[1] * w[1] + s[2] * w[2] + s[3] * w[3]; } }
#pragma unroll
            for (int r = 0; r < 17; ++r) red[(wave * 17 + r) * 64 + lane] = a[r];
            __syncthreads();
            for (int i = tid; i < 17 * 64; i += NTHREADS) { const int r = i >> 6, n = i & 63; float s = INP(I_MODB)[l * 6144 + nb * 64 + n];
#pragma unroll
                for (int w8 = 0; w8 < 8; ++w8) s += red[(w8 * 17 + r) * 64 + n];
                modv[((size_t)l * 17 + r) * 6144 + nb * 64 + n] = s; }
            __syncthreads(); }
        }
        { float* cosT = WSP(float, WS_ROPE); float* sinT = cosT + 2048 * 32; float* rwT = WSP(float, WS_RW); float* lamv = WSP(float, WS_MISC);
        for (int i = bid * NTHREADS + tid; i < 2048 * 32; i += G * NTHREADS) { const int t = i >> 5, j = i & 31; const float pos = (float)(j < 16 ? (t >> 6) : (t & 63));
            const float inv = powf(10000.f, -(float)(2 * (j & 15)) / 32.f); const float ang = pos * inv; cosT[i] = cosf(ang); sinT[i] = sinf(ang); }
        if (bid == 0 && tid < 2) { const float* lp = INP(I_LAM) + tid * 256; float s1 = 0.f, s2 = 0.f; for (int d = 0; d < 64; ++d) { s1 += lp[d] * lp[64 + d]; s2 += lp[128 + d] * lp[192 + d]; }
            const float lam_init = 0.8f - 0.6f * expf(-0.3f * (float)(2 * tid)); lamv[tid] = expf(s1) - expf(s2) + lam_init; lamv[2 + tid] = 1.f - lam_init; }
        for (int i = bid * NTHREADS + tid; i < 4 * 32 * 1024; i += G * NTHREADS) { const int l = i >> 15, e = (i >> 10) & 31, k = i & 1023; rwT[i] = INP(I_RW)[((size_t)l * 1024 + k) * 32 + e]; } }
        { LAS float* scr = (LAS float*)(lds + wave * 8704);
          bf16* Wqkv_t = WSP(bf16, WS_WQKV); bf16* Win_t = WSP(bf16, WS_WIN); bf16* Wo_t = WSP(bf16, WS_WO); bf16* Wout_t = WSP(bf16, WS_WOUT); bf16* Wgu_t = WSP(bf16, WS_WGU); bf16* Wd_t = WSP(bf16, WS_WD);
          constexpr int I_QKV = 16 * 96, I_SQ = 16 * 32, I_GU = 16 * 64, I_D = 16 * 32;
          constexpr int T0 = 2 * I_QKV, T1 = T0 + 2 * I_QKV, T2 = T1 + 2 * I_SQ, T3 = T2 + 2 * I_SQ, T4 = T3 + 128 * I_GU, T5 = T4 + 128 * I_D;
          for (int rep = 0; rep < NREP(0); ++rep)
          for (int it = gw; it < T5; it += NGW) {
            if (it < T0) { const int j = it / I_QKV; transpose_item<1>(INP(I_WQKV) + (size_t)j * 1024 * 3072, 1024, 3072, Wqkv_t + (size_t)j * 3072 * 1024, scr, it % I_QKV, lane); }
            else if (it < T1) { const int r = it - T0, j = r / I_QKV; transpose_item<0>(INP(I_WIN) + (size_t)j * 1024 * 3072, 1024, 3072, Win_t + (size_t)j * 3072 * 1024, scr, r % I_QKV, lane); }
            else if (it < T2) { const int r = it - T1, j = r / I_SQ; transpose_item<0>(INP(I_WO) + (size_t)j * 1024 * 1024, 1024, 1024, Wo_t + (size_t)j * 1024 * 1024, scr, r % I_SQ, lane); }
            else if (it < T3) { const int r = it - T2, j = r / I_SQ; transpose_item<0>(INP(I_WOUT) + (size_t)j * 1024 * 1024, 1024, 1024, Wout_t + (size_t)j * 1024 * 1024, scr, r % I_SQ, lane); }
            else if (it < T4) { const int r = it - T3, j = r / I_GU;
                if (MOE_FP8) transpose_item8(INP(I_WGU) + (size_t)j * 1024 * 2048, 1024, 2048, (unsigned char*)Wgu_t + (size_t)j * 2048 * 1024, scr, r % I_GU, lane);
                else transpose_item<0>(INP(I_WGU) + (size_t)j * 1024 * 2048, 1024, 2048, Wgu_t + (size_t)j * 2048 * 1024, scr, r % I_GU, lane); }
            else { const int r = it - T4, j = r / I_D;
                if (MOE_FP8) transpose_item8(INP(I_WD) + (size_t)j * 1024 * 1024, 1024, 1024, (unsigned char*)Wd_t + (size_t)j * 1024 * 1024, scr, r % I_D, lane);
                else transpose_item<0>(INP(I_WD) + (size_t)j * 1024 * 1024, 1024, 1024, Wd_t + (size_t)j * 1024 * 1024, scr, r % I_D, lane); }
          }
        }
        __syncthreads();
    }
    SEAM(0);

    if (PS(1) && IN(1)) { PHASE_IDS
        const float* g = INP(I_NORMG); const float* modv = WSP(float, WS_MODV); float* X = WSP(float, WS_X); bf16* H = WSP(bf16, WS_H);
        for (int row = gw; row < M; row += NGW) { const int b = row_batch(row), jj = row % RPB; const bool cx = jj < CTXL; const int rb = cx ? 16 : b;
            const float* src = cx ? INP(I_CTX) + ((size_t)b * CTXL + jj) * D : INP(I_X) + ((size_t)b * SEQ + (jj - CTXL)) * D;
            f32x4 v[4]; load_row_f32(src, lane, v);
#pragma unroll
            for (int j = 0; j < 4; ++j) *(f32x4*)(X + (size_t)row * D + 256 * j + 4 * lane) = v[j];
            norm_mod_store(v, g, modv + rb * 6144 + 1024, modv + rb * 6144, lane, H + (size_t)row * D); }
    }
    SEAM(1);

    for (int l = 0; l < DEPTH; ++l) {
        const int pb = 2 + 7 * l; const bool attn = (l & 1) == 0; const int j2 = l >> 1; const bool lat_only = (l == DEPTH - 1);
#define MV() (WSP(float, WS_MODV) + (size_t)l * 17 * 6144)
        const unsigned* gcnt = (const unsigned*)(ctl + CW_CNT) + l * 32;

        if (IN(pb)) { PHASE_IDS
            if (PS(2) && attn) {
                SchedQKV S{(const char*)WSP(bf16, WS_H), (const char*)(WSP(bf16, WS_WQKV) + (size_t)j2 * 3072 * 1024)};
                EpiQKV E{WSP(bf16, WS_Q), WSP(bf16, WS_K), WSP(bf16, WS_VT), WSP(float, WS_ROPE), WSP(float, WS_ROPE) + 2048 * 32};
                for (int rep = 0; rep < NREP(2); ++rep) pg8::gemm_phase<EpiQKV, SchedQKV>(lds, S, E, tid);
            } else if (PS(3)) {
                SchedPlain S{(const char*)WSP(bf16, WS_H), (const char*)(WSP(bf16, WS_WIN) + (size_t)j2 * 3072 * 1024), 12, lat_only};
                EpiPlain E{WSP(bf16, WS_BCO), 3072};
                for (int rep = 0; rep < NREP(3); ++rep) pg8::gemm_phase<EpiPlain, SchedPlain>(lds, S, E, tid);
            }
        }
        SEAM(pb);

        if (IN(pb + 1)) { PHASE_IDS
            if (PS(4) && attn) {
                const float* lamv = WSP(float, WS_MISC); const float lam = lamv[j2], osc = lamv[2 + j2]; const float* subg = INP(I_SUBG) + j2 * 128;
                const bf16* Qb = WSP(bf16, WS_Q); const bf16* Kb = WSP(bf16, WS_K); const bf16* Vt = WSP(bf16, WS_VT); bf16* Ob = WSP(bf16, WS_O);
                LAS float* wsc = (LAS float*)(lds + LX_WSC + wave * 1024);
                const int vcu = (G % 8 == 0) ? (bid % 8) * (G / 8) + bid / 8 : bid;
                for (int rep = 0; rep < NREP(4); ++rep)
                if (G == 256) {
                    const int xc = bid & 7, j = bid >> 3;
                    for (int sstep = 0; sstep < 8; ++sstep) { const int bh = xc * 16 + 2 * sstep + (j >> 4), b = bh >> 3, h = bh & 7;
                        att::attn_unit(lds, wsc, Qb, Kb, Vt, Ob, b * RPB, h, b * RPB + CTXL + (j & 15) * 128, 36, lam, osc, subg, tid); }
                    { const int bh = xc * 16 + (j >> 1), b = bh >> 3, h = bh & 7;
                      att::attn_unit(lds, wsc, Qb, Kb, Vt, Ob, b * RPB, h, b * RPB + (j & 1) * 128, 4, lam, osc, subg, tid); }
                } else {
                    for (int u = bid; u < 128 * 18; u += G) { const int bh = u / 18, k = u % 18, b = bh >> 3, h = bh & 7;
                        att::attn_unit(lds, wsc, Qb, Kb, Vt, Ob, b * RPB, h, k < 16 ? b * RPB + CTXL + k * 128 : b * RPB + (k - 16) * 128, k < 16 ? 36 : 4, lam, osc, subg, tid); }
                }
            } else if (PS(5)) {
                const float* cw = INP(I_CONVW) + (size_t)j2 * 3 * 1024; const bf16* BCO = WSP(bf16, WS_BCO); bf16* Ob = WSP(bf16, WS_O);
                const int nact = lat_only ? 32768 : M; const int nitems = (nact / 16) * 2;
                for (int it = gw; it < nitems; it += NGW) { const int strip = it >> 1, ch = (it & 1) * 512 + lane * 8; const int row0 = act_row(strip * 16, lat_only);
                    const int jj = row0 % RPB; const int seq_lo = jj < CTXL ? row0 - jj : row0 - jj + CTXL, seq_hi = jj < CTXL ? row0 - jj + CTXL : row0 - jj + RPB;
                    float w0[8], w1[8], w2[8];
#pragma unroll
                    for (int q = 0; q < 8; ++q) { w0[q] = cw[ch + q]; w1[q] = cw[1024 + ch + q]; w2[q] = cw[2048 + ch + q]; }
                    float up[8], uc[8], un[8];
                    auto load_u = [&](int row, float (&u)[8]) {
                        if (row < seq_lo || row >= seq_hi) {
#pragma unroll
                            for (int q = 0; q < 8; ++q) u[q] = 0.f;
                        } else { const bf16* p = BCO + (size_t)row * 3072; const u32x4 gc = *(const u32x4*)(p + 1024 + ch), xt = *(const u32x4*)(p + 2048 + ch);
#pragma unroll
                            for (int q = 0; q < 4; ++q) { u[2 * q] = bf2f((unsigned short)(gc[q] & 0xffffu)) * bf2f((unsigned short)(xt[q] & 0xffffu)); u[2 * q + 1] = bf2f((unsigned short)(gc[q] >> 16)) * bf2f((unsigned short)(xt[q] >> 16)); } } };
                    load_u(row0 - 1, up); load_u(row0, uc);
                    for (int r = 0; r < 16; ++r) { const int row = row0 + r; load_u(row + 1, un);
                        const u32x4 gb = *(const u32x4*)(BCO + (size_t)row * 3072 + ch); float z[8];
#pragma unroll
                        for (int q = 0; q < 8; ++q) { const float gbv = bf2f((unsigned short)((q & 1) ? (gb[q >> 1] >> 16) : (gb[q >> 1] & 0xffffu))); z[q] = gbv * (w0[q] * up[q] + w1[q] * uc[q] + w2[q] * un[q]); }
                        u32x4 o; o.x = cvt_pk_bf16(z[0], z[1]); o.y = cvt_pk_bf16(z[2], z[3]); o.z = cvt_pk_bf16(z[4], z[5]); o.w = cvt_pk_bf16(z[6], z[7]);
                        *(u32x4*)(Ob + (size_t)row * 1024 + ch) = o;
#pragma unroll
                        for (int q = 0; q < 8; ++q) { up[q] = uc[q]; uc[q] = un[q]; } } }
            }
        }
        SEAM(pb + 1);

        if (PS(6) && IN(pb + 2)) { PHASE_IDS
            SchedPlain S{(const char*)WSP(bf16, WS_O), (const char*)(WSP(bf16, attn ? WS_WO : WS_WOUT) + (size_t)j2 * 1024 * 1024), 4, lat_only};
            float* X = WSP(float, WS_X);
            EpiResid E{X, X, MV() + 2 * 1024};
            pg8::gemm_phase<EpiResid, SchedPlain>(lds, S, E, tid);
        }
        SEAM(pb + 2);

        if (PS(7) && IN(pb + 3)) { PHASE_IDS
            LAS int* lcnt = (LAS int*)(lds + LX_LCNT); LAS int* lbase = (LAS int*)(lds + LX_LBASE); LAS int* asg = (LAS int*)(lds + LX_ASG);
            LAS float* wsc = (LAS float*)(lds + LX_WSC + wave * 1024);
            __syncthreads();
            float* X = WSP(float, WS_X); bf16* H = WSP(bf16, WS_H); const float* mv = MV(); int* topE = WSP(int, WS_TOPE); float* topG = WSP(float, WS_TOPG); int* topP = WSP(int, WS_TOPP); int* list = WSP(int, WS_LIST);
            { const float* rw = WSP(float, WS_RW) + (size_t)l * 32 * 1024; for (int i = tid; i < 32 * 1024 / 4; i += NTHREADS) ((LAS f32x4*)lds)[i] = ((const f32x4*)rw)[i]; }
            if (tid < 32) lcnt[tid] = 0;
            __syncthreads();
            const int nact = lat_only ? 32768 : M; const int rpb = (nact + G - 1) / G; const int a0 = bid * rpb; int nr = nact - a0; nr = nr < 0 ? 0 : (nr > rpb ? rpb : nr);
            const float* g = INP(I_NORMG) + ((size_t)l * 2 + 1) * 1024; const float* rb_ = INP(I_RB) + l * 32;
            for (int i = wave; i < nr; i += NWAVES) { const int row = act_row(a0 + i, lat_only); const int rb = row_is_ctx(row) ? 16 : row_batch(row);
                f32x4 v[4]; load_row_f32(X + (size_t)row * D, lane, v);
                if (MOE_FP8) { norm_mod_f32(v, g, mv + rb * 6144 + 4 * 1024, mv + rb * 6144 + 3 * 1024, lane); unsigned char* h8 = WSP(unsigned char, WS_H8) + (size_t)row * 1024;
#pragma unroll
                    for (int j = 0; j < 4; ++j) *(unsigned*)(h8 + 256 * j + 4 * lane) = pack_fp8x4(16.f * v[j][0], 16.f * v[j][1], 16.f * v[j][2], 16.f * v[j][3]); }
                else norm_mod_store(v, g, mv + rb * 6144 + 4 * 1024, mv + rb * 6144 + 3 * 1024, lane, H + (size_t)row * D);
                float a[32];
#pragma unroll
                for (int e = 0; e < 32; ++e) { float s = 0.f;
#pragma unroll
                    for (int j = 0; j < 4; ++j) { const f32x4 w = *(const LAS f32x4*)(lds + ((e * 1024 + 256 * j + 4 * lane) << 2)); s += v[j][0] * w[0] + v[j][1] * w[1] + v[j][2] * w[2] + v[j][3] * w[3]; }
                    a[e] = s; }
#define RS_STEP(NIN, MASK) { const bool bit_ = (lane & (MASK)) != 0; _Pragma("unroll") for (int q = 0; q < (NIN) / 2; ++q) { const float keep_ = bit_ ? a[q + (NIN) / 2] : a[q]; const float send_ = bit_ ? a[q] : a[q + (NIN) / 2]; a[q] = keep_ + __shfl_xor(send_, (MASK)); } }
                RS_STEP(32, 32) RS_STEP(16, 16) RS_STEP(8, 8) RS_STEP(4, 4) RS_STEP(2, 2)
#undef RS_STEP
                const int my_e = lane >> 1; const float lg = a[0] + __shfl_xor(a[0], 1) + rb_[my_e];
                if ((lane & 1) == 0) wsc[my_e] = lg;
                asm volatile("s_waitcnt lgkmcnt(0)" ::: "memory");
                int rank = 0;
#pragma unroll
                for (int e = 0; e < 32; ++e) { const float o = wsc[e]; rank += (o > lg || (o == lg && e < my_e)) ? 1 : 0; }
                asm volatile("s_waitcnt lgkmcnt(0)" ::: "memory");
                if ((lane & 1) == 0 && rank < 4) { wsc[64 + rank] = lg; ((LAS int*)wsc)[72 + rank] = my_e; }
                asm volatile("s_waitcnt lgkmcnt(0)" ::: "memory");
                const float t0 = wsc[64], t1 = wsc[65], t2 = wsc[66], t3 = wsc[67];
                const float p0 = 1.f, p1 = __expf(t1 - t0), p2 = __expf(t2 - t0), p3 = __expf(t3 - t0); const float inv = 1.f / (p0 + p1 + p2 + p3);
                if (lane < 4) { const int e = ((LAS int*)wsc)[72 + lane]; const float p = lane == 0 ? p0 : lane == 1 ? p1 : lane == 2 ? p2 : p3;
                    const int lp = __hip_atomic_fetch_add(lcnt + e, 1, __ATOMIC_RELAXED, __HIP_MEMORY_SCOPE_WORKGROUP);
                    topE[row * 4 + lane] = e; topG[row * 4 + lane] = p * inv; asg[i * 4 + lane] = (lp << 5) | e; }
                asm volatile("s_waitcnt lgkmcnt(0)" ::: "memory");
            }
            __syncthreads();
            if (tid < 32) lbase[tid] = (int)__hip_atomic_fetch_add((unsigned*)gcnt + tid, (unsigned)lcnt[tid], RLX_AGENT);
            __syncthreads();
            for (int i = tid; i < nr * 4; i += NTHREADS) { const int av = asg[i], e = av & 31, pos = lbase[e] + (av >> 5); const int row = act_row(a0 + (i >> 2), lat_only);
                list[(size_t)e * CAP + pos] = row; topP[row * 4 + (i & 3)] = pos; }
            __syncthreads();
        }
        SEAM(pb + 3);

        if (PS(8) && IN(pb + 4)) { PHASE_IDS
            moe_table(lds, gcnt, tid);
            constexpr int RBM = MOE_FP8 ? 1024 : 2048;
            typedef SchedMoe<true, RBM, 0x78787878, 0x78787878> SG;
            SG S{(const char*)(MOE_FP8 ? (void*)WSP(unsigned char, WS_H8) : (void*)WSP(bf16, WS_H)), (const char*)WSP(bf16, WS_WGU) + (size_t)l * 32 * 2048 * RBM, WSP(int, WS_LIST), 8, (size_t)2048 * RBM,
                 (LAS const int*)(lds + LX_TSTART), (LAS const int*)(lds + LX_ECNT), (LAS const int*)(lds + LX_TILEE)};
            EpiSwiglu<MOE_FP8 != 0> E{WSP(bf16, WS_ACT), INP(I_BGU) + (size_t)l * 32 * 2048};
            pg8::gemm_phase<EpiSwiglu<MOE_FP8 != 0>, SG>(lds, S, E, tid);
        }
        SEAM(pb + 4);

        if (PS(9) && IN(pb + 5)) { PHASE_IDS
            moe_table(lds, gcnt, tid);
            constexpr int RBM = MOE_FP8 ? 1024 : 2048;
            typedef SchedMoe<false, RBM, 0x79797979, 0x79797979> SD;
            SD S{(const char*)WSP(bf16, WS_ACT), (const char*)WSP(bf16, WS_WD) + (size_t)l * 32 * 1024 * RBM, WSP(int, WS_LIST), 4, (size_t)1024 * RBM,
                 (LAS const int*)(lds + LX_TSTART), (LAS const int*)(lds + LX_ECNT), (LAS const int*)(lds + LX_TILEE)};
            EpiDown E{WSP(bf16, WS_Y), INP(I_BD) + (size_t)l * 32 * 1024};
            pg8::gemm_phase<EpiDown, SD>(lds, S, E, tid);
        }
        SEAM(pb + 5);

        if (PS(10) && IN(pb + 6)) { PHASE_IDS
            moe_table(lds, gcnt, tid);
            LAS const int* tstart = (LAS const int*)(lds + LX_TSTART);
            const int nact = lat_only ? 32768 : M;
            const float* gn = (l + 1 < DEPTH) ? INP(I_NORMG) + (size_t)(l + 1) * 2 * 1024 : INP(I_FINALG);
            const float* mv = MV(); const float* mvn = mv + 17 * 6144; float* X = WSP(float, WS_X); bf16* H = WSP(bf16, WS_H); const bf16* Yb = WSP(bf16, WS_Y);
            const int* topE = WSP(int, WS_TOPE); const float* topG = WSP(float, WS_TOPG); const int* topP = WSP(int, WS_TOPP);
            for (int ai = gw; ai < nact; ai += NGW) { const int row = act_row(ai, lat_only); const bool cx = row_is_ctx(row); const int rb = cx ? 16 : row_batch(row);
                f32x4 v[4]; load_row_f32(X + (size_t)row * D, lane, v);
                const int4 ev = *(const int4*)(topE + row * 4), pv = *(const int4*)(topP + row * 4); const f32x4 gv = *(const f32x4*)(topG + row * 4);
                const int ee[4] = {ev.x, ev.y, ev.z, ev.w}, pp[4] = {pv.x, pv.y, pv.z, pv.w};
                f32x4 acc4[4];
#pragma unroll
                for (int j = 0; j < 4; ++j) acc4[j] = (f32x4){0.f, 0.f, 0.f, 0.f};
#pragma unroll
                for (int k = 0; k < 4; ++k) { const bf16* yr = Yb + (size_t)(tstart[ee[k]] * 256 + pp[k]) * 1024; const float gk = gv[k];
#pragma unroll
                    for (int j = 0; j < 4; ++j) { const u32x2 w = *(const u32x2*)(yr + 256 * j + 4 * lane);
                        acc4[j][0] += gk * bf2f((unsigned short)(w.x & 0xffffu)); acc4[j][1] += gk * bf2f((unsigned short)(w.x >> 16)); acc4[j][2] += gk * bf2f((unsigned short)(w.y & 0xffffu)); acc4[j][3] += gk * bf2f((unsigned short)(w.y >> 16)); } }
                const float* g2 = mv + rb * 6144 + 5 * 1024;
#pragma unroll
                for (int j = 0; j < 4; ++j) { const f32x4 gg = *(const f32x4*)(g2 + 256 * j + 4 * lane); v[j] = v[j] + gg * acc4[j]; }
                if (l + 1 < DEPTH) {
#pragma unroll
                    for (int j = 0; j < 4; ++j) *(f32x4*)(X + (size_t)row * D + 256 * j + 4 * lane) = v[j];
                    if (!(l + 1 == DEPTH - 1 && cx))
                        norm_mod_store(v, gn, mvn + rb * 6144 + 1024, mvn + rb * 6144, lane, H + (size_t)row * D);
                } else {
                    const float rstd = row_rstd(v); float* op = OUTP() + ((size_t)row_batch(row) * SEQ + (row % RPB - CTXL)) * D;
#pragma unroll
                    for (int j = 0; j < 4; ++j) { const f32x4 gg = *(const f32x4*)(gn + 256 * j + 4 * lane); *(f32x4*)(op + 256 * j + 4 * lane) = (v[j] * rstd) * gg; }
                }
            }
        }
        if (l + 1 < DEPTH) SEAM(pb + 6);
    }
#undef IN
#undef SEAM
#undef MV
}

extern "C" void kernel_launch(void* const* d_in, const int* in_sizes, int n_in, void* d_out, int out_size, void* d_ws, size_t ws_size, hipStream_t stream) {
    static int grid = 0;
    if (grid == 0) {
        if (n_in != 21 || out_size != NB * SEQ * D || ws_size < WS_END) { fprintf(stderr, "kernel_launch: unexpected shapes (n_in %d, out %d, ws %zu)\n", n_in, out_size, ws_size); grid = -1; return; }
        int dev = 0, cus = 0, per_cu = 0;
        if (hipGetDevice(&dev) != hipSuccess || hipDeviceGetAttribute(&cus, hipDeviceAttributeMultiprocessorCount, dev) != hipSuccess) { grid = -1; return; }
        if (hipFuncSetAttribute((const void*)fwd, hipFuncAttributeMaxDynamicSharedMemorySize, LDS_BYTES) != hipSuccess) { fprintf(stderr, "kernel_launch: hipFuncSetAttribute failed\n"); grid = -1; return; }
        if (hipOccupancyMaxActiveBlocksPerMultiprocessor(&per_cu, (const void*)fwd, NTHREADS, LDS_BYTES) != hipSuccess || per_cu < 1) { fprintf(stderr, "kernel_launch: occupancy query says %d\n", per_cu); }
        (void)hipGetLastError();
        if (cus < 160) { fprintf(stderr, "kernel_launch: needs >= 160 CUs\n"); grid = -1; return; }
        grid = cus;
    }
    if (grid < 0) return;
    if (hipMemsetAsync((char*)d_ws + WS_CTL, 0, CTL_ZERO_BYTES, stream) != hipSuccess) return;
    Args a{};
    for (int i = 0; i < 21; ++i) a.in[i] = (const float*)d_in[i];
    a.out = (float*)d_out; a.ws = (unsigned char*)d_ws;
#if MK_PER_PHASE
    for (int p = 0; p < NPHASE; ++p) { a.ph_lo = p; a.ph_hi = p + 1; hipLaunchKernelGGL(fwd, dim3(grid), dim3(NTHREADS), LDS_BYTES, stream, a); }
#else
    a.ph_lo = 0; a.ph_hi = NPHASE;
    hipLaunchKernelGGL(fwd, dim3(grid), dim3(NTHREADS), LDS_BYTES, stream, a);
#endif
    const hipError_t le = hipPeekAtLastError();
    if (le != hipSuccess) fprintf(stderr, "kernel_launch: launch failed: %s\n", hipGetErrorName(le));
}
```

```cpp
#include <hip/hip_runtime.h>
#include <cstdio>
#include <cstdint>

#ifndef MK_PER_PHASE
#define MK_PER_PHASE 0
#endif

#ifndef MOE_FP8
#define MOE_FP8 1
#endif
#ifndef PHSEL
#define PHSEL 0xffff
#endif
#define PS(k) ((PHSEL >> (k)) & 1)
#ifndef PROBE_REP
#define PROBE_REP 0
#endif
#define NREP(k) (1 + ((PROBE_REP >> (k)) & 1))
#ifndef PROBE_NOST
#define PROBE_NOST 0
#endif
#define GAS __attribute__((address_space(1)))
#define LAS __attribute__((address_space(3)))
typedef unsigned short bf16;
typedef short bf16x8 __attribute__((ext_vector_type(8)));
typedef float f32x4 __attribute__((ext_vector_type(4)));
typedef float f32x2 __attribute__((ext_vector_type(2)));
typedef float f32x16 __attribute__((ext_vector_type(16)));
typedef unsigned u32x4 __attribute__((ext_vector_type(4)));
typedef unsigned u32x2 __attribute__((ext_vector_type(2)));
typedef GAS unsigned gu32;

constexpr int D = 1024, NB = 16, SEQ = 2048, CTXL = 256, RPB = SEQ + CTXL, M = NB * RPB, DEPTH = 4;
constexpr int NE = 32, TOPK = 4, NMOD = 6;
constexpr int CAP = M;
constexpr int ACT_ROWS = M * TOPK + NE * 256;
constexpr float EPS = 1e-5f;
constexpr float C2 = 0.125f * 1.4426950408889634f;
constexpr int NPHASE = 2 + 7 * DEPTH;

constexpr size_t MiB = 1u << 20;
constexpr size_t WS_CTL = 0, CTL_ZERO_BYTES = 1 * MiB;
constexpr size_t WS_MODV = 1 * MiB;
constexpr size_t WS_ROPE = 3 * MiB;
constexpr size_t WS_RW = 4 * MiB;
constexpr size_t WS_MISC = 5 * MiB;
constexpr size_t WS_TOPE = 6 * MiB;
constexpr size_t WS_TOPG = 7 * MiB;
constexpr size_t WS_TOPP = 8 * MiB;
constexpr size_t WS_LIST = 9 * MiB;
constexpr size_t WS_WQKV = 16 * MiB;
constexpr size_t WS_WIN = 28 * MiB;
constexpr size_t WS_WO = 40 * MiB;
constexpr size_t WS_WOUT = 44 * MiB;
constexpr size_t WS_WGU = 48 * MiB;
constexpr size_t WS_WD = 560 * MiB;
constexpr size_t WS_X = 816 * MiB;
constexpr size_t WS_H = 960 * MiB;
constexpr size_t WS_Q = 1032 * MiB;
constexpr size_t WS_K = 1104 * MiB;
constexpr size_t WS_VT = 1176 * MiB;
constexpr size_t WS_BCO = WS_Q;
constexpr size_t WS_O = 1248 * MiB;
constexpr size_t WS_ACT = 1320 * MiB;
constexpr size_t WS_Y = 1624 * MiB;
constexpr size_t WS_H8 = 1928 * MiB;
constexpr size_t WS_END = 1964 * MiB;
static_assert((size_t)M * 3072 * 2 == 216 * MiB && (size_t)ACT_ROWS * 2048 == 304 * MiB && (size_t)M * 4096 == 144 * MiB, "ws map");

constexpr int CW_TMO = 0;
constexpr int CW_BAR = 4096;
constexpr int CW_CNT = 16384;

constexpr int RING_BYTES = 131072;
constexpr int LX = RING_BYTES;
constexpr int LX_MISC = LX + 0;
constexpr int LX_TSTART = LX + 256;
constexpr int LX_ECNT = LX + 512;
constexpr int LX_LCNT = LX + 640;
constexpr int LX_LBASE = LX + 768;
constexpr int LX_TILEE = LX + 1024;
constexpr int LX_WSC = LX + 4096;
constexpr int LX_ASG = LX + 12288;
constexpr int LDS_BYTES = LX + 16384;
constexpr int NWAVES = 8, NTHREADS = 512;

#define RLX_AGENT __ATOMIC_RELAXED, __HIP_MEMORY_SCOPE_AGENT
__device__ __forceinline__ unsigned f2bf(float f) { unsigned u = __builtin_bit_cast(unsigned, f); return (u + 0x7fffu + ((u >> 16) & 1u)) >> 16; }
__device__ __forceinline__ unsigned cvt_pk_bf16(float lo, float hi) { unsigned r; asm volatile("v_cvt_pk_bf16_f32 %0, %1, %2" : "=v"(r) : "v"(lo), "v"(hi)); return r; }
__device__ __forceinline__ float bf2f(unsigned short b) { return __builtin_bit_cast(float, (unsigned)b << 16); }
__device__ __forceinline__ float wave_sum(float v) {
#pragma unroll
    for (int o = 1; o < 64; o <<= 1) v += __shfl_xor(v, o);
    return v;
}

#define XB_TMO      128
#define XB_XCNT(j)  (256  + 64 * (j))
#define XB_XSUB(j)  (1280 + 64 * (j))
#define XB_XGEN(j)  (2304 + 64 * (j))
#define XB_TOP      3328
#define XB_TOPGEN   3392
#define XCD_BAR_WORDS 3456
#define XB_SPIN_CAP (1u << 18)
__device__ __forceinline__ unsigned xb_ld(unsigned* p)              { return __hip_atomic_load(p, __ATOMIC_RELAXED, __HIP_MEMORY_SCOPE_AGENT); }
__device__ __forceinline__ unsigned xb_add(unsigned* p, unsigned v) { return __hip_atomic_fetch_add(p, v, __ATOMIC_RELAXED, __HIP_MEMORY_SCOPE_AGENT); }
__device__ __forceinline__ unsigned xb_xcc_id() { return (unsigned)__builtin_amdgcn_s_getreg((3 << 11) | 20) & 0xFu; }
#define XB_SPIN(cond, bar) do { unsigned _sp = 0; while (cond) { __builtin_amdgcn_s_sleep(1); \
    if ((++_sp & 255u) == 0u) { if (xb_ld(&(bar)[XB_TMO])) break; if (_sp > XB_SPIN_CAP) { atomicAdd(&(bar)[XB_TMO], 1u); break; } } } } while (0)
struct XcdBarrier { unsigned* bar; unsigned x; volatile LAS unsigned* st; };
__device__ __forceinline__ XcdBarrier xcd_barrier_post(unsigned* bar, volatile LAS unsigned* st) {
    XcdBarrier b; b.bar = bar; b.x = xb_xcc_id(); b.st = st;
    if (threadIdx.x == 0) (void)xb_add(&bar[XB_XCNT(b.x)], 1u);
    return b;
}
__device__ __forceinline__ void xcd_barrier_complete(unsigned* bar, unsigned x, unsigned& nloc, unsigned& nx) {
    const unsigned G = gridDim.x * gridDim.y * gridDim.z;
    unsigned sum, cnt, mine, sp = 0u;
    for (;;) {
        sum = 0u; cnt = 0u; mine = 0u;
#pragma unroll
        for (unsigned j = 0; j < 16; ++j) { const unsigned c = xb_ld(&bar[XB_XCNT(j)]); sum += c; cnt += (c > 0u) ? 1u : 0u; mine = (j == x) ? c : mine; }
        if (sum == G) break;
        __builtin_amdgcn_s_sleep(1);
        if ((++sp & 255u) == 0u) { if (xb_ld(&bar[XB_TMO])) break; if (sp > XB_SPIN_CAP) { atomicAdd(&bar[XB_TMO], 1u); break; } }
    }
    nloc = mine > 0u ? mine : 1u; nx = cnt > 0u ? cnt : 1u;
}
__device__ __forceinline__ void xcd_barrier(const XcdBarrier& b) {
    asm volatile("s_waitcnt vmcnt(0)" ::: "memory");
    __syncthreads();
    if (threadIdx.x == 0) {
        unsigned* bar = b.bar; unsigned bx = b.x;
        asm volatile("" : "+s"(bar), "+s"(bx));
        __builtin_amdgcn_s_waitcnt(0);
        unsigned nloc = b.st[0], nx = b.st[1];
        if (nloc == 0u) { xcd_barrier_complete(bar, bx, nloc, nx); b.st[0] = nloc; b.st[1] = nx; }
        const unsigned old = xb_add(&bar[XB_XSUB(bx)], 1u);
        const unsigned gen = old / nloc;
        if (old + 1u == (gen + 1u) * nloc) {
            __builtin_amdgcn_fence(__ATOMIC_RELEASE, "agent");
            asm volatile("s_waitcnt vmcnt(0)" ::: "memory");
            const unsigned og = xb_add(&bar[XB_TOP], 1u);
            const unsigned tg = og / nx;
            if (og + 1u == (tg + 1u) * nx) xb_add(&bar[XB_TOPGEN], 1u);
            else XB_SPIN(xb_ld(&bar[XB_TOPGEN]) == tg, bar);
            __builtin_amdgcn_fence(__ATOMIC_ACQUIRE, "agent");
            xb_add(&bar[XB_XGEN(bx)], 1u);
            asm volatile("s_waitcnt vmcnt(0)" ::: "memory");
        } else {
            XB_SPIN(xb_ld(&bar[XB_XGEN(bx)]) == gen, bar);
            __builtin_amdgcn_fence(__ATOMIC_ACQUIRE, "agent");
            asm volatile("s_waitcnt vmcnt(0)" ::: "memory");
        }
    }
    __syncthreads();
}

namespace pg8 {
constexpr int BM = 256, BK = 64, HALF = 128, HTB = HALF * BK * 2, STAGE_BYTES = 8 * HTB, KD = 1024;
__host__ __device__ __forceinline__ int lds_byte(int r, int c) { const int st = (r >> 4) * 2 + (c >> 5), rr = r & 15, cc = c & 31, ob = rr * 64 + cc * 2; return st * 1024 + (ob ^ (((ob >> 9) & 1) << 5)); }
__host__ __device__ __forceinline__ void stage_rc(int b, int& R, int& C) { const int st = b / 1024, sb = b % 1024, swz = sb ^ (((sb >> 9) & 1) << 5); R = (st >> 1) * 16 + swz / 64; C = (st & 1) * 32 + (swz % 64) / 2; }
__host__ __device__ __forceinline__ int perm32(int rho) { const int n = rho >> 4, i = rho & 15; return 8 * (i >> 2) + 4 * n + (i & 3); }

struct Unit { int pm, pn, e, kind; };
typedef int v8i __attribute__((ext_vector_type(8)));
typedef int v4i __attribute__((ext_vector_type(4)));
__device__ __forceinline__ v8i cat8(bf16x8 lo, bf16x8 hi) { const v4i a = __builtin_bit_cast(v4i, lo), b = __builtin_bit_cast(v4i, hi); return __builtin_shufflevector(a, b, 0, 1, 2, 3, 4, 5, 6, 7); }

__device__ __forceinline__ bool deal(int i, int npu, int ntiles, int& mt, int& r) {
    const int G = gridDim.x, c = blockIdx.x;
    if ((G & 7) == 0) { const int x = c & 7, q = i * (G >> 3) + (c >> 3); mt = (q / npu) * 8 + x; r = q % npu; }
    else { const int L = i * G + c; mt = L / npu; r = L % npu; }
    return mt < ntiles;
}

__device__ __forceinline__ void mfma8(f32x4& acc, const v8i a, const v8i b, int sc) {
    asm volatile("v_mfma_scale_f32_16x16x128_f8f6f4 %0, %1, %2, %0, %3, %3 op_sel_hi:[0,0,0]" : "+v"(acc) : "v"(a), "v"(b), "v"(sc)); }
__device__ __forceinline__ void glds16s(const char* sbase, unsigned voff, unsigned lds_dst) { unsigned keep;
    asm volatile("s_mov_b32 %0, m0\n\ts_mov_b32 m0, %3\n\ts_nop 0\n\tglobal_load_lds_dwordx4 %1, %2\n\ts_mov_b32 m0, %0" : "=&s"(keep) : "v"(voff), "s"(sbase), "s"(lds_dst) : "memory"); }
template <class Epi, class Sched>
__device__ __forceinline__ void gemm_phase(LAS unsigned char* lds, const Sched& S, const Epi& E, const int tid) {
    const int wid = __builtin_amdgcn_readfirstlane(tid >> 6), lane = tid & 63, wr = wid >> 2, wc = wid & 3, fr = lane & 15, fq = lane >> 4;
    constexpr int RB = Sched::RB, nt = RB / 128;
    constexpr bool F8 = (RB == 1024);
    unsigned voffB[2];
#pragma unroll
    for (int i = 0; i < 2; ++i) { int R_, C_; stage_rc(tid * 16 + i * 8192, R_, C_); const int Rb = (R_ & ~31) + perm32(R_ & 31); voffB[i] = (unsigned)(Rb * RB + C_ * 2); }
    constexpr bool GA = Sched::GATHER;
    constexpr int NH = GA ? 2 : 1;
    constexpr size_t kstep = (size_t)(BK * 2);
    constexpr size_t hstep = (size_t)HALF * RB;
    const unsigned ldsw = (unsigned)wid * 1024u, lds0 = (unsigned)(uintptr_t)lds;
    const int aoff = lds_byte(wr * 64 + fr, fq * 8), boff = lds_byte(wc * 32 + fr, fq * 8);
#define PG8_SA(b, h) (((b) * 2 + (h)) * HTB)
#define PG8_SB(b, h) ((4 + (b) * 2 + (h)) * HTB)
#define PG8_STAGE(bufoff, gbase, voff) do { _Pragma("unroll") for (int _i = 0; _i < 2; ++_i) \
        glds16s((const char*)(gbase), (voff)[_i], (unsigned)__builtin_amdgcn_readfirstlane(lds0 + (unsigned)(bufoff) + ldsw + _i * 8192u)); } while (0)
#define PG8_LDA(dst, b, h) do { _Pragma("unroll") for (int m = 0; m < 4; ++m) _Pragma("unroll") for (int k = 0; k < 2; ++k) dst[m][k] = *(const LAS bf16x8*)(lds + PG8_SA(b, h) + aoff + m * 2048 + k * 1024); } while (0)
#define PG8_LDB(dst, b, h) do { _Pragma("unroll") for (int n = 0; n < 2; ++n) _Pragma("unroll") for (int k = 0; k < 2; ++k) dst[n][k] = *(const LAS bf16x8*)(lds + PG8_SB(b, h) + boff + n * 2048 + k * 1024); } while (0)
#define PG8_MMA(ai, bj, At, Bt) do { __builtin_amdgcn_s_setprio(1); _Pragma("unroll") for (int m = 0; m < 4; ++m) _Pragma("unroll") for (int n = 0; n < 2; ++n) { \
        if constexpr (F8) mfma8(acc[ai][bj][m][n], cat8(Bt[n][0], Bt[n][1]), cat8(At[m][0], At[m][1]), sc8); \
        else { _Pragma("unroll") for (int k = 0; k < 2; ++k) acc[ai][bj][m][n] = __builtin_amdgcn_mfma_f32_16x16x32_bf16(Bt[n][k], At[m][k], acc[ai][bj][m][n], 0, 0, 0); } } __builtin_amdgcn_s_setprio(0); } while (0)
#define PG8_WAIT_V(n) asm volatile("s_waitcnt vmcnt(" #n ")" ::: "memory")
#define PG8_WAIT_L(n) asm volatile("s_waitcnt lgkmcnt(" #n ")" ::: "memory")
#define PG8_BAR __builtin_amdgcn_s_barrier()
#define PG8_SCHED __builtin_amdgcn_sched_barrier(0)
    Unit cur, nxt; int ui = 0;
    if (!S.next(0, cur)) return;
    static_assert(Sched::SCALE_A == Sched::SCALE_B, "one scale register");
    int sc8 = Sched::SCALE_A; asm volatile("" : "+v"(sc8));
    f32x4 acc[2][2][4][2];
#pragma unroll
    for (int a = 0; a < 2; ++a)
#pragma unroll
        for (int b = 0; b < 2; ++b)
#pragma unroll
            for (int m = 0; m < 4; ++m)
#pragma unroll
                for (int n = 0; n < 2; ++n) acc[a][b][m][n] = (f32x4){0.f, 0.f, 0.f, 0.f};
    bf16x8 At[4][2], B0[2][2], B1[2][2];
    constexpr int NI = GA ? 1 : 2;
    unsigned vC[NH][NI], vN[NH][NI];
    unsigned cb2[2];
#pragma unroll
    for (int i = 0; i < 2; ++i) { int R_, C_; stage_rc(tid * 16 + i * 8192, R_, C_); cb2[i] = (unsigned)(C_ * 2); }
    const unsigned idx_slot = (unsigned)__builtin_amdgcn_readfirstlane((unsigned)(uintptr_t)(lds + LX_WSC) + (unsigned)wid * 1024u);
    if constexpr (GA) { S.idx_dma(cur, lane, idx_slot); asm volatile("s_waitcnt vmcnt(0)" ::: "memory"); S.a_offs_lds(cur, tid, vC, (LAS const int*)(lds + LX_WSC + wid * 1024)); }
    else S.a_offs(cur, tid, vC);
#define PG8_HA(h) (GA ? 0 : (h) * hstep)
#define PG8_VH(v, h) (v)[GA ? (h) : 0]
#define PG8_STAGE_A(bufoff, gbase, vv) do { _Pragma("unroll") for (int _i = 0; _i < 2; ++_i) { unsigned o_; if constexpr (GA) o_ = (((vv)[0] >> (16 * _i)) & 0xffffu) * (unsigned)RB + cb2[_i]; else o_ = (vv)[NI - 2 + _i]; \
        glds16s((const char*)(gbase), o_, (unsigned)__builtin_amdgcn_readfirstlane(lds0 + (unsigned)(bufoff) + ldsw + _i * 8192u)); } } while (0)
    const char* cA = S.a_base(cur); const char* cB = S.b_base(cur);
    PG8_STAGE(PG8_SB(0, 0), cB, voffB); PG8_STAGE(PG8_SB(0, 1), cB + hstep, voffB); PG8_STAGE_A(PG8_SA(0, 0), cA, vC[0]); PG8_STAGE_A(PG8_SA(0, 1), cA + PG8_HA(1), PG8_VH(vC, 1));
    if (wr == 1) PG8_BAR;
    PG8_WAIT_V(2); PG8_BAR;
    PG8_STAGE(PG8_SB(1, 0), cB + kstep, voffB); PG8_STAGE_A(PG8_SA(1, 0), cA + kstep, vC[0]); PG8_STAGE(PG8_SB(1, 1), cB + hstep + kstep, voffB);
    PG8_WAIT_V(6); PG8_BAR;
    for (;;) {
        const bool has_next = S.next(ui + 1, nxt);
        const char* nA = cA; const char* nB = cB;
#pragma unroll
        for (int h = 0; h < NH; ++h)
#pragma unroll
            for (int i = 0; i < NI; ++i) vN[h][i] = vC[h][i];
        if (has_next) { if constexpr (GA) S.idx_dma(nxt, lane, idx_slot); else S.a_offs(nxt, tid, vN); nA = S.a_base(nxt); nB = S.b_base(nxt); }
#pragma unroll 1
        for (int t = 0; t < nt; t += 2) {
            const bool last = (t == nt - 2);
            const char* a1 = cA + (size_t)(t + 1) * kstep;
            const char* a2 = last ? nA : cA + (size_t)(t + 2) * kstep; const char* b2 = last ? nB : cB + (size_t)(t + 2) * kstep;
            const char* a3 = a2 + kstep; const char* b3 = b2 + kstep;
            if constexpr (GA) { if (last && has_next) S.a_offs_lds(nxt, tid, vN, (LAS const int*)(lds + LX_WSC + wid * 1024)); }
            unsigned w0[NI], w1[NI];
#pragma unroll
            for (int i = 0; i < NI; ++i) { w0[i] = last ? vN[0][i] : vC[0][i]; w1[i] = last ? PG8_VH(vN, 1)[i] : PG8_VH(vC, 1)[i]; }
            PG8_LDB(B0, 0, 0); PG8_LDB(B1, 0, 1); PG8_SCHED; PG8_LDA(At, 0, 0); PG8_STAGE_A(PG8_SA(1, 1), a1 + PG8_HA(1), PG8_VH(vC, 1));
            PG8_WAIT_V(8); PG8_WAIT_L(0); PG8_BAR; PG8_MMA(0, 0, At, B0); PG8_MMA(0, 1, At, B1); PG8_BAR; PG8_SCHED;
            PG8_LDA(At, 0, 1); PG8_STAGE(PG8_SB(0, 0), b2, voffB); PG8_STAGE(PG8_SB(0, 1), b2 + hstep, voffB); PG8_STAGE_A(PG8_SA(0, 0), a2, w0);
            PG8_WAIT_V(8); PG8_WAIT_L(0); PG8_BAR; PG8_MMA(1, 0, At, B0); PG8_MMA(1, 1, At, B1); PG8_BAR; PG8_SCHED;
            PG8_LDB(B0, 1, 0); PG8_LDB(B1, 1, 1); PG8_SCHED; PG8_LDA(At, 1, 0); PG8_STAGE_A(PG8_SA(0, 1), a2 + PG8_HA(1), w1);
            PG8_WAIT_V(8); PG8_WAIT_L(0); PG8_BAR; PG8_MMA(0, 0, At, B0); PG8_MMA(0, 1, At, B1); PG8_BAR; PG8_SCHED;
            PG8_LDA(At, 1, 1); PG8_STAGE(PG8_SB(1, 0), b3, voffB); PG8_STAGE(PG8_SB(1, 1), b3 + hstep, voffB); PG8_STAGE_A(PG8_SA(1, 0), a3, w0);
            PG8_WAIT_V(8); PG8_WAIT_L(0); PG8_BAR; PG8_MMA(1, 0, At, B0); PG8_MMA(1, 1, At, B1); PG8_BAR; PG8_SCHED;
        }
        if (wr == 0) PG8_BAR;
        E(acc, cur, wr, wc, fr, fq);
        if (!has_next) break;
#pragma unroll
        for (int a = 0; a < 2; ++a)
#pragma unroll
            for (int b = 0; b < 2; ++b)
#pragma unroll
                for (int m = 0; m < 4; ++m)
#pragma unroll
                    for (int n = 0; n < 2; ++n) acc[a][b][m][n] = (f32x4){0.f, 0.f, 0.f, 0.f};
        cur = nxt; cA = nA; cB = nB; ++ui;
#pragma unroll
        for (int h = 0; h < NH; ++h)
#pragma unroll
            for (int i = 0; i < NI; ++i) vC[h][i] = vN[h][i];
        if (wr == 1) PG8_BAR;
    }
    PG8_WAIT_V(0);
    PG8_BAR;
#undef PG8_SA
#undef PG8_HA
#undef PG8_VH
#undef PG8_SB
#undef PG8_STAGE
#undef PG8_STAGE_A
#undef PG8_LDA
#undef PG8_LDB
#undef PG8_MMA
#undef PG8_WAIT_V
#undef PG8_WAIT_L
#undef PG8_BAR
#undef PG8_SCHED
}
}
using pg8::Unit;

__device__ __forceinline__ int tile_row0(int mt, bool lat_only) { return lat_only ? ((mt >> 3) * 9 + 1 + (mt & 7)) * 256 : mt * 256; }

struct SchedQKV {
    static constexpr int RB = 2048, SCALE_A = 0, SCALE_B = 0;
    const char* H; const char* Wt;
    __device__ __forceinline__ bool next(int i, Unit& u) const { int mt, r; if (!pg8::deal(i, 12, M / 256, mt, r)) return false;
        if (r < 8) { u.kind = 0; u.pm = mt; u.pn = r; } else { u.kind = 1; u.pm = r - 8; u.pn = mt; } u.e = 0; return true; }
    static constexpr bool GATHER = false;
    __device__ __forceinline__ void a_offs(const Unit& u, int tid, unsigned (&v)[1][2]) const {
#pragma unroll
        for (int i = 0; i < 2; ++i) { int R, C; pg8::stage_rc(tid * 16 + i * 8192, R, C); v[0][i] = (unsigned)((u.pm * 256 + R) * 1024 + C) * 2u; } }
    __device__ __forceinline__ const char* a_base(const Unit& u) const { return u.kind == 0 ? H : Wt + (size_t)2048 * 2048; }
    __device__ __forceinline__ const char* b_base(const Unit& u) const { return (u.kind == 0 ? Wt : H) + (size_t)u.pn * 256 * 2048; }
};
struct SchedPlain {
    static constexpr int RB = 2048, SCALE_A = 0, SCALE_B = 0;
    const char* A; const char* Bt; int npu; bool lat_only;
    __device__ __forceinline__ bool next(int i, Unit& u) const { int mt, r; if (!pg8::deal(i, npu, lat_only ? 128 : 144, mt, r)) return false;
        u.pm = tile_row0(mt, lat_only) >> 8; u.pn = r; u.e = 0; u.kind = 0; return true; }
    static constexpr bool GATHER = false;
    __device__ __forceinline__ void a_offs(const Unit& u, int tid, unsigned (&v)[1][2]) const {
#pragma unroll
        for (int i = 0; i < 2; ++i) { int R, C; pg8::stage_rc(tid * 16 + i * 8192, R, C); v[0][i] = (unsigned)((u.pm * 256 + R) * 1024 + C) * 2u; } }
    __device__ __forceinline__ const char* a_base(const Unit&) const { return A; }
    __device__ __forceinline__ const char* b_base(const Unit& u) const { return Bt + (size_t)u.pn * 256 * 2048; }
};
template <bool GATHER_, int RB_, int SA_, int SB_> struct SchedMoe {
    static constexpr bool GATHER = GATHER_;
    static constexpr int RB = RB_, SCALE_A = SA_, SCALE_B = SB_;
    const char* A; const char* Wt; const int* list; int npu; size_t estride;
    LAS const int* tstart; LAS const int* ecnt; LAS const int* tile_e;
    __device__ __forceinline__ bool next(int i, Unit& u) const { int mt, r; const int ntl = __builtin_amdgcn_readfirstlane(tstart[32]);
        if (!pg8::deal(i, npu, ntl, mt, r)) { if (!(PROBE_REP & (GATHER_ ? 0x100 : 0x200))) return false; int n_i = 0; while (pg8::deal(n_i, npu, ntl, mt, r)) ++n_i; if (i >= 2 * n_i || !pg8::deal(i - n_i, npu, ntl, mt, r)) return false; }
        u.pm = mt; u.pn = r; u.e = __builtin_amdgcn_readfirstlane(tile_e[mt]); u.kind = 0; return true; }
    __device__ __forceinline__ void idx_dma(const Unit& u, int lane, unsigned slot) const {
        const int j0 = (u.pm - __builtin_amdgcn_readfirstlane(tstart[u.e])) * 256;
        pg8::glds16s((const char*)(list + (size_t)u.e * CAP + j0), (unsigned)lane * 16u, slot); }
    __device__ __forceinline__ void a_offs_lds(const Unit& u, int tid, unsigned (&v)[2][1], LAS const int* slot) const {
        const int j0 = (u.pm - __builtin_amdgcn_readfirstlane(tstart[u.e])) * 256, cnt = __builtin_amdgcn_readfirstlane(ecnt[u.e]);
#pragma unroll
        for (int h = 0; h < 2; ++h) { unsigned pk = 0;
#pragma unroll
            for (int i = 0; i < 2; ++i) { int R, C; pg8::stage_rc(tid * 16 + i * 8192, R, C); const int r = h * 128 + R; const unsigned tok = (j0 + r) < cnt ? (unsigned)slot[r] : 0u; pk |= tok << (16 * i); }
            v[h][0] = pk; }
    }
    __device__ __forceinline__ void a_offs(const Unit& u, int tid, unsigned (&v)[GATHER_ ? 2 : 1][GATHER_ ? 1 : 2]) const {
        if constexpr (GATHER_) { const int j0 = (u.pm - __builtin_amdgcn_readfirstlane(tstart[u.e])) * 256, cnt = __builtin_amdgcn_readfirstlane(ecnt[u.e]); const int* lp = list + (size_t)u.e * CAP;
#pragma unroll
            for (int h = 0; h < 2; ++h) { unsigned pk = 0;
#pragma unroll
                for (int i = 0; i < 2; ++i) { int R, C; pg8::stage_rc(tid * 16 + i * 8192, R, C); const int idx = j0 + h * 128 + R; const unsigned tok = idx < cnt ? (unsigned)lp[idx] : 0u; pk |= tok << (16 * i); }
                v[h][0] = pk; }
        } else {
#pragma unroll
            for (int i = 0; i < 2; ++i) { int R, C; pg8::stage_rc(tid * 16 + i * 8192, R, C); v[0][i] = (unsigned)((u.pm * 256 + R) * RB + C * 2); } }
    }
    __device__ __forceinline__ const char* a_base(const Unit&) const { return A; }
    __device__ __forceinline__ const char* b_base(const Unit& u) const { return Wt + (size_t)u.e * estride + (size_t)u.pn * 256 * RB; }
};

#define EPI_LOOP_ROWS for (int ai = 0; ai < 2; ++ai) _Pragma("unroll") for (int m = 0; m < 4; ++m)
__device__ __forceinline__ u32x4 pack8(const f32x4& v0, const f32x4& v1) { u32x4 w; w.x = cvt_pk_bf16(v0[0], v0[1]); w.y = cvt_pk_bf16(v0[2], v0[3]); w.z = cvt_pk_bf16(v1[0], v1[1]); w.w = cvt_pk_bf16(v1[2], v1[3]); return w; }

struct EpiQKV {
    bf16* Q; bf16* Kb; bf16* Vt; const float* cosT; const float* sinT; bool dost;
    __device__ __forceinline__ void operator()(const f32x4 (&acc)[2][2][4][2], const Unit& u, int wr, int wc, int fr, int fq) const {
        asm volatile("" : "+v"(fr), "+v"(fq));
        if (u.kind == 0) {
            const bool isq = u.pn < 4; bf16* base = isq ? Q : Kb; const float sc = isq ? C2 : 1.f;
            const bool lat = (u.pm % 9) != 0; const int jp0 = 16 * (wc & 1) + 4 * fq;
#pragma unroll
            EPI_LOOP_ROWS { const int row = u.pm * 256 + ai * 128 + wr * 64 + m * 16 + fr; const int t = (row % RPB) - CTXL;
                f32x4 cs = {1.f, 1.f, 1.f, 1.f}, sn = {0.f, 0.f, 0.f, 0.f};
                if (lat) { cs = *(const f32x4*)(cosT + t * 32 + jp0); sn = *(const f32x4*)(sinT + t * 32 + jp0); }
#pragma unroll
                for (int bj = 0; bj < 2; ++bj) { const f32x4 a = acc[ai][bj][m][0], b = acc[ai][bj][m][1]; f32x4 o0, o1;
                    o0[0] = (a[0] * cs[0] - a[1] * sn[0]) * sc; o0[1] = (a[1] * cs[0] + a[0] * sn[0]) * sc; o0[2] = (a[2] * cs[1] - a[3] * sn[1]) * sc; o0[3] = (a[3] * cs[1] + a[2] * sn[1]) * sc;
                    o1[0] = (b[0] * cs[2] - b[1] * sn[2]) * sc; o1[1] = (b[1] * cs[2] + b[0] * sn[2]) * sc; o1[2] = (b[2] * cs[3] - b[3] * sn[3]) * sc; o1[3] = (b[3] * cs[3] + b[2] * sn[3]) * sc;
                    const int col = (u.pn & 3) * 256 + bj * 128 + wc * 32 + fq * 8;
                    const u32x4 pk_ = pack8(o0, o1); if (dost) *(u32x4*)(base + (size_t)row * 1024 + col) = pk_; } }
        } else {
#pragma unroll
            EPI_LOOP_ROWS { const int row = u.pm * 256 + ai * 128 + wr * 64 + m * 16 + fr;
#pragma unroll
                for (int bj = 0; bj < 2; ++bj) { const int col = u.pn * 256 + bj * 128 + wc * 32 + fq * 8;
                    const u32x4 pk_ = pack8(acc[ai][bj][m][0], acc[ai][bj][m][1]); if (dost) *(u32x4*)(Vt + (size_t)row * M + col) = pk_; } }
        }
    }
};
struct EpiPlain {
    bf16* O; int ldc;
    __device__ __forceinline__ void operator()(const f32x4 (&acc)[2][2][4][2], const Unit& u, int wr, int wc, int fr, int fq) const {
        asm volatile("" : "+v"(fr), "+v"(fq));
#pragma unroll
        EPI_LOOP_ROWS { const int row = u.pm * 256 + ai * 128 + wr * 64 + m * 16 + fr;
#pragma unroll
            for (int bj = 0; bj < 2; ++bj) { const int col = u.pn * 256 + bj * 128 + wc * 32 + fq * 8;
                *(u32x4*)(O + (size_t)row * ldc + col) = pack8(acc[ai][bj][m][0], acc[ai][bj][m][1]); } }
    }
};
struct EpiResid {
    const float* Xin; float* X; const float* gate;
    __device__ __forceinline__ void operator()(const f32x4 (&acc)[2][2][4][2], const Unit& u, int wr, int wc, int fr, int fq) const {
        asm volatile("" : "+v"(fr), "+v"(fq));
        const int rb = (u.pm % 9) == 0 ? 16 : u.pm / 9; const float* gp = gate + rb * 6144;
        f32x4 gv[2][2];
#pragma unroll
        for (int bj = 0; bj < 2; ++bj) { const int col = u.pn * 256 + bj * 128 + wc * 32 + fq * 8; gv[bj][0] = *(const f32x4*)(gp + col); gv[bj][1] = *(const f32x4*)(gp + col + 4); }
#pragma unroll
        EPI_LOOP_ROWS { const int row = u.pm * 256 + ai * 128 + wr * 64 + m * 16 + fr;
#pragma unroll
            for (int bj = 0; bj < 2; ++bj) { const int col = u.pn * 256 + bj * 128 + wc * 32 + fq * 8; const size_t o = (size_t)row * 1024 + col;
                const f32x4 x0 = *(const f32x4*)(Xin + o), x1 = *(const f32x4*)(Xin + o + 4);
                *(f32x4*)(X + o) = x0 + gv[bj][0] * acc[ai][bj][m][0]; *(f32x4*)(X + o + 4) = x1 + gv[bj][1] * acc[ai][bj][m][1]; } }
    }
};
__device__ __forceinline__ float clamp8(float v) { return fminf(fmaxf(v, -448.f), 448.f); }
__device__ __forceinline__ unsigned pack_fp8x4(float a, float b, float c, float d) {
    int w = 0; w = __builtin_amdgcn_cvt_pk_fp8_f32(clamp8(a), clamp8(b), w, false); w = __builtin_amdgcn_cvt_pk_fp8_f32(clamp8(c), clamp8(d), w, true); return (unsigned)w; }
__device__ __forceinline__ float swiglu1(float g, float l) {
    g = fminf(g, 7.f); l = fminf(fmaxf(l, -7.f), 7.f);
    const float s = __builtin_amdgcn_rcpf(1.f + __builtin_amdgcn_exp2f(-1.702f * 1.4426950408889634f * g));
    return g * s * (l + 1.f);
}
template <bool F8> struct EpiSwiglu {
    bf16* ACT; const float* bgu;
    __device__ __forceinline__ void operator()(const f32x4 (&acc)[2][2][4][2], const Unit& u, int wr, int wc, int fr, int fq) const {
        asm volatile("" : "+v"(fr), "+v"(fq));
        const float* bp = bgu + u.e * 2048; f32x4 bv[2][2];
#pragma unroll
        for (int bj = 0; bj < 2; ++bj) { const int col = u.pn * 256 + bj * 128 + wc * 32 + fq * 8; bv[bj][0] = *(const f32x4*)(bp + col); bv[bj][1] = *(const f32x4*)(bp + col + 4); }
#pragma unroll
        EPI_LOOP_ROWS { const int row = u.pm * 256 + ai * 128 + wr * 64 + m * 16 + fr;
#pragma unroll
            for (int bj = 0; bj < 2; ++bj) { const f32x4 a = acc[ai][bj][m][0] + bv[bj][0], b = acc[ai][bj][m][1] + bv[bj][1];
                const int col = u.pn * 128 + bj * 64 + wc * 16 + fq * 4;
                if constexpr (F8) { *(unsigned*)((unsigned char*)ACT + (size_t)row * 1024 + col) = pack_fp8x4(4.f * swiglu1(a[0], a[1]), 4.f * swiglu1(a[2], a[3]), 4.f * swiglu1(b[0], b[1]), 4.f * swiglu1(b[2], b[3])); }
                else { u32x2 w; w.x = cvt_pk_bf16(swiglu1(a[0], a[1]), swiglu1(a[2], a[3])); w.y = cvt_pk_bf16(swiglu1(b[0], b[1]), swiglu1(b[2], b[3]));
                    *(u32x2*)(ACT + (size_t)row * 1024 + col) = w; } } }
    }
};
struct EpiDown {
    bf16* Y; const float* bd;
    __device__ __forceinline__ void operator()(const f32x4 (&acc)[2][2][4][2], const Unit& u, int wr, int wc, int fr, int fq) const {
        asm volatile("" : "+v"(fr), "+v"(fq));
        const float* bp = bd + u.e * 1024; f32x4 bv[2][2];
#pragma unroll
        for (int bj = 0; bj < 2; ++bj) { const int col = u.pn * 256 + bj * 128 + wc * 32 + fq * 8; bv[bj][0] = *(const f32x4*)(bp + col); bv[bj][1] = *(const f32x4*)(bp + col + 4); }
#pragma unroll
        EPI_LOOP_ROWS { const int row = u.pm * 256 + ai * 128 + wr * 64 + m * 16 + fr;
#pragma unroll
            for (int bj = 0; bj < 2; ++bj) { const int col = u.pn * 256 + bj * 128 + wc * 32 + fq * 8;
                *(u32x4*)(Y + (size_t)row * 1024 + col) = pack8(acc[ai][bj][m][0] + bv[bj][0], acc[ai][bj][m][1] + bv[bj][1]); } }
    }
};

namespace att {
constexpr int SLOT = 32768, VOFF = 16384;
__device__ __forceinline__ void glds16(const void* gsrc, unsigned lds_dst) { unsigned keep;
    asm volatile("s_mov_b32 %0, m0\n\ts_mov_b32 m0, %2\n\ts_nop 0\n\tglobal_load_lds_dwordx4 %1, off\n\ts_mov_b32 m0, %0" : "=&s"(keep) : "v"(gsrc), "s"(lds_dst) : "memory"); }
#define ATT_WAIT_BAR(N) asm volatile("s_waitcnt vmcnt(" #N ") lgkmcnt(0)\n\ts_barrier" ::: "memory")
__device__ __forceinline__ float half_swap_max(float m) { auto rr = __builtin_amdgcn_permlane32_swap(__float_as_uint(m), __float_as_uint(m), false, false); return fmaxf(__uint_as_float(rr[0]), __uint_as_float(rr[1])); }
__device__ __forceinline__ float half_swap_sum(float m) { auto rr = __builtin_amdgcn_permlane32_swap(__float_as_uint(m), __float_as_uint(m), false, false); return __uint_as_float(rr[0]) + __uint_as_float(rr[1]); }
__device__ __forceinline__ int crow(int r, int hi) { return (r & 3) + 8 * (r >> 2) + 4 * hi; }

__device__ __forceinline__ void attn_unit(LAS unsigned char* lds, LAS float* wsc  , const bf16* Q, const bf16* Kb, const bf16* Vt, bf16* O,
                                          int krow0, int h, int qrow0, int NT, float lam, float osc, const float* subg, const int tid) {
    const int lane = tid & 63, r32 = lane & 31, hi = lane >> 5; const int wid = __builtin_amdgcn_readfirstlane(tid >> 6);
    const int qg = wid >> 1, c = wid & 1;
    const unsigned lds0 = (unsigned)(uintptr_t)lds;
    const bf16* ksrc[2]; const bf16* vsrc[2];
#pragma unroll
    for (int i = 0; i < 2; ++i) { const int p = 2 * wid + i;
        { const int row = 4 * p + (lane >> 4), ch = (lane & 15) ^ (row & 15); ksrc[i] = Kb + (size_t)(krow0 + row) * 1024 + h * 128 + ch * 8; }
        { const int row = 8 * p + (lane >> 3), ch = (lane & 7) ^ ((row >> 1) & 7); vsrc[i] = Vt + (size_t)(h * 128 + row) * M + krow0 + ch * 8; } }
    const unsigned kdst = lds0 + (unsigned)wid * 2048u, vdst = lds0 + VOFF + (unsigned)wid * 2048u;
#define ATT_DMA(t, slot) do { const unsigned so_ = (unsigned)(slot) * SLOT; \
        glds16(ksrc[0] + (size_t)(t) * 64 * 1024, (unsigned)__builtin_amdgcn_readfirstlane(kdst + so_)); glds16(ksrc[1] + (size_t)(t) * 64 * 1024, (unsigned)__builtin_amdgcn_readfirstlane(kdst + so_ + 1024u)); \
        glds16(vsrc[0] + (size_t)(t) * 64, (unsigned)__builtin_amdgcn_readfirstlane(vdst + so_)); glds16(vsrc[1] + (size_t)(t) * 64, (unsigned)__builtin_amdgcn_readfirstlane(vdst + so_ + 1024u)); } while (0)
    const int key0 = (r32 & 0x13) | ((r32 & 4) << 1) | ((r32 & 8) >> 1);
    const int kx = key0 & 15, vx = (r32 >> 1) & 7;
    bf16x8 qf[4];
    { const bf16* qp = Q + (size_t)(qrow0 + qg * 32 + r32) * 1024 + h * 128 + c * 64 + hi * 8;
#pragma unroll
      for (int d0 = 0; d0 < 4; ++d0) qf[d0] = *(const bf16x8*)(qp + d0 * 16); }
    f32x16 o[4];
#pragma unroll
    for (int d0 = 0; d0 < 4; ++d0) o[d0] = f32x16{};
    float mref = 0.f, lsum = 0.f;
    asm volatile("s_waitcnt vmcnt(0)" ::: "memory");
    const int grp = wid >> 2;
    ATT_DMA(0, 0);
    if (NT > 1) ATT_DMA(1, 1);
    for (int t = 0; t < NT; ++t) {
        const int slot = t & 3;
        if (grp == 0 || t == 0) {
            if (t + 1 < NT) { ATT_WAIT_BAR(4); } else { ATT_WAIT_BAR(0); }
            if (t + 2 < NT) ATT_DMA(t + 2, (t + 2) & 3);
        }
        const LAS unsigned char* kb_ = lds + slot * SLOT; const LAS unsigned char* vb_ = kb_ + VOFF;
        f32x16 s0, s1;
#pragma unroll
        for (int r = 0; r < 16; ++r) { s0[r] = -mref; s1[r] = -mref; }
        bf16x8 kf[8];
#pragma unroll
        for (int d0 = 0; d0 < 4; ++d0) { const int ch = (c * 8 + d0 * 2 + hi) ^ kx;
            kf[2 * d0] = *(const LAS bf16x8*)(kb_ + key0 * 256 + ch * 16); kf[2 * d0 + 1] = *(const LAS bf16x8*)(kb_ + (key0 + 32) * 256 + ch * 16); }
        __builtin_amdgcn_sched_barrier(0);
#pragma unroll
        for (int d0 = 0; d0 < 4; ++d0) { s0 = __builtin_amdgcn_mfma_f32_32x32x16_bf16(kf[2 * d0], qf[d0], s0, 0, 0, 0); s1 = __builtin_amdgcn_mfma_f32_32x32x16_bf16(kf[2 * d0 + 1], qf[d0], s1, 0, 0, 0); }
        bf16x8 vA[8], vB[8];
#pragma unroll
        for (int ks = 0; ks < 2; ++ks) { const int ch = (2 * ks + hi) ^ vx;
#pragma unroll
            for (int d0 = 0; d0 < 4; ++d0) vA[ks * 4 + d0] = *(const LAS bf16x8*)(vb_ + (d0 * 32 + r32) * 128 + ch * 16); }
        __builtin_amdgcn_sched_barrier(0);
        float rm = fmaxf(s0[0], s1[0]);
#pragma unroll
        for (int r = 1; r < 16; ++r) rm = fmaxf(rm, fmaxf(s0[r], s1[r]));
        rm = half_swap_max(rm);
        const bool need = (t == 0) || (rm > 8.f);
        if (__any(need)) {
            const float dl = need ? rm : 0.f; mref += dl;
#pragma unroll
            for (int r = 0; r < 16; ++r) { s0[r] -= dl; s1[r] -= dl; }
            const float f = (t == 0) ? 1.f : __builtin_amdgcn_exp2f(-dl); lsum *= f;
            if (hi == 0) wsc[r32] = f;
            asm volatile("s_waitcnt lgkmcnt(0)" ::: "memory");
#pragma unroll
            for (int r = 0; r < 16; ++r) { const float fr_ = wsc[crow(r, hi)];
#pragma unroll
                for (int d0 = 0; d0 < 4; ++d0) o[d0][r] *= fr_; }
            asm volatile("s_waitcnt lgkmcnt(0)" ::: "memory");
        }
        float sa = 0.f;
#pragma unroll
        for (int r = 0; r < 16; ++r) { s0[r] = __builtin_amdgcn_exp2f(s0[r]); s1[r] = __builtin_amdgcn_exp2f(s1[r]); sa += s0[r] + s1[r]; }
        lsum += sa;
        bf16x8 pa[4];
#pragma unroll
        for (int s = 0; s < 2; ++s) { u32x4 w0, w1;
            w0.x = cvt_pk_bf16(s0[8 * s + 0], s0[8 * s + 1]); w0.y = cvt_pk_bf16(s0[8 * s + 2], s0[8 * s + 3]); w0.z = cvt_pk_bf16(s0[8 * s + 4], s0[8 * s + 5]); w0.w = cvt_pk_bf16(s0[8 * s + 6], s0[8 * s + 7]);
            w1.x = cvt_pk_bf16(s1[8 * s + 0], s1[8 * s + 1]); w1.y = cvt_pk_bf16(s1[8 * s + 2], s1[8 * s + 3]); w1.z = cvt_pk_bf16(s1[8 * s + 4], s1[8 * s + 5]); w1.w = cvt_pk_bf16(s1[8 * s + 6], s1[8 * s + 7]);
            pa[s] = __builtin_bit_cast(bf16x8, w0); pa[2 + s] = __builtin_bit_cast(bf16x8, w1); }
        if (grp == 1 && t + 1 < NT) {
            if (t + 2 < NT) { ATT_WAIT_BAR(4); } else { ATT_WAIT_BAR(0); }
            if (t + 3 < NT) ATT_DMA(t + 3, (t + 3) & 3);
        }
        __builtin_amdgcn_sched_barrier(0);
#pragma unroll
        for (int ks = 2; ks < 4; ++ks) { const int ch = (2 * ks + hi) ^ vx;
#pragma unroll
            for (int d0 = 0; d0 < 4; ++d0) vB[(ks - 2) * 4 + d0] = *(const LAS bf16x8*)(vb_ + (d0 * 32 + r32) * 128 + ch * 16); }
        __builtin_amdgcn_sched_barrier(0);
#pragma unroll
        for (int ks = 0; ks < 2; ++ks)
#pragma unroll
            for (int d0 = 0; d0 < 4; ++d0) o[d0] = __builtin_amdgcn_mfma_f32_32x32x16_bf16(pa[ks], vA[ks * 4 + d0], o[d0], 0, 0, 0);
        __builtin_amdgcn_sched_barrier(0);
#pragma unroll
        for (int ks = 2; ks < 4; ++ks)
#pragma unroll
            for (int d0 = 0; d0 < 4; ++d0) o[d0] = __builtin_amdgcn_mfma_f32_32x32x16_bf16(pa[ks], vB[(ks - 2) * 4 + d0], o[d0], 0, 0, 0);
    }
    const float lt = half_swap_sum(lsum);
    if (hi == 0) wsc[64 + r32] = (c ? -lam : 1.f) * __builtin_amdgcn_rcpf(lt);
    asm volatile("s_waitcnt lgkmcnt(0)\n\ts_barrier" ::: "memory");
    LAS float* xch = (LAS float*)(lds + qg * 16384);
#pragma unroll
    for (int r = 0; r < 16; ++r) { const float a = wsc[64 + crow(r, hi)];
#pragma unroll
        for (int d0 = 0; d0 < 4; ++d0) o[d0][r] *= a; }
    if (c == 1) {
#pragma unroll
        for (int d0 = 0; d0 < 4; ++d0)
#pragma unroll
            for (int r = 0; r < 16; ++r) xch[(d0 * 16 + r) * 64 + lane] = o[d0][r];
    }
    asm volatile("s_waitcnt lgkmcnt(0)\n\ts_barrier" ::: "memory");
    if (c == 0) {
        float sg[4];
#pragma unroll
        for (int d0 = 0; d0 < 4; ++d0) sg[d0] = subg[d0 * 32 + r32] * osc;
        bf16* Ow = O + (size_t)(qrow0 + qg * 32) * 1024 + h * 128 + r32;
#pragma unroll
        for (int r = 0; r < 16; ++r) { const int qr = crow(r, hi);
            float v[4], ss = 0.f;
#pragma unroll
            for (int d0 = 0; d0 < 4; ++d0) { v[d0] = o[d0][r] + xch[(d0 * 16 + r) * 64 + lane]; ss += v[d0] * v[d0]; }
#pragma unroll
            for (int of = 1; of < 32; of <<= 1) ss += __shfl_xor(ss, of);
            const float rn = __builtin_amdgcn_rsqf(ss * (1.f / 128.f) + EPS);
#pragma unroll
            for (int d0 = 0; d0 < 4; ++d0) Ow[(size_t)qr * 1024 + d0 * 32] = (bf16)f2bf(v[d0] * rn * sg[d0]); }
    }
    asm volatile("s_waitcnt lgkmcnt(0)\n\ts_barrier" ::: "memory");
#undef ATT_DMA
}
}

__device__ __forceinline__ void load_row_f32(const float* p, int lane, f32x4 (&v)[4]) {
#pragma unroll
    for (int j = 0; j < 4; ++j) v[j] = *(const f32x4*)(p + 256 * j + 4 * lane);
}
__device__ __forceinline__ float row_rstd(const f32x4 (&v)[4]) {
    float s = 0.f;
#pragma unroll
    for (int j = 0; j < 4; ++j) s += (v[j][0] * v[j][0] + v[j][1] * v[j][1]) + (v[j][2] * v[j][2] + v[j][3] * v[j][3]);
    return 1.0f / sqrtf(wave_sum(s) * (1.f / D) + EPS);
}
__device__ __forceinline__ void norm_mod_store(f32x4 (&v)[4], const float* g, const float* sc, const float* sh, int lane, bf16* hrow) {
    const float rstd = row_rstd(v);
#pragma unroll
    for (int j = 0; j < 4; ++j) { const int c = 256 * j + 4 * lane; const f32x4 gg = *(const f32x4*)(g + c), ss = *(const f32x4*)(sc + c), hh = *(const f32x4*)(sh + c);
        v[j] = (v[j] * rstd) * gg * (ss + 1.f) + hh;
        u32x2 w; w.x = cvt_pk_bf16(v[j][0], v[j][1]); w.y = cvt_pk_bf16(v[j][2], v[j][3]); *(u32x2*)(hrow + c) = w; }
}
__device__ __forceinline__ void norm_mod_f32(f32x4 (&v)[4], const float* g, const float* sc, const float* sh, int lane) {
    const float rstd = row_rstd(v);
#pragma unroll
    for (int j = 0; j < 4; ++j) { const int c = 256 * j + 4 * lane; const f32x4 gg = *(const f32x4*)(g + c), ss = *(const f32x4*)(sc + c), hh = *(const f32x4*)(sh + c);
        v[j] = (v[j] * rstd) * gg * (ss + 1.f) + hh; }
}
__device__ __forceinline__ int row_batch(int row) { return row / RPB; }
__device__ __forceinline__ bool row_is_ctx(int row) { return (row % RPB) < CTXL; }
__device__ __forceinline__ int act_row(int ai, bool lat_only) { return lat_only ? (ai >> 11) * RPB + CTXL + (ai & 2047) : ai; }

template <int MODE>
__device__ __forceinline__ void transpose_item(const float* W, int K, int N, bf16* WT, LAS float* scr, int item, int lane) {
    const int nblk = N / 32, kb = item / nblk, nb = item % nblk, k0 = 64 * kb, n0 = 32 * nb;
#pragma unroll 8
    for (int i = 0; i < 32; ++i) { const int kk = 2 * i + (lane >> 5); scr[kk * 33 + (lane & 31)] = W[(size_t)(k0 + kk) * N + n0 + (lane & 31)]; }
    asm volatile("s_waitcnt lgkmcnt(0)" ::: "memory");
    const int c = lane & 7;
#pragma unroll
    for (int j = 0; j < 4; ++j) { const int n = (lane >> 3) + 8 * j; const LAS float* s = scr + (8 * c) * 33 + n;
        u32x4 o; o.x = cvt_pk_bf16(s[0 * 33], s[1 * 33]); o.y = cvt_pk_bf16(s[2 * 33], s[3 * 33]); o.z = cvt_pk_bf16(s[4 * 33], s[5 * 33]); o.w = cvt_pk_bf16(s[6 * 33], s[7 * 33]);
        int nn = n0 + n;
        if (MODE == 1 && nn < 2048) { const int i6 = nn & 63; nn = (nn & ~63) + (i6 < 32 ? 2 * i6 : 2 * (i6 - 32) + 1); }
        *(u32x4*)(WT + (size_t)nn * K + k0 + 8 * c) = o; }
    asm volatile("s_waitcnt lgkmcnt(0)" ::: "memory");
}

__device__ __forceinline__ void transpose_item8(const float* W, int K, int N, unsigned char* WT, LAS float* scr, int item, int lane) {
    const int nblk = N / 32, kb = item / nblk, nb = item % nblk, k0 = 64 * kb, n0 = 32 * nb;
#pragma unroll 8
    for (int i = 0; i < 32; ++i) { const int kk = 2 * i + (lane >> 5); scr[kk * 33 + (lane & 31)] = W[(size_t)(k0 + kk) * N + n0 + (lane & 31)]; }
    asm volatile("s_waitcnt lgkmcnt(0)" ::: "memory");
    const int c = lane & 7;
#pragma unroll
    for (int j = 0; j < 4; ++j) { const int n = (lane >> 3) + 8 * j; const LAS float* s = scr + (8 * c) * 33 + n;
        u32x2 o; o.x = pack_fp8x4(1024.f * s[0 * 33], 1024.f * s[1 * 33], 1024.f * s[2 * 33], 1024.f * s[3 * 33]); o.y = pack_fp8x4(1024.f * s[4 * 33], 1024.f * s[5 * 33], 1024.f * s[6 * 33], 1024.f * s[7 * 33]);
        *(u32x2*)(WT + (size_t)(n0 + n) * K + k0 + 8 * c) = o; }
    asm volatile("s_waitcnt lgkmcnt(0)" ::: "memory");
}

struct Args { const float* in[21]; float* out; unsigned char* ws; int ph_lo, ph_hi; };
enum { I_X = 0, I_C, I_CTX, I_CCTX, I_MODW, I_MODB, I_NORMG, I_WQKV, I_WO, I_LAM, I_SUBG, I_WIN, I_CONVW, I_WOUT, I_RW, I_RB, I_WGU, I_BGU, I_WD, I_BD, I_FINALG };

__device__ __forceinline__ void moe_table(LAS unsigned char* lds, const unsigned* gcnt, int tid) {
    LAS int* ecnt = (LAS int*)(lds + LX_ECNT); LAS int* tstart = (LAS int*)(lds + LX_TSTART); LAS int* tile_e = (LAS int*)(lds + LX_TILEE);
    __syncthreads();
    if (tid < 32) ecnt[tid] = (int)__hip_atomic_load(gcnt + tid, RLX_AGENT);
    __syncthreads();
    if (tid == 0) { int ts = 0; for (int e = 0; e < 32; ++e) { tstart[e] = ts; ts += (ecnt[e] + 255) >> 8; } tstart[32] = ts; }
    __syncthreads();
    { const int e = tid >> 4, l16 = tid & 15; const int t0 = tstart[e], n = tstart[e + 1] - t0; for (int j = l16; j < n; j += 16) tile_e[t0 + j] = e; }
    __syncthreads();
}

typedef const __attribute__((address_space(4))) unsigned char* kptr_t;
__device__ __forceinline__ kptr_t kargs() { kptr_t p = (kptr_t)__builtin_amdgcn_kernarg_segment_ptr(); asm volatile("" : "+s"(p)); return p; }
#define INP(k) (*(const float* const __attribute__((address_space(4)))*)(kargs() + 8 * (k)))
#define OUTP() (*(float* const __attribute__((address_space(4)))*)(kargs() + 168))
#define WSB() (*(unsigned char* const __attribute__((address_space(4)))*)(kargs() + 176))
#define WSP(T, off) ((T*)(WSB() + (off)))
static_assert(sizeof(Args) == 192, "kernarg layout");
__global__ void __launch_bounds__(NTHREADS, 2) fwd(Args args) {
    extern __shared__ __attribute__((aligned(16))) unsigned char lds_raw[];
    LAS unsigned char* lds = (LAS unsigned char*)lds_raw;
    const int tid = threadIdx.x, lane = tid & 63, wave = __builtin_amdgcn_readfirstlane(tid >> 6);
    const int G = gridDim.x, bid = blockIdx.x;
    const int gw = bid * NWAVES + wave, NGW = G * NWAVES;
    gu32* ctl = (gu32*)WSP(unsigned, WS_CTL);
    for (int u = tid; u < (LDS_BYTES - LX) / 4; u += NTHREADS) ((LAS unsigned*)(lds + LX))[u] = 0u;
    __syncthreads();
    volatile LAS unsigned* MISC = (volatile LAS unsigned*)(lds + LX_MISC);
    XcdBarrier bar; bar.bar = (unsigned*)(ctl + CW_BAR); bar.x = 0; bar.st = nullptr;
    if (!MK_PER_PHASE) bar = xcd_barrier_post((unsigned*)(ctl + CW_BAR), MISC + 8);
    (void)args;
    const int lo = *(const int __attribute__((address_space(4)))*)(kargs() + 184), hi = *(const int __attribute__((address_space(4)))*)(kargs() + 188);
#define IN(k) (lo <= (k) && (k) < hi)
#define PHASE_IDS int tid = threadIdx.x; asm volatile("" : "+v"(tid)); const int lane = tid & 63, wave = __builtin_amdgcn_readfirstlane(tid >> 6); const int gw = bid * NWAVES + wave; (void)lane; (void)gw;
#define SEAM(k) do { if (IN(k) && IN((k) + 1)) { if (MK_PER_PHASE) { if (tid == 0) __hip_atomic_store(ctl + CW_TMO, 0xBADu, RLX_AGENT); } else xcd_barrier(bar); } } while (0)

    if (PS(0) && IN(0)) { PHASE_IDS
        float* modv = WSP(float, WS_MODV);
        { LAS float* sil = (LAS float*)lds;
          LAS float* red = (LAS float*)(lds + 69632);
          for (int i = tid; i < 17 * 1024; i += NTHREADS) { const int r = i >> 10, k = i & 1023; const float cv = r < 16 ? INP(I_C)[r * 1024 + k] : INP(I_CCTX)[k]; sil[i] = cv / (1.f + __expf(-cv)); }
          __syncthreads();
          for (int it = bid; it < 4 * 96; it += G) { const int l = it / 96, nb = it % 96; const float* W = INP(I_MODW) + (size_t)l * 1024 * 6144 + nb * 64 + lane;
            float a[17];
#pragma unroll
            for (int r = 0; r < 17; ++r) a[r] = 0.f;
            for (int k = wave * 128; k < wave * 128 + 128; k += 4) { float w[4];
#pragma unroll
                for (int q = 0; q < 4; ++q) w[q] = W[(size_t)(k + q) * 6144];
#pragma unroll
                for (int r = 0; r < 17; ++r) { const f32x4 s = *(const LAS f32x4*)(sil + r * 1024 + k); a[r] += s[0] * w[0] + s[1] * w[1] + s[2] * w[2] + s[3] * w[3]; } }
#pragma unroll
            for (int r = 0; r < 17; ++r) red[(wave * 17 + r) * 64 + lane] = a[r];
            __syncthreads();
            for (int i = tid; i < 17 * 64; i += NTHREADS) { const int r = i >> 6, n = i & 63; float s = INP(I_MODB)[l * 6144 + nb * 64 + n];
#pragma unroll
                for (int w8 = 0; w8 < 8; ++w8) s += red[(w8 * 17 + r) * 64 + n];
                modv[((size_t)l * 17 + r) * 6144 + nb * 64 + n] = s; }
            __syncthreads(); }
        }
        { float* cosT = WSP(float, WS_ROPE); float* sinT = cosT + 2048 * 32; float* rwT = WSP(float, WS_RW); float* lamv = WSP(float, WS_MISC);
        for (int i = bid * NTHREADS + tid; i < 2048 * 32; i += G * NTHREADS) { const int t = i >> 5, j = i & 31; const float pos = (float)(j < 16 ? (t >> 6) : (t & 63));
            const float inv = powf(10000.f, -(float)(2 * (j & 15)) / 32.f); const float ang = pos * inv; cosT[i] = cosf(ang); sinT[i] = sinf(ang); }
        if (bid == 0 && tid < 2) { const float* lp = INP(I_LAM) + tid * 256; float s1 = 0.f, s2 = 0.f; for (int d = 0; d < 64; ++d) { s1 += lp[d] * lp[64 + d]; s2 += lp[128 + d] * lp[192 + d]; }
            const float lam_init = 0.8f - 0.6f * expf(-0.3f * (float)(2 * tid)); lamv[tid] = expf(s1) - expf(s2) + lam_init; lamv[2 + tid] = 1.f - lam_init; }
        for (int i = bid * NTHREADS + tid; i < 4 * 32 * 1024; i += G * NTHREADS) { const int l = i >> 15, e = (i >> 10) & 31, k = i & 1023; rwT[i] = INP(I_RW)[((size_t)l * 1024 + k) * 32 + e]; } }
        { LAS float* scr = (LAS float*)(lds + wave * 8704);
          bf16* Wqkv_t = WSP(bf16, WS_WQKV); bf16* Win_t = WSP(bf16, WS_WIN); bf16* Wo_t = WSP(bf16, WS_WO); bf16* Wout_t = WSP(bf16, WS_WOUT); bf16* Wgu_t = WSP(bf16, WS_WGU); bf16* Wd_t = WSP(bf16, WS_WD);
          constexpr int I_QKV = 16 * 96, I_SQ = 16 * 32, I_GU = 16 * 64, I_D = 16 * 32;
          constexpr int T0 = 2 * I_QKV, T1 = T0 + 2 * I_QKV, T2 = T1 + 2 * I_SQ, T3 = T2 + 2 * I_SQ, T4 = T3 + 128 * I_GU, T5 = T4 + 128 * I_D;
          for (int rep = 0; rep < NREP(0); ++rep)
          for (int it = gw; it < T5; it += NGW) {
            if (it < T0) { const int j = it / I_QKV; transpose_item<1>(INP(I_WQKV) + (size_t)j * 1024 * 3072, 1024, 3072, Wqkv_t + (size_t)j * 3072 * 1024, scr, it % I_QKV, lane); }
            else if (it < T1) { const int r = it - T0, j = r / I_QKV; transpose_item<0>(INP(I_WIN) + (size_t)j * 1024 * 3072, 1024, 3072, Win_t + (size_t)j * 3072 * 1024, scr, r % I_QKV, lane); }
            else if (it < T2) { const int r = it - T1, j = r / I_SQ; transpose_item<0>(INP(I_WO) + (size_t)j * 1024 * 1024, 1024, 1024, Wo_t + (size_t)j * 1024 * 1024, scr, r % I_SQ, lane); }
            else if (it < T3) { const int r = it - T2, j = r / I_SQ; transpose_item<0>(INP(I_WOUT) + (size_t)j * 1024 * 1024, 1024, 1024, Wout_t + (size_t)j * 1024 * 1024, scr, r % I_SQ, lane); }
            else if (it < T4) { const int r = it - T3, j = r / I_GU;
                if (MOE_FP8) transpose_item8(INP(I_WGU) + (size_t)j * 1024 * 2048, 1024, 2048, (unsigned char*)Wgu_t + (size_t)j * 2048 * 1024, scr, r % I_GU, lane);
                else transpose_item<0>(INP(I_WGU) + (size_t)j * 1024 * 2048, 1024, 2048, Wgu_t + (size_t)j * 2048 * 1024, scr, r % I_GU, lane); }
            else { const int r = it - T4, j = r / I_D;
                if (MOE_FP8) transpose_item8(INP(I_WD) + (size_t)j * 1024 * 1024, 1024, 1024, (unsigned char*)Wd_t + (size_t)j * 1024 * 1024, scr, r % I_D, lane);
                else transpose_item<0>(INP(I_WD) + (size_t)j * 1024 * 1024, 1024, 1024, Wd_t + (size_t)j * 1024 * 1024, scr, r % I_D, lane); }
          }
        }
        __syncthreads();
    }
    SEAM(0);

    if (PS(1) && IN(1)) { PHASE_IDS
        const float* g = INP(I_NORMG); const float* modv = WSP(float, WS_MODV); float* X = WSP(float, WS_X); bf16* H = WSP(bf16, WS_H);
        for (int row = gw; row < M; row += NGW) { const int b = row_batch(row), jj = row % RPB; const bool cx = jj < CTXL; const int rb = cx ? 16 : b;
            const float* src = cx ? INP(I_CTX) + ((size_t)b * CTXL + jj) * D : INP(I_X) + ((size_t)b * SEQ + (jj - CTXL)) * D;
            f32x4 v[4]; load_row_f32(src, lane, v);
#pragma unroll
            for (int j = 0; j < 4; ++j) *(f32x4*)(X + (size_t)row * D + 256 * j + 4 * lane) = v[j];
            norm_mod_store(v, g, modv + rb * 6144 + 1024, modv + rb * 6144, lane, H + (size_t)row * D); }
    }
    SEAM(1);

    for (int l = 0; l < DEPTH; ++l) {
        const int pb = 2 + 7 * l; const bool attn = (l & 1) == 0; const int j2 = l >> 1; const bool lat_only = (l == DEPTH - 1);
#define MV() (WSP(float, WS_MODV) + (size_t)l * 17 * 6144)
        const unsigned* gcnt = (const unsigned*)(ctl + CW_CNT) + l * 32;

        if (IN(pb)) { PHASE_IDS
            if (PS(2) && attn) {
                SchedQKV S{(const char*)WSP(bf16, WS_H), (const char*)(WSP(bf16, WS_WQKV) + (size_t)j2 * 3072 * 1024)};
                EpiQKV E{WSP(bf16, WS_Q), WSP(bf16, WS_K), WSP(bf16, WS_VT), WSP(float, WS_ROPE), WSP(float, WS_ROPE) + 2048 * 32, true};
                for (int rep = 0; rep < NREP(2); ++rep) { int z_ = rep; asm volatile("" : "+s"(z_)); E.dost = !PROBE_NOST || (z_ == NREP(2) - 1); pg8::gemm_phase<EpiQKV, SchedQKV>(lds, S, E, tid); }
            } else if (PS(3)) {
                SchedPlain S{(const char*)WSP(bf16, WS_H), (const char*)(WSP(bf16, WS_WIN) + (size_t)j2 * 3072 * 1024), 12, lat_only};
                EpiPlain E{WSP(bf16, WS_BCO), 3072};
                for (int rep = 0; rep < NREP(3); ++rep) pg8::gemm_phase<EpiPlain, SchedPlain>(lds, S, E, tid);
            }
        }
        SEAM(pb);

        if (IN(pb + 1)) { PHASE_IDS
            if (PS(4) && attn) {
                const float* lamv = WSP(float, WS_MISC); const float lam = lamv[j2], osc = lamv[2 + j2]; const float* subg = INP(I_SUBG) + j2 * 128;
                const bf16* Qb = WSP(bf16, WS_Q); const bf16* Kb = WSP(bf16, WS_K); const bf16* Vt = WSP(bf16, WS_VT); bf16* Ob = WSP(bf16, WS_O);
                LAS float* wsc = (LAS float*)(lds + LX_WSC + wave * 1024);
                const int vcu = (G % 8 == 0) ? (bid % 8) * (G / 8) + bid / 8 : bid;
                for (int rep = 0; rep < NREP(4); ++rep)
                if (G == 256) {
                    const int xc = bid & 7, j = bid >> 3;
                    for (int sstep = 0; sstep < 8; ++sstep) { const int bh = xc * 16 + 2 * sstep + (j >> 4), b = bh >> 3, h = bh & 7;
                        att::attn_unit(lds, wsc, Qb, Kb, Vt, Ob, b * RPB, h, b * RPB + CTXL + (j & 15) * 128, 36, lam, osc, subg, tid); }
                    { const int bh = xc * 16 + (j >> 1), b = bh >> 3, h = bh & 7;
                      att::attn_unit(lds, wsc, Qb, Kb, Vt, Ob, b * RPB, h, b * RPB + (j & 1) * 128, 4, lam, osc, subg, tid); }
                } else {
                    for (int u = bid; u < 128 * 18; u += G) { const int bh = u / 18, k = u % 18, b = bh >> 3, h = bh & 7;
                        att::attn_unit(lds, wsc, Qb, Kb, Vt, Ob, b * RPB, h, k < 16 ? b * RPB + CTXL + k * 128 : b * RPB + (k - 16) * 128, k < 16 ? 36 : 4, lam, osc, subg, tid); }
                }
            } else if (PS(5)) {
                const float* cw = INP(I_CONVW) + (size_t)j2 * 3 * 1024; const bf16* BCO = WSP(bf16, WS_BCO); bf16* Ob = WSP(bf16, WS_O);
                const int nact = lat_only ? 32768 : M; const int nitems = (nact / 16) * 2;
                for (int it = gw; it < nitems; it += NGW) { const int strip = it >> 1, ch = (it & 1) * 512 + lane * 8; const int row0 = act_row(strip * 16, lat_only);
                    const int jj = row0 % RPB; const int seq_lo = jj < CTXL ? row0 - jj : row0 - jj + CTXL, seq_hi = jj < CTXL ? row0 - jj + CTXL : row0 - jj + RPB;
                    float w0[8], w1[8], w2[8];
#pragma unroll
                    for (int q = 0; q < 8; ++q) { w0[q] = cw[ch + q]; w1[q] = cw[1024 + ch + q]; w2[q] = cw[2048 + ch + q]; }
                    float up[8], uc[8], un[8];
                    auto load_u = [&](int row, float (&u)[8]) {
                        if (row < seq_lo || row >= seq_hi) {
#pragma unroll
                            for (int q = 0; q < 8; ++q) u[q] = 0.f;
                        } else { const bf16* p = BCO + (size_t)row * 3072; const u32x4 gc = *(const u32x4*)(p + 1024 + ch), xt = *(const u32x4*)(p + 2048 + ch);
#pragma unroll
                            for (int q = 0; q < 4; ++q) { u[2 * q] = bf2f((unsigned short)(gc[q] & 0xffffu)) * bf2f((unsigned short)(xt[q] & 0xffffu)); u[2 * q + 1] = bf2f((unsigned short)(gc[q] >> 16)) * bf2f((unsigned short)(xt[q] >> 16)); } } };
                    load_u(row0 - 1, up); load_u(row0, uc);
                    for (int r = 0; r < 16; ++r) { const int row = row0 + r; load_u(row + 1, un);
                        const u32x4 gb = *(const u32x4*)(BCO + (size_t)row * 3072 + ch); float z[8];
#pragma unroll
                        for (int q = 0; q < 8; ++q) { const float gbv = bf2f((unsigned short)((q & 1) ? (gb[q >> 1] >> 16) : (gb[q >> 1] & 0xffffu))); z[q] = gbv * (w0[q] * up[q] + w1[q] * uc[q] + w2[q] * un[q]); }
                        u32x4 o; o.x = cvt_pk_bf16(z[0], z[1]); o.y = cvt_pk_bf16(z[2], z[3]); o.z = cvt_pk_bf16(z[4], z[5]); o.w = cvt_pk_bf16(z[6], z[7]);
                        *(u32x4*)(Ob + (size_t)row * 1024 + ch) = o;
#pragma unroll
                        for (int q = 0; q < 8; ++q) { up[q] = uc[q]; uc[q] = un[q]; } } }
            }
        }
        SEAM(pb + 1);

        if (PS(6) && IN(pb + 2)) { PHASE_IDS
            SchedPlain S{(const char*)WSP(bf16, WS_O), (const char*)(WSP(bf16, attn ? WS_WO : WS_WOUT) + (size_t)j2 * 1024 * 1024), 4, lat_only};
            float* X = WSP(float, WS_X);
            EpiResid E{X, X, MV() + 2 * 1024};
            pg8::gemm_phase<EpiResid, SchedPlain>(lds, S, E, tid);
        }
        SEAM(pb + 2);

        if (PS(7) && IN(pb + 3)) { PHASE_IDS
            LAS int* lcnt = (LAS int*)(lds + LX_LCNT); LAS int* lbase = (LAS int*)(lds + LX_LBASE); LAS int* asg = (LAS int*)(lds + LX_ASG);
            LAS float* wsc = (LAS float*)(lds + LX_WSC + wave * 1024);
            LAS unsigned char* tile = lds;
            LAS float* part = (LAS float*)(lds + 65536);
            float* X = WSP(float, WS_X); bf16* H = WSP(bf16, WS_H); const float* mv = MV(); int* topE = WSP(int, WS_TOPE); float* topG = WSP(float, WS_TOPG); int* topP = WSP(int, WS_TOPP); int* list = WSP(int, WS_LIST);
            const int r32 = lane & 31, hi = lane >> 5;
            bf16x8 wf[8];
            { const float* rw = WSP(float, WS_RW) + (size_t)l * 32 * 1024 + r32 * 1024 + wave * 128 + hi * 8;
#pragma unroll
              for (int s8 = 0; s8 < 8; ++s8) { const f32x4 a = *(const f32x4*)(rw + 16 * s8), b = *(const f32x4*)(rw + 16 * s8 + 4); wf[s8] = __builtin_bit_cast(bf16x8, pack8(a, b)); } }
            __syncthreads();
            if (tid < 32) lcnt[tid] = 0;
            __syncthreads();
            const int nact = lat_only ? 32768 : M; const int rpb = (nact + G - 1) / G; const int a0 = bid * rpb; int nr = nact - a0; nr = nr < 0 ? 0 : (nr > rpb ? rpb : nr);
            const float* g = INP(I_NORMG) + ((size_t)l * 2 + 1) * 1024; const float* rb_ = INP(I_RB) + l * 32;
            for (int g0 = 0; g0 < nr; g0 += 32) {
                f32x4 v[4][4]; int rowq[4]; bool okq[4];
#pragma unroll
                for (int q = 0; q < 4; ++q) { const int i = g0 + wave + 8 * q; okq[q] = i < nr; rowq[q] = act_row(a0 + (okq[q] ? i : nr - 1), lat_only); load_row_f32(X + (size_t)rowq[q] * D, lane, v[q]); }
#pragma unroll
                for (int q = 0; q < 4; ++q) { const int row = rowq[q]; const int rb = row_is_ctx(row) ? 16 : row_batch(row); const int tr = wave + 8 * q;
                    norm_mod_f32(v[q], g, mv + rb * 6144 + 4 * 1024, mv + rb * 6144 + 3 * 1024, lane);
                    if (MOE_FP8) { unsigned char* h8 = WSP(unsigned char, WS_H8) + (size_t)row * 1024;
#pragma unroll
                        for (int j = 0; j < 4; ++j) { const unsigned pk_ = pack_fp8x4(16.f * v[q][j][0], 16.f * v[q][j][1], 16.f * v[q][j][2], 16.f * v[q][j][3]); if (okq[q]) *(unsigned*)(h8 + 256 * j + 4 * lane) = pk_; } }
#pragma unroll
                    for (int j = 0; j < 4; ++j) { u32x2 w; w.x = cvt_pk_bf16(v[q][j][0], v[q][j][1]); w.y = cvt_pk_bf16(v[q][j][2], v[q][j][3]);
                        if (!MOE_FP8 && okq[q]) *(u32x2*)(H + (size_t)row * D + 256 * j + 4 * lane) = w;
                        const int ch = 32 * j + (lane >> 1); *(LAS u32x2*)(tile + tr * 2048 + ((ch ^ (tr & 15)) << 4) + (lane & 1) * 8) = w; } }
                __syncthreads();
                { f32x16 acc = f32x16{};
#pragma unroll
                  for (int s8 = 0; s8 < 8; ++s8) { const int ch = wave * 16 + 2 * s8 + hi; const bf16x8 bfr = *(const LAS bf16x8*)(tile + r32 * 2048 + ((ch ^ (r32 & 15)) << 4));
                      acc = __builtin_amdgcn_mfma_f32_32x32x16_bf16(wf[s8], bfr, acc, 0, 0, 0); }
#pragma unroll
                  for (int r = 0; r < 16; ++r) { const int e = (r & 3) + 8 * (r >> 2) + 4 * hi; part[(wave * 32 + e) * 33 + r32] = acc[r]; } }
                __syncthreads();
#pragma unroll 1
                for (int q = 0; q < 4; ++q) { const int tr = wave + 8 * q; const int i = g0 + tr; const int row = rowq[q]; const int my_e = r32;
                    float lg = rb_[my_e];
#pragma unroll
                    for (int w8 = 0; w8 < 8; ++w8) lg += part[(w8 * 32 + my_e) * 33 + tr];
                    if (lane < 32) wsc[my_e] = lg;
                    asm volatile("s_waitcnt lgkmcnt(0)" ::: "memory");
                    int rank = 0;
#pragma unroll
                    for (int e = 0; e < 32; ++e) { const float o = wsc[e]; rank += (o > lg || (o == lg && e < my_e)) ? 1 : 0; }
                    asm volatile("s_waitcnt lgkmcnt(0)" ::: "memory");
                    if (lane < 32 && rank < 4) { wsc[64 + rank] = lg; ((LAS int*)wsc)[72 + rank] = my_e; }
                    asm volatile("s_waitcnt lgkmcnt(0)" ::: "memory");
                    const float t0 = wsc[64], t1 = wsc[65], t2 = wsc[66], t3 = wsc[67];
                    const float p0 = 1.f, p1 = __expf(t1 - t0), p2 = __expf(t2 - t0), p3 = __expf(t3 - t0); const float inv = 1.f / (p0 + p1 + p2 + p3);
                    if (lane < 4 && okq[q]) { const int e = ((LAS int*)wsc)[72 + lane]; const float p = lane == 0 ? p0 : lane == 1 ? p1 : lane == 2 ? p2 : p3;
                        const int lp = __hip_atomic_fetch_add(lcnt + e, 1, __ATOMIC_RELAXED, __HIP_MEMORY_SCOPE_WORKGROUP);
                        topE[row * 4 + lane] = e; topG[row * 4 + lane] = p * inv; asg[i * 4 + lane] = (lp << 5) | e; }
                    asm volatile("s_waitcnt lgkmcnt(0)" ::: "memory");
                }
            }
            __syncthreads();
            if (tid < 32) lbase[tid] = (int)__hip_atomic_fetch_add((unsigned*)gcnt + tid, (unsigned)lcnt[tid], RLX_AGENT);
            __syncthreads();
            for (int i = tid; i < nr * 4; i += NTHREADS) { const int av = asg[i], e = av & 31, pos = lbase[e] + (av >> 5); const int row = act_row(a0 + (i >> 2), lat_only);
                list[(size_t)e * CAP + pos] = row; topP[row * 4 + (i & 3)] = pos; }
            __syncthreads();
        }
        SEAM(pb + 3);

        if (PS(8) && IN(pb + 4)) { PHASE_IDS
            moe_table(lds, gcnt, tid);
            constexpr int RBM = MOE_FP8 ? 1024 : 2048;
            typedef SchedMoe<true, RBM, 0x78787878, 0x78787878> SG;
            SG S{(const char*)(MOE_FP8 ? (void*)WSP(unsigned char, WS_H8) : (void*)WSP(bf16, WS_H)), (const char*)WSP(bf16, WS_WGU) + (size_t)l * 32 * 2048 * RBM, WSP(int, WS_LIST), 8, (size_t)2048 * RBM,
                 (LAS const int*)(lds + LX_TSTART), (LAS const int*)(lds + LX_ECNT), (LAS const int*)(lds + LX_TILEE)};
            EpiSwiglu<MOE_FP8 != 0> E{WSP(bf16, WS_ACT), INP(I_BGU) + (size_t)l * 32 * 2048};
            pg8::gemm_phase<EpiSwiglu<MOE_FP8 != 0>, SG>(lds, S, E, tid);
        }
        SEAM(pb + 4);

        if (PS(9) && IN(pb + 5)) { PHASE_IDS
            moe_table(lds, gcnt, tid);
            constexpr int RBM = MOE_FP8 ? 1024 : 2048;
            typedef SchedMoe<false, RBM, 0x79797979, 0x79797979> SD;
            SD S{(const char*)WSP(bf16, WS_ACT), (const char*)WSP(bf16, WS_WD) + (size_t)l * 32 * 1024 * RBM, WSP(int, WS_LIST), 4, (size_t)1024 * RBM,
                 (LAS const int*)(lds + LX_TSTART), (LAS const int*)(lds + LX_ECNT), (LAS const int*)(lds + LX_TILEE)};
            EpiDown E{WSP(bf16, WS_Y), INP(I_BD) + (size_t)l * 32 * 1024};
            pg8::gemm_phase<EpiDown, SD>(lds, S, E, tid);
        }
        SEAM(pb + 5);

        if (PS(10) && IN(pb + 6)) { PHASE_IDS
            moe_table(lds, gcnt, tid);
            LAS const int* tstart = (LAS const int*)(lds + LX_TSTART);
            const int nact = lat_only ? 32768 : M;
            const float* gn = (l + 1 < DEPTH) ? INP(I_NORMG) + (size_t)(l + 1) * 2 * 1024 : INP(I_FINALG);
            const float* mv = MV(); const float* mvn = mv + 17 * 6144; float* X = WSP(float, WS_X); bf16* H = WSP(bf16, WS_H); const bf16* Yb = WSP(bf16, WS_Y);
            const int* topE = WSP(int, WS_TOPE); const float* topG = WSP(float, WS_TOPG); const int* topP = WSP(int, WS_TOPP);
            for (int rep = 0; rep < NREP(10); ++rep) { int z_ = rep; asm volatile("" : "+s"(z_)); const bool dost = (z_ == NREP(10) - 1);
            for (int ai = gw; ai < nact; ai += NGW) { const int row = act_row(ai, lat_only); const bool cx = row_is_ctx(row); const int rb = cx ? 16 : row_batch(row);
                f32x4 v[4]; load_row_f32(X + (size_t)row * D, lane, v);
                const int4 ev = *(const int4*)(topE + row * 4), pv = *(const int4*)(topP + row * 4); const f32x4 gv = *(const f32x4*)(topG + row * 4);
                const int ee[4] = {ev.x, ev.y, ev.z, ev.w}, pp[4] = {pv.x, pv.y, pv.z, pv.w};
                f32x4 acc4[4];
#pragma unroll
                for (int j = 0; j < 4; ++j) acc4[j] = (f32x4){0.f, 0.f, 0.f, 0.f};
#pragma unroll
                for (int k = 0; k < 4; ++k) { const bf16* yr = Yb + (size_t)(tstart[ee[k]] * 256 + pp[k]) * 1024; const float gk = gv[k];
#pragma unroll
                    for (int j = 0; j < 4; ++j) { const u32x2 w = *(const u32x2*)(yr + 256 * j + 4 * lane);
                        acc4[j][0] += gk * bf2f((unsigned short)(w.x & 0xffffu)); acc4[j][1] += gk * bf2f((unsigned short)(w.x >> 16)); acc4[j][2] += gk * bf2f((unsigned short)(w.y & 0xffffu)); acc4[j][3] += gk * bf2f((unsigned short)(w.y >> 16)); } }
                const float* g2 = mv + rb * 6144 + 5 * 1024;
#pragma unroll
                for (int j = 0; j < 4; ++j) { const f32x4 gg = *(const f32x4*)(g2 + 256 * j + 4 * lane); v[j] = v[j] + gg * acc4[j]; }
                if (l + 1 < DEPTH) {
#pragma unroll
                    for (int j = 0; j < 4; ++j) if (dost) *(f32x4*)(X + (size_t)row * D + 256 * j + 4 * lane) = v[j];
                    if (!(l + 1 == DEPTH - 1 && cx))
                        norm_mod_store(v, gn, mvn + rb * 6144 + 1024, mvn + rb * 6144, lane, H + (size_t)row * D);
                } else {
                    const float rstd = row_rstd(v); float* op = OUTP() + ((size_t)row_batch(row) * SEQ + (row % RPB - CTXL)) * D;
#pragma unroll
                    for (int j = 0; j < 4; ++j) { const f32x4 gg = *(const f32x4*)(gn + 256 * j + 4 * lane); const f32x4 ov_ = (v[j] * rstd) * gg; if (dost) *(f32x4*)(op + 256 * j + 4 * lane) = ov_; }
                }
            } }
        }
        if (l + 1 < DEPTH) SEAM(pb + 6);
    }
#undef IN
#undef SEAM
#undef MV
}

extern "C" void kernel_launch(void* const* d_in, const int* in_sizes, int n_in, void* d_out, int out_size, void* d_ws, size_t ws_size, hipStream_t stream) {
    static int grid = 0;
    if (grid == 0) {
        if (n_in != 21 || out_size != NB * SEQ * D || ws_size < WS_END) { fprintf(stderr, "kernel_launch: unexpected shapes (n_in %d, out %d, ws %zu)\n", n_in, out_size, ws_size); grid = -1; return; }
        int dev = 0, cus = 0, per_cu = 0;
        if (hipGetDevice(&dev) != hipSuccess || hipDeviceGetAttribute(&cus, hipDeviceAttributeMultiprocessorCount, dev) != hipSuccess) { grid = -1; return; }
        if (hipFuncSetAttribute((const void*)fwd, hipFuncAttributeMaxDynamicSharedMemorySize, LDS_BYTES) != hipSuccess) { fprintf(stderr, "kernel_launch: hipFuncSetAttribute failed\n"); grid = -1; return; }
        if (hipOccupancyMaxActiveBlocksPerMultiprocessor(&per_cu, (const void*)fwd, NTHREADS, LDS_BYTES) != hipSuccess || per_cu < 1) { fprintf(stderr, "kernel_launch: occupancy query says %d\n", per_cu); }
        (void)hipGetLastError();
        if (cus < 160) { fprintf(stderr, "kernel_launch: needs >= 160 CUs\n"); grid = -1; return; }
        grid = cus;
    }
    if (grid < 0) return;
    if (hipMemsetAsync((char*)d_ws + WS_CTL, 0, CTL_ZERO_BYTES, stream) != hipSuccess) return;
    Args a{};
    for (int i = 0; i < 21; ++i) a.in[i] = (const float*)d_in[i];
    a.out = (float*)d_out; a.ws = (unsigned char*)d_ws;
#if MK_PER_PHASE
    for (int p = 0; p < NPHASE; ++p) { a.ph_lo = p; a.ph_hi = p + 1; hipLaunchKernelGGL(fwd, dim3(grid), dim3(NTHREADS), LDS_BYTES, stream, a); }
#else
    a.ph_lo = 0; a.ph_hi = NPHASE;
    hipLaunchKernelGGL(fwd, dim3(grid), dim3(NTHREADS), LDS_BYTES, stream, a);
#endif
    const hipError_t le = hipPeekAtLastError();
    if (le != hipSuccess) fprintf(stderr, "kernel_launch: launch failed: %s\n", hipGetErrorName(le));
}
```

```cpp
#include <hip/hip_runtime.h>
#include <cstdio>
#include <cstdint>

#ifndef MK_PER_PHASE
#define MK_PER_PHASE 0
#endif

#ifndef MOE_FP8
#define MOE_FP8 1
#endif
#ifndef STAGGER
#define STAGGER 0
#endif
#define STAG(t) (STAGGER ? (t) : 0)
#ifndef PROBE_T
#define PROBE_T 0
#endif
#ifndef PROBE_TQ
#define PROBE_TQ 30.f
#endif
#ifndef ATT_PROBE_TID
#define ATT_PROBE_TID 0
#endif
#ifndef PROBE_BID
#define PROBE_BID 0
#endif
#ifndef PROBE_TPH
#define PROBE_TPH 8
#endif
#ifndef FP8_ATT
#define FP8_ATT 1
#endif
#ifndef FP8_ATT_O
#define FP8_ATT_O 1
#endif
#ifndef FP8_CONV
#define FP8_CONV 0
#endif
#ifndef X_BF16
#define X_BF16 1
#endif
#ifndef Y_FP8
#define Y_FP8 1
#endif
#ifndef CONV_FUSE_U
#define CONV_FUSE_U 1
#endif
#ifndef ATT_FP8
#define ATT_FP8 1
#endif
#ifndef PHSEL
#define PHSEL 0xffff
#endif
#define PS(k) ((PHSEL >> (k)) & 1)
#ifndef PROBE_REP
#define PROBE_REP 0
#endif
#define NREP(k) (1 + ((PROBE_REP >> (k)) & 1))
#ifndef PROBE_NOST
#define PROBE_NOST 0
#endif
#define GAS __attribute__((address_space(1)))
#define LAS __attribute__((address_space(3)))
typedef unsigned short bf16;
typedef short bf16x8 __attribute__((ext_vector_type(8)));
typedef float f32x4 __attribute__((ext_vector_type(4)));
typedef float f32x2 __attribute__((ext_vector_type(2)));
typedef float f32x16 __attribute__((ext_vector_type(16)));
typedef unsigned u32x4 __attribute__((ext_vector_type(4)));
typedef unsigned u32x2 __attribute__((ext_vector_type(2)));
typedef GAS unsigned gu32;

constexpr int D = 1024, NB = 16, SEQ = 2048, CTXL = 256, RPB = SEQ + CTXL, M = NB * RPB, DEPTH = 4;
constexpr int NE = 32, TOPK = 4, NMOD = 6;
constexpr int CAP = M;
constexpr int ACT_ROWS = M * TOPK + NE * 256;
constexpr float EPS = 1e-5f;
constexpr float C2 = 0.125f * 1.4426950408889634f;
constexpr int NPHASE = 2 + 7 * DEPTH;
static_assert(!(FP8_CONV && CONV_FUSE_U), "the fused u epilogue needs the (bf16) interleaved copy of conv_w_in");

constexpr size_t MiB = 1u << 20;
constexpr size_t WS_CTL = 0, CTL_ZERO_BYTES = 1 * MiB;
constexpr size_t WS_MODV = 1 * MiB;
constexpr size_t WS_ROPE = 3 * MiB;
constexpr size_t WS_RW = 4 * MiB;
constexpr size_t WS_MISC = 5 * MiB;
constexpr size_t WS_TOPE = 6 * MiB;
constexpr size_t WS_TOPG = 7 * MiB;
constexpr size_t WS_TOPP = 8 * MiB;
constexpr size_t WS_LIST = 9 * MiB;
constexpr size_t WS_WQKV = 16 * MiB;
constexpr size_t WS_WIN = 28 * MiB;
constexpr size_t WS_WO = 40 * MiB;
constexpr size_t WS_WOUT = 44 * MiB;
constexpr size_t WS_WGU = 48 * MiB;
constexpr size_t WS_WD = 560 * MiB;
constexpr size_t WS_X = 816 * MiB;
constexpr size_t WS_H = 960 * MiB;
constexpr size_t WS_Q = 1032 * MiB;
constexpr size_t WS_K = 1104 * MiB;
constexpr size_t WS_VT = 1176 * MiB;
constexpr size_t WS_BCO = WS_Q;
constexpr size_t WS_O = 1248 * MiB;
constexpr size_t WS_ACT = 1320 * MiB;
constexpr size_t WS_Y = 1624 * MiB;
constexpr size_t WS_H8 = 1928 * MiB;
constexpr size_t WS_END = 1964 * MiB;
static_assert((size_t)M * 3072 * 2 == 216 * MiB && (size_t)ACT_ROWS * 2048 == 304 * MiB && (size_t)M * 4096 == 144 * MiB, "ws map");

constexpr int CW_TMO = 0;
constexpr int CW_BAR = 4096;
constexpr int CW_CNT = 16384;

constexpr int RING_BYTES = 131072;
constexpr int LX = RING_BYTES;
constexpr int LX_MISC = LX + 0;
constexpr int LX_TSTART = LX + 256;
constexpr int LX_ECNT = LX + 512;
constexpr int LX_LCNT = LX + 640;
constexpr int LX_LBASE = LX + 768;
constexpr int LX_TILEE = LX + 1024;
constexpr int LX_WSC = LX + 4096;
constexpr int LX_ASG = LX + 12288;
constexpr int LX_EPI = LX + 16384;
constexpr int LDS_BYTES = LX + 32768;
constexpr int NWAVES = 8, NTHREADS = 512;

#define RLX_AGENT __ATOMIC_RELAXED, __HIP_MEMORY_SCOPE_AGENT
__device__ __forceinline__ unsigned f2bf(float f) { unsigned u = __builtin_bit_cast(unsigned, f); return (u + 0x7fffu + ((u >> 16) & 1u)) >> 16; }
typedef __bf16 bf16x2_t __attribute__((ext_vector_type(2)));
__device__ __forceinline__ unsigned cvt_pk_bf16(float lo, float hi) { const f32x2 v = {lo, hi}; const bf16x2_t b = __builtin_convertvector(v, bf16x2_t); return __builtin_bit_cast(unsigned, b); }
__device__ __forceinline__ float bf2f(unsigned short b) { return __builtin_bit_cast(float, (unsigned)b << 16); }
__device__ __forceinline__ float wave_sum(float v) {
    v += __builtin_bit_cast(float, __builtin_amdgcn_update_dpp(0, __builtin_bit_cast(int, v), 0xB1, 0xF, 0xF, true));
    v += __builtin_bit_cast(float, __builtin_amdgcn_update_dpp(0, __builtin_bit_cast(int, v), 0x4E, 0xF, 0xF, true));
    v += __builtin_bit_cast(float, __builtin_amdgcn_update_dpp(0, __builtin_bit_cast(int, v), 0x124, 0xF, 0xF, true));
    v += __builtin_bit_cast(float, __builtin_amdgcn_update_dpp(0, __builtin_bit_cast(int, v), 0x128, 0xF, 0xF, true));
    v += __shfl_xor(v, 16);
    auto rr = __builtin_amdgcn_permlane32_swap(__float_as_uint(v), __float_as_uint(v), false, false);
    return __uint_as_float(rr[0]) + __uint_as_float(rr[1]);
}

#define XB_TMO      128
#define XB_XCNT(j)  (256  + 64 * (j))
#define XB_XSUB(j)  (1280 + 64 * (j))
#define XB_XGEN(j)  (2304 + 64 * (j))
#define XB_TOP      3328
#define XB_TOPGEN   3392
#define XCD_BAR_WORDS 3456
#define XB_SPIN_CAP (1u << 18)
__device__ __forceinline__ unsigned xb_ld(unsigned* p)              { return __hip_atomic_load(p, __ATOMIC_RELAXED, __HIP_MEMORY_SCOPE_AGENT); }
__device__ __forceinline__ unsigned xb_add(unsigned* p, unsigned v) { return __hip_atomic_fetch_add(p, v, __ATOMIC_RELAXED, __HIP_MEMORY_SCOPE_AGENT); }
__device__ __forceinline__ unsigned xb_xcc_id() { return (unsigned)__builtin_amdgcn_s_getreg((3 << 11) | 20) & 0xFu; }
#define XB_SPIN(cond, bar) do { unsigned _sp = 0; while (cond) { __builtin_amdgcn_s_sleep(1); \
    if ((++_sp & 255u) == 0u) { if (xb_ld(&(bar)[XB_TMO])) break; if (_sp > XB_SPIN_CAP) { atomicAdd(&(bar)[XB_TMO], 1u); break; } } } } while (0)
struct XcdBarrier { unsigned* bar; unsigned x; volatile LAS unsigned* st; };
__device__ __forceinline__ XcdBarrier xcd_barrier_post(unsigned* bar, volatile LAS unsigned* st) {
    XcdBarrier b; b.bar = bar; b.x = xb_xcc_id(); b.st = st;
    if (threadIdx.x == 0) (void)xb_add(&bar[XB_XCNT(b.x)], 1u);
    return b;
}
__device__ __forceinline__ void xcd_barrier_complete(unsigned* bar, unsigned x, unsigned& nloc, unsigned& nx) {
    const unsigned G = gridDim.x * gridDim.y * gridDim.z;
    unsigned sum, cnt, mine, sp = 0u;
    for (;;) {
        sum = 0u; cnt = 0u; mine = 0u;
#pragma unroll
        for (unsigned j = 0; j < 16; ++j) { const unsigned c = xb_ld(&bar[XB_XCNT(j)]); sum += c; cnt += (c > 0u) ? 1u : 0u; mine = (j == x) ? c : mine; }
        if (sum == G) break;
        __builtin_amdgcn_s_sleep(1);
        if ((++sp & 255u) == 0u) { if (xb_ld(&bar[XB_TMO])) break; if (sp > XB_SPIN_CAP) { atomicAdd(&bar[XB_TMO], 1u); break; } }
    }
    nloc = mine > 0u ? mine : 1u; nx = cnt > 0u ? cnt : 1u;
}
__device__ __forceinline__ void xcd_barrier(const XcdBarrier& b) {
    asm volatile("s_waitcnt vmcnt(0)" ::: "memory");
    __syncthreads();
    if (threadIdx.x == 0) {
        unsigned* bar = b.bar; unsigned bx = b.x;
        asm volatile("" : "+s"(bar), "+s"(bx));
        __builtin_amdgcn_s_waitcnt(0);
        unsigned nloc = b.st[0], nx = b.st[1];
        if (nloc == 0u) { xcd_barrier_complete(bar, bx, nloc, nx); b.st[0] = nloc; b.st[1] = nx; }
        const unsigned old = xb_add(&bar[XB_XSUB(bx)], 1u);
        const unsigned gen = old / nloc;
        if (old + 1u == (gen + 1u) * nloc) {
            __builtin_amdgcn_fence(__ATOMIC_RELEASE, "agent");
            asm volatile("s_waitcnt vmcnt(0)" ::: "memory");
            const unsigned og = xb_add(&bar[XB_TOP], 1u);
            const unsigned tg = og / nx;
            if (og + 1u == (tg + 1u) * nx) xb_add(&bar[XB_TOPGEN], 1u);
            else XB_SPIN(xb_ld(&bar[XB_TOPGEN]) == tg, bar);
            __builtin_amdgcn_fence(__ATOMIC_ACQUIRE, "agent");
            xb_add(&bar[XB_XGEN(bx)], 1u);
            asm volatile("s_waitcnt vmcnt(0)" ::: "memory");
        } else {
            XB_SPIN(xb_ld(&bar[XB_XGEN(bx)]) == gen, bar);
            __builtin_amdgcn_fence(__ATOMIC_ACQUIRE, "agent");
            asm volatile("s_waitcnt vmcnt(0)" ::: "memory");
        }
    }
    __syncthreads();
}

namespace pg8 {
constexpr int BM = 256, BK = 64, HALF = 128, HTB = HALF * BK * 2, STAGE_BYTES = 8 * HTB, KD = 1024;
__host__ __device__ __forceinline__ int lds_byte(int r, int c) { const int st = (r >> 4) * 2 + (c >> 5), rr = r & 15, cc = c & 31, ob = rr * 64 + cc * 2; return st * 1024 + (ob ^ (((ob >> 9) & 1) << 5)); }
__host__ __device__ __forceinline__ void stage_rc(int b, int& R, int& C) { const int st = b / 1024, sb = b % 1024, swz = sb ^ (((sb >> 9) & 1) << 5); R = (st >> 1) * 16 + swz / 64; C = (st & 1) * 32 + (swz % 64) / 2; }
__host__ __device__ __forceinline__ int perm32(int rho) { const int n = rho >> 4, i = rho & 15; return 8 * (i >> 2) + 4 * n + (i & 3); }

struct Unit { int pm, pn, e, kind; };
typedef int v8i __attribute__((ext_vector_type(8)));
typedef int v4i __attribute__((ext_vector_type(4)));
__device__ __forceinline__ v8i cat8(bf16x8 lo, bf16x8 hi) { const v4i a = __builtin_bit_cast(v4i, lo), b = __builtin_bit_cast(v4i, hi); return __builtin_shufflevector(a, b, 0, 1, 2, 3, 4, 5, 6, 7); }

__device__ __forceinline__ bool deal(int i, int npu, int ntiles, int& mt, int& r) {
    const int G = gridDim.x, c = blockIdx.x;
    if ((G & 7) == 0) { const int x = c & 7, q = i * (G >> 3) + (c >> 3); mt = (q / npu) * 8 + x; r = q % npu; }
    else { const int L = i * G + c; mt = L / npu; r = L % npu; }
    return mt < ntiles;
}

__device__ __forceinline__ void mfma8(f32x4& acc, const v8i a, const v8i b, int sc) {
    asm volatile("v_mfma_scale_f32_16x16x128_f8f6f4 %0, %1, %2, %0, %3, %3 op_sel_hi:[0,0,0]" : "+v"(acc) : "v"(a), "v"(b), "v"(sc)); }
__device__ __forceinline__ void glds16s(const char* sbase, unsigned voff, unsigned lds_dst) { unsigned keep;
    asm volatile("s_mov_b32 %0, m0\n\ts_mov_b32 m0, %3\n\ts_nop 0\n\tglobal_load_lds_dwordx4 %1, %2\n\ts_mov_b32 m0, %0" : "=&s"(keep) : "v"(voff), "s"(sbase), "s"(lds_dst) : "memory"); }
template <class Epi, class Sched, int PH = 0>
__device__ __forceinline__ void gemm_phase(LAS unsigned char* lds, const Sched& S, const Epi& E, const int tid, const int stagger_ticks = 0) {
    const int wid = __builtin_amdgcn_readfirstlane(tid >> 6), lane = tid & 63, wr = wid >> 2, wc = wid & 3, fr = lane & 15, fq = lane >> 4;
    constexpr int RB = Sched::RB, nt = RB / 128;
    constexpr bool F8 = (RB == 1024);
    unsigned voffB[2];
#pragma unroll
    for (int i = 0; i < 2; ++i) { int R_, C_; stage_rc(tid * 16 + i * 8192, R_, C_); const int Rb = (R_ & ~31) + perm32(R_ & 31); voffB[i] = (unsigned)(Rb * RB + C_ * 2); }
    constexpr bool GA = Sched::GATHER;
    constexpr int NH = GA ? 2 : 1;
    constexpr size_t kstep = (size_t)(BK * 2);
    constexpr size_t hstep = (size_t)HALF * RB, bstep = hstep;
    const unsigned ldsw = (unsigned)wid * 1024u, lds0 = (unsigned)(uintptr_t)lds;
    const int aoff = lds_byte(wr * 64 + fr, fq * 8), boff = lds_byte(wc * 32 + fr, fq * 8);
#define PG8_SA(b, h) (((b) * 2 + (h)) * HTB)
#define PG8_SB(b, h) ((4 + (b) * 2 + (h)) * HTB)
#define PG8_STAGE(bufoff, gbase, voff) do { _Pragma("unroll") for (int _i = 0; _i < 2; ++_i) \
        glds16s((const char*)(gbase), (voff)[_i], (unsigned)__builtin_amdgcn_readfirstlane(lds0 + (unsigned)(bufoff) + ldsw + _i * 8192u)); } while (0)
#define PG8_LDA(dst, b, h) do { _Pragma("unroll") for (int m = 0; m < 4; ++m) _Pragma("unroll") for (int k = 0; k < 2; ++k) dst[m][k] = *(const LAS bf16x8*)(lds + PG8_SA(b, h) + aoff + m * 2048 + k * 1024); } while (0)
#define PG8_LDB(dst, b, h) do { _Pragma("unroll") for (int n = 0; n < 2; ++n) _Pragma("unroll") for (int k = 0; k < 2; ++k) dst[n][k] = *(const LAS bf16x8*)(lds + PG8_SB(b, h) + boff + n * 2048 + k * 1024); } while (0)
#define PG8_MMA(ai, bj, At, Bt) do { __builtin_amdgcn_s_setprio(1); _Pragma("unroll") for (int m = 0; m < 4; ++m) _Pragma("unroll") for (int n = 0; n < 2; ++n) { \
        if constexpr (F8) mfma8(acc[ai][bj][m][n], cat8(Bt[n][0], Bt[n][1]), cat8(At[m][0], At[m][1]), sc8); \
        else { _Pragma("unroll") for (int k = 0; k < 2; ++k) acc[ai][bj][m][n] = __builtin_amdgcn_mfma_f32_16x16x32_bf16(Bt[n][k], At[m][k], acc[ai][bj][m][n], 0, 0, 0); } } __builtin_amdgcn_s_setprio(0); } while (0)
#define PG8_WAIT_V(n) asm volatile("s_waitcnt vmcnt(" #n ")" ::: "memory")
#define PG8_WAIT_VF do { if (fe) { if constexpr (Epi::NST == 16 && !PROBE_NOST) PG8_WAIT_V(24); else if constexpr (Epi::NST == 4 && !PROBE_NOST) PG8_WAIT_V(12); else if constexpr (Epi::NST == 8 && !PROBE_NOST) PG8_WAIT_V(16); else PG8_WAIT_V(8); } else PG8_WAIT_V(8); } while (0)
#define PG8_WAIT_L(n) asm volatile("s_waitcnt lgkmcnt(" #n ")" ::: "memory")
#define PG8_BAR __builtin_amdgcn_s_barrier()
#define PG8_SCHED __builtin_amdgcn_sched_barrier(0)
    Unit cur, nxt; int ui = 0;
    if (!S.next(0, cur)) return;
#define PT_ON(r) (PROBE_T == (r) && PH == PROBE_TPH)
#define PT_BEG(r) do { if (PT_ON(r)) pt0_ = __builtin_amdgcn_s_memtime(); } while (0)
#define PT_END(r) do { if (PT_ON(r)) { const unsigned long long d_ = __builtin_amdgcn_s_memtime() - pt0_; if (blockIdx.x == 0 && tid == 0) *(LAS unsigned long long*)(lds + LX_MISC + 64) += d_; } } while (0)
    unsigned long long pt0_ = 0; (void)pt0_;
    PT_BEG(3);
    if (stagger_ticks > 0 && (int)(blockIdx.x >> 3) >= (int)(gridDim.x >> 4)) { const unsigned long long t0_ = __builtin_amdgcn_s_memrealtime(); while ((long long)(__builtin_amdgcn_s_memrealtime() - t0_) < (long long)stagger_ticks) __builtin_amdgcn_s_sleep(16); }
    static_assert(Sched::SCALE_A == Sched::SCALE_B, "one scale register");
    int sc8 = Sched::SCALE_A; asm volatile("" : "+v"(sc8));
    f32x4 acc[2][2][4][2];
#pragma unroll
    for (int a = 0; a < 2; ++a)
#pragma unroll
        for (int b = 0; b < 2; ++b)
#pragma unroll
            for (int m = 0; m < 4; ++m)
#pragma unroll
                for (int n = 0; n < 2; ++n) acc[a][b][m][n] = (f32x4){0.f, 0.f, 0.f, 0.f};
    bf16x8 At[4][2], B0[2][2], B1[2][2];
    constexpr int NI = GA ? 1 : 2;
    unsigned vC[NH][NI], vN[NH][NI];
    unsigned cb2[2];
#pragma unroll
    for (int i = 0; i < 2; ++i) { int R_, C_; stage_rc(tid * 16 + i * 8192, R_, C_); cb2[i] = (unsigned)(C_ * 2); }
    const unsigned idx_slot = (unsigned)__builtin_amdgcn_readfirstlane((unsigned)(uintptr_t)(lds + LX_WSC) + (unsigned)wid * 1024u);
    if constexpr (GA) { S.idx_dma(cur, lane, idx_slot); asm volatile("s_waitcnt vmcnt(0)" ::: "memory"); S.a_offs_lds(cur, tid, vC, (LAS const int*)(lds + LX_WSC + wid * 1024)); }
    else S.a_offs(cur, tid, vC);
    const unsigned bias_slot0 = (unsigned)(uintptr_t)(lds + LX_ASG);
    if constexpr (Epi::BIAS_DMA) { if (wid == 0) glds16s((const char*)E.bias_src(cur), (unsigned)lane * 16u, (unsigned)__builtin_amdgcn_readfirstlane(bias_slot0)); }
#define PG8_HA(h) (GA ? 0 : (h) * hstep)
#define PG8_VH(v, h) (v)[GA ? (h) : 0]
#define PG8_STAGE_A(bufoff, gbase, vv) do { _Pragma("unroll") for (int _i = 0; _i < 2; ++_i) { unsigned o_; if constexpr (GA) o_ = (((vv)[0] >> (16 * _i)) & 0xffffu) * (unsigned)RB + cb2[_i]; else o_ = (vv)[NI - 2 + _i]; \
        glds16s((const char*)(gbase), o_, (unsigned)__builtin_amdgcn_readfirstlane(lds0 + (unsigned)(bufoff) + ldsw + _i * 8192u)); } } while (0)
    const char* cA = S.a_base(cur); const char* cB = S.b_base(cur);
    PG8_STAGE(PG8_SB(0, 0), cB, voffB); PG8_STAGE(PG8_SB(0, 1), cB + bstep, voffB); PG8_STAGE_A(PG8_SA(0, 0), cA, vC[0]); PG8_STAGE_A(PG8_SA(0, 1), cA + PG8_HA(1), PG8_VH(vC, 1));
    if (wr == 1) PG8_BAR;
    PG8_WAIT_V(2); PG8_BAR;
    PG8_STAGE(PG8_SB(1, 0), cB + kstep, voffB); PG8_STAGE_A(PG8_SA(1, 0), cA + kstep, vC[0]); PG8_STAGE(PG8_SB(1, 1), cB + bstep + kstep, voffB);
    PG8_WAIT_V(6); PG8_BAR;
    for (;;) {
        const bool has_next = S.next(ui + 1, nxt);
        const char* nA = cA; const char* nB = cB;
#pragma unroll
        for (int h = 0; h < NH; ++h)
#pragma unroll
            for (int i = 0; i < NI; ++i) vN[h][i] = vC[h][i];
        if (has_next) { if constexpr (GA) S.idx_dma(nxt, lane, idx_slot); else S.a_offs(nxt, tid, vN); nA = S.a_base(nxt); nB = S.b_base(nxt); }
        if constexpr (Epi::BIAS_DMA) { if (ui > 0 && wid == 0) glds16s((const char*)E.bias_src(cur), (unsigned)lane * 16u, (unsigned)__builtin_amdgcn_readfirstlane(bias_slot0 + (unsigned)(ui & 1) * 1024u)); }
        PT_BEG(2);
#pragma unroll 1
        for (int t = 0; t < nt; t += 2) {
            const bool last = (t == nt - 2);
            const char* a1 = cA + (size_t)(t + 1) * kstep;
            const char* a2 = last ? nA : cA + (size_t)(t + 2) * kstep; const char* b2 = last ? nB : cB + (size_t)(t + 2) * kstep;
            const char* a3 = a2 + kstep; const char* b3 = b2 + kstep;
            if constexpr (GA) { if (last && has_next) S.a_offs_lds(nxt, tid, vN, (LAS const int*)(lds + LX_WSC + wid * 1024)); }
            unsigned w0[NI], w1[NI];
#pragma unroll
            for (int i = 0; i < NI; ++i) { w0[i] = last ? vN[0][i] : vC[0][i]; w1[i] = last ? PG8_VH(vN, 1)[i] : PG8_VH(vC, 1)[i]; }
            const bool fe = (t == 0) && (ui > 0);
            PG8_LDB(B0, 0, 0); PG8_LDB(B1, 0, 1); PG8_SCHED; PG8_LDA(At, 0, 0); if (!fe) PG8_STAGE_A(PG8_SA(1, 1), a1 + PG8_HA(1), PG8_VH(vC, 1));
            PG8_WAIT_VF; PG8_WAIT_L(0); PG8_BAR; PG8_MMA(0, 0, At, B0); PG8_MMA(0, 1, At, B1); PG8_BAR; PG8_SCHED;
            PG8_LDA(At, 0, 1); PG8_STAGE(PG8_SB(0, 0), b2, voffB); PG8_STAGE(PG8_SB(0, 1), b2 + bstep, voffB); PG8_STAGE_A(PG8_SA(0, 0), a2, w0);
            PG8_WAIT_VF; PG8_WAIT_L(0); PG8_BAR; PG8_MMA(1, 0, At, B0); PG8_MMA(1, 1, At, B1); PG8_BAR; PG8_SCHED;
            PG8_LDB(B0, 1, 0); PG8_LDB(B1, 1, 1); PG8_SCHED; PG8_LDA(At, 1, 0); PG8_STAGE_A(PG8_SA(0, 1), a2 + PG8_HA(1), w1);
            PG8_WAIT_VF; PG8_WAIT_L(0); PG8_BAR; PG8_MMA(0, 0, At, B0); PG8_MMA(0, 1, At, B1); PG8_BAR; PG8_SCHED;
            PG8_LDA(At, 1, 1); PG8_STAGE(PG8_SB(1, 0), b3, voffB); PG8_STAGE(PG8_SB(1, 1), b3 + bstep, voffB); PG8_STAGE_A(PG8_SA(1, 0), a3, w0);
            PG8_WAIT_V(8); PG8_WAIT_L(0); PG8_BAR; PG8_MMA(1, 0, At, B0); PG8_MMA(1, 1, At, B1); PG8_BAR; PG8_SCHED;
        }
        PT_END(2);
        if (has_next) PG8_STAGE_A(PG8_SA(1, 1), nA + kstep + PG8_HA(1), PG8_VH(vN, 1));
        if (wr == 0) PG8_BAR;
        PT_BEG(1);
        if constexpr (Epi::BIAS_DMA) E(acc, cur, wr, wc, fr, fq, (LAS const float*)(lds + LX_ASG + (ui & 1) * 1024)); else E(acc, cur, wr, wc, fr, fq);
        PT_END(1);
        if (!has_next) break;
#pragma unroll
        for (int a = 0; a < 2; ++a)
#pragma unroll
            for (int b = 0; b < 2; ++b)
#pragma unroll
                for (int m = 0; m < 4; ++m)
#pragma unroll
                    for (int n = 0; n < 2; ++n) acc[a][b][m][n] = (f32x4){0.f, 0.f, 0.f, 0.f};
        cur = nxt; cA = nA; cB = nB; ++ui;
#pragma unroll
        for (int h = 0; h < NH; ++h)
#pragma unroll
            for (int i = 0; i < NI; ++i) vC[h][i] = vN[h][i];
        if (wr == 1) PG8_BAR;
    }
    PG8_WAIT_V(0);
    PG8_BAR;
    PT_END(3);
#undef PT_ON
#undef PT_BEG
#undef PT_END
#undef PG8_SA
#undef PG8_HA
#undef PG8_VH
#undef PG8_SB
#undef PG8_STAGE
#undef PG8_STAGE_A
#undef PG8_LDA
#undef PG8_LDB
#undef PG8_MMA
#undef PG8_WAIT_V
#undef PG8_WAIT_VF
#undef PG8_WAIT_L
#undef PG8_BAR
#undef PG8_SCHED
}
}
using pg8::Unit;

__device__ __forceinline__ int tile_row0(int mt, bool lat_only) { return lat_only ? ((mt >> 3) * 9 + 1 + (mt & 7)) * 256 : mt * 256; }

template <int RB_, int SC_> struct SchedQKV {
    static constexpr int RB = RB_, SCALE_A = SC_, SCALE_B = SC_;
    const char* H; const char* Wt;
    __device__ __forceinline__ bool next(int i, Unit& u) const { int mt, r; if (!pg8::deal(i, 12, M / 256, mt, r)) return false;
        if (r < 8) { u.kind = 0; u.pm = mt; u.pn = r; } else { u.kind = 1; u.pm = r - 8; u.pn = mt; } u.e = 0; return true; }
    static constexpr bool GATHER = false;
    __device__ __forceinline__ void a_offs(const Unit& u, int tid, unsigned (&v)[1][2]) const {
#pragma unroll
        for (int i = 0; i < 2; ++i) { int R, C; pg8::stage_rc(tid * 16 + i * 8192, R, C); v[0][i] = (unsigned)((u.pm * 256 + R) * RB + C * 2); } }
    __device__ __forceinline__ const char* a_base(const Unit& u) const { return u.kind == 0 ? H : Wt + (size_t)2048 * RB; }
    __device__ __forceinline__ const char* b_base(const Unit& u) const { return (u.kind == 0 ? Wt : H) + (size_t)u.pn * 256 * RB; }
};
template <int RB_, int SC_> struct SchedPlain {
    static constexpr int RB = RB_, SCALE_A = SC_, SCALE_B = SC_;
    const char* A; const char* Bt; int npu; bool lat_only;
    __device__ __forceinline__ bool next(int i, Unit& u) const { int mt, r; if (!pg8::deal(i, npu, lat_only ? 128 : 144, mt, r)) return false;
        u.pm = tile_row0(mt, lat_only) >> 8; u.pn = r; u.e = 0; u.kind = 0; return true; }
    static constexpr bool GATHER = false;
    __device__ __forceinline__ void a_offs(const Unit& u, int tid, unsigned (&v)[1][2]) const {
#pragma unroll
        for (int i = 0; i < 2; ++i) { int R, C; pg8::stage_rc(tid * 16 + i * 8192, R, C); v[0][i] = (unsigned)((u.pm * 256 + R) * RB + C * 2); } }
    __device__ __forceinline__ const char* a_base(const Unit&) const { return A; }
    __device__ __forceinline__ const char* b_base(const Unit& u) const { return Bt + (size_t)u.pn * 256 * RB; }
};
template <bool GATHER_, int RB_, int SA_, int SB_> struct SchedMoe {
    static constexpr bool GATHER = GATHER_;
    static constexpr int RB = RB_, SCALE_A = SA_, SCALE_B = SB_;
    const char* A; const char* Wt; const int* list; int npu; size_t estride;
    LAS const int* tstart; LAS const int* ecnt; LAS const int* tile_e;
    __device__ __forceinline__ bool next(int i, Unit& u) const { int mt, r; const int ntl = __builtin_amdgcn_readfirstlane(tstart[32]);
        int xp = 0;
        if (!pg8::deal(i, npu, ntl, mt, r)) { if (!(PROBE_REP & (GATHER_ ? 0x100 : 0x200))) return false; int n_i = 0; while (pg8::deal(n_i, npu, ntl, mt, r)) ++n_i; if (i >= 2 * n_i || !pg8::deal(i - n_i, npu, ntl, mt, r)) return false; xp = 1; }
        u.pm = mt; u.pn = r; u.e = __builtin_amdgcn_readfirstlane(tile_e[mt]); u.kind = xp; return true; }
    __device__ __forceinline__ void idx_dma(const Unit& u, int lane, unsigned slot) const {
        const int j0 = (u.pm - __builtin_amdgcn_readfirstlane(tstart[u.e])) * 256;
        pg8::glds16s((const char*)(list + (size_t)u.e * CAP + j0), (unsigned)lane * 16u, slot); }
    __device__ __forceinline__ void a_offs_lds(const Unit& u, int tid, unsigned (&v)[2][1], LAS const int* slot) const {
        const int j0 = (u.pm - __builtin_amdgcn_readfirstlane(tstart[u.e])) * 256, cnt = __builtin_amdgcn_readfirstlane(ecnt[u.e]);
#pragma unroll
        for (int h = 0; h < 2; ++h) { unsigned pk = 0;
#pragma unroll
            for (int i = 0; i < 2; ++i) { int R, C; pg8::stage_rc(tid * 16 + i * 8192, R, C); const int r = h * 128 + R; const unsigned tok = (j0 + r) < cnt ? (unsigned)slot[r] : 0u; pk |= tok << (16 * i); }
            v[h][0] = pk; }
    }
    __device__ __forceinline__ void a_offs(const Unit& u, int tid, unsigned (&v)[GATHER_ ? 2 : 1][GATHER_ ? 1 : 2]) const {
        if constexpr (GATHER_) { const int j0 = (u.pm - __builtin_amdgcn_readfirstlane(tstart[u.e])) * 256, cnt = __builtin_amdgcn_readfirstlane(ecnt[u.e]); const int* lp = list + (size_t)u.e * CAP;
#pragma unroll
            for (int h = 0; h < 2; ++h) { unsigned pk = 0;
#pragma unroll
                for (int i = 0; i < 2; ++i) { int R, C; pg8::stage_rc(tid * 16 + i * 8192, R, C); const int idx = j0 + h * 128 + R; const unsigned tok = idx < cnt ? (unsigned)lp[idx] : 0u; pk |= tok << (16 * i); }
                v[h][0] = pk; }
        } else {
#pragma unroll
            for (int i = 0; i < 2; ++i) { int R, C; pg8::stage_rc(tid * 16 + i * 8192, R, C); v[0][i] = (unsigned)((u.pm * 256 + R) * RB + C * 2); } }
    }
    __device__ __forceinline__ const char* a_base(const Unit&) const { return A; }
    __device__ __forceinline__ const char* b_base(const Unit& u) const { return Wt + (size_t)u.e * estride + (size_t)u.pn * 256 * RB; }
};

#define EPI_LOOP_ROWS for (int ai = 0; ai < 2; ++ai) _Pragma("unroll") for (int m = 0; m < 4; ++m)
__device__ __forceinline__ u32x4 pack8(const f32x4& v0, const f32x4& v1) { u32x4 w; w.x = cvt_pk_bf16(v0[0], v0[1]); w.y = cvt_pk_bf16(v0[2], v0[3]); w.z = cvt_pk_bf16(v1[0], v1[1]); w.w = cvt_pk_bf16(v1[2], v1[3]); return w; }

__device__ __forceinline__ float clamp8(float v) { return fminf(fmaxf(v, -448.f), 448.f); }
__device__ __forceinline__ unsigned pack_fp8x4(float a, float b, float c, float d) {
    int w = 0; w = __builtin_amdgcn_cvt_pk_fp8_f32(clamp8(a), clamp8(b), w, false); w = __builtin_amdgcn_cvt_pk_fp8_f32(clamp8(c), clamp8(d), w, true); return (unsigned)w; }
struct EpiQKV {
    static constexpr bool BIAS_DMA = false;
    static constexpr int NST = ATT_FP8 ? 8 : 16;
    bf16* Q; bf16* Kb; bf16* Vt; const float* cosT; const float* sinT; bool dost; LAS unsigned char* stg;
    __device__ __forceinline__ void operator()(const f32x4 (&acc)[2][2][4][2], const Unit& u, int wr, int wc, int fr, int fq) const {
        asm volatile("" : "+v"(fr), "+v"(fq));
        if constexpr (ATT_FP8 != 0) {
            const bool isq = u.pn < 4, k0 = (u.kind == 0); const bool lat = k0 && (u.pm % 9) != 0;
            unsigned char* base8 = (unsigned char*)Q + (k0 ? (isq ? (size_t)0 : WS_K - WS_Q) : WS_VT - WS_Q); const size_t ld = k0 ? 1024 : (size_t)M; const int colbase = k0 ? (u.pn & 3) * 256 : u.pn * 256;
            const float sc = k0 ? (isq ? C2 * 64.f : 16.f) : 16.f;
            LAS unsigned char* sw = stg + (wr * 4 + wc) * 2048; const int lane = fq * 16 + fr; const int jp0 = 16 * (wc & 1) + 4 * fq;
#pragma unroll
            for (int ai = 0; ai < 2; ++ai) {
                f32x4 cs[4], sn[4];
#pragma unroll
                for (int m = 0; m < 4; ++m) { const int row = u.pm * 256 + ai * 128 + wr * 64 + m * 16 + fr; const int t = lat ? (row % RPB) - CTXL : 0;
                    const f32x4 cv = *(const f32x4*)(cosT + t * 32 + jp0), sv = *(const f32x4*)(cosT + 2048 * 32 + t * 32 + jp0);
#pragma unroll
                    for (int j = 0; j < 4; ++j) { cs[m][j] = lat ? cv[j] : 1.f; sn[m][j] = lat ? sv[j] : 0.f; } }
#pragma unroll
                for (int bj = 0; bj < 2; ++bj) {
#pragma unroll
                    for (int m = 0; m < 4; ++m) { const f32x4 a = acc[ai][bj][m][0], b = acc[ai][bj][m][1]; const f32x4 c_ = cs[m], s_ = sn[m];
                        u32x2 w8;
                        w8.x = pack_fp8x4((a[0] * c_[0] - a[1] * s_[0]) * sc, (a[1] * c_[0] + a[0] * s_[0]) * sc, (a[2] * c_[1] - a[3] * s_[1]) * sc, (a[3] * c_[1] + a[2] * s_[1]) * sc);
                        w8.y = pack_fp8x4((b[0] * c_[2] - b[1] * s_[2]) * sc, (b[1] * c_[2] + b[0] * s_[2]) * sc, (b[2] * c_[3] - b[3] * s_[3]) * sc, (b[3] * c_[3] + b[2] * s_[3]) * sc);
                        *(LAS u32x2*)(sw + (16 * m + fr) * 32 + fq * 8) = w8; }
                    asm volatile("s_waitcnt lgkmcnt(0)" ::: "memory");
#pragma unroll
                    for (int k = 0; k < 2; ++k) { const int p = lane + 64 * k, rr = p >> 1, hf = p & 1; const u32x4 v = *(const LAS u32x4*)(sw + p * 16);
                        const int row = u.pm * 256 + ai * 128 + wr * 64 + rr; const int col = colbase + bj * 128 + wc * 32 + hf * 16;
                        if (dost) *(u32x4*)(base8 + (size_t)row * ld + col) = v; }
                    asm volatile("s_waitcnt lgkmcnt(0)" ::: "memory");
                }
            }
        } else if (u.kind == 0) {
            const bool isq = u.pn < 4; bf16* base = isq ? Q : Kb; const float sc = isq ? C2 : 1.f;
            const bool lat = (u.pm % 9) != 0;
#pragma unroll
            EPI_LOOP_ROWS { const int row = u.pm * 256 + ai * 128 + wr * 64 + m * 16 + fr; const int t = (row % RPB) - CTXL;
#pragma unroll
                for (int bj = 0; bj < 2; ++bj) { const f32x4 a = acc[ai][bj][m][0], b = acc[ai][bj][m][1]; f32x4 o0, o1;
                    f32x4 cs = {1.f, 1.f, 1.f, 1.f}, sn = {0.f, 0.f, 0.f, 0.f}; const int jp0 = 16 * (wc & 1) + 4 * fq;
                    if (lat) { cs = *(const f32x4*)(cosT + t * 32 + jp0); sn = *(const f32x4*)(sinT + t * 32 + jp0); }
                    o0[0] = (a[0] * cs[0] - a[1] * sn[0]) * sc; o0[1] = (a[1] * cs[0] + a[0] * sn[0]) * sc; o0[2] = (a[2] * cs[1] - a[3] * sn[1]) * sc; o0[3] = (a[3] * cs[1] + a[2] * sn[1]) * sc;
                    o1[0] = (b[0] * cs[2] - b[1] * sn[2]) * sc; o1[1] = (b[1] * cs[2] + b[0] * sn[2]) * sc; o1[2] = (b[2] * cs[3] - b[3] * sn[3]) * sc; o1[3] = (b[3] * cs[3] + b[2] * sn[3]) * sc;
                    const int col = (u.pn & 3) * 256 + bj * 128 + wc * 32 + fq * 8;
                    if (ATT_FP8) { const float s8 = isq ? 64.f : 16.f; u32x2 w8; w8.x = pack_fp8x4(s8 * o0[0], s8 * o0[1], s8 * o0[2], s8 * o0[3]); w8.y = pack_fp8x4(s8 * o1[0], s8 * o1[1], s8 * o1[2], s8 * o1[3]);
                        if (dost) *(u32x2*)((unsigned char*)base + (size_t)row * 1024 + col) = w8; }
                    else { const u32x4 pk_ = pack8(o0, o1); if (dost) *(u32x4*)(base + (size_t)row * 1024 + col) = pk_; } } }
        } else {
#pragma unroll
            EPI_LOOP_ROWS { const int row = u.pm * 256 + ai * 128 + wr * 64 + m * 16 + fr;
#pragma unroll
                for (int bj = 0; bj < 2; ++bj) { const int col = u.pn * 256 + bj * 128 + wc * 32 + fq * 8;
                    if (ATT_FP8) { const f32x4 a_ = acc[ai][bj][m][0], b_ = acc[ai][bj][m][1]; u32x2 w8; w8.x = pack_fp8x4(16.f * a_[0], 16.f * a_[1], 16.f * a_[2], 16.f * a_[3]); w8.y = pack_fp8x4(16.f * b_[0], 16.f * b_[1], 16.f * b_[2], 16.f * b_[3]);
                        if (dost) *(u32x2*)((unsigned char*)Vt + (size_t)row * M + col) = w8; }
                    else { const u32x4 pk_ = pack8(acc[ai][bj][m][0], acc[ai][bj][m][1]); if (dost) *(u32x4*)(Vt + (size_t)row * M + col) = pk_; } } }
        }
    }
};
struct EpiPlain {
    static constexpr bool BIAS_DMA = false;
    static constexpr int NST = 16;
    bf16* O; int ldc;
    __device__ __forceinline__ void operator()(const f32x4 (&acc)[2][2][4][2], const Unit& u, int wr, int wc, int fr, int fq) const {
        asm volatile("" : "+v"(fr), "+v"(fq));
#pragma unroll
        EPI_LOOP_ROWS { const int row = u.pm * 256 + ai * 128 + wr * 64 + m * 16 + fr;
#pragma unroll
            for (int bj = 0; bj < 2; ++bj) { const int col = u.pn * 256 + bj * 128 + wc * 32 + fq * 8;
                *(u32x4*)(O + (size_t)row * ldc + col) = pack8(acc[ai][bj][m][0], acc[ai][bj][m][1]); } }
    }
};
struct EpiConvIn {
    static constexpr bool BIAS_DMA = false;
    static constexpr int NST = 16;
    bf16* Bb; bf16* Ub;
    __device__ __forceinline__ void operator()(const f32x4 (&acc)[2][2][4][2], const Unit& u, int wr, int wc, int fr, int fq) const {
        asm volatile("" : "+v"(fr), "+v"(fq));
        if (u.pn < 4) {
#pragma unroll
            EPI_LOOP_ROWS { const int row = u.pm * 256 + ai * 128 + wr * 64 + m * 16 + fr;
#pragma unroll
                for (int bj = 0; bj < 2; ++bj) { const int col = u.pn * 256 + bj * 128 + wc * 32 + fq * 8;
                    *(u32x4*)(Bb + (size_t)row * 1024 + col) = pack8(acc[ai][bj][m][0], acc[ai][bj][m][1]); } }
        } else {
#pragma unroll
            EPI_LOOP_ROWS { const int row = u.pm * 256 + ai * 128 + wr * 64 + m * 16 + fr;
#pragma unroll
                for (int bj = 0; bj < 2; ++bj) { const f32x4 a = acc[ai][bj][m][0], b = acc[ai][bj][m][1]; const int col = (u.pn - 4) * 128 + bj * 64 + wc * 16 + fq * 4;
                    u32x2 w; w.x = cvt_pk_bf16(a[0] * a[1], a[2] * a[3]); w.y = cvt_pk_bf16(b[0] * b[1], b[2] * b[3]);
                    *(u32x2*)(Ub + (size_t)row * 1024 + col) = w; } }
        }
    }
};
struct EpiResid {
    static constexpr bool BIAS_DMA = false;
    static constexpr int NST = X_BF16 ? 16 : 0;
    const void* Xin; void* X; const float* gate;
    const float* in_x; const float* in_ctx;
    __device__ __forceinline__ void operator()(const f32x4 (&acc)[2][2][4][2], const Unit& u, int wr, int wc, int fr, int fq) const {
        asm volatile("" : "+v"(fr), "+v"(fq));
        const int rb = (u.pm % 9) == 0 ? 16 : u.pm / 9; const float* gp = gate + rb * 6144;
        f32x4 gv[2][2];
#pragma unroll
        for (int bj = 0; bj < 2; ++bj) { const int col = u.pn * 256 + bj * 128 + wc * 32 + fq * 8; gv[bj][0] = *(const f32x4*)(gp + col); gv[bj][1] = *(const f32x4*)(gp + col + 4); }
        if (X_BF16 && !in_x) {
#pragma unroll
            for (int ai = 0; ai < 2; ++ai) { u32x4 xw[4][2];
#pragma unroll
                for (int m = 0; m < 4; ++m)
#pragma unroll
                    for (int bj = 0; bj < 2; ++bj) xw[m][bj] = *(const u32x4*)((const bf16*)Xin + (size_t)(u.pm * 256 + ai * 128 + wr * 64 + m * 16 + fr) * 1024 + u.pn * 256 + bj * 128 + wc * 32 + fq * 8);
#pragma unroll
                for (int m = 0; m < 4; ++m)
#pragma unroll
                    for (int bj = 0; bj < 2; ++bj) { const u32x4 w = xw[m][bj];
                        const f32x4 x0 = {bf2f((unsigned short)(w.x & 0xffffu)), bf2f((unsigned short)(w.x >> 16)), bf2f((unsigned short)(w.y & 0xffffu)), bf2f((unsigned short)(w.y >> 16))};
                        const f32x4 x1 = {bf2f((unsigned short)(w.z & 0xffffu)), bf2f((unsigned short)(w.z >> 16)), bf2f((unsigned short)(w.w & 0xffffu)), bf2f((unsigned short)(w.w >> 16))};
                        *(u32x4*)((bf16*)X + (size_t)(u.pm * 256 + ai * 128 + wr * 64 + m * 16 + fr) * 1024 + u.pn * 256 + bj * 128 + wc * 32 + fq * 8) = pack8(x0 + gv[bj][0] * acc[ai][bj][m][0], x1 + gv[bj][1] * acc[ai][bj][m][1]); } }
        } else {
#pragma unroll
            EPI_LOOP_ROWS { const int row = u.pm * 256 + ai * 128 + wr * 64 + m * 16 + fr;
#pragma unroll
                for (int bj = 0; bj < 2; ++bj) { const int col = u.pn * 256 + bj * 128 + wc * 32 + fq * 8; const size_t o = (size_t)row * 1024 + col;
                    const float* xs = (const float*)Xin + o;
                    if (in_x) { const int b_ = u.pm / 9, jt_ = u.pm % 9; const size_t ro = (size_t)(row - u.pm * 256) * 1024 + col;
                        xs = jt_ == 0 ? in_ctx + (size_t)b_ * CTXL * 1024 + ro : in_x + ((size_t)b_ * SEQ + (jt_ - 1) * 256) * 1024 + ro; }
                    const f32x4 x0 = *(const f32x4*)(xs), x1 = *(const f32x4*)(xs + 4);
                    const f32x4 r0 = x0 + gv[bj][0] * acc[ai][bj][m][0], r1 = x1 + gv[bj][1] * acc[ai][bj][m][1];
                    if (X_BF16) *(u32x4*)((bf16*)X + o) = pack8(r0, r1);
                    else { *(f32x4*)((float*)X + o) = r0; *(f32x4*)((float*)X + o + 4) = r1; } } }
        }
    }
};
__device__ __forceinline__ float swiglu1(float g, float l) {
    g = fminf(g, 7.f); l = fminf(fmaxf(l, -7.f), 7.f);
    const float s = __builtin_amdgcn_rcpf(1.f + __builtin_amdgcn_exp2f(-1.702f * 1.4426950408889634f * g));
    return g * s * (l + 1.f);
}
__device__ __forceinline__ float swiglu4(float g, float l) {
    g = fminf(g, 7.f); l = __builtin_amdgcn_fmed3f(l, -7.f, 7.f);
    const float r = __builtin_amdgcn_rcpf(1.f + __builtin_amdgcn_exp2f(g * (-1.702f * 1.4426950408889634f)));
    return (g * r) * __builtin_fmaf(l, 4.f, 4.f);
}
template <bool F8> struct EpiSwiglu {
    static constexpr bool BIAS_DMA = true;
    static constexpr int NST = F8 ? 4 : 16;
    bf16* ACT; const float* bgu; LAS unsigned char* stg;
    __device__ __forceinline__ const float* bias_src(const Unit& u) const { return bgu + u.e * 2048 + u.pn * 256; }
    __device__ __forceinline__ void operator()(const f32x4 (&acc)[2][2][4][2], const Unit& u, int wr, int wc, int fr, int fq, LAS const float* bl) const {
        asm volatile("" : "+v"(fr), "+v"(fq));
        f32x4 bv[2][2];
#pragma unroll
        for (int bj = 0; bj < 2; ++bj) { const int col = bj * 128 + wc * 32 + fq * 8; bv[bj][0] = *(const LAS f32x4*)(bl + col); bv[bj][1] = *(const LAS f32x4*)(bl + col + 4); }
        if constexpr (F8) {
            LAS unsigned* sw = (LAS unsigned*)(stg + (wr * 4 + wc) * 2048); const int lane = fq * 16 + fr;
#pragma unroll
            for (int ai = 0; ai < 2; ++ai) {
#pragma unroll
                for (int m = 0; m < 4; ++m)
#pragma unroll
                    for (int bj = 0; bj < 2; ++bj) { const f32x4 a = acc[ai][bj][m][0] + bv[bj][0], b = acc[ai][bj][m][1] + bv[bj][1];
                        int w = 0; w = __builtin_amdgcn_cvt_pk_fp8_f32(swiglu4(a[0], a[1]), swiglu4(a[2], a[3]), w, false); w = __builtin_amdgcn_cvt_pk_fp8_f32(swiglu4(b[0], b[1]), swiglu4(b[2], b[3]), w, true);
                        sw[((16 * m + fr) * 2 + bj) * 4 + fq] = (unsigned)w; }
                asm volatile("s_waitcnt lgkmcnt(0)" ::: "memory");
#pragma unroll
                for (int k = 0; k < 2; ++k) { const int p = lane + 64 * k, rr = p >> 1, bj = p & 1; const u32x4 v = *(const LAS u32x4*)(sw + p * 4);
                    const int row = u.pm * 256 + ai * 128 + wr * 64 + rr; const int col = u.pn * 128 + bj * 64 + wc * 16;
                    if (!(PROBE_NOST && u.kind)) *(u32x4*)((unsigned char*)ACT + (size_t)row * 1024 + col) = v; }
                asm volatile("s_waitcnt lgkmcnt(0)" ::: "memory");
            }
        } else {
#pragma unroll
            EPI_LOOP_ROWS { const int row = u.pm * 256 + ai * 128 + wr * 64 + m * 16 + fr;
#pragma unroll
                for (int bj = 0; bj < 2; ++bj) { const f32x4 a = acc[ai][bj][m][0] + bv[bj][0], b = acc[ai][bj][m][1] + bv[bj][1];
                    const int col = u.pn * 128 + bj * 64 + wc * 16 + fq * 4;
                    u32x2 w; w.x = cvt_pk_bf16(swiglu1(a[0], a[1]), swiglu1(a[2], a[3])); w.y = cvt_pk_bf16(swiglu1(b[0], b[1]), swiglu1(b[2], b[3]));
                    *(u32x2*)(ACT + (size_t)row * 1024 + col) = w; } }
        }
    }
};
struct EpiDown {
    static constexpr bool BIAS_DMA = true;
    static constexpr int NST = Y_FP8 ? 8 : 16;
    bf16* Y; const float* bd; LAS unsigned char* stg;
    __device__ __forceinline__ const float* bias_src(const Unit& u) const { return bd + u.e * 1024 + u.pn * 256; }
    __device__ __forceinline__ void operator()(const f32x4 (&acc)[2][2][4][2], const Unit& u, int wr, int wc, int fr, int fq, LAS const float* bl) const {
        asm volatile("" : "+v"(fr), "+v"(fq));
        f32x4 bv[2][2];
#pragma unroll
        for (int bj = 0; bj < 2; ++bj) { const int col = bj * 128 + wc * 32 + fq * 8; bv[bj][0] = *(const LAS f32x4*)(bl + col); bv[bj][1] = *(const LAS f32x4*)(bl + col + 4); }
        if constexpr (Y_FP8 != 0) {
            LAS unsigned char* sw = stg + (wr * 4 + wc) * 2048; const int lane = fq * 16 + fr;
#pragma unroll
            for (int ai = 0; ai < 2; ++ai)
#pragma unroll
                for (int bj = 0; bj < 2; ++bj) {
#pragma unroll
                    for (int m = 0; m < 4; ++m) { const f32x4 y0 = acc[ai][bj][m][0] + bv[bj][0], y1 = acc[ai][bj][m][1] + bv[bj][1];
                        u32x2 w; w.x = pack_fp8x4(16.f * y0[0], 16.f * y0[1], 16.f * y0[2], 16.f * y0[3]); w.y = pack_fp8x4(16.f * y1[0], 16.f * y1[1], 16.f * y1[2], 16.f * y1[3]);
                        *(LAS u32x2*)(sw + (16 * m + fr) * 32 + fq * 8) = w; }
                    asm volatile("s_waitcnt lgkmcnt(0)" ::: "memory");
#pragma unroll
                    for (int k = 0; k < 2; ++k) { const int p = lane + 64 * k, rr = p >> 1, hf = p & 1; const u32x4 v = *(const LAS u32x4*)(sw + p * 16);
                        const int row = u.pm * 256 + ai * 128 + wr * 64 + rr; const int col = u.pn * 256 + bj * 128 + wc * 32 + hf * 16;
                        if (!(PROBE_NOST && u.kind)) *(u32x4*)((unsigned char*)Y + (size_t)row * 1024 + col) = v; }
                    asm volatile("s_waitcnt lgkmcnt(0)" ::: "memory");
                }
        } else {
#pragma unroll
            EPI_LOOP_ROWS { const int row = u.pm * 256 + ai * 128 + wr * 64 + m * 16 + fr;
#pragma unroll
                for (int bj = 0; bj < 2; ++bj) { const int col = u.pn * 256 + bj * 128 + wc * 32 + fq * 8;
                    const u32x4 pk_ = pack8(acc[ai][bj][m][0] + bv[bj][0], acc[ai][bj][m][1] + bv[bj][1]); if (!(PROBE_NOST && u.kind)) *(u32x4*)(Y + (size_t)row * 1024 + col) = pk_; } }
        }
    }
};

namespace att {
constexpr int SLOT = 32768, VOFF = 16384;
__device__ __forceinline__ void glds16(const void* gsrc, unsigned lds_dst) { unsigned keep;
    asm volatile("s_mov_b32 %0, m0\n\ts_mov_b32 m0, %2\n\ts_nop 0\n\tglobal_load_lds_dwordx4 %1, off\n\ts_mov_b32 m0, %0" : "=&s"(keep) : "v"(gsrc), "s"(lds_dst) : "memory"); }
#define ATT_WAIT_BAR(N) asm volatile("s_waitcnt vmcnt(" #N ") lgkmcnt(0)\n\ts_barrier" ::: "memory")
__device__ __forceinline__ float half_swap_max(float m) { auto rr = __builtin_amdgcn_permlane32_swap(__float_as_uint(m), __float_as_uint(m), false, false); return fmaxf(__uint_as_float(rr[0]), __uint_as_float(rr[1])); }
__device__ __forceinline__ float half_swap_sum(float m) { auto rr = __builtin_amdgcn_permlane32_swap(__float_as_uint(m), __float_as_uint(m), false, false); return __uint_as_float(rr[0]) + __uint_as_float(rr[1]); }
__device__ __forceinline__ int crow(int r, int hi) { return (r & 3) + 8 * (r >> 2) + 4 * hi; }
__device__ __forceinline__ float max3f(float a, float b, float c) { float r; asm("v_max3_f32 %0, %1, %2, %3" : "=v"(r) : "v"(a), "v"(b), "v"(c)); return r; }

__device__ __forceinline__ void attn_unit(LAS unsigned char* lds, LAS float* wsc  , const bf16* Q, const bf16* Kb, const bf16* Vt, bf16* O,
                                          int krow0, int h, int qrow0, int NT, float lam, float osc, const float* subg, const int tid) {
    const int lane = tid & 63, r32 = lane & 31, hi = lane >> 5; const int wid = __builtin_amdgcn_readfirstlane(tid >> 6);
    const int qg = wid >> 1, c = wid & 1;
    const unsigned lds0 = (unsigned)(uintptr_t)lds;
    const bf16* ksrc[2]; const bf16* vsrc[2];
#pragma unroll
    for (int i = 0; i < 2; ++i) { const int p = 2 * wid + i;
        { const int row = 4 * p + (lane >> 4), ch = (lane & 15) ^ (row & 15); ksrc[i] = Kb + (size_t)(krow0 + row) * 1024 + h * 128 + ch * 8; }
        { const int row = 8 * p + (lane >> 3), ch = (lane & 7) ^ ((row >> 1) & 7); vsrc[i] = Vt + (size_t)(h * 128 + row) * M + krow0 + ch * 8; } }
    const unsigned kdst = lds0 + (unsigned)wid * 2048u, vdst = lds0 + VOFF + (unsigned)wid * 2048u;
#define ATT_DMA(t, slot) do { const unsigned so_ = (unsigned)(slot) * SLOT; \
        glds16(ksrc[0] + (size_t)(t) * 64 * 1024, (unsigned)__builtin_amdgcn_readfirstlane(kdst + so_)); glds16(ksrc[1] + (size_t)(t) * 64 * 1024, (unsigned)__builtin_amdgcn_readfirstlane(kdst + so_ + 1024u)); \
        glds16(vsrc[0] + (size_t)(t) * 64, (unsigned)__builtin_amdgcn_readfirstlane(vdst + so_)); glds16(vsrc[1] + (size_t)(t) * 64, (unsigned)__builtin_amdgcn_readfirstlane(vdst + so_ + 1024u)); } while (0)
    const int key0 = (r32 & 0x13) | ((r32 & 4) << 1) | ((r32 & 8) >> 1);
    const int kx = key0 & 15, vx = (r32 >> 1) & 7;
    bf16x8 qf[4];
    { const bf16* qp = Q + (size_t)(qrow0 + qg * 32 + r32) * 1024 + h * 128 + c * 64 + hi * 8;
#pragma unroll
      for (int d0 = 0; d0 < 4; ++d0) qf[d0] = *(const bf16x8*)(qp + d0 * 16); }
    float sg[4];
#pragma unroll
    for (int d0 = 0; d0 < 4; ++d0) sg[d0] = subg[d0 * 32 + r32] * osc;
    f32x16 o[4];
#pragma unroll
    for (int d0 = 0; d0 < 4; ++d0) o[d0] = f32x16{};
    float mref = 0.f, lsum = 0.f; f32x16 negm = f32x16{};
    asm volatile("s_waitcnt vmcnt(0)" ::: "memory");
#define AT_BEG(r) do { if (PROBE_T == (r)) at0_ = __builtin_amdgcn_s_memtime(); } while (0)
#define AT_END(r) do { if (PROBE_T == (r)) { const unsigned long long d_ = __builtin_amdgcn_s_memtime() - at0_; if (blockIdx.x == 0 && tid == ATT_PROBE_TID) *(LAS unsigned long long*)(lds + LX_MISC + 64) += d_; } } while (0)
    unsigned long long at0_ = 0; (void)at0_;
    AT_BEG(7);
    AT_BEG(13);
    ATT_DMA(0, 0);
    if (NT > 1) ATT_DMA(1, 1);
    for (int t = 0; t < NT; ++t) {
        const int slot = t & 3;
        AT_BEG(4);
        if (t + 1 < NT) { ATT_WAIT_BAR(4); } else { ATT_WAIT_BAR(0); }
        AT_END(4);
        if (t == 0) AT_END(13);
        if (t + 2 < NT) ATT_DMA(t + 2, (t + 2) & 3);
        AT_BEG(5);
        const LAS unsigned char* kb_ = lds + slot * SLOT; const LAS unsigned char* vb_ = kb_ + VOFF;
        f32x16 s0, s1;
        bf16x8 kf[8];
#pragma unroll
        for (int d0 = 0; d0 < 4; ++d0) { const int ch = (c * 8 + d0 * 2 + hi) ^ kx;
            kf[d0] = *(const LAS bf16x8*)(kb_ + key0 * 256 + ch * 16); kf[4 + d0] = *(const LAS bf16x8*)(kb_ + (key0 + 32) * 256 + ch * 16); }
        bf16x8 vA[8], vB[8];
#pragma unroll
        for (int ks = 0; ks < 2; ++ks) { const int ch = (2 * ks + hi) ^ vx;
#pragma unroll
            for (int d0 = 0; d0 < 4; ++d0) vA[ks * 4 + d0] = *(const LAS bf16x8*)(vb_ + (d0 * 32 + r32) * 128 + ch * 16); }
#pragma unroll
        for (int d0 = 0; d0 < 4; ++d0) s0 = __builtin_amdgcn_mfma_f32_32x32x16_bf16(kf[d0], qf[d0], d0 == 0 ? negm : s0, 0, 0, 0);
#pragma unroll
        for (int d0 = 0; d0 < 4; ++d0) s1 = __builtin_amdgcn_mfma_f32_32x32x16_bf16(kf[4 + d0], qf[d0], d0 == 0 ? negm : s1, 0, 0, 0);
        float rm = s0[0];
#pragma unroll
        for (int r = 1; r < 16; ++r) rm = fmaxf(rm, s0[r]);
        float sa = 0.f;
#pragma unroll
        for (int r = 0; r < 16; ++r) { s0[r] = __builtin_amdgcn_exp2f(s0[r]); sa += s0[r]; }
        bf16x8 pa[4];
#pragma unroll
        for (int s = 0; s < 2; ++s) { u32x4 w0;
            w0.x = cvt_pk_bf16(s0[8 * s + 0], s0[8 * s + 1]); w0.y = cvt_pk_bf16(s0[8 * s + 2], s0[8 * s + 3]); w0.z = cvt_pk_bf16(s0[8 * s + 4], s0[8 * s + 5]); w0.w = cvt_pk_bf16(s0[8 * s + 6], s0[8 * s + 7]);
            pa[s] = __builtin_bit_cast(bf16x8, w0); }
#pragma unroll
        for (int ks = 2; ks < 4; ++ks) { const int ch = (2 * ks + hi) ^ vx;
#pragma unroll
            for (int d0 = 0; d0 < 4; ++d0) vB[(ks - 2) * 4 + d0] = *(const LAS bf16x8*)(vb_ + (d0 * 32 + r32) * 128 + ch * 16); }
#pragma unroll
        for (int ks = 0; ks < 2; ++ks)
#pragma unroll
            for (int d0 = 0; d0 < 4; ++d0) o[d0] = __builtin_amdgcn_mfma_f32_32x32x16_bf16(pa[ks], vA[ks * 4 + d0], o[d0], 0, 0, 0);
#pragma unroll
        for (int r = 0; r < 16; ++r) rm = fmaxf(rm, s1[r]);
#pragma unroll
        for (int r = 0; r < 16; ++r) { s1[r] = __builtin_amdgcn_exp2f(s1[r]); sa += s1[r]; }
        lsum += sa;
#pragma unroll
        for (int s = 0; s < 2; ++s) { u32x4 w1;
            w1.x = cvt_pk_bf16(s1[8 * s + 0], s1[8 * s + 1]); w1.y = cvt_pk_bf16(s1[8 * s + 2], s1[8 * s + 3]); w1.z = cvt_pk_bf16(s1[8 * s + 4], s1[8 * s + 5]); w1.w = cvt_pk_bf16(s1[8 * s + 6], s1[8 * s + 7]);
            pa[2 + s] = __builtin_bit_cast(bf16x8, w1); }
#pragma unroll
        for (int ks = 2; ks < 4; ++ks)
#pragma unroll
            for (int d0 = 0; d0 < 4; ++d0) o[d0] = __builtin_amdgcn_mfma_f32_32x32x16_bf16(pa[ks], vB[(ks - 2) * 4 + d0], o[d0], 0, 0, 0);
        AT_END(5);
        rm = half_swap_max(rm);
        const bool need = (t == 0) || (rm > 8.f);
        if (__any(need)) {
            const float dl = need ? rm : 0.f; mref += dl;
#pragma unroll
            for (int r = 0; r < 16; ++r) negm[r] = -mref;
            const float f = __builtin_amdgcn_exp2f(-dl); lsum *= f;
            if (hi == 0) wsc[r32] = f;
            asm volatile("s_waitcnt lgkmcnt(0)" ::: "memory");
#pragma unroll
            for (int r = 0; r < 16; ++r) { const float fr_ = wsc[crow(r, hi)];
#pragma unroll
                for (int d0 = 0; d0 < 4; ++d0) o[d0][r] *= fr_; }
            asm volatile("s_waitcnt lgkmcnt(0)" ::: "memory");
        }
    }
    AT_BEG(14);
    const float lt = half_swap_sum(lsum);
    if (hi == 0) wsc[64 + r32] = (c ? -lam : 1.f) * __builtin_amdgcn_rcpf(lt);
    asm volatile("s_waitcnt lgkmcnt(0)\n\ts_barrier" ::: "memory");
    LAS float* xch = (LAS float*)(lds + qg * 16384);
#pragma unroll
    for (int r = 0; r < 16; ++r) { const float a = wsc[64 + crow(r, hi)];
#pragma unroll
        for (int d0 = 0; d0 < 4; ++d0) o[d0][r] *= a; }
    if (c == 1) {
#pragma unroll
        for (int d0 = 0; d0 < 4; ++d0)
#pragma unroll
            for (int r = 0; r < 16; ++r) xch[(d0 * 16 + r) * 64 + lane] = o[d0][r];
    }
    asm volatile("s_waitcnt lgkmcnt(0)\n\ts_barrier" ::: "memory");
    if (c == 0) {
        constexpr int OB = FP8_ATT_O ? 1 : 2;
        LAS unsigned char* stg = lds + 65536 + qg * 8192;
#pragma unroll
        for (int d0 = 0; d0 < 4; ++d0)
#pragma unroll
            for (int r = 0; r < 16; ++r) o[d0][r] += xch[(d0 * 16 + r) * 64 + lane];
        float ss[16], tt[16];
#pragma unroll
        for (int r = 0; r < 16; ++r) { float x = (o[0][r] * o[0][r] + o[1][r] * o[1][r]) + (o[2][r] * o[2][r] + o[3][r] * o[3][r]);
            x += __builtin_bit_cast(float, __builtin_amdgcn_update_dpp(0, __builtin_bit_cast(int, x), 0xB1, 0xF, 0xF, true));
            x += __builtin_bit_cast(float, __builtin_amdgcn_update_dpp(0, __builtin_bit_cast(int, x), 0x4E, 0xF, 0xF, true));
            x += __builtin_bit_cast(float, __builtin_amdgcn_update_dpp(0, __builtin_bit_cast(int, x), 0x124, 0xF, 0xF, true));
            x += __builtin_bit_cast(float, __builtin_amdgcn_update_dpp(0, __builtin_bit_cast(int, x), 0x128, 0xF, 0xF, true));
            ss[r] = x; }
#pragma unroll
        for (int r = 0; r < 16; ++r) tt[r] = __shfl_xor(ss[r], 16);
#pragma unroll
        for (int r = 0; r < 16; ++r) { const int qr = crow(r, hi); const float rn = __builtin_amdgcn_rsqf((ss[r] + tt[r]) * (1.f / 128.f) + EPS);
#pragma unroll
            for (int d0 = 0; d0 < 4; ++d0) { const float ov = o[d0][r] * rn * sg[d0];
                if (FP8_ATT_O) { const float o4 = clamp8(4.f * ov); *(LAS unsigned char*)(stg + qr * 128 + d0 * 32 + r32) = (unsigned char)(__builtin_amdgcn_cvt_pk_fp8_f32(o4, o4, 0, false) & 0xff); }
                else *(LAS unsigned short*)(stg + (qr * 128 + d0 * 32 + r32) * 2) = (unsigned short)f2bf(ov); } }
        asm volatile("s_waitcnt lgkmcnt(0)" ::: "memory");
        unsigned char* Ob = (unsigned char*)O + ((size_t)(qrow0 + qg * 32) * 1024 + h * 128) * OB;
#pragma unroll
        for (int k = 0; k < 4 * OB; ++k) { const int off = lane * 16 + 1024 * k, row = off / (128 * OB), cb = off % (128 * OB);
            *(u32x4*)(Ob + (size_t)row * 1024 * OB + cb) = *(const LAS u32x4*)(stg + off); }
    }
    asm volatile("s_waitcnt lgkmcnt(0)\n\ts_barrier" ::: "memory");
    AT_END(7);
    AT_END(14);
#undef AT_BEG
#undef AT_END
#undef ATT_DMA
}

typedef int v8i __attribute__((ext_vector_type(8)));
typedef int v4i_ __attribute__((ext_vector_type(4)));
__device__ __forceinline__ v8i cat16(u32x4 lo, u32x4 hi2) { const v4i_ a = __builtin_bit_cast(v4i_, lo), b = __builtin_bit_cast(v4i_, hi2); return __builtin_shufflevector(a, b, 0, 1, 2, 3, 4, 5, 6, 7); }
constexpr float ATT_TGT = 2.f;
__device__ __forceinline__ void attn_unit8(LAS unsigned char* lds, LAS float* wsc, const unsigned char* Q8, const unsigned char* K8, const unsigned char* V8t, bf16* O,
                                           int krow0, int h, int qrow0, int NT, float lam, float osc, const float* subg, const int tid) {
    constexpr int SL = 16384, VO = 8192;
    const int lane = tid & 63, r32 = lane & 31, hi = lane >> 5; const int wid = __builtin_amdgcn_readfirstlane(tid >> 6);
    const int qg = wid >> 1, c = wid & 1;
    const unsigned lds0 = (unsigned)(uintptr_t)lds;
    const unsigned char* ksrc; const unsigned char* vsrc;
    { const int key = 8 * wid + (lane >> 3), ch = (lane & 7) ^ ((key >> 1) & 7); ksrc = K8 + (size_t)(krow0 + key) * 1024 + h * 128 + ch * 16; }
    { const int dv = 16 * wid + (lane >> 2), ch = (lane & 3) ^ ((dv >> 2) & 3); vsrc = V8t + (size_t)(h * 128 + dv) * M + krow0 + ch * 16; }
    const unsigned kdst = lds0 + (unsigned)wid * 1024u, vdst = lds0 + VO + (unsigned)wid * 1024u;
#define ATT_DMA8(t, slot) do { const unsigned so_ = (unsigned)(slot) * SL; \
        glds16(ksrc + (size_t)(t) * 64 * 1024, (unsigned)__builtin_amdgcn_readfirstlane(kdst + so_)); glds16(vsrc + (size_t)(t) * 64, (unsigned)__builtin_amdgcn_readfirstlane(vdst + so_)); } while (0)
    const int key0 = 32 * ((r32 >> 2) & 1) + (r32 & 3) + 4 * (r32 >> 3);
    const int kx = (key0 >> 1) & 7, vx = (r32 >> 2) & 3;
    const int kc0 = ((c * 4 + 2 * hi) ^ kx) * 16, kc1 = ((c * 4 + 2 * hi + 1) ^ kx) * 16;
    const int vc0 = ((2 * hi) ^ vx) * 16, vc1 = ((2 * hi + 1) ^ vx) * 16;
    v8i qf;
    { const unsigned char* qp = Q8 + (size_t)(qrow0 + qg * 32 + r32) * 1024 + h * 128 + c * 64 + hi * 32;
      qf = cat16(*(const u32x4*)qp, *(const u32x4*)(qp + 16)); }
    float sg[4];
#pragma unroll
    for (int d0 = 0; d0 < 4; ++d0) sg[d0] = subg[d0 * 32 + r32] * osc;
    f32x16 o[4];
#pragma unroll
    for (int d0 = 0; d0 < 4; ++d0) o[d0] = f32x16{};
    float mref = 0.f, lsum = 0.f; f32x16 negm;
#pragma unroll
    for (int r = 0; r < 16; ++r) negm[r] = ATT_TGT;
    const int NS = NT >> 2;
    asm volatile("s_waitcnt vmcnt(0)" ::: "memory");
#pragma unroll
    for (int j = 0; j < 4; ++j) ATT_DMA8(j, j);
    ATT_WAIT_BAR(0);
    if (NS > 1) {
#pragma unroll
        for (int j = 0; j < 4; ++j) ATT_DMA8(4 + j, 4 + j);
    }
#define ATT_KFRAG(kb_, kk) cat16(*(const LAS u32x4*)((kb_) + (key0 + (kk)) * 128 + kc0), *(const LAS u32x4*)((kb_) + (key0 + (kk)) * 128 + kc1))
#define ATT_VFRAG(vb_, d0) cat16(*(const LAS u32x4*)((vb_) + ((d0) * 32 + r32) * 64 + vc0), *(const LAS u32x4*)((vb_) + ((d0) * 32 + r32) * 64 + vc1))
#define ATT_QK(kb_, kk) __builtin_amdgcn_mfma_scale_f32_32x32x64_f8f6f4(ATT_KFRAG(kb_, kk), qf, negm, 0, 0, 0, 0x7A7A7A7A, 0, 0x7A7A7A7A)
    {
        const f32x16 s0 = ATT_QK(lds, 0), s1 = ATT_QK(lds, 16);
        float rm = s0[0];
#pragma unroll
        for (int r = 1; r < 16; ++r) rm = fmaxf(rm, s0[r]);
#pragma unroll
        for (int r = 0; r < 16; ++r) rm = fmaxf(rm, s1[r]);
        mref = half_swap_max(rm) - ATT_TGT;
#pragma unroll
        for (int r = 0; r < 16; ++r) negm[r] = ATT_TGT - mref;
    }
    for (int st = 0; st < NS; ++st) {
        if (st > 0) {
            ATT_WAIT_BAR(0);
            if (st + 1 < NS) {
#pragma unroll
                for (int j = 0; j < 4; ++j) ATT_DMA8(4 * (st + 1) + j, ((st + 1) & 1) * 4 + j);
            }
        }
        const LAS unsigned char* sb_ = lds + (st & 1) * 4 * SL;
        v8i pfp = {0, 0, 0, 0, 0, 0, 0, 0};
#pragma unroll
        for (int j = 0; j < 4; ++j) {
            const LAS unsigned char* kb_ = sb_ + j * SL;
            __builtin_amdgcn_s_setprio(1);
            f32x16 s0 = ATT_QK(kb_, 0), s1 = ATT_QK(kb_, 16);
            __builtin_amdgcn_s_setprio(0);
            if (j > 0) { const LAS unsigned char* vp_ = kb_ - SL + VO;
#pragma unroll
                for (int d0 = 0; d0 < 4; ++d0) o[d0] = __builtin_amdgcn_mfma_scale_f32_32x32x64_f8f6f4(pfp, ATT_VFRAG(vp_, d0), o[d0], 0, 0, 0, 0x7F7F7F7F, 0, 0x7F7F7F7F); }
#pragma unroll
            for (int r = 0; r < 16; ++r) { s0[r] = __builtin_amdgcn_exp2f(s0[r]); s1[r] = __builtin_amdgcn_exp2f(s1[r]); }
            float sa = 0.f, sb = 0.f;
#pragma unroll
            for (int r = 0; r < 16; ++r) { sa += s0[r]; sb += s1[r]; }
            sa += sb;
            if (__any(!(sa <= 448.f))) {
                unsigned ko_ = (unsigned)(uintptr_t)kb_; asm volatile("" : "+v"(ko_));
                const LAS unsigned char* kr_ = (const LAS unsigned char*)(uintptr_t)ko_;
                s0 = ATT_QK(kr_, 0); s1 = ATT_QK(kr_, 16);
                float rm = s0[0];
#pragma unroll
                for (int r = 1; r < 16; ++r) rm = fmaxf(rm, s0[r]);
#pragma unroll
                for (int r = 0; r < 16; ++r) rm = fmaxf(rm, s1[r]);
                rm = half_swap_max(rm);
                const float dl = fmaxf(rm - ATT_TGT, 0.f); mref += dl;
#pragma unroll
                for (int r = 0; r < 16; ++r) negm[r] = ATT_TGT - mref;
                const float f = __builtin_amdgcn_exp2f(-dl); lsum *= f;
                if (hi == 0) wsc[r32] = f;
                asm volatile("s_waitcnt lgkmcnt(0)" ::: "memory");
#pragma unroll
                for (int r = 0; r < 16; ++r) { const float fr_ = wsc[crow(r, hi)];
#pragma unroll
                    for (int d0 = 0; d0 < 4; ++d0) o[d0][r] *= fr_; }
                asm volatile("s_waitcnt lgkmcnt(0)" ::: "memory");
#pragma unroll
                for (int r = 0; r < 16; ++r) { s0[r] = __builtin_amdgcn_exp2f(s0[r] - dl); s1[r] = __builtin_amdgcn_exp2f(s1[r] - dl); }
                sa = 0.f; sb = 0.f;
#pragma unroll
                for (int r = 0; r < 16; ++r) { sa += s0[r]; sb += s1[r]; }
                sa += sb;
            }
            lsum += sa;
#pragma unroll
            for (int jj = 0; jj < 4; ++jj) { int w = __builtin_bit_cast(int, s0[4 * jj]); w = __builtin_amdgcn_cvt_pk_fp8_f32(s0[4 * jj], s0[4 * jj + 1], w, false); w = __builtin_amdgcn_cvt_pk_fp8_f32(s0[4 * jj + 2], s0[4 * jj + 3], w, true); pfp[jj] = w;
                int w2 = __builtin_bit_cast(int, s1[4 * jj]); w2 = __builtin_amdgcn_cvt_pk_fp8_f32(s1[4 * jj], s1[4 * jj + 1], w2, false); w2 = __builtin_amdgcn_cvt_pk_fp8_f32(s1[4 * jj + 2], s1[4 * jj + 3], w2, true); pfp[4 + jj] = w2; }
        }
        {
            const LAS unsigned char* vl_ = sb_ + 3 * SL + VO;
#pragma unroll
            for (int d0 = 0; d0 < 4; ++d0) o[d0] = __builtin_amdgcn_mfma_scale_f32_32x32x64_f8f6f4(pfp, ATT_VFRAG(vl_, d0), o[d0], 0, 0, 0, 0x7F7F7F7F, 0, 0x7F7F7F7F);
        }
    }
#undef ATT_KFRAG
#undef ATT_VFRAG
#undef ATT_QK
    const float lt = half_swap_sum(lsum);
    if (hi == 0) wsc[64 + r32] = (c ? -lam : 1.f) * __builtin_amdgcn_rcpf(16.f * lt);
    asm volatile("s_waitcnt lgkmcnt(0)\n\ts_barrier" ::: "memory");
    LAS float* xch = (LAS float*)(lds + qg * 16384);
#pragma unroll
    for (int r = 0; r < 16; ++r) { const float a = wsc[64 + crow(r, hi)];
#pragma unroll
        for (int d0 = 0; d0 < 4; ++d0) o[d0][r] *= a; }
    if (c == 1) {
#pragma unroll
        for (int d0 = 0; d0 < 4; ++d0)
#pragma unroll
            for (int r = 0; r < 16; ++r) xch[(d0 * 16 + r) * 64 + lane] = o[d0][r];
    }
    asm volatile("s_waitcnt lgkmcnt(0)\n\ts_barrier" ::: "memory");
    if (c == 0) {
        constexpr int OB = FP8_ATT_O ? 1 : 2;
        LAS unsigned char* stg = lds + 65536 + qg * 8192;
#pragma unroll
        for (int d0 = 0; d0 < 4; ++d0)
#pragma unroll
            for (int r = 0; r < 16; ++r) o[d0][r] += xch[(d0 * 16 + r) * 64 + lane];
        float ss[16], tt[16];
#pragma unroll
        for (int r = 0; r < 16; ++r) { float x = (o[0][r] * o[0][r] + o[1][r] * o[1][r]) + (o[2][r] * o[2][r] + o[3][r] * o[3][r]);
            x += __builtin_bit_cast(float, __builtin_amdgcn_update_dpp(0, __builtin_bit_cast(int, x), 0xB1, 0xF, 0xF, true));
            x += __builtin_bit_cast(float, __builtin_amdgcn_update_dpp(0, __builtin_bit_cast(int, x), 0x4E, 0xF, 0xF, true));
            x += __builtin_bit_cast(float, __builtin_amdgcn_update_dpp(0, __builtin_bit_cast(int, x), 0x124, 0xF, 0xF, true));
            x += __builtin_bit_cast(float, __builtin_amdgcn_update_dpp(0, __builtin_bit_cast(int, x), 0x128, 0xF, 0xF, true));
            ss[r] = x; }
#pragma unroll
        for (int r = 0; r < 16; ++r) tt[r] = __shfl_xor(ss[r], 16);
#pragma unroll
        for (int r = 0; r < 16; ++r) { const int qr = crow(r, hi); const float rn = __builtin_amdgcn_rsqf((ss[r] + tt[r]) * (1.f / 128.f) + EPS);
#pragma unroll
            for (int d0 = 0; d0 < 4; ++d0) { const float ov = o[d0][r] * rn * sg[d0];
                if (FP8_ATT_O) { const float o4 = clamp8(4.f * ov); *(LAS unsigned char*)(stg + qr * 128 + d0 * 32 + r32) = (unsigned char)(__builtin_amdgcn_cvt_pk_fp8_f32(o4, o4, 0, false) & 0xff); }
                else *(LAS unsigned short*)(stg + (qr * 128 + d0 * 32 + r32) * 2) = (unsigned short)f2bf(ov); } }
        asm volatile("s_waitcnt lgkmcnt(0)" ::: "memory");
        unsigned char* Ob = (unsigned char*)O + ((size_t)(qrow0 + qg * 32) * 1024 + h * 128) * OB;
#pragma unroll
        for (int k = 0; k < 4 * OB; ++k) { const int off = lane * 16 + 1024 * k, row = off / (128 * OB), cb = off % (128 * OB);
            *(u32x4*)(Ob + (size_t)row * 1024 * OB + cb) = *(const LAS u32x4*)(stg + off); }
    }
    asm volatile("s_waitcnt lgkmcnt(0)\n\ts_barrier" ::: "memory");
#undef ATT_DMA8
}
}

#if ATT_FP8
#define ATT_CALL(l_, w_, q_, k_, v_, o_, ...) att::attn_unit8(l_, w_, (const unsigned char*)(q_), (const unsigned char*)(k_), (const unsigned char*)(v_), o_, __VA_ARGS__)
#else
#define ATT_CALL att::attn_unit
#endif
__device__ __forceinline__ void load_row_f32(const float* p, int lane, f32x4 (&v)[4]) {
#pragma unroll
    for (int j = 0; j < 4; ++j) v[j] = *(const f32x4*)(p + 256 * j + 4 * lane);
}
__device__ __forceinline__ void load_row_x(const void* Xb, size_t row, int lane, f32x4 (&v)[4]) {
    if (X_BF16) { const bf16* p = (const bf16*)Xb + row * D;
#pragma unroll
        for (int j = 0; j < 4; ++j) { const u32x2 w = *(const u32x2*)(p + 256 * j + 4 * lane);
            v[j] = (f32x4){bf2f((unsigned short)(w.x & 0xffffu)), bf2f((unsigned short)(w.x >> 16)), bf2f((unsigned short)(w.y & 0xffffu)), bf2f((unsigned short)(w.y >> 16))}; } }
    else load_row_f32((const float*)Xb + row * D, lane, v);
}
__device__ __forceinline__ void store_row_x(void* Xb, size_t row, int lane, const f32x4 (&v)[4]) {
    if (X_BF16) { bf16* p = (bf16*)Xb + row * D;
#pragma unroll
        for (int j = 0; j < 4; ++j) { u32x2 w; w.x = cvt_pk_bf16(v[j][0], v[j][1]); w.y = cvt_pk_bf16(v[j][2], v[j][3]); *(u32x2*)(p + 256 * j + 4 * lane) = w; } }
    else { float* p = (float*)Xb + row * D;
#pragma unroll
        for (int j = 0; j < 4; ++j) *(f32x4*)(p + 256 * j + 4 * lane) = v[j]; }
}
__device__ __forceinline__ float row_rstd(const f32x4 (&v)[4]) {
    float s = 0.f;
#pragma unroll
    for (int j = 0; j < 4; ++j) s += (v[j][0] * v[j][0] + v[j][1] * v[j][1]) + (v[j][2] * v[j][2] + v[j][3] * v[j][3]);
    return 1.0f / sqrtf(wave_sum(s) * (1.f / D) + EPS);
}
__device__ __forceinline__ void norm_mod_store(f32x4 (&v)[4], const float* g, const float* sc, const float* sh, int lane, bf16* hrow) {
    const float rstd = row_rstd(v);
#pragma unroll
    for (int j = 0; j < 4; ++j) { const int c = 256 * j + 4 * lane; const f32x4 gg = *(const f32x4*)(g + c), ss = *(const f32x4*)(sc + c), hh = *(const f32x4*)(sh + c);
        v[j] = (v[j] * rstd) * gg * (ss + 1.f) + hh;
        u32x2 w; w.x = cvt_pk_bf16(v[j][0], v[j][1]); w.y = cvt_pk_bf16(v[j][2], v[j][3]); *(u32x2*)(hrow + c) = w; }
}
__device__ __forceinline__ void norm_mod_f32(f32x4 (&v)[4], const float* g, const float* sc, const float* sh, int lane) {
    const float rstd = row_rstd(v);
#pragma unroll
    for (int j = 0; j < 4; ++j) { const int c = 256 * j + 4 * lane; const f32x4 gg = *(const f32x4*)(g + c), ss = *(const f32x4*)(sc + c), hh = *(const f32x4*)(sh + c);
        v[j] = (v[j] * rstd) * gg * (ss + 1.f) + hh; }
}
__device__ __forceinline__ void norm_mod_store_mix(bool f8, f32x4 (&v)[4], const float* g, const float* sc, const float* sh, int lane, bf16* hrow, unsigned char* h8row) {
    if (f8) { norm_mod_f32(v, g, sc, sh, lane);
#pragma unroll
        for (int j = 0; j < 4; ++j) *(unsigned*)(h8row + 256 * j + 4 * lane) = pack_fp8x4(16.f * v[j][0], 16.f * v[j][1], 16.f * v[j][2], 16.f * v[j][3]); }
    else norm_mod_store(v, g, sc, sh, lane, hrow);
}
__device__ __forceinline__ int row_batch(int row) { return row / RPB; }
__device__ __forceinline__ bool row_is_ctx(int row) { return (row % RPB) < CTXL; }
__device__ __forceinline__ int act_row(int ai, bool lat_only) { return lat_only ? (ai >> 11) * RPB + CTXL + (ai & 2047) : ai; }

template <int MODE>
__device__ __forceinline__ void transpose_item(const float* W, int K, int N, bf16* WT, LAS float* scr, int item, int lane) {
    const int nblk = N / 32, kb = item / nblk, nb = item % nblk, k0 = 64 * kb, n0 = 32 * nb;
#pragma unroll 8
    for (int i = 0; i < 32; ++i) { const int kk = 2 * i + (lane >> 5); scr[kk * 33 + (lane & 31)] = W[(size_t)(k0 + kk) * N + n0 + (lane & 31)]; }
    asm volatile("s_waitcnt lgkmcnt(0)" ::: "memory");
    const int c = lane & 7;
#pragma unroll
    for (int j = 0; j < 4; ++j) { const int n = (lane >> 3) + 8 * j; const LAS float* s = scr + (8 * c) * 33 + n;
        u32x4 o; o.x = cvt_pk_bf16(s[0 * 33], s[1 * 33]); o.y = cvt_pk_bf16(s[2 * 33], s[3 * 33]); o.z = cvt_pk_bf16(s[4 * 33], s[5 * 33]); o.w = cvt_pk_bf16(s[6 * 33], s[7 * 33]);
        int nn = n0 + n;
        if (MODE == 1 && nn < 2048) { const int i6 = nn & 63; nn = (nn & ~63) + (i6 < 32 ? 2 * i6 : 2 * (i6 - 32) + 1); }
        if (MODE == 2 && nn >= 1024) nn = nn < 2048 ? 1024 + 2 * (nn - 1024) : 1024 + 2 * (nn - 2048) + 1;
        *(u32x4*)(WT + (size_t)nn * K + k0 + 8 * c) = o; }
    asm volatile("s_waitcnt lgkmcnt(0)" ::: "memory");
}

template <int MODE = 0>
__device__ __forceinline__ void transpose_item8(const float* W, int K, int N, unsigned char* WT, LAS float* scr, int item, int lane) {
    const int nblk = N / 16, kb = item / nblk, nb = item % nblk, k0 = 128 * kb, n0 = 16 * nb;
    f32x4 v[8];
#pragma unroll
    for (int i = 0; i < 8; ++i) v[i] = *(const f32x4*)(W + (size_t)(k0 + 16 * i + (lane >> 2)) * N + n0 + 4 * (lane & 3));
#pragma unroll
    for (int i = 0; i < 8; ++i) *(LAS f32x4*)(scr + (16 * i + (lane >> 2)) * 20 + 4 * (lane & 3)) = v[i] * 1024.f;
    asm volatile("s_waitcnt lgkmcnt(0)" ::: "memory");
    const int kc = lane & 7;
#pragma unroll
    for (int j = 0; j < 2; ++j) { const int n = (lane >> 3) + 8 * j; const LAS float* s = scr + (16 * kc) * 20 + n;
        u32x4 o;
        o.x = pack_fp8x4(s[0 * 20], s[1 * 20], s[2 * 20], s[3 * 20]); o.y = pack_fp8x4(s[4 * 20], s[5 * 20], s[6 * 20], s[7 * 20]);
        o.z = pack_fp8x4(s[8 * 20], s[9 * 20], s[10 * 20], s[11 * 20]); o.w = pack_fp8x4(s[12 * 20], s[13 * 20], s[14 * 20], s[15 * 20]);
        int nn = n0 + n;
        if (MODE == 1 && nn < 2048) { const int i6 = nn & 63; nn = (nn & ~63) + (i6 < 32 ? 2 * i6 : 2 * (i6 - 32) + 1); }
        *(u32x4*)(WT + (size_t)nn * K + k0 + 16 * kc) = o; }
    asm volatile("s_waitcnt lgkmcnt(0)" ::: "memory");
}

__device__ __forceinline__ void item8_load(const float* W, int N, int item, int lane, f32x4 (&v)[8]) {
    const int nblk = N / 16, kb = item / nblk, nb = item % nblk, k0 = 128 * kb, n0 = 16 * nb;
#pragma unroll
    for (int i = 0; i < 8; ++i) v[i] = *(const f32x4*)(W + (size_t)(k0 + 16 * i + (lane >> 2)) * N + n0 + 4 * (lane & 3));
}
__device__ __forceinline__ void item8_store(const f32x4 (&v)[8], int K, int N, unsigned char* WT, LAS float* scr, int item, int lane) {
    const int nblk = N / 16, kb = item / nblk, nb = item % nblk, k0 = 128 * kb, n0 = 16 * nb;
#pragma unroll
    for (int i = 0; i < 8; ++i) *(LAS f32x4*)(scr + (16 * i + (lane >> 2)) * 20 + 4 * (lane & 3)) = v[i] * 1024.f;
    asm volatile("s_waitcnt lgkmcnt(0)" ::: "memory");
    const int kc = lane & 7;
#pragma unroll
    for (int j = 0; j < 2; ++j) { const int n = (lane >> 3) + 8 * j; const LAS float* s = scr + (16 * kc) * 20 + n;
        u32x4 o;
        o.x = pack_fp8x4(s[0 * 20], s[1 * 20], s[2 * 20], s[3 * 20]); o.y = pack_fp8x4(s[4 * 20], s[5 * 20], s[6 * 20], s[7 * 20]);
        o.z = pack_fp8x4(s[8 * 20], s[9 * 20], s[10 * 20], s[11 * 20]); o.w = pack_fp8x4(s[12 * 20], s[13 * 20], s[14 * 20], s[15 * 20]);
        *(u32x4*)(WT + (size_t)(n0 + n) * K + k0 + 16 * kc) = o; }
    asm volatile("s_waitcnt lgkmcnt(0)" ::: "memory");
}

struct Args { const float* in[21]; float* out; unsigned char* ws; int ph_lo, ph_hi; };
enum { I_X = 0, I_C, I_CTX, I_CCTX, I_MODW, I_MODB, I_NORMG, I_WQKV, I_WO, I_LAM, I_SUBG, I_WIN, I_CONVW, I_WOUT, I_RW, I_RB, I_WGU, I_BGU, I_WD, I_BD, I_FINALG };

__device__ __forceinline__ void moe_table(LAS unsigned char* lds, const unsigned* gcnt, int tid) {
    LAS int* ecnt = (LAS int*)(lds + LX_ECNT); LAS int* tstart = (LAS int*)(lds + LX_TSTART); LAS int* tile_e = (LAS int*)(lds + LX_TILEE);
    __syncthreads();
    if (tid < 32) ecnt[tid] = (int)__hip_atomic_load(gcnt + tid, RLX_AGENT);
    __syncthreads();
    if (tid == 0) { int ts = 0; for (int e = 0; e < 32; ++e) { tstart[e] = ts; ts += (ecnt[e] + 255) >> 8; } tstart[32] = ts; }
    __syncthreads();
    { const int e = tid >> 4, l16 = tid & 15; const int t0 = tstart[e], n = tstart[e + 1] - t0; for (int j = l16; j < n; j += 16) tile_e[t0 + j] = e; }
    __syncthreads();
}

typedef const __attribute__((address_space(4))) unsigned char* kptr_t;
__device__ __forceinline__ kptr_t kargs() { kptr_t p = (kptr_t)__builtin_amdgcn_kernarg_segment_ptr(); asm volatile("" : "+s"(p)); return p; }
#define INP(k) (*(const float* const __attribute__((address_space(4)))*)(kargs() + 8 * (k)))
#define OUTP() (*(float* const __attribute__((address_space(4)))*)(kargs() + 168))
#define WSB() (*(unsigned char* const __attribute__((address_space(4)))*)(kargs() + 176))
#define WSP(T, off) ((T*)(WSB() + (off)))
static_assert(sizeof(Args) == 192, "kernarg layout");
__global__ void __launch_bounds__(NTHREADS, 2) fwd(Args args) {
    extern __shared__ __attribute__((aligned(16))) unsigned char lds_raw[];
    LAS unsigned char* lds = (LAS unsigned char*)lds_raw;
    const int tid = threadIdx.x, lane = tid & 63, wave = __builtin_amdgcn_readfirstlane(tid >> 6);
    const int G = gridDim.x, bid = blockIdx.x;
    const int gw = bid * NWAVES + wave, NGW = G * NWAVES;
    gu32* ctl = (gu32*)WSP(unsigned, WS_CTL);
    for (int u = tid; u < (LDS_BYTES - LX) / 4; u += NTHREADS) ((LAS unsigned*)(lds + LX))[u] = 0u;
    __syncthreads();
    volatile LAS unsigned* MISC = (volatile LAS unsigned*)(lds + LX_MISC);
    XcdBarrier bar; bar.bar = (unsigned*)(ctl + CW_BAR); bar.x = 0; bar.st = nullptr;
    if (!MK_PER_PHASE) bar = xcd_barrier_post((unsigned*)(ctl + CW_BAR), MISC + 8);
    (void)args;
    const unsigned long long pt_start = PROBE_T ? __builtin_amdgcn_s_memtime() : 0ull; (void)pt_start;
    const unsigned long long pt_rstart = PROBE_T ? __builtin_amdgcn_s_memrealtime() : 0ull; (void)pt_rstart;
    const int lo = *(const int __attribute__((address_space(4)))*)(kargs() + 184), hi = *(const int __attribute__((address_space(4)))*)(kargs() + 188);
#define IN(k) (lo <= (k) && (k) < hi)
#define PHASE_IDS int tid = threadIdx.x; asm volatile("" : "+v"(tid)); const int lane = tid & 63, wave = __builtin_amdgcn_readfirstlane(tid >> 6); const int gw = bid * NWAVES + wave; (void)lane; (void)gw;
#define SEAM(k) do { if (IN(k) && IN((k) + 1)) { if (MK_PER_PHASE) { if (tid == 0) __hip_atomic_store(ctl + CW_TMO, 0xBADu, RLX_AGENT); } else { unsigned long long b0_ = 0; if (PROBE_T == 10) b0_ = __builtin_amdgcn_s_memtime(); xcd_barrier(bar); if (PROBE_REP & 0x10000) xcd_barrier(bar); if (PROBE_T == 10 && bid == PROBE_BID && threadIdx.x == 0) *(LAS unsigned long long*)(lds + LX_MISC + 64) += __builtin_amdgcn_s_memtime() - b0_; } } } while (0)

    if (PS(0) && IN(0)) { PHASE_IDS
        float* modv = WSP(float, WS_MODV);
        unsigned long long p0t_ = (PROBE_T == 11 || PROBE_T == 12) ? __builtin_amdgcn_s_memtime() : 0ull; (void)p0t_;
        { LAS float* sil = (LAS float*)lds;
          LAS float* red = (LAS float*)(lds + 69632);
          for (int i = tid; i < 17 * 1024; i += NTHREADS) { const int r = i >> 10, k = i & 1023; const float cv = r < 16 ? INP(I_C)[r * 1024 + k] : INP(I_CCTX)[k]; sil[i] = cv / (1.f + __expf(-cv)); }
          __syncthreads();
          for (int it = bid; it < 4 * 96; it += G) { const int l = it / 96, nb = it % 96; const float* W = INP(I_MODW) + (size_t)l * 1024 * 6144 + nb * 64 + lane;
            float a[17];
#pragma unroll
            for (int r = 0; r < 17; ++r) a[r] = 0.f;
            for (int k = wave * 128; k < wave * 128 + 128; k += 4) { float w[4];
#pragma unroll
                for (int q = 0; q < 4; ++q) w[q] = W[(size_t)(k + q) * 6144];
#pragma unroll
                for (int r = 0; r < 17; ++r) { const f32x4 s = *(const LAS f32x4*)(sil + r * 1024 + k); a[r] += s[0] * w[0] + s[1] * w[1] + s[2] * w[2] + s[3] * w[3]; } }
#pragma unroll
            for (int r = 0; r < 17; ++r) red[(wave * 17 + r) * 64 + lane] = a[r];
            __syncthreads();
            for (int i = tid; i < 17 * 64; i += NTHREADS) { const int r = i >> 6, n = i & 63; float s = INP(I_MODB)[l * 6144 + nb * 64 + n];
#pragma unroll
                for (int w8 = 0; w8 < 8; ++w8) s += red[(w8 * 17 + r) * 64 + n];
                modv[((size_t)l * 17 + r) * 6144 + nb * 64 + n] = s; }
            __syncthreads(); }
        }
        if (PROBE_T == 11 && bid == 0 && tid == 0) *(LAS unsigned long long*)(lds + LX_MISC + 64) += __builtin_amdgcn_s_memtime() - p0t_;
        { float* cosT = WSP(float, WS_ROPE); float* sinT = cosT + 2048 * 32; float* rwT = WSP(float, WS_RW); float* lamv = WSP(float, WS_MISC);
        for (int i = bid * NTHREADS + tid; i < 2048 * 32; i += G * NTHREADS) { const int t = i >> 5, j = i & 31; const float pos = (float)(j < 16 ? (t >> 6) : (t & 63));
            const float inv = powf(10000.f, -(float)(2 * (j & 15)) / 32.f); const float ang = pos * inv; cosT[i] = cosf(ang); sinT[i] = sinf(ang); }
        if (bid == 0 && tid < 2) { const float* lp = INP(I_LAM) + tid * 256; float s1 = 0.f, s2 = 0.f; for (int d = 0; d < 64; ++d) { s1 += lp[d] * lp[64 + d]; s2 += lp[128 + d] * lp[192 + d]; }
            const float lam_init = 0.8f - 0.6f * expf(-0.3f * (float)(2 * tid)); lamv[tid] = expf(s1) - expf(s2) + lam_init; lamv[2 + tid] = 1.f - lam_init; }
        for (int i = bid * NTHREADS + tid; i < 4 * 32 * 1024; i += G * NTHREADS) { const int l = i >> 15, e = (i >> 10) & 31, k = i & 1023; rwT[i] = INP(I_RW)[((size_t)l * 1024 + k) * 32 + e]; } }
        if (PROBE_T == 12) p0t_ = __builtin_amdgcn_s_memtime();
        { LAS float* scr = (LAS float*)(lds + wave * 10240);
          bf16* Wqkv_t = WSP(bf16, WS_WQKV); bf16* Win_t = WSP(bf16, WS_WIN); bf16* Wo_t = WSP(bf16, WS_WO); bf16* Wout_t = WSP(bf16, WS_WOUT); bf16* Wgu_t = WSP(bf16, WS_WGU); bf16* Wd_t = WSP(bf16, WS_WD);
          constexpr int I_QKV = 16 * 96, I_SQ = 16 * 32, I_GU = 16 * 64, I_D = 16 * 32;
          constexpr int T0 = 2 * I_QKV, T1 = T0 + 2 * I_QKV, T2 = T1 + 2 * I_SQ, T3 = T2 + 2 * I_SQ, T4 = T3 + 128 * I_GU, T5 = T4 + 128 * I_D;
          for (int rep = 0; rep < NREP(0); ++rep) {
          for (int it = gw; it < (MOE_FP8 ? T3 : T5); it += NGW) {
            if (it < T0) { const int j = it / I_QKV; if (FP8_ATT) transpose_item8<1>(INP(I_WQKV) + (size_t)j * 1024 * 3072, 1024, 3072, (unsigned char*)Wqkv_t + (size_t)j * 3072 * 1024, scr, it % I_QKV, lane); else transpose_item<1>(INP(I_WQKV) + (size_t)j * 1024 * 3072, 1024, 3072, Wqkv_t + (size_t)j * 3072 * 1024, scr, it % I_QKV, lane); }
            else if (it < T1) { const int r = it - T0, j = r / I_QKV; if (FP8_CONV) transpose_item8<0>(INP(I_WIN) + (size_t)j * 1024 * 3072, 1024, 3072, (unsigned char*)Win_t + (size_t)j * 3072 * 1024, scr, r % I_QKV, lane); else transpose_item<CONV_FUSE_U ? 2 : 0>(INP(I_WIN) + (size_t)j * 1024 * 3072, 1024, 3072, Win_t + (size_t)j * 3072 * 1024, scr, r % I_QKV, lane); }
            else if (it < T2) { const int r = it - T1, j = r / I_SQ; if (FP8_ATT_O) transpose_item8<0>(INP(I_WO) + (size_t)j * 1024 * 1024, 1024, 1024, (unsigned char*)Wo_t + (size_t)j * 1024 * 1024, scr, r % I_SQ, lane); else transpose_item<0>(INP(I_WO) + (size_t)j * 1024 * 1024, 1024, 1024, Wo_t + (size_t)j * 1024 * 1024, scr, r % I_SQ, lane); }
            else if (it < T3) { const int r = it - T2, j = r / I_SQ; if (FP8_CONV) transpose_item8<0>(INP(I_WOUT) + (size_t)j * 1024 * 1024, 1024, 1024, (unsigned char*)Wout_t + (size_t)j * 1024 * 1024, scr, r % I_SQ, lane); else transpose_item<0>(INP(I_WOUT) + (size_t)j * 1024 * 1024, 1024, 1024, Wout_t + (size_t)j * 1024 * 1024, scr, r % I_SQ, lane); }
            else if (it < T4) { const int r = it - T3, j = r / I_GU; transpose_item<0>(INP(I_WGU) + (size_t)j * 1024 * 2048, 1024, 2048, Wgu_t + (size_t)j * 2048 * 1024, scr, r % I_GU, lane); }
            else { const int r = it - T4, j = r / I_D; transpose_item<0>(INP(I_WD) + (size_t)j * 1024 * 1024, 1024, 1024, Wd_t + (size_t)j * 1024 * 1024, scr, r % I_D, lane); }
          }
          if (MOE_FP8) {
            constexpr int NGUI = 128 * I_GU, NMOE = NGUI + 128 * I_D;
            const float* wgu = INP(I_WGU); const float* wd = INP(I_WD);
#define MOE_DEC(r_, W_, N_, WT_, IT_) do { if ((r_) < NGUI) { const int j_ = (r_) / I_GU; W_ = wgu + (size_t)j_ * 1024 * 2048; N_ = 2048; WT_ = (unsigned char*)Wgu_t + (size_t)j_ * 2048 * 1024; IT_ = (r_) % I_GU; } \
              else { const int q_ = (r_) - NGUI, j_ = q_ / I_D; W_ = wd + (size_t)j_ * 1024 * 1024; N_ = 1024; WT_ = (unsigned char*)Wd_t + (size_t)j_ * 1024 * 1024; IT_ = q_ % I_D; } } while (0)
            f32x4 vc[8], vn[8]; const float* Wc = nullptr; int Nc = 0, itc = 0; unsigned char* WTc = nullptr;
            int r = gw;
            if (r < NMOE) { MOE_DEC(r, Wc, Nc, WTc, itc); item8_load(Wc, Nc, itc, lane, vc); }
            for (; r < NMOE; r += NGW) { const int rn = r + NGW; const bool hn = rn < NMOE; const float* Wn = Wc; int Nn = Nc, itn = itc; unsigned char* WTn = WTc;
                if (hn) { MOE_DEC(rn, Wn, Nn, WTn, itn); item8_load(Wn, Nn, itn, lane, vn); }
                item8_store(vc, 1024, Nc, WTc, scr, itc, lane);
                if (hn) { Wc = Wn; Nc = Nn; itc = itn; WTc = WTn;
#pragma unroll
                    for (int i = 0; i < 8; ++i) vc[i] = vn[i]; } }
#undef MOE_DEC
          }
          }
        }
        if (PROBE_T == 12 && bid == 0 && tid == 0) *(LAS unsigned long long*)(lds + LX_MISC + 64) += __builtin_amdgcn_s_memtime() - p0t_;
        __syncthreads();
    }
    SEAM(0);

    if (PS(1) && IN(1)) { PHASE_IDS
        const float* g = INP(I_NORMG); const float* modv = WSP(float, WS_MODV); float* X = WSP(float, WS_X); bf16* H = WSP(bf16, WS_H);
        for (int row = gw; row < M; row += NGW) { const int b = row_batch(row), jj = row % RPB; const bool cx = jj < CTXL; const int rb = cx ? 16 : b;
            const float* src = cx ? INP(I_CTX) + ((size_t)b * CTXL + jj) * D : INP(I_X) + ((size_t)b * SEQ + (jj - CTXL)) * D;
            f32x4 v[4]; load_row_f32(src, lane, v);
            norm_mod_store_mix(FP8_ATT != 0, v, g, modv + rb * 6144 + 1024, modv + rb * 6144, lane, H + (size_t)row * D, WSP(unsigned char, WS_H8) + (size_t)row * 1024); }
    }
    SEAM(1);

    for (int l = 0; l < DEPTH; ++l) {
        const int pb = 2 + 7 * l; const bool attn = (l & 1) == 0; const int j2 = l >> 1; const bool lat_only = (l == DEPTH - 1);
#define MV() (WSP(float, WS_MODV) + (size_t)l * 17 * 6144)
        const unsigned* gcnt = (const unsigned*)(ctl + CW_CNT) + l * 32;

        if (IN(pb)) { PHASE_IDS
            if (PS(2) && attn) {
                constexpr int RBX = FP8_ATT ? 1024 : 2048; constexpr int SCX = FP8_ATT ? 0x78787878 : 0;
                typedef SchedQKV<RBX, SCX> SQ;
                SQ S{FP8_ATT ? (const char*)WSP(unsigned char, WS_H8) : (const char*)WSP(bf16, WS_H), (const char*)WSP(bf16, WS_WQKV) + (size_t)j2 * 3072 * RBX};
                EpiQKV E{WSP(bf16, WS_Q), WSP(bf16, WS_K), WSP(bf16, WS_VT), WSP(float, WS_ROPE), WSP(float, WS_ROPE) + 2048 * 32, true, lds + LX_EPI};
                for (int rep = 0; rep < NREP(2); ++rep) { int z_ = rep; asm volatile("" : "+s"(z_)); E.dost = !PROBE_NOST || (z_ == NREP(2) - 1); pg8::gemm_phase<EpiQKV, SQ, 2>(lds, S, E, tid, STAG(1500)); }
            } else if (PS(3)) {
                constexpr int RBX = FP8_CONV ? 1024 : 2048; constexpr int SCX = FP8_CONV ? 0x78787878 : 0;
                typedef SchedPlain<RBX, SCX> SP;
                SP S{FP8_CONV ? (const char*)WSP(unsigned char, WS_H8) : (const char*)WSP(bf16, WS_H), (const char*)WSP(bf16, WS_WIN) + (size_t)j2 * 3072 * RBX, 12, lat_only};
                if (CONV_FUSE_U) { EpiConvIn E{WSP(bf16, WS_BCO), WSP(bf16, WS_BCO) + (size_t)M * 1024};
                    for (int rep = 0; rep < NREP(3); ++rep) pg8::gemm_phase<EpiConvIn, SP, 3>(lds, S, E, tid, STAG(1500)); }
                else { EpiPlain E{WSP(bf16, WS_BCO), 3072};
                    for (int rep = 0; rep < NREP(3); ++rep) pg8::gemm_phase<EpiPlain, SP, 3>(lds, S, E, tid, STAG(1500)); }
            }
        }
        SEAM(pb);

        if (IN(pb + 1)) { PHASE_IDS
            if (PS(4) && attn) {
                const float* lamv = WSP(float, WS_MISC); const float lam = lamv[j2], osc = lamv[2 + j2]; const float* subg = INP(I_SUBG) + j2 * 128;
                const bf16* Qb = WSP(bf16, WS_Q); const bf16* Kb = WSP(bf16, WS_K); const bf16* Vt = WSP(bf16, WS_VT); bf16* Ob = WSP(bf16, WS_O);
                LAS float* wsc = (LAS float*)(lds + LX_WSC + wave * 1024);
                const int vcu = (G % 8 == 0) ? (bid % 8) * (G / 8) + bid / 8 : bid;
                for (int rep = 0; rep < NREP(4); ++rep)
                if (G == 256) {
                    const int xc = bid & 7, j = bid >> 3;
                    for (int sstep = 0; sstep < 8; ++sstep) { const int bh = xc * 16 + 2 * sstep + (j >> 4), b = bh >> 3, h = bh & 7;
                        ATT_CALL(lds, wsc, Qb, Kb, Vt, Ob, b * RPB, h, b * RPB + CTXL + (j & 15) * 128, 36, lam, osc, subg, tid); }
                    { const int bh = xc * 16 + (j >> 1), b = bh >> 3, h = bh & 7;
                      ATT_CALL(lds, wsc, Qb, Kb, Vt, Ob, b * RPB, h, b * RPB + (j & 1) * 128, 4, lam, osc, subg, tid); }
                } else {
                    for (int u = bid; u < 128 * 18; u += G) { const int bh = u / 18, k = u % 18, b = bh >> 3, h = bh & 7;
                        ATT_CALL(lds, wsc, Qb, Kb, Vt, Ob, b * RPB, h, k < 16 ? b * RPB + CTXL + k * 128 : b * RPB + (k - 16) * 128, k < 16 ? 36 : 4, lam, osc, subg, tid); }
                }
            } else if (PS(5)) {
                const float* cw = INP(I_CONVW) + (size_t)j2 * 3 * 1024; const bf16* BCO = WSP(bf16, WS_BCO); bf16* Ob = WSP(bf16, WS_O);
                const int nact = lat_only ? 32768 : M; const int nitems = (nact / 16) * 2;
                for (int it = gw; it < nitems; it += NGW) { const int strip = it >> 1, ch = (it & 1) * 512 + lane * 8; const int row0 = act_row(strip * 16, lat_only);
                    const int jj = row0 % RPB; const int seq_lo = jj < CTXL ? row0 - jj : row0 - jj + CTXL, seq_hi = jj < CTXL ? row0 - jj + CTXL : row0 - jj + RPB;
                    float w0[8], w1[8], w2[8];
#pragma unroll
                    for (int q = 0; q < 8; ++q) { w0[q] = cw[ch + q]; w1[q] = cw[1024 + ch + q]; w2[q] = cw[2048 + ch + q]; }
                    float up[8], uc[8], un[8];
                    auto load_u = [&](int row, float (&u)[8]) {
                        if (row < seq_lo || row >= seq_hi) {
#pragma unroll
                            for (int q = 0; q < 8; ++q) u[q] = 0.f;
                        } else if (CONV_FUSE_U) { const u32x4 uu = *(const u32x4*)(BCO + (size_t)M * 1024 + (size_t)row * 1024 + ch);
#pragma unroll
                            for (int q = 0; q < 4; ++q) { u[2 * q] = bf2f((unsigned short)(uu[q] & 0xffffu)); u[2 * q + 1] = bf2f((unsigned short)(uu[q] >> 16)); }
                        } else { const bf16* p = BCO + (size_t)row * 3072; const u32x4 gc = *(const u32x4*)(p + 1024 + ch), xt = *(const u32x4*)(p + 2048 + ch);
#pragma unroll
                            for (int q = 0; q < 4; ++q) { u[2 * q] = bf2f((unsigned short)(gc[q] & 0xffffu)) * bf2f((unsigned short)(xt[q] & 0xffffu)); u[2 * q + 1] = bf2f((unsigned short)(gc[q] >> 16)) * bf2f((unsigned short)(xt[q] >> 16)); } } };
                    load_u(row0 - 1, up); load_u(row0, uc);
                    for (int r = 0; r < 16; ++r) { const int row = row0 + r; load_u(row + 1, un);
                        const u32x4 gb = *(const u32x4*)(BCO + (size_t)row * (CONV_FUSE_U ? 1024 : 3072) + ch); float z[8];
#pragma unroll
                        for (int q = 0; q < 8; ++q) { const float gbv = bf2f((unsigned short)((q & 1) ? (gb[q >> 1] >> 16) : (gb[q >> 1] & 0xffffu))); z[q] = gbv * (w0[q] * up[q] + w1[q] * uc[q] + w2[q] * un[q]); }
                        if (FP8_CONV) { u32x2 o; o.x = pack_fp8x4(4.f * z[0], 4.f * z[1], 4.f * z[2], 4.f * z[3]); o.y = pack_fp8x4(4.f * z[4], 4.f * z[5], 4.f * z[6], 4.f * z[7]); *(u32x2*)((unsigned char*)Ob + (size_t)row * 1024 + ch) = o; }
                        else { u32x4 o; o.x = cvt_pk_bf16(z[0], z[1]); o.y = cvt_pk_bf16(z[2], z[3]); o.z = cvt_pk_bf16(z[4], z[5]); o.w = cvt_pk_bf16(z[6], z[7]);
                        *(u32x4*)(Ob + (size_t)row * 1024 + ch) = o; }
#pragma unroll
                        for (int q = 0; q < 8; ++q) { up[q] = uc[q]; uc[q] = un[q]; } } }
            }
        }
        SEAM(pb + 1);

        if (PS(6) && IN(pb + 2)) { PHASE_IDS
            float* X = WSP(float, WS_X);
            EpiResid E{X, X, MV() + 2 * 1024, l == 0 ? INP(I_X) : nullptr, l == 0 ? INP(I_CTX) : nullptr};
            if (attn) { constexpr int RBX = FP8_ATT_O ? 1024 : 2048; constexpr int SCX = FP8_ATT_O ? 0x79797979 : 0;
                typedef SchedPlain<RBX, SCX> SP;
                SP S{(const char*)WSP(bf16, WS_O), (const char*)WSP(bf16, WS_WO) + (size_t)j2 * 1024 * RBX, 4, lat_only};
                pg8::gemm_phase<EpiResid, SP, 6>(lds, S, E, tid, STAG(1500));
            } else { constexpr int RBX = FP8_CONV ? 1024 : 2048; constexpr int SCX = FP8_CONV ? 0x79797979 : 0;
                typedef SchedPlain<RBX, SCX> SP;
                SP S{(const char*)WSP(bf16, WS_O), (const char*)WSP(bf16, WS_WOUT) + (size_t)j2 * 1024 * RBX, 4, lat_only};
                pg8::gemm_phase<EpiResid, SP, 6>(lds, S, E, tid, STAG(1500));
            }
        }
        SEAM(pb + 2);

        if (PS(7) && IN(pb + 3)) { PHASE_IDS
            LAS int* lcnt = (LAS int*)(lds + LX_LCNT); LAS int* lbase = (LAS int*)(lds + LX_LBASE); LAS int* asg = (LAS int*)(lds + LX_ASG);
            LAS float* wsc = (LAS float*)(lds + LX_WSC + wave * 1024);
            LAS unsigned char* tile = lds;
            LAS float* part = (LAS float*)(lds + 65536);
            float* X = WSP(float, WS_X); bf16* H = WSP(bf16, WS_H); const float* mv = MV(); int* topE = WSP(int, WS_TOPE); float* topG = WSP(float, WS_TOPG); int* topP = WSP(int, WS_TOPP); int* list = WSP(int, WS_LIST);
            const int r32 = lane & 31, hi = lane >> 5;
            bf16x8 wf[8];
            { const float* rw = WSP(float, WS_RW) + (size_t)l * 32 * 1024 + r32 * 1024 + wave * 128 + hi * 8;
#pragma unroll
              for (int s8 = 0; s8 < 8; ++s8) { const f32x4 a = *(const f32x4*)(rw + 16 * s8), b = *(const f32x4*)(rw + 16 * s8 + 4); wf[s8] = __builtin_bit_cast(bf16x8, pack8(a, b)); } }
            __syncthreads();
            if (tid < 32) lcnt[tid] = 0;
            __syncthreads();
            const int nact = lat_only ? 32768 : M; const int rpb = (nact + G - 1) / G; const int a0 = bid * rpb; int nr = nact - a0; nr = nr < 0 ? 0 : (nr > rpb ? rpb : nr);
            const float* g = INP(I_NORMG) + ((size_t)l * 2 + 1) * 1024; const float* rb_ = INP(I_RB) + l * 32;
            for (int g0 = 0; g0 < nr; g0 += 32) {
                f32x4 v[4][4]; int rowq[4]; bool okq[4];
#pragma unroll
                for (int q = 0; q < 4; ++q) { const int i = g0 + wave + 8 * q; okq[q] = i < nr; rowq[q] = act_row(a0 + (okq[q] ? i : nr - 1), lat_only); load_row_x(X, (size_t)rowq[q], lane, v[q]); }
#pragma unroll
                for (int q = 0; q < 4; ++q) { const int row = rowq[q]; const int rb = row_is_ctx(row) ? 16 : row_batch(row); const int tr = wave + 8 * q;
                    norm_mod_f32(v[q], g, mv + rb * 6144 + 4 * 1024, mv + rb * 6144 + 3 * 1024, lane);
                    if (MOE_FP8) { unsigned char* h8 = WSP(unsigned char, WS_H8) + (size_t)row * 1024;
#pragma unroll
                        for (int j = 0; j < 4; ++j) { const unsigned pk_ = pack_fp8x4(16.f * v[q][j][0], 16.f * v[q][j][1], 16.f * v[q][j][2], 16.f * v[q][j][3]); if (okq[q]) *(unsigned*)(h8 + 256 * j + 4 * lane) = pk_; } }
#pragma unroll
                    for (int j = 0; j < 4; ++j) { u32x2 w; w.x = cvt_pk_bf16(v[q][j][0], v[q][j][1]); w.y = cvt_pk_bf16(v[q][j][2], v[q][j][3]);
                        if (!MOE_FP8 && okq[q]) *(u32x2*)(H + (size_t)row * D + 256 * j + 4 * lane) = w;
                        const int ch = 32 * j + (lane >> 1); *(LAS u32x2*)(tile + tr * 2048 + ((ch ^ (tr & 15)) << 4) + (lane & 1) * 8) = w; } }
                __syncthreads();
                { f32x16 acc = f32x16{};
#pragma unroll
                  for (int s8 = 0; s8 < 8; ++s8) { const int ch = wave * 16 + 2 * s8 + hi; const bf16x8 bfr = *(const LAS bf16x8*)(tile + r32 * 2048 + ((ch ^ (r32 & 15)) << 4));
                      acc = __builtin_amdgcn_mfma_f32_32x32x16_bf16(wf[s8], bfr, acc, 0, 0, 0); }
#pragma unroll
                  for (int r = 0; r < 16; ++r) { const int e = (r & 3) + 8 * (r >> 2) + 4 * hi; part[(wave * 32 + e) * 33 + r32] = acc[r]; } }
                __syncthreads();
#pragma unroll 1
                for (int q = 0; q < 4; ++q) { const int tr = wave + 8 * q; const int i = g0 + tr; const int row = rowq[q]; const int my_e = r32;
                    float lg = rb_[my_e];
#pragma unroll
                    for (int w8 = 0; w8 < 8; ++w8) lg += part[(w8 * 32 + my_e) * 33 + tr];
                    if (lane < 32) wsc[my_e] = lg;
                    asm volatile("s_waitcnt lgkmcnt(0)" ::: "memory");
                    int rank = 0;
#pragma unroll
                    for (int e = 0; e < 32; ++e) { const float o = wsc[e]; rank += (o > lg || (o == lg && e < my_e)) ? 1 : 0; }
                    asm volatile("s_waitcnt lgkmcnt(0)" ::: "memory");
                    if (lane < 32 && rank < 4) { wsc[64 + rank] = lg; ((LAS int*)wsc)[72 + rank] = my_e; }
                    asm volatile("s_waitcnt lgkmcnt(0)" ::: "memory");
                    const float t0 = wsc[64], t1 = wsc[65], t2 = wsc[66], t3 = wsc[67];
                    const float p0 = 1.f, p1 = __expf(t1 - t0), p2 = __expf(t2 - t0), p3 = __expf(t3 - t0); const float inv = 1.f / (p0 + p1 + p2 + p3);
                    if (lane < 4 && okq[q]) { const int e = ((LAS int*)wsc)[72 + lane]; const float p = lane == 0 ? p0 : lane == 1 ? p1 : lane == 2 ? p2 : p3;
                        const int lp = __hip_atomic_fetch_add(lcnt + e, 1, __ATOMIC_RELAXED, __HIP_MEMORY_SCOPE_WORKGROUP);
                        topE[row * 4 + lane] = e; topG[row * 4 + lane] = p * inv; asg[i * 4 + lane] = (lp << 5) | e; }
                    asm volatile("s_waitcnt lgkmcnt(0)" ::: "memory");
                }
            }
            __syncthreads();
            if (tid < 32) lbase[tid] = (int)__hip_atomic_fetch_add((unsigned*)gcnt + tid, (unsigned)lcnt[tid], RLX_AGENT);
            __syncthreads();
            for (int i = tid; i < nr * 4; i += NTHREADS) { const int av = asg[i], e = av & 31, pos = lbase[e] + (av >> 5); const int row = act_row(a0 + (i >> 2), lat_only);
                list[(size_t)e * CAP + pos] = row; topP[row * 4 + (i & 3)] = pos; }
            __syncthreads();
        }
        SEAM(pb + 3);

        if (PS(8) && IN(pb + 4)) { PHASE_IDS
            moe_table(lds, gcnt, tid);
            constexpr int RBM = MOE_FP8 ? 1024 : 2048;
            typedef SchedMoe<true, RBM, 0x78787878, 0x78787878> SG;
            SG S{(const char*)(MOE_FP8 ? (void*)WSP(unsigned char, WS_H8) : (void*)WSP(bf16, WS_H)), (const char*)WSP(bf16, WS_WGU) + (size_t)l * 32 * 2048 * RBM, WSP(int, WS_LIST), 8, (size_t)2048 * RBM,
                 (LAS const int*)(lds + LX_TSTART), (LAS const int*)(lds + LX_ECNT), (LAS const int*)(lds + LX_TILEE)};
            EpiSwiglu<MOE_FP8 != 0> E{WSP(bf16, WS_ACT), INP(I_BGU) + (size_t)l * 32 * 2048, lds + LX_EPI};
            pg8::gemm_phase<EpiSwiglu<MOE_FP8 != 0>, SG, 8>(lds, S, E, tid, STAG(900));
        }
        SEAM(pb + 4);

        if (PS(9) && IN(pb + 5)) { PHASE_IDS
            if (MK_PER_PHASE || lo == pb + 5) moe_table(lds, gcnt, tid);
            constexpr int RBM = MOE_FP8 ? 1024 : 2048;
            typedef SchedMoe<false, RBM, 0x79797979, 0x79797979> SD;
            SD S{(const char*)WSP(bf16, WS_ACT), (const char*)WSP(bf16, WS_WD) + (size_t)l * 32 * 1024 * RBM, WSP(int, WS_LIST), 4, (size_t)1024 * RBM,
                 (LAS const int*)(lds + LX_TSTART), (LAS const int*)(lds + LX_ECNT), (LAS const int*)(lds + LX_TILEE)};
            EpiDown E{WSP(bf16, WS_Y), INP(I_BD) + (size_t)l * 32 * 1024, lds + LX_EPI};
            pg8::gemm_phase<EpiDown, SD, 9>(lds, S, E, tid, STAG(1100));
            if (PROBE_T && l == DEPTH - 1 && bid == (PROBE_T == 10 ? PROBE_BID : 0) && tid == 0) { unsigned long long acc_ = *(LAS unsigned long long*)(lds + LX_MISC + 64); unsigned long long tot_ = __builtin_amdgcn_s_memtime() - pt_start;
                if (PROBE_T == 9) { acc_ = tot_; tot_ = (__builtin_amdgcn_s_memrealtime() - pt_rstart) * 30ull; }
                WSP(float, WS_MISC)[16] = floorf((float)((double)acc_ / (double)tot_) * PROBE_TQ + 0.5f) / PROBE_TQ; }
        }
        SEAM(pb + 5);

        if (PS(10) && IN(pb + 6)) { PHASE_IDS
            if (MK_PER_PHASE || lo >= pb + 5) moe_table(lds, gcnt, tid);
            LAS const int* tstart = (LAS const int*)(lds + LX_TSTART);
            const int nact = lat_only ? 32768 : M;
            const float* gn = (l + 1 < DEPTH) ? INP(I_NORMG) + (size_t)(l + 1) * 2 * 1024 : INP(I_FINALG);
            const float* mv = MV(); const float* mvn = mv + 17 * 6144; float* X = WSP(float, WS_X); bf16* H = WSP(bf16, WS_H); const bf16* Yb = WSP(bf16, WS_Y);
            const int* topE = WSP(int, WS_TOPE); const float* topG = WSP(float, WS_TOPG); const int* topP = WSP(int, WS_TOPP);
            for (int ai = gw; ai < nact; ai += 2 * NGW) {
                int row[2]; bool ok[2]; int4 ev[2], pv[2]; f32x4 gv[2];
#pragma unroll
                for (int u = 0; u < 2; ++u) { const int a2 = ai + u * NGW; ok[u] = a2 < nact; row[u] = act_row(ok[u] ? a2 : ai, lat_only);
                    ev[u] = *(const int4*)(topE + row[u] * 4); pv[u] = *(const int4*)(topP + row[u] * 4); gv[u] = *(const f32x4*)(topG + row[u] * 4); }
                f32x4 v[2][4]; u32x2 yw[2][4][4];
#pragma unroll
                for (int u = 0; u < 2; ++u) { load_row_x(X, (size_t)row[u], lane, v[u]);
                    const int ee[4] = {ev[u].x, ev[u].y, ev[u].z, ev[u].w}, pp[4] = {pv[u].x, pv[u].y, pv[u].z, pv[u].w};
#pragma unroll
                    for (int k = 0; k < 4; ++k) { const size_t yrow = (size_t)(tstart[ee[k]] * 256 + pp[k]);
#pragma unroll
                        for (int j = 0; j < 4; ++j) { if (Y_FP8) { yw[u][k][j].x = *(const unsigned*)((const unsigned char*)Yb + yrow * 1024 + 256 * j + 4 * lane); yw[u][k][j].y = 0u; }
                            else yw[u][k][j] = *(const u32x2*)(Yb + yrow * 1024 + 256 * j + 4 * lane); } } }
#pragma unroll
                for (int u = 0; u < 2; ++u) { if (!ok[u]) continue;
                    const int rw_ = row[u]; const bool cx = row_is_ctx(rw_); const int rb = cx ? 16 : row_batch(rw_);
                    f32x4 acc4[4];
#pragma unroll
                    for (int j = 0; j < 4; ++j) acc4[j] = (f32x4){0.f, 0.f, 0.f, 0.f};
#pragma unroll
                    for (int k = 0; k < 4; ++k) { const float gk = gv[u][k];
#pragma unroll
                        for (int j = 0; j < 4; ++j) { const u32x2 w = yw[u][k][j];
                            if (Y_FP8) { const f32x2 lo = __builtin_amdgcn_cvt_pk_f32_fp8((int)w.x, false), hi2 = __builtin_amdgcn_cvt_pk_f32_fp8((int)w.x, true); const float g16 = gk * (1.f / 16.f);
                                acc4[j][0] += g16 * lo[0]; acc4[j][1] += g16 * lo[1]; acc4[j][2] += g16 * hi2[0]; acc4[j][3] += g16 * hi2[1]; }
                            else { acc4[j][0] += gk * bf2f((unsigned short)(w.x & 0xffffu)); acc4[j][1] += gk * bf2f((unsigned short)(w.x >> 16)); acc4[j][2] += gk * bf2f((unsigned short)(w.y & 0xffffu)); acc4[j][3] += gk * bf2f((unsigned short)(w.y >> 16)); } } }
                    const float* g2 = mv + rb * 6144 + 5 * 1024;
#pragma unroll
                    for (int j = 0; j < 4; ++j) { const f32x4 gg = *(const f32x4*)(g2 + 256 * j + 4 * lane); v[u][j] = v[u][j] + gg * acc4[j]; }
                    if (l + 1 < DEPTH) {
                        store_row_x(X, (size_t)rw_, lane, v[u]);
                        if (!(l + 1 == DEPTH - 1 && cx))
                            norm_mod_store_mix(((l + 1) & 1) ? (FP8_CONV != 0) : (FP8_ATT != 0), v[u], gn, mvn + rb * 6144 + 1024, mvn + rb * 6144, lane, H + (size_t)rw_ * D, WSP(unsigned char, WS_H8) + (size_t)rw_ * 1024);
                    } else {
                        float rstd = row_rstd(v[u]); if (PROBE_T) rstd *= 1.f + sqrtf(WSP(float, WS_MISC)[16]); float* op = OUTP() + ((size_t)row_batch(rw_) * SEQ + (rw_ % RPB - CTXL)) * D;
#pragma unroll
                        for (int j = 0; j < 4; ++j) { const f32x4 gg = *(const f32x4*)(gn + 256 * j + 4 * lane); *(f32x4*)(op + 256 * j + 4 * lane) = (v[u][j] * rstd) * gg; }
                    }
                }
            }
        }
        if (l + 1 < DEPTH) SEAM(pb + 6);
    }
#undef IN
#undef SEAM
#undef MV
}

extern "C" void kernel_launch(void* const* d_in, const int* in_sizes, int n_in, void* d_out, int out_size, void* d_ws, size_t ws_size, hipStream_t stream) {
    static int grid = 0;
    if (grid == 0) {
        if (n_in != 21 || out_size != NB * SEQ * D || ws_size < WS_END) { fprintf(stderr, "kernel_launch: unexpected shapes (n_in %d, out %d, ws %zu)\n", n_in, out_size, ws_size); grid = -1; return; }
        int dev = 0, cus = 0, per_cu = 0;
        if (hipGetDevice(&dev) != hipSuccess || hipDeviceGetAttribute(&cus, hipDeviceAttributeMultiprocessorCount, dev) != hipSuccess) { grid = -1; return; }
        if (hipFuncSetAttribute((const void*)fwd, hipFuncAttributeMaxDynamicSharedMemorySize, LDS_BYTES) != hipSuccess) { fprintf(stderr, "kernel_launch: hipFuncSetAttribute failed\n"); grid = -1; return; }
        if (hipOccupancyMaxActiveBlocksPerMultiprocessor(&per_cu, (const void*)fwd, NTHREADS, LDS_BYTES) != hipSuccess || per_cu < 1) { fprintf(stderr, "kernel_launch: occupancy query says %d\n", per_cu); }
        (void)hipGetLastError();
        if (cus < 160) { fprintf(stderr, "kernel_launch: needs >= 160 CUs\n"); grid = -1; return; }
        grid = cus;
    }
    if (grid < 0) return;
    if (hipMemsetAsync((char*)d_ws + WS_CTL, 0, CTL_ZERO_BYTES, stream) != hipSuccess) return;
    Args a{};
    for (int i = 0; i < 21; ++i) a.in[i] = (const float*)d_in[i];
    a.out = (float*)d_out; a.ws = (unsigned char*)d_ws;
#if MK_PER_PHASE
    for (int p = 0; p < NPHASE; ++p) { a.ph_lo = p; a.ph_hi = p + 1; hipLaunchKernelGGL(fwd, dim3(grid), dim3(NTHREADS), LDS_BYTES, stream, a); }
#else
    a.ph_lo = 0; a.ph_hi = NPHASE;
    hipLaunchKernelGGL(fwd, dim3(grid), dim3(NTHREADS), LDS_BYTES, stream, a);
#endif
    const hipError_t le = hipPeekAtLastError();
    if (le != hipSuccess) fprintf(stderr, "kernel_launch: launch failed: %s\n", hipGetErrorName(le));
}
```

```cpp
#include <hip/hip_runtime.h>
#include <cstdio>
#include <cstdint>

#ifndef MK_PER_PHASE
#define MK_PER_PHASE 0
#endif

#ifndef MOE_FP8
#define MOE_FP8 1
#endif
#ifndef STAGGER
#define STAGGER 0
#endif
#define STAG(t) (STAGGER ? (t) : 0)
#ifndef PROBE_T
#define PROBE_T 0
#endif
#ifndef PROBE_TQ
#define PROBE_TQ 30.f
#endif
#ifndef ATT_PROBE_TID
#define ATT_PROBE_TID 0
#endif
#ifndef PROBE_BID
#define PROBE_BID 0
#endif
#ifndef PROBE_TPH
#define PROBE_TPH 8
#endif
#ifndef FP8_ATT
#define FP8_ATT 1
#endif
#ifndef FP8_ATT_O
#define FP8_ATT_O 1
#endif
#ifndef FP8_CONV
#define FP8_CONV 0
#endif
#ifndef X_BF16
#define X_BF16 1
#endif
#ifndef Y_FP8
#define Y_FP8 1
#endif
#ifndef CONV_FUSE_U
#define CONV_FUSE_U 1
#endif
#ifndef ATT_FP8
#define ATT_FP8 1
#endif
#ifndef PHSEL
#define PHSEL 0xffff
#endif
#define PS(k) ((PHSEL >> (k)) & 1)
#ifndef PROBE_REP
#define MOE_XCD_RANGE 1
#define PROBE_REP 0
#endif
#define NREP(k) (1 + ((PROBE_REP >> (k)) & 1))
#ifndef PROBE_NOST
#define PROBE_NOST 0
#endif
#define GAS __attribute__((address_space(1)))
#define LAS __attribute__((address_space(3)))
typedef unsigned short bf16;
typedef short bf16x8 __attribute__((ext_vector_type(8)));
typedef float f32x4 __attribute__((ext_vector_type(4)));
typedef float f32x2 __attribute__((ext_vector_type(2)));
typedef float f32x16 __attribute__((ext_vector_type(16)));
typedef unsigned u32x4 __attribute__((ext_vector_type(4)));
typedef unsigned u32x2 __attribute__((ext_vector_type(2)));
typedef GAS unsigned gu32;

constexpr int D = 1024, NB = 16, SEQ = 2048, CTXL = 256, RPB = SEQ + CTXL, M = NB * RPB, DEPTH = 4;
constexpr int NE = 32, TOPK = 4, NMOD = 6;
constexpr int CAP = M;
constexpr int ACT_ROWS = M * TOPK + NE * 256;
constexpr float EPS = 1e-5f;
constexpr float C2 = 0.125f * 1.4426950408889634f;
constexpr int NPHASE = 2 + 7 * DEPTH;
static_assert(!(FP8_CONV && CONV_FUSE_U), "the fused u epilogue needs the (bf16) interleaved copy of conv_w_in");

constexpr size_t MiB = 1u << 20;
constexpr size_t WS_CTL = 0, CTL_ZERO_BYTES = 1 * MiB;
constexpr size_t WS_MODV = 1 * MiB;
constexpr size_t WS_ROPE = 3 * MiB;
constexpr size_t WS_RW = 4 * MiB;
constexpr size_t WS_MISC = 5 * MiB;
constexpr size_t WS_TOPE = 6 * MiB;
constexpr size_t WS_TOPG = 7 * MiB;
constexpr size_t WS_TOPP = 8 * MiB;
constexpr size_t WS_LIST = 9 * MiB;
constexpr size_t WS_WQKV = 16 * MiB;
constexpr size_t WS_WIN = 28 * MiB;
constexpr size_t WS_WO = 40 * MiB;
constexpr size_t WS_WOUT = 44 * MiB;
constexpr size_t WS_WGU = 48 * MiB;
constexpr size_t WS_WD = 560 * MiB;
constexpr size_t WS_X = 816 * MiB;
constexpr size_t WS_H = 960 * MiB;
constexpr size_t WS_Q = 1032 * MiB;
constexpr size_t WS_K = 1104 * MiB;
constexpr size_t WS_VT = 1176 * MiB;
constexpr size_t WS_BCO = WS_Q;
constexpr size_t WS_O = 1248 * MiB;
constexpr size_t WS_ACT = 1320 * MiB;
constexpr size_t WS_Y = 1624 * MiB;
constexpr size_t WS_H8 = 1928 * MiB;
constexpr size_t WS_END = 1964 * MiB;
static_assert((size_t)M * 3072 * 2 == 216 * MiB && (size_t)ACT_ROWS * 2048 == 304 * MiB && (size_t)M * 4096 == 144 * MiB, "ws map");

constexpr int CW_TMO = 0;
constexpr int CW_BAR = 4096;
constexpr int CW_CNT = 16384;

constexpr int RING_BYTES = 131072;
constexpr int LX = RING_BYTES;
constexpr int LX_MISC = LX + 0;
constexpr int LX_TSTART = LX + 256;
constexpr int LX_ECNT = LX + 512;
constexpr int LX_LCNT = LX + 640;
constexpr int LX_LBASE = LX + 768;
constexpr int LX_TILEE = LX + 1024;
constexpr int LX_WSC = LX + 4096;
constexpr int LX_ASG = LX + 12288;
constexpr int LX_EPI = LX + 16384;
constexpr int LDS_BYTES = LX + 32768;
constexpr int NWAVES = 8, NTHREADS = 512;

#define RLX_AGENT __ATOMIC_RELAXED, __HIP_MEMORY_SCOPE_AGENT
__device__ __forceinline__ unsigned f2bf(float f) { unsigned u = __builtin_bit_cast(unsigned, f); return (u + 0x7fffu + ((u >> 16) & 1u)) >> 16; }
typedef __bf16 bf16x2_t __attribute__((ext_vector_type(2)));
__device__ __forceinline__ unsigned cvt_pk_bf16(float lo, float hi) { const f32x2 v = {lo, hi}; const bf16x2_t b = __builtin_convertvector(v, bf16x2_t); return __builtin_bit_cast(unsigned, b); }
__device__ __forceinline__ float bf2f(unsigned short b) { return __builtin_bit_cast(float, (unsigned)b << 16); }
__device__ __forceinline__ float wave_sum(float v) {
    v += __builtin_bit_cast(float, __builtin_amdgcn_update_dpp(0, __builtin_bit_cast(int, v), 0xB1, 0xF, 0xF, true));
    v += __builtin_bit_cast(float, __builtin_amdgcn_update_dpp(0, __builtin_bit_cast(int, v), 0x4E, 0xF, 0xF, true));
    v += __builtin_bit_cast(float, __builtin_amdgcn_update_dpp(0, __builtin_bit_cast(int, v), 0x124, 0xF, 0xF, true));
    v += __builtin_bit_cast(float, __builtin_amdgcn_update_dpp(0, __builtin_bit_cast(int, v), 0x128, 0xF, 0xF, true));
    v += __shfl_xor(v, 16);
    auto rr = __builtin_amdgcn_permlane32_swap(__float_as_uint(v), __float_as_uint(v), false, false);
    return __uint_as_float(rr[0]) + __uint_as_float(rr[1]);
}

#define XB_TMO      128
#define XB_XCNT(j)  (256  + 64 * (j))
#define XB_XSUB(j)  (1280 + 64 * (j))
#define XB_XGEN(j)  (2304 + 64 * (j))
#define XB_TOP      3328
#define XB_TOPGEN   3392
#define XCD_BAR_WORDS 3456
#define XB_SPIN_CAP (1u << 18)
__device__ __forceinline__ unsigned xb_ld(unsigned* p)              { return __hip_atomic_load(p, __ATOMIC_RELAXED, __HIP_MEMORY_SCOPE_AGENT); }
__device__ __forceinline__ unsigned xb_add(unsigned* p, unsigned v) { return __hip_atomic_fetch_add(p, v, __ATOMIC_RELAXED, __HIP_MEMORY_SCOPE_AGENT); }
__device__ __forceinline__ unsigned xb_xcc_id() { return (unsigned)__builtin_amdgcn_s_getreg((3 << 11) | 20) & 0xFu; }
#define XB_SPIN(cond, bar) do { unsigned _sp = 0; while (cond) { __builtin_amdgcn_s_sleep(1); \
    if ((++_sp & 255u) == 0u) { if (xb_ld(&(bar)[XB_TMO])) break; if (_sp > XB_SPIN_CAP) { atomicAdd(&(bar)[XB_TMO], 1u); break; } } } } while (0)
struct XcdBarrier { unsigned* bar; unsigned x; volatile LAS unsigned* st; };
__device__ __forceinline__ XcdBarrier xcd_barrier_post(unsigned* bar, volatile LAS unsigned* st) {
    XcdBarrier b; b.bar = bar; b.x = xb_xcc_id(); b.st = st;
    if (threadIdx.x == 0) (void)xb_add(&bar[XB_XCNT(b.x)], 1u);
    return b;
}
__device__ __forceinline__ void xcd_barrier_complete(unsigned* bar, unsigned x, unsigned& nloc, unsigned& nx) {
    const unsigned G = gridDim.x * gridDim.y * gridDim.z;
    unsigned sum, cnt, mine, sp = 0u;
    for (;;) {
        sum = 0u; cnt = 0u; mine = 0u;
#pragma unroll
        for (unsigned j = 0; j < 16; ++j) { const unsigned c = xb_ld(&bar[XB_XCNT(j)]); sum += c; cnt += (c > 0u) ? 1u : 0u; mine = (j == x) ? c : mine; }
        if (sum == G) break;
        __builtin_amdgcn_s_sleep(1);
        if ((++sp & 255u) == 0u) { if (xb_ld(&bar[XB_TMO])) break; if (sp > XB_SPIN_CAP) { atomicAdd(&bar[XB_TMO], 1u); break; } }
    }
    nloc = mine > 0u ? mine : 1u; nx = cnt > 0u ? cnt : 1u;
}
__device__ __forceinline__ void xcd_barrier(const XcdBarrier& b) {
    asm volatile("s_waitcnt vmcnt(0)" ::: "memory");
    __syncthreads();
    if (threadIdx.x == 0) {
        unsigned* bar = b.bar; unsigned bx = b.x;
        asm volatile("" : "+s"(bar), "+s"(bx));
        __builtin_amdgcn_s_waitcnt(0);
        unsigned nloc = b.st[0], nx = b.st[1];
        if (nloc == 0u) { xcd_barrier_complete(bar, bx, nloc, nx); b.st[0] = nloc; b.st[1] = nx; }
        const unsigned old = xb_add(&bar[XB_XSUB(bx)], 1u);
        const unsigned gen = old / nloc;
        if (old + 1u == (gen + 1u) * nloc) {
            __builtin_amdgcn_fence(__ATOMIC_RELEASE, "agent");
            asm volatile("s_waitcnt vmcnt(0)" ::: "memory");
            const unsigned og = xb_add(&bar[XB_TOP], 1u);
            const unsigned tg = og / nx;
            if (og + 1u == (tg + 1u) * nx) xb_add(&bar[XB_TOPGEN], 1u);
            else XB_SPIN(xb_ld(&bar[XB_TOPGEN]) == tg, bar);
            __builtin_amdgcn_fence(__ATOMIC_ACQUIRE, "agent");
            xb_add(&bar[XB_XGEN(bx)], 1u);
            asm volatile("s_waitcnt vmcnt(0)" ::: "memory");
        } else {
            XB_SPIN(xb_ld(&bar[XB_XGEN(bx)]) == gen, bar);
            __builtin_amdgcn_fence(__ATOMIC_ACQUIRE, "agent");
            asm volatile("s_waitcnt vmcnt(0)" ::: "memory");
        }
    }
    __syncthreads();
}

namespace pg8 {
constexpr int BM = 256, BK = 64, HALF = 128, HTB = HALF * BK * 2, STAGE_BYTES = 8 * HTB, KD = 1024;
__host__ __device__ __forceinline__ int lds_byte(int r, int c) { const int st = (r >> 4) * 2 + (c >> 5), rr = r & 15, cc = c & 31, ob = rr * 64 + cc * 2; return st * 1024 + (ob ^ (((ob >> 9) & 1) << 5)); }
__host__ __device__ __forceinline__ void stage_rc(int b, int& R, int& C) { const int st = b / 1024, sb = b % 1024, swz = sb ^ (((sb >> 9) & 1) << 5); R = (st >> 1) * 16 + swz / 64; C = (st & 1) * 32 + (swz % 64) / 2; }
__host__ __device__ __forceinline__ int perm32(int rho) { const int n = rho >> 4, i = rho & 15; return 8 * (i >> 2) + 4 * n + (i & 3); }

struct Unit { int pm, pn, e, kind; };
typedef int v8i __attribute__((ext_vector_type(8)));
typedef int v4i __attribute__((ext_vector_type(4)));
__device__ __forceinline__ v8i cat8(bf16x8 lo, bf16x8 hi) { const v4i a = __builtin_bit_cast(v4i, lo), b = __builtin_bit_cast(v4i, hi); return __builtin_shufflevector(a, b, 0, 1, 2, 3, 4, 5, 6, 7); }

__device__ __forceinline__ bool deal(int i, int npu, int ntiles, int& mt, int& r) {
    const int G = gridDim.x, c = blockIdx.x;
    if ((G & 7) == 0) { const int x = c & 7, q = i * (G >> 3) + (c >> 3); mt = (q / npu) * 8 + x; r = q % npu; }
    else { const int L = i * G + c; mt = L / npu; r = L % npu; }
    return mt < ntiles;
}

__device__ __forceinline__ void mfma8(f32x4& acc, const v8i a, const v8i b, int sc) {
    asm volatile("v_mfma_scale_f32_16x16x128_f8f6f4 %0, %1, %2, %0, %3, %3 op_sel_hi:[0,0,0]" : "+v"(acc) : "v"(a), "v"(b), "v"(sc)); }
__device__ __forceinline__ void glds16s(const char* sbase, unsigned voff, unsigned lds_dst) { unsigned keep;
    asm volatile("s_mov_b32 %0, m0\n\ts_mov_b32 m0, %3\n\ts_nop 0\n\tglobal_load_lds_dwordx4 %1, %2\n\ts_mov_b32 m0, %0" : "=&s"(keep) : "v"(voff), "s"(sbase), "s"(lds_dst) : "memory"); }
template <class Epi, class Sched, int PH = 0>
__device__ __forceinline__ void gemm_phase(LAS unsigned char* lds, const Sched& S, const Epi& E, const int tid, const int stagger_ticks = 0) {
    const int wid = __builtin_amdgcn_readfirstlane(tid >> 6), lane = tid & 63, wr = wid >> 2, wc = wid & 3, fr = lane & 15, fq = lane >> 4;
    constexpr int RB = Sched::RB, nt = RB / 128;
    constexpr bool F8 = (RB == 1024);
    unsigned voffB[2];
#pragma unroll
    for (int i = 0; i < 2; ++i) { int R_, C_; stage_rc(tid * 16 + i * 8192, R_, C_); const int Rb = (R_ & ~31) + perm32(R_ & 31); voffB[i] = (unsigned)(Rb * RB + C_ * 2); }
    constexpr bool GA = Sched::GATHER;
    constexpr int NH = GA ? 2 : 1;
    constexpr size_t kstep = (size_t)(BK * 2);
    constexpr size_t hstep = (size_t)HALF * RB, bstep = hstep;
    const unsigned ldsw = (unsigned)wid * 1024u, lds0 = (unsigned)(uintptr_t)lds;
    const int aoff = lds_byte(wr * 64 + fr, fq * 8), boff = lds_byte(wc * 32 + fr, fq * 8);
#define PG8_SA(b, h) (((b) * 2 + (h)) * HTB)
#define PG8_SB(b, h) ((4 + (b) * 2 + (h)) * HTB)
#define PG8_STAGE(bufoff, gbase, voff) do { _Pragma("unroll") for (int _i = 0; _i < 2; ++_i) \
        glds16s((const char*)(gbase), (voff)[_i], (unsigned)__builtin_amdgcn_readfirstlane(lds0 + (unsigned)(bufoff) + ldsw + _i * 8192u)); } while (0)
#define PG8_LDA(dst, b, h) do { _Pragma("unroll") for (int m = 0; m < 4; ++m) _Pragma("unroll") for (int k = 0; k < 2; ++k) dst[m][k] = *(const LAS bf16x8*)(lds + PG8_SA(b, h) + aoff + m * 2048 + k * 1024); } while (0)
#define PG8_LDB(dst, b, h) do { _Pragma("unroll") for (int n = 0; n < 2; ++n) _Pragma("unroll") for (int k = 0; k < 2; ++k) dst[n][k] = *(const LAS bf16x8*)(lds + PG8_SB(b, h) + boff + n * 2048 + k * 1024); } while (0)
#define PG8_MMA(ai, bj, At, Bt) do { __builtin_amdgcn_s_setprio(1); _Pragma("unroll") for (int m = 0; m < 4; ++m) _Pragma("unroll") for (int n = 0; n < 2; ++n) { \
        if constexpr (F8) mfma8(acc[ai][bj][m][n], cat8(Bt[n][0], Bt[n][1]), cat8(At[m][0], At[m][1]), sc8); \
        else { _Pragma("unroll") for (int k = 0; k < 2; ++k) acc[ai][bj][m][n] = __builtin_amdgcn_mfma_f32_16x16x32_bf16(Bt[n][k], At[m][k], acc[ai][bj][m][n], 0, 0, 0); } } __builtin_amdgcn_s_setprio(0); } while (0)
#define PG8_WAIT_V(n) asm volatile("s_waitcnt vmcnt(" #n ")" ::: "memory")
#define PG8_WAIT_VF do { if (fe) { if constexpr (Epi::NST == 16 && !PROBE_NOST) PG8_WAIT_V(24); else if constexpr (Epi::NST == 4 && !PROBE_NOST) PG8_WAIT_V(12); else if constexpr (Epi::NST == 8 && !PROBE_NOST) PG8_WAIT_V(16); else PG8_WAIT_V(8); } else PG8_WAIT_V(8); } while (0)
#define PG8_WAIT_L(n) asm volatile("s_waitcnt lgkmcnt(" #n ")" ::: "memory")
#define PG8_BAR __builtin_amdgcn_s_barrier()
#define PG8_SCHED __builtin_amdgcn_sched_barrier(0)
    Unit cur, nxt; int ui = 0;
    if (!S.next(0, cur)) return;
#define PT_ON(r) (PROBE_T == (r) && PH == PROBE_TPH)
#define PT_BEG(r) do { if (PT_ON(r)) pt0_ = __builtin_amdgcn_s_memtime(); } while (0)
#define PT_END(r) do { if (PT_ON(r)) { const unsigned long long d_ = __builtin_amdgcn_s_memtime() - pt0_; if (blockIdx.x == 0 && tid == 0) *(LAS unsigned long long*)(lds + LX_MISC + 64) += d_; } } while (0)
    unsigned long long pt0_ = 0; (void)pt0_;
    PT_BEG(3);
    if (stagger_ticks > 0 && (int)(blockIdx.x >> 3) >= (int)(gridDim.x >> 4)) { const unsigned long long t0_ = __builtin_amdgcn_s_memrealtime(); while ((long long)(__builtin_amdgcn_s_memrealtime() - t0_) < (long long)stagger_ticks) __builtin_amdgcn_s_sleep(16); }
    static_assert(Sched::SCALE_A == Sched::SCALE_B, "one scale register");
    int sc8 = Sched::SCALE_A; asm volatile("" : "+v"(sc8));
    f32x4 acc[2][2][4][2];
#pragma unroll
    for (int a = 0; a < 2; ++a)
#pragma unroll
        for (int b = 0; b < 2; ++b)
#pragma unroll
            for (int m = 0; m < 4; ++m)
#pragma unroll
                for (int n = 0; n < 2; ++n) acc[a][b][m][n] = (f32x4){0.f, 0.f, 0.f, 0.f};
    bf16x8 At[4][2], B0[2][2], B1[2][2];
    constexpr int NI = GA ? 1 : 2;
    unsigned vC[NH][NI], vN[NH][NI];
    unsigned cb2[2];
#pragma unroll
    for (int i = 0; i < 2; ++i) { int R_, C_; stage_rc(tid * 16 + i * 8192, R_, C_); cb2[i] = (unsigned)(C_ * 2); }
    const unsigned idx_slot = (unsigned)__builtin_amdgcn_readfirstlane((unsigned)(uintptr_t)(lds + LX_WSC) + (unsigned)wid * 1024u);
    if constexpr (GA) { S.idx_dma(cur, lane, idx_slot); asm volatile("s_waitcnt vmcnt(0)" ::: "memory"); S.a_offs_lds(cur, tid, vC, (LAS const int*)(lds + LX_WSC + wid * 1024)); }
    else S.a_offs(cur, tid, vC);
    const unsigned bias_slot0 = (unsigned)(uintptr_t)(lds + LX_ASG);
    if constexpr (Epi::BIAS_DMA) { if (wid == 0) glds16s((const char*)E.bias_src(cur), (unsigned)lane * 16u, (unsigned)__builtin_amdgcn_readfirstlane(bias_slot0)); }
#define PG8_HA(h) (GA ? 0 : (h) * hstep)
#define PG8_VH(v, h) (v)[GA ? (h) : 0]
#define PG8_STAGE_A(bufoff, gbase, vv) do { _Pragma("unroll") for (int _i = 0; _i < 2; ++_i) { unsigned o_; if constexpr (GA) o_ = (((vv)[0] >> (16 * _i)) & 0xffffu) * (unsigned)RB + cb2[_i]; else o_ = (vv)[NI - 2 + _i]; \
        glds16s((const char*)(gbase), o_, (unsigned)__builtin_amdgcn_readfirstlane(lds0 + (unsigned)(bufoff) + ldsw + _i * 8192u)); } } while (0)
    const char* cA = S.a_base(cur); const char* cB = S.b_base(cur);
    PG8_STAGE(PG8_SB(0, 0), cB, voffB); PG8_STAGE(PG8_SB(0, 1), cB + bstep, voffB); PG8_STAGE_A(PG8_SA(0, 0), cA, vC[0]); PG8_STAGE_A(PG8_SA(0, 1), cA + PG8_HA(1), PG8_VH(vC, 1));
    if (wr == 1) PG8_BAR;
    PG8_WAIT_V(2); PG8_BAR;
    PG8_STAGE(PG8_SB(1, 0), cB + kstep, voffB); PG8_STAGE_A(PG8_SA(1, 0), cA + kstep, vC[0]); PG8_STAGE(PG8_SB(1, 1), cB + bstep + kstep, voffB);
    PG8_WAIT_V(6); PG8_BAR;
    for (;;) {
        const bool has_next = S.next(ui + 1, nxt);
        const char* nA = cA; const char* nB = cB;
#pragma unroll
        for (int h = 0; h < NH; ++h)
#pragma unroll
            for (int i = 0; i < NI; ++i) vN[h][i] = vC[h][i];
        if (has_next) { if constexpr (GA) S.idx_dma(nxt, lane, idx_slot); else S.a_offs(nxt, tid, vN); nA = S.a_base(nxt); nB = S.b_base(nxt); }
        if constexpr (Epi::BIAS_DMA) { if (ui > 0 && wid == 0) glds16s((const char*)E.bias_src(cur), (unsigned)lane * 16u, (unsigned)__builtin_amdgcn_readfirstlane(bias_slot0 + (unsigned)(ui & 1) * 1024u)); }
        PT_BEG(2);
#pragma unroll 1
        for (int t = 0; t < nt; t += 2) {
            const bool last = (t == nt - 2);
            const char* a1 = cA + (size_t)(t + 1) * kstep;
            const char* a2 = last ? nA : cA + (size_t)(t + 2) * kstep; const char* b2 = last ? nB : cB + (size_t)(t + 2) * kstep;
            const char* a3 = a2 + kstep; const char* b3 = b2 + kstep;
            if constexpr (GA) { if (last && has_next) S.a_offs_lds(nxt, tid, vN, (LAS const int*)(lds + LX_WSC + wid * 1024)); }
            unsigned w0[NI], w1[NI];
#pragma unroll
            for (int i = 0; i < NI; ++i) { w0[i] = last ? vN[0][i] : vC[0][i]; w1[i] = last ? PG8_VH(vN, 1)[i] : PG8_VH(vC, 1)[i]; }
            const bool fe = (t == 0) && (ui > 0);
            PG8_LDB(B0, 0, 0); PG8_LDB(B1, 0, 1); PG8_SCHED; PG8_LDA(At, 0, 0); if (!fe) PG8_STAGE_A(PG8_SA(1, 1), a1 + PG8_HA(1), PG8_VH(vC, 1));
            PG8_WAIT_VF; PG8_WAIT_L(0); PG8_BAR; PG8_MMA(0, 0, At, B0); PG8_MMA(0, 1, At, B1); PG8_BAR; PG8_SCHED;
            PG8_LDA(At, 0, 1); PG8_STAGE(PG8_SB(0, 0), b2, voffB); PG8_STAGE(PG8_SB(0, 1), b2 + bstep, voffB); PG8_STAGE_A(PG8_SA(0, 0), a2, w0);
            PG8_WAIT_VF; PG8_WAIT_L(0); PG8_BAR; PG8_MMA(1, 0, At, B0); PG8_MMA(1, 1, At, B1); PG8_BAR; PG8_SCHED;
            PG8_LDB(B0, 1, 0); PG8_LDB(B1, 1, 1); PG8_SCHED; PG8_LDA(At, 1, 0); PG8_STAGE_A(PG8_SA(0, 1), a2 + PG8_HA(1), w1);
            PG8_WAIT_VF; PG8_WAIT_L(0); PG8_BAR; PG8_MMA(0, 0, At, B0); PG8_MMA(0, 1, At, B1); PG8_BAR; PG8_SCHED;
            PG8_LDA(At, 1, 1); PG8_STAGE(PG8_SB(1, 0), b3, voffB); PG8_STAGE(PG8_SB(1, 1), b3 + bstep, voffB); PG8_STAGE_A(PG8_SA(1, 0), a3, w0);
            PG8_WAIT_V(8); PG8_WAIT_L(0); PG8_BAR; PG8_MMA(1, 0, At, B0); PG8_MMA(1, 1, At, B1); PG8_BAR; PG8_SCHED;
        }
        PT_END(2);
        if (has_next) PG8_STAGE_A(PG8_SA(1, 1), nA + kstep + PG8_HA(1), PG8_VH(vN, 1));
        if (wr == 0) PG8_BAR;
        PT_BEG(1);
        if constexpr (Epi::BIAS_DMA) E(acc, cur, wr, wc, fr, fq, (LAS const float*)(lds + LX_ASG + (ui & 1) * 1024)); else E(acc, cur, wr, wc, fr, fq);
        PT_END(1);
        if (!has_next) break;
#pragma unroll
        for (int a = 0; a < 2; ++a)
#pragma unroll
            for (int b = 0; b < 2; ++b)
#pragma unroll
                for (int m = 0; m < 4; ++m)
#pragma unroll
                    for (int n = 0; n < 2; ++n) acc[a][b][m][n] = (f32x4){0.f, 0.f, 0.f, 0.f};
        cur = nxt; cA = nA; cB = nB; ++ui;
#pragma unroll
        for (int h = 0; h < NH; ++h)
#pragma unroll
            for (int i = 0; i < NI; ++i) vC[h][i] = vN[h][i];
        if (wr == 1) PG8_BAR;
    }
    PG8_WAIT_V(0);
    PG8_BAR;
    PT_END(3);
#undef PT_ON
#undef PT_BEG
#undef PT_END
#undef PG8_SA
#undef PG8_HA
#undef PG8_VH
#undef PG8_SB
#undef PG8_STAGE
#undef PG8_STAGE_A
#undef PG8_LDA
#undef PG8_LDB
#undef PG8_MMA
#undef PG8_WAIT_V
#undef PG8_WAIT_VF
#undef PG8_WAIT_L
#undef PG8_BAR
#undef PG8_SCHED
}
}
using pg8::Unit;

__device__ __forceinline__ int tile_row0(int mt, bool lat_only) { return lat_only ? ((mt >> 3) * 9 + 1 + (mt & 7)) * 256 : mt * 256; }

template <int RB_, int SC_> struct SchedQKV {
    static constexpr int RB = RB_, SCALE_A = SC_, SCALE_B = SC_;
    const char* H; const char* Wt;
    __device__ __forceinline__ bool next(int i, Unit& u) const { int mt, r; if (!pg8::deal(i, 12, M / 256, mt, r)) return false;
        if (r < 8) { u.kind = 0; u.pm = mt; u.pn = r; } else { u.kind = 1; u.pm = r - 8; u.pn = mt; } u.e = 0; return true; }
    static constexpr bool GATHER = false;
    __device__ __forceinline__ void a_offs(const Unit& u, int tid, unsigned (&v)[1][2]) const {
#pragma unroll
        for (int i = 0; i < 2; ++i) { int R, C; pg8::stage_rc(tid * 16 + i * 8192, R, C); v[0][i] = (unsigned)((u.pm * 256 + R) * RB + C * 2); } }
    __device__ __forceinline__ const char* a_base(const Unit& u) const { return u.kind == 0 ? H : Wt + (size_t)2048 * RB; }
    __device__ __forceinline__ const char* b_base(const Unit& u) const { return (u.kind == 0 ? Wt : H) + (size_t)u.pn * 256 * RB; }
};
template <int RB_, int SC_> struct SchedPlain {
    static constexpr int RB = RB_, SCALE_A = SC_, SCALE_B = SC_;
    const char* A; const char* Bt; int npu; bool lat_only;
    __device__ __forceinline__ bool next(int i, Unit& u) const { int mt, r; if (!pg8::deal(i, npu, lat_only ? 128 : 144, mt, r)) return false;
        u.pm = tile_row0(mt, lat_only) >> 8; u.pn = r; u.e = 0; u.kind = 0; return true; }
    static constexpr bool GATHER = false;
    __device__ __forceinline__ void a_offs(const Unit& u, int tid, unsigned (&v)[1][2]) const {
#pragma unroll
        for (int i = 0; i < 2; ++i) { int R, C; pg8::stage_rc(tid * 16 + i * 8192, R, C); v[0][i] = (unsigned)((u.pm * 256 + R) * RB + C * 2); } }
    __device__ __forceinline__ const char* a_base(const Unit&) const { return A; }
    __device__ __forceinline__ const char* b_base(const Unit& u) const { return Bt + (size_t)u.pn * 256 * RB; }
};
template <bool GATHER_, int RB_, int SA_, int SB_> struct SchedMoe {
    static constexpr bool GATHER = GATHER_;
    static constexpr int RB = RB_, SCALE_A = SA_, SCALE_B = SB_;
    const char* A; const char* Wt; const int* list; int npu; size_t estride;
    LAS const int* tstart; LAS const int* ecnt; LAS const int* tile_e;
    __device__ __forceinline__ bool mdeal(int i, int ntl, int& mt, int& r) const {
        const int G = gridDim.x, c = blockIdx.x;
        if (MOE_XCD_RANGE && (G & 7) == 0) { const int x = c & 7, q = i * (G >> 3) + (c >> 3); const int lo = (x * ntl) >> 3, hi = ((x + 1) * ntl) >> 3; mt = lo + q / npu; r = q % npu; return mt < hi; }
        return pg8::deal(i, npu, ntl, mt, r); }
    __device__ __forceinline__ bool next(int i, Unit& u) const { int mt, r; const int ntl = __builtin_amdgcn_readfirstlane(tstart[32]);
        int xp = 0;
        if (!mdeal(i, ntl, mt, r)) { if (!(PROBE_REP & (GATHER_ ? 0x100 : 0x200))) return false; int n_i = 0; while (mdeal(n_i, ntl, mt, r)) ++n_i; if (i >= 2 * n_i || !mdeal(i - n_i, ntl, mt, r)) return false; xp = 1; }
        u.pm = mt; u.pn = r; u.e = __builtin_amdgcn_readfirstlane(tile_e[mt]); u.kind = xp; return true; }
    __device__ __forceinline__ void idx_dma(const Unit& u, int lane, unsigned slot) const {
        const int j0 = (u.pm - __builtin_amdgcn_readfirstlane(tstart[u.e])) * 256;
        pg8::glds16s((const char*)(list + (size_t)u.e * CAP + j0), (unsigned)lane * 16u, slot); }
    __device__ __forceinline__ void a_offs_lds(const Unit& u, int tid, unsigned (&v)[2][1], LAS const int* slot) const {
        const int j0 = (u.pm - __builtin_amdgcn_readfirstlane(tstart[u.e])) * 256, cnt = __builtin_amdgcn_readfirstlane(ecnt[u.e]);
#pragma unroll
        for (int h = 0; h < 2; ++h) { unsigned pk = 0;
#pragma unroll
            for (int i = 0; i < 2; ++i) { int R, C; pg8::stage_rc(tid * 16 + i * 8192, R, C); const int r = h * 128 + R; const unsigned tok = (j0 + r) < cnt ? (unsigned)slot[r] : 0u; pk |= tok << (16 * i); }
            v[h][0] = pk; }
    }
    __device__ __forceinline__ void a_offs(const Unit& u, int tid, unsigned (&v)[GATHER_ ? 2 : 1][GATHER_ ? 1 : 2]) const {
        if constexpr (GATHER_) { const int j0 = (u.pm - __builtin_amdgcn_readfirstlane(tstart[u.e])) * 256, cnt = __builtin_amdgcn_readfirstlane(ecnt[u.e]); const int* lp = list + (size_t)u.e * CAP;
#pragma unroll
            for (int h = 0; h < 2; ++h) { unsigned pk = 0;
#pragma unroll
                for (int i = 0; i < 2; ++i) { int R, C; pg8::stage_rc(tid * 16 + i * 8192, R, C); const int idx = j0 + h * 128 + R; const unsigned tok = idx < cnt ? (unsigned)lp[idx] : 0u; pk |= tok << (16 * i); }
                v[h][0] = pk; }
        } else {
#pragma unroll
            for (int i = 0; i < 2; ++i) { int R, C; pg8::stage_rc(tid * 16 + i * 8192, R, C); v[0][i] = (unsigned)((u.pm * 256 + R) * RB + C * 2); } }
    }
    __device__ __forceinline__ const char* a_base(const Unit&) const { return A; }
    __device__ __forceinline__ const char* b_base(const Unit& u) const { return Wt + (size_t)u.e * estride + (size_t)u.pn * 256 * RB; }
};

#define EPI_LOOP_ROWS for (int ai = 0; ai < 2; ++ai) _Pragma("unroll") for (int m = 0; m < 4; ++m)
__device__ __forceinline__ u32x4 pack8(const f32x4& v0, const f32x4& v1) { u32x4 w; w.x = cvt_pk_bf16(v0[0], v0[1]); w.y = cvt_pk_bf16(v0[2], v0[3]); w.z = cvt_pk_bf16(v1[0], v1[1]); w.w = cvt_pk_bf16(v1[2], v1[3]); return w; }

__device__ __forceinline__ float clamp8(float v) { return fminf(fmaxf(v, -448.f), 448.f); }
__device__ __forceinline__ unsigned pack_fp8x4(float a, float b, float c, float d) {
    int w = 0; w = __builtin_amdgcn_cvt_pk_fp8_f32(clamp8(a), clamp8(b), w, false); w = __builtin_amdgcn_cvt_pk_fp8_f32(clamp8(c), clamp8(d), w, true); return (unsigned)w; }
struct EpiQKV {
    static constexpr bool BIAS_DMA = false;
    static constexpr int NST = ATT_FP8 ? 8 : 16;
    bf16* Q; bf16* Kb; bf16* Vt; const float* cosT; const float* sinT; bool dost; LAS unsigned char* stg;
    __device__ __forceinline__ void operator()(const f32x4 (&acc)[2][2][4][2], const Unit& u, int wr, int wc, int fr, int fq) const {
        asm volatile("" : "+v"(fr), "+v"(fq));
        if constexpr (ATT_FP8 != 0) {
            const bool isq = u.pn < 4, k0 = (u.kind == 0); const bool lat = k0 && (u.pm % 9) != 0;
            unsigned char* base8 = (unsigned char*)Q + (k0 ? (isq ? (size_t)0 : WS_K - WS_Q) : WS_VT - WS_Q); const size_t ld = k0 ? 1024 : (size_t)M; const int colbase = k0 ? (u.pn & 3) * 256 : u.pn * 256;
            const float sc = k0 ? (isq ? C2 * 64.f : 16.f) : 16.f;
            LAS unsigned char* sw = stg + (wr * 4 + wc) * 2048; const int lane = fq * 16 + fr; const int jp0 = 16 * (wc & 1) + 4 * fq;
#pragma unroll
            for (int ai = 0; ai < 2; ++ai) {
                f32x4 cs[4], sn[4];
#pragma unroll
                for (int m = 0; m < 4; ++m) { const int row = u.pm * 256 + ai * 128 + wr * 64 + m * 16 + fr; const int t = lat ? (row % RPB) - CTXL : 0;
                    const f32x4 cv = *(const f32x4*)(cosT + t * 32 + jp0), sv = *(const f32x4*)(cosT + 2048 * 32 + t * 32 + jp0);
#pragma unroll
                    for (int j = 0; j < 4; ++j) { cs[m][j] = lat ? cv[j] : 1.f; sn[m][j] = lat ? sv[j] : 0.f; } }
#pragma unroll
                for (int bj = 0; bj < 2; ++bj) {
#pragma unroll
                    for (int m = 0; m < 4; ++m) { const f32x4 a = acc[ai][bj][m][0], b = acc[ai][bj][m][1]; const f32x4 c_ = cs[m], s_ = sn[m];
                        u32x2 w8;
                        w8.x = pack_fp8x4((a[0] * c_[0] - a[1] * s_[0]) * sc, (a[1] * c_[0] + a[0] * s_[0]) * sc, (a[2] * c_[1] - a[3] * s_[1]) * sc, (a[3] * c_[1] + a[2] * s_[1]) * sc);
                        w8.y = pack_fp8x4((b[0] * c_[2] - b[1] * s_[2]) * sc, (b[1] * c_[2] + b[0] * s_[2]) * sc, (b[2] * c_[3] - b[3] * s_[3]) * sc, (b[3] * c_[3] + b[2] * s_[3]) * sc);
                        *(LAS u32x2*)(sw + (16 * m + fr) * 32 + fq * 8) = w8; }
                    asm volatile("s_waitcnt lgkmcnt(0)" ::: "memory");
#pragma unroll
                    for (int k = 0; k < 2; ++k) { const int p = lane + 64 * k, rr = p >> 1, hf = p & 1; const u32x4 v = *(const LAS u32x4*)(sw + p * 16);
                        const int row = u.pm * 256 + ai * 128 + wr * 64 + rr; const int col = colbase + bj * 128 + wc * 32 + hf * 16;
                        if (dost) *(u32x4*)(base8 + (size_t)row * ld + col) = v; }
                    asm volatile("s_waitcnt lgkmcnt(0)" ::: "memory");
                }
            }
        } else if (u.kind == 0) {
            const bool isq = u.pn < 4; bf16* base = isq ? Q : Kb; const float sc = isq ? C2 : 1.f;
            const bool lat = (u.pm % 9) != 0;
#pragma unroll
            EPI_LOOP_ROWS { const int row = u.pm * 256 + ai * 128 + wr * 64 + m * 16 + fr; const int t = (row % RPB) - CTXL;
#pragma unroll
                for (int bj = 0; bj < 2; ++bj) { const f32x4 a = acc[ai][bj][m][0], b = acc[ai][bj][m][1]; f32x4 o0, o1;
                    f32x4 cs = {1.f, 1.f, 1.f, 1.f}, sn = {0.f, 0.f, 0.f, 0.f}; const int jp0 = 16 * (wc & 1) + 4 * fq;
                    if (lat) { cs = *(const f32x4*)(cosT + t * 32 + jp0); sn = *(const f32x4*)(sinT + t * 32 + jp0); }
                    o0[0] = (a[0] * cs[0] - a[1] * sn[0]) * sc; o0[1] = (a[1] * cs[0] + a[0] * sn[0]) * sc; o0[2] = (a[2] * cs[1] - a[3] * sn[1]) * sc; o0[3] = (a[3] * cs[1] + a[2] * sn[1]) * sc;
                    o1[0] = (b[0] * cs[2] - b[1] * sn[2]) * sc; o1[1] = (b[1] * cs[2] + b[0] * sn[2]) * sc; o1[2] = (b[2] * cs[3] - b[3] * sn[3]) * sc; o1[3] = (b[3] * cs[3] + b[2] * sn[3]) * sc;
                    const int col = (u.pn & 3) * 256 + bj * 128 + wc * 32 + fq * 8;
                    if (ATT_FP8) { const float s8 = isq ? 64.f : 16.f; u32x2 w8; w8.x = pack_fp8x4(s8 * o0[0], s8 * o0[1], s8 * o0[2], s8 * o0[3]); w8.y = pack_fp8x4(s8 * o1[0], s8 * o1[1], s8 * o1[2], s8 * o1[3]);
                        if (dost) *(u32x2*)((unsigned char*)base + (size_t)row * 1024 + col) = w8; }
                    else { const u32x4 pk_ = pack8(o0, o1); if (dost) *(u32x4*)(base + (size_t)row * 1024 + col) = pk_; } } }
        } else {
#pragma unroll
            EPI_LOOP_ROWS { const int row = u.pm * 256 + ai * 128 + wr * 64 + m * 16 + fr;
#pragma unroll
                for (int bj = 0; bj < 2; ++bj) { const int col = u.pn * 256 + bj * 128 + wc * 32 + fq * 8;
                    if (ATT_FP8) { const f32x4 a_ = acc[ai][bj][m][0], b_ = acc[ai][bj][m][1]; u32x2 w8; w8.x = pack_fp8x4(16.f * a_[0], 16.f * a_[1], 16.f * a_[2], 16.f * a_[3]); w8.y = pack_fp8x4(16.f * b_[0], 16.f * b_[1], 16.f * b_[2], 16.f * b_[3]);
                        if (dost) *(u32x2*)((unsigned char*)Vt + (size_t)row * M + col) = w8; }
                    else { const u32x4 pk_ = pack8(acc[ai][bj][m][0], acc[ai][bj][m][1]); if (dost) *(u32x4*)(Vt + (size_t)row * M + col) = pk_; } } }
        }
    }
};
struct EpiPlain {
    static constexpr bool BIAS_DMA = false;
    static constexpr int NST = 16;
    bf16* O; int ldc;
    __device__ __forceinline__ void operator()(const f32x4 (&acc)[2][2][4][2], const Unit& u, int wr, int wc, int fr, int fq) const {
        asm volatile("" : "+v"(fr), "+v"(fq));
#pragma unroll
        EPI_LOOP_ROWS { const int row = u.pm * 256 + ai * 128 + wr * 64 + m * 16 + fr;
#pragma unroll
            for (int bj = 0; bj < 2; ++bj) { const int col = u.pn * 256 + bj * 128 + wc * 32 + fq * 8;
                *(u32x4*)(O + (size_t)row * ldc + col) = pack8(acc[ai][bj][m][0], acc[ai][bj][m][1]); } }
    }
};
struct EpiConvIn {
    static constexpr bool BIAS_DMA = false;
    static constexpr int NST = 16;
    bf16* Bb; bf16* Ub;
    __device__ __forceinline__ void operator()(const f32x4 (&acc)[2][2][4][2], const Unit& u, int wr, int wc, int fr, int fq) const {
        asm volatile("" : "+v"(fr), "+v"(fq));
        if (u.pn < 4) {
#pragma unroll
            EPI_LOOP_ROWS { const int row = u.pm * 256 + ai * 128 + wr * 64 + m * 16 + fr;
#pragma unroll
                for (int bj = 0; bj < 2; ++bj) { const int col = u.pn * 256 + bj * 128 + wc * 32 + fq * 8;
                    *(u32x4*)(Bb + (size_t)row * 1024 + col) = pack8(acc[ai][bj][m][0], acc[ai][bj][m][1]); } }
        } else {
#pragma unroll
            EPI_LOOP_ROWS { const int row = u.pm * 256 + ai * 128 + wr * 64 + m * 16 + fr;
#pragma unroll
                for (int bj = 0; bj < 2; ++bj) { const f32x4 a = acc[ai][bj][m][0], b = acc[ai][bj][m][1]; const int col = (u.pn - 4) * 128 + bj * 64 + wc * 16 + fq * 4;
                    u32x2 w; w.x = cvt_pk_bf16(a[0] * a[1], a[2] * a[3]); w.y = cvt_pk_bf16(b[0] * b[1], b[2] * b[3]);
                    *(u32x2*)(Ub + (size_t)row * 1024 + col) = w; } }
        }
    }
};
struct EpiResid {
    static constexpr bool BIAS_DMA = false;
    static constexpr int NST = X_BF16 ? 16 : 0;
    const void* Xin; void* X; const float* gate;
    const float* in_x; const float* in_ctx;
    __device__ __forceinline__ void operator()(const f32x4 (&acc)[2][2][4][2], const Unit& u, int wr, int wc, int fr, int fq) const {
        asm volatile("" : "+v"(fr), "+v"(fq));
        const int rb = (u.pm % 9) == 0 ? 16 : u.pm / 9; const float* gp = gate + rb * 6144;
        f32x4 gv[2][2];
#pragma unroll
        for (int bj = 0; bj < 2; ++bj) { const int col = u.pn * 256 + bj * 128 + wc * 32 + fq * 8; gv[bj][0] = *(const f32x4*)(gp + col); gv[bj][1] = *(const f32x4*)(gp + col + 4); }
        if (X_BF16 && !in_x) {
#pragma unroll
            for (int ai = 0; ai < 2; ++ai) { u32x4 xw[4][2];
#pragma unroll
                for (int m = 0; m < 4; ++m)
#pragma unroll
                    for (int bj = 0; bj < 2; ++bj) xw[m][bj] = *(const u32x4*)((const bf16*)Xin + (size_t)(u.pm * 256 + ai * 128 + wr * 64 + m * 16 + fr) * 1024 + u.pn * 256 + bj * 128 + wc * 32 + fq * 8);
#pragma unroll
                for (int m = 0; m < 4; ++m)
#pragma unroll
                    for (int bj = 0; bj < 2; ++bj) { const u32x4 w = xw[m][bj];
                        const f32x4 x0 = {bf2f((unsigned short)(w.x & 0xffffu)), bf2f((unsigned short)(w.x >> 16)), bf2f((unsigned short)(w.y & 0xffffu)), bf2f((unsigned short)(w.y >> 16))};
                        const f32x4 x1 = {bf2f((unsigned short)(w.z & 0xffffu)), bf2f((unsigned short)(w.z >> 16)), bf2f((unsigned short)(w.w & 0xffffu)), bf2f((unsigned short)(w.w >> 16))};
                        *(u32x4*)((bf16*)X + (size_t)(u.pm * 256 + ai * 128 + wr * 64 + m * 16 + fr) * 1024 + u.pn * 256 + bj * 128 + wc * 32 + fq * 8) = pack8(x0 + gv[bj][0] * acc[ai][bj][m][0], x1 + gv[bj][1] * acc[ai][bj][m][1]); } }
        } else {
#pragma unroll
            EPI_LOOP_ROWS { const int row = u.pm * 256 + ai * 128 + wr * 64 + m * 16 + fr;
#pragma unroll
                for (int bj = 0; bj < 2; ++bj) { const int col = u.pn * 256 + bj * 128 + wc * 32 + fq * 8; const size_t o = (size_t)row * 1024 + col;
                    const float* xs = (const float*)Xin + o;
                    if (in_x) { const int b_ = u.pm / 9, jt_ = u.pm % 9; const size_t ro = (size_t)(row - u.pm * 256) * 1024 + col;
                        xs = jt_ == 0 ? in_ctx + (size_t)b_ * CTXL * 1024 + ro : in_x + ((size_t)b_ * SEQ + (jt_ - 1) * 256) * 1024 + ro; }
                    const f32x4 x0 = *(const f32x4*)(xs), x1 = *(const f32x4*)(xs + 4);
                    const f32x4 r0 = x0 + gv[bj][0] * acc[ai][bj][m][0], r1 = x1 + gv[bj][1] * acc[ai][bj][m][1];
                    if (X_BF16) *(u32x4*)((bf16*)X + o) = pack8(r0, r1);
                    else { *(f32x4*)((float*)X + o) = r0; *(f32x4*)((float*)X + o + 4) = r1; } } }
        }
    }
};
__device__ __forceinline__ float swiglu1(float g, float l) {
    g = fminf(g, 7.f); l = fminf(fmaxf(l, -7.f), 7.f);
    const float s = __builtin_amdgcn_rcpf(1.f + __builtin_amdgcn_exp2f(-1.702f * 1.4426950408889634f * g));
    return g * s * (l + 1.f);
}
__device__ __forceinline__ float swiglu4(float g, float l) {
    g = fminf(g, 7.f); l = __builtin_amdgcn_fmed3f(l, -7.f, 7.f);
    const float r = __builtin_amdgcn_rcpf(1.f + __builtin_amdgcn_exp2f(g * (-1.702f * 1.4426950408889634f)));
    return (g * r) * __builtin_fmaf(l, 4.f, 4.f);
}
template <bool F8> struct EpiSwiglu {
    static constexpr bool BIAS_DMA = true;
    static constexpr int NST = F8 ? 4 : 16;
    bf16* ACT; const float* bgu; LAS unsigned char* stg;
    __device__ __forceinline__ const float* bias_src(const Unit& u) const { return bgu + u.e * 2048 + u.pn * 256; }
    __device__ __forceinline__ void operator()(const f32x4 (&acc)[2][2][4][2], const Unit& u, int wr, int wc, int fr, int fq, LAS const float* bl) const {
        asm volatile("" : "+v"(fr), "+v"(fq));
        f32x4 bv[2][2];
#pragma unroll
        for (int bj = 0; bj < 2; ++bj) { const int col = bj * 128 + wc * 32 + fq * 8; bv[bj][0] = *(const LAS f32x4*)(bl + col); bv[bj][1] = *(const LAS f32x4*)(bl + col + 4); }
        if constexpr (F8) {
            LAS unsigned* sw = (LAS unsigned*)(stg + (wr * 4 + wc) * 2048); const int lane = fq * 16 + fr;
#pragma unroll
            for (int ai = 0; ai < 2; ++ai) {
#pragma unroll
                for (int m = 0; m < 4; ++m)
#pragma unroll
                    for (int bj = 0; bj < 2; ++bj) { const f32x4 a = acc[ai][bj][m][0] + bv[bj][0], b = acc[ai][bj][m][1] + bv[bj][1];
                        int w = 0; w = __builtin_amdgcn_cvt_pk_fp8_f32(swiglu4(a[0], a[1]), swiglu4(a[2], a[3]), w, false); w = __builtin_amdgcn_cvt_pk_fp8_f32(swiglu4(b[0], b[1]), swiglu4(b[2], b[3]), w, true);
                        sw[((16 * m + fr) * 2 + bj) * 4 + fq] = (unsigned)w; }
                asm volatile("s_waitcnt lgkmcnt(0)" ::: "memory");
#pragma unroll
                for (int k = 0; k < 2; ++k) { const int p = lane + 64 * k, rr = p >> 1, bj = p & 1; const u32x4 v = *(const LAS u32x4*)(sw + p * 4);
                    const int row = u.pm * 256 + ai * 128 + wr * 64 + rr; const int col = u.pn * 128 + bj * 64 + wc * 16;
                    if (!(PROBE_NOST && u.kind)) *(u32x4*)((unsigned char*)ACT + (size_t)row * 1024 + col) = v; }
                asm volatile("s_waitcnt lgkmcnt(0)" ::: "memory");
            }
        } else {
#pragma unroll
            EPI_LOOP_ROWS { const int row = u.pm * 256 + ai * 128 + wr * 64 + m * 16 + fr;
#pragma unroll
                for (int bj = 0; bj < 2; ++bj) { const f32x4 a = acc[ai][bj][m][0] + bv[bj][0], b = acc[ai][bj][m][1] + bv[bj][1];
                    const int col = u.pn * 128 + bj * 64 + wc * 16 + fq * 4;
                    u32x2 w; w.x = cvt_pk_bf16(swiglu1(a[0], a[1]), swiglu1(a[2], a[3])); w.y = cvt_pk_bf16(swiglu1(b[0], b[1]), swiglu1(b[2], b[3]));
                    *(u32x2*)(ACT + (size_t)row * 1024 + col) = w; } }
        }
    }
};
struct EpiDown {
    static constexpr bool BIAS_DMA = true;
    static constexpr int NST = Y_FP8 ? 8 : 16;
    bf16* Y; const float* bd; LAS unsigned char* stg;
    __device__ __forceinline__ const float* bias_src(const Unit& u) const { return bd + u.e * 1024 + u.pn * 256; }
    __device__ __forceinline__ void operator()(const f32x4 (&acc)[2][2][4][2], const Unit& u, int wr, int wc, int fr, int fq, LAS const float* bl) const {
        asm volatile("" : "+v"(fr), "+v"(fq));
        f32x4 bv[2][2];
#pragma unroll
        for (int bj = 0; bj < 2; ++bj) { const int col = bj * 128 + wc * 32 + fq * 8; bv[bj][0] = *(const LAS f32x4*)(bl + col); bv[bj][1] = *(const LAS f32x4*)(bl + col + 4); }
        if constexpr (Y_FP8 != 0) {
            LAS unsigned char* sw = stg + (wr * 4 + wc) * 2048; const int lane = fq * 16 + fr;
#pragma unroll
            for (int ai = 0; ai < 2; ++ai)
#pragma unroll
                for (int bj = 0; bj < 2; ++bj) {
#pragma unroll
                    for (int m = 0; m < 4; ++m) { const f32x4 y0 = acc[ai][bj][m][0] + bv[bj][0], y1 = acc[ai][bj][m][1] + bv[bj][1];
                        u32x2 w; w.x = pack_fp8x4(16.f * y0[0], 16.f * y0[1], 16.f * y0[2], 16.f * y0[3]); w.y = pack_fp8x4(16.f * y1[0], 16.f * y1[1], 16.f * y1[2], 16.f * y1[3]);
                        *(LAS u32x2*)(sw + (16 * m + fr) * 32 + fq * 8) = w; }
                    asm volatile("s_waitcnt lgkmcnt(0)" ::: "memory");
#pragma unroll
                    for (int k = 0; k < 2; ++k) { const int p = lane + 64 * k, rr = p >> 1, hf = p & 1; const u32x4 v = *(const LAS u32x4*)(sw + p * 16);
                        const int row = u.pm * 256 + ai * 128 + wr * 64 + rr; const int col = u.pn * 256 + bj * 128 + wc * 32 + hf * 16;
                        if (!(PROBE_NOST && u.kind)) *(u32x4*)((unsigned char*)Y + (size_t)row * 1024 + col) = v; }
                    asm volatile("s_waitcnt lgkmcnt(0)" ::: "memory");
                }
        } else {
#pragma unroll
            EPI_LOOP_ROWS { const int row = u.pm * 256 + ai * 128 + wr * 64 + m * 16 + fr;
#pragma unroll
                for (int bj = 0; bj < 2; ++bj) { const int col = u.pn * 256 + bj * 128 + wc * 32 + fq * 8;
                    const u32x4 pk_ = pack8(acc[ai][bj][m][0] + bv[bj][0], acc[ai][bj][m][1] + bv[bj][1]); if (!(PROBE_NOST && u.kind)) *(u32x4*)(Y + (size_t)row * 1024 + col) = pk_; } }
        }
    }
};

namespace att {
constexpr int SLOT = 32768, VOFF = 16384;
__device__ __forceinline__ void glds16(const void* gsrc, unsigned lds_dst) { unsigned keep;
    asm volatile("s_mov_b32 %0, m0\n\ts_mov_b32 m0, %2\n\ts_nop 0\n\tglobal_load_lds_dwordx4 %1, off\n\ts_mov_b32 m0, %0" : "=&s"(keep) : "v"(gsrc), "s"(lds_dst) : "memory"); }
#define ATT_WAIT_BAR(N) asm volatile("s_waitcnt vmcnt(" #N ") lgkmcnt(0)\n\ts_barrier" ::: "memory")
__device__ __forceinline__ float half_swap_max(float m) { auto rr = __builtin_amdgcn_permlane32_swap(__float_as_uint(m), __float_as_uint(m), false, false); return fmaxf(__uint_as_float(rr[0]), __uint_as_float(rr[1])); }
__device__ __forceinline__ float half_swap_sum(float m) { auto rr = __builtin_amdgcn_permlane32_swap(__float_as_uint(m), __float_as_uint(m), false, false); return __uint_as_float(rr[0]) + __uint_as_float(rr[1]); }
__device__ __forceinline__ int crow(int r, int hi) { return (r & 3) + 8 * (r >> 2) + 4 * hi; }
__device__ __forceinline__ float max3f(float a, float b, float c) { float r; asm("v_max3_f32 %0, %1, %2, %3" : "=v"(r) : "v"(a), "v"(b), "v"(c)); return r; }

__device__ __forceinline__ void attn_unit(LAS unsigned char* lds, LAS float* wsc  , const bf16* Q, const bf16* Kb, const bf16* Vt, bf16* O,
                                          int krow0, int h, int qrow0, int NT, float lam, float osc, const float* subg, const int tid) {
    const int lane = tid & 63, r32 = lane & 31, hi = lane >> 5; const int wid = __builtin_amdgcn_readfirstlane(tid >> 6);
    const int qg = wid >> 1, c = wid & 1;
    const unsigned lds0 = (unsigned)(uintptr_t)lds;
    const bf16* ksrc[2]; const bf16* vsrc[2];
#pragma unroll
    for (int i = 0; i < 2; ++i) { const int p = 2 * wid + i;
        { const int row = 4 * p + (lane >> 4), ch = (lane & 15) ^ (row & 15); ksrc[i] = Kb + (size_t)(krow0 + row) * 1024 + h * 128 + ch * 8; }
        { const int row = 8 * p + (lane >> 3), ch = (lane & 7) ^ ((row >> 1) & 7); vsrc[i] = Vt + (size_t)(h * 128 + row) * M + krow0 + ch * 8; } }
    const unsigned kdst = lds0 + (unsigned)wid * 2048u, vdst = lds0 + VOFF + (unsigned)wid * 2048u;
#define ATT_DMA(t, slot) do { const unsigned so_ = (unsigned)(slot) * SLOT; \
        glds16(ksrc[0] + (size_t)(t) * 64 * 1024, (unsigned)__builtin_amdgcn_readfirstlane(kdst + so_)); glds16(ksrc[1] + (size_t)(t) * 64 * 1024, (unsigned)__builtin_amdgcn_readfirstlane(kdst + so_ + 1024u)); \
        glds16(vsrc[0] + (size_t)(t) * 64, (unsigned)__builtin_amdgcn_readfirstlane(vdst + so_)); glds16(vsrc[1] + (size_t)(t) * 64, (unsigned)__builtin_amdgcn_readfirstlane(vdst + so_ + 1024u)); } while (0)
    const int key0 = (r32 & 0x13) | ((r32 & 4) << 1) | ((r32 & 8) >> 1);
    const int kx = key0 & 15, vx = (r32 >> 1) & 7;
    bf16x8 qf[4];
    { const bf16* qp = Q + (size_t)(qrow0 + qg * 32 + r32) * 1024 + h * 128 + c * 64 + hi * 8;
#pragma unroll
      for (int d0 = 0; d0 < 4; ++d0) qf[d0] = *(const bf16x8*)(qp + d0 * 16); }
    float sg[4];
#pragma unroll
    for (int d0 = 0; d0 < 4; ++d0) sg[d0] = subg[d0 * 32 + r32] * osc;
    f32x16 o[4];
#pragma unroll
    for (int d0 = 0; d0 < 4; ++d0) o[d0] = f32x16{};
    float mref = 0.f, lsum = 0.f; f32x16 negm = f32x16{};
    asm volatile("s_waitcnt vmcnt(0)" ::: "memory");
#define AT_BEG(r) do { if (PROBE_T == (r)) at0_ = __builtin_amdgcn_s_memtime(); } while (0)
#define AT_END(r) do { if (PROBE_T == (r)) { const unsigned long long d_ = __builtin_amdgcn_s_memtime() - at0_; if (blockIdx.x == 0 && tid == ATT_PROBE_TID) *(LAS unsigned long long*)(lds + LX_MISC + 64) += d_; } } while (0)
    unsigned long long at0_ = 0; (void)at0_;
    AT_BEG(7);
    AT_BEG(13);
    ATT_DMA(0, 0);
    if (NT > 1) ATT_DMA(1, 1);
    for (int t = 0; t < NT; ++t) {
        const int slot = t & 3;
        AT_BEG(4);
        if (t + 1 < NT) { ATT_WAIT_BAR(4); } else { ATT_WAIT_BAR(0); }
        AT_END(4);
        if (t == 0) AT_END(13);
        if (t + 2 < NT) ATT_DMA(t + 2, (t + 2) & 3);
        AT_BEG(5);
        const LAS unsigned char* kb_ = lds + slot * SLOT; const LAS unsigned char* vb_ = kb_ + VOFF;
        f32x16 s0, s1;
        bf16x8 kf[8];
#pragma unroll
        for (int d0 = 0; d0 < 4; ++d0) { const int ch = (c * 8 + d0 * 2 + hi) ^ kx;
            kf[d0] = *(const LAS bf16x8*)(kb_ + key0 * 256 + ch * 16); kf[4 + d0] = *(const LAS bf16x8*)(kb_ + (key0 + 32) * 256 + ch * 16); }
        bf16x8 vA[8], vB[8];
#pragma unroll
        for (int ks = 0; ks < 2; ++ks) { const int ch = (2 * ks + hi) ^ vx;
#pragma unroll
            for (int d0 = 0; d0 < 4; ++d0) vA[ks * 4 + d0] = *(const LAS bf16x8*)(vb_ + (d0 * 32 + r32) * 128 + ch * 16); }
#pragma unroll
        for (int d0 = 0; d0 < 4; ++d0) s0 = __builtin_amdgcn_mfma_f32_32x32x16_bf16(kf[d0], qf[d0], d0 == 0 ? negm : s0, 0, 0, 0);
#pragma unroll
        for (int d0 = 0; d0 < 4; ++d0) s1 = __builtin_amdgcn_mfma_f32_32x32x16_bf16(kf[4 + d0], qf[d0], d0 == 0 ? negm : s1, 0, 0, 0);
        float rm = s0[0];
#pragma unroll
        for (int r = 1; r < 16; ++r) rm = fmaxf(rm, s0[r]);
        float sa = 0.f;
#pragma unroll
        for (int r = 0; r < 16; ++r) { s0[r] = __builtin_amdgcn_exp2f(s0[r]); sa += s0[r]; }
        bf16x8 pa[4];
#pragma unroll
        for (int s = 0; s < 2; ++s) { u32x4 w0;
            w0.x = cvt_pk_bf16(s0[8 * s + 0], s0[8 * s + 1]); w0.y = cvt_pk_bf16(s0[8 * s + 2], s0[8 * s + 3]); w0.z = cvt_pk_bf16(s0[8 * s + 4], s0[8 * s + 5]); w0.w = cvt_pk_bf16(s0[8 * s + 6], s0[8 * s + 7]);
            pa[s] = __builtin_bit_cast(bf16x8, w0); }
#pragma unroll
        for (int ks = 2; ks < 4; ++ks) { const int ch = (2 * ks + hi) ^ vx;
#pragma unroll
            for (int d0 = 0; d0 < 4; ++d0) vB[(ks - 2) * 4 + d0] = *(const LAS bf16x8*)(vb_ + (d0 * 32 + r32) * 128 + ch * 16); }
#pragma unroll
        for (int ks = 0; ks < 2; ++ks)
#pragma unroll
            for (int d0 = 0; d0 < 4; ++d0) o[d0] = __builtin_amdgcn_mfma_f32_32x32x16_bf16(pa[ks], vA[ks * 4 + d0], o[d0], 0, 0, 0);
#pragma unroll
        for (int r = 0; r < 16; ++r) rm = fmaxf(rm, s1[r]);
#pragma unroll
        for (int r = 0; r < 16; ++r) { s1[r] = __builtin_amdgcn_exp2f(s1[r]); sa += s1[r]; }
        lsum += sa;
#pragma unroll
        for (int s = 0; s < 2; ++s) { u32x4 w1;
            w1.x = cvt_pk_bf16(s1[8 * s + 0], s1[8 * s + 1]); w1.y = cvt_pk_bf16(s1[8 * s + 2], s1[8 * s + 3]); w1.z = cvt_pk_bf16(s1[8 * s + 4], s1[8 * s + 5]); w1.w = cvt_pk_bf16(s1[8 * s + 6], s1[8 * s + 7]);
            pa[2 + s] = __builtin_bit_cast(bf16x8, w1); }
#pragma unroll
        for (int ks = 2; ks < 4; ++ks)
#pragma unroll
            for (int d0 = 0; d0 < 4; ++d0) o[d0] = __builtin_amdgcn_mfma_f32_32x32x16_bf16(pa[ks], vB[(ks - 2) * 4 + d0], o[d0], 0, 0, 0);
        AT_END(5);
        rm = half_swap_max(rm);
        const bool need = (t == 0) || (rm > 8.f);
        if (__any(need)) {
            const float dl = need ? rm : 0.f; mref += dl;
#pragma unroll
            for (int r = 0; r < 16; ++r) negm[r] = -mref;
            const float f = __builtin_amdgcn_exp2f(-dl); lsum *= f;
            if (hi == 0) wsc[r32] = f;
            asm volatile("s_waitcnt lgkmcnt(0)" ::: "memory");
#pragma unroll
            for (int r = 0; r < 16; ++r) { const float fr_ = wsc[crow(r, hi)];
#pragma unroll
                for (int d0 = 0; d0 < 4; ++d0) o[d0][r] *= fr_; }
            asm volatile("s_waitcnt lgkmcnt(0)" ::: "memory");
        }
    }
    AT_BEG(14);
    const float lt = half_swap_sum(lsum);
    if (hi == 0) wsc[64 + r32] = (c ? -lam : 1.f) * __builtin_amdgcn_rcpf(lt);
    asm volatile("s_waitcnt lgkmcnt(0)\n\ts_barrier" ::: "memory");
    LAS float* xch = (LAS float*)(lds + qg * 16384);
#pragma unroll
    for (int r = 0; r < 16; ++r) { const float a = wsc[64 + crow(r, hi)];
#pragma unroll
        for (int d0 = 0; d0 < 4; ++d0) o[d0][r] *= a; }
    if (c == 1) {
#pragma unroll
        for (int d0 = 0; d0 < 4; ++d0)
#pragma unroll
            for (int r = 0; r < 16; ++r) xch[(d0 * 16 + r) * 64 + lane] = o[d0][r];
    }
    asm volatile("s_waitcnt lgkmcnt(0)\n\ts_barrier" ::: "memory");
    if (c == 0) {
        constexpr int OB = FP8_ATT_O ? 1 : 2;
        LAS unsigned char* stg = lds + 65536 + qg * 8192;
#pragma unroll
        for (int d0 = 0; d0 < 4; ++d0)
#pragma unroll
            for (int r = 0; r < 16; ++r) o[d0][r] += xch[(d0 * 16 + r) * 64 + lane];
        float ss[16], tt[16];
#pragma unroll
        for (int r = 0; r < 16; ++r) { float x = (o[0][r] * o[0][r] + o[1][r] * o[1][r]) + (o[2][r] * o[2][r] + o[3][r] * o[3][r]);
            x += __builtin_bit_cast(float, __builtin_amdgcn_update_dpp(0, __builtin_bit_cast(int, x), 0xB1, 0xF, 0xF, true));
            x += __builtin_bit_cast(float, __builtin_amdgcn_update_dpp(0, __builtin_bit_cast(int, x), 0x4E, 0xF, 0xF, true));
            x += __builtin_bit_cast(float, __builtin_amdgcn_update_dpp(0, __builtin_bit_cast(int, x), 0x124, 0xF, 0xF, true));
            x += __builtin_bit_cast(float, __builtin_amdgcn_update_dpp(0, __builtin_bit_cast(int, x), 0x128, 0xF, 0xF, true));
            ss[r] = x; }
#pragma unroll
        for (int r = 0; r < 16; ++r) tt[r] = __shfl_xor(ss[r], 16);
#pragma unroll
        for (int r = 0; r < 16; ++r) { const int qr = crow(r, hi); const float rn = __builtin_amdgcn_rsqf((ss[r] + tt[r]) * (1.f / 128.f) + EPS);
#pragma unroll
            for (int d0 = 0; d0 < 4; ++d0) { const float ov = o[d0][r] * rn * sg[d0];
                if (FP8_ATT_O) { const float o4 = clamp8(4.f * ov); *(LAS unsigned char*)(stg + qr * 128 + d0 * 32 + r32) = (unsigned char)(__builtin_amdgcn_cvt_pk_fp8_f32(o4, o4, 0, false) & 0xff); }
                else *(LAS unsigned short*)(stg + (qr * 128 + d0 * 32 + r32) * 2) = (unsigned short)f2bf(ov); } }
        asm volatile("s_waitcnt lgkmcnt(0)" ::: "memory");
        unsigned char* Ob = (unsigned char*)O + ((size_t)(qrow0 + qg * 32) * 1024 + h * 128) * OB;
#pragma unroll
        for (int k = 0; k < 4 * OB; ++k) { const int off = lane * 16 + 1024 * k, row = off / (128 * OB), cb = off % (128 * OB);
            *(u32x4*)(Ob + (size_t)row * 1024 * OB + cb) = *(const LAS u32x4*)(stg + off); }
    }
    asm volatile("s_waitcnt lgkmcnt(0)\n\ts_barrier" ::: "memory");
    AT_END(7);
    AT_END(14);
#undef AT_BEG
#undef AT_END
#undef ATT_DMA
}

typedef int v8i __attribute__((ext_vector_type(8)));
typedef int v4i_ __attribute__((ext_vector_type(4)));
__device__ __forceinline__ v8i cat16(u32x4 lo, u32x4 hi2) { const v4i_ a = __builtin_bit_cast(v4i_, lo), b = __builtin_bit_cast(v4i_, hi2); return __builtin_shufflevector(a, b, 0, 1, 2, 3, 4, 5, 6, 7); }
constexpr float ATT_TGT = 2.f;
__device__ __forceinline__ void attn_unit8(LAS unsigned char* lds, LAS float* wsc, const unsigned char* Q8, const unsigned char* K8, const unsigned char* V8t, bf16* O,
                                           int krow0, int h, int qrow0, int NT, float lam, float osc, const float* subg, const int tid) {
    constexpr int SL = 16384, VO = 8192;
    const int lane = tid & 63, r32 = lane & 31, hi = lane >> 5; const int wid = __builtin_amdgcn_readfirstlane(tid >> 6);
    const int qg = wid >> 1, c = wid & 1;
    const unsigned lds0 = (unsigned)(uintptr_t)lds;
    const unsigned char* ksrc; const unsigned char* vsrc;
    { const int key = 8 * wid + (lane >> 3), ch = (lane & 7) ^ ((key >> 1) & 7); ksrc = K8 + (size_t)(krow0 + key) * 1024 + h * 128 + ch * 16; }
    { const int dv = 16 * wid + (lane >> 2), ch = (lane & 3) ^ ((dv >> 2) & 3); vsrc = V8t + (size_t)(h * 128 + dv) * M + krow0 + ch * 16; }
    const unsigned kdst = lds0 + (unsigned)wid * 1024u, vdst = lds0 + VO + (unsigned)wid * 1024u;
#define ATT_DMA8(t, slot) do { const unsigned so_ = (unsigned)(slot) * SL; \
        glds16(ksrc + (size_t)(t) * 64 * 1024, (unsigned)__builtin_amdgcn_readfirstlane(kdst + so_)); glds16(vsrc + (size_t)(t) * 64, (unsigned)__builtin_amdgcn_readfirstlane(vdst + so_)); } while (0)
    const int key0 = 32 * ((r32 >> 2) & 1) + (r32 & 3) + 4 * (r32 >> 3);
    const int kx = (key0 >> 1) & 7, vx = (r32 >> 2) & 3;
    const int kc0 = ((c * 4 + 2 * hi) ^ kx) * 16, kc1 = ((c * 4 + 2 * hi + 1) ^ kx) * 16;
    const int vc0 = ((2 * hi) ^ vx) * 16, vc1 = ((2 * hi + 1) ^ vx) * 16;
    v8i qf;
    { const unsigned char* qp = Q8 + (size_t)(qrow0 + qg * 32 + r32) * 1024 + h * 128 + c * 64 + hi * 32;
      qf = cat16(*(const u32x4*)qp, *(const u32x4*)(qp + 16)); }
    float sg[4];
#pragma unroll
    for (int d0 = 0; d0 < 4; ++d0) sg[d0] = subg[d0 * 32 + r32] * osc;
    f32x16 o[4];
#pragma unroll
    for (int d0 = 0; d0 < 4; ++d0) o[d0] = f32x16{};
    float mref = 0.f, lsum = 0.f; f32x16 negm;
#pragma unroll
    for (int r = 0; r < 16; ++r) negm[r] = ATT_TGT;
    const int NS = NT >> 2;
    asm volatile("s_waitcnt vmcnt(0)" ::: "memory");
#pragma unroll
    for (int j = 0; j < 4; ++j) ATT_DMA8(j, j);
    ATT_WAIT_BAR(0);
    if (NS > 1) {
#pragma unroll
        for (int j = 0; j < 4; ++j) ATT_DMA8(4 + j, 4 + j);
    }
#define ATT_KFRAG(kb_, kk) cat16(*(const LAS u32x4*)((kb_) + (key0 + (kk)) * 128 + kc0), *(const LAS u32x4*)((kb_) + (key0 + (kk)) * 128 + kc1))
#define ATT_VFRAG(vb_, d0) cat16(*(const LAS u32x4*)((vb_) + ((d0) * 32 + r32) * 64 + vc0), *(const LAS u32x4*)((vb_) + ((d0) * 32 + r32) * 64 + vc1))
#define ATT_QK(kb_, kk) __builtin_amdgcn_mfma_scale_f32_32x32x64_f8f6f4(ATT_KFRAG(kb_, kk), qf, negm, 0, 0, 0, 0x7A7A7A7A, 0, 0x7A7A7A7A)
    {
        const f32x16 s0 = ATT_QK(lds, 0), s1 = ATT_QK(lds, 16);
        float rm = s0[0];
#pragma unroll
        for (int r = 1; r < 16; ++r) rm = fmaxf(rm, s0[r]);
#pragma unroll
        for (int r = 0; r < 16; ++r) rm = fmaxf(rm, s1[r]);
        mref = half_swap_max(rm) - ATT_TGT;
#pragma unroll
        for (int r = 0; r < 16; ++r) negm[r] = ATT_TGT - mref;
    }
    for (int st = 0; st < NS; ++st) {
        if (st > 0) {
            ATT_WAIT_BAR(0);
            if (st + 1 < NS) {
#pragma unroll
                for (int j = 0; j < 4; ++j) ATT_DMA8(4 * (st + 1) + j, ((st + 1) & 1) * 4 + j);
            }
        }
        const LAS unsigned char* sb_ = lds + (st & 1) * 4 * SL;
        v8i pfp = {0, 0, 0, 0, 0, 0, 0, 0};
#pragma unroll
        for (int j = 0; j < 4; ++j) {
            const LAS unsigned char* kb_ = sb_ + j * SL;
            f32x16 s0 = ATT_QK(kb_, 0), s1 = ATT_QK(kb_, 16);
            if (j > 0) { const LAS unsigned char* vp_ = kb_ - SL + VO;
#pragma unroll
                for (int d0 = 0; d0 < 4; ++d0) o[d0] = __builtin_amdgcn_mfma_scale_f32_32x32x64_f8f6f4(pfp, ATT_VFRAG(vp_, d0), o[d0], 0, 0, 0, 0x7F7F7F7F, 0, 0x7F7F7F7F); }
#pragma unroll
            for (int r = 0; r < 16; ++r) { s0[r] = __builtin_amdgcn_exp2f(s0[r]); s1[r] = __builtin_amdgcn_exp2f(s1[r]); }
            float sa = 0.f, sb = 0.f;
#pragma unroll
            for (int r = 0; r < 16; ++r) { sa += s0[r]; sb += s1[r]; }
            sa += sb;
            if (__any(!(sa <= 448.f))) {
                unsigned ko_ = (unsigned)(uintptr_t)kb_; asm volatile("" : "+v"(ko_));
                const LAS unsigned char* kr_ = (const LAS unsigned char*)(uintptr_t)ko_;
                s0 = ATT_QK(kr_, 0); s1 = ATT_QK(kr_, 16);
                float rm = s0[0];
#pragma unroll
                for (int r = 1; r < 16; ++r) rm = fmaxf(rm, s0[r]);
#pragma unroll
                for (int r = 0; r < 16; ++r) rm = fmaxf(rm, s1[r]);
                rm = half_swap_max(rm);
                const float dl = fmaxf(rm - ATT_TGT, 0.f); mref += dl;
#pragma unroll
                for (int r = 0; r < 16; ++r) negm[r] = ATT_TGT - mref;
                const float f = __builtin_amdgcn_exp2f(-dl); lsum *= f;
                if (hi == 0) wsc[r32] = f;
                asm volatile("s_waitcnt lgkmcnt(0)" ::: "memory");
#pragma unroll
                for (int r = 0; r < 16; ++r) { const float fr_ = wsc[crow(r, hi)];
#pragma unroll
                    for (int d0 = 0; d0 < 4; ++d0) o[d0][r] *= fr_; }
                asm volatile("s_waitcnt lgkmcnt(0)" ::: "memory");
#pragma unroll
                for (int r = 0; r < 16; ++r) { s0[r] = __builtin_amdgcn_exp2f(s0[r] - dl); s1[r] = __builtin_amdgcn_exp2f(s1[r] - dl); }
                sa = 0.f; sb = 0.f;
#pragma unroll
                for (int r = 0; r < 16; ++r) { sa += s0[r]; sb += s1[r]; }
                sa += sb;
            }
            lsum += sa;
#pragma unroll
            for (int jj = 0; jj < 4; ++jj) { int w = __builtin_bit_cast(int, s0[4 * jj]); w = __builtin_amdgcn_cvt_pk_fp8_f32(s0[4 * jj], s0[4 * jj + 1], w, false); w = __builtin_amdgcn_cvt_pk_fp8_f32(s0[4 * jj + 2], s0[4 * jj + 3], w, true); pfp[jj] = w;
                int w2 = __builtin_bit_cast(int, s1[4 * jj]); w2 = __builtin_amdgcn_cvt_pk_fp8_f32(s1[4 * jj], s1[4 * jj + 1], w2, false); w2 = __builtin_amdgcn_cvt_pk_fp8_f32(s1[4 * jj + 2], s1[4 * jj + 3], w2, true); pfp[4 + jj] = w2; }
        }
        {
            const LAS unsigned char* vl_ = sb_ + 3 * SL + VO;
#pragma unroll
            for (int d0 = 0; d0 < 4; ++d0) o[d0] = __builtin_amdgcn_mfma_scale_f32_32x32x64_f8f6f4(pfp, ATT_VFRAG(vl_, d0), o[d0], 0, 0, 0, 0x7F7F7F7F, 0, 0x7F7F7F7F);
        }
    }
#undef ATT_KFRAG
#undef ATT_VFRAG
#undef ATT_QK
    const float lt = half_swap_sum(lsum);
    if (hi == 0) wsc[64 + r32] = (c ? -lam : 1.f) * __builtin_amdgcn_rcpf(16.f * lt);
    asm volatile("s_waitcnt lgkmcnt(0)\n\ts_barrier" ::: "memory");
    LAS float* xch = (LAS float*)(lds + qg * 16384);
#pragma unroll
    for (int r = 0; r < 16; ++r) { const float a = wsc[64 + crow(r, hi)];
#pragma unroll
        for (int d0 = 0; d0 < 4; ++d0) o[d0][r] *= a; }
    if (c == 1) {
#pragma unroll
        for (int d0 = 0; d0 < 4; ++d0)
#pragma unroll
            for (int r = 0; r < 16; ++r) xch[(d0 * 16 + r) * 64 + lane] = o[d0][r];
    }
    asm volatile("s_waitcnt lgkmcnt(0)\n\ts_barrier" ::: "memory");
    if (c == 0) {
        constexpr int OB = FP8_ATT_O ? 1 : 2;
        LAS unsigned char* stg = lds + 65536 + qg * 8192;
#pragma unroll
        for (int d0 = 0; d0 < 4; ++d0)
#pragma unroll
            for (int r = 0; r < 16; ++r) o[d0][r] += xch[(d0 * 16 + r) * 64 + lane];
        float ss[16], tt[16];
#pragma unroll
        for (int r = 0; r < 16; ++r) { float x = (o[0][r] * o[0][r] + o[1][r] * o[1][r]) + (o[2][r] * o[2][r] + o[3][r] * o[3][r]);
            x += __builtin_bit_cast(float, __builtin_amdgcn_update_dpp(0, __builtin_bit_cast(int, x), 0xB1, 0xF, 0xF, true));
            x += __builtin_bit_cast(float, __builtin_amdgcn_update_dpp(0, __builtin_bit_cast(int, x), 0x4E, 0xF, 0xF, true));
            x += __builtin_bit_cast(float, __builtin_amdgcn_update_dpp(0, __builtin_bit_cast(int, x), 0x124, 0xF, 0xF, true));
            x += __builtin_bit_cast(float, __builtin_amdgcn_update_dpp(0, __builtin_bit_cast(int, x), 0x128, 0xF, 0xF, true));
            ss[r] = x; }
#pragma unroll
        for (int r = 0; r < 16; ++r) tt[r] = __shfl_xor(ss[r], 16);
#pragma unroll
        for (int r = 0; r < 16; ++r) { const int qr = crow(r, hi); const float rn = __builtin_amdgcn_rsqf((ss[r] + tt[r]) * (1.f / 128.f) + EPS);
#pragma unroll
            for (int d0 = 0; d0 < 4; ++d0) { const float ov = o[d0][r] * rn * sg[d0];
                if (FP8_ATT_O) { const float o4 = clamp8(4.f * ov); *(LAS unsigned char*)(stg + qr * 128 + d0 * 32 + r32) = (unsigned char)(__builtin_amdgcn_cvt_pk_fp8_f32(o4, o4, 0, false) & 0xff); }
                else *(LAS unsigned short*)(stg + (qr * 128 + d0 * 32 + r32) * 2) = (unsigned short)f2bf(ov); } }
        asm volatile("s_waitcnt lgkmcnt(0)" ::: "memory");
        unsigned char* Ob = (unsigned char*)O + ((size_t)(qrow0 + qg * 32) * 1024 + h * 128) * OB;
#pragma unroll
        for (int k = 0; k < 4 * OB; ++k) { const int off = lane * 16 + 1024 * k, row = off / (128 * OB), cb = off % (128 * OB);
            *(u32x4*)(Ob + (size_t)row * 1024 * OB + cb) = *(const LAS u32x4*)(stg + off); }
    }
    asm volatile("s_waitcnt lgkmcnt(0)\n\ts_barrier" ::: "memory");
#undef ATT_DMA8
}
}

#if ATT_FP8
#define ATT_CALL(l_, w_, q_, k_, v_, o_, ...) att::attn_unit8(l_, w_, (const unsigned char*)(q_), (const unsigned char*)(k_), (const unsigned char*)(v_), o_, __VA_ARGS__)
#else
#define ATT_CALL att::attn_unit
#endif
__device__ __forceinline__ void load_row_f32(const float* p, int lane, f32x4 (&v)[4]) {
#pragma unroll
    for (int j = 0; j < 4; ++j) v[j] = *(const f32x4*)(p + 256 * j + 4 * lane);
}
__device__ __forceinline__ void load_row_x(const void* Xb, size_t row, int lane, f32x4 (&v)[4]) {
    if (X_BF16) { const bf16* p = (const bf16*)Xb + row * D;
#pragma unroll
        for (int j = 0; j < 4; ++j) { const u32x2 w = *(const u32x2*)(p + 256 * j + 4 * lane);
            v[j] = (f32x4){bf2f((unsigned short)(w.x & 0xffffu)), bf2f((unsigned short)(w.x >> 16)), bf2f((unsigned short)(w.y & 0xffffu)), bf2f((unsigned short)(w.y >> 16))}; } }
    else load_row_f32((const float*)Xb + row * D, lane, v);
}
__device__ __forceinline__ void store_row_x(void* Xb, size_t row, int lane, const f32x4 (&v)[4]) {
    if (X_BF16) { bf16* p = (bf16*)Xb + row * D;
#pragma unroll
        for (int j = 0; j < 4; ++j) { u32x2 w; w.x = cvt_pk_bf16(v[j][0], v[j][1]); w.y = cvt_pk_bf16(v[j][2], v[j][3]); *(u32x2*)(p + 256 * j + 4 * lane) = w; } }
    else { float* p = (float*)Xb + row * D;
#pragma unroll
        for (int j = 0; j < 4; ++j) *(f32x4*)(p + 256 * j + 4 * lane) = v[j]; }
}
__device__ __forceinline__ float row_rstd(const f32x4 (&v)[4]) {
    float s = 0.f;
#pragma unroll
    for (int j = 0; j < 4; ++j) s += (v[j][0] * v[j][0] + v[j][1] * v[j][1]) + (v[j][2] * v[j][2] + v[j][3] * v[j][3]);
    return 1.0f / sqrtf(wave_sum(s) * (1.f / D) + EPS);
}
__device__ __forceinline__ void norm_mod_store(f32x4 (&v)[4], const float* g, const float* sc, const float* sh, int lane, bf16* hrow) {
    const float rstd = row_rstd(v);
#pragma unroll
    for (int j = 0; j < 4; ++j) { const int c = 256 * j + 4 * lane; const f32x4 gg = *(const f32x4*)(g + c), ss = *(const f32x4*)(sc + c), hh = *(const f32x4*)(sh + c);
        v[j] = (v[j] * rstd) * gg * (ss + 1.f) + hh;
        u32x2 w; w.x = cvt_pk_bf16(v[j][0], v[j][1]); w.y = cvt_pk_bf16(v[j][2], v[j][3]); *(u32x2*)(hrow + c) = w; }
}
__device__ __forceinline__ void norm_mod_f32(f32x4 (&v)[4], const float* g, const float* sc, const float* sh, int lane) {
    const float rstd = row_rstd(v);
#pragma unroll
    for (int j = 0; j < 4; ++j) { const int c = 256 * j + 4 * lane; const f32x4 gg = *(const f32x4*)(g + c), ss = *(const f32x4*)(sc + c), hh = *(const f32x4*)(sh + c);
        v[j] = (v[j] * rstd) * gg * (ss + 1.f) + hh; }
}
__device__ __forceinline__ void norm_mod_store_mix(bool f8, f32x4 (&v)[4], const float* g, const float* sc, const float* sh, int lane, bf16* hrow, unsigned char* h8row) {
    if (f8) { norm_mod_f32(v, g, sc, sh, lane);
#pragma unroll
        for (int j = 0; j < 4; ++j) *(unsigned*)(h8row + 256 * j + 4 * lane) = pack_fp8x4(16.f * v[j][0], 16.f * v[j][1], 16.f * v[j][2], 16.f * v[j][3]); }
    else norm_mod_store(v, g, sc, sh, lane, hrow);
}
__device__ __forceinline__ int row_batch(int row) { return row / RPB; }
__device__ __forceinline__ bool row_is_ctx(int row) { return (row % RPB) < CTXL; }
__device__ __forceinline__ int act_row(int ai, bool lat_only) { return lat_only ? (ai >> 11) * RPB + CTXL + (ai & 2047) : ai; }

template <int MODE>
__device__ __forceinline__ void transpose_item(const float* W, int K, int N, bf16* WT, LAS float* scr, int item, int lane) {
    const int nblk = N / 32, kb = item / nblk, nb = item % nblk, k0 = 64 * kb, n0 = 32 * nb;
#pragma unroll 8
    for (int i = 0; i < 32; ++i) { const int kk = 2 * i + (lane >> 5); scr[kk * 33 + (lane & 31)] = W[(size_t)(k0 + kk) * N + n0 + (lane & 31)]; }
    asm volatile("s_waitcnt lgkmcnt(0)" ::: "memory");
    const int c = lane & 7;
#pragma unroll
    for (int j = 0; j < 4; ++j) { const int n = (lane >> 3) + 8 * j; const LAS float* s = scr + (8 * c) * 33 + n;
        u32x4 o; o.x = cvt_pk_bf16(s[0 * 33], s[1 * 33]); o.y = cvt_pk_bf16(s[2 * 33], s[3 * 33]); o.z = cvt_pk_bf16(s[4 * 33], s[5 * 33]); o.w = cvt_pk_bf16(s[6 * 33], s[7 * 33]);
        int nn = n0 + n;
        if (MODE == 1 && nn < 2048) { const int i6 = nn & 63; nn = (nn & ~63) + (i6 < 32 ? 2 * i6 : 2 * (i6 - 32) + 1); }
        if (MODE == 2 && nn >= 1024) nn = nn < 2048 ? 1024 + 2 * (nn - 1024) : 1024 + 2 * (nn - 2048) + 1;
        *(u32x4*)(WT + (size_t)nn * K + k0 + 8 * c) = o; }
    asm volatile("s_waitcnt lgkmcnt(0)" ::: "memory");
}

template <int MODE = 0>
__device__ __forceinline__ void transpose_item8(const float* W, int K, int N, unsigned char* WT, LAS float* scr, int item, int lane) {
    const int nblk = N / 16, kb = item / nblk, nb = item % nblk, k0 = 128 * kb, n0 = 16 * nb;
    f32x4 v[8];
#pragma unroll
    for (int i = 0; i < 8; ++i) v[i] = *(const f32x4*)(W + (size_t)(k0 + 16 * i + (lane >> 2)) * N + n0 + 4 * (lane & 3));
#pragma unroll
    for (int i = 0; i < 8; ++i) *(LAS f32x4*)(scr + (16 * i + (lane >> 2)) * 20 + 4 * (lane & 3)) = v[i] * 1024.f;
    asm volatile("s_waitcnt lgkmcnt(0)" ::: "memory");
    const int kc = lane & 7;
#pragma unroll
    for (int j = 0; j < 2; ++j) { const int n = (lane >> 3) + 8 * j; const LAS float* s = scr + (16 * kc) * 20 + n;
        u32x4 o;
        o.x = pack_fp8x4(s[0 * 20], s[1 * 20], s[2 * 20], s[3 * 20]); o.y = pack_fp8x4(s[4 * 20], s[5 * 20], s[6 * 20], s[7 * 20]);
        o.z = pack_fp8x4(s[8 * 20], s[9 * 20], s[10 * 20], s[11 * 20]); o.w = pack_fp8x4(s[12 * 20], s[13 * 20], s[14 * 20], s[15 * 20]);
        int nn = n0 + n;
        if (MODE == 1 && nn < 2048) { const int i6 = nn & 63; nn = (nn & ~63) + (i6 < 32 ? 2 * i6 : 2 * (i6 - 32) + 1); }
        *(u32x4*)(WT + (size_t)nn * K + k0 + 16 * kc) = o; }
    asm volatile("s_waitcnt lgkmcnt(0)" ::: "memory");
}

__device__ __forceinline__ void item8_load(const float* W, int N, int item, int lane, f32x4 (&v)[8]) {
    const int nblk = N / 16, kb = item / nblk, nb = item % nblk, k0 = 128 * kb, n0 = 16 * nb;
#pragma unroll
    for (int i = 0; i < 8; ++i) v[i] = *(const f32x4*)(W + (size_t)(k0 + 16 * i + (lane >> 2)) * N + n0 + 4 * (lane & 3));
}
__device__ __forceinline__ void item8_store(const f32x4 (&v)[8], int K, int N, unsigned char* WT, LAS float* scr, int item, int lane) {
    const int nblk = N / 16, kb = item / nblk, nb = item % nblk, k0 = 128 * kb, n0 = 16 * nb;
#pragma unroll
    for (int i = 0; i < 8; ++i) *(LAS f32x4*)(scr + (16 * i + (lane >> 2)) * 20 + 4 * (lane & 3)) = v[i] * 1024.f;
    asm volatile("s_waitcnt lgkmcnt(0)" ::: "memory");
    const int kc = lane & 7;
#pragma unroll
    for (int j = 0; j < 2; ++j) { const int n = (lane >> 3) + 8 * j; const LAS float* s = scr + (16 * kc) * 20 + n;
        u32x4 o;
        o.x = pack_fp8x4(s[0 * 20], s[1 * 20], s[2 * 20], s[3 * 20]); o.y = pack_fp8x4(s[4 * 20], s[5 * 20], s[6 * 20], s[7 * 20]);
        o.z = pack_fp8x4(s[8 * 20], s[9 * 20], s[10 * 20], s[11 * 20]); o.w = pack_fp8x4(s[12 * 20], s[13 * 20], s[14 * 20], s[15 * 20]);
        *(u32x4*)(WT + (size_t)(n0 + n) * K + k0 + 16 * kc) = o; }
    asm volatile("s_waitcnt lgkmcnt(0)" ::: "memory");
}

struct Args { const float* in[21]; float* out; unsigned char* ws; int ph_lo, ph_hi; };
enum { I_X = 0, I_C, I_CTX, I_CCTX, I_MODW, I_MODB, I_NORMG, I_WQKV, I_WO, I_LAM, I_SUBG, I_WIN, I_CONVW, I_WOUT, I_RW, I_RB, I_WGU, I_BGU, I_WD, I_BD, I_FINALG };

__device__ __forceinline__ void moe_table(LAS unsigned char* lds, const unsigned* gcnt, int tid) {
    LAS int* ecnt = (LAS int*)(lds + LX_ECNT); LAS int* tstart = (LAS int*)(lds + LX_TSTART); LAS int* tile_e = (LAS int*)(lds + LX_TILEE);
    __syncthreads();
    if (tid < 32) ecnt[tid] = (int)__hip_atomic_load(gcnt + tid, RLX_AGENT);
    __syncthreads();
    if (tid == 0) { int ts = 0; for (int e = 0; e < 32; ++e) { tstart[e] = ts; ts += (ecnt[e] + 255) >> 8; } tstart[32] = ts; }
    __syncthreads();
    { const int e = tid >> 4, l16 = tid & 15; const int t0 = tstart[e], n = tstart[e + 1] - t0; for (int j = l16; j < n; j += 16) tile_e[t0 + j] = e; }
    __syncthreads();
}

typedef const __attribute__((address_space(4))) unsigned char* kptr_t;
__device__ __forceinline__ kptr_t kargs() { kptr_t p = (kptr_t)__builtin_amdgcn_kernarg_segment_ptr(); asm volatile("" : "+s"(p)); return p; }
#define INP(k) (*(const float* const __attribute__((address_space(4)))*)(kargs() + 8 * (k)))
#define OUTP() (*(float* const __attribute__((address_space(4)))*)(kargs() + 168))
#define WSB() (*(unsigned char* const __attribute__((address_space(4)))*)(kargs() + 176))
#define WSP(T, off) ((T*)(WSB() + (off)))
static_assert(sizeof(Args) == 192, "kernarg layout");
__global__ void __launch_bounds__(NTHREADS, 2) fwd(Args args) {
    extern __shared__ __attribute__((aligned(16))) unsigned char lds_raw[];
    LAS unsigned char* lds = (LAS unsigned char*)lds_raw;
    const int tid = threadIdx.x, lane = tid & 63, wave = __builtin_amdgcn_readfirstlane(tid >> 6);
    const int G = gridDim.x, bid = blockIdx.x;
    const int gw = bid * NWAVES + wave, NGW = G * NWAVES;
    gu32* ctl = (gu32*)WSP(unsigned, WS_CTL);
    for (int u = tid; u < (LDS_BYTES - LX) / 4; u += NTHREADS) ((LAS unsigned*)(lds + LX))[u] = 0u;
    __syncthreads();
    volatile LAS unsigned* MISC = (volatile LAS unsigned*)(lds + LX_MISC);
    XcdBarrier bar; bar.bar = (unsigned*)(ctl + CW_BAR); bar.x = 0; bar.st = nullptr;
    if (!MK_PER_PHASE) bar = xcd_barrier_post((unsigned*)(ctl + CW_BAR), MISC + 8);
    (void)args;
    const unsigned long long pt_start = PROBE_T ? __builtin_amdgcn_s_memtime() : 0ull; (void)pt_start;
    const unsigned long long pt_rstart = PROBE_T ? __builtin_amdgcn_s_memrealtime() : 0ull; (void)pt_rstart;
    const int lo = *(const int __attribute__((address_space(4)))*)(kargs() + 184), hi = *(const int __attribute__((address_space(4)))*)(kargs() + 188);
#define IN(k) (lo <= (k) && (k) < hi)
#define PHASE_IDS int tid = threadIdx.x; asm volatile("" : "+v"(tid)); const int lane = tid & 63, wave = __builtin_amdgcn_readfirstlane(tid >> 6); const int gw = bid * NWAVES + wave; (void)lane; (void)gw;
#define SEAM(k) do { if (IN(k) && IN((k) + 1)) { if (MK_PER_PHASE) { if (tid == 0) __hip_atomic_store(ctl + CW_TMO, 0xBADu, RLX_AGENT); } else { unsigned long long b0_ = 0; if (PROBE_T == 10) b0_ = __builtin_amdgcn_s_memtime(); xcd_barrier(bar); if (PROBE_REP & 0x10000) xcd_barrier(bar); if (PROBE_T == 10 && bid == PROBE_BID && threadIdx.x == 0) *(LAS unsigned long long*)(lds + LX_MISC + 64) += __builtin_amdgcn_s_memtime() - b0_; } } } while (0)

    if (PS(0) && IN(0)) { PHASE_IDS
        float* modv = WSP(float, WS_MODV);
        unsigned long long p0t_ = (PROBE_T == 11 || PROBE_T == 12) ? __builtin_amdgcn_s_memtime() : 0ull; (void)p0t_;
        { LAS float* sil = (LAS float*)lds;
          LAS float* red = (LAS float*)(lds + 69632);
          for (int i = tid; i < 17 * 1024; i += NTHREADS) { const int r = i >> 10, k = i & 1023; const float cv = r < 16 ? INP(I_C)[r * 1024 + k] : INP(I_CCTX)[k]; sil[i] = cv / (1.f + __expf(-cv)); }
          __syncthreads();
          for (int it = bid; it < 4 * 96; it += G) { const int l = it / 96, nb = it % 96; const float* W = INP(I_MODW) + (size_t)l * 1024 * 6144 + nb * 64 + lane;
            float a[17];
#pragma unroll
            for (int r = 0; r < 17; ++r) a[r] = 0.f;
            for (int k = wave * 128; k < wave * 128 + 128; k += 4) { float w[4];
#pragma unroll
                for (int q = 0; q < 4; ++q) w[q] = W[(size_t)(k + q) * 6144];
#pragma unroll
                for (int r = 0; r < 17; ++r) { const f32x4 s = *(const LAS f32x4*)(sil + r * 1024 + k); a[r] += s[0] * w[0] + s[1] * w[1] + s[2] * w[2] + s[3] * w[3]; } }
#pragma unroll
            for (int r = 0; r < 17; ++r) red[(wave * 17 + r) * 64 + lane] = a[r];
            __syncthreads();
            for (int i = tid; i < 17 * 64; i += NTHREADS) { const int r = i >> 6, n = i & 63; float s = INP(I_MODB)[l * 6144 + nb * 64 + n];
#pragma unroll
                for (int w8 = 0; w8 < 8; ++w8) s += red[(w8 * 17 + r) * 64 + n];
                modv[((size_t)l * 17 + r) * 6144 + nb * 64 + n] = s; }
            __syncthreads(); }
        }
        if (PROBE_T == 11 && bid == 0 && tid == 0) *(LAS unsigned long long*)(lds + LX_MISC + 64) += __builtin_amdgcn_s_memtime() - p0t_;
        { float* cosT = WSP(float, WS_ROPE); float* sinT = cosT + 2048 * 32; float* rwT = WSP(float, WS_RW); float* lamv = WSP(float, WS_MISC);
        for (int i = bid * NTHREADS + tid; i < 2048 * 32; i += G * NTHREADS) { const int t = i >> 5, j = i & 31; const float pos = (float)(j < 16 ? (t >> 6) : (t & 63));
            const float inv = powf(10000.f, -(float)(2 * (j & 15)) / 32.f); const float ang = pos * inv; cosT[i] = cosf(ang); sinT[i] = sinf(ang); }
        if (bid == 0 && tid < 2) { const float* lp = INP(I_LAM) + tid * 256; float s1 = 0.f, s2 = 0.f; for (int d = 0; d < 64; ++d) { s1 += lp[d] * lp[64 + d]; s2 += lp[128 + d] * lp[192 + d]; }
            const float lam_init = 0.8f - 0.6f * expf(-0.3f * (float)(2 * tid)); lamv[tid] = expf(s1) - expf(s2) + lam_init; lamv[2 + tid] = 1.f - lam_init; }
        for (int i = bid * NTHREADS + tid; i < 4 * 32 * 1024; i += G * NTHREADS) { const int l = i >> 15, e = (i >> 10) & 31, k = i & 1023; rwT[i] = INP(I_RW)[((size_t)l * 1024 + k) * 32 + e]; } }
        if (PROBE_T == 12) p0t_ = __builtin_amdgcn_s_memtime();
        { LAS float* scr = (LAS float*)(lds + wave * 10240);
          bf16* Wqkv_t = WSP(bf16, WS_WQKV); bf16* Win_t = WSP(bf16, WS_WIN); bf16* Wo_t = WSP(bf16, WS_WO); bf16* Wout_t = WSP(bf16, WS_WOUT); bf16* Wgu_t = WSP(bf16, WS_WGU); bf16* Wd_t = WSP(bf16, WS_WD);
          constexpr int I_QKV = 16 * 96, I_SQ = 16 * 32, I_GU = 16 * 64, I_D = 16 * 32;
          constexpr int T0 = 2 * I_QKV, T1 = T0 + 2 * I_QKV, T2 = T1 + 2 * I_SQ, T3 = T2 + 2 * I_SQ, T4 = T3 + 128 * I_GU, T5 = T4 + 128 * I_D;
          for (int rep = 0; rep < NREP(0); ++rep) {
          for (int it = gw; it < (MOE_FP8 ? T3 : T5); it += NGW) {
            if (it < T0) { const int j = it / I_QKV; if (FP8_ATT) transpose_item8<1>(INP(I_WQKV) + (size_t)j * 1024 * 3072, 1024, 3072, (unsigned char*)Wqkv_t + (size_t)j * 3072 * 1024, scr, it % I_QKV, lane); else transpose_item<1>(INP(I_WQKV) + (size_t)j * 1024 * 3072, 1024, 3072, Wqkv_t + (size_t)j * 3072 * 1024, scr, it % I_QKV, lane); }
            else if (it < T1) { const int r = it - T0, j = r / I_QKV; if (FP8_CONV) transpose_item8<0>(INP(I_WIN) + (size_t)j * 1024 * 3072, 1024, 3072, (unsigned char*)Win_t + (size_t)j * 3072 * 1024, scr, r % I_QKV, lane); else transpose_item<CONV_FUSE_U ? 2 : 0>(INP(I_WIN) + (size_t)j * 1024 * 3072, 1024, 3072, Win_t + (size_t)j * 3072 * 1024, scr, r % I_QKV, lane); }
            else if (it < T2) { const int r = it - T1, j = r / I_SQ; if (FP8_ATT_O) transpose_item8<0>(INP(I_WO) + (size_t)j * 1024 * 1024, 1024, 1024, (unsigned char*)Wo_t + (size_t)j * 1024 * 1024, scr, r % I_SQ, lane); else transpose_item<0>(INP(I_WO) + (size_t)j * 1024 * 1024, 1024, 1024, Wo_t + (size_t)j * 1024 * 1024, scr, r % I_SQ, lane); }
            else if (it < T3) { const int r = it - T2, j = r / I_SQ; if (FP8_CONV) transpose_item8<0>(INP(I_WOUT) + (size_t)j * 1024 * 1024, 1024, 1024, (unsigned char*)Wout_t + (size_t)j * 1024 * 1024, scr, r % I_SQ, lane); else transpose_item<0>(INP(I_WOUT) + (size_t)j * 1024 * 1024, 1024, 1024, Wout_t + (size_t)j * 1024 * 1024, scr, r % I_SQ, lane); }
            else if (it < T4) { const int r = it - T3, j = r / I_GU; transpose_item<0>(INP(I_WGU) + (size_t)j * 1024 * 2048, 1024, 2048, Wgu_t + (size_t)j * 2048 * 1024, scr, r % I_GU, lane); }
            else { const int r = it - T4, j = r / I_D; transpose_item<0>(INP(I_WD) + (size_t)j * 1024 * 1024, 1024, 1024, Wd_t + (size_t)j * 1024 * 1024, scr, r % I_D, lane); }
          }
          if (MOE_FP8) {
            constexpr int NGUI = 128 * I_GU, NMOE = NGUI + 128 * I_D;
            const float* wgu = INP(I_WGU); const float* wd = INP(I_WD);
#define MOE_DEC(r_, W_, N_, WT_, IT_) do { if ((r_) < NGUI) { const int j_ = (r_) / I_GU; W_ = wgu + (size_t)j_ * 1024 * 2048; N_ = 2048; WT_ = (unsigned char*)Wgu_t + (size_t)j_ * 2048 * 1024; IT_ = (r_) % I_GU; } \
              else { const int q_ = (r_) - NGUI, j_ = q_ / I_D; W_ = wd + (size_t)j_ * 1024 * 1024; N_ = 1024; WT_ = (unsigned char*)Wd_t + (size_t)j_ * 1024 * 1024; IT_ = q_ % I_D; } } while (0)
            f32x4 vc[8], vn[8]; const float* Wc = nullptr; int Nc = 0, itc = 0; unsigned char* WTc = nullptr;
            int r = gw;
            if (r < NMOE) { MOE_DEC(r, Wc, Nc, WTc, itc); item8_load(Wc, Nc, itc, lane, vc); }
            for (; r < NMOE; r += NGW) { const int rn = r + NGW; const bool hn = rn < NMOE; const float* Wn = Wc; int Nn = Nc, itn = itc; unsigned char* WTn = WTc;
                if (hn) { MOE_DEC(rn, Wn, Nn, WTn, itn); item8_load(Wn, Nn, itn, lane, vn); }
                item8_store(vc, 1024, Nc, WTc, scr, itc, lane);
                if (hn) { Wc = Wn; Nc = Nn; itc = itn; WTc = WTn;
#pragma unroll
                    for (int i = 0; i < 8; ++i) vc[i] = vn[i]; } }
#undef MOE_DEC
          }
          }
        }
        if (PROBE_T == 12 && bid == 0 && tid == 0) *(LAS unsigned long long*)(lds + LX_MISC + 64) += __builtin_amdgcn_s_memtime() - p0t_;
        __syncthreads();
    }
    SEAM(0);

    if (PS(1) && IN(1)) { PHASE_IDS
        const float* g = INP(I_NORMG); const float* modv = WSP(float, WS_MODV); float* X = WSP(float, WS_X); bf16* H = WSP(bf16, WS_H);
        for (int row = gw; row < M; row += NGW) { const int b = row_batch(row), jj = row % RPB; const bool cx = jj < CTXL; const int rb = cx ? 16 : b;
            const float* src = cx ? INP(I_CTX) + ((size_t)b * CTXL + jj) * D : INP(I_X) + ((size_t)b * SEQ + (jj - CTXL)) * D;
            f32x4 v[4]; load_row_f32(src, lane, v);
            norm_mod_store_mix(FP8_ATT != 0, v, g, modv + rb * 6144 + 1024, modv + rb * 6144, lane, H + (size_t)row * D, WSP(unsigned char, WS_H8) + (size_t)row * 1024); }
    }
    SEAM(1);

    for (int l = 0; l < DEPTH; ++l) {
        const int pb = 2 + 7 * l; const bool attn = (l & 1) == 0; const int j2 = l >> 1; const bool lat_only = (l == DEPTH - 1);
#define MV() (WSP(float, WS_MODV) + (size_t)l * 17 * 6144)
        const unsigned* gcnt = (const unsigned*)(ctl + CW_CNT) + l * 32;

        if (IN(pb)) { PHASE_IDS
            if (PS(2) && attn) {
                constexpr int RBX = FP8_ATT ? 1024 : 2048; constexpr int SCX = FP8_ATT ? 0x78787878 : 0;
                typedef SchedQKV<RBX, SCX> SQ;
                SQ S{FP8_ATT ? (const char*)WSP(unsigned char, WS_H8) : (const char*)WSP(bf16, WS_H), (const char*)WSP(bf16, WS_WQKV) + (size_t)j2 * 3072 * RBX};
                EpiQKV E{WSP(bf16, WS_Q), WSP(bf16, WS_K), WSP(bf16, WS_VT), WSP(float, WS_ROPE), WSP(float, WS_ROPE) + 2048 * 32, true, lds + LX_EPI};
                for (int rep = 0; rep < NREP(2); ++rep) { int z_ = rep; asm volatile("" : "+s"(z_)); E.dost = !PROBE_NOST || (z_ == NREP(2) - 1); pg8::gemm_phase<EpiQKV, SQ, 2>(lds, S, E, tid, STAG(1500)); }
            } else if (PS(3)) {
                constexpr int RBX = FP8_CONV ? 1024 : 2048; constexpr int SCX = FP8_CONV ? 0x78787878 : 0;
                typedef SchedPlain<RBX, SCX> SP;
                SP S{FP8_CONV ? (const char*)WSP(unsigned char, WS_H8) : (const char*)WSP(bf16, WS_H), (const char*)WSP(bf16, WS_WIN) + (size_t)j2 * 3072 * RBX, 12, lat_only};
                if (CONV_FUSE_U) { EpiConvIn E{WSP(bf16, WS_BCO), WSP(bf16, WS_BCO) + (size_t)M * 1024};
                    for (int rep = 0; rep < NREP(3); ++rep) pg8::gemm_phase<EpiConvIn, SP, 3>(lds, S, E, tid, STAG(1500)); }
                else { EpiPlain E{WSP(bf16, WS_BCO), 3072};
                    for (int rep = 0; rep < NREP(3); ++rep) pg8::gemm_phase<EpiPlain, SP, 3>(lds, S, E, tid, STAG(1500)); }
            }
        }
        SEAM(pb);

        if (IN(pb + 1)) { PHASE_IDS
            if (PS(4) && attn) {
                const float* lamv = WSP(float, WS_MISC); const float lam = lamv[j2], osc = lamv[2 + j2]; const float* subg = INP(I_SUBG) + j2 * 128;
                const bf16* Qb = WSP(bf16, WS_Q); const bf16* Kb = WSP(bf16, WS_K); const bf16* Vt = WSP(bf16, WS_VT); bf16* Ob = WSP(bf16, WS_O);
                LAS float* wsc = (LAS float*)(lds + LX_WSC + wave * 1024);
                const int vcu = (G % 8 == 0) ? (bid % 8) * (G / 8) + bid / 8 : bid;
                for (int rep = 0; rep < NREP(4); ++rep)
                if (G == 256) {
                    const int xc = bid & 7, j = bid >> 3;
                    for (int sstep = 0; sstep < 8; ++sstep) { const int bh = xc * 16 + 2 * sstep + (j >> 4), b = bh >> 3, h = bh & 7;
                        ATT_CALL(lds, wsc, Qb, Kb, Vt, Ob, b * RPB, h, b * RPB + CTXL + (j & 15) * 128, 36, lam, osc, subg, tid); }
                    { const int bh = xc * 16 + (j >> 1), b = bh >> 3, h = bh & 7;
                      ATT_CALL(lds, wsc, Qb, Kb, Vt, Ob, b * RPB, h, b * RPB + (j & 1) * 128, 4, lam, osc, subg, tid); }
                } else {
                    for (int u = bid; u < 128 * 18; u += G) { const int bh = u / 18, k = u % 18, b = bh >> 3, h = bh & 7;
                        ATT_CALL(lds, wsc, Qb, Kb, Vt, Ob, b * RPB, h, k < 16 ? b * RPB + CTXL + k * 128 : b * RPB + (k - 16) * 128, k < 16 ? 36 : 4, lam, osc, subg, tid); }
                }
            } else if (PS(5)) {
                const float* cw = INP(I_CONVW) + (size_t)j2 * 3 * 1024; const bf16* BCO = WSP(bf16, WS_BCO); bf16* Ob = WSP(bf16, WS_O);
                const int nact = lat_only ? 32768 : M; const int nitems = (nact / 16) * 2;
                for (int it = gw; it < nitems; it += NGW) { const int strip = it >> 1, ch = (it & 1) * 512 + lane * 8; const int row0 = act_row(strip * 16, lat_only);
                    const int jj = row0 % RPB; const int seq_lo = jj < CTXL ? row0 - jj : row0 - jj + CTXL, seq_hi = jj < CTXL ? row0 - jj + CTXL : row0 - jj + RPB;
                    float w0[8], w1[8], w2[8];
#pragma unroll
                    for (int q = 0; q < 8; ++q) { w0[q] = cw[ch + q]; w1[q] = cw[1024 + ch + q]; w2[q] = cw[2048 + ch + q]; }
                    float up[8], uc[8], un[8];
                    auto load_u = [&](int row, float (&u)[8]) {
                        if (row < seq_lo || row >= seq_hi) {
#pragma unroll
                            for (int q = 0; q < 8; ++q) u[q] = 0.f;
                        } else if (CONV_FUSE_U) { const u32x4 uu = *(const u32x4*)(BCO + (size_t)M * 1024 + (size_t)row * 1024 + ch);
#pragma unroll
                            for (int q = 0; q < 4; ++q) { u[2 * q] = bf2f((unsigned short)(uu[q] & 0xffffu)); u[2 * q + 1] = bf2f((unsigned short)(uu[q] >> 16)); }
                        } else { const bf16* p = BCO + (size_t)row * 3072; const u32x4 gc = *(const u32x4*)(p + 1024 + ch), xt = *(const u32x4*)(p + 2048 + ch);
#pragma unroll
                            for (int q = 0; q < 4; ++q) { u[2 * q] = bf2f((unsigned short)(gc[q] & 0xffffu)) * bf2f((unsigned short)(xt[q] & 0xffffu)); u[2 * q + 1] = bf2f((unsigned short)(gc[q] >> 16)) * bf2f((unsigned short)(xt[q] >> 16)); } } };
                    load_u(row0 - 1, up); load_u(row0, uc);
                    for (int r = 0; r < 16; ++r) { const int row = row0 + r; load_u(row + 1, un);
                        const u32x4 gb = *(const u32x4*)(BCO + (size_t)row * (CONV_FUSE_U ? 1024 : 3072) + ch); float z[8];
#pragma unroll
                        for (int q = 0; q < 8; ++q) { const float gbv = bf2f((unsigned short)((q & 1) ? (gb[q >> 1] >> 16) : (gb[q >> 1] & 0xffffu))); z[q] = gbv * (w0[q] * up[q] + w1[q] * uc[q] + w2[q] * un[q]); }
                        if (FP8_CONV) { u32x2 o; o.x = pack_fp8x4(4.f * z[0], 4.f * z[1], 4.f * z[2], 4.f * z[3]); o.y = pack_fp8x4(4.f * z[4], 4.f * z[5], 4.f * z[6], 4.f * z[7]); *(u32x2*)((unsigned char*)Ob + (size_t)row * 1024 + ch) = o; }
                        else { u32x4 o; o.x = cvt_pk_bf16(z[0], z[1]); o.y = cvt_pk_bf16(z[2], z[3]); o.z = cvt_pk_bf16(z[4], z[5]); o.w = cvt_pk_bf16(z[6], z[7]);
                        *(u32x4*)(Ob + (size_t)row * 1024 + ch) = o; }
#pragma unroll
                        for (int q = 0; q < 8; ++q) { up[q] = uc[q]; uc[q] = un[q]; } } }
            }
        }
        SEAM(pb + 1);

        if (PS(6) && IN(pb + 2)) { PHASE_IDS
            float* X = WSP(float, WS_X);
            EpiResid E{X, X, MV() + 2 * 1024, l == 0 ? INP(I_X) : nullptr, l == 0 ? INP(I_CTX) : nullptr};
            if (attn) { constexpr int RBX = FP8_ATT_O ? 1024 : 2048; constexpr int SCX = FP8_ATT_O ? 0x79797979 : 0;
                typedef SchedPlain<RBX, SCX> SP;
                SP S{(const char*)WSP(bf16, WS_O), (const char*)WSP(bf16, WS_WO) + (size_t)j2 * 1024 * RBX, 4, lat_only};
                pg8::gemm_phase<EpiResid, SP, 6>(lds, S, E, tid, STAG(1500));
            } else { constexpr int RBX = FP8_CONV ? 1024 : 2048; constexpr int SCX = FP8_CONV ? 0x79797979 : 0;
                typedef SchedPlain<RBX, SCX> SP;
                SP S{(const char*)WSP(bf16, WS_O), (const char*)WSP(bf16, WS_WOUT) + (size_t)j2 * 1024 * RBX, 4, lat_only};
                pg8::gemm_phase<EpiResid, SP, 6>(lds, S, E, tid, STAG(1500));
            }
        }
        SEAM(pb + 2);

        if (PS(7) && IN(pb + 3)) { PHASE_IDS
            LAS int* lcnt = (LAS int*)(lds + LX_LCNT); LAS int* lbase = (LAS int*)(lds + LX_LBASE); LAS int* asg = (LAS int*)(lds + LX_ASG);
            LAS float* wsc = (LAS float*)(lds + LX_WSC + wave * 1024);
            LAS unsigned char* tile = lds;
            LAS float* part = (LAS float*)(lds + 65536);
            float* X = WSP(float, WS_X); bf16* H = WSP(bf16, WS_H); const float* mv = MV(); int* topE = WSP(int, WS_TOPE); float* topG = WSP(float, WS_TOPG); int* topP = WSP(int, WS_TOPP); int* list = WSP(int, WS_LIST);
            const int r32 = lane & 31, hi = lane >> 5;
            bf16x8 wf[8];
            { const float* rw = WSP(float, WS_RW) + (size_t)l * 32 * 1024 + r32 * 1024 + wave * 128 + hi * 8;
#pragma unroll
              for (int s8 = 0; s8 < 8; ++s8) { const f32x4 a = *(const f32x4*)(rw + 16 * s8), b = *(const f32x4*)(rw + 16 * s8 + 4); wf[s8] = __builtin_bit_cast(bf16x8, pack8(a, b)); } }
            __syncthreads();
            if (tid < 32) lcnt[tid] = 0;
            __syncthreads();
            const int nact = lat_only ? 32768 : M; const int rpb = (nact + G - 1) / G; const int a0 = bid * rpb; int nr = nact - a0; nr = nr < 0 ? 0 : (nr > rpb ? rpb : nr);
            const float* g = INP(I_NORMG) + ((size_t)l * 2 + 1) * 1024; const float* rb_ = INP(I_RB) + l * 32;
            for (int g0 = 0; g0 < nr; g0 += 32) {
                f32x4 v[4][4]; int rowq[4]; bool okq[4];
#pragma unroll
                for (int q = 0; q < 4; ++q) { const int i = g0 + wave + 8 * q; okq[q] = i < nr; rowq[q] = act_row(a0 + (okq[q] ? i : nr - 1), lat_only); load_row_x(X, (size_t)rowq[q], lane, v[q]); }
#pragma unroll
                for (int q = 0; q < 4; ++q) { const int row = rowq[q]; const int rb = row_is_ctx(row) ? 16 : row_batch(row); const int tr = wave + 8 * q;
                    norm_mod_f32(v[q], g, mv + rb * 6144 + 4 * 1024, mv + rb * 6144 + 3 * 1024, lane);
                    if (MOE_FP8) { unsigned char* h8 = WSP(unsigned char, WS_H8) + (size_t)row * 1024;
#pragma unroll
                        for (int j = 0; j < 4; ++j) { const unsigned pk_ = pack_fp8x4(16.f * v[q][j][0], 16.f * v[q][j][1], 16.f * v[q][j][2], 16.f * v[q][j][3]); if (okq[q]) *(unsigned*)(h8 + 256 * j + 4 * lane) = pk_; } }
#pragma unroll
                    for (int j = 0; j < 4; ++j) { u32x2 w; w.x = cvt_pk_bf16(v[q][j][0], v[q][j][1]); w.y = cvt_pk_bf16(v[q][j][2], v[q][j][3]);
                        if (!MOE_FP8 && okq[q]) *(u32x2*)(H + (size_t)row * D + 256 * j + 4 * lane) = w;
                        const int ch = 32 * j + (lane >> 1); *(LAS u32x2*)(tile + tr * 2048 + ((ch ^ (tr & 15)) << 4) + (lane & 1) * 8) = w; } }
                __syncthreads();
                { f32x16 acc = f32x16{};
#pragma unroll
                  for (int s8 = 0; s8 < 8; ++s8) { const int ch = wave * 16 + 2 * s8 + hi; const bf16x8 bfr = *(const LAS bf16x8*)(tile + r32 * 2048 + ((ch ^ (r32 & 15)) << 4));
                      acc = __builtin_amdgcn_mfma_f32_32x32x16_bf16(wf[s8], bfr, acc, 0, 0, 0); }
#pragma unroll
                  for (int r = 0; r < 16; ++r) { const int e = (r & 3) + 8 * (r >> 2) + 4 * hi; part[(wave * 32 + e) * 33 + r32] = acc[r]; } }
                __syncthreads();
#pragma unroll 1
                for (int q = 0; q < 4; ++q) { const int tr = wave + 8 * q; const int i = g0 + tr; const int row = rowq[q]; const int my_e = r32;
                    float lg = rb_[my_e];
#pragma unroll
                    for (int w8 = 0; w8 < 8; ++w8) lg += part[(w8 * 32 + my_e) * 33 + tr];
                    if (lane < 32) wsc[my_e] = lg;
                    asm volatile("s_waitcnt lgkmcnt(0)" ::: "memory");
                    int rank = 0;
#pragma unroll
                    for (int e = 0; e < 32; ++e) { const float o = wsc[e]; rank += (o > lg || (o == lg && e < my_e)) ? 1 : 0; }
                    asm volatile("s_waitcnt lgkmcnt(0)" ::: "memory");
                    if (lane < 32 && rank < 4) { wsc[64 + rank] = lg; ((LAS int*)wsc)[72 + rank] = my_e; }
                    asm volatile("s_waitcnt lgkmcnt(0)" ::: "memory");
                    const float t0 = wsc[64], t1 = wsc[65], t2 = wsc[66], t3 = wsc[67];
                    const float p0 = 1.f, p1 = __expf(t1 - t0), p2 = __expf(t2 - t0), p3 = __expf(t3 - t0); const float inv = 1.f / (p0 + p1 + p2 + p3);
                    if (lane < 4 && okq[q]) { const int e = ((LAS int*)wsc)[72 + lane]; const float p = lane == 0 ? p0 : lane == 1 ? p1 : lane == 2 ? p2 : p3;
                        const int lp = __hip_atomic_fetch_add(lcnt + e, 1, __ATOMIC_RELAXED, __HIP_MEMORY_SCOPE_WORKGROUP);
                        topE[row * 4 + lane] = e; topG[row * 4 + lane] = p * inv; asg[i * 4 + lane] = (lp << 5) | e; }
                    asm volatile("s_waitcnt lgkmcnt(0)" ::: "memory");
                }
            }
            __syncthreads();
            if (tid < 32) lbase[tid] = (int)__hip_atomic_fetch_add((unsigned*)gcnt + tid, (unsigned)lcnt[tid], RLX_AGENT);
            __syncthreads();
            for (int i = tid; i < nr * 4; i += NTHREADS) { const int av = asg[i], e = av & 31, pos = lbase[e] + (av >> 5); const int row = act_row(a0 + (i >> 2), lat_only);
                list[(size_t)e * CAP + pos] = row; topP[row * 4 + (i & 3)] = pos; }
            __syncthreads();
        }
        SEAM(pb + 3);

        if (PS(8) && IN(pb + 4)) { PHASE_IDS
            moe_table(lds, gcnt, tid);
            constexpr int RBM = MOE_FP8 ? 1024 : 2048;
            typedef SchedMoe<true, RBM, 0x78787878, 0x78787878> SG;
            SG S{(const char*)(MOE_FP8 ? (void*)WSP(unsigned char, WS_H8) : (void*)WSP(bf16, WS_H)), (const char*)WSP(bf16, WS_WGU) + (size_t)l * 32 * 2048 * RBM, WSP(int, WS_LIST), 8, (size_t)2048 * RBM,
                 (LAS const int*)(lds + LX_TSTART), (LAS const int*)(lds + LX_ECNT), (LAS const int*)(lds + LX_TILEE)};
            EpiSwiglu<MOE_FP8 != 0> E{WSP(bf16, WS_ACT), INP(I_BGU) + (size_t)l * 32 * 2048, lds + LX_EPI};
            pg8::gemm_phase<EpiSwiglu<MOE_FP8 != 0>, SG, 8>(lds, S, E, tid, STAG(900));
        }
        SEAM(pb + 4);

        if (PS(9) && IN(pb + 5)) { PHASE_IDS
            if (MK_PER_PHASE || lo == pb + 5) moe_table(lds, gcnt, tid);
            constexpr int RBM = MOE_FP8 ? 1024 : 2048;
            typedef SchedMoe<false, RBM, 0x79797979, 0x79797979> SD;
            SD S{(const char*)WSP(bf16, WS_ACT), (const char*)WSP(bf16, WS_WD) + (size_t)l * 32 * 1024 * RBM, WSP(int, WS_LIST), 4, (size_t)1024 * RBM,
                 (LAS const int*)(lds + LX_TSTART), (LAS const int*)(lds + LX_ECNT), (LAS const int*)(lds + LX_TILEE)};
            EpiDown E{WSP(bf16, WS_Y), INP(I_BD) + (size_t)l * 32 * 1024, lds + LX_EPI};
            pg8::gemm_phase<EpiDown, SD, 9>(lds, S, E, tid, STAG(1100));
            if (PROBE_T && l == DEPTH - 1 && bid == (PROBE_T == 10 ? PROBE_BID : 0) && tid == 0) { unsigned long long acc_ = *(LAS unsigned long long*)(lds + LX_MISC + 64); unsigned long long tot_ = __builtin_amdgcn_s_memtime() - pt_start;
                if (PROBE_T == 9) { acc_ = tot_; tot_ = (__builtin_amdgcn_s_memrealtime() - pt_rstart) * 30ull; }
                WSP(float, WS_MISC)[16] = floorf((float)((double)acc_ / (double)tot_) * PROBE_TQ + 0.5f) / PROBE_TQ; }
        }
        SEAM(pb + 5);

        if (PS(10) && IN(pb + 6)) { PHASE_IDS
            if (MK_PER_PHASE || lo >= pb + 5) moe_table(lds, gcnt, tid);
            LAS const int* tstart = (LAS const int*)(lds + LX_TSTART);
            const int nact = lat_only ? 32768 : M;
            const float* gn = (l + 1 < DEPTH) ? INP(I_NORMG) + (size_t)(l + 1) * 2 * 1024 : INP(I_FINALG);
            const float* mv = MV(); const float* mvn = mv + 17 * 6144; float* X = WSP(float, WS_X); bf16* H = WSP(bf16, WS_H); const bf16* Yb = WSP(bf16, WS_Y);
            const int* topE = WSP(int, WS_TOPE); const float* topG = WSP(float, WS_TOPG); const int* topP = WSP(int, WS_TOPP);
            for (int ai = gw; ai < nact; ai += 2 * NGW) {
                int row[2]; bool ok[2]; int4 ev[2], pv[2]; f32x4 gv[2];
#pragma unroll
                for (int u = 0; u < 2; ++u) { const int a2 = ai + u * NGW; ok[u] = a2 < nact; row[u] = act_row(ok[u] ? a2 : ai, lat_only);
                    ev[u] = *(const int4*)(topE + row[u] * 4); pv[u] = *(const int4*)(topP + row[u] * 4); gv[u] = *(const f32x4*)(topG + row[u] * 4); }
                f32x4 v[2][4]; u32x2 yw[2][4][4];
#pragma unroll
                for (int u = 0; u < 2; ++u) { load_row_x(X, (size_t)row[u], lane, v[u]);
                    const int ee[4] = {ev[u].x, ev[u].y, ev[u].z, ev[u].w}, pp[4] = {pv[u].x, pv[u].y, pv[u].z, pv[u].w};
#pragma unroll
                    for (int k = 0; k < 4; ++k) { const size_t yrow = (size_t)(tstart[ee[k]] * 256 + pp[k]);
#pragma unroll
                        for (int j = 0; j < 4; ++j) { if (Y_FP8) { yw[u][k][j].x = *(const unsigned*)((const unsigned char*)Yb + yrow * 1024 + 256 * j + 4 * lane); yw[u][k][j].y = 0u; }
                            else yw[u][k][j] = *(const u32x2*)(Yb + yrow * 1024 + 256 * j + 4 * lane); } } }
#pragma unroll
                for (int u = 0; u < 2; ++u) { if (!ok[u]) continue;
                    const int rw_ = row[u]; const bool cx = row_is_ctx(rw_); const int rb = cx ? 16 : row_batch(rw_);
                    f32x4 acc4[4];
#pragma unroll
                    for (int j = 0; j < 4; ++j) acc4[j] = (f32x4){0.f, 0.f, 0.f, 0.f};
#pragma unroll
                    for (int k = 0; k < 4; ++k) { const float gk = gv[u][k];
#pragma unroll
                        for (int j = 0; j < 4; ++j) { const u32x2 w = yw[u][k][j];
                            if (Y_FP8) { const f32x2 lo = __builtin_amdgcn_cvt_pk_f32_fp8((int)w.x, false), hi2 = __builtin_amdgcn_cvt_pk_f32_fp8((int)w.x, true); const float g16 = gk * (1.f / 16.f);
                                acc4[j][0] += g16 * lo[0]; acc4[j][1] += g16 * lo[1]; acc4[j][2] += g16 * hi2[0]; acc4[j][3] += g16 * hi2[1]; }
                            else { acc4[j][0] += gk * bf2f((unsigned short)(w.x & 0xffffu)); acc4[j][1] += gk * bf2f((unsigned short)(w.x >> 16)); acc4[j][2] += gk * bf2f((unsigned short)(w.y & 0xffffu)); acc4[j][3] += gk * bf2f((unsigned short)(w.y >> 16)); } } }
                    const float* g2 = mv + rb * 6144 + 5 * 1024;
#pragma unroll
                    for (int j = 0; j < 4; ++j) { const f32x4 gg = *(const f32x4*)(g2 + 256 * j + 4 * lane); v[u][j] = v[u][j] + gg * acc4[j]; }
                    if (l + 1 < DEPTH) {
                        store_row_x(X, (size_t)rw_, lane, v[u]);
                        if (!(l + 1 == DEPTH - 1 && cx))
                            norm_mod_store_mix(((l + 1) & 1) ? (FP8_CONV != 0) : (FP8_ATT != 0), v[u], gn, mvn + rb * 6144 + 1024, mvn + rb * 6144, lane, H + (size_t)rw_ * D, WSP(unsigned char, WS_H8) + (size_t)rw_ * 1024);
                    } else {
                        float rstd = row_rstd(v[u]); if (PROBE_T) rstd *= 1.f + sqrtf(WSP(float, WS_MISC)[16]); float* op = OUTP() + ((size_t)row_batch(rw_) * SEQ + (rw_ % RPB - CTXL)) * D;
#pragma unroll
                        for (int j = 0; j < 4; ++j) { const f32x4 gg = *(const f32x4*)(gn + 256 * j + 4 * lane); *(f32x4*)(op + 256 * j + 4 * lane) = (v[u][j] * rstd) * gg; }
                    }
                }
            }
        }
        if (l + 1 < DEPTH) SEAM(pb + 6);
    }
#undef IN
#undef SEAM
#undef MV
}

extern "C" void kernel_launch(void* const* d_in, const int* in_sizes, int n_in, void* d_out, int out_size, void* d_ws, size_t ws_size, hipStream_t stream) {
    static int grid = 0;
    if (grid == 0) {
        if (n_in != 21 || out_size != NB * SEQ * D || ws_size < WS_END) { fprintf(stderr, "kernel_launch: unexpected shapes (n_in %d, out %d, ws %zu)\n", n_in, out_size, ws_size); grid = -1; return; }
        int dev = 0, cus = 0, per_cu = 0;
        if (hipGetDevice(&dev) != hipSuccess || hipDeviceGetAttribute(&cus, hipDeviceAttributeMultiprocessorCount, dev) != hipSuccess) { grid = -1; return; }
        if (hipFuncSetAttribute((const void*)fwd, hipFuncAttributeMaxDynamicSharedMemorySize, LDS_BYTES) != hipSuccess) { fprintf(stderr, "kernel_launch: hipFuncSetAttribute failed\n"); grid = -1; return; }
        if (hipOccupancyMaxActiveBlocksPerMultiprocessor(&per_cu, (const void*)fwd, NTHREADS, LDS_BYTES) != hipSuccess || per_cu < 1) { fprintf(stderr, "kernel_launch: occupancy query says %d\n", per_cu); }
        (void)hipGetLastError();
        if (cus < 160) { fprintf(stderr, "kernel_launch: needs >= 160 CUs\n"); grid = -1; return; }
        grid = cus;
    }
    if (grid < 0) return;
    if (hipMemsetAsync((char*)d_ws + WS_CTL, 0, CTL_ZERO_BYTES, stream) != hipSuccess) return;
    Args a{};
    for (int i = 0; i < 21; ++i) a.in[i] = (const float*)d_in[i];
    a.out = (float*)d_out; a.ws = (unsigned char*)d_ws;
#if MK_PER_PHASE
    for (int p = 0; p < NPHASE; ++p) { a.ph_lo = p; a.ph_hi = p + 1; hipLaunchKernelGGL(fwd, dim3(grid), dim3(NTHREADS), LDS_BYTES, stream, a); }
#else
    a.ph_lo = 0; a.ph_hi = NPHASE;
    hipLaunchKernelGGL(fwd, dim3(grid), dim3(NTHREADS), LDS_BYTES, stream, a);
#endif
    const hipError_t le = hipPeekAtLastError();
    if (le != hipSuccess) fprintf(stderr, "kernel_launch: launch failed: %s\n", hipGetErrorName(le));
}
```

```cpp
#include <hip/hip_runtime.h>
#include <cstdio>
#include <cstdint>

#ifndef MK_PER_PHASE
#define MK_PER_PHASE 0
#endif

#ifndef MOE_FP8
#define MOE_FP8 1
#endif
#ifndef STAGGER
#define STAGGER 0
#endif
#define STAG(t) (STAGGER ? (t) : 0)
#ifndef PROBE_T
#define PROBE_T 0
#endif
#ifndef PROBE_TQ
#define PROBE_TQ 30.f
#endif
#ifndef ATT_PROBE_TID
#define ATT_PROBE_TID 0
#endif
#ifndef PROBE_BID
#define PROBE_BID 0
#endif
#ifndef PROBE_TPH
#define PROBE_TPH 8
#endif
#ifndef FP8_ATT
#define FP8_ATT 1
#endif
#ifndef FP8_ATT_O
#define FP8_ATT_O 1
#endif
#ifndef FP8_CONV
#define FP8_CONV 0
#endif
#ifndef X_BF16
#define X_BF16 1
#endif
#ifndef Y_FP8
#define Y_FP8 1
#endif
#ifndef CONV_FUSE_U
#define CONV_FUSE_U 1
#endif
#ifndef ATT_FP8
#define ATT_FP8 1
#endif
#ifndef PHSEL
#define PHSEL 0xffff
#endif
#define PS(k) ((PHSEL >> (k)) & 1)
#ifndef PROBE_REP
#define MOE_XCD_RANGE 1
#define PROBE_REP 0
#endif
#define NREP(k) (1 + ((PROBE_REP >> (k)) & 1))
#ifndef PROBE_NOST
#define PROBE_NOST 0
#endif
#define GAS __attribute__((address_space(1)))
#define LAS __attribute__((address_space(3)))
typedef unsigned short bf16;
typedef short bf16x8 __attribute__((ext_vector_type(8)));
typedef float f32x4 __attribute__((ext_vector_type(4)));
typedef float f32x2 __attribute__((ext_vector_type(2)));
typedef float f32x16 __attribute__((ext_vector_type(16)));
typedef unsigned u32x4 __attribute__((ext_vector_type(4)));
typedef unsigned u32x2 __attribute__((ext_vector_type(2)));
typedef GAS unsigned gu32;

constexpr int D = 1024, NB = 16, SEQ = 2048, CTXL = 256, RPB = SEQ + CTXL, M = NB * RPB, DEPTH = 4;
constexpr int NE = 32, TOPK = 4, NMOD = 6;
constexpr int CAP = M;
constexpr int ACT_ROWS = M * TOPK + NE * 256;
constexpr float EPS = 1e-5f;
constexpr float C2 = 0.125f * 1.4426950408889634f;
constexpr int NPHASE = 2 + 7 * DEPTH;
static_assert(!(FP8_CONV && CONV_FUSE_U), "the fused u epilogue needs the (bf16) interleaved copy of conv_w_in");

constexpr size_t MiB = 1u << 20;
constexpr size_t WS_CTL = 0, CTL_ZERO_BYTES = 1 * MiB;
constexpr size_t WS_MODV = 1 * MiB;
constexpr size_t WS_ROPE = 3 * MiB;
constexpr size_t WS_RW = 4 * MiB;
constexpr size_t WS_MISC = 5 * MiB;
constexpr size_t WS_TOPE = 6 * MiB;
constexpr size_t WS_TOPG = 7 * MiB;
constexpr size_t WS_TOPP = 8 * MiB;
constexpr size_t WS_LIST = 9 * MiB;
constexpr size_t WS_WQKV = 16 * MiB;
constexpr size_t WS_WIN = 28 * MiB;
constexpr size_t WS_WO = 40 * MiB;
constexpr size_t WS_WOUT = 44 * MiB;
constexpr size_t WS_WGU = 48 * MiB;
constexpr size_t WS_WD = 560 * MiB;
constexpr size_t WS_X = 816 * MiB;
constexpr size_t WS_H = 960 * MiB;
constexpr size_t WS_Q = 1032 * MiB;
constexpr size_t WS_K = 1104 * MiB;
constexpr size_t WS_VT = 1176 * MiB;
constexpr size_t WS_BCO = WS_Q;
constexpr size_t WS_O = 1248 * MiB;
constexpr size_t WS_ACT = 1320 * MiB;
constexpr size_t WS_Y = 1624 * MiB;
constexpr size_t WS_H8 = 1928 * MiB;
constexpr size_t WS_END = 1964 * MiB;
static_assert((size_t)M * 3072 * 2 == 216 * MiB && (size_t)ACT_ROWS * 2048 == 304 * MiB && (size_t)M * 4096 == 144 * MiB, "ws map");

constexpr int CW_TMO = 0;
constexpr int CW_BAR = 4096;
constexpr int CW_CNT = 16384;

constexpr int RING_BYTES = 131072;
constexpr int LX = RING_BYTES;
constexpr int LX_MISC = LX + 0;
constexpr int LX_TSTART = LX + 256;
constexpr int LX_ECNT = LX + 512;
constexpr int LX_LCNT = LX + 640;
constexpr int LX_LBASE = LX + 768;
constexpr int LX_TILEE = LX + 1024;
constexpr int LX_WSC = LX + 4096;
constexpr int LX_ASG = LX + 12288;
constexpr int LX_EPI = LX + 16384;
constexpr int LDS_BYTES = LX + 32768;
constexpr int NWAVES = 8, NTHREADS = 512;

#define RLX_AGENT __ATOMIC_RELAXED, __HIP_MEMORY_SCOPE_AGENT
__device__ __forceinline__ unsigned f2bf(float f) { unsigned u = __builtin_bit_cast(unsigned, f); return (u + 0x7fffu + ((u >> 16) & 1u)) >> 16; }
typedef __bf16 bf16x2_t __attribute__((ext_vector_type(2)));
__device__ __forceinline__ unsigned cvt_pk_bf16(float lo, float hi) { const f32x2 v = {lo, hi}; const bf16x2_t b = __builtin_convertvector(v, bf16x2_t); return __builtin_bit_cast(unsigned, b); }
__device__ __forceinline__ float bf2f(unsigned short b) { return __builtin_bit_cast(float, (unsigned)b << 16); }
__device__ __forceinline__ float wave_sum(float v) {
    v += __builtin_bit_cast(float, __builtin_amdgcn_update_dpp(0, __builtin_bit_cast(int, v), 0xB1, 0xF, 0xF, true));
    v += __builtin_bit_cast(float, __builtin_amdgcn_update_dpp(0, __builtin_bit_cast(int, v), 0x4E, 0xF, 0xF, true));
    v += __builtin_bit_cast(float, __builtin_amdgcn_update_dpp(0, __builtin_bit_cast(int, v), 0x124, 0xF, 0xF, true));
    v += __builtin_bit_cast(float, __builtin_amdgcn_update_dpp(0, __builtin_bit_cast(int, v), 0x128, 0xF, 0xF, true));
    v += __shfl_xor(v, 16);
    auto rr = __builtin_amdgcn_permlane32_swap(__float_as_uint(v), __float_as_uint(v), false, false);
    return __uint_as_float(rr[0]) + __uint_as_float(rr[1]);
}

#define XB_TMO      128
#define XB_XCNT(j)  (256  + 64 * (j))
#define XB_XSUB(j)  (1280 + 64 * (j))
#define XB_XGEN(j)  (2304 + 64 * (j))
#define XB_TOP      3328
#define XB_TOPGEN   3392
#define XCD_BAR_WORDS 3456
#define XB_SPIN_CAP (1u << 18)
__device__ __forceinline__ unsigned xb_ld(unsigned* p)              { return __hip_atomic_load(p, __ATOMIC_RELAXED, __HIP_MEMORY_SCOPE_AGENT); }
__device__ __forceinline__ unsigned xb_add(unsigned* p, unsigned v) { return __hip_atomic_fetch_add(p, v, __ATOMIC_RELAXED, __HIP_MEMORY_SCOPE_AGENT); }
__device__ __forceinline__ unsigned xb_xcc_id() { return (unsigned)__builtin_amdgcn_s_getreg((3 << 11) | 20) & 0xFu; }
#define XB_SPIN(cond, bar) do { unsigned _sp = 0; while (cond) { __builtin_amdgcn_s_sleep(1); \
    if ((++_sp & 255u) == 0u) { if (xb_ld(&(bar)[XB_TMO])) break; if (_sp > XB_SPIN_CAP) { atomicAdd(&(bar)[XB_TMO], 1u); break; } } } } while (0)
struct XcdBarrier { unsigned* bar; unsigned x; volatile LAS unsigned* st; };
__device__ __forceinline__ XcdBarrier xcd_barrier_post(unsigned* bar, volatile LAS unsigned* st) {
    XcdBarrier b; b.bar = bar; b.x = xb_xcc_id(); b.st = st;
    if (threadIdx.x == 0) (void)xb_add(&bar[XB_XCNT(b.x)], 1u);
    return b;
}
__device__ __forceinline__ void xcd_barrier_complete(unsigned* bar, unsigned x, unsigned& nloc, unsigned& nx) {
    const unsigned G = gridDim.x * gridDim.y * gridDim.z;
    unsigned sum, cnt, mine, sp = 0u;
    for (;;) {
        sum = 0u; cnt = 0u; mine = 0u;
#pragma unroll
        for (unsigned j = 0; j < 16; ++j) { const unsigned c = xb_ld(&bar[XB_XCNT(j)]); sum += c; cnt += (c > 0u) ? 1u : 0u; mine = (j == x) ? c : mine; }
        if (sum == G) break;
        __builtin_amdgcn_s_sleep(1);
        if ((++sp & 255u) == 0u) { if (xb_ld(&bar[XB_TMO])) break; if (sp > XB_SPIN_CAP) { atomicAdd(&bar[XB_TMO], 1u); break; } }
    }
    nloc = mine > 0u ? mine : 1u; nx = cnt > 0u ? cnt : 1u;
}
__device__ __forceinline__ void xcd_barrier(const XcdBarrier& b) {
    asm volatile("s_waitcnt vmcnt(0)" ::: "memory");
    __syncthreads();
    if (threadIdx.x == 0) {
        unsigned* bar = b.bar; unsigned bx = b.x;
        asm volatile("" : "+s"(bar), "+s"(bx));
        __builtin_amdgcn_s_waitcnt(0);
        unsigned nloc = b.st[0], nx = b.st[1];
        if (nloc == 0u) { xcd_barrier_complete(bar, bx, nloc, nx); b.st[0] = nloc; b.st[1] = nx; }
        const unsigned old = xb_add(&bar[XB_XSUB(bx)], 1u);
        const unsigned gen = old / nloc;
        if (old + 1u == (gen + 1u) * nloc) {
            __builtin_amdgcn_fence(__ATOMIC_RELEASE, "agent");
            asm volatile("s_waitcnt vmcnt(0)" ::: "memory");
            const unsigned og = xb_add(&bar[XB_TOP], 1u);
            const unsigned tg = og / nx;
            if (og + 1u == (tg + 1u) * nx) xb_add(&bar[XB_TOPGEN], 1u);
            else XB_SPIN(xb_ld(&bar[XB_TOPGEN]) == tg, bar);
            __builtin_amdgcn_fence(__ATOMIC_ACQUIRE, "agent");
            xb_add(&bar[XB_XGEN(bx)], 1u);
            asm volatile("s_waitcnt vmcnt(0)" ::: "memory");
        } else {
            XB_SPIN(xb_ld(&bar[XB_XGEN(bx)]) == gen, bar);
            __builtin_amdgcn_fence(__ATOMIC_ACQUIRE, "agent");
            asm volatile("s_waitcnt vmcnt(0)" ::: "memory");
        }
    }
    __syncthreads();
}

namespace pg8 {
constexpr int BM = 256, BK = 64, HALF = 128, HTB = HALF * BK * 2, STAGE_BYTES = 8 * HTB, KD = 1024;
__host__ __device__ __forceinline__ int lds_byte(int r, int c) { const int st = (r >> 4) * 2 + (c >> 5), rr = r & 15, cc = c & 31, ob = rr * 64 + cc * 2; return st * 1024 + (ob ^ (((ob >> 9) & 1) << 5)); }
__host__ __device__ __forceinline__ void stage_rc(int b, int& R, int& C) { const int st = b / 1024, sb = b % 1024, swz = sb ^ (((sb >> 9) & 1) << 5); R = (st >> 1) * 16 + swz / 64; C = (st & 1) * 32 + (swz % 64) / 2; }
__host__ __device__ __forceinline__ int perm32(int rho) { const int n = rho >> 4, i = rho & 15; return 8 * (i >> 2) + 4 * n + (i & 3); }

struct Unit { int pm, pn, e, kind; };
typedef int v8i __attribute__((ext_vector_type(8)));
typedef int v4i __attribute__((ext_vector_type(4)));
__device__ __forceinline__ v8i cat8(bf16x8 lo, bf16x8 hi) { const v4i a = __builtin_bit_cast(v4i, lo), b = __builtin_bit_cast(v4i, hi); return __builtin_shufflevector(a, b, 0, 1, 2, 3, 4, 5, 6, 7); }

__device__ __forceinline__ bool deal(int i, int npu, int ntiles, int& mt, int& r) {
    const int G = gridDim.x, c = blockIdx.x;
    if ((G & 7) == 0) { const int x = c & 7, q = i * (G >> 3) + (c >> 3); mt = (q / npu) * 8 + x; r = q % npu; }
    else { const int L = i * G + c; mt = L / npu; r = L % npu; }
    return mt < ntiles;
}

__device__ __forceinline__ void mfma8(f32x4& acc, const v8i a, const v8i b, int sc) {
    asm volatile("v_mfma_scale_f32_16x16x128_f8f6f4 %0, %1, %2, %0, %3, %3 op_sel_hi:[0,0,0]" : "+v"(acc) : "v"(a), "v"(b), "v"(sc)); }
__device__ __forceinline__ void glds16s(const char* sbase, unsigned voff, unsigned lds_dst) { unsigned keep;
    asm volatile("s_mov_b32 %0, m0\n\ts_mov_b32 m0, %3\n\ts_nop 0\n\tglobal_load_lds_dwordx4 %1, %2\n\ts_mov_b32 m0, %0" : "=&s"(keep) : "v"(voff), "s"(sbase), "s"(lds_dst) : "memory"); }
template <class Epi, class Sched, int PH = 0>
__device__ __forceinline__ void gemm_phase(LAS unsigned char* lds, const Sched& S, const Epi& E, const int tid, const int stagger_ticks = 0) {
    const int wid = __builtin_amdgcn_readfirstlane(tid >> 6), lane = tid & 63, wr = wid >> 2, wc = wid & 3, fr = lane & 15, fq = lane >> 4;
    constexpr int RB = Sched::RB, nt = RB / 128;
    constexpr bool F8 = (RB == 1024);
    unsigned voffB[2];
#pragma unroll
    for (int i = 0; i < 2; ++i) { int R_, C_; stage_rc(tid * 16 + i * 8192, R_, C_); const int Rb = (R_ & ~31) + perm32(R_ & 31); voffB[i] = (unsigned)(Rb * RB + C_ * 2); }
    constexpr bool GA = Sched::GATHER;
    constexpr int NH = GA ? 2 : 1;
    constexpr size_t kstep = (size_t)(BK * 2);
    constexpr size_t hstep = (size_t)HALF * RB, bstep = hstep;
    const unsigned ldsw = (unsigned)wid * 1024u, lds0 = (unsigned)(uintptr_t)lds;
    const int aoff = lds_byte(wr * 64 + fr, fq * 8), boff = lds_byte(wc * 32 + fr, fq * 8);
#define PG8_SA(b, h) (((b) * 2 + (h)) * HTB)
#define PG8_SB(b, h) ((4 + (b) * 2 + (h)) * HTB)
#define PG8_STAGE(bufoff, gbase, voff) do { _Pragma("unroll") for (int _i = 0; _i < 2; ++_i) \
        glds16s((const char*)(gbase), (voff)[_i], (unsigned)__builtin_amdgcn_readfirstlane(lds0 + (unsigned)(bufoff) + ldsw + _i * 8192u)); } while (0)
#define PG8_LDA(dst, b, h) do { _Pragma("unroll") for (int m = 0; m < 4; ++m) _Pragma("unroll") for (int k = 0; k < 2; ++k) dst[m][k] = *(const LAS bf16x8*)(lds + PG8_SA(b, h) + aoff + m * 2048 + k * 1024); } while (0)
#define PG8_LDB(dst, b, h) do { _Pragma("unroll") for (int n = 0; n < 2; ++n) _Pragma("unroll") for (int k = 0; k < 2; ++k) dst[n][k] = *(const LAS bf16x8*)(lds + PG8_SB(b, h) + boff + n * 2048 + k * 1024); } while (0)
#define PG8_MMA(ai, bj, At, Bt) do { __builtin_amdgcn_s_setprio(1); _Pragma("unroll") for (int m = 0; m < 4; ++m) _Pragma("unroll") for (int n = 0; n < 2; ++n) { \
        if constexpr (F8) mfma8(acc[ai][bj][m][n], cat8(Bt[n][0], Bt[n][1]), cat8(At[m][0], At[m][1]), sc8); \
        else { _Pragma("unroll") for (int k = 0; k < 2; ++k) acc[ai][bj][m][n] = __builtin_amdgcn_mfma_f32_16x16x32_bf16(Bt[n][k], At[m][k], acc[ai][bj][m][n], 0, 0, 0); } } __builtin_amdgcn_s_setprio(0); } while (0)
#define PG8_WAIT_V(n) asm volatile("s_waitcnt vmcnt(" #n ")" ::: "memory")
#define PG8_WAIT_VF do { if (fe) { if constexpr (Epi::NST == 16 && !PROBE_NOST) PG8_WAIT_V(24); else if constexpr (Epi::NST == 4 && !PROBE_NOST) PG8_WAIT_V(12); else if constexpr (Epi::NST == 8 && !PROBE_NOST) PG8_WAIT_V(16); else PG8_WAIT_V(8); } else PG8_WAIT_V(8); } while (0)
#define PG8_WAIT_L(n) asm volatile("s_waitcnt lgkmcnt(" #n ")" ::: "memory")
#define PG8_BAR __builtin_amdgcn_s_barrier()
#define PG8_SCHED __builtin_amdgcn_sched_barrier(0)
    Unit cur, nxt; int ui = 0;
    if (!S.next(0, cur)) return;
#define PT_ON(r) (PROBE_T == (r) && PH == PROBE_TPH)
#define PT_BEG(r) do { if (PT_ON(r)) pt0_ = __builtin_amdgcn_s_memtime(); } while (0)
#define PT_END(r) do { if (PT_ON(r)) { const unsigned long long d_ = __builtin_amdgcn_s_memtime() - pt0_; if (blockIdx.x == 0 && tid == 0) *(LAS unsigned long long*)(lds + LX_MISC + 64) += d_; } } while (0)
    unsigned long long pt0_ = 0; (void)pt0_;
    PT_BEG(3);
    if (stagger_ticks > 0 && (int)(blockIdx.x >> 3) >= (int)(gridDim.x >> 4)) { const unsigned long long t0_ = __builtin_amdgcn_s_memrealtime(); while ((long long)(__builtin_amdgcn_s_memrealtime() - t0_) < (long long)stagger_ticks) __builtin_amdgcn_s_sleep(16); }
    static_assert(Sched::SCALE_A == Sched::SCALE_B, "one scale register");
    int sc8 = Sched::SCALE_A; asm volatile("" : "+v"(sc8));
    f32x4 acc[2][2][4][2];
#pragma unroll
    for (int a = 0; a < 2; ++a)
#pragma unroll
        for (int b = 0; b < 2; ++b)
#pragma unroll
            for (int m = 0; m < 4; ++m)
#pragma unroll
                for (int n = 0; n < 2; ++n) acc[a][b][m][n] = (f32x4){0.f, 0.f, 0.f, 0.f};
    bf16x8 At[4][2], B0[2][2], B1[2][2];
    constexpr int NI = GA ? 1 : 2;
    unsigned vC[NH][NI], vN[NH][NI];
    unsigned cb2[2];
#pragma unroll
    for (int i = 0; i < 2; ++i) { int R_, C_; stage_rc(tid * 16 + i * 8192, R_, C_); cb2[i] = (unsigned)(C_ * 2); }
    const unsigned idx_slot = (unsigned)__builtin_amdgcn_readfirstlane((unsigned)(uintptr_t)(lds + LX_WSC) + (unsigned)wid * 1024u);
    if constexpr (GA) { S.idx_dma(cur, lane, idx_slot); asm volatile("s_waitcnt vmcnt(0)" ::: "memory"); S.a_offs_lds(cur, tid, vC, (LAS const int*)(lds + LX_WSC + wid * 1024)); }
    else S.a_offs(cur, tid, vC);
    const unsigned bias_slot0 = (unsigned)(uintptr_t)(lds + LX_ASG);
    if constexpr (Epi::BIAS_DMA) { Unit n1_; const bool h1_ = S.next(1, n1_);
        if (wid == 0) { glds16s((const char*)E.bias_src(cur), (unsigned)lane * 16u, (unsigned)__builtin_amdgcn_readfirstlane(bias_slot0));
            if (h1_) glds16s((const char*)E.bias_src(n1_), (unsigned)lane * 16u, (unsigned)__builtin_amdgcn_readfirstlane(bias_slot0 + 1024u)); } }
    auto acc_init = [&](int slot) {
        if constexpr (Epi::BIAS_DMA) { int fq2 = fq; asm volatile("" : "+v"(fq2)); LAS const float* bl_ = (LAS const float*)(lds + LX_ASG + slot * 1024); f32x4 bv_[2][2];
            _Pragma("unroll") for (int bj = 0; bj < 2; ++bj) { const int col = bj * 128 + wc * 32 + fq2 * 8; bv_[bj][0] = *(const LAS f32x4*)(bl_ + col); bv_[bj][1] = *(const LAS f32x4*)(bl_ + col + 4); }
            _Pragma("unroll") for (int a = 0; a < 2; ++a) _Pragma("unroll") for (int b = 0; b < 2; ++b) _Pragma("unroll") for (int m = 0; m < 4; ++m) _Pragma("unroll") for (int n = 0; n < 2; ++n) acc[a][b][m][n] = bv_[b][n]; }
        else { _Pragma("unroll") for (int a = 0; a < 2; ++a) _Pragma("unroll") for (int b = 0; b < 2; ++b) _Pragma("unroll") for (int m = 0; m < 4; ++m) _Pragma("unroll") for (int n = 0; n < 2; ++n) acc[a][b][m][n] = (f32x4){0.f, 0.f, 0.f, 0.f}; } };
#define PG8_HA(h) (GA ? 0 : (h) * hstep)
#define PG8_VH(v, h) (v)[GA ? (h) : 0]
#define PG8_STAGE_A(bufoff, gbase, vv) do { _Pragma("unroll") for (int _i = 0; _i < 2; ++_i) { unsigned o_; if constexpr (GA) o_ = (((vv)[0] >> (16 * _i)) & 0xffffu) * (unsigned)RB + cb2[_i]; else o_ = (vv)[NI - 2 + _i]; \
        glds16s((const char*)(gbase), o_, (unsigned)__builtin_amdgcn_readfirstlane(lds0 + (unsigned)(bufoff) + ldsw + _i * 8192u)); } } while (0)
    const char* cA = S.a_base(cur); const char* cB = S.b_base(cur);
    PG8_STAGE(PG8_SB(0, 0), cB, voffB); PG8_STAGE(PG8_SB(0, 1), cB + bstep, voffB); PG8_STAGE_A(PG8_SA(0, 0), cA, vC[0]); PG8_STAGE_A(PG8_SA(0, 1), cA + PG8_HA(1), PG8_VH(vC, 1));
    if (wr == 1) PG8_BAR;
    PG8_WAIT_V(2); PG8_BAR;
    PG8_STAGE(PG8_SB(1, 0), cB + kstep, voffB); PG8_STAGE_A(PG8_SA(1, 0), cA + kstep, vC[0]); PG8_STAGE(PG8_SB(1, 1), cB + bstep + kstep, voffB);
    PG8_WAIT_V(6); PG8_BAR;
    if constexpr (Epi::BIAS_DMA) acc_init(0);
    for (;;) {
        const bool has_next = S.next(ui + 1, nxt);
        const char* nA = cA; const char* nB = cB;
#pragma unroll
        for (int h = 0; h < NH; ++h)
#pragma unroll
            for (int i = 0; i < NI; ++i) vN[h][i] = vC[h][i];
        if (has_next) { if constexpr (GA) S.idx_dma(nxt, lane, idx_slot); else S.a_offs(nxt, tid, vN); nA = S.a_base(nxt); nB = S.b_base(nxt); }
        if constexpr (Epi::BIAS_DMA) { if (ui > 0 && has_next && wid == 0) glds16s((const char*)E.bias_src(nxt), (unsigned)lane * 16u, (unsigned)__builtin_amdgcn_readfirstlane(bias_slot0 + (unsigned)((ui + 1) & 1) * 1024u)); }
        PT_BEG(2);
#pragma unroll 1
        for (int t = 0; t < nt; t += 2) {
            const bool last = (t == nt - 2);
            const char* a1 = cA + (size_t)(t + 1) * kstep;
            const char* a2 = last ? nA : cA + (size_t)(t + 2) * kstep; const char* b2 = last ? nB : cB + (size_t)(t + 2) * kstep;
            const char* a3 = a2 + kstep; const char* b3 = b2 + kstep;
            if constexpr (GA) { if (last && has_next) S.a_offs_lds(nxt, tid, vN, (LAS const int*)(lds + LX_WSC + wid * 1024)); }
            unsigned w0[NI], w1[NI];
#pragma unroll
            for (int i = 0; i < NI; ++i) { w0[i] = last ? vN[0][i] : vC[0][i]; w1[i] = last ? PG8_VH(vN, 1)[i] : PG8_VH(vC, 1)[i]; }
            const bool fe = (t == 0) && (ui > 0);
            PG8_LDB(B0, 0, 0); PG8_LDB(B1, 0, 1); PG8_SCHED; PG8_LDA(At, 0, 0); if (!fe) PG8_STAGE_A(PG8_SA(1, 1), a1 + PG8_HA(1), PG8_VH(vC, 1));
            PG8_WAIT_VF; PG8_WAIT_L(0); PG8_BAR; PG8_MMA(0, 0, At, B0); PG8_MMA(0, 1, At, B1); PG8_BAR; PG8_SCHED;
            PG8_LDA(At, 0, 1); PG8_STAGE(PG8_SB(0, 0), b2, voffB); PG8_STAGE(PG8_SB(0, 1), b2 + bstep, voffB); PG8_STAGE_A(PG8_SA(0, 0), a2, w0);
            PG8_WAIT_VF; PG8_WAIT_L(0); PG8_BAR; PG8_MMA(1, 0, At, B0); PG8_MMA(1, 1, At, B1); PG8_BAR; PG8_SCHED;
            PG8_LDB(B0, 1, 0); PG8_LDB(B1, 1, 1); PG8_SCHED; PG8_LDA(At, 1, 0); PG8_STAGE_A(PG8_SA(0, 1), a2 + PG8_HA(1), w1);
            PG8_WAIT_VF; PG8_WAIT_L(0); PG8_BAR; PG8_MMA(0, 0, At, B0); PG8_MMA(0, 1, At, B1); PG8_BAR; PG8_SCHED;
            PG8_LDA(At, 1, 1); PG8_STAGE(PG8_SB(1, 0), b3, voffB); PG8_STAGE(PG8_SB(1, 1), b3 + bstep, voffB); PG8_STAGE_A(PG8_SA(1, 0), a3, w0);
            PG8_WAIT_V(8); PG8_WAIT_L(0); PG8_BAR; PG8_MMA(1, 0, At, B0); PG8_MMA(1, 1, At, B1); PG8_BAR; PG8_SCHED;
        }
        PT_END(2);
        if (has_next) PG8_STAGE_A(PG8_SA(1, 1), nA + kstep + PG8_HA(1), PG8_VH(vN, 1));
        if (wr == 0) PG8_BAR;
        PT_BEG(1);
        if constexpr (Epi::BIAS_DMA) E(acc, cur, wr, wc, fr, fq, (LAS const float*)(lds + LX_ASG + (ui & 1) * 1024)); else E(acc, cur, wr, wc, fr, fq);
        PT_END(1);
        if (!has_next) break;
        acc_init((ui + 1) & 1);
        cur = nxt; cA = nA; cB = nB; ++ui;
#pragma unroll
        for (int h = 0; h < NH; ++h)
#pragma unroll
            for (int i = 0; i < NI; ++i) vC[h][i] = vN[h][i];
        if (wr == 1) PG8_BAR;
    }
    PG8_WAIT_V(0);
    PG8_BAR;
    PT_END(3);
#undef PT_ON
#undef PT_BEG
#undef PT_END
#undef PG8_SA
#undef PG8_HA
#undef PG8_VH
#undef PG8_SB
#undef PG8_STAGE
#undef PG8_STAGE_A
#undef PG8_LDA
#undef PG8_LDB
#undef PG8_MMA
#undef PG8_WAIT_V
#undef PG8_WAIT_VF
#undef PG8_WAIT_L
#undef PG8_BAR
#undef PG8_SCHED
}
}
using pg8::Unit;

__device__ __forceinline__ int tile_row0(int mt, bool lat_only) { return lat_only ? ((mt >> 3) * 9 + 1 + (mt & 7)) * 256 : mt * 256; }

template <int RB_, int SC_> struct SchedQKV {
    static constexpr int RB = RB_, SCALE_A = SC_, SCALE_B = SC_;
    const char* H; const char* Wt;
    __device__ __forceinline__ bool next(int i, Unit& u) const { int mt, r; if (!pg8::deal(i, 12, M / 256, mt, r)) return false;
        if (r < 8) { u.kind = 0; u.pm = mt; u.pn = r; } else { u.kind = 1; u.pm = r - 8; u.pn = mt; } u.e = 0; return true; }
    static constexpr bool GATHER = false;
    __device__ __forceinline__ void a_offs(const Unit& u, int tid, unsigned (&v)[1][2]) const {
#pragma unroll
        for (int i = 0; i < 2; ++i) { int R, C; pg8::stage_rc(tid * 16 + i * 8192, R, C); v[0][i] = (unsigned)((u.pm * 256 + R) * RB + C * 2); } }
    __device__ __forceinline__ const char* a_base(const Unit& u) const { return u.kind == 0 ? H : Wt + (size_t)2048 * RB; }
    __device__ __forceinline__ const char* b_base(const Unit& u) const { return (u.kind == 0 ? Wt : H) + (size_t)u.pn * 256 * RB; }
};
template <int RB_, int SC_> struct SchedPlain {
    static constexpr int RB = RB_, SCALE_A = SC_, SCALE_B = SC_;
    const char* A; const char* Bt; int npu; bool lat_only;
    __device__ __forceinline__ bool next(int i, Unit& u) const { int mt, r; if (!pg8::deal(i, npu, lat_only ? 128 : 144, mt, r)) return false;
        u.pm = tile_row0(mt, lat_only) >> 8; u.pn = r; u.e = 0; u.kind = 0; return true; }
    static constexpr bool GATHER = false;
    __device__ __forceinline__ void a_offs(const Unit& u, int tid, unsigned (&v)[1][2]) const {
#pragma unroll
        for (int i = 0; i < 2; ++i) { int R, C; pg8::stage_rc(tid * 16 + i * 8192, R, C); v[0][i] = (unsigned)((u.pm * 256 + R) * RB + C * 2); } }
    __device__ __forceinline__ const char* a_base(const Unit&) const { return A; }
    __device__ __forceinline__ const char* b_base(const Unit& u) const { return Bt + (size_t)u.pn * 256 * RB; }
};
template <bool GATHER_, int RB_, int SA_, int SB_> struct SchedMoe {
    static constexpr bool GATHER = GATHER_;
    static constexpr int RB = RB_, SCALE_A = SA_, SCALE_B = SB_;
    const char* A; const char* Wt; const int* list; int npu; size_t estride;
    LAS const int* tstart; LAS const int* ecnt; LAS const int* tile_e;
    __device__ __forceinline__ bool mdeal(int i, int ntl, int& mt, int& r) const {
        const int G = gridDim.x, c = blockIdx.x;
        if (MOE_XCD_RANGE && (G & 7) == 0) { const int x = c & 7, q = i * (G >> 3) + (c >> 3); const int lo = (x * ntl) >> 3, hi = ((x + 1) * ntl) >> 3; mt = lo + q / npu; r = q % npu; return mt < hi; }
        return pg8::deal(i, npu, ntl, mt, r); }
    __device__ __forceinline__ bool next(int i, Unit& u) const { int mt, r; const int ntl = __builtin_amdgcn_readfirstlane(tstart[32]);
        int xp = 0;
        if (!mdeal(i, ntl, mt, r)) { if (!(PROBE_REP & (GATHER_ ? 0x100 : 0x200))) return false; int n_i = 0; while (mdeal(n_i, ntl, mt, r)) ++n_i; if (i >= 2 * n_i || !mdeal(i - n_i, ntl, mt, r)) return false; xp = 1; }
        u.pm = mt; u.pn = r; u.e = __builtin_amdgcn_readfirstlane(tile_e[mt]); u.kind = xp; return true; }
    __device__ __forceinline__ void idx_dma(const Unit& u, int lane, unsigned slot) const {
        const int j0 = (u.pm - __builtin_amdgcn_readfirstlane(tstart[u.e])) * 256;
        pg8::glds16s((const char*)(list + (size_t)u.e * CAP + j0), (unsigned)lane * 16u, slot); }
    __device__ __forceinline__ void a_offs_lds(const Unit& u, int tid, unsigned (&v)[2][1], LAS const int* slot) const {
        const int j0 = (u.pm - __builtin_amdgcn_readfirstlane(tstart[u.e])) * 256, cnt = __builtin_amdgcn_readfirstlane(ecnt[u.e]);
#pragma unroll
        for (int h = 0; h < 2; ++h) { unsigned pk = 0;
#pragma unroll
            for (int i = 0; i < 2; ++i) { int R, C; pg8::stage_rc(tid * 16 + i * 8192, R, C); const int r = h * 128 + R; const unsigned tok = (j0 + r) < cnt ? (unsigned)slot[r] : 0u; pk |= tok << (16 * i); }
            v[h][0] = pk; }
    }
    __device__ __forceinline__ void a_offs(const Unit& u, int tid, unsigned (&v)[GATHER_ ? 2 : 1][GATHER_ ? 1 : 2]) const {
        if constexpr (GATHER_) { const int j0 = (u.pm - __builtin_amdgcn_readfirstlane(tstart[u.e])) * 256, cnt = __builtin_amdgcn_readfirstlane(ecnt[u.e]); const int* lp = list + (size_t)u.e * CAP;
#pragma unroll
            for (int h = 0; h < 2; ++h) { unsigned pk = 0;
#pragma unroll
                for (int i = 0; i < 2; ++i) { int R, C; pg8::stage_rc(tid * 16 + i * 8192, R, C); const int idx = j0 + h * 128 + R; const unsigned tok = idx < cnt ? (unsigned)lp[idx] : 0u; pk |= tok << (16 * i); }
                v[h][0] = pk; }
        } else {
#pragma unroll
            for (int i = 0; i < 2; ++i) { int R, C; pg8::stage_rc(tid * 16 + i * 8192, R, C); v[0][i] = (unsigned)((u.pm * 256 + R) * RB + C * 2); } }
    }
    __device__ __forceinline__ const char* a_base(const Unit&) const { return A; }
    __device__ __forceinline__ const char* b_base(const Unit& u) const { return Wt + (size_t)u.e * estride + (size_t)u.pn * 256 * RB; }
};

#define EPI_LOOP_ROWS for (int ai = 0; ai < 2; ++ai) _Pragma("unroll") for (int m = 0; m < 4; ++m)
__device__ __forceinline__ u32x4 pack8(const f32x4& v0, const f32x4& v1) { u32x4 w; w.x = cvt_pk_bf16(v0[0], v0[1]); w.y = cvt_pk_bf16(v0[2], v0[3]); w.z = cvt_pk_bf16(v1[0], v1[1]); w.w = cvt_pk_bf16(v1[2], v1[3]); return w; }

__device__ __forceinline__ float clamp8(float v) { return fminf(fmaxf(v, -448.f), 448.f); }
__device__ __forceinline__ unsigned pack_fp8x4(float a, float b, float c, float d) {
    int w = 0; w = __builtin_amdgcn_cvt_pk_fp8_f32(clamp8(a), clamp8(b), w, false); w = __builtin_amdgcn_cvt_pk_fp8_f32(clamp8(c), clamp8(d), w, true); return (unsigned)w; }
struct EpiQKV {
    static constexpr bool BIAS_DMA = false;
    static constexpr int NST = ATT_FP8 ? 8 : 16;
    bf16* Q; bf16* Kb; bf16* Vt; const float* cosT; const float* sinT; bool dost; LAS unsigned char* stg;
    __device__ __forceinline__ void operator()(const f32x4 (&acc)[2][2][4][2], const Unit& u, int wr, int wc, int fr, int fq) const {
        asm volatile("" : "+v"(fr), "+v"(fq));
        if constexpr (ATT_FP8 != 0) {
            const bool isq = u.pn < 4, k0 = (u.kind == 0); const bool lat = k0 && (u.pm % 9) != 0;
            unsigned char* base8 = (unsigned char*)Q + (k0 ? (isq ? (size_t)0 : WS_K - WS_Q) : WS_VT - WS_Q); const size_t ld = k0 ? 1024 : (size_t)M; const int colbase = k0 ? (u.pn & 3) * 256 : u.pn * 256;
            const float sc = k0 ? (isq ? C2 * 64.f : 16.f) : 16.f;
            LAS unsigned char* sw = stg + (wr * 4 + wc) * 2048; const int lane = fq * 16 + fr; const int jp0 = 16 * (wc & 1) + 4 * fq;
#pragma unroll
            for (int ai = 0; ai < 2; ++ai) {
                f32x4 cs[4], sn[4];
#pragma unroll
                for (int m = 0; m < 4; ++m) { const int row = u.pm * 256 + ai * 128 + wr * 64 + m * 16 + fr; const int t = lat ? (row % RPB) - CTXL : 0;
                    const f32x4 cv = *(const f32x4*)(cosT + t * 32 + jp0), sv = *(const f32x4*)(cosT + 2048 * 32 + t * 32 + jp0);
#pragma unroll
                    for (int j = 0; j < 4; ++j) { cs[m][j] = lat ? cv[j] : 1.f; sn[m][j] = lat ? sv[j] : 0.f; } }
#pragma unroll
                for (int bj = 0; bj < 2; ++bj) {
#pragma unroll
                    for (int m = 0; m < 4; ++m) { const f32x4 a = acc[ai][bj][m][0], b = acc[ai][bj][m][1]; const f32x4 c_ = cs[m], s_ = sn[m];
                        u32x2 w8;
                        w8.x = pack_fp8x4((a[0] * c_[0] - a[1] * s_[0]) * sc, (a[1] * c_[0] + a[0] * s_[0]) * sc, (a[2] * c_[1] - a[3] * s_[1]) * sc, (a[3] * c_[1] + a[2] * s_[1]) * sc);
                        w8.y = pack_fp8x4((b[0] * c_[2] - b[1] * s_[2]) * sc, (b[1] * c_[2] + b[0] * s_[2]) * sc, (b[2] * c_[3] - b[3] * s_[3]) * sc, (b[3] * c_[3] + b[2] * s_[3]) * sc);
                        *(LAS u32x2*)(sw + (16 * m + fr) * 32 + fq * 8) = w8; }
                    asm volatile("s_waitcnt lgkmcnt(0)" ::: "memory");
#pragma unroll
                    for (int k = 0; k < 2; ++k) { const int p = lane + 64 * k, rr = p >> 1, hf = p & 1; const u32x4 v = *(const LAS u32x4*)(sw + p * 16);
                        const int row = u.pm * 256 + ai * 128 + wr * 64 + rr; const int col = colbase + bj * 128 + wc * 32 + hf * 16;
                        if (dost) *(u32x4*)(base8 + (size_t)row * ld + col) = v; }
                    asm volatile("s_waitcnt lgkmcnt(0)" ::: "memory");
                }
            }
        } else if (u.kind == 0) {
            const bool isq = u.pn < 4; bf16* base = isq ? Q : Kb; const float sc = isq ? C2 : 1.f;
            const bool lat = (u.pm % 9) != 0;
#pragma unroll
            EPI_LOOP_ROWS { const int row = u.pm * 256 + ai * 128 + wr * 64 + m * 16 + fr; const int t = (row % RPB) - CTXL;
#pragma unroll
                for (int bj = 0; bj < 2; ++bj) { const f32x4 a = acc[ai][bj][m][0], b = acc[ai][bj][m][1]; f32x4 o0, o1;
                    f32x4 cs = {1.f, 1.f, 1.f, 1.f}, sn = {0.f, 0.f, 0.f, 0.f}; const int jp0 = 16 * (wc & 1) + 4 * fq;
                    if (lat) { cs = *(const f32x4*)(cosT + t * 32 + jp0); sn = *(const f32x4*)(sinT + t * 32 + jp0); }
                    o0[0] = (a[0] * cs[0] - a[1] * sn[0]) * sc; o0[1] = (a[1] * cs[0] + a[0] * sn[0]) * sc; o0[2] = (a[2] * cs[1] - a[3] * sn[1]) * sc; o0[3] = (a[3] * cs[1] + a[2] * sn[1]) * sc;
                    o1[0] = (b[0] * cs[2] - b[1] * sn[2]) * sc; o1[1] = (b[1] * cs[2] + b[0] * sn[2]) * sc; o1[2] = (b[2] * cs[3] - b[3] * sn[3]) * sc; o1[3] = (b[3] * cs[3] + b[2] * sn[3]) * sc;
                    const int col = (u.pn & 3) * 256 + bj * 128 + wc * 32 + fq * 8;
                    if (ATT_FP8) { const float s8 = isq ? 64.f : 16.f; u32x2 w8; w8.x = pack_fp8x4(s8 * o0[0], s8 * o0[1], s8 * o0[2], s8 * o0[3]); w8.y = pack_fp8x4(s8 * o1[0], s8 * o1[1], s8 * o1[2], s8 * o1[3]);
                        if (dost) *(u32x2*)((unsigned char*)base + (size_t)row * 1024 + col) = w8; }
                    else { const u32x4 pk_ = pack8(o0, o1); if (dost) *(u32x4*)(base + (size_t)row * 1024 + col) = pk_; } } }
        } else {
#pragma unroll
            EPI_LOOP_ROWS { const int row = u.pm * 256 + ai * 128 + wr * 64 + m * 16 + fr;
#pragma unroll
                for (int bj = 0; bj < 2; ++bj) { const int col = u.pn * 256 + bj * 128 + wc * 32 + fq * 8;
                    if (ATT_FP8) { const f32x4 a_ = acc[ai][bj][m][0], b_ = acc[ai][bj][m][1]; u32x2 w8; w8.x = pack_fp8x4(16.f * a_[0], 16.f * a_[1], 16.f * a_[2], 16.f * a_[3]); w8.y = pack_fp8x4(16.f * b_[0], 16.f * b_[1], 16.f * b_[2], 16.f * b_[3]);
                        if (dost) *(u32x2*)((unsigned char*)Vt + (size_t)row * M + col) = w8; }
                    else { const u32x4 pk_ = pack8(acc[ai][bj][m][0], acc[ai][bj][m][1]); if (dost) *(u32x4*)(Vt + (size_t)row * M + col) = pk_; } } }
        }
    }
};
struct EpiPlain {
    static constexpr bool BIAS_DMA = false;
    static constexpr int NST = 16;
    bf16* O; int ldc;
    __device__ __forceinline__ void operator()(const f32x4 (&acc)[2][2][4][2], const Unit& u, int wr, int wc, int fr, int fq) const {
        asm volatile("" : "+v"(fr), "+v"(fq));
#pragma unroll
        EPI_LOOP_ROWS { const int row = u.pm * 256 + ai * 128 + wr * 64 + m * 16 + fr;
#pragma unroll
            for (int bj = 0; bj < 2; ++bj) { const int col = u.pn * 256 + bj * 128 + wc * 32 + fq * 8;
                *(u32x4*)(O + (size_t)row * ldc + col) = pack8(acc[ai][bj][m][0], acc[ai][bj][m][1]); } }
    }
};
struct EpiConvIn {
    static constexpr bool BIAS_DMA = false;
    static constexpr int NST = 16;
    bf16* Bb; bf16* Ub;
    __device__ __forceinline__ void operator()(const f32x4 (&acc)[2][2][4][2], const Unit& u, int wr, int wc, int fr, int fq) const {
        asm volatile("" : "+v"(fr), "+v"(fq));
        if (u.pn < 4) {
#pragma unroll
            EPI_LOOP_ROWS { const int row = u.pm * 256 + ai * 128 + wr * 64 + m * 16 + fr;
#pragma unroll
                for (int bj = 0; bj < 2; ++bj) { const int col = u.pn * 256 + bj * 128 + wc * 32 + fq * 8;
                    *(u32x4*)(Bb + (size_t)row * 1024 + col) = pack8(acc[ai][bj][m][0], acc[ai][bj][m][1]); } }
        } else {
#pragma unroll
            EPI_LOOP_ROWS { const int row = u.pm * 256 + ai * 128 + wr * 64 + m * 16 + fr;
#pragma unroll
                for (int bj = 0; bj < 2; ++bj) { const f32x4 a = acc[ai][bj][m][0], b = acc[ai][bj][m][1]; const int col = (u.pn - 4) * 128 + bj * 64 + wc * 16 + fq * 4;
                    u32x2 w; w.x = cvt_pk_bf16(a[0] * a[1], a[2] * a[3]); w.y = cvt_pk_bf16(b[0] * b[1], b[2] * b[3]);
                    *(u32x2*)(Ub + (size_t)row * 1024 + col) = w; } }
        }
    }
};
struct EpiResid {
    static constexpr bool BIAS_DMA = false;
    static constexpr int NST = X_BF16 ? 16 : 0;
    const void* Xin; void* X; const float* gate;
    const float* in_x; const float* in_ctx;
    __device__ __forceinline__ void operator()(const f32x4 (&acc)[2][2][4][2], const Unit& u, int wr, int wc, int fr, int fq) const {
        asm volatile("" : "+v"(fr), "+v"(fq));
        const int rb = (u.pm % 9) == 0 ? 16 : u.pm / 9; const float* gp = gate + rb * 6144;
        f32x4 gv[2][2];
#pragma unroll
        for (int bj = 0; bj < 2; ++bj) { const int col = u.pn * 256 + bj * 128 + wc * 32 + fq * 8; gv[bj][0] = *(const f32x4*)(gp + col); gv[bj][1] = *(const f32x4*)(gp + col + 4); }
        if (X_BF16 && !in_x) {
#pragma unroll
            for (int ai = 0; ai < 2; ++ai) { u32x4 xw[4][2];
#pragma unroll
                for (int m = 0; m < 4; ++m)
#pragma unroll
                    for (int bj = 0; bj < 2; ++bj) xw[m][bj] = *(const u32x4*)((const bf16*)Xin + (size_t)(u.pm * 256 + ai * 128 + wr * 64 + m * 16 + fr) * 1024 + u.pn * 256 + bj * 128 + wc * 32 + fq * 8);
#pragma unroll
                for (int m = 0; m < 4; ++m)
#pragma unroll
                    for (int bj = 0; bj < 2; ++bj) { const u32x4 w = xw[m][bj];
                        const f32x4 x0 = {bf2f((unsigned short)(w.x & 0xffffu)), bf2f((unsigned short)(w.x >> 16)), bf2f((unsigned short)(w.y & 0xffffu)), bf2f((unsigned short)(w.y >> 16))};
                        const f32x4 x1 = {bf2f((unsigned short)(w.z & 0xffffu)), bf2f((unsigned short)(w.z >> 16)), bf2f((unsigned short)(w.w & 0xffffu)), bf2f((unsigned short)(w.w >> 16))};
                        *(u32x4*)((bf16*)X + (size_t)(u.pm * 256 + ai * 128 + wr * 64 + m * 16 + fr) * 1024 + u.pn * 256 + bj * 128 + wc * 32 + fq * 8) = pack8(x0 + gv[bj][0] * acc[ai][bj][m][0], x1 + gv[bj][1] * acc[ai][bj][m][1]); } }
        } else {
#pragma unroll
            EPI_LOOP_ROWS { const int row = u.pm * 256 + ai * 128 + wr * 64 + m * 16 + fr;
#pragma unroll
                for (int bj = 0; bj < 2; ++bj) { const int col = u.pn * 256 + bj * 128 + wc * 32 + fq * 8; const size_t o = (size_t)row * 1024 + col;
                    const float* xs = (const float*)Xin + o;
                    if (in_x) { const int b_ = u.pm / 9, jt_ = u.pm % 9; const size_t ro = (size_t)(row - u.pm * 256) * 1024 + col;
                        xs = jt_ == 0 ? in_ctx + (size_t)b_ * CTXL * 1024 + ro : in_x + ((size_t)b_ * SEQ + (jt_ - 1) * 256) * 1024 + ro; }
                    const f32x4 x0 = *(const f32x4*)(xs), x1 = *(const f32x4*)(xs + 4);
                    const f32x4 r0 = x0 + gv[bj][0] * acc[ai][bj][m][0], r1 = x1 + gv[bj][1] * acc[ai][bj][m][1];
                    if (X_BF16) *(u32x4*)((bf16*)X + o) = pack8(r0, r1);
                    else { *(f32x4*)((float*)X + o) = r0; *(f32x4*)((float*)X + o + 4) = r1; } } }
        }
    }
};
__device__ __forceinline__ float swiglu1(float g, float l) {
    g = fminf(g, 7.f); l = fminf(fmaxf(l, -7.f), 7.f);
    const float s = __builtin_amdgcn_rcpf(1.f + __builtin_amdgcn_exp2f(-1.702f * 1.4426950408889634f * g));
    return g * s * (l + 1.f);
}
__device__ __forceinline__ float swiglu4(float g, float l) {
    g = fminf(g, 7.f); l = __builtin_amdgcn_fmed3f(l, -7.f, 7.f);
    const float r = __builtin_amdgcn_rcpf(1.f + __builtin_amdgcn_exp2f(g * (-1.702f * 1.4426950408889634f)));
    return (g * r) * __builtin_fmaf(l, 4.f, 4.f);
}
template <bool F8> struct EpiSwiglu {
    static constexpr bool BIAS_DMA = true;
    static constexpr int NST = F8 ? 4 : 16;
    bf16* ACT; const float* bgu; LAS unsigned char* stg;
    __device__ __forceinline__ const float* bias_src(const Unit& u) const { return bgu + u.e * 2048 + u.pn * 256; }
    __device__ __forceinline__ void operator()(const f32x4 (&acc)[2][2][4][2], const Unit& u, int wr, int wc, int fr, int fq, LAS const float* bl) const {
        asm volatile("" : "+v"(fr), "+v"(fq));
        (void)bl;
        if constexpr (F8) {
            LAS unsigned* sw = (LAS unsigned*)(stg + (wr * 4 + wc) * 2048); const int lane = fq * 16 + fr;
#pragma unroll
            for (int ai = 0; ai < 2; ++ai) {
#pragma unroll
                for (int m = 0; m < 4; ++m)
#pragma unroll
                    for (int bj = 0; bj < 2; ++bj) { const f32x4 a = acc[ai][bj][m][0], b = acc[ai][bj][m][1];
                        int w = 0; w = __builtin_amdgcn_cvt_pk_fp8_f32(swiglu4(a[0], a[1]), swiglu4(a[2], a[3]), w, false); w = __builtin_amdgcn_cvt_pk_fp8_f32(swiglu4(b[0], b[1]), swiglu4(b[2], b[3]), w, true);
                        sw[((16 * m + fr) * 2 + bj) * 4 + fq] = (unsigned)w; }
                asm volatile("s_waitcnt lgkmcnt(0)" ::: "memory");
#pragma unroll
                for (int k = 0; k < 2; ++k) { const int p = lane + 64 * k, rr = p >> 1, bj = p & 1; const u32x4 v = *(const LAS u32x4*)(sw + p * 4);
                    const int row = u.pm * 256 + ai * 128 + wr * 64 + rr; const int col = u.pn * 128 + bj * 64 + wc * 16;
                    if (!(PROBE_NOST && u.kind)) *(u32x4*)((unsigned char*)ACT + (size_t)row * 1024 + col) = v; }
                asm volatile("s_waitcnt lgkmcnt(0)" ::: "memory");
            }
        } else {
#pragma unroll
            EPI_LOOP_ROWS { const int row = u.pm * 256 + ai * 128 + wr * 64 + m * 16 + fr;
#pragma unroll
                for (int bj = 0; bj < 2; ++bj) { const f32x4 a = acc[ai][bj][m][0], b = acc[ai][bj][m][1];
                    const int col = u.pn * 128 + bj * 64 + wc * 16 + fq * 4;
                    u32x2 w; w.x = cvt_pk_bf16(swiglu1(a[0], a[1]), swiglu1(a[2], a[3])); w.y = cvt_pk_bf16(swiglu1(b[0], b[1]), swiglu1(b[2], b[3]));
                    *(u32x2*)(ACT + (size_t)row * 1024 + col) = w; } }
        }
    }
};
struct EpiDown {
    static constexpr bool BIAS_DMA = true;
    static constexpr int NST = Y_FP8 ? 8 : 16;
    bf16* Y; const float* bd; LAS unsigned char* stg;
    __device__ __forceinline__ const float* bias_src(const Unit& u) const { return bd + u.e * 1024 + u.pn * 256; }
    __device__ __forceinline__ void operator()(const f32x4 (&acc)[2][2][4][2], const Unit& u, int wr, int wc, int fr, int fq, LAS const float* bl) const {
        asm volatile("" : "+v"(fr), "+v"(fq));
        (void)bl;
        if constexpr (Y_FP8 != 0) {
            LAS unsigned char* sw = stg + (wr * 4 + wc) * 2048; const int lane = fq * 16 + fr;
#pragma unroll
            for (int ai = 0; ai < 2; ++ai)
#pragma unroll
                for (int bj = 0; bj < 2; ++bj) {
#pragma unroll
                    for (int m = 0; m < 4; ++m) { const f32x4 y0 = acc[ai][bj][m][0], y1 = acc[ai][bj][m][1];
                        u32x2 w; w.x = pack_fp8x4(16.f * y0[0], 16.f * y0[1], 16.f * y0[2], 16.f * y0[3]); w.y = pack_fp8x4(16.f * y1[0], 16.f * y1[1], 16.f * y1[2], 16.f * y1[3]);
                        *(LAS u32x2*)(sw + (16 * m + fr) * 32 + fq * 8) = w; }
                    asm volatile("s_waitcnt lgkmcnt(0)" ::: "memory");
#pragma unroll
                    for (int k = 0; k < 2; ++k) { const int p = lane + 64 * k, rr = p >> 1, hf = p & 1; const u32x4 v = *(const LAS u32x4*)(sw + p * 16);
                        const int row = u.pm * 256 + ai * 128 + wr * 64 + rr; const int col = u.pn * 256 + bj * 128 + wc * 32 + hf * 16;
                        if (!(PROBE_NOST && u.kind)) *(u32x4*)((unsigned char*)Y + (size_t)row * 1024 + col) = v; }
                    asm volatile("s_waitcnt lgkmcnt(0)" ::: "memory");
                }
        } else {
#pragma unroll
            EPI_LOOP_ROWS { const int row = u.pm * 256 + ai * 128 + wr * 64 + m * 16 + fr;
#pragma unroll
                for (int bj = 0; bj < 2; ++bj) { const int col = u.pn * 256 + bj * 128 + wc * 32 + fq * 8;
                    const u32x4 pk_ = pack8(acc[ai][bj][m][0], acc[ai][bj][m][1]); if (!(PROBE_NOST && u.kind)) *(u32x4*)(Y + (size_t)row * 1024 + col) = pk_; } }
        }
    }
};

namespace att {
constexpr int SLOT = 32768, VOFF = 16384;
__device__ __forceinline__ void glds16(const void* gsrc, unsigned lds_dst) { unsigned keep;
    asm volatile("s_mov_b32 %0, m0\n\ts_mov_b32 m0, %2\n\ts_nop 0\n\tglobal_load_lds_dwordx4 %1, off\n\ts_mov_b32 m0, %0" : "=&s"(keep) : "v"(gsrc), "s"(lds_dst) : "memory"); }
#define ATT_WAIT_BAR(N) asm volatile("s_waitcnt vmcnt(" #N ") lgkmcnt(0)\n\ts_barrier" ::: "memory")
__device__ __forceinline__ float half_swap_max(float m) { auto rr = __builtin_amdgcn_permlane32_swap(__float_as_uint(m), __float_as_uint(m), false, false); return fmaxf(__uint_as_float(rr[0]), __uint_as_float(rr[1])); }
__device__ __forceinline__ float half_swap_sum(float m) { auto rr = __builtin_amdgcn_permlane32_swap(__float_as_uint(m), __float_as_uint(m), false, false); return __uint_as_float(rr[0]) + __uint_as_float(rr[1]); }
__device__ __forceinline__ int crow(int r, int hi) { return (r & 3) + 8 * (r >> 2) + 4 * hi; }
__device__ __forceinline__ float max3f(float a, float b, float c) { float r; asm("v_max3_f32 %0, %1, %2, %3" : "=v"(r) : "v"(a), "v"(b), "v"(c)); return r; }

__device__ __forceinline__ void attn_unit(LAS unsigned char* lds, LAS float* wsc  , const bf16* Q, const bf16* Kb, const bf16* Vt, bf16* O,
                                          int krow0, int h, int qrow0, int NT, float lam, float osc, const float* subg, const int tid) {
    const int lane = tid & 63, r32 = lane & 31, hi = lane >> 5; const int wid = __builtin_amdgcn_readfirstlane(tid >> 6);
    const int qg = wid >> 1, c = wid & 1;
    const unsigned lds0 = (unsigned)(uintptr_t)lds;
    const bf16* ksrc[2]; const bf16* vsrc[2];
#pragma unroll
    for (int i = 0; i < 2; ++i) { const int p = 2 * wid + i;
        { const int row = 4 * p + (lane >> 4), ch = (lane & 15) ^ (row & 15); ksrc[i] = Kb + (size_t)(krow0 + row) * 1024 + h * 128 + ch * 8; }
        { const int row = 8 * p + (lane >> 3), ch = (lane & 7) ^ ((row >> 1) & 7); vsrc[i] = Vt + (size_t)(h * 128 + row) * M + krow0 + ch * 8; } }
    const unsigned kdst = lds0 + (unsigned)wid * 2048u, vdst = lds0 + VOFF + (unsigned)wid * 2048u;
#define ATT_DMA(t, slot) do { const unsigned so_ = (unsigned)(slot) * SLOT; \
        glds16(ksrc[0] + (size_t)(t) * 64 * 1024, (unsigned)__builtin_amdgcn_readfirstlane(kdst + so_)); glds16(ksrc[1] + (size_t)(t) * 64 * 1024, (unsigned)__builtin_amdgcn_readfirstlane(kdst + so_ + 1024u)); \
        glds16(vsrc[0] + (size_t)(t) * 64, (unsigned)__builtin_amdgcn_readfirstlane(vdst + so_)); glds16(vsrc[1] + (size_t)(t) * 64, (unsigned)__builtin_amdgcn_readfirstlane(vdst + so_ + 1024u)); } while (0)
    const int key0 = (r32 & 0x13) | ((r32 & 4) << 1) | ((r32 & 8) >> 1);
    const int kx = key0 & 15, vx = (r32 >> 1) & 7;
    bf16x8 qf[4];
    { const bf16* qp = Q + (size_t)(qrow0 + qg * 32 + r32) * 1024 + h * 128 + c * 64 + hi * 8;
#pragma unroll
      for (int d0 = 0; d0 < 4; ++d0) qf[d0] = *(const bf16x8*)(qp + d0 * 16); }
    float sg[4];
#pragma unroll
    for (int d0 = 0; d0 < 4; ++d0) sg[d0] = subg[d0 * 32 + r32] * osc;
    f32x16 o[4];
#pragma unroll
    for (int d0 = 0; d0 < 4; ++d0) o[d0] = f32x16{};
    float mref = 0.f, lsum = 0.f; f32x16 negm = f32x16{};
    asm volatile("s_waitcnt vmcnt(0)" ::: "memory");
#define AT_BEG(r) do { if (PROBE_T == (r)) at0_ = __builtin_amdgcn_s_memtime(); } while (0)
#define AT_END(r) do { if (PROBE_T == (r)) { const unsigned long long d_ = __builtin_amdgcn_s_memtime() - at0_; if (blockIdx.x == 0 && tid == ATT_PROBE_TID) *(LAS unsigned long long*)(lds + LX_MISC + 64) += d_; } } while (0)
    unsigned long long at0_ = 0; (void)at0_;
    AT_BEG(7);
    AT_BEG(13);
    ATT_DMA(0, 0);
    if (NT > 1) ATT_DMA(1, 1);
    for (int t = 0; t < NT; ++t) {
        const int slot = t & 3;
        AT_BEG(4);
        if (t + 1 < NT) { ATT_WAIT_BAR(4); } else { ATT_WAIT_BAR(0); }
        AT_END(4);
        if (t == 0) AT_END(13);
        if (t + 2 < NT) ATT_DMA(t + 2, (t + 2) & 3);
        AT_BEG(5);
        const LAS unsigned char* kb_ = lds + slot * SLOT; const LAS unsigned char* vb_ = kb_ + VOFF;
        f32x16 s0, s1;
        bf16x8 kf[8];
#pragma unroll
        for (int d0 = 0; d0 < 4; ++d0) { const int ch = (c * 8 + d0 * 2 + hi) ^ kx;
            kf[d0] = *(const LAS bf16x8*)(kb_ + key0 * 256 + ch * 16); kf[4 + d0] = *(const LAS bf16x8*)(kb_ + (key0 + 32) * 256 + ch * 16); }
        bf16x8 vA[8], vB[8];
#pragma unroll
        for (int ks = 0; ks < 2; ++ks) { const int ch = (2 * ks + hi) ^ vx;
#pragma unroll
            for (int d0 = 0; d0 < 4; ++d0) vA[ks * 4 + d0] = *(const LAS bf16x8*)(vb_ + (d0 * 32 + r32) * 128 + ch * 16); }
#pragma unroll
        for (int d0 = 0; d0 < 4; ++d0) s0 = __builtin_amdgcn_mfma_f32_32x32x16_bf16(kf[d0], qf[d0], d0 == 0 ? negm : s0, 0, 0, 0);
#pragma unroll
        for (int d0 = 0; d0 < 4; ++d0) s1 = __builtin_amdgcn_mfma_f32_32x32x16_bf16(kf[4 + d0], qf[d0], d0 == 0 ? negm : s1, 0, 0, 0);
        float rm = s0[0];
#pragma unroll
        for (int r = 1; r < 16; ++r) rm = fmaxf(rm, s0[r]);
        float sa = 0.f;
#pragma unroll
        for (int r = 0; r < 16; ++r) { s0[r] = __builtin_amdgcn_exp2f(s0[r]); sa += s0[r]; }
        bf16x8 pa[4];
#pragma unroll
        for (int s = 0; s < 2; ++s) { u32x4 w0;
            w0.x = cvt_pk_bf16(s0[8 * s + 0], s0[8 * s + 1]); w0.y = cvt_pk_bf16(s0[8 * s + 2], s0[8 * s + 3]); w0.z = cvt_pk_bf16(s0[8 * s + 4], s0[8 * s + 5]); w0.w = cvt_pk_bf16(s0[8 * s + 6], s0[8 * s + 7]);
            pa[s] = __builtin_bit_cast(bf16x8, w0); }
#pragma unroll
        for (int ks = 2; ks < 4; ++ks) { const int ch = (2 * ks + hi) ^ vx;
#pragma unroll
            for (int d0 = 0; d0 < 4; ++d0) vB[(ks - 2) * 4 + d0] = *(const LAS bf16x8*)(vb_ + (d0 * 32 + r32) * 128 + ch * 16); }
#pragma unroll
        for (int ks = 0; ks < 2; ++ks)
#pragma unroll
            for (int d0 = 0; d0 < 4; ++d0) o[d0] = __builtin_amdgcn_mfma_f32_32x32x16_bf16(pa[ks], vA[ks * 4 + d0], o[d0], 0, 0, 0);
#pragma unroll
        for (int r = 0; r < 16; ++r) rm = fmaxf(rm, s1[r]);
#pragma unroll
        for (int r = 0; r < 16; ++r) { s1[r] = __builtin_amdgcn_exp2f(s1[r]); sa += s1[r]; }
        lsum += sa;
#pragma unroll
        for (int s = 0; s < 2; ++s) { u32x4 w1;
            w1.x = cvt_pk_bf16(s1[8 * s + 0], s1[8 * s + 1]); w1.y = cvt_pk_bf16(s1[8 * s + 2], s1[8 * s + 3]); w1.z = cvt_pk_bf16(s1[8 * s + 4], s1[8 * s + 5]); w1.w = cvt_pk_bf16(s1[8 * s + 6], s1[8 * s + 7]);
            pa[2 + s] = __builtin_bit_cast(bf16x8, w1); }
#pragma unroll
        for (int ks = 2; ks < 4; ++ks)
#pragma unroll
            for (int d0 = 0; d0 < 4; ++d0) o[d0] = __builtin_amdgcn_mfma_f32_32x32x16_bf16(pa[ks], vB[(ks - 2) * 4 + d0], o[d0], 0, 0, 0);
        AT_END(5);
        rm = half_swap_max(rm);
        const bool need = (t == 0) || (rm > 8.f);
        if (__any(need)) {
            const float dl = need ? rm : 0.f; mref += dl;
#pragma unroll
            for (int r = 0; r < 16; ++r) negm[r] = -mref;
            const float f = __builtin_amdgcn_exp2f(-dl); lsum *= f;
            if (hi == 0) wsc[r32] = f;
            asm volatile("s_waitcnt lgkmcnt(0)" ::: "memory");
#pragma unroll
            for (int r = 0; r < 16; ++r) { const float fr_ = wsc[crow(r, hi)];
#pragma unroll
                for (int d0 = 0; d0 < 4; ++d0) o[d0][r] *= fr_; }
            asm volatile("s_waitcnt lgkmcnt(0)" ::: "memory");
        }
    }
    AT_BEG(14);
    const float lt = half_swap_sum(lsum);
    if (hi == 0) wsc[64 + r32] = (c ? -lam : 1.f) * __builtin_amdgcn_rcpf(lt);
    asm volatile("s_waitcnt lgkmcnt(0)\n\ts_barrier" ::: "memory");
    LAS float* xch = (LAS float*)(lds + qg * 16384);
#pragma unroll
    for (int r = 0; r < 16; ++r) { const float a = wsc[64 + crow(r, hi)];
#pragma unroll
        for (int d0 = 0; d0 < 4; ++d0) o[d0][r] *= a; }
    if (c == 1) {
#pragma unroll
        for (int d0 = 0; d0 < 4; ++d0)
#pragma unroll
            for (int r = 0; r < 16; ++r) xch[(d0 * 16 + r) * 64 + lane] = o[d0][r];
    }
    asm volatile("s_waitcnt lgkmcnt(0)\n\ts_barrier" ::: "memory");
    if (c == 0) {
        constexpr int OB = FP8_ATT_O ? 1 : 2;
        LAS unsigned char* stg = lds + 65536 + qg * 8192;
#pragma unroll
        for (int d0 = 0; d0 < 4; ++d0)
#pragma unroll
            for (int r = 0; r < 16; ++r) o[d0][r] += xch[(d0 * 16 + r) * 64 + lane];
        float ss[16], tt[16];
#pragma unroll
        for (int r = 0; r < 16; ++r) { float x = (o[0][r] * o[0][r] + o[1][r] * o[1][r]) + (o[2][r] * o[2][r] + o[3][r] * o[3][r]);
            x += __builtin_bit_cast(float, __builtin_amdgcn_update_dpp(0, __builtin_bit_cast(int, x), 0xB1, 0xF, 0xF, true));
            x += __builtin_bit_cast(float, __builtin_amdgcn_update_dpp(0, __builtin_bit_cast(int, x), 0x4E, 0xF, 0xF, true));
            x += __builtin_bit_cast(float, __builtin_amdgcn_update_dpp(0, __builtin_bit_cast(int, x), 0x124, 0xF, 0xF, true));
            x += __builtin_bit_cast(float, __builtin_amdgcn_update_dpp(0, __builtin_bit_cast(int, x), 0x128, 0xF, 0xF, true));
            ss[r] = x; }
#pragma unroll
        for (int r = 0; r < 16; ++r) tt[r] = __shfl_xor(ss[r], 16);
#pragma unroll
        for (int r = 0; r < 16; ++r) { const int qr = crow(r, hi); const float rn = __builtin_amdgcn_rsqf((ss[r] + tt[r]) * (1.f / 128.f) + EPS);
#pragma unroll
            for (int d0 = 0; d0 < 4; ++d0) { const float ov = o[d0][r] * rn * sg[d0];
                if (FP8_ATT_O) { const float o4 = clamp8(4.f * ov); *(LAS unsigned char*)(stg + qr * 128 + d0 * 32 + r32) = (unsigned char)(__builtin_amdgcn_cvt_pk_fp8_f32(o4, o4, 0, false) & 0xff); }
                else *(LAS unsigned short*)(stg + (qr * 128 + d0 * 32 + r32) * 2) = (unsigned short)f2bf(ov); } }
        asm volatile("s_waitcnt lgkmcnt(0)" ::: "memory");
        unsigned char* Ob = (unsigned char*)O + ((size_t)(qrow0 + qg * 32) * 1024 + h * 128) * OB;
#pragma unroll
        for (int k = 0; k < 4 * OB; ++k) { const int off = lane * 16 + 1024 * k, row = off / (128 * OB), cb = off % (128 * OB);
            *(u32x4*)(Ob + (size_t)row * 1024 * OB + cb) = *(const LAS u32x4*)(stg + off); }
    }
    asm volatile("s_waitcnt lgkmcnt(0)\n\ts_barrier" ::: "memory");
    AT_END(7);
    AT_END(14);
#undef AT_BEG
#undef AT_END
#undef ATT_DMA
}

typedef int v8i __attribute__((ext_vector_type(8)));
typedef int v4i_ __attribute__((ext_vector_type(4)));
__device__ __forceinline__ v8i cat16(u32x4 lo, u32x4 hi2) { const v4i_ a = __builtin_bit_cast(v4i_, lo), b = __builtin_bit_cast(v4i_, hi2); return __builtin_shufflevector(a, b, 0, 1, 2, 3, 4, 5, 6, 7); }
constexpr float ATT_TGT = 2.f;
__device__ __forceinline__ void attn_unit8(LAS unsigned char* lds, LAS float* wsc, const unsigned char* Q8, const unsigned char* K8, const unsigned char* V8t, bf16* O,
                                           int krow0, int h, int qrow0, int NT, float lam, float osc, const float* subg, const int tid) {
    constexpr int SL = 16384, VO = 8192;
    const int lane = tid & 63, r32 = lane & 31, hi = lane >> 5; const int wid = __builtin_amdgcn_readfirstlane(tid >> 6);
    const int qg = wid >> 1, c = wid & 1;
    const unsigned lds0 = (unsigned)(uintptr_t)lds;
    const unsigned char* ksrc; const unsigned char* vsrc;
    { const int key = 8 * wid + (lane >> 3), ch = (lane & 7) ^ ((key >> 1) & 7); ksrc = K8 + (size_t)(krow0 + key) * 1024 + h * 128 + ch * 16; }
    { const int dv = 16 * wid + (lane >> 2), ch = (lane & 3) ^ ((dv >> 2) & 3); vsrc = V8t + (size_t)(h * 128 + dv) * M + krow0 + ch * 16; }
    const unsigned kdst = lds0 + (unsigned)wid * 1024u, vdst = lds0 + VO + (unsigned)wid * 1024u;
#define ATT_DMA8(t, slot) do { const unsigned so_ = (unsigned)(slot) * SL; \
        glds16(ksrc + (size_t)(t) * 64 * 1024, (unsigned)__builtin_amdgcn_readfirstlane(kdst + so_)); glds16(vsrc + (size_t)(t) * 64, (unsigned)__builtin_amdgcn_readfirstlane(vdst + so_)); } while (0)
    const int key0 = 32 * ((r32 >> 2) & 1) + (r32 & 3) + 4 * (r32 >> 3);
    const int kx = (key0 >> 1) & 7, vx = (r32 >> 2) & 3;
    const int kc0 = ((c * 4 + 2 * hi) ^ kx) * 16, kc1 = ((c * 4 + 2 * hi + 1) ^ kx) * 16;
    const int vc0 = ((2 * hi) ^ vx) * 16, vc1 = ((2 * hi + 1) ^ vx) * 16;
    v8i qf;
    { const unsigned char* qp = Q8 + (size_t)(qrow0 + qg * 32 + r32) * 1024 + h * 128 + c * 64 + hi * 32;
      qf = cat16(*(const u32x4*)qp, *(const u32x4*)(qp + 16)); }
    float sg[4];
#pragma unroll
    for (int d0 = 0; d0 < 4; ++d0) sg[d0] = subg[d0 * 32 + r32] * osc;
    f32x16 o[4];
#pragma unroll
    for (int d0 = 0; d0 < 4; ++d0) o[d0] = f32x16{};
    float mref = 0.f, lsum = 0.f; f32x16 negm;
#pragma unroll
    for (int r = 0; r < 16; ++r) negm[r] = ATT_TGT;
    const int NS = NT >> 2;
    asm volatile("s_waitcnt vmcnt(0)" ::: "memory");
#pragma unroll
    for (int j = 0; j < 4; ++j) ATT_DMA8(j, j);
    ATT_WAIT_BAR(0);
    if (NS > 1) {
#pragma unroll
        for (int j = 0; j < 4; ++j) ATT_DMA8(4 + j, 4 + j);
    }
#define ATT_KFRAG(kb_, kk) cat16(*(const LAS u32x4*)((kb_) + (key0 + (kk)) * 128 + kc0), *(const LAS u32x4*)((kb_) + (key0 + (kk)) * 128 + kc1))
#define ATT_VFRAG(vb_, d0) cat16(*(const LAS u32x4*)((vb_) + ((d0) * 32 + r32) * 64 + vc0), *(const LAS u32x4*)((vb_) + ((d0) * 32 + r32) * 64 + vc1))
#define ATT_QK(kb_, kk) __builtin_amdgcn_mfma_scale_f32_32x32x64_f8f6f4(ATT_KFRAG(kb_, kk), qf, negm, 0, 0, 0, 0x7A7A7A7A, 0, 0x7A7A7A7A)
    {
        const f32x16 s0 = ATT_QK(lds, 0), s1 = ATT_QK(lds, 16);
        float rm = s0[0];
#pragma unroll
        for (int r = 1; r < 16; ++r) rm = fmaxf(rm, s0[r]);
#pragma unroll
        for (int r = 0; r < 16; ++r) rm = fmaxf(rm, s1[r]);
        mref = half_swap_max(rm) - ATT_TGT;
#pragma unroll
        for (int r = 0; r < 16; ++r) negm[r] = ATT_TGT - mref;
    }
    for (int st = 0; st < NS; ++st) {
        if (st > 0) {
            ATT_WAIT_BAR(0);
            if (st + 1 < NS) {
#pragma unroll
                for (int j = 0; j < 4; ++j) ATT_DMA8(4 * (st + 1) + j, ((st + 1) & 1) * 4 + j);
            }
        }
        const LAS unsigned char* sb_ = lds + (st & 1) * 4 * SL;
        v8i pfp = {0, 0, 0, 0, 0, 0, 0, 0};
#pragma unroll
        for (int j = 0; j < 4; ++j) {
            const LAS unsigned char* kb_ = sb_ + j * SL;
            f32x16 s0 = ATT_QK(kb_, 0), s1 = ATT_QK(kb_, 16);
            if (j > 0) { const LAS unsigned char* vp_ = kb_ - SL + VO;
#pragma unroll
                for (int d0 = 0; d0 < 4; ++d0) o[d0] = __builtin_amdgcn_mfma_scale_f32_32x32x64_f8f6f4(pfp, ATT_VFRAG(vp_, d0), o[d0], 0, 0, 0, 0x7F7F7F7F, 0, 0x7F7F7F7F); }
#pragma unroll
            for (int r = 0; r < 16; ++r) { s0[r] = __builtin_amdgcn_exp2f(s0[r]); s1[r] = __builtin_amdgcn_exp2f(s1[r]); }
            float sa = 0.f, sb = 0.f;
#pragma unroll
            for (int r = 0; r < 16; ++r) { sa += s0[r]; sb += s1[r]; }
            sa += sb;
            if (__any(!(sa <= 448.f))) {
                unsigned ko_ = (unsigned)(uintptr_t)kb_; asm volatile("" : "+v"(ko_));
                const LAS unsigned char* kr_ = (const LAS unsigned char*)(uintptr_t)ko_;
                s0 = ATT_QK(kr_, 0); s1 = ATT_QK(kr_, 16);
                float rm = s0[0];
#pragma unroll
                for (int r = 1; r < 16; ++r) rm = fmaxf(rm, s0[r]);
#pragma unroll
                for (int r = 0; r < 16; ++r) rm = fmaxf(rm, s1[r]);
                rm = half_swap_max(rm);
                const float dl = fmaxf(rm - ATT_TGT, 0.f); mref += dl;
#pragma unroll
                for (int r = 0; r < 16; ++r) negm[r] = ATT_TGT - mref;
                const float f = __builtin_amdgcn_exp2f(-dl); lsum *= f;
                if (hi == 0) wsc[r32] = f;
                asm volatile("s_waitcnt lgkmcnt(0)" ::: "memory");
#pragma unroll
                for (int r = 0; r < 16; ++r) { const float fr_ = wsc[crow(r, hi)];
#pragma unroll
                    for (int d0 = 0; d0 < 4; ++d0) o[d0][r] *= fr_; }
                asm volatile("s_waitcnt lgkmcnt(0)" ::: "memory");
#pragma unroll
                for (int r = 0; r < 16; ++r) { s0[r] = __builtin_amdgcn_exp2f(s0[r] - dl); s1[r] = __builtin_amdgcn_exp2f(s1[r] - dl); }
                sa = 0.f; sb = 0.f;
#pragma unroll
                for (int r = 0; r < 16; ++r) { sa += s0[r]; sb += s1[r]; }
                sa += sb;
            }
            lsum += sa;
#pragma unroll
            for (int jj = 0; jj < 4; ++jj) { int w = __builtin_bit_cast(int, s0[4 * jj]); w = __builtin_amdgcn_cvt_pk_fp8_f32(s0[4 * jj], s0[4 * jj + 1], w, false); w = __builtin_amdgcn_cvt_pk_fp8_f32(s0[4 * jj + 2], s0[4 * jj + 3], w, true); pfp[jj] = w;
                int w2 = __builtin_bit_cast(int, s1[4 * jj]); w2 = __builtin_amdgcn_cvt_pk_fp8_f32(s1[4 * jj], s1[4 * jj + 1], w2, false); w2 = __builtin_amdgcn_cvt_pk_fp8_f32(s1[4 * jj + 2], s1[4 * jj + 3], w2, true); pfp[4 + jj] = w2; }
        }
        {
            const LAS unsigned char* vl_ = sb_ + 3 * SL + VO;
#pragma unroll
            for (int d0 = 0; d0 < 4; ++d0) o[d0] = __builtin_amdgcn_mfma_scale_f32_32x32x64_f8f6f4(pfp, ATT_VFRAG(vl_, d0), o[d0], 0, 0, 0, 0x7F7F7F7F, 0, 0x7F7F7F7F);
        }
    }
#undef ATT_KFRAG
#undef ATT_VFRAG
#undef ATT_QK
    const float lt = half_swap_sum(lsum);
    if (hi == 0) wsc[64 + r32] = (c ? -lam : 1.f) * __builtin_amdgcn_rcpf(16.f * lt);
    asm volatile("s_waitcnt lgkmcnt(0)\n\ts_barrier" ::: "memory");
    LAS float* xch = (LAS float*)(lds + qg * 16384);
#pragma unroll
    for (int r = 0; r < 16; ++r) { const float a = wsc[64 + crow(r, hi)];
#pragma unroll
        for (int d0 = 0; d0 < 4; ++d0) o[d0][r] *= a; }
    if (c == 1) {
#pragma unroll
        for (int d0 = 0; d0 < 4; ++d0)
#pragma unroll
            for (int r = 0; r < 16; ++r) xch[(d0 * 16 + r) * 64 + lane] = o[d0][r];
    }
    asm volatile("s_waitcnt lgkmcnt(0)\n\ts_barrier" ::: "memory");
    if (c == 0) {
        constexpr int OB = FP8_ATT_O ? 1 : 2;
        LAS unsigned char* stg = lds + 65536 + qg * 8192;
#pragma unroll
        for (int d0 = 0; d0 < 4; ++d0)
#pragma unroll
            for (int r = 0; r < 16; ++r) o[d0][r] += xch[(d0 * 16 + r) * 64 + lane];
        float ss[16], tt[16];
#pragma unroll
        for (int r = 0; r < 16; ++r) { float x = (o[0][r] * o[0][r] + o[1][r] * o[1][r]) + (o[2][r] * o[2][r] + o[3][r] * o[3][r]);
            x += __builtin_bit_cast(float, __builtin_amdgcn_update_dpp(0, __builtin_bit_cast(int, x), 0xB1, 0xF, 0xF, true));
            x += __builtin_bit_cast(float, __builtin_amdgcn_update_dpp(0, __builtin_bit_cast(int, x), 0x4E, 0xF, 0xF, true));
            x += __builtin_bit_cast(float, __builtin_amdgcn_update_dpp(0, __builtin_bit_cast(int, x), 0x124, 0xF, 0xF, true));
            x += __builtin_bit_cast(float, __builtin_amdgcn_update_dpp(0, __builtin_bit_cast(int, x), 0x128, 0xF, 0xF, true));
            ss[r] = x; }
#pragma unroll
        for (int r = 0; r < 16; ++r) tt[r] = __shfl_xor(ss[r], 16);
#pragma unroll
        for (int r = 0; r < 16; ++r) { const int qr = crow(r, hi); const float rn = __builtin_amdgcn_rsqf((ss[r] + tt[r]) * (1.f / 128.f) + EPS);
#pragma unroll
            for (int d0 = 0; d0 < 4; ++d0) { const float ov = o[d0][r] * rn * sg[d0];
                if (FP8_ATT_O) { const float o4 = clamp8(4.f * ov); *(LAS unsigned char*)(stg + qr * 128 + d0 * 32 + r32) = (unsigned char)(__builtin_amdgcn_cvt_pk_fp8_f32(o4, o4, 0, false) & 0xff); }
                else *(LAS unsigned short*)(stg + (qr * 128 + d0 * 32 + r32) * 2) = (unsigned short)f2bf(ov); } }
        asm volatile("s_waitcnt lgkmcnt(0)" ::: "memory");
        unsigned char* Ob = (unsigned char*)O + ((size_t)(qrow0 + qg * 32) * 1024 + h * 128) * OB;
#pragma unroll
        for (int k = 0; k < 4 * OB; ++k) { const int off = lane * 16 + 1024 * k, row = off / (128 * OB), cb = off % (128 * OB);
            *(u32x4*)(Ob + (size_t)row * 1024 * OB + cb) = *(const LAS u32x4*)(stg + off); }
    }
    asm volatile("s_waitcnt lgkmcnt(0)\n\ts_barrier" ::: "memory");
#undef ATT_DMA8
}
}

#if ATT_FP8
#define ATT_CALL(l_, w_, q_, k_, v_, o_, ...) att::attn_unit8(l_, w_, (const unsigned char*)(q_), (const unsigned char*)(k_), (const unsigned char*)(v_), o_, __VA_ARGS__)
#else
#define ATT_CALL att::attn_unit
#endif
__device__ __forceinline__ void load_row_f32(const float* p, int lane, f32x4 (&v)[4]) {
#pragma unroll
    for (int j = 0; j < 4; ++j) v[j] = *(const f32x4*)(p + 256 * j + 4 * lane);
}
__device__ __forceinline__ void load_row_x(const void* Xb, size_t row, int lane, f32x4 (&v)[4]) {
    if (X_BF16) { const bf16* p = (const bf16*)Xb + row * D;
#pragma unroll
        for (int j = 0; j < 4; ++j) { const u32x2 w = *(const u32x2*)(p + 256 * j + 4 * lane);
            v[j] = (f32x4){bf2f((unsigned short)(w.x & 0xffffu)), bf2f((unsigned short)(w.x >> 16)), bf2f((unsigned short)(w.y & 0xffffu)), bf2f((unsigned short)(w.y >> 16))}; } }
    else load_row_f32((const float*)Xb + row * D, lane, v);
}
__device__ __forceinline__ void store_row_x(void* Xb, size_t row, int lane, const f32x4 (&v)[4]) {
    if (X_BF16) { bf16* p = (bf16*)Xb + row * D;
#pragma unroll
        for (int j = 0; j < 4; ++j) { u32x2 w; w.x = cvt_pk_bf16(v[j][0], v[j][1]); w.y = cvt_pk_bf16(v[j][2], v[j][3]); *(u32x2*)(p + 256 * j + 4 * lane) = w; } }
    else { float* p = (float*)Xb + row * D;
#pragma unroll
        for (int j = 0; j < 4; ++j) *(f32x4*)(p + 256 * j + 4 * lane) = v[j]; }
}
__device__ __forceinline__ float row_rstd(const f32x4 (&v)[4]) {
    float s = 0.f;
#pragma unroll
    for (int j = 0; j < 4; ++j) s += (v[j][0] * v[j][0] + v[j][1] * v[j][1]) + (v[j][2] * v[j][2] + v[j][3] * v[j][3]);
    return 1.0f / sqrtf(wave_sum(s) * (1.f / D) + EPS);
}
__device__ __forceinline__ void norm_mod_store(f32x4 (&v)[4], const float* g, const float* sc, const float* sh, int lane, bf16* hrow) {
    const float rstd = row_rstd(v);
#pragma unroll
    for (int j = 0; j < 4; ++j) { const int c = 256 * j + 4 * lane; const f32x4 gg = *(const f32x4*)(g + c), ss = *(const f32x4*)(sc + c), hh = *(const f32x4*)(sh + c);
        v[j] = (v[j] * rstd) * gg * (ss + 1.f) + hh;
        u32x2 w; w.x = cvt_pk_bf16(v[j][0], v[j][1]); w.y = cvt_pk_bf16(v[j][2], v[j][3]); *(u32x2*)(hrow + c) = w; }
}
__device__ __forceinline__ void norm_mod_f32(f32x4 (&v)[4], const float* g, const float* sc, const float* sh, int lane) {
    const float rstd = row_rstd(v);
#pragma unroll
    for (int j = 0; j < 4; ++j) { const int c = 256 * j + 4 * lane; const f32x4 gg = *(const f32x4*)(g + c), ss = *(const f32x4*)(sc + c), hh = *(const f32x4*)(sh + c);
        v[j] = (v[j] * rstd) * gg * (ss + 1.f) + hh; }
}
__device__ __forceinline__ void norm_mod_store_mix(bool f8, f32x4 (&v)[4], const float* g, const float* sc, const float* sh, int lane, bf16* hrow, unsigned char* h8row) {
    if (f8) { norm_mod_f32(v, g, sc, sh, lane);
#pragma unroll
        for (int j = 0; j < 4; ++j) *(unsigned*)(h8row + 256 * j + 4 * lane) = pack_fp8x4(16.f * v[j][0], 16.f * v[j][1], 16.f * v[j][2], 16.f * v[j][3]); }
    else norm_mod_store(v, g, sc, sh, lane, hrow);
}
__device__ __forceinline__ int row_batch(int row) { return row / RPB; }
__device__ __forceinline__ bool row_is_ctx(int row) { return (row % RPB) < CTXL; }
__device__ __forceinline__ int act_row(int ai, bool lat_only) { return lat_only ? (ai >> 11) * RPB + CTXL + (ai & 2047) : ai; }

template <int MODE>
__device__ __forceinline__ void transpose_item(const float* W, int K, int N, bf16* WT, LAS float* scr, int item, int lane) {
    const int nblk = N / 32, kb = item / nblk, nb = item % nblk, k0 = 64 * kb, n0 = 32 * nb;
#pragma unroll 8
    for (int i = 0; i < 32; ++i) { const int kk = 2 * i + (lane >> 5); scr[kk * 33 + (lane & 31)] = W[(size_t)(k0 + kk) * N + n0 + (lane & 31)]; }
    asm volatile("s_waitcnt lgkmcnt(0)" ::: "memory");
    const int c = lane & 7;
#pragma unroll
    for (int j = 0; j < 4; ++j) { const int n = (lane >> 3) + 8 * j; const LAS float* s = scr + (8 * c) * 33 + n;
        u32x4 o; o.x = cvt_pk_bf16(s[0 * 33], s[1 * 33]); o.y = cvt_pk_bf16(s[2 * 33], s[3 * 33]); o.z = cvt_pk_bf16(s[4 * 33], s[5 * 33]); o.w = cvt_pk_bf16(s[6 * 33], s[7 * 33]);
        int nn = n0 + n;
        if (MODE == 1 && nn < 2048) { const int i6 = nn & 63; nn = (nn & ~63) + (i6 < 32 ? 2 * i6 : 2 * (i6 - 32) + 1); }
        if (MODE == 2 && nn >= 1024) nn = nn < 2048 ? 1024 + 2 * (nn - 1024) : 1024 + 2 * (nn - 2048) + 1;
        *(u32x4*)(WT + (size_t)nn * K + k0 + 8 * c) = o; }
    asm volatile("s_waitcnt lgkmcnt(0)" ::: "memory");
}

template <int MODE = 0>
__device__ __forceinline__ void transpose_item8(const float* W, int K, int N, unsigned char* WT, LAS float* scr, int item, int lane) {
    const int nblk = N / 16, kb = item / nblk, nb = item % nblk, k0 = 128 * kb, n0 = 16 * nb;
    f32x4 v[8];
#pragma unroll
    for (int i = 0; i < 8; ++i) v[i] = *(const f32x4*)(W + (size_t)(k0 + 16 * i + (lane >> 2)) * N + n0 + 4 * (lane & 3));
#pragma unroll
    for (int i = 0; i < 8; ++i) *(LAS f32x4*)(scr + (16 * i + (lane >> 2)) * 20 + 4 * (lane & 3)) = v[i] * 1024.f;
    asm volatile("s_waitcnt lgkmcnt(0)" ::: "memory");
    const int kc = lane & 7;
#pragma unroll
    for (int j = 0; j < 2; ++j) { const int n = (lane >> 3) + 8 * j; const LAS float* s = scr + (16 * kc) * 20 + n;
        u32x4 o;
        o.x = pack_fp8x4(s[0 * 20], s[1 * 20], s[2 * 20], s[3 * 20]); o.y = pack_fp8x4(s[4 * 20], s[5 * 20], s[6 * 20], s[7 * 20]);
        o.z = pack_fp8x4(s[8 * 20], s[9 * 20], s[10 * 20], s[11 * 20]); o.w = pack_fp8x4(s[12 * 20], s[13 * 20], s[14 * 20], s[15 * 20]);
        int nn = n0 + n;
        if (MODE == 1 && nn < 2048) { const int i6 = nn & 63; nn = (nn & ~63) + (i6 < 32 ? 2 * i6 : 2 * (i6 - 32) + 1); }
        *(u32x4*)(WT + (size_t)nn * K + k0 + 16 * kc) = o; }
    asm volatile("s_waitcnt lgkmcnt(0)" ::: "memory");
}

__device__ __forceinline__ void item8_load(const float* W, int N, int item, int lane, f32x4 (&v)[8]) {
    const int nblk = N / 16, kb = item / nblk, nb = item % nblk, k0 = 128 * kb, n0 = 16 * nb;
#pragma unroll
    for (int i = 0; i < 8; ++i) v[i] = *(const f32x4*)(W + (size_t)(k0 + 16 * i + (lane >> 2)) * N + n0 + 4 * (lane & 3));
}
__device__ __forceinline__ void item8_store(const f32x4 (&v)[8], int K, int N, unsigned char* WT, LAS float* scr, int item, int lane) {
    const int nblk = N / 16, kb = item / nblk, nb = item % nblk, k0 = 128 * kb, n0 = 16 * nb;
#pragma unroll
    for (int i = 0; i < 8; ++i) *(LAS f32x4*)(scr + (16 * i + (lane >> 2)) * 20 + 4 * (lane & 3)) = v[i] * 1024.f;
    asm volatile("s_waitcnt lgkmcnt(0)" ::: "memory");
    const int kc = lane & 7;
#pragma unroll
    for (int j = 0; j < 2; ++j) { const int n = (lane >> 3) + 8 * j; const LAS float* s = scr + (16 * kc) * 20 + n;
        u32x4 o;
        o.x = pack_fp8x4(s[0 * 20], s[1 * 20], s[2 * 20], s[3 * 20]); o.y = pack_fp8x4(s[4 * 20], s[5 * 20], s[6 * 20], s[7 * 20]);
        o.z = pack_fp8x4(s[8 * 20], s[9 * 20], s[10 * 20], s[11 * 20]); o.w = pack_fp8x4(s[12 * 20], s[13 * 20], s[14 * 20], s[15 * 20]);
        *(u32x4*)(WT + (size_t)(n0 + n) * K + k0 + 16 * kc) = o; }
    asm volatile("s_waitcnt lgkmcnt(0)" ::: "memory");
}

struct Args { const float* in[21]; float* out; unsigned char* ws; int ph_lo, ph_hi; };
enum { I_X = 0, I_C, I_CTX, I_CCTX, I_MODW, I_MODB, I_NORMG, I_WQKV, I_WO, I_LAM, I_SUBG, I_WIN, I_CONVW, I_WOUT, I_RW, I_RB, I_WGU, I_BGU, I_WD, I_BD, I_FINALG };

__device__ __forceinline__ void moe_table(LAS unsigned char* lds, const unsigned* gcnt, int tid) {
    LAS int* ecnt = (LAS int*)(lds + LX_ECNT); LAS int* tstart = (LAS int*)(lds + LX_TSTART); LAS int* tile_e = (LAS int*)(lds + LX_TILEE);
    __syncthreads();
    if (tid < 32) ecnt[tid] = (int)__hip_atomic_load(gcnt + tid, RLX_AGENT);
    __syncthreads();
    if (tid == 0) { int ts = 0; for (int e = 0; e < 32; ++e) { tstart[e] = ts; ts += (ecnt[e] + 255) >> 8; } tstart[32] = ts; }
    __syncthreads();
    { const int e = tid >> 4, l16 = tid & 15; const int t0 = tstart[e], n = tstart[e + 1] - t0; for (int j = l16; j < n; j += 16) tile_e[t0 + j] = e; }
    __syncthreads();
}

typedef const __attribute__((address_space(4))) unsigned char* kptr_t;
__device__ __forceinline__ kptr_t kargs() { kptr_t p = (kptr_t)__builtin_amdgcn_kernarg_segment_ptr(); asm volatile("" : "+s"(p)); return p; }
#define INP(k) (*(const float* const __attribute__((address_space(4)))*)(kargs() + 8 * (k)))
#define OUTP() (*(float* const __attribute__((address_space(4)))*)(kargs() + 168))
#define WSB() (*(unsigned char* const __attribute__((address_space(4)))*)(kargs() + 176))
#define WSP(T, off) ((T*)(WSB() + (off)))
static_assert(sizeof(Args) == 192, "kernarg layout");
__global__ void __launch_bounds__(NTHREADS, 2) fwd(Args args) {
    extern __shared__ __attribute__((aligned(16))) unsigned char lds_raw[];
    LAS unsigned char* lds = (LAS unsigned char*)lds_raw;
    const int tid = threadIdx.x, lane = tid & 63, wave = __builtin_amdgcn_readfirstlane(tid >> 6);
    const int G = gridDim.x, bid = blockIdx.x;
    const int gw = bid * NWAVES + wave, NGW = G * NWAVES;
    gu32* ctl = (gu32*)WSP(unsigned, WS_CTL);
    for (int u = tid; u < (LDS_BYTES - LX) / 4; u += NTHREADS) ((LAS unsigned*)(lds + LX))[u] = 0u;
    __syncthreads();
    volatile LAS unsigned* MISC = (volatile LAS unsigned*)(lds + LX_MISC);
    XcdBarrier bar; bar.bar = (unsigned*)(ctl + CW_BAR); bar.x = 0; bar.st = nullptr;
    if (!MK_PER_PHASE) bar = xcd_barrier_post((unsigned*)(ctl + CW_BAR), MISC + 8);
    (void)args;
    const unsigned long long pt_start = PROBE_T ? __builtin_amdgcn_s_memtime() : 0ull; (void)pt_start;
    const unsigned long long pt_rstart = PROBE_T ? __builtin_amdgcn_s_memrealtime() : 0ull; (void)pt_rstart;
    const int lo = *(const int __attribute__((address_space(4)))*)(kargs() + 184), hi = *(const int __attribute__((address_space(4)))*)(kargs() + 188);
#define IN(k) (lo <= (k) && (k) < hi)
#define PHASE_IDS int tid = threadIdx.x; asm volatile("" : "+v"(tid)); const int lane = tid & 63, wave = __builtin_amdgcn_readfirstlane(tid >> 6); const int gw = bid * NWAVES + wave; (void)lane; (void)gw;
#define SEAM(k) do { if (IN(k) && IN((k) + 1)) { if (MK_PER_PHASE) { if (tid == 0) __hip_atomic_store(ctl + CW_TMO, 0xBADu, RLX_AGENT); } else { unsigned long long b0_ = 0; if (PROBE_T == 10) b0_ = __builtin_amdgcn_s_memtime(); xcd_barrier(bar); if (PROBE_REP & 0x10000) xcd_barrier(bar); if (PROBE_T == 10 && bid == PROBE_BID && threadIdx.x == 0) *(LAS unsigned long long*)(lds + LX_MISC + 64) += __builtin_amdgcn_s_memtime() - b0_; } } } while (0)

    if (PS(0) && IN(0)) { PHASE_IDS
        float* modv = WSP(float, WS_MODV);
        unsigned long long p0t_ = (PROBE_T == 11 || PROBE_T == 12) ? __builtin_amdgcn_s_memtime() : 0ull; (void)p0t_;
        { LAS float* sil = (LAS float*)lds;
          LAS float* red = (LAS float*)(lds + 69632);
          for (int i = tid; i < 17 * 1024; i += NTHREADS) { const int r = i >> 10, k = i & 1023; const float cv = r < 16 ? INP(I_C)[r * 1024 + k] : INP(I_CCTX)[k]; sil[i] = cv / (1.f + __expf(-cv)); }
          __syncthreads();
          for (int it = bid; it < 4 * 96; it += G) { const int l = it / 96, nb = it % 96; const float* W = INP(I_MODW) + (size_t)l * 1024 * 6144 + nb * 64 + lane;
            float a[17];
#pragma unroll
            for (int r = 0; r < 17; ++r) a[r] = 0.f;
            for (int k = wave * 128; k < wave * 128 + 128; k += 4) { float w[4];
#pragma unroll
                for (int q = 0; q < 4; ++q) w[q] = W[(size_t)(k + q) * 6144];
#pragma unroll
                for (int r = 0; r < 17; ++r) { const f32x4 s = *(const LAS f32x4*)(sil + r * 1024 + k); a[r] += s[0] * w[0] + s[1] * w[1] + s[2] * w[2] + s[3] * w[3]; } }
#pragma unroll
            for (int r = 0; r < 17; ++r) red[(wave * 17 + r) * 64 + lane] = a[r];
            __syncthreads();
            for (int i = tid; i < 17 * 64; i += NTHREADS) { const int r = i >> 6, n = i & 63; float s = INP(I_MODB)[l * 6144 + nb * 64 + n];
#pragma unroll
                for (int w8 = 0; w8 < 8; ++w8) s += red[(w8 * 17 + r) * 64 + n];
                modv[((size_t)l * 17 + r) * 6144 + nb * 64 + n] = s; }
            __syncthreads(); }
        }
        if (PROBE_T == 11 && bid == 0 && tid == 0) *(LAS unsigned long long*)(lds + LX_MISC + 64) += __builtin_amdgcn_s_memtime() - p0t_;
        { float* cosT = WSP(float, WS_ROPE); float* sinT = cosT + 2048 * 32; float* rwT = WSP(float, WS_RW); float* lamv = WSP(float, WS_MISC);
        for (int i = bid * NTHREADS + tid; i < 2048 * 32; i += G * NTHREADS) { const int t = i >> 5, j = i & 31; const float pos = (float)(j < 16 ? (t >> 6) : (t & 63));
            const float inv = powf(10000.f, -(float)(2 * (j & 15)) / 32.f); const float ang = pos * inv; cosT[i] = cosf(ang); sinT[i] = sinf(ang); }
        if (bid == 0 && tid < 2) { const float* lp = INP(I_LAM) + tid * 256; float s1 = 0.f, s2 = 0.f; for (int d = 0; d < 64; ++d) { s1 += lp[d] * lp[64 + d]; s2 += lp[128 + d] * lp[192 + d]; }
            const float lam_init = 0.8f - 0.6f * expf(-0.3f * (float)(2 * tid)); lamv[tid] = expf(s1) - expf(s2) + lam_init; lamv[2 + tid] = 1.f - lam_init; }
        for (int i = bid * NTHREADS + tid; i < 4 * 32 * 1024; i += G * NTHREADS) { const int l = i >> 15, e = (i >> 10) & 31, k = i & 1023; rwT[i] = INP(I_RW)[((size_t)l * 1024 + k) * 32 + e]; } }
        if (PROBE_T == 12) p0t_ = __builtin_amdgcn_s_memtime();
        { LAS float* scr = (LAS float*)(lds + wave * 10240);
          bf16* Wqkv_t = WSP(bf16, WS_WQKV); bf16* Win_t = WSP(bf16, WS_WIN); bf16* Wo_t = WSP(bf16, WS_WO); bf16* Wout_t = WSP(bf16, WS_WOUT); bf16* Wgu_t = WSP(bf16, WS_WGU); bf16* Wd_t = WSP(bf16, WS_WD);
          constexpr int I_QKV = 16 * 96, I_SQ = 16 * 32, I_GU = 16 * 64, I_D = 16 * 32;
          constexpr int T0 = 2 * I_QKV, T1 = T0 + 2 * I_QKV, T2 = T1 + 2 * I_SQ, T3 = T2 + 2 * I_SQ, T4 = T3 + 128 * I_GU, T5 = T4 + 128 * I_D;
          for (int rep = 0; rep < NREP(0); ++rep) {
          for (int it = gw; it < (MOE_FP8 ? T3 : T5); it += NGW) {
            if (it < T0) { const int j = it / I_QKV; if (FP8_ATT) transpose_item8<1>(INP(I_WQKV) + (size_t)j * 1024 * 3072, 1024, 3072, (unsigned char*)Wqkv_t + (size_t)j * 3072 * 1024, scr, it % I_QKV, lane); else transpose_item<1>(INP(I_WQKV) + (size_t)j * 1024 * 3072, 1024, 3072, Wqkv_t + (size_t)j * 3072 * 1024, scr, it % I_QKV, lane); }
            else if (it < T1) { const int r = it - T0, j = r / I_QKV; if (FP8_CONV) transpose_item8<0>(INP(I_WIN) + (size_t)j * 1024 * 3072, 1024, 3072, (unsigned char*)Win_t + (size_t)j * 3072 * 1024, scr, r % I_QKV, lane); else transpose_item<CONV_FUSE_U ? 2 : 0>(INP(I_WIN) + (size_t)j * 1024 * 3072, 1024, 3072, Win_t + (size_t)j * 3072 * 1024, scr, r % I_QKV, lane); }
            else if (it < T2) { const int r = it - T1, j = r / I_SQ; if (FP8_ATT_O) transpose_item8<0>(INP(I_WO) + (size_t)j * 1024 * 1024, 1024, 1024, (unsigned char*)Wo_t + (size_t)j * 1024 * 1024, scr, r % I_SQ, lane); else transpose_item<0>(INP(I_WO) + (size_t)j * 1024 * 1024, 1024, 1024, Wo_t + (size_t)j * 1024 * 1024, scr, r % I_SQ, lane); }
            else if (it < T3) { const int r = it - T2, j = r / I_SQ; if (FP8_CONV) transpose_item8<0>(INP(I_WOUT) + (size_t)j * 1024 * 1024, 1024, 1024, (unsigned char*)Wout_t + (size_t)j * 1024 * 1024, scr, r % I_SQ, lane); else transpose_item<0>(INP(I_WOUT) + (size_t)j * 1024 * 1024, 1024, 1024, Wout_t + (size_t)j * 1024 * 1024, scr, r % I_SQ, lane); }
            else if (it < T4) { const int r = it - T3, j = r / I_GU; transpose_item<0>(INP(I_WGU) + (size_t)j * 1024 * 2048, 1024, 2048, Wgu_t + (size_t)j * 2048 * 1024, scr, r % I_GU, lane); }
            else { const int r = it - T4, j = r / I_D; transpose_item<0>(INP(I_WD) + (size_t)j * 1024 * 1024, 1024, 1024, Wd_t + (size_t)j * 1024 * 1024, scr, r % I_D, lane); }
          }
          if (MOE_FP8) {
            constexpr int NGUI = 128 * I_GU, NMOE = NGUI + 128 * I_D;
            const float* wgu = INP(I_WGU); const float* wd = INP(I_WD);
#define MOE_DEC(r_, W_, N_, WT_, IT_) do { if ((r_) < NGUI) { const int j_ = (r_) / I_GU; W_ = wgu + (size_t)j_ * 1024 * 2048; N_ = 2048; WT_ = (unsigned char*)Wgu_t + (size_t)j_ * 2048 * 1024; IT_ = (r_) % I_GU; } \
              else { const int q_ = (r_) - NGUI, j_ = q_ / I_D; W_ = wd + (size_t)j_ * 1024 * 1024; N_ = 1024; WT_ = (unsigned char*)Wd_t + (size_t)j_ * 1024 * 1024; IT_ = q_ % I_D; } } while (0)
            f32x4 vc[8], vn[8]; const float* Wc = nullptr; int Nc = 0, itc = 0; unsigned char* WTc = nullptr;
            int r = gw;
            if (r < NMOE) { MOE_DEC(r, Wc, Nc, WTc, itc); item8_load(Wc, Nc, itc, lane, vc); }
            for (; r < NMOE; r += NGW) { const int rn = r + NGW; const bool hn = rn < NMOE; const float* Wn = Wc; int Nn = Nc, itn = itc; unsigned char* WTn = WTc;
                if (hn) { MOE_DEC(rn, Wn, Nn, WTn, itn); item8_load(Wn, Nn, itn, lane, vn); }
                item8_store(vc, 1024, Nc, WTc, scr, itc, lane);
                if (hn) { Wc = Wn; Nc = Nn; itc = itn; WTc = WTn;
#pragma unroll
                    for (int i = 0; i < 8; ++i) vc[i] = vn[i]; } }
#undef MOE_DEC
          }
          }
        }
        if (PROBE_T == 12 && bid == 0 && tid == 0) *(LAS unsigned long long*)(lds + LX_MISC + 64) += __builtin_amdgcn_s_memtime() - p0t_;
        __syncthreads();
    }
    SEAM(0);

    if (PS(1) && IN(1)) { PHASE_IDS
        const float* g = INP(I_NORMG); const float* modv = WSP(float, WS_MODV); float* X = WSP(float, WS_X); bf16* H = WSP(bf16, WS_H);
        for (int row = gw; row < M; row += NGW) { const int b = row_batch(row), jj = row % RPB; const bool cx = jj < CTXL; const int rb = cx ? 16 : b;
            const float* src = cx ? INP(I_CTX) + ((size_t)b * CTXL + jj) * D : INP(I_X) + ((size_t)b * SEQ + (jj - CTXL)) * D;
            f32x4 v[4]; load_row_f32(src, lane, v);
            norm_mod_store_mix(FP8_ATT != 0, v, g, modv + rb * 6144 + 1024, modv + rb * 6144, lane, H + (size_t)row * D, WSP(unsigned char, WS_H8) + (size_t)row * 1024); }
    }
    SEAM(1);

    for (int l = 0; l < DEPTH; ++l) {
        const int pb = 2 + 7 * l; const bool attn = (l & 1) == 0; const int j2 = l >> 1; const bool lat_only = (l == DEPTH - 1);
#define MV() (WSP(float, WS_MODV) + (size_t)l * 17 * 6144)
        const unsigned* gcnt = (const unsigned*)(ctl + CW_CNT) + l * 32;

        if (IN(pb)) { PHASE_IDS
            if (PS(2) && attn) {
                constexpr int RBX = FP8_ATT ? 1024 : 2048; constexpr int SCX = FP8_ATT ? 0x78787878 : 0;
                typedef SchedQKV<RBX, SCX> SQ;
                SQ S{FP8_ATT ? (const char*)WSP(unsigned char, WS_H8) : (const char*)WSP(bf16, WS_H), (const char*)WSP(bf16, WS_WQKV) + (size_t)j2 * 3072 * RBX};
                EpiQKV E{WSP(bf16, WS_Q), WSP(bf16, WS_K), WSP(bf16, WS_VT), WSP(float, WS_ROPE), WSP(float, WS_ROPE) + 2048 * 32, true, lds + LX_EPI};
                for (int rep = 0; rep < NREP(2); ++rep) { int z_ = rep; asm volatile("" : "+s"(z_)); E.dost = !PROBE_NOST || (z_ == NREP(2) - 1); pg8::gemm_phase<EpiQKV, SQ, 2>(lds, S, E, tid, STAG(1500)); }
            } else if (PS(3)) {
                constexpr int RBX = FP8_CONV ? 1024 : 2048; constexpr int SCX = FP8_CONV ? 0x78787878 : 0;
                typedef SchedPlain<RBX, SCX> SP;
                SP S{FP8_CONV ? (const char*)WSP(unsigned char, WS_H8) : (const char*)WSP(bf16, WS_H), (const char*)WSP(bf16, WS_WIN) + (size_t)j2 * 3072 * RBX, 12, lat_only};
                if (CONV_FUSE_U) { EpiConvIn E{WSP(bf16, WS_BCO), WSP(bf16, WS_BCO) + (size_t)M * 1024};
                    for (int rep = 0; rep < NREP(3); ++rep) pg8::gemm_phase<EpiConvIn, SP, 3>(lds, S, E, tid, STAG(1500)); }
                else { EpiPlain E{WSP(bf16, WS_BCO), 3072};
                    for (int rep = 0; rep < NREP(3); ++rep) pg8::gemm_phase<EpiPlain, SP, 3>(lds, S, E, tid, STAG(1500)); }
            }
        }
        SEAM(pb);

        if (IN(pb + 1)) { PHASE_IDS
            if (PS(4) && attn) {
                const float* lamv = WSP(float, WS_MISC); const float lam = lamv[j2], osc = lamv[2 + j2]; const float* subg = INP(I_SUBG) + j2 * 128;
                const bf16* Qb = WSP(bf16, WS_Q); const bf16* Kb = WSP(bf16, WS_K); const bf16* Vt = WSP(bf16, WS_VT); bf16* Ob = WSP(bf16, WS_O);
                LAS float* wsc = (LAS float*)(lds + LX_WSC + wave * 1024);
                const int vcu = (G % 8 == 0) ? (bid % 8) * (G / 8) + bid / 8 : bid;
                for (int rep = 0; rep < NREP(4); ++rep)
                if (G == 256) {
                    const int xc = bid & 7, j = bid >> 3;
                    for (int sstep = 0; sstep < 8; ++sstep) { const int bh = xc * 16 + 2 * sstep + (j >> 4), b = bh >> 3, h = bh & 7;
                        ATT_CALL(lds, wsc, Qb, Kb, Vt, Ob, b * RPB, h, b * RPB + CTXL + (j & 15) * 128, 36, lam, osc, subg, tid); }
                    { const int bh = xc * 16 + (j >> 1), b = bh >> 3, h = bh & 7;
                      ATT_CALL(lds, wsc, Qb, Kb, Vt, Ob, b * RPB, h, b * RPB + (j & 1) * 128, 4, lam, osc, subg, tid); }
                } else {
                    for (int u = bid; u < 128 * 18; u += G) { const int bh = u / 18, k = u % 18, b = bh >> 3, h = bh & 7;
                        ATT_CALL(lds, wsc, Qb, Kb, Vt, Ob, b * RPB, h, k < 16 ? b * RPB + CTXL + k * 128 : b * RPB + (k - 16) * 128, k < 16 ? 36 : 4, lam, osc, subg, tid); }
                }
            } else if (PS(5)) {
                const float* cw = INP(I_CONVW) + (size_t)j2 * 3 * 1024; const bf16* BCO = WSP(bf16, WS_BCO); bf16* Ob = WSP(bf16, WS_O);
                const int nact = lat_only ? 32768 : M; const int nitems = (nact / 16) * 2;
                for (int it = gw; it < nitems; it += NGW) { const int strip = it >> 1, ch = (it & 1) * 512 + lane * 8; const int row0 = act_row(strip * 16, lat_only);
                    const int jj = row0 % RPB; const int seq_lo = jj < CTXL ? row0 - jj : row0 - jj + CTXL, seq_hi = jj < CTXL ? row0 - jj + CTXL : row0 - jj + RPB;
                    float w0[8], w1[8], w2[8];
#pragma unroll
                    for (int q = 0; q < 8; ++q) { w0[q] = cw[ch + q]; w1[q] = cw[1024 + ch + q]; w2[q] = cw[2048 + ch + q]; }
                    float up[8], uc[8], un[8];
                    auto load_u = [&](int row, float (&u)[8]) {
                        if (row < seq_lo || row >= seq_hi) {
#pragma unroll
                            for (int q = 0; q < 8; ++q) u[q] = 0.f;
                        } else if (CONV_FUSE_U) { const u32x4 uu = *(const u32x4*)(BCO + (size_t)M * 1024 + (size_t)row * 1024 + ch);
#pragma unroll
                            for (int q = 0; q < 4; ++q) { u[2 * q] = bf2f((unsigned short)(uu[q] & 0xffffu)); u[2 * q + 1] = bf2f((unsigned short)(uu[q] >> 16)); }
                        } else { const bf16* p = BCO + (size_t)row * 3072; const u32x4 gc = *(const u32x4*)(p + 1024 + ch), xt = *(const u32x4*)(p + 2048 + ch);
#pragma unroll
                            for (int q = 0; q < 4; ++q) { u[2 * q] = bf2f((unsigned short)(gc[q] & 0xffffu)) * bf2f((unsigned short)(xt[q] & 0xffffu)); u[2 * q + 1] = bf2f((unsigned short)(gc[q] >> 16)) * bf2f((unsigned short)(xt[q] >> 16)); } } };
                    load_u(row0 - 1, up); load_u(row0, uc);
                    for (int r = 0; r < 16; ++r) { const int row = row0 + r; load_u(row + 1, un);
                        const u32x4 gb = *(const u32x4*)(BCO + (size_t)row * (CONV_FUSE_U ? 1024 : 3072) + ch); float z[8];
#pragma unroll
                        for (int q = 0; q < 8; ++q) { const float gbv = bf2f((unsigned short)((q & 1) ? (gb[q >> 1] >> 16) : (gb[q >> 1] & 0xffffu))); z[q] = gbv * (w0[q] * up[q] + w1[q] * uc[q] + w2[q] * un[q]); }
                        if (FP8_CONV) { u32x2 o; o.x = pack_fp8x4(4.f * z[0], 4.f * z[1], 4.f * z[2], 4.f * z[3]); o.y = pack_fp8x4(4.f * z[4], 4.f * z[5], 4.f * z[6], 4.f * z[7]); *(u32x2*)((unsigned char*)Ob + (size_t)row * 1024 + ch) = o; }
                        else { u32x4 o; o.x = cvt_pk_bf16(z[0], z[1]); o.y = cvt_pk_bf16(z[2], z[3]); o.z = cvt_pk_bf16(z[4], z[5]); o.w = cvt_pk_bf16(z[6], z[7]);
                        *(u32x4*)(Ob + (size_t)row * 1024 + ch) = o; }
#pragma unroll
                        for (int q = 0; q < 8; ++q) { up[q] = uc[q]; uc[q] = un[q]; } } }
            }
        }
        SEAM(pb + 1);

        if (PS(6) && IN(pb + 2)) { PHASE_IDS
            float* X = WSP(float, WS_X);
            EpiResid E{X, X, MV() + 2 * 1024, l == 0 ? INP(I_X) : nullptr, l == 0 ? INP(I_CTX) : nullptr};
            if (attn) { constexpr int RBX = FP8_ATT_O ? 1024 : 2048; constexpr int SCX = FP8_ATT_O ? 0x79797979 : 0;
                typedef SchedPlain<RBX, SCX> SP;
                SP S{(const char*)WSP(bf16, WS_O), (const char*)WSP(bf16, WS_WO) + (size_t)j2 * 1024 * RBX, 4, lat_only};
                pg8::gemm_phase<EpiResid, SP, 6>(lds, S, E, tid, STAG(1500));
            } else { constexpr int RBX = FP8_CONV ? 1024 : 2048; constexpr int SCX = FP8_CONV ? 0x79797979 : 0;
                typedef SchedPlain<RBX, SCX> SP;
                SP S{(const char*)WSP(bf16, WS_O), (const char*)WSP(bf16, WS_WOUT) + (size_t)j2 * 1024 * RBX, 4, lat_only};
                pg8::gemm_phase<EpiResid, SP, 6>(lds, S, E, tid, STAG(1500));
            }
        }
        SEAM(pb + 2);

        if (PS(7) && IN(pb + 3)) { PHASE_IDS
            LAS int* lcnt = (LAS int*)(lds + LX_LCNT); LAS int* lbase = (LAS int*)(lds + LX_LBASE); LAS int* asg = (LAS int*)(lds + LX_ASG);
            LAS float* wsc = (LAS float*)(lds + LX_WSC + wave * 1024);
            LAS unsigned char* tile = lds;
            LAS float* part = (LAS float*)(lds + 65536);
            float* X = WSP(float, WS_X); bf16* H = WSP(bf16, WS_H); const float* mv = MV(); int* topE = WSP(int, WS_TOPE); float* topG = WSP(float, WS_TOPG); int* topP = WSP(int, WS_TOPP); int* list = WSP(int, WS_LIST);
            const int r32 = lane & 31, hi = lane >> 5;
            bf16x8 wf[8];
            { const float* rw = WSP(float, WS_RW) + (size_t)l * 32 * 1024 + r32 * 1024 + wave * 128 + hi * 8;
#pragma unroll
              for (int s8 = 0; s8 < 8; ++s8) { const f32x4 a = *(const f32x4*)(rw + 16 * s8), b = *(const f32x4*)(rw + 16 * s8 + 4); wf[s8] = __builtin_bit_cast(bf16x8, pack8(a, b)); } }
            __syncthreads();
            if (tid < 32) lcnt[tid] = 0;
            __syncthreads();
            const int nact = lat_only ? 32768 : M; const int rpb = (nact + G - 1) / G; const int a0 = bid * rpb; int nr = nact - a0; nr = nr < 0 ? 0 : (nr > rpb ? rpb : nr);
            const float* g = INP(I_NORMG) + ((size_t)l * 2 + 1) * 1024; const float* rb_ = INP(I_RB) + l * 32;
            for (int g0 = 0; g0 < nr; g0 += 32) {
                f32x4 v[4][4]; int rowq[4]; bool okq[4];
#pragma unroll
                for (int q = 0; q < 4; ++q) { const int i = g0 + wave + 8 * q; okq[q] = i < nr; rowq[q] = act_row(a0 + (okq[q] ? i : nr - 1), lat_only); load_row_x(X, (size_t)rowq[q], lane, v[q]); }
#pragma unroll
                for (int q = 0; q < 4; ++q) { const int row = rowq[q]; const int rb = row_is_ctx(row) ? 16 : row_batch(row); const int tr = wave + 8 * q;
                    norm_mod_f32(v[q], g, mv + rb * 6144 + 4 * 1024, mv + rb * 6144 + 3 * 1024, lane);
                    if (MOE_FP8) { unsigned char* h8 = WSP(unsigned char, WS_H8) + (size_t)row * 1024;
#pragma unroll
                        for (int j = 0; j < 4; ++j) { const unsigned pk_ = pack_fp8x4(16.f * v[q][j][0], 16.f * v[q][j][1], 16.f * v[q][j][2], 16.f * v[q][j][3]); if (okq[q]) *(unsigned*)(h8 + 256 * j + 4 * lane) = pk_; } }
#pragma unroll
                    for (int j = 0; j < 4; ++j) { u32x2 w; w.x = cvt_pk_bf16(v[q][j][0], v[q][j][1]); w.y = cvt_pk_bf16(v[q][j][2], v[q][j][3]);
                        if (!MOE_FP8 && okq[q]) *(u32x2*)(H + (size_t)row * D + 256 * j + 4 * lane) = w;
                        const int ch = 32 * j + (lane >> 1); *(LAS u32x2*)(tile + tr * 2048 + ((ch ^ (tr & 15)) << 4) + (lane & 1) * 8) = w; } }
                __syncthreads();
                { f32x16 acc = f32x16{};
#pragma unroll
                  for (int s8 = 0; s8 < 8; ++s8) { const int ch = wave * 16 + 2 * s8 + hi; const bf16x8 bfr = *(const LAS bf16x8*)(tile + r32 * 2048 + ((ch ^ (r32 & 15)) << 4));
                      acc = __builtin_amdgcn_mfma_f32_32x32x16_bf16(wf[s8], bfr, acc, 0, 0, 0); }
#pragma unroll
                  for (int r = 0; r < 16; ++r) { const int e = (r & 3) + 8 * (r >> 2) + 4 * hi; part[(wave * 32 + e) * 33 + r32] = acc[r]; } }
                __syncthreads();
#pragma unroll 1
                for (int q = 0; q < 4; ++q) { const int tr = wave + 8 * q; const int i = g0 + tr; const int row = rowq[q]; const int my_e = r32;
                    float lg = rb_[my_e];
#pragma unroll
                    for (int w8 = 0; w8 < 8; ++w8) lg += part[(w8 * 32 + my_e) * 33 + tr];
                    if (lane < 32) wsc[my_e] = lg;
                    asm volatile("s_waitcnt lgkmcnt(0)" ::: "memory");
                    int rank = 0;
#pragma unroll
                    for (int e = 0; e < 32; ++e) { const float o = wsc[e]; rank += (o > lg || (o == lg && e < my_e)) ? 1 : 0; }
                    asm volatile("s_waitcnt lgkmcnt(0)" ::: "memory");
                    if (lane < 32 && rank < 4) { wsc[64 + rank] = lg; ((LAS int*)wsc)[72 + rank] = my_e; }
                    asm volatile("s_waitcnt lgkmcnt(0)" ::: "memory");
                    const float t0 = wsc[64], t1 = wsc[65], t2 = wsc[66], t3 = wsc[67];
                    const float p0 = 1.f, p1 = __expf(t1 - t0), p2 = __expf(t2 - t0), p3 = __expf(t3 - t0); const float inv = 1.f / (p0 + p1 + p2 + p3);
                    if (lane < 4 && okq[q]) { const int e = ((LAS int*)wsc)[72 + lane]; const float p = lane == 0 ? p0 : lane == 1 ? p1 : lane == 2 ? p2 : p3;
                        const int lp = __hip_atomic_fetch_add(lcnt + e, 1, __ATOMIC_RELAXED, __HIP_MEMORY_SCOPE_WORKGROUP);
                        topE[row * 4 + lane] = e; topG[row * 4 + lane] = p * inv; asg[i * 4 + lane] = (lp << 5) | e; }
                    asm volatile("s_waitcnt lgkmcnt(0)" ::: "memory");
                }
            }
            __syncthreads();
            if (tid < 32) lbase[tid] = (int)__hip_atomic_fetch_add((unsigned*)gcnt + tid, (unsigned)lcnt[tid], RLX_AGENT);
            __syncthreads();
            for (int i = tid; i < nr * 4; i += NTHREADS) { const int av = asg[i], e = av & 31, pos = lbase[e] + (av >> 5); const int row = act_row(a0 + (i >> 2), lat_only);
                list[(size_t)e * CAP + pos] = row; topP[row * 4 + (i & 3)] = pos; }
            __syncthreads();
        }
        SEAM(pb + 3);

        if (PS(8) && IN(pb + 4)) { PHASE_IDS
            moe_table(lds, gcnt, tid);
            constexpr int RBM = MOE_FP8 ? 1024 : 2048;
            typedef SchedMoe<true, RBM, 0x78787878, 0x78787878> SG;
            SG S{(const char*)(MOE_FP8 ? (void*)WSP(unsigned char, WS_H8) : (void*)WSP(bf16, WS_H)), (const char*)WSP(bf16, WS_WGU) + (size_t)l * 32 * 2048 * RBM, WSP(int, WS_LIST), 8, (size_t)2048 * RBM,
                 (LAS const int*)(lds + LX_TSTART), (LAS const int*)(lds + LX_ECNT), (LAS const int*)(lds + LX_TILEE)};
            EpiSwiglu<MOE_FP8 != 0> E{WSP(bf16, WS_ACT), INP(I_BGU) + (size_t)l * 32 * 2048, lds + LX_EPI};
            pg8::gemm_phase<EpiSwiglu<MOE_FP8 != 0>, SG, 8>(lds, S, E, tid, STAG(900));
        }
        SEAM(pb + 4);

        if (PS(9) && IN(pb + 5)) { PHASE_IDS
            if (MK_PER_PHASE || lo == pb + 5) moe_table(lds, gcnt, tid);
            constexpr int RBM = MOE_FP8 ? 1024 : 2048;
            typedef SchedMoe<false, RBM, 0x79797979, 0x79797979> SD;
            SD S{(const char*)WSP(bf16, WS_ACT), (const char*)WSP(bf16, WS_WD) + (size_t)l * 32 * 1024 * RBM, WSP(int, WS_LIST), 4, (size_t)1024 * RBM,
                 (LAS const int*)(lds + LX_TSTART), (LAS const int*)(lds + LX_ECNT), (LAS const int*)(lds + LX_TILEE)};
            EpiDown E{WSP(bf16, WS_Y), INP(I_BD) + (size_t)l * 32 * 1024, lds + LX_EPI};
            pg8::gemm_phase<EpiDown, SD, 9>(lds, S, E, tid, STAG(1100));
            if (PROBE_T && l == DEPTH - 1 && bid == (PROBE_T == 10 ? PROBE_BID : 0) && tid == 0) { unsigned long long acc_ = *(LAS unsigned long long*)(lds + LX_MISC + 64); unsigned long long tot_ = __builtin_amdgcn_s_memtime() - pt_start;
                if (PROBE_T == 9) { acc_ = tot_; tot_ = (__builtin_amdgcn_s_memrealtime() - pt_rstart) * 30ull; }
                WSP(float, WS_MISC)[16] = floorf((float)((double)acc_ / (double)tot_) * PROBE_TQ + 0.5f) / PROBE_TQ; }
        }
        SEAM(pb + 5);

        if (PS(10) && IN(pb + 6)) { PHASE_IDS
            if (MK_PER_PHASE || lo >= pb + 5) moe_table(lds, gcnt, tid);
            LAS const int* tstart = (LAS const int*)(lds + LX_TSTART);
            const int nact = lat_only ? 32768 : M;
            const float* gn = (l + 1 < DEPTH) ? INP(I_NORMG) + (size_t)(l + 1) * 2 * 1024 : INP(I_FINALG);
            const float* mv = MV(); const float* mvn = mv + 17 * 6144; float* X = WSP(float, WS_X); bf16* H = WSP(bf16, WS_H); const bf16* Yb = WSP(bf16, WS_Y);
            const int* topE = WSP(int, WS_TOPE); const float* topG = WSP(float, WS_TOPG); const int* topP = WSP(int, WS_TOPP);
            for (int ai = gw; ai < nact; ai += 2 * NGW) {
                int row[2]; bool ok[2]; int4 ev[2], pv[2]; f32x4 gv[2];
#pragma unroll
                for (int u = 0; u < 2; ++u) { const int a2 = ai + u * NGW; ok[u] = a2 < nact; row[u] = act_row(ok[u] ? a2 : ai, lat_only);
                    ev[u] = *(const int4*)(topE + row[u] * 4); pv[u] = *(const int4*)(topP + row[u] * 4); gv[u] = *(const f32x4*)(topG + row[u] * 4); }
                f32x4 v[2][4]; u32x2 yw[2][4][4];
#pragma unroll
                for (int u = 0; u < 2; ++u) { load_row_x(X, (size_t)row[u], lane, v[u]);
                    const int ee[4] = {ev[u].x, ev[u].y, ev[u].z, ev[u].w}, pp[4] = {pv[u].x, pv[u].y, pv[u].z, pv[u].w};
#pragma unroll
                    for (int k = 0; k < 4; ++k) { const size_t yrow = (size_t)(tstart[ee[k]] * 256 + pp[k]);
#pragma unroll
                        for (int j = 0; j < 4; ++j) { if (Y_FP8) { yw[u][k][j].x = *(const unsigned*)((const unsigned char*)Yb + yrow * 1024 + 256 * j + 4 * lane); yw[u][k][j].y = 0u; }
                            else yw[u][k][j] = *(const u32x2*)(Yb + yrow * 1024 + 256 * j + 4 * lane); } } }
#pragma unroll
                for (int u = 0; u < 2; ++u) { if (!ok[u]) continue;
                    const int rw_ = row[u]; const bool cx = row_is_ctx(rw_); const int rb = cx ? 16 : row_batch(rw_);
                    f32x4 acc4[4];
#pragma unroll
                    for (int j = 0; j < 4; ++j) acc4[j] = (f32x4){0.f, 0.f, 0.f, 0.f};
#pragma unroll
                    for (int k = 0; k < 4; ++k) { const float gk = gv[u][k];
#pragma unroll
                        for (int j = 0; j < 4; ++j) { const u32x2 w = yw[u][k][j];
                            if (Y_FP8) { const f32x2 lo = __builtin_amdgcn_cvt_pk_f32_fp8((int)w.x, false), hi2 = __builtin_amdgcn_cvt_pk_f32_fp8((int)w.x, true); const float g16 = gk * (1.f / 16.f);
                                acc4[j][0] += g16 * lo[0]; acc4[j][1] += g16 * lo[1]; acc4[j][2] += g16 * hi2[0]; acc4[j][3] += g16 * hi2[1]; }
                            else { acc4[j][0] += gk * bf2f((unsigned short)(w.x & 0xffffu)); acc4[j][1] += gk * bf2f((unsigned short)(w.x >> 16)); acc4[j][2] += gk * bf2f((unsigned short)(w.y & 0xffffu)); acc4[j][3] += gk * bf2f((unsigned short)(w.y >> 16)); } } }
                    const float* g2 = mv + rb * 6144 + 5 * 1024;
#pragma unroll
                    for (int j = 0; j < 4; ++j) { const f32x4 gg = *(const f32x4*)(g2 + 256 * j + 4 * lane); v[u][j] = v[u][j] + gg * acc4[j]; }
                    if (l + 1 < DEPTH) {
                        store_row_x(X, (size_t)rw_, lane, v[u]);
                        if (!(l + 1 == DEPTH - 1 && cx))
                            norm_mod_store_mix(((l + 1) & 1) ? (FP8_CONV != 0) : (FP8_ATT != 0), v[u], gn, mvn + rb * 6144 + 1024, mvn + rb * 6144, lane, H + (size_t)rw_ * D, WSP(unsigned char, WS_H8) + (size_t)rw_ * 1024);
                    } else {
                        float rstd = row_rstd(v[u]); if (PROBE_T) rstd *= 1.f + sqrtf(WSP(float, WS_MISC)[16]); float* op = OUTP() + ((size_t)row_batch(rw_) * SEQ + (rw_ % RPB - CTXL)) * D;
#pragma unroll
                        for (int j = 0; j < 4; ++j) { const f32x4 gg = *(const f32x4*)(gn + 256 * j + 4 * lane); *(f32x4*)(op + 256 * j + 4 * lane) = (v[u][j] * rstd) * gg; }
                    }
                }
            }
        }
        if (l + 1 < DEPTH) SEAM(pb + 6);
    }
#undef IN
#undef SEAM
#undef MV
}

extern "C" void kernel_launch(void* const* d_in, const int* in_sizes, int n_in, void* d_out, int out_size, void* d_ws, size_t ws_size, hipStream_t stream) {
    static int grid = 0;
    if (grid == 0) {
        if (n_in != 21 || out_size != NB * SEQ * D || ws_size < WS_END) { fprintf(stderr, "kernel_launch: unexpected shapes (n_in %d, out %d, ws %zu)\n", n_in, out_size, ws_size); grid = -1; return; }
        int dev = 0, cus = 0, per_cu = 0;
        if (hipGetDevice(&dev) != hipSuccess || hipDeviceGetAttribute(&cus, hipDeviceAttributeMultiprocessorCount, dev) != hipSuccess) { grid = -1; return; }
        if (hipFuncSetAttribute((const void*)fwd, hipFuncAttributeMaxDynamicSharedMemorySize, LDS_BYTES) != hipSuccess) { fprintf(stderr, "kernel_launch: hipFuncSetAttribute failed\n"); grid = -1; return; }
        if (hipOccupancyMaxActiveBlocksPerMultiprocessor(&per_cu, (const void*)fwd, NTHREADS, LDS_BYTES) != hipSuccess || per_cu < 1) { fprintf(stderr, "kernel_launch: occupancy query says %d\n", per_cu); }
        (void)hipGetLastError();
        if (cus < 160) { fprintf(stderr, "kernel_launch: needs >= 160 CUs\n"); grid = -1; return; }
        grid = cus;
    }
    if (grid < 0) return;
    if (hipMemsetAsync((char*)d_ws + WS_CTL, 0, CTL_ZERO_BYTES, stream) != hipSuccess) return;
    Args a{};
    for (int i = 0; i < 21; ++i) a.in[i] = (const float*)d_in[i];
    a.out = (float*)d_out; a.ws = (unsigned char*)d_ws;
#if MK_PER_PHASE
    for (int p = 0; p < NPHASE; ++p) { a.ph_lo = p; a.ph_hi = p + 1; hipLaunchKernelGGL(fwd, dim3(grid), dim3(NTHREADS), LDS_BYTES, stream, a); }
#else
    a.ph_lo = 0; a.ph_hi = NPHASE;
    hipLaunchKernelGGL(fwd, dim3(grid), dim3(NTHREADS), LDS_BYTES, stream, a);
#endif
    const hipError_t le = hipPeekAtLastError();
    if (le != hipSuccess) fprintf(stderr, "kernel_launch: launch failed: %s\n", hipGetErrorName(le));
}
```

```cpp
#include <hip/hip_runtime.h>
#include <cstdio>
#include <cstdint>

#ifndef MK_PER_PHASE
#define MK_PER_PHASE 0
#endif

#ifndef MOE_FP8
#define MOE_FP8 1
#endif
#ifndef STAGGER
#define STAGGER 0
#endif
#define STAG(t) (STAGGER ? (t) : 0)
#ifndef PROBE_T
#define PROBE_T 0
#endif
#ifndef PROBE_TQ
#define PROBE_TQ 30.f
#endif
#ifndef ATT_PROBE_TID
#define ATT_PROBE_TID 0
#endif
#ifndef PROBE_BID
#define PROBE_BID 0
#endif
#ifndef PROBE_TPH
#define PROBE_TPH 8
#endif
#ifndef FP8_ATT
#define FP8_ATT 1
#endif
#ifndef FP8_ATT_O
#define FP8_ATT_O 1
#endif
#ifndef FP8_CONV
#define FP8_CONV 0
#endif
#ifndef X_BF16
#define X_BF16 1
#endif
#ifndef Y_FP8
#define Y_FP8 1
#endif
#ifndef CONV_FUSE_U
#define CONV_FUSE_U 1
#endif
#ifndef ATT_FP8
#define ATT_FP8 1
#endif
#ifndef PHSEL
#define PHSEL 0xffff
#endif
#define PS(k) ((PHSEL >> (k)) & 1)
#ifndef PROBE_REP
#define MOE_XCD_RANGE 1
#define PROBE_REP 0
#endif
#define NREP(k) (1 + ((PROBE_REP >> (k)) & 1))
#ifndef PROBE_NOST
#define PROBE_NOST 0
#endif
#define GAS __attribute__((address_space(1)))
#define LAS __attribute__((address_space(3)))
typedef unsigned short bf16;
typedef short bf16x8 __attribute__((ext_vector_type(8)));
typedef float f32x4 __attribute__((ext_vector_type(4)));
typedef float f32x2 __attribute__((ext_vector_type(2)));
typedef float f32x16 __attribute__((ext_vector_type(16)));
typedef unsigned u32x4 __attribute__((ext_vector_type(4)));
typedef unsigned u32x2 __attribute__((ext_vector_type(2)));
typedef GAS unsigned gu32;

constexpr int D = 1024, NB = 16, SEQ = 2048, CTXL = 256, RPB = SEQ + CTXL, M = NB * RPB, DEPTH = 4;
constexpr int NE = 32, TOPK = 4, NMOD = 6;
constexpr int CAP = M;
constexpr int ACT_ROWS = M * TOPK + NE * 256;
constexpr float EPS = 1e-5f;
constexpr float C2 = 0.125f * 1.4426950408889634f;
constexpr int NPHASE = 2 + 7 * DEPTH;
static_assert(!(FP8_CONV && CONV_FUSE_U), "the fused u epilogue needs the (bf16) interleaved copy of conv_w_in");

constexpr size_t MiB = 1u << 20;
constexpr size_t WS_CTL = 0, CTL_ZERO_BYTES = 1 * MiB;
constexpr size_t WS_MODV = 1 * MiB;
constexpr size_t WS_ROPE = 3 * MiB;
constexpr size_t WS_RW = 4 * MiB;
constexpr size_t WS_MISC = 5 * MiB;
constexpr size_t WS_TOPE = 6 * MiB;
constexpr size_t WS_TOPG = 7 * MiB;
constexpr size_t WS_TOPP = 8 * MiB;
constexpr size_t WS_LIST = 9 * MiB;
constexpr size_t WS_WQKV = 16 * MiB;
constexpr size_t WS_WIN = 28 * MiB;
constexpr size_t WS_WO = 40 * MiB;
constexpr size_t WS_WOUT = 44 * MiB;
constexpr size_t WS_WGU = 48 * MiB;
constexpr size_t WS_WD = 560 * MiB;
constexpr size_t WS_X = 816 * MiB;
constexpr size_t WS_H = 960 * MiB;
constexpr size_t WS_Q = 1032 * MiB;
constexpr size_t WS_K = 1104 * MiB;
constexpr size_t WS_VT = 1176 * MiB;
constexpr size_t WS_BCO = WS_Q;
constexpr size_t WS_O = 1248 * MiB;
constexpr size_t WS_ACT = 1320 * MiB;
constexpr size_t WS_Y = 1624 * MiB;
constexpr size_t WS_H8 = 1928 * MiB;
constexpr size_t WS_END = 1964 * MiB;
static_assert((size_t)M * 3072 * 2 == 216 * MiB && (size_t)ACT_ROWS * 2048 == 304 * MiB && (size_t)M * 4096 == 144 * MiB, "ws map");

constexpr int CW_TMO = 0;
constexpr int CW_BAR = 4096;
constexpr int CW_CNT = 16384;

constexpr int RING_BYTES = 131072;
constexpr int LX = RING_BYTES;
constexpr int LX_MISC = LX + 0;
constexpr int LX_TSTART = LX + 256;
constexpr int LX_ECNT = LX + 512;
constexpr int LX_LCNT = LX + 640;
constexpr int LX_LBASE = LX + 768;
constexpr int LX_TILEE = LX + 1024;
constexpr int LX_WSC = LX + 4096;
constexpr int LX_ASG = LX + 12288;
constexpr int LX_EPI = LX + 16384;
constexpr int LDS_BYTES = LX + 32768;
constexpr int NWAVES = 8, NTHREADS = 512;

#define RLX_AGENT __ATOMIC_RELAXED, __HIP_MEMORY_SCOPE_AGENT
__device__ __forceinline__ unsigned f2bf(float f) { unsigned u = __builtin_bit_cast(unsigned, f); return (u + 0x7fffu + ((u >> 16) & 1u)) >> 16; }
typedef __bf16 bf16x2_t __attribute__((ext_vector_type(2)));
__device__ __forceinline__ unsigned cvt_pk_bf16(float lo, float hi) { const f32x2 v = {lo, hi}; const bf16x2_t b = __builtin_convertvector(v, bf16x2_t); return __builtin_bit_cast(unsigned, b); }
__device__ __forceinline__ float bf2f(unsigned short b) { return __builtin_bit_cast(float, (unsigned)b << 16); }
__device__ __forceinline__ float wave_sum(float v) {
    v += __builtin_bit_cast(float, __builtin_amdgcn_update_dpp(0, __builtin_bit_cast(int, v), 0xB1, 0xF, 0xF, true));
    v += __builtin_bit_cast(float, __builtin_amdgcn_update_dpp(0, __builtin_bit_cast(int, v), 0x4E, 0xF, 0xF, true));
    v += __builtin_bit_cast(float, __builtin_amdgcn_update_dpp(0, __builtin_bit_cast(int, v), 0x124, 0xF, 0xF, true));
    v += __builtin_bit_cast(float, __builtin_amdgcn_update_dpp(0, __builtin_bit_cast(int, v), 0x128, 0xF, 0xF, true));
    v += __shfl_xor(v, 16);
    auto rr = __builtin_amdgcn_permlane32_swap(__float_as_uint(v), __float_as_uint(v), false, false);
    return __uint_as_float(rr[0]) + __uint_as_float(rr[1]);
}

#define XB_TMO      128
#define XB_XCNT(j)  (256  + 64 * (j))
#define XB_XSUB(j)  (1280 + 64 * (j))
#define XB_XGEN(j)  (2304 + 64 * (j))
#define XB_TOP      3328
#define XB_TOPGEN   3392
#define XCD_BAR_WORDS 3456
#define XB_SPIN_CAP (1u << 18)
__device__ __forceinline__ unsigned xb_ld(unsigned* p)              { return __hip_atomic_load(p, __ATOMIC_RELAXED, __HIP_MEMORY_SCOPE_AGENT); }
__device__ __forceinline__ unsigned xb_add(unsigned* p, unsigned v) { return __hip_atomic_fetch_add(p, v, __ATOMIC_RELAXED, __HIP_MEMORY_SCOPE_AGENT); }
__device__ __forceinline__ unsigned xb_xcc_id() { return (unsigned)__builtin_amdgcn_s_getreg((3 << 11) | 20) & 0xFu; }
#define XB_SPIN(cond, bar) do { unsigned _sp = 0; while (cond) { __builtin_amdgcn_s_sleep(1); \
    if ((++_sp & 255u) == 0u) { if (xb_ld(&(bar)[XB_TMO])) break; if (_sp > XB_SPIN_CAP) { atomicAdd(&(bar)[XB_TMO], 1u); break; } } } } while (0)
struct XcdBarrier { unsigned* bar; unsigned x; volatile LAS unsigned* st; };
__device__ __forceinline__ XcdBarrier xcd_barrier_post(unsigned* bar, volatile LAS unsigned* st) {
    XcdBarrier b; b.bar = bar; b.x = xb_xcc_id(); b.st = st;
    if (threadIdx.x == 0) (void)xb_add(&bar[XB_XCNT(b.x)], 1u);
    return b;
}
__device__ __forceinline__ void xcd_barrier_complete(unsigned* bar, unsigned x, unsigned& nloc, unsigned& nx) {
    const unsigned G = gridDim.x * gridDim.y * gridDim.z;
    unsigned sum, cnt, mine, sp = 0u;
    for (;;) {
        sum = 0u; cnt = 0u; mine = 0u;
#pragma unroll
        for (unsigned j = 0; j < 16; ++j) { const unsigned c = xb_ld(&bar[XB_XCNT(j)]); sum += c; cnt += (c > 0u) ? 1u : 0u; mine = (j == x) ? c : mine; }
        if (sum == G) break;
        __builtin_amdgcn_s_sleep(1);
        if ((++sp & 255u) == 0u) { if (xb_ld(&bar[XB_TMO])) break; if (sp > XB_SPIN_CAP) { atomicAdd(&bar[XB_TMO], 1u); break; } }
    }
    nloc = mine > 0u ? mine : 1u; nx = cnt > 0u ? cnt : 1u;
}
__device__ __forceinline__ void xcd_barrier(const XcdBarrier& b) {
    asm volatile("s_waitcnt vmcnt(0)" ::: "memory");
    __syncthreads();
    if (threadIdx.x == 0) {
        unsigned* bar = b.bar; unsigned bx = b.x;
        asm volatile("" : "+s"(bar), "+s"(bx));
        __builtin_amdgcn_s_waitcnt(0);
        unsigned nloc = b.st[0], nx = b.st[1];
        if (nloc == 0u) { xcd_barrier_complete(bar, bx, nloc, nx); b.st[0] = nloc; b.st[1] = nx; }
        const unsigned old = xb_add(&bar[XB_XSUB(bx)], 1u);
        const unsigned gen = old / nloc;
        if (old + 1u == (gen + 1u) * nloc) {
            __builtin_amdgcn_fence(__ATOMIC_RELEASE, "agent");
            asm volatile("s_waitcnt vmcnt(0)" ::: "memory");
            const unsigned og = xb_add(&bar[XB_TOP], 1u);
            const unsigned tg = og / nx;
            if (og + 1u == (tg + 1u) * nx) xb_add(&bar[XB_TOPGEN], 1u);
            else XB_SPIN(xb_ld(&bar[XB_TOPGEN]) == tg, bar);
            __builtin_amdgcn_fence(__ATOMIC_ACQUIRE, "agent");
            xb_add(&bar[XB_XGEN(bx)], 1u);
            asm volatile("s_waitcnt vmcnt(0)" ::: "memory");
        } else {
            XB_SPIN(xb_ld(&bar[XB_XGEN(bx)]) == gen, bar);
            __builtin_amdgcn_fence(__ATOMIC_ACQUIRE, "agent");
            asm volatile("s_waitcnt vmcnt(0)" ::: "memory");
        }
    }
    __syncthreads();
}

namespace pg8 {
constexpr int BM = 256, BK = 64, HALF = 128, HTB = HALF * BK * 2, STAGE_BYTES = 8 * HTB, KD = 1024;
__host__ __device__ __forceinline__ int lds_byte(int r, int c) { const int st = (r >> 4) * 2 + (c >> 5), rr = r & 15, cc = c & 31, ob = rr * 64 + cc * 2; return st * 1024 + (ob ^ (((ob >> 9) & 1) << 5)); }
__host__ __device__ __forceinline__ void stage_rc(int b, int& R, int& C) { const int st = b / 1024, sb = b % 1024, swz = sb ^ (((sb >> 9) & 1) << 5); R = (st >> 1) * 16 + swz / 64; C = (st & 1) * 32 + (swz % 64) / 2; }
__host__ __device__ __forceinline__ int perm32(int rho) { const int n = rho >> 4, i = rho & 15; return 8 * (i >> 2) + 4 * n + (i & 3); }

struct Unit { int pm, pn, e, kind; };
typedef int v8i __attribute__((ext_vector_type(8)));
typedef int v4i __attribute__((ext_vector_type(4)));
__device__ __forceinline__ v8i cat8(bf16x8 lo, bf16x8 hi) { const v4i a = __builtin_bit_cast(v4i, lo), b = __builtin_bit_cast(v4i, hi); return __builtin_shufflevector(a, b, 0, 1, 2, 3, 4, 5, 6, 7); }

__device__ __forceinline__ bool deal(int i, int npu, int ntiles, int& mt, int& r) {
    const int G = gridDim.x, c = blockIdx.x;
    if ((G & 7) == 0) { const int x = c & 7, q = i * (G >> 3) + (c >> 3); mt = (q / npu) * 8 + x; r = q % npu; }
    else { const int L = i * G + c; mt = L / npu; r = L % npu; }
    return mt < ntiles;
}

__device__ __forceinline__ void mfma8(f32x4& acc, const v8i a, const v8i b, int sc) {
    asm volatile("v_mfma_scale_f32_16x16x128_f8f6f4 %0, %1, %2, %0, %3, %3 op_sel_hi:[0,0,0]" : "+v"(acc) : "v"(a), "v"(b), "v"(sc)); }
__device__ __forceinline__ void glds16s(const char* sbase, unsigned voff, unsigned lds_dst) { unsigned keep;
    asm volatile("s_mov_b32 %0, m0\n\ts_mov_b32 m0, %3\n\ts_nop 0\n\tglobal_load_lds_dwordx4 %1, %2\n\ts_mov_b32 m0, %0" : "=&s"(keep) : "v"(voff), "s"(sbase), "s"(lds_dst) : "memory"); }
template <class Epi, class Sched, int PH = 0>
__device__ __forceinline__ void gemm_phase(LAS unsigned char* lds, const Sched& S, const Epi& E, const int tid, const int stagger_ticks = 0) {
    const int wid = __builtin_amdgcn_readfirstlane(tid >> 6), lane = tid & 63, wr = wid >> 2, wc = wid & 3, fr = lane & 15, fq = lane >> 4;
    constexpr int RB = Sched::RB, nt = RB / 128;
    constexpr bool F8 = (RB == 1024);
    unsigned voffB[2];
#pragma unroll
    for (int i = 0; i < 2; ++i) { int R_, C_; stage_rc(tid * 16 + i * 8192, R_, C_); const int Rb = (R_ & ~31) + perm32(R_ & 31); voffB[i] = (unsigned)(Rb * RB + C_ * 2); }
    constexpr bool GA = Sched::GATHER;
    constexpr int NH = GA ? 2 : 1;
    constexpr size_t kstep = (size_t)(BK * 2);
    constexpr size_t hstep = (size_t)HALF * RB, bstep = hstep;
    const unsigned ldsw = (unsigned)wid * 1024u, lds0 = (unsigned)(uintptr_t)lds;
    const int aoff = lds_byte(wr * 64 + fr, fq * 8), boff = lds_byte(wc * 32 + fr, fq * 8);
#define PG8_SA(b, h) (((b) * 2 + (h)) * HTB)
#define PG8_SB(b, h) ((4 + (b) * 2 + (h)) * HTB)
#define PG8_STAGE(bufoff, gbase, voff) do { _Pragma("unroll") for (int _i = 0; _i < 2; ++_i) \
        glds16s((const char*)(gbase), (voff)[_i], (unsigned)__builtin_amdgcn_readfirstlane(lds0 + (unsigned)(bufoff) + ldsw + _i * 8192u)); } while (0)
#define PG8_LDA(dst, b, h) do { _Pragma("unroll") for (int m = 0; m < 4; ++m) _Pragma("unroll") for (int k = 0; k < 2; ++k) dst[m][k] = *(const LAS bf16x8*)(lds + PG8_SA(b, h) + aoff + m * 2048 + k * 1024); } while (0)
#define PG8_LDB(dst, b, h) do { _Pragma("unroll") for (int n = 0; n < 2; ++n) _Pragma("unroll") for (int k = 0; k < 2; ++k) dst[n][k] = *(const LAS bf16x8*)(lds + PG8_SB(b, h) + boff + n * 2048 + k * 1024); } while (0)
#define PG8_MMA(ai, bj, At, Bt) do { __builtin_amdgcn_s_setprio(1); _Pragma("unroll") for (int m = 0; m < 4; ++m) _Pragma("unroll") for (int n = 0; n < 2; ++n) { \
        if constexpr (F8) mfma8(acc[ai][bj][m][n], cat8(Bt[n][0], Bt[n][1]), cat8(At[m][0], At[m][1]), sc8); \
        else { _Pragma("unroll") for (int k = 0; k < 2; ++k) acc[ai][bj][m][n] = __builtin_amdgcn_mfma_f32_16x16x32_bf16(Bt[n][k], At[m][k], acc[ai][bj][m][n], 0, 0, 0); } } __builtin_amdgcn_s_setprio(0); } while (0)
#define PG8_WAIT_V(n) asm volatile("s_waitcnt vmcnt(" #n ")" ::: "memory")
#define PG8_WAIT_VF do { if (fe) { if constexpr (Epi::NST == 16 && !PROBE_NOST) PG8_WAIT_V(24); else if constexpr (Epi::NST == 4 && !PROBE_NOST) PG8_WAIT_V(12); else if constexpr (Epi::NST == 8 && !PROBE_NOST) PG8_WAIT_V(16); else PG8_WAIT_V(8); } else PG8_WAIT_V(8); } while (0)
#define PG8_WAIT_L(n) asm volatile("s_waitcnt lgkmcnt(" #n ")" ::: "memory")
#define PG8_BAR __builtin_amdgcn_s_barrier()
#define PG8_SCHED __builtin_amdgcn_sched_barrier(0)
    Unit cur, nxt; int ui = 0;
    if (!S.next(0, cur)) return;
#define PT_ON(r) (PROBE_T == (r) && PH == PROBE_TPH)
#define PT_BEG(r) do { if (PT_ON(r)) pt0_ = __builtin_amdgcn_s_memtime(); } while (0)
#define PT_END(r) do { if (PT_ON(r)) { const unsigned long long d_ = __builtin_amdgcn_s_memtime() - pt0_; if (blockIdx.x == 0 && tid == 0) *(LAS unsigned long long*)(lds + LX_MISC + 64) += d_; } } while (0)
    unsigned long long pt0_ = 0; (void)pt0_;
    PT_BEG(3);
    if (stagger_ticks > 0 && (int)(blockIdx.x >> 3) >= (int)(gridDim.x >> 4)) { const unsigned long long t0_ = __builtin_amdgcn_s_memrealtime(); while ((long long)(__builtin_amdgcn_s_memrealtime() - t0_) < (long long)stagger_ticks) __builtin_amdgcn_s_sleep(16); }
    static_assert(Sched::SCALE_A == Sched::SCALE_B, "one scale register");
    int sc8 = Sched::SCALE_A; asm volatile("" : "+v"(sc8));
    f32x4 acc[2][2][4][2];
#pragma unroll
    for (int a = 0; a < 2; ++a)
#pragma unroll
        for (int b = 0; b < 2; ++b)
#pragma unroll
            for (int m = 0; m < 4; ++m)
#pragma unroll
                for (int n = 0; n < 2; ++n) acc[a][b][m][n] = (f32x4){0.f, 0.f, 0.f, 0.f};
    bf16x8 At[4][2], B0[2][2], B1[2][2];
    constexpr int NI = GA ? 1 : 2;
    unsigned vC[NH][NI], vN[NH][NI];
    unsigned cb2[2];
#pragma unroll
    for (int i = 0; i < 2; ++i) { int R_, C_; stage_rc(tid * 16 + i * 8192, R_, C_); cb2[i] = (unsigned)(C_ * 2); }
    const unsigned idx_slot = (unsigned)__builtin_amdgcn_readfirstlane((unsigned)(uintptr_t)(lds + LX_WSC) + (unsigned)wid * 1024u);
    if constexpr (GA) { S.idx_dma(cur, lane, idx_slot); asm volatile("s_waitcnt vmcnt(0)" ::: "memory"); S.a_offs_lds(cur, tid, vC, (LAS const int*)(lds + LX_WSC + wid * 1024)); }
    else S.a_offs(cur, tid, vC);
    const unsigned bias_slot0 = (unsigned)(uintptr_t)(lds + LX_ASG);
    if constexpr (Epi::BIAS_DMA) { Unit n1_; const bool h1_ = S.next(1, n1_);
        if (wid == 0) { glds16s((const char*)E.bias_src(cur), (unsigned)lane * 16u, (unsigned)__builtin_amdgcn_readfirstlane(bias_slot0));
            if (h1_) glds16s((const char*)E.bias_src(n1_), (unsigned)lane * 16u, (unsigned)__builtin_amdgcn_readfirstlane(bias_slot0 + 1024u)); } }
    auto acc_init = [&](int slot) {
        if constexpr (Epi::BIAS_DMA) { int fq2 = fq; asm volatile("" : "+v"(fq2)); LAS const float* bl_ = (LAS const float*)(lds + LX_ASG + slot * 1024); f32x4 bv_[2][2];
            _Pragma("unroll") for (int bj = 0; bj < 2; ++bj) { const int col = bj * 128 + wc * 32 + fq2 * 8; bv_[bj][0] = *(const LAS f32x4*)(bl_ + col); bv_[bj][1] = *(const LAS f32x4*)(bl_ + col + 4);
                if constexpr (Epi::GATE_COLS) { bv_[bj][0][0] *= Epi::GATE_MUL; bv_[bj][0][2] *= Epi::GATE_MUL; bv_[bj][1][0] *= Epi::GATE_MUL; bv_[bj][1][2] *= Epi::GATE_MUL; } }
            _Pragma("unroll") for (int a = 0; a < 2; ++a) _Pragma("unroll") for (int b = 0; b < 2; ++b) _Pragma("unroll") for (int m = 0; m < 4; ++m) _Pragma("unroll") for (int n = 0; n < 2; ++n) acc[a][b][m][n] = bv_[b][n]; }
        else { _Pragma("unroll") for (int a = 0; a < 2; ++a) _Pragma("unroll") for (int b = 0; b < 2; ++b) _Pragma("unroll") for (int m = 0; m < 4; ++m) _Pragma("unroll") for (int n = 0; n < 2; ++n) acc[a][b][m][n] = (f32x4){0.f, 0.f, 0.f, 0.f}; } };
#define PG8_HA(h) (GA ? 0 : (h) * hstep)
#define PG8_VH(v, h) (v)[GA ? (h) : 0]
#define PG8_STAGE_A(bufoff, gbase, vv) do { _Pragma("unroll") for (int _i = 0; _i < 2; ++_i) { unsigned o_; if constexpr (GA) o_ = (((vv)[0] >> (16 * _i)) & 0xffffu) * (unsigned)RB + cb2[_i]; else o_ = (vv)[NI - 2 + _i]; \
        glds16s((const char*)(gbase), o_, (unsigned)__builtin_amdgcn_readfirstlane(lds0 + (unsigned)(bufoff) + ldsw + _i * 8192u)); } } while (0)
    const char* cA = S.a_base(cur); const char* cB = S.b_base(cur);
    PG8_STAGE(PG8_SB(0, 0), cB, voffB); PG8_STAGE(PG8_SB(0, 1), cB + bstep, voffB); PG8_STAGE_A(PG8_SA(0, 0), cA, vC[0]); PG8_STAGE_A(PG8_SA(0, 1), cA + PG8_HA(1), PG8_VH(vC, 1));
    if (wr == 1) PG8_BAR;
    PG8_WAIT_V(2); PG8_BAR;
    PG8_STAGE(PG8_SB(1, 0), cB + kstep, voffB); PG8_STAGE_A(PG8_SA(1, 0), cA + kstep, vC[0]); PG8_STAGE(PG8_SB(1, 1), cB + bstep + kstep, voffB);
    PG8_WAIT_V(6); PG8_BAR;
    if constexpr (Epi::BIAS_DMA) acc_init(0);
    for (;;) {
        const bool has_next = S.next(ui + 1, nxt);
        const char* nA = cA; const char* nB = cB;
#pragma unroll
        for (int h = 0; h < NH; ++h)
#pragma unroll
            for (int i = 0; i < NI; ++i) vN[h][i] = vC[h][i];
        if (has_next) { if constexpr (GA) S.idx_dma(nxt, lane, idx_slot); else S.a_offs(nxt, tid, vN); nA = S.a_base(nxt); nB = S.b_base(nxt); }
        if constexpr (Epi::BIAS_DMA) { if (ui > 0 && has_next && wid == 0) glds16s((const char*)E.bias_src(nxt), (unsigned)lane * 16u, (unsigned)__builtin_amdgcn_readfirstlane(bias_slot0 + (unsigned)((ui + 1) & 1) * 1024u)); }
        PT_BEG(2);
#pragma unroll 1
        for (int t = 0; t < nt; t += 2) {
            const bool last = (t == nt - 2);
            const char* a1 = cA + (size_t)(t + 1) * kstep;
            const char* a2 = last ? nA : cA + (size_t)(t + 2) * kstep; const char* b2 = last ? nB : cB + (size_t)(t + 2) * kstep;
            const char* a3 = a2 + kstep; const char* b3 = b2 + kstep;
            if constexpr (GA) { if (last && has_next) S.a_offs_lds(nxt, tid, vN, (LAS const int*)(lds + LX_WSC + wid * 1024)); }
            unsigned w0[NI], w1[NI];
#pragma unroll
            for (int i = 0; i < NI; ++i) { w0[i] = last ? vN[0][i] : vC[0][i]; w1[i] = last ? PG8_VH(vN, 1)[i] : PG8_VH(vC, 1)[i]; }
            const bool fe = (t == 0) && (ui > 0);
            PG8_LDB(B0, 0, 0); PG8_LDB(B1, 0, 1); PG8_SCHED; PG8_LDA(At, 0, 0); if (!fe) PG8_STAGE_A(PG8_SA(1, 1), a1 + PG8_HA(1), PG8_VH(vC, 1));
            PG8_WAIT_VF; PG8_WAIT_L(0); PG8_BAR; PG8_MMA(0, 0, At, B0); PG8_MMA(0, 1, At, B1); PG8_BAR; PG8_SCHED;
            PG8_LDA(At, 0, 1); PG8_STAGE(PG8_SB(0, 0), b2, voffB); PG8_STAGE(PG8_SB(0, 1), b2 + bstep, voffB); PG8_STAGE_A(PG8_SA(0, 0), a2, w0);
            PG8_WAIT_VF; PG8_WAIT_L(0); PG8_BAR; PG8_MMA(1, 0, At, B0); PG8_MMA(1, 1, At, B1); PG8_BAR; PG8_SCHED;
            PG8_LDB(B0, 1, 0); PG8_LDB(B1, 1, 1); PG8_SCHED; PG8_LDA(At, 1, 0); PG8_STAGE_A(PG8_SA(0, 1), a2 + PG8_HA(1), w1);
            PG8_WAIT_VF; PG8_WAIT_L(0); PG8_BAR; PG8_MMA(0, 0, At, B0); PG8_MMA(0, 1, At, B1); PG8_BAR; PG8_SCHED;
            PG8_LDA(At, 1, 1); PG8_STAGE(PG8_SB(1, 0), b3, voffB); PG8_STAGE(PG8_SB(1, 1), b3 + bstep, voffB); PG8_STAGE_A(PG8_SA(1, 0), a3, w0);
            PG8_WAIT_V(8); PG8_WAIT_L(0); PG8_BAR; PG8_MMA(1, 0, At, B0); PG8_MMA(1, 1, At, B1); PG8_BAR; PG8_SCHED;
        }
        PT_END(2);
        if (has_next) PG8_STAGE_A(PG8_SA(1, 1), nA + kstep + PG8_HA(1), PG8_VH(vN, 1));
        if (wr == 0) PG8_BAR;
        PT_BEG(1);
        if constexpr (Epi::BIAS_DMA) E(acc, cur, wr, wc, fr, fq, (LAS const float*)(lds + LX_ASG + (ui & 1) * 1024)); else E(acc, cur, wr, wc, fr, fq);
        PT_END(1);
        if (!has_next) break;
        acc_init((ui + 1) & 1);
        cur = nxt; cA = nA; cB = nB; ++ui;
#pragma unroll
        for (int h = 0; h < NH; ++h)
#pragma unroll
            for (int i = 0; i < NI; ++i) vC[h][i] = vN[h][i];
        if (wr == 1) PG8_BAR;
    }
    PG8_WAIT_V(0);
    PG8_BAR;
    PT_END(3);
#undef PT_ON
#undef PT_BEG
#undef PT_END
#undef PG8_SA
#undef PG8_HA
#undef PG8_VH
#undef PG8_SB
#undef PG8_STAGE
#undef PG8_STAGE_A
#undef PG8_LDA
#undef PG8_LDB
#undef PG8_MMA
#undef PG8_WAIT_V
#undef PG8_WAIT_VF
#undef PG8_WAIT_L
#undef PG8_BAR
#undef PG8_SCHED
}
}
using pg8::Unit;

__device__ __forceinline__ int tile_row0(int mt, bool lat_only) { return lat_only ? ((mt >> 3) * 9 + 1 + (mt & 7)) * 256 : mt * 256; }

template <int RB_, int SC_> struct SchedQKV {
    static constexpr int RB = RB_, SCALE_A = SC_, SCALE_B = SC_;
    const char* H; const char* Wt;
    __device__ __forceinline__ bool next(int i, Unit& u) const { int mt, r; if (!pg8::deal(i, 12, M / 256, mt, r)) return false;
        if (r < 8) { u.kind = 0; u.pm = mt; u.pn = r; } else { u.kind = 1; u.pm = r - 8; u.pn = mt; } u.e = 0; return true; }
    static constexpr bool GATHER = false;
    __device__ __forceinline__ void a_offs(const Unit& u, int tid, unsigned (&v)[1][2]) const {
#pragma unroll
        for (int i = 0; i < 2; ++i) { int R, C; pg8::stage_rc(tid * 16 + i * 8192, R, C); v[0][i] = (unsigned)((u.pm * 256 + R) * RB + C * 2); } }
    __device__ __forceinline__ const char* a_base(const Unit& u) const { return u.kind == 0 ? H : Wt + (size_t)2048 * RB; }
    __device__ __forceinline__ const char* b_base(const Unit& u) const { return (u.kind == 0 ? Wt : H) + (size_t)u.pn * 256 * RB; }
};
template <int RB_, int SC_> struct SchedPlain {
    static constexpr int RB = RB_, SCALE_A = SC_, SCALE_B = SC_;
    const char* A; const char* Bt; int npu; bool lat_only;
    __device__ __forceinline__ bool next(int i, Unit& u) const { int mt, r; if (!pg8::deal(i, npu, lat_only ? 128 : 144, mt, r)) return false;
        u.pm = tile_row0(mt, lat_only) >> 8; u.pn = r; u.e = 0; u.kind = 0; return true; }
    static constexpr bool GATHER = false;
    __device__ __forceinline__ void a_offs(const Unit& u, int tid, unsigned (&v)[1][2]) const {
#pragma unroll
        for (int i = 0; i < 2; ++i) { int R, C; pg8::stage_rc(tid * 16 + i * 8192, R, C); v[0][i] = (unsigned)((u.pm * 256 + R) * RB + C * 2); } }
    __device__ __forceinline__ const char* a_base(const Unit&) const { return A; }
    __device__ __forceinline__ const char* b_base(const Unit& u) const { return Bt + (size_t)u.pn * 256 * RB; }
};
template <bool GATHER_, int RB_, int SA_, int SB_> struct SchedMoe {
    static constexpr bool GATHER = GATHER_;
    static constexpr int RB = RB_, SCALE_A = SA_, SCALE_B = SB_;
    const char* A; const char* Wt; const int* list; int npu; size_t estride;
    LAS const int* tstart; LAS const int* ecnt; LAS const int* tile_e;
    __device__ __forceinline__ bool mdeal(int i, int ntl, int& mt, int& r) const {
        const int G = gridDim.x, c = blockIdx.x;
        if (MOE_XCD_RANGE && (G & 7) == 0) { const int x = c & 7, q = i * (G >> 3) + (c >> 3); const int lo = (x * ntl) >> 3, hi = ((x + 1) * ntl) >> 3; mt = lo + q / npu; r = q % npu; return mt < hi; }
        return pg8::deal(i, npu, ntl, mt, r); }
    __device__ __forceinline__ bool next(int i, Unit& u) const { int mt, r; const int ntl = __builtin_amdgcn_readfirstlane(tstart[32]);
        int xp = 0;
        if (!mdeal(i, ntl, mt, r)) { if (!(PROBE_REP & (GATHER_ ? 0x100 : 0x200))) return false; int n_i = 0; while (mdeal(n_i, ntl, mt, r)) ++n_i; if (i >= 2 * n_i || !mdeal(i - n_i, ntl, mt, r)) return false; xp = 1; }
        u.pm = mt; u.pn = r; u.e = __builtin_amdgcn_readfirstlane(tile_e[mt]); u.kind = xp; return true; }
    __device__ __forceinline__ void idx_dma(const Unit& u, int lane, unsigned slot) const {
        const int j0 = (u.pm - __builtin_amdgcn_readfirstlane(tstart[u.e])) * 256;
        pg8::glds16s((const char*)(list + (size_t)u.e * CAP + j0), (unsigned)lane * 16u, slot); }
    __device__ __forceinline__ void a_offs_lds(const Unit& u, int tid, unsigned (&v)[2][1], LAS const int* slot) const {
        const int j0 = (u.pm - __builtin_amdgcn_readfirstlane(tstart[u.e])) * 256, cnt = __builtin_amdgcn_readfirstlane(ecnt[u.e]);
#pragma unroll
        for (int h = 0; h < 2; ++h) { unsigned pk = 0;
#pragma unroll
            for (int i = 0; i < 2; ++i) { int R, C; pg8::stage_rc(tid * 16 + i * 8192, R, C); const int r = h * 128 + R; const unsigned tok = (j0 + r) < cnt ? (unsigned)slot[r] : 0u; pk |= tok << (16 * i); }
            v[h][0] = pk; }
    }
    __device__ __forceinline__ void a_offs(const Unit& u, int tid, unsigned (&v)[GATHER_ ? 2 : 1][GATHER_ ? 1 : 2]) const {
        if constexpr (GATHER_) { const int j0 = (u.pm - __builtin_amdgcn_readfirstlane(tstart[u.e])) * 256, cnt = __builtin_amdgcn_readfirstlane(ecnt[u.e]); const int* lp = list + (size_t)u.e * CAP;
#pragma unroll
            for (int h = 0; h < 2; ++h) { unsigned pk = 0;
#pragma unroll
                for (int i = 0; i < 2; ++i) { int R, C; pg8::stage_rc(tid * 16 + i * 8192, R, C); const int idx = j0 + h * 128 + R; const unsigned tok = idx < cnt ? (unsigned)lp[idx] : 0u; pk |= tok << (16 * i); }
                v[h][0] = pk; }
        } else {
#pragma unroll
            for (int i = 0; i < 2; ++i) { int R, C; pg8::stage_rc(tid * 16 + i * 8192, R, C); v[0][i] = (unsigned)((u.pm * 256 + R) * RB + C * 2); } }
    }
    __device__ __forceinline__ const char* a_base(const Unit&) const { return A; }
    __device__ __forceinline__ const char* b_base(const Unit& u) const { return Wt + (size_t)u.e * estride + (size_t)u.pn * 256 * RB; }
};

#define EPI_LOOP_ROWS for (int ai = 0; ai < 2; ++ai) _Pragma("unroll") for (int m = 0; m < 4; ++m)
__device__ __forceinline__ u32x4 pack8(const f32x4& v0, const f32x4& v1) { u32x4 w; w.x = cvt_pk_bf16(v0[0], v0[1]); w.y = cvt_pk_bf16(v0[2], v0[3]); w.z = cvt_pk_bf16(v1[0], v1[1]); w.w = cvt_pk_bf16(v1[2], v1[3]); return w; }

__device__ __forceinline__ float clamp8(float v) { return __builtin_amdgcn_fmed3f(v, -448.f, 448.f); }
__device__ __forceinline__ unsigned pack_fp8x4(float a, float b, float c, float d) {
    const float ca = clamp8(a); int w = __builtin_bit_cast(int, ca);
    w = __builtin_amdgcn_cvt_pk_fp8_f32(ca, clamp8(b), w, false); w = __builtin_amdgcn_cvt_pk_fp8_f32(clamp8(c), clamp8(d), w, true); return (unsigned)w; }
struct EpiQKV {
    static constexpr bool BIAS_DMA = false;
    static constexpr int NST = ATT_FP8 ? 8 : 16;
    bf16* Q; bf16* Kb; bf16* Vt; const float* cosT; const float* sinT; bool dost; LAS unsigned char* stg;
    __device__ __forceinline__ void operator()(const f32x4 (&acc)[2][2][4][2], const Unit& u, int wr, int wc, int fr, int fq) const {
        asm volatile("" : "+v"(fr), "+v"(fq));
        if constexpr (ATT_FP8 != 0) {
            const bool isq = u.pn < 4, k0 = (u.kind == 0); const bool lat = k0 && (u.pm % 9) != 0;
            unsigned char* base8 = (unsigned char*)Q + (k0 ? (isq ? (size_t)0 : WS_K - WS_Q) : WS_VT - WS_Q); const size_t ld = k0 ? 1024 : (size_t)M; const int colbase = k0 ? (u.pn & 3) * 256 : u.pn * 256;
            const float sc = k0 ? (isq ? C2 * 64.f : 16.f) : 16.f;
            LAS unsigned char* sw = stg + (wr * 4 + wc) * 2048; const int lane = fq * 16 + fr; const int jp0 = 16 * (wc & 1) + 4 * fq;
#pragma unroll
            for (int ai = 0; ai < 2; ++ai) {
                f32x4 cs[4], sn[4];
#pragma unroll
                for (int m = 0; m < 4; ++m) { const int row = u.pm * 256 + ai * 128 + wr * 64 + m * 16 + fr; const int t = lat ? (row % RPB) - CTXL : 0;
                    const f32x4 cv = *(const f32x4*)(cosT + t * 32 + jp0), sv = *(const f32x4*)(cosT + 2048 * 32 + t * 32 + jp0);
#pragma unroll
                    for (int j = 0; j < 4; ++j) { cs[m][j] = lat ? cv[j] : 1.f; sn[m][j] = lat ? sv[j] : 0.f; } }
#pragma unroll
                for (int bj = 0; bj < 2; ++bj) {
#pragma unroll
                    for (int m = 0; m < 4; ++m) { const f32x4 a = acc[ai][bj][m][0], b = acc[ai][bj][m][1]; const f32x4 c_ = cs[m], s_ = sn[m];
                        u32x2 w8;
                        w8.x = pack_fp8x4((a[0] * c_[0] - a[1] * s_[0]) * sc, (a[1] * c_[0] + a[0] * s_[0]) * sc, (a[2] * c_[1] - a[3] * s_[1]) * sc, (a[3] * c_[1] + a[2] * s_[1]) * sc);
                        w8.y = pack_fp8x4((b[0] * c_[2] - b[1] * s_[2]) * sc, (b[1] * c_[2] + b[0] * s_[2]) * sc, (b[2] * c_[3] - b[3] * s_[3]) * sc, (b[3] * c_[3] + b[2] * s_[3]) * sc);
                        *(LAS u32x2*)(sw + (16 * m + fr) * 32 + fq * 8) = w8; }
                    asm volatile("s_waitcnt lgkmcnt(0)" ::: "memory");
#pragma unroll
                    for (int k = 0; k < 2; ++k) { const int p = lane + 64 * k, rr = p >> 1, hf = p & 1; const u32x4 v = *(const LAS u32x4*)(sw + p * 16);
                        const int row = u.pm * 256 + ai * 128 + wr * 64 + rr; const int col = colbase + bj * 128 + wc * 32 + hf * 16;
                        if (dost) *(u32x4*)(base8 + (size_t)row * ld + col) = v; }
                    asm volatile("s_waitcnt lgkmcnt(0)" ::: "memory");
                }
            }
        } else if (u.kind == 0) {
            const bool isq = u.pn < 4; bf16* base = isq ? Q : Kb; const float sc = isq ? C2 : 1.f;
            const bool lat = (u.pm % 9) != 0;
#pragma unroll
            EPI_LOOP_ROWS { const int row = u.pm * 256 + ai * 128 + wr * 64 + m * 16 + fr; const int t = (row % RPB) - CTXL;
#pragma unroll
                for (int bj = 0; bj < 2; ++bj) { const f32x4 a = acc[ai][bj][m][0], b = acc[ai][bj][m][1]; f32x4 o0, o1;
                    f32x4 cs = {1.f, 1.f, 1.f, 1.f}, sn = {0.f, 0.f, 0.f, 0.f}; const int jp0 = 16 * (wc & 1) + 4 * fq;
                    if (lat) { cs = *(const f32x4*)(cosT + t * 32 + jp0); sn = *(const f32x4*)(sinT + t * 32 + jp0); }
                    o0[0] = (a[0] * cs[0] - a[1] * sn[0]) * sc; o0[1] = (a[1] * cs[0] + a[0] * sn[0]) * sc; o0[2] = (a[2] * cs[1] - a[3] * sn[1]) * sc; o0[3] = (a[3] * cs[1] + a[2] * sn[1]) * sc;
                    o1[0] = (b[0] * cs[2] - b[1] * sn[2]) * sc; o1[1] = (b[1] * cs[2] + b[0] * sn[2]) * sc; o1[2] = (b[2] * cs[3] - b[3] * sn[3]) * sc; o1[3] = (b[3] * cs[3] + b[2] * sn[3]) * sc;
                    const int col = (u.pn & 3) * 256 + bj * 128 + wc * 32 + fq * 8;
                    if (ATT_FP8) { const float s8 = isq ? 64.f : 16.f; u32x2 w8; w8.x = pack_fp8x4(s8 * o0[0], s8 * o0[1], s8 * o0[2], s8 * o0[3]); w8.y = pack_fp8x4(s8 * o1[0], s8 * o1[1], s8 * o1[2], s8 * o1[3]);
                        if (dost) *(u32x2*)((unsigned char*)base + (size_t)row * 1024 + col) = w8; }
                    else { const u32x4 pk_ = pack8(o0, o1); if (dost) *(u32x4*)(base + (size_t)row * 1024 + col) = pk_; } } }
        } else {
#pragma unroll
            EPI_LOOP_ROWS { const int row = u.pm * 256 + ai * 128 + wr * 64 + m * 16 + fr;
#pragma unroll
                for (int bj = 0; bj < 2; ++bj) { const int col = u.pn * 256 + bj * 128 + wc * 32 + fq * 8;
                    if (ATT_FP8) { const f32x4 a_ = acc[ai][bj][m][0], b_ = acc[ai][bj][m][1]; u32x2 w8; w8.x = pack_fp8x4(16.f * a_[0], 16.f * a_[1], 16.f * a_[2], 16.f * a_[3]); w8.y = pack_fp8x4(16.f * b_[0], 16.f * b_[1], 16.f * b_[2], 16.f * b_[3]);
                        if (dost) *(u32x2*)((unsigned char*)Vt + (size_t)row * M + col) = w8; }
                    else { const u32x4 pk_ = pack8(acc[ai][bj][m][0], acc[ai][bj][m][1]); if (dost) *(u32x4*)(Vt + (size_t)row * M + col) = pk_; } } }
        }
    }
};
struct EpiPlain {
    static constexpr bool BIAS_DMA = false;
    static constexpr int NST = 16;
    bf16* O; int ldc;
    __device__ __forceinline__ void operator()(const f32x4 (&acc)[2][2][4][2], const Unit& u, int wr, int wc, int fr, int fq) const {
        asm volatile("" : "+v"(fr), "+v"(fq));
#pragma unroll
        EPI_LOOP_ROWS { const int row = u.pm * 256 + ai * 128 + wr * 64 + m * 16 + fr;
#pragma unroll
            for (int bj = 0; bj < 2; ++bj) { const int col = u.pn * 256 + bj * 128 + wc * 32 + fq * 8;
                *(u32x4*)(O + (size_t)row * ldc + col) = pack8(acc[ai][bj][m][0], acc[ai][bj][m][1]); } }
    }
};
struct EpiConvIn {
    static constexpr bool BIAS_DMA = false;
    static constexpr int NST = 16;
    bf16* Bb; bf16* Ub;
    __device__ __forceinline__ void operator()(const f32x4 (&acc)[2][2][4][2], const Unit& u, int wr, int wc, int fr, int fq) const {
        asm volatile("" : "+v"(fr), "+v"(fq));
        if (u.pn < 4) {
#pragma unroll
            EPI_LOOP_ROWS { const int row = u.pm * 256 + ai * 128 + wr * 64 + m * 16 + fr;
#pragma unroll
                for (int bj = 0; bj < 2; ++bj) { const int col = u.pn * 256 + bj * 128 + wc * 32 + fq * 8;
                    *(u32x4*)(Bb + (size_t)row * 1024 + col) = pack8(acc[ai][bj][m][0], acc[ai][bj][m][1]); } }
        } else {
#pragma unroll
            EPI_LOOP_ROWS { const int row = u.pm * 256 + ai * 128 + wr * 64 + m * 16 + fr;
#pragma unroll
                for (int bj = 0; bj < 2; ++bj) { const f32x4 a = acc[ai][bj][m][0], b = acc[ai][bj][m][1]; const int col = (u.pn - 4) * 128 + bj * 64 + wc * 16 + fq * 4;
                    u32x2 w; w.x = cvt_pk_bf16(a[0] * a[1], a[2] * a[3]); w.y = cvt_pk_bf16(b[0] * b[1], b[2] * b[3]);
                    *(u32x2*)(Ub + (size_t)row * 1024 + col) = w; } }
        }
    }
};
struct EpiResid {
    static constexpr bool BIAS_DMA = false;
    static constexpr int NST = X_BF16 ? 16 : 0;
    const void* Xin; void* X; const float* gate;
    const float* in_x; const float* in_ctx;
    __device__ __forceinline__ void operator()(const f32x4 (&acc)[2][2][4][2], const Unit& u, int wr, int wc, int fr, int fq) const {
        asm volatile("" : "+v"(fr), "+v"(fq));
        const int rb = (u.pm % 9) == 0 ? 16 : u.pm / 9; const float* gp = gate + rb * 6144;
        f32x4 gv[2][2];
#pragma unroll
        for (int bj = 0; bj < 2; ++bj) { const int col = u.pn * 256 + bj * 128 + wc * 32 + fq * 8; gv[bj][0] = *(const f32x4*)(gp + col); gv[bj][1] = *(const f32x4*)(gp + col + 4); }
        if (X_BF16 && !in_x) {
#pragma unroll
            for (int ai = 0; ai < 2; ++ai) { u32x4 xw[4][2];
#pragma unroll
                for (int m = 0; m < 4; ++m)
#pragma unroll
                    for (int bj = 0; bj < 2; ++bj) xw[m][bj] = *(const u32x4*)((const bf16*)Xin + (size_t)(u.pm * 256 + ai * 128 + wr * 64 + m * 16 + fr) * 1024 + u.pn * 256 + bj * 128 + wc * 32 + fq * 8);
#pragma unroll
                for (int m = 0; m < 4; ++m)
#pragma unroll
                    for (int bj = 0; bj < 2; ++bj) { const u32x4 w = xw[m][bj];
                        const f32x4 x0 = {bf2f((unsigned short)(w.x & 0xffffu)), bf2f((unsigned short)(w.x >> 16)), bf2f((unsigned short)(w.y & 0xffffu)), bf2f((unsigned short)(w.y >> 16))};
                        const f32x4 x1 = {bf2f((unsigned short)(w.z & 0xffffu)), bf2f((unsigned short)(w.z >> 16)), bf2f((unsigned short)(w.w & 0xffffu)), bf2f((unsigned short)(w.w >> 16))};
                        *(u32x4*)((bf16*)X + (size_t)(u.pm * 256 + ai * 128 + wr * 64 + m * 16 + fr) * 1024 + u.pn * 256 + bj * 128 + wc * 32 + fq * 8) = pack8(x0 + gv[bj][0] * acc[ai][bj][m][0], x1 + gv[bj][1] * acc[ai][bj][m][1]); } }
        } else {
#pragma unroll
            EPI_LOOP_ROWS { const int row = u.pm * 256 + ai * 128 + wr * 64 + m * 16 + fr;
#pragma unroll
                for (int bj = 0; bj < 2; ++bj) { const int col = u.pn * 256 + bj * 128 + wc * 32 + fq * 8; const size_t o = (size_t)row * 1024 + col;
                    const float* xs = (const float*)Xin + o;
                    if (in_x) { const int b_ = u.pm / 9, jt_ = u.pm % 9; const size_t ro = (size_t)(row - u.pm * 256) * 1024 + col;
                        xs = jt_ == 0 ? in_ctx + (size_t)b_ * CTXL * 1024 + ro : in_x + ((size_t)b_ * SEQ + (jt_ - 1) * 256) * 1024 + ro; }
                    const f32x4 x0 = *(const f32x4*)(xs), x1 = *(const f32x4*)(xs + 4);
                    const f32x4 r0 = x0 + gv[bj][0] * acc[ai][bj][m][0], r1 = x1 + gv[bj][1] * acc[ai][bj][m][1];
                    if (X_BF16) *(u32x4*)((bf16*)X + o) = pack8(r0, r1);
                    else { *(f32x4*)((float*)X + o) = r0; *(f32x4*)((float*)X + o + 4) = r1; } } }
        }
    }
};
__device__ __forceinline__ float swiglu1(float g, float l) {
    g = fminf(g, 7.f); l = fminf(fmaxf(l, -7.f), 7.f);
    const float s = __builtin_amdgcn_rcpf(1.f + __builtin_amdgcn_exp2f(-1.702f * 1.4426950408889634f * g));
    return g * s * (l + 1.f);
}
constexpr float GATE_PRE = -1.702f * 1.4426950408889634f;
__device__ __forceinline__ float swiglu4(float t, float l) {
    t = __builtin_amdgcn_fmed3f(t, 7.f * GATE_PRE, 3.0e38f); l = __builtin_amdgcn_fmed3f(l, -7.f, 7.f);
    const float r = __builtin_amdgcn_rcpf(1.f + __builtin_amdgcn_exp2f(t));
    return (t * r) * __builtin_fmaf(l, 4.f / GATE_PRE, 4.f / GATE_PRE);
}
template <bool F8> struct EpiSwiglu {
    static constexpr bool BIAS_DMA = true, GATE_COLS = F8; static constexpr float GATE_MUL = -1.702f * 1.4426950408889634f;
    static constexpr int NST = F8 ? 4 : 16;
    bf16* ACT; const float* bgu; LAS unsigned char* stg;
    __device__ __forceinline__ const float* bias_src(const Unit& u) const { return bgu + u.e * 2048 + u.pn * 256; }
    __device__ __forceinline__ void operator()(const f32x4 (&acc)[2][2][4][2], const Unit& u, int wr, int wc, int fr, int fq, LAS const float* bl) const {
        asm volatile("" : "+v"(fr), "+v"(fq));
        (void)bl;
        if constexpr (F8) {
            LAS unsigned* sw = (LAS unsigned*)(stg + (wr * 4 + wc) * 2048); const int lane = fq * 16 + fr;
#pragma unroll
            for (int ai = 0; ai < 2; ++ai) {
#pragma unroll
                for (int m = 0; m < 4; ++m)
#pragma unroll
                    for (int bj = 0; bj < 2; ++bj) { const f32x4 a = acc[ai][bj][m][0], b = acc[ai][bj][m][1];
                        const float s0_ = swiglu4(a[0], a[1]); int w = __builtin_bit_cast(int, s0_);
                        w = __builtin_amdgcn_cvt_pk_fp8_f32(s0_, swiglu4(a[2], a[3]), w, false); w = __builtin_amdgcn_cvt_pk_fp8_f32(swiglu4(b[0], b[1]), swiglu4(b[2], b[3]), w, true);
                        sw[((16 * m + fr) * 2 + bj) * 4 + fq] = (unsigned)w; }
                asm volatile("s_waitcnt lgkmcnt(0)" ::: "memory");
#pragma unroll
                for (int k = 0; k < 2; ++k) { const int p = lane + 64 * k, rr = p >> 1, bj = p & 1; const u32x4 v = *(const LAS u32x4*)(sw + p * 4);
                    const int row = u.pm * 256 + ai * 128 + wr * 64 + rr; const int col = u.pn * 128 + bj * 64 + wc * 16;
                    if (!(PROBE_NOST && u.kind)) *(u32x4*)((unsigned char*)ACT + (size_t)row * 1024 + col) = v; }
                asm volatile("s_waitcnt lgkmcnt(0)" ::: "memory");
            }
        } else {
#pragma unroll
            EPI_LOOP_ROWS { const int row = u.pm * 256 + ai * 128 + wr * 64 + m * 16 + fr;
#pragma unroll
                for (int bj = 0; bj < 2; ++bj) { const f32x4 a = acc[ai][bj][m][0], b = acc[ai][bj][m][1];
                    const int col = u.pn * 128 + bj * 64 + wc * 16 + fq * 4;
                    u32x2 w; w.x = cvt_pk_bf16(swiglu1(a[0], a[1]), swiglu1(a[2], a[3])); w.y = cvt_pk_bf16(swiglu1(b[0], b[1]), swiglu1(b[2], b[3]));
                    *(u32x2*)(ACT + (size_t)row * 1024 + col) = w; } }
        }
    }
};
struct EpiDown {
    static constexpr bool BIAS_DMA = true, GATE_COLS = false; static constexpr float GATE_MUL = 1.f;
    static constexpr int NST = Y_FP8 ? 8 : 16;
    bf16* Y; const float* bd; LAS unsigned char* stg;
    __device__ __forceinline__ const float* bias_src(const Unit& u) const { return bd + u.e * 1024 + u.pn * 256; }
    __device__ __forceinline__ void operator()(const f32x4 (&acc)[2][2][4][2], const Unit& u, int wr, int wc, int fr, int fq, LAS const float* bl) const {
        asm volatile("" : "+v"(fr), "+v"(fq));
        (void)bl;
        if constexpr (Y_FP8 != 0) {
            LAS unsigned char* sw = stg + (wr * 4 + wc) * 2048; const int lane = fq * 16 + fr;
#pragma unroll
            for (int ai = 0; ai < 2; ++ai)
#pragma unroll
                for (int bj = 0; bj < 2; ++bj) {
#pragma unroll
                    for (int m = 0; m < 4; ++m) { const f32x4 y0 = acc[ai][bj][m][0], y1 = acc[ai][bj][m][1];
                        u32x2 w; w.x = pack_fp8x4(16.f * y0[0], 16.f * y0[1], 16.f * y0[2], 16.f * y0[3]); w.y = pack_fp8x4(16.f * y1[0], 16.f * y1[1], 16.f * y1[2], 16.f * y1[3]);
                        *(LAS u32x2*)(sw + (16 * m + fr) * 32 + fq * 8) = w; }
                    asm volatile("s_waitcnt lgkmcnt(0)" ::: "memory");
#pragma unroll
                    for (int k = 0; k < 2; ++k) { const int p = lane + 64 * k, rr = p >> 1, hf = p & 1; const u32x4 v = *(const LAS u32x4*)(sw + p * 16);
                        const int row = u.pm * 256 + ai * 128 + wr * 64 + rr; const int col = u.pn * 256 + bj * 128 + wc * 32 + hf * 16;
                        if (!(PROBE_NOST && u.kind)) *(u32x4*)((unsigned char*)Y + (size_t)row * 1024 + col) = v; }
                    asm volatile("s_waitcnt lgkmcnt(0)" ::: "memory");
                }
        } else {
#pragma unroll
            EPI_LOOP_ROWS { const int row = u.pm * 256 + ai * 128 + wr * 64 + m * 16 + fr;
#pragma unroll
                for (int bj = 0; bj < 2; ++bj) { const int col = u.pn * 256 + bj * 128 + wc * 32 + fq * 8;
                    const u32x4 pk_ = pack8(acc[ai][bj][m][0], acc[ai][bj][m][1]); if (!(PROBE_NOST && u.kind)) *(u32x4*)(Y + (size_t)row * 1024 + col) = pk_; } }
        }
    }
};

namespace att {
constexpr int SLOT = 32768, VOFF = 16384;
__device__ __forceinline__ void glds16(const void* gsrc, unsigned lds_dst) { unsigned keep;
    asm volatile("s_mov_b32 %0, m0\n\ts_mov_b32 m0, %2\n\ts_nop 0\n\tglobal_load_lds_dwordx4 %1, off\n\ts_mov_b32 m0, %0" : "=&s"(keep) : "v"(gsrc), "s"(lds_dst) : "memory"); }
#define ATT_WAIT_BAR(N) asm volatile("s_waitcnt vmcnt(" #N ") lgkmcnt(0)\n\ts_barrier" ::: "memory")
__device__ __forceinline__ float half_swap_max(float m) { auto rr = __builtin_amdgcn_permlane32_swap(__float_as_uint(m), __float_as_uint(m), false, false); return fmaxf(__uint_as_float(rr[0]), __uint_as_float(rr[1])); }
__device__ __forceinline__ float half_swap_sum(float m) { auto rr = __builtin_amdgcn_permlane32_swap(__float_as_uint(m), __float_as_uint(m), false, false); return __uint_as_float(rr[0]) + __uint_as_float(rr[1]); }
__device__ __forceinline__ int crow(int r, int hi) { return (r & 3) + 8 * (r >> 2) + 4 * hi; }
__device__ __forceinline__ float max3f(float a, float b, float c) { float r; asm("v_max3_f32 %0, %1, %2, %3" : "=v"(r) : "v"(a), "v"(b), "v"(c)); return r; }

__device__ __forceinline__ void attn_unit(LAS unsigned char* lds, LAS float* wsc  , const bf16* Q, const bf16* Kb, const bf16* Vt, bf16* O,
                                          int krow0, int h, int qrow0, int NT, float lam, float osc, const float* subg, const int tid) {
    const int lane = tid & 63, r32 = lane & 31, hi = lane >> 5; const int wid = __builtin_amdgcn_readfirstlane(tid >> 6);
    const int qg = wid >> 1, c = wid & 1;
    const unsigned lds0 = (unsigned)(uintptr_t)lds;
    const bf16* ksrc[2]; const bf16* vsrc[2];
#pragma unroll
    for (int i = 0; i < 2; ++i) { const int p = 2 * wid + i;
        { const int row = 4 * p + (lane >> 4), ch = (lane & 15) ^ (row & 15); ksrc[i] = Kb + (size_t)(krow0 + row) * 1024 + h * 128 + ch * 8; }
        { const int row = 8 * p + (lane >> 3), ch = (lane & 7) ^ ((row >> 1) & 7); vsrc[i] = Vt + (size_t)(h * 128 + row) * M + krow0 + ch * 8; } }
    const unsigned kdst = lds0 + (unsigned)wid * 2048u, vdst = lds0 + VOFF + (unsigned)wid * 2048u;
#define ATT_DMA(t, slot) do { const unsigned so_ = (unsigned)(slot) * SLOT; \
        glds16(ksrc[0] + (size_t)(t) * 64 * 1024, (unsigned)__builtin_amdgcn_readfirstlane(kdst + so_)); glds16(ksrc[1] + (size_t)(t) * 64 * 1024, (unsigned)__builtin_amdgcn_readfirstlane(kdst + so_ + 1024u)); \
        glds16(vsrc[0] + (size_t)(t) * 64, (unsigned)__builtin_amdgcn_readfirstlane(vdst + so_)); glds16(vsrc[1] + (size_t)(t) * 64, (unsigned)__builtin_amdgcn_readfirstlane(vdst + so_ + 1024u)); } while (0)
    const int key0 = (r32 & 0x13) | ((r32 & 4) << 1) | ((r32 & 8) >> 1);
    const int kx = key0 & 15, vx = (r32 >> 1) & 7;
    bf16x8 qf[4];
    { const bf16* qp = Q + (size_t)(qrow0 + qg * 32 + r32) * 1024 + h * 128 + c * 64 + hi * 8;
#pragma unroll
      for (int d0 = 0; d0 < 4; ++d0) qf[d0] = *(const bf16x8*)(qp + d0 * 16); }
    float sg[4];
#pragma unroll
    for (int d0 = 0; d0 < 4; ++d0) sg[d0] = subg[d0 * 32 + r32] * osc;
    f32x16 o[4];
#pragma unroll
    for (int d0 = 0; d0 < 4; ++d0) o[d0] = f32x16{};
    float mref = 0.f, lsum = 0.f; f32x16 negm = f32x16{};
    asm volatile("s_waitcnt vmcnt(0)" ::: "memory");
#define AT_BEG(r) do { if (PROBE_T == (r)) at0_ = __builtin_amdgcn_s_memtime(); } while (0)
#define AT_END(r) do { if (PROBE_T == (r)) { const unsigned long long d_ = __builtin_amdgcn_s_memtime() - at0_; if (blockIdx.x == 0 && tid == ATT_PROBE_TID) *(LAS unsigned long long*)(lds + LX_MISC + 64) += d_; } } while (0)
    unsigned long long at0_ = 0; (void)at0_;
    AT_BEG(7);
    AT_BEG(13);
    ATT_DMA(0, 0);
    if (NT > 1) ATT_DMA(1, 1);
    for (int t = 0; t < NT; ++t) {
        const int slot = t & 3;
        AT_BEG(4);
        if (t + 1 < NT) { ATT_WAIT_BAR(4); } else { ATT_WAIT_BAR(0); }
        AT_END(4);
        if (t == 0) AT_END(13);
        if (t + 2 < NT) ATT_DMA(t + 2, (t + 2) & 3);
        AT_BEG(5);
        const LAS unsigned char* kb_ = lds + slot * SLOT; const LAS unsigned char* vb_ = kb_ + VOFF;
        f32x16 s0, s1;
        bf16x8 kf[8];
#pragma unroll
        for (int d0 = 0; d0 < 4; ++d0) { const int ch = (c * 8 + d0 * 2 + hi) ^ kx;
            kf[d0] = *(const LAS bf16x8*)(kb_ + key0 * 256 + ch * 16); kf[4 + d0] = *(const LAS bf16x8*)(kb_ + (key0 + 32) * 256 + ch * 16); }
        bf16x8 vA[8], vB[8];
#pragma unroll
        for (int ks = 0; ks < 2; ++ks) { const int ch = (2 * ks + hi) ^ vx;
#pragma unroll
            for (int d0 = 0; d0 < 4; ++d0) vA[ks * 4 + d0] = *(const LAS bf16x8*)(vb_ + (d0 * 32 + r32) * 128 + ch * 16); }
#pragma unroll
        for (int d0 = 0; d0 < 4; ++d0) s0 = __builtin_amdgcn_mfma_f32_32x32x16_bf16(kf[d0], qf[d0], d0 == 0 ? negm : s0, 0, 0, 0);
#pragma unroll
        for (int d0 = 0; d0 < 4; ++d0) s1 = __builtin_amdgcn_mfma_f32_32x32x16_bf16(kf[4 + d0], qf[d0], d0 == 0 ? negm : s1, 0, 0, 0);
        float rm = s0[0];
#pragma unroll
        for (int r = 1; r < 16; ++r) rm = fmaxf(rm, s0[r]);
        float sa = 0.f;
#pragma unroll
        for (int r = 0; r < 16; ++r) { s0[r] = __builtin_amdgcn_exp2f(s0[r]); sa += s0[r]; }
        bf16x8 pa[4];
#pragma unroll
        for (int s = 0; s < 2; ++s) { u32x4 w0;
            w0.x = cvt_pk_bf16(s0[8 * s + 0], s0[8 * s + 1]); w0.y = cvt_pk_bf16(s0[8 * s + 2], s0[8 * s + 3]); w0.z = cvt_pk_bf16(s0[8 * s + 4], s0[8 * s + 5]); w0.w = cvt_pk_bf16(s0[8 * s + 6], s0[8 * s + 7]);
            pa[s] = __builtin_bit_cast(bf16x8, w0); }
#pragma unroll
        for (int ks = 2; ks < 4; ++ks) { const int ch = (2 * ks + hi) ^ vx;
#pragma unroll
            for (int d0 = 0; d0 < 4; ++d0) vB[(ks - 2) * 4 + d0] = *(const LAS bf16x8*)(vb_ + (d0 * 32 + r32) * 128 + ch * 16); }
#pragma unroll
        for (int ks = 0; ks < 2; ++ks)
#pragma unroll
            for (int d0 = 0; d0 < 4; ++d0) o[d0] = __builtin_amdgcn_mfma_f32_32x32x16_bf16(pa[ks], vA[ks * 4 + d0], o[d0], 0, 0, 0);
#pragma unroll
        for (int r = 0; r < 16; ++r) rm = fmaxf(rm, s1[r]);
#pragma unroll
        for (int r = 0; r < 16; ++r) { s1[r] = __builtin_amdgcn_exp2f(s1[r]); sa += s1[r]; }
        lsum += sa;
#pragma unroll
        for (int s = 0; s < 2; ++s) { u32x4 w1;
            w1.x = cvt_pk_bf16(s1[8 * s + 0], s1[8 * s + 1]); w1.y = cvt_pk_bf16(s1[8 * s + 2], s1[8 * s + 3]); w1.z = cvt_pk_bf16(s1[8 * s + 4], s1[8 * s + 5]); w1.w = cvt_pk_bf16(s1[8 * s + 6], s1[8 * s + 7]);
            pa[2 + s] = __builtin_bit_cast(bf16x8, w1); }
#pragma unroll
        for (int ks = 2; ks < 4; ++ks)
#pragma unroll
            for (int d0 = 0; d0 < 4; ++d0) o[d0] = __builtin_amdgcn_mfma_f32_32x32x16_bf16(pa[ks], vB[(ks - 2) * 4 + d0], o[d0], 0, 0, 0);
        AT_END(5);
        rm = half_swap_max(rm);
        const bool need = (t == 0) || (rm > 8.f);
        if (__any(need)) {
            const float dl = need ? rm : 0.f; mref += dl;
#pragma unroll
            for (int r = 0; r < 16; ++r) negm[r] = -mref;
            const float f = __builtin_amdgcn_exp2f(-dl); lsum *= f;
            if (hi == 0) wsc[r32] = f;
            asm volatile("s_waitcnt lgkmcnt(0)" ::: "memory");
#pragma unroll
            for (int r = 0; r < 16; ++r) { const float fr_ = wsc[crow(r, hi)];
#pragma unroll
                for (int d0 = 0; d0 < 4; ++d0) o[d0][r] *= fr_; }
            asm volatile("s_waitcnt lgkmcnt(0)" ::: "memory");
        }
    }
    AT_BEG(14);
    const float lt = half_swap_sum(lsum);
    if (hi == 0) wsc[64 + r32] = (c ? -lam : 1.f) * __builtin_amdgcn_rcpf(lt);
    asm volatile("s_waitcnt lgkmcnt(0)\n\ts_barrier" ::: "memory");
    LAS float* xch = (LAS float*)(lds + qg * 16384);
#pragma unroll
    for (int r = 0; r < 16; ++r) { const float a = wsc[64 + crow(r, hi)];
#pragma unroll
        for (int d0 = 0; d0 < 4; ++d0) o[d0][r] *= a; }
    if (c == 1) {
#pragma unroll
        for (int d0 = 0; d0 < 4; ++d0)
#pragma unroll
            for (int r = 0; r < 16; ++r) xch[(d0 * 16 + r) * 64 + lane] = o[d0][r];
    }
    asm volatile("s_waitcnt lgkmcnt(0)\n\ts_barrier" ::: "memory");
    if (c == 0) {
        constexpr int OB = FP8_ATT_O ? 1 : 2;
        LAS unsigned char* stg = lds + 65536 + qg * 8192;
#pragma unroll
        for (int d0 = 0; d0 < 4; ++d0)
#pragma unroll
            for (int r = 0; r < 16; ++r) o[d0][r] += xch[(d0 * 16 + r) * 64 + lane];
        float ss[16], tt[16];
#pragma unroll
        for (int r = 0; r < 16; ++r) { float x = (o[0][r] * o[0][r] + o[1][r] * o[1][r]) + (o[2][r] * o[2][r] + o[3][r] * o[3][r]);
            x += __builtin_bit_cast(float, __builtin_amdgcn_update_dpp(0, __builtin_bit_cast(int, x), 0xB1, 0xF, 0xF, true));
            x += __builtin_bit_cast(float, __builtin_amdgcn_update_dpp(0, __builtin_bit_cast(int, x), 0x4E, 0xF, 0xF, true));
            x += __builtin_bit_cast(float, __builtin_amdgcn_update_dpp(0, __builtin_bit_cast(int, x), 0x124, 0xF, 0xF, true));
            x += __builtin_bit_cast(float, __builtin_amdgcn_update_dpp(0, __builtin_bit_cast(int, x), 0x128, 0xF, 0xF, true));
            ss[r] = x; }
#pragma unroll
        for (int r = 0; r < 16; ++r) tt[r] = __shfl_xor(ss[r], 16);
#pragma unroll
        for (int r = 0; r < 16; ++r) { const int qr = crow(r, hi); const float rn = __builtin_amdgcn_rsqf((ss[r] + tt[r]) * (1.f / 128.f) + EPS);
#pragma unroll
            for (int d0 = 0; d0 < 4; ++d0) { const float ov = o[d0][r] * rn * sg[d0];
                if (FP8_ATT_O) { const float o4 = clamp8(4.f * ov); *(LAS unsigned char*)(stg + qr * 128 + d0 * 32 + r32) = (unsigned char)(__builtin_amdgcn_cvt_pk_fp8_f32(o4, o4, 0, false) & 0xff); }
                else *(LAS unsigned short*)(stg + (qr * 128 + d0 * 32 + r32) * 2) = (unsigned short)f2bf(ov); } }
        asm volatile("s_waitcnt lgkmcnt(0)" ::: "memory");
        unsigned char* Ob = (unsigned char*)O + ((size_t)(qrow0 + qg * 32) * 1024 + h * 128) * OB;
#pragma unroll
        for (int k = 0; k < 4 * OB; ++k) { const int off = lane * 16 + 1024 * k, row = off / (128 * OB), cb = off % (128 * OB);
            *(u32x4*)(Ob + (size_t)row * 1024 * OB + cb) = *(const LAS u32x4*)(stg + off); }
    }
    asm volatile("s_waitcnt lgkmcnt(0)\n\ts_barrier" ::: "memory");
    AT_END(7);
    AT_END(14);
#undef AT_BEG
#undef AT_END
#undef ATT_DMA
}

typedef int v8i __attribute__((ext_vector_type(8)));
typedef int v4i_ __attribute__((ext_vector_type(4)));
__device__ __forceinline__ v8i cat16(u32x4 lo, u32x4 hi2) { const v4i_ a = __builtin_bit_cast(v4i_, lo), b = __builtin_bit_cast(v4i_, hi2); return __builtin_shufflevector(a, b, 0, 1, 2, 3, 4, 5, 6, 7); }
constexpr float ATT_TGT = 2.f;
__device__ __forceinline__ void attn_unit8(LAS unsigned char* lds, LAS float* wsc, const unsigned char* Q8, const unsigned char* K8, const unsigned char* V8t, bf16* O,
                                           int krow0, int h, int qrow0, int NT, float lam, float osc, const float* subg, const int tid) {
    constexpr int SL = 16384, VO = 8192;
    const int lane = tid & 63, r32 = lane & 31, hi = lane >> 5; const int wid = __builtin_amdgcn_readfirstlane(tid >> 6);
    const int qg = wid >> 1, c = wid & 1;
    const unsigned lds0 = (unsigned)(uintptr_t)lds;
    const unsigned char* ksrc; const unsigned char* vsrc;
    { const int key = 8 * wid + (lane >> 3), ch = (lane & 7) ^ ((key >> 1) & 7); ksrc = K8 + (size_t)(krow0 + key) * 1024 + h * 128 + ch * 16; }
    { const int dv = 16 * wid + (lane >> 2), ch = (lane & 3) ^ ((dv >> 2) & 3); vsrc = V8t + (size_t)(h * 128 + dv) * M + krow0 + ch * 16; }
    const unsigned kdst = lds0 + (unsigned)wid * 1024u, vdst = lds0 + VO + (unsigned)wid * 1024u;
#define ATT_DMA8(t, slot) do { const unsigned so_ = (unsigned)(slot) * SL; \
        glds16(ksrc + (size_t)(t) * 64 * 1024, (unsigned)__builtin_amdgcn_readfirstlane(kdst + so_)); glds16(vsrc + (size_t)(t) * 64, (unsigned)__builtin_amdgcn_readfirstlane(vdst + so_)); } while (0)
    const int key0 = 32 * ((r32 >> 2) & 1) + (r32 & 3) + 4 * (r32 >> 3);
    const int kx = (key0 >> 1) & 7, vx = (r32 >> 2) & 3;
    const int kc0 = ((c * 4 + 2 * hi) ^ kx) * 16, kc1 = ((c * 4 + 2 * hi + 1) ^ kx) * 16;
    const int vc0 = ((2 * hi) ^ vx) * 16, vc1 = ((2 * hi + 1) ^ vx) * 16;
    v8i qf;
    { const unsigned char* qp = Q8 + (size_t)(qrow0 + qg * 32 + r32) * 1024 + h * 128 + c * 64 + hi * 32;
      qf = cat16(*(const u32x4*)qp, *(const u32x4*)(qp + 16)); }
    float sg[4];
#pragma unroll
    for (int d0 = 0; d0 < 4; ++d0) sg[d0] = subg[d0 * 32 + r32] * osc;
    f32x16 o[4];
#pragma unroll
    for (int d0 = 0; d0 < 4; ++d0) o[d0] = f32x16{};
    float mref = 0.f, lsum = 0.f; f32x16 negm;
#pragma unroll
    for (int r = 0; r < 16; ++r) negm[r] = ATT_TGT;
    const int NS = NT >> 2;
    asm volatile("s_waitcnt vmcnt(0)" ::: "memory");
#pragma unroll
    for (int j = 0; j < 4; ++j) ATT_DMA8(j, j);
    ATT_WAIT_BAR(0);
    if (NS > 1) {
#pragma unroll
        for (int j = 0; j < 4; ++j) ATT_DMA8(4 + j, 4 + j);
    }
#define ATT_KFRAG(kb_, kk) cat16(*(const LAS u32x4*)((kb_) + (key0 + (kk)) * 128 + kc0), *(const LAS u32x4*)((kb_) + (key0 + (kk)) * 128 + kc1))
#define ATT_VFRAG(vb_, d0) cat16(*(const LAS u32x4*)((vb_) + ((d0) * 32 + r32) * 64 + vc0), *(const LAS u32x4*)((vb_) + ((d0) * 32 + r32) * 64 + vc1))
#define ATT_QK(kb_, kk) __builtin_amdgcn_mfma_scale_f32_32x32x64_f8f6f4(ATT_KFRAG(kb_, kk), qf, negm, 0, 0, 0, 0x7A7A7A7A, 0, 0x7A7A7A7A)
    {
        const f32x16 s0 = ATT_QK(lds, 0), s1 = ATT_QK(lds, 16);
        float rm = s0[0];
#pragma unroll
        for (int r = 1; r < 16; ++r) rm = fmaxf(rm, s0[r]);
#pragma unroll
        for (int r = 0; r < 16; ++r) rm = fmaxf(rm, s1[r]);
        mref = half_swap_max(rm) - ATT_TGT;
#pragma unroll
        for (int r = 0; r < 16; ++r) negm[r] = ATT_TGT - mref;
    }
    for (int st = 0; st < NS; ++st) {
        if (st > 0) {
            ATT_WAIT_BAR(0);
            if (st + 1 < NS) {
#pragma unroll
                for (int j = 0; j < 4; ++j) ATT_DMA8(4 * (st + 1) + j, ((st + 1) & 1) * 4 + j);
            }
        }
        const LAS unsigned char* sb_ = lds + (st & 1) * 4 * SL;
        v8i pfp = {0, 0, 0, 0, 0, 0, 0, 0};
#pragma unroll
        for (int j = 0; j < 4; ++j) {
            const LAS unsigned char* kb_ = sb_ + j * SL;
            f32x16 s0 = ATT_QK(kb_, 0), s1 = ATT_QK(kb_, 16);
            if (j > 0) { const LAS unsigned char* vp_ = kb_ - SL + VO;
#pragma unroll
                for (int d0 = 0; d0 < 4; ++d0) o[d0] = __builtin_amdgcn_mfma_scale_f32_32x32x64_f8f6f4(pfp, ATT_VFRAG(vp_, d0), o[d0], 0, 0, 0, 0x7F7F7F7F, 0, 0x7F7F7F7F); }
#pragma unroll
            for (int r = 0; r < 16; ++r) { s0[r] = __builtin_amdgcn_exp2f(s0[r]); s1[r] = __builtin_amdgcn_exp2f(s1[r]); }
            float sa = 0.f, sb = 0.f;
#pragma unroll
            for (int r = 0; r < 16; ++r) { sa += s0[r]; sb += s1[r]; }
            sa += sb;
            if (__any(!(sa <= 448.f))) {
                unsigned ko_ = (unsigned)(uintptr_t)kb_; asm volatile("" : "+v"(ko_));
                const LAS unsigned char* kr_ = (const LAS unsigned char*)(uintptr_t)ko_;
                s0 = ATT_QK(kr_, 0); s1 = ATT_QK(kr_, 16);
                float rm = s0[0];
#pragma unroll
                for (int r = 1; r < 16; ++r) rm = fmaxf(rm, s0[r]);
#pragma unroll
                for (int r = 0; r < 16; ++r) rm = fmaxf(rm, s1[r]);
                rm = half_swap_max(rm);
                const float dl = fmaxf(rm - ATT_TGT, 0.f); mref += dl;
#pragma unroll
                for (int r = 0; r < 16; ++r) negm[r] = ATT_TGT - mref;
                const float f = __builtin_amdgcn_exp2f(-dl); lsum *= f;
                if (hi == 0) wsc[r32] = f;
                asm volatile("s_waitcnt lgkmcnt(0)" ::: "memory");
#pragma unroll
                for (int r = 0; r < 16; ++r) { const float fr_ = wsc[crow(r, hi)];
#pragma unroll
                    for (int d0 = 0; d0 < 4; ++d0) o[d0][r] *= fr_; }
                asm volatile("s_waitcnt lgkmcnt(0)" ::: "memory");
#pragma unroll
                for (int r = 0; r < 16; ++r) { s0[r] = __builtin_amdgcn_exp2f(s0[r] - dl); s1[r] = __builtin_amdgcn_exp2f(s1[r] - dl); }
                sa = 0.f; sb = 0.f;
#pragma unroll
                for (int r = 0; r < 16; ++r) { sa += s0[r]; sb += s1[r]; }
                sa += sb;
            }
            lsum += sa;
#pragma unroll
            for (int jj = 0; jj < 4; ++jj) { int w = __builtin_bit_cast(int, s0[4 * jj]); w = __builtin_amdgcn_cvt_pk_fp8_f32(s0[4 * jj], s0[4 * jj + 1], w, false); w = __builtin_amdgcn_cvt_pk_fp8_f32(s0[4 * jj + 2], s0[4 * jj + 3], w, true); pfp[jj] = w;
                int w2 = __builtin_bit_cast(int, s1[4 * jj]); w2 = __builtin_amdgcn_cvt_pk_fp8_f32(s1[4 * jj], s1[4 * jj + 1], w2, false); w2 = __builtin_amdgcn_cvt_pk_fp8_f32(s1[4 * jj + 2], s1[4 * jj + 3], w2, true); pfp[4 + jj] = w2; }
        }
        {
            const LAS unsigned char* vl_ = sb_ + 3 * SL + VO;
#pragma unroll
            for (int d0 = 0; d0 < 4; ++d0) o[d0] = __builtin_amdgcn_mfma_scale_f32_32x32x64_f8f6f4(pfp, ATT_VFRAG(vl_, d0), o[d0], 0, 0, 0, 0x7F7F7F7F, 0, 0x7F7F7F7F);
        }
    }
#undef ATT_KFRAG
#undef ATT_VFRAG
#undef ATT_QK
    const float lt = half_swap_sum(lsum);
    if (hi == 0) wsc[64 + r32] = (c ? -lam : 1.f) * __builtin_amdgcn_rcpf(16.f * lt);
    asm volatile("s_waitcnt lgkmcnt(0)\n\ts_barrier" ::: "memory");
    LAS float* xch = (LAS float*)(lds + qg * 16384);
#pragma unroll
    for (int r = 0; r < 16; ++r) { const float a = wsc[64 + crow(r, hi)];
#pragma unroll
        for (int d0 = 0; d0 < 4; ++d0) o[d0][r] *= a; }
    if (c == 1) {
#pragma unroll
        for (int d0 = 0; d0 < 4; ++d0)
#pragma unroll
            for (int r = 0; r < 16; ++r) xch[(d0 * 16 + r) * 64 + lane] = o[d0][r];
    }
    asm volatile("s_waitcnt lgkmcnt(0)\n\ts_barrier" ::: "memory");
    if (c == 0) {
        constexpr int OB = FP8_ATT_O ? 1 : 2;
        LAS unsigned char* stg = lds + 65536 + qg * 8192;
#pragma unroll
        for (int d0 = 0; d0 < 4; ++d0)
#pragma unroll
            for (int r = 0; r < 16; ++r) o[d0][r] += xch[(d0 * 16 + r) * 64 + lane];
        float ss[16], tt[16];
#pragma unroll
        for (int r = 0; r < 16; ++r) { float x = (o[0][r] * o[0][r] + o[1][r] * o[1][r]) + (o[2][r] * o[2][r] + o[3][r] * o[3][r]);
            x += __builtin_bit_cast(float, __builtin_amdgcn_update_dpp(0, __builtin_bit_cast(int, x), 0xB1, 0xF, 0xF, true));
            x += __builtin_bit_cast(float, __builtin_amdgcn_update_dpp(0, __builtin_bit_cast(int, x), 0x4E, 0xF, 0xF, true));
            x += __builtin_bit_cast(float, __builtin_amdgcn_update_dpp(0, __builtin_bit_cast(int, x), 0x124, 0xF, 0xF, true));
            x += __builtin_bit_cast(float, __builtin_amdgcn_update_dpp(0, __builtin_bit_cast(int, x), 0x128, 0xF, 0xF, true));
            ss[r] = x; }
#pragma unroll
        for (int r = 0; r < 16; ++r) tt[r] = __shfl_xor(ss[r], 16);
#pragma unroll
        for (int r = 0; r < 16; ++r) { const int qr = crow(r, hi); const float rn = __builtin_amdgcn_rsqf((ss[r] + tt[r]) * (1.f / 128.f) + EPS);
#pragma unroll
            for (int d0 = 0; d0 < 4; ++d0) { const float ov = o[d0][r] * rn * sg[d0];
                if (FP8_ATT_O) { const float o4 = clamp8(4.f * ov); *(LAS unsigned char*)(stg + qr * 128 + d0 * 32 + r32) = (unsigned char)(__builtin_amdgcn_cvt_pk_fp8_f32(o4, o4, 0, false) & 0xff); }
                else *(LAS unsigned short*)(stg + (qr * 128 + d0 * 32 + r32) * 2) = (unsigned short)f2bf(ov); } }
        asm volatile("s_waitcnt lgkmcnt(0)" ::: "memory");
        unsigned char* Ob = (unsigned char*)O + ((size_t)(qrow0 + qg * 32) * 1024 + h * 128) * OB;
#pragma unroll
        for (int k = 0; k < 4 * OB; ++k) { const int off = lane * 16 + 1024 * k, row = off / (128 * OB), cb = off % (128 * OB);
            *(u32x4*)(Ob + (size_t)row * 1024 * OB + cb) = *(const LAS u32x4*)(stg + off); }
    }
    asm volatile("s_waitcnt lgkmcnt(0)\n\ts_barrier" ::: "memory");
#undef ATT_DMA8
}
}

#if ATT_FP8
#define ATT_CALL(l_, w_, q_, k_, v_, o_, ...) att::attn_unit8(l_, w_, (const unsigned char*)(q_), (const unsigned char*)(k_), (const unsigned char*)(v_), o_, __VA_ARGS__)
#else
#define ATT_CALL att::attn_unit
#endif
__device__ __forceinline__ void load_row_f32(const float* p, int lane, f32x4 (&v)[4]) {
#pragma unroll
    for (int j = 0; j < 4; ++j) v[j] = *(const f32x4*)(p + 256 * j + 4 * lane);
}
__device__ __forceinline__ void load_row_x(const void* Xb, size_t row, int lane, f32x4 (&v)[4]) {
    if (X_BF16) { const bf16* p = (const bf16*)Xb + row * D;
#pragma unroll
        for (int j = 0; j < 4; ++j) { const u32x2 w = *(const u32x2*)(p + 256 * j + 4 * lane);
            v[j] = (f32x4){bf2f((unsigned short)(w.x & 0xffffu)), bf2f((unsigned short)(w.x >> 16)), bf2f((unsigned short)(w.y & 0xffffu)), bf2f((unsigned short)(w.y >> 16))}; } }
    else load_row_f32((const float*)Xb + row * D, lane, v);
}
__device__ __forceinline__ void store_row_x(void* Xb, size_t row, int lane, const f32x4 (&v)[4]) {
    if (X_BF16) { bf16* p = (bf16*)Xb + row * D;
#pragma unroll
        for (int j = 0; j < 4; ++j) { u32x2 w; w.x = cvt_pk_bf16(v[j][0], v[j][1]); w.y = cvt_pk_bf16(v[j][2], v[j][3]); *(u32x2*)(p + 256 * j + 4 * lane) = w; } }
    else { float* p = (float*)Xb + row * D;
#pragma unroll
        for (int j = 0; j < 4; ++j) *(f32x4*)(p + 256 * j + 4 * lane) = v[j]; }
}
__device__ __forceinline__ float row_rstd(const f32x4 (&v)[4]) {
    float s = 0.f;
#pragma unroll
    for (int j = 0; j < 4; ++j) s += (v[j][0] * v[j][0] + v[j][1] * v[j][1]) + (v[j][2] * v[j][2] + v[j][3] * v[j][3]);
    return 1.0f / sqrtf(wave_sum(s) * (1.f / D) + EPS);
}
__device__ __forceinline__ void norm_mod_store(f32x4 (&v)[4], const float* g, const float* sc, const float* sh, int lane, bf16* hrow) {
    const float rstd = row_rstd(v);
#pragma unroll
    for (int j = 0; j < 4; ++j) { const int c = 256 * j + 4 * lane; const f32x4 gg = *(const f32x4*)(g + c), ss = *(const f32x4*)(sc + c), hh = *(const f32x4*)(sh + c);
        v[j] = (v[j] * rstd) * gg * (ss + 1.f) + hh;
        u32x2 w; w.x = cvt_pk_bf16(v[j][0], v[j][1]); w.y = cvt_pk_bf16(v[j][2], v[j][3]); *(u32x2*)(hrow + c) = w; }
}
__device__ __forceinline__ void norm_mod_f32(f32x4 (&v)[4], const float* g, const float* sc, const float* sh, int lane) {
    const float rstd = row_rstd(v);
#pragma unroll
    for (int j = 0; j < 4; ++j) { const int c = 256 * j + 4 * lane; const f32x4 gg = *(const f32x4*)(g + c), ss = *(const f32x4*)(sc + c), hh = *(const f32x4*)(sh + c);
        v[j] = (v[j] * rstd) * gg * (ss + 1.f) + hh; }
}
__device__ __forceinline__ void norm_mod_store_mix(bool f8, f32x4 (&v)[4], const float* g, const float* sc, const float* sh, int lane, bf16* hrow, unsigned char* h8row) {
    if (f8) { norm_mod_f32(v, g, sc, sh, lane);
#pragma unroll
        for (int j = 0; j < 4; ++j) *(unsigned*)(h8row + 256 * j + 4 * lane) = pack_fp8x4(16.f * v[j][0], 16.f * v[j][1], 16.f * v[j][2], 16.f * v[j][3]); }
    else norm_mod_store(v, g, sc, sh, lane, hrow);
}
__device__ __forceinline__ int row_batch(int row) { return row / RPB; }
__device__ __forceinline__ bool row_is_ctx(int row) { return (row % RPB) < CTXL; }
__device__ __forceinline__ int act_row(int ai, bool lat_only) { return lat_only ? (ai >> 11) * RPB + CTXL + (ai & 2047) : ai; }

template <int MODE>
__device__ __forceinline__ void transpose_item(const float* W, int K, int N, bf16* WT, LAS float* scr, int item, int lane) {
    const int nblk = N / 32, kb = item / nblk, nb = item % nblk, k0 = 64 * kb, n0 = 32 * nb;
#pragma unroll 8
    for (int i = 0; i < 32; ++i) { const int kk = 2 * i + (lane >> 5); scr[kk * 33 + (lane & 31)] = W[(size_t)(k0 + kk) * N + n0 + (lane & 31)]; }
    asm volatile("s_waitcnt lgkmcnt(0)" ::: "memory");
    const int c = lane & 7;
#pragma unroll
    for (int j = 0; j < 4; ++j) { const int n = (lane >> 3) + 8 * j; const LAS float* s = scr + (8 * c) * 33 + n;
        u32x4 o; o.x = cvt_pk_bf16(s[0 * 33], s[1 * 33]); o.y = cvt_pk_bf16(s[2 * 33], s[3 * 33]); o.z = cvt_pk_bf16(s[4 * 33], s[5 * 33]); o.w = cvt_pk_bf16(s[6 * 33], s[7 * 33]);
        int nn = n0 + n;
        if (MODE == 1 && nn < 2048) { const int i6 = nn & 63; nn = (nn & ~63) + (i6 < 32 ? 2 * i6 : 2 * (i6 - 32) + 1); }
        if (MODE == 2 && nn >= 1024) nn = nn < 2048 ? 1024 + 2 * (nn - 1024) : 1024 + 2 * (nn - 2048) + 1;
        *(u32x4*)(WT + (size_t)nn * K + k0 + 8 * c) = o; }
    asm volatile("s_waitcnt lgkmcnt(0)" ::: "memory");
}

template <int MODE = 0>
__device__ __forceinline__ void transpose_item8(const float* W, int K, int N, unsigned char* WT, LAS float* scr, int item, int lane) {
    const int nblk = N / 16, kb = item / nblk, nb = item % nblk, k0 = 128 * kb, n0 = 16 * nb;
    f32x4 v[8];
#pragma unroll
    for (int i = 0; i < 8; ++i) v[i] = *(const f32x4*)(W + (size_t)(k0 + 16 * i + (lane >> 2)) * N + n0 + 4 * (lane & 3));
#pragma unroll
    for (int i = 0; i < 8; ++i) *(LAS f32x4*)(scr + (16 * i + (lane >> 2)) * 20 + 4 * (lane & 3)) = v[i] * 1024.f;
    asm volatile("s_waitcnt lgkmcnt(0)" ::: "memory");
    const int kc = lane & 7;
#pragma unroll
    for (int j = 0; j < 2; ++j) { const int n = (lane >> 3) + 8 * j; const LAS float* s = scr + (16 * kc) * 20 + n;
        u32x4 o;
        o.x = pack_fp8x4(s[0 * 20], s[1 * 20], s[2 * 20], s[3 * 20]); o.y = pack_fp8x4(s[4 * 20], s[5 * 20], s[6 * 20], s[7 * 20]);
        o.z = pack_fp8x4(s[8 * 20], s[9 * 20], s[10 * 20], s[11 * 20]); o.w = pack_fp8x4(s[12 * 20], s[13 * 20], s[14 * 20], s[15 * 20]);
        int nn = n0 + n;
        if (MODE == 1 && nn < 2048) { const int i6 = nn & 63; nn = (nn & ~63) + (i6 < 32 ? 2 * i6 : 2 * (i6 - 32) + 1); }
        *(u32x4*)(WT + (size_t)nn * K + k0 + 16 * kc) = o; }
    asm volatile("s_waitcnt lgkmcnt(0)" ::: "memory");
}

__device__ __forceinline__ void item8_load(const float* W, int N, int item, int lane, f32x4 (&v)[8]) {
    const int nblk = N / 16, kb = item / nblk, nb = item % nblk, k0 = 128 * kb, n0 = 16 * nb;
#pragma unroll
    for (int i = 0; i < 8; ++i) v[i] = *(const f32x4*)(W + (size_t)(k0 + 16 * i + (lane >> 2)) * N + n0 + 4 * (lane & 3));
}
__device__ __forceinline__ void item8_store(const f32x4 (&v)[8], int K, int N, unsigned char* WT, LAS float* scr, int item, int lane) {
    const int nblk = N / 16, kb = item / nblk, nb = item % nblk, k0 = 128 * kb, n0 = 16 * nb;
    const float ge = (N == 2048) ? 1024.f * GATE_PRE : 1024.f; const f32x4 mulv = {ge, 1024.f, ge, 1024.f};
#pragma unroll
    for (int i = 0; i < 8; ++i) *(LAS f32x4*)(scr + (16 * i + (lane >> 2)) * 20 + 4 * (lane & 3)) = v[i] * mulv;
    asm volatile("s_waitcnt lgkmcnt(0)" ::: "memory");
    const int kc = lane & 7;
#pragma unroll
    for (int j = 0; j < 2; ++j) { const int n = (lane >> 3) + 8 * j; const LAS float* s = scr + (16 * kc) * 20 + n;
        u32x4 o;
        o.x = pack_fp8x4(s[0 * 20], s[1 * 20], s[2 * 20], s[3 * 20]); o.y = pack_fp8x4(s[4 * 20], s[5 * 20], s[6 * 20], s[7 * 20]);
        o.z = pack_fp8x4(s[8 * 20], s[9 * 20], s[10 * 20], s[11 * 20]); o.w = pack_fp8x4(s[12 * 20], s[13 * 20], s[14 * 20], s[15 * 20]);
        *(u32x4*)(WT + (size_t)(n0 + n) * K + k0 + 16 * kc) = o; }
    asm volatile("s_waitcnt lgkmcnt(0)" ::: "memory");
}

struct Args { const float* in[21]; float* out; unsigned char* ws; int ph_lo, ph_hi; };
enum { I_X = 0, I_C, I_CTX, I_CCTX, I_MODW, I_MODB, I_NORMG, I_WQKV, I_WO, I_LAM, I_SUBG, I_WIN, I_CONVW, I_WOUT, I_RW, I_RB, I_WGU, I_BGU, I_WD, I_BD, I_FINALG };

__device__ __forceinline__ void moe_table(LAS unsigned char* lds, const unsigned* gcnt, int tid) {
    LAS int* ecnt = (LAS int*)(lds + LX_ECNT); LAS int* tstart = (LAS int*)(lds + LX_TSTART); LAS int* tile_e = (LAS int*)(lds + LX_TILEE);
    __syncthreads();
    if (tid < 32) ecnt[tid] = (int)__hip_atomic_load(gcnt + tid, RLX_AGENT);
    __syncthreads();
    if (tid == 0) { int ts = 0; for (int e = 0; e < 32; ++e) { tstart[e] = ts; ts += (ecnt[e] + 255) >> 8; } tstart[32] = ts; }
    __syncthreads();
    { const int e = tid >> 4, l16 = tid & 15; const int t0 = tstart[e], n = tstart[e + 1] - t0; for (int j = l16; j < n; j += 16) tile_e[t0 + j] = e; }
    __syncthreads();
}

typedef const __attribute__((address_space(4))) unsigned char* kptr_t;
__device__ __forceinline__ kptr_t kargs() { kptr_t p = (kptr_t)__builtin_amdgcn_kernarg_segment_ptr(); asm volatile("" : "+s"(p)); return p; }
#define INP(k) (*(const float* const __attribute__((address_space(4)))*)(kargs() + 8 * (k)))
#define OUTP() (*(float* const __attribute__((address_space(4)))*)(kargs() + 168))
#define WSB() (*(unsigned char* const __attribute__((address_space(4)))*)(kargs() + 176))
#define WSP(T, off) ((T*)(WSB() + (off)))
static_assert(sizeof(Args) == 192, "kernarg layout");
__global__ void __launch_bounds__(NTHREADS, 2) fwd(Args args) {
    extern __shared__ __attribute__((aligned(16))) unsigned char lds_raw[];
    LAS unsigned char* lds = (LAS unsigned char*)lds_raw;
    const int tid = threadIdx.x, lane = tid & 63, wave = __builtin_amdgcn_readfirstlane(tid >> 6);
    const int G = gridDim.x, bid = blockIdx.x;
    const int gw = bid * NWAVES + wave, NGW = G * NWAVES;
    gu32* ctl = (gu32*)WSP(unsigned, WS_CTL);
    for (int u = tid; u < (LDS_BYTES - LX) / 4; u += NTHREADS) ((LAS unsigned*)(lds + LX))[u] = 0u;
    __syncthreads();
    volatile LAS unsigned* MISC = (volatile LAS unsigned*)(lds + LX_MISC);
    XcdBarrier bar; bar.bar = (unsigned*)(ctl + CW_BAR); bar.x = 0; bar.st = nullptr;
    if (!MK_PER_PHASE) bar = xcd_barrier_post((unsigned*)(ctl + CW_BAR), MISC + 8);
    (void)args;
    const unsigned long long pt_start = PROBE_T ? __builtin_amdgcn_s_memtime() : 0ull; (void)pt_start;
    const unsigned long long pt_rstart = PROBE_T ? __builtin_amdgcn_s_memrealtime() : 0ull; (void)pt_rstart;
    const int lo = *(const int __attribute__((address_space(4)))*)(kargs() + 184), hi = *(const int __attribute__((address_space(4)))*)(kargs() + 188);
#define IN(k) (lo <= (k) && (k) < hi)
#define PHASE_IDS int tid = threadIdx.x; asm volatile("" : "+v"(tid)); const int lane = tid & 63, wave = __builtin_amdgcn_readfirstlane(tid >> 6); const int gw = bid * NWAVES + wave; (void)lane; (void)gw;
#define SEAM(k) do { if (IN(k) && IN((k) + 1)) { if (MK_PER_PHASE) { if (tid == 0) __hip_atomic_store(ctl + CW_TMO, 0xBADu, RLX_AGENT); } else { unsigned long long b0_ = 0; if (PROBE_T == 10) b0_ = __builtin_amdgcn_s_memtime(); xcd_barrier(bar); if (PROBE_REP & 0x10000) xcd_barrier(bar); if (PROBE_T == 10 && bid == PROBE_BID && threadIdx.x == 0) *(LAS unsigned long long*)(lds + LX_MISC + 64) += __builtin_amdgcn_s_memtime() - b0_; } } } while (0)

    if (PS(0) && IN(0)) { PHASE_IDS
        float* modv = WSP(float, WS_MODV);
        unsigned long long p0t_ = (PROBE_T == 11 || PROBE_T == 12) ? __builtin_amdgcn_s_memtime() : 0ull; (void)p0t_;
        { LAS float* sil = (LAS float*)lds;
          LAS float* red = (LAS float*)(lds + 69632);
          for (int i = tid; i < 17 * 1024; i += NTHREADS) { const int r = i >> 10, k = i & 1023; const float cv = r < 16 ? INP(I_C)[r * 1024 + k] : INP(I_CCTX)[k]; sil[i] = cv / (1.f + __expf(-cv)); }
          __syncthreads();
          for (int it = bid; it < 4 * 96; it += G) { const int l = it / 96, nb = it % 96; const float* W = INP(I_MODW) + (size_t)l * 1024 * 6144 + nb * 64 + lane;
            float a[17];
#pragma unroll
            for (int r = 0; r < 17; ++r) a[r] = 0.f;
            for (int k = wave * 128; k < wave * 128 + 128; k += 4) { float w[4];
#pragma unroll
                for (int q = 0; q < 4; ++q) w[q] = W[(size_t)(k + q) * 6144];
#pragma unroll
                for (int r = 0; r < 17; ++r) { const f32x4 s = *(const LAS f32x4*)(sil + r * 1024 + k); a[r] += s[0] * w[0] + s[1] * w[1] + s[2] * w[2] + s[3] * w[3]; } }
#pragma unroll
            for (int r = 0; r < 17; ++r) red[(wave * 17 + r) * 64 + lane] = a[r];
            __syncthreads();
            for (int i = tid; i < 17 * 64; i += NTHREADS) { const int r = i >> 6, n = i & 63; float s = INP(I_MODB)[l * 6144 + nb * 64 + n];
#pragma unroll
                for (int w8 = 0; w8 < 8; ++w8) s += red[(w8 * 17 + r) * 64 + n];
                modv[((size_t)l * 17 + r) * 6144 + nb * 64 + n] = s; }
            __syncthreads(); }
        }
        if (PROBE_T == 11 && bid == 0 && tid == 0) *(LAS unsigned long long*)(lds + LX_MISC + 64) += __builtin_amdgcn_s_memtime() - p0t_;
        { float* cosT = WSP(float, WS_ROPE); float* sinT = cosT + 2048 * 32; float* rwT = WSP(float, WS_RW); float* lamv = WSP(float, WS_MISC);
        for (int i = bid * NTHREADS + tid; i < 2048 * 32; i += G * NTHREADS) { const int t = i >> 5, j = i & 31; const float pos = (float)(j < 16 ? (t >> 6) : (t & 63));
            const float inv = powf(10000.f, -(float)(2 * (j & 15)) / 32.f); const float ang = pos * inv; cosT[i] = cosf(ang); sinT[i] = sinf(ang); }
        if (bid == 0 && tid < 2) { const float* lp = INP(I_LAM) + tid * 256; float s1 = 0.f, s2 = 0.f; for (int d = 0; d < 64; ++d) { s1 += lp[d] * lp[64 + d]; s2 += lp[128 + d] * lp[192 + d]; }
            const float lam_init = 0.8f - 0.6f * expf(-0.3f * (float)(2 * tid)); lamv[tid] = expf(s1) - expf(s2) + lam_init; lamv[2 + tid] = 1.f - lam_init; }
        for (int i = bid * NTHREADS + tid; i < 4 * 32 * 1024; i += G * NTHREADS) { const int l = i >> 15, e = (i >> 10) & 31, k = i & 1023; rwT[i] = INP(I_RW)[((size_t)l * 1024 + k) * 32 + e]; } }
        if (PROBE_T == 12) p0t_ = __builtin_amdgcn_s_memtime();
        { LAS float* scr = (LAS float*)(lds + wave * 10240);
          bf16* Wqkv_t = WSP(bf16, WS_WQKV); bf16* Win_t = WSP(bf16, WS_WIN); bf16* Wo_t = WSP(bf16, WS_WO); bf16* Wout_t = WSP(bf16, WS_WOUT); bf16* Wgu_t = WSP(bf16, WS_WGU); bf16* Wd_t = WSP(bf16, WS_WD);
          constexpr int I_QKV = 16 * 96, I_SQ = 16 * 32, I_GU = 16 * 64, I_D = 16 * 32;
          constexpr int T0 = 2 * I_QKV, T1 = T0 + 2 * I_QKV, T2 = T1 + 2 * I_SQ, T3 = T2 + 2 * I_SQ, T4 = T3 + 128 * I_GU, T5 = T4 + 128 * I_D;
          for (int rep = 0; rep < NREP(0); ++rep) {
          for (int it = gw; it < (MOE_FP8 ? T3 : T5); it += NGW) {
            if (it < T0) { const int j = it / I_QKV; if (FP8_ATT) transpose_item8<1>(INP(I_WQKV) + (size_t)j * 1024 * 3072, 1024, 3072, (unsigned char*)Wqkv_t + (size_t)j * 3072 * 1024, scr, it % I_QKV, lane); else transpose_item<1>(INP(I_WQKV) + (size_t)j * 1024 * 3072, 1024, 3072, Wqkv_t + (size_t)j * 3072 * 1024, scr, it % I_QKV, lane); }
            else if (it < T1) { const int r = it - T0, j = r / I_QKV; if (FP8_CONV) transpose_item8<0>(INP(I_WIN) + (size_t)j * 1024 * 3072, 1024, 3072, (unsigned char*)Win_t + (size_t)j * 3072 * 1024, scr, r % I_QKV, lane); else transpose_item<CONV_FUSE_U ? 2 : 0>(INP(I_WIN) + (size_t)j * 1024 * 3072, 1024, 3072, Win_t + (size_t)j * 3072 * 1024, scr, r % I_QKV, lane); }
            else if (it < T2) { const int r = it - T1, j = r / I_SQ; if (FP8_ATT_O) transpose_item8<0>(INP(I_WO) + (size_t)j * 1024 * 1024, 1024, 1024, (unsigned char*)Wo_t + (size_t)j * 1024 * 1024, scr, r % I_SQ, lane); else transpose_item<0>(INP(I_WO) + (size_t)j * 1024 * 1024, 1024, 1024, Wo_t + (size_t)j * 1024 * 1024, scr, r % I_SQ, lane); }
            else if (it < T3) { const int r = it - T2, j = r / I_SQ; if (FP8_CONV) transpose_item8<0>(INP(I_WOUT) + (size_t)j * 1024 * 1024, 1024, 1024, (unsigned char*)Wout_t + (size_t)j * 1024 * 1024, scr, r % I_SQ, lane); else transpose_item<0>(INP(I_WOUT) + (size_t)j * 1024 * 1024, 1024, 1024, Wout_t + (size_t)j * 1024 * 1024, scr, r % I_SQ, lane); }
            else if (it < T4) { const int r = it - T3, j = r / I_GU; transpose_item<0>(INP(I_WGU) + (size_t)j * 1024 * 2048, 1024, 2048, Wgu_t + (size_t)j * 2048 * 1024, scr, r % I_GU, lane); }
            else { const int r = it - T4, j = r / I_D; transpose_item<0>(INP(I_WD) + (size_t)j * 1024 * 1024, 1024, 1024, Wd_t + (size_t)j * 1024 * 1024, scr, r % I_D, lane); }
          }
          if (MOE_FP8) {
            constexpr int NGUI = 128 * I_GU, NMOE = NGUI + 128 * I_D;
            const float* wgu = INP(I_WGU); const float* wd = INP(I_WD);
#define MOE_DEC(r_, W_, N_, WT_, IT_) do { if ((r_) < NGUI) { const int j_ = (r_) / I_GU; W_ = wgu + (size_t)j_ * 1024 * 2048; N_ = 2048; WT_ = (unsigned char*)Wgu_t + (size_t)j_ * 2048 * 1024; IT_ = (r_) % I_GU; } \
              else { const int q_ = (r_) - NGUI, j_ = q_ / I_D; W_ = wd + (size_t)j_ * 1024 * 1024; N_ = 1024; WT_ = (unsigned char*)Wd_t + (size_t)j_ * 1024 * 1024; IT_ = q_ % I_D; } } while (0)
            f32x4 vc[8], vn[8]; const float* Wc = nullptr; int Nc = 0, itc = 0; unsigned char* WTc = nullptr;
            int r = gw;
            if (r < NMOE) { MOE_DEC(r, Wc, Nc, WTc, itc); item8_load(Wc, Nc, itc, lane, vc); }
            for (; r < NMOE; r += NGW) { const int rn = r + NGW; const bool hn = rn < NMOE; const float* Wn = Wc; int Nn = Nc, itn = itc; unsigned char* WTn = WTc;
                if (hn) { MOE_DEC(rn, Wn, Nn, WTn, itn); item8_load(Wn, Nn, itn, lane, vn); }
                item8_store(vc, 1024, Nc, WTc, scr, itc, lane);
                if (hn) { Wc = Wn; Nc = Nn; itc = itn; WTc = WTn;
#pragma unroll
                    for (int i = 0; i < 8; ++i) vc[i] = vn[i]; } }
#undef MOE_DEC
          }
          }
        }
        if (PROBE_T == 12 && bid == 0 && tid == 0) *(LAS unsigned long long*)(lds + LX_MISC + 64) += __builtin_amdgcn_s_memtime() - p0t_;
        __syncthreads();
    }
    SEAM(0);

    if (PS(1) && IN(1)) { PHASE_IDS
        const float* g = INP(I_NORMG); const float* modv = WSP(float, WS_MODV); float* X = WSP(float, WS_X); bf16* H = WSP(bf16, WS_H);
        for (int row = gw; row < M; row += NGW) { const int b = row_batch(row), jj = row % RPB; const bool cx = jj < CTXL; const int rb = cx ? 16 : b;
            const float* src = cx ? INP(I_CTX) + ((size_t)b * CTXL + jj) * D : INP(I_X) + ((size_t)b * SEQ + (jj - CTXL)) * D;
            f32x4 v[4]; load_row_f32(src, lane, v);
            norm_mod_store_mix(FP8_ATT != 0, v, g, modv + rb * 6144 + 1024, modv + rb * 6144, lane, H + (size_t)row * D, WSP(unsigned char, WS_H8) + (size_t)row * 1024); }
    }
    SEAM(1);

    for (int l = 0; l < DEPTH; ++l) {
        const int pb = 2 + 7 * l; const bool attn = (l & 1) == 0; const int j2 = l >> 1; const bool lat_only = (l == DEPTH - 1);
#define MV() (WSP(float, WS_MODV) + (size_t)l * 17 * 6144)
        const unsigned* gcnt = (const unsigned*)(ctl + CW_CNT) + l * 32;

        if (IN(pb)) { PHASE_IDS
            if (PS(2) && attn) {
                constexpr int RBX = FP8_ATT ? 1024 : 2048; constexpr int SCX = FP8_ATT ? 0x78787878 : 0;
                typedef SchedQKV<RBX, SCX> SQ;
                SQ S{FP8_ATT ? (const char*)WSP(unsigned char, WS_H8) : (const char*)WSP(bf16, WS_H), (const char*)WSP(bf16, WS_WQKV) + (size_t)j2 * 3072 * RBX};
                EpiQKV E{WSP(bf16, WS_Q), WSP(bf16, WS_K), WSP(bf16, WS_VT), WSP(float, WS_ROPE), WSP(float, WS_ROPE) + 2048 * 32, true, lds + LX_EPI};
                for (int rep = 0; rep < NREP(2); ++rep) { int z_ = rep; asm volatile("" : "+s"(z_)); E.dost = !PROBE_NOST || (z_ == NREP(2) - 1); pg8::gemm_phase<EpiQKV, SQ, 2>(lds, S, E, tid, STAG(1500)); }
            } else if (PS(3)) {
                constexpr int RBX = FP8_CONV ? 1024 : 2048; constexpr int SCX = FP8_CONV ? 0x78787878 : 0;
                typedef SchedPlain<RBX, SCX> SP;
                SP S{FP8_CONV ? (const char*)WSP(unsigned char, WS_H8) : (const char*)WSP(bf16, WS_H), (const char*)WSP(bf16, WS_WIN) + (size_t)j2 * 3072 * RBX, 12, lat_only};
                if (CONV_FUSE_U) { EpiConvIn E{WSP(bf16, WS_BCO), WSP(bf16, WS_BCO) + (size_t)M * 1024};
                    for (int rep = 0; rep < NREP(3); ++rep) pg8::gemm_phase<EpiConvIn, SP, 3>(lds, S, E, tid, STAG(1500)); }
                else { EpiPlain E{WSP(bf16, WS_BCO), 3072};
                    for (int rep = 0; rep < NREP(3); ++rep) pg8::gemm_phase<EpiPlain, SP, 3>(lds, S, E, tid, STAG(1500)); }
            }
        }
        SEAM(pb);

        if (IN(pb + 1)) { PHASE_IDS
            if (PS(4) && attn) {
                const float* lamv = WSP(float, WS_MISC); const float lam = lamv[j2], osc = lamv[2 + j2]; const float* subg = INP(I_SUBG) + j2 * 128;
                const bf16* Qb = WSP(bf16, WS_Q); const bf16* Kb = WSP(bf16, WS_K); const bf16* Vt = WSP(bf16, WS_VT); bf16* Ob = WSP(bf16, WS_O);
                LAS float* wsc = (LAS float*)(lds + LX_WSC + wave * 1024);
                const int vcu = (G % 8 == 0) ? (bid % 8) * (G / 8) + bid / 8 : bid;
                for (int rep = 0; rep < NREP(4); ++rep)
                if (G == 256) {
                    const int xc = bid & 7, j = bid >> 3;
                    for (int sstep = 0; sstep < 8; ++sstep) { const int bh = xc * 16 + 2 * sstep + (j >> 4), b = bh >> 3, h = bh & 7;
                        ATT_CALL(lds, wsc, Qb, Kb, Vt, Ob, b * RPB, h, b * RPB + CTXL + (j & 15) * 128, 36, lam, osc, subg, tid); }
                    { const int bh = xc * 16 + (j >> 1), b = bh >> 3, h = bh & 7;
                      ATT_CALL(lds, wsc, Qb, Kb, Vt, Ob, b * RPB, h, b * RPB + (j & 1) * 128, 4, lam, osc, subg, tid); }
                } else {
                    for (int u = bid; u < 128 * 18; u += G) { const int bh = u / 18, k = u % 18, b = bh >> 3, h = bh & 7;
                        ATT_CALL(lds, wsc, Qb, Kb, Vt, Ob, b * RPB, h, k < 16 ? b * RPB + CTXL + k * 128 : b * RPB + (k - 16) * 128, k < 16 ? 36 : 4, lam, osc, subg, tid); }
                }
            } else if (PS(5)) {
                const float* cw = INP(I_CONVW) + (size_t)j2 * 3 * 1024; const bf16* BCO = WSP(bf16, WS_BCO); bf16* Ob = WSP(bf16, WS_O);
                const int nact = lat_only ? 32768 : M; const int nitems = (nact / 16) * 2;
                for (int it = gw; it < nitems; it += NGW) { const int strip = it >> 1, ch = (it & 1) * 512 + lane * 8; const int row0 = act_row(strip * 16, lat_only);
                    const int jj = row0 % RPB; const int seq_lo = jj < CTXL ? row0 - jj : row0 - jj + CTXL, seq_hi = jj < CTXL ? row0 - jj + CTXL : row0 - jj + RPB;
                    float w0[8], w1[8], w2[8];
#pragma unroll
                    for (int q = 0; q < 8; ++q) { w0[q] = cw[ch + q]; w1[q] = cw[1024 + ch + q]; w2[q] = cw[2048 + ch + q]; }
                    float up[8], uc[8], un[8];
                    auto load_u = [&](int row, float (&u)[8]) {
                        if (row < seq_lo || row >= seq_hi) {
#pragma unroll
                            for (int q = 0; q < 8; ++q) u[q] = 0.f;
                        } else if (CONV_FUSE_U) { const u32x4 uu = *(const u32x4*)(BCO + (size_t)M * 1024 + (size_t)row * 1024 + ch);
#pragma unroll
                            for (int q = 0; q < 4; ++q) { u[2 * q] = bf2f((unsigned short)(uu[q] & 0xffffu)); u[2 * q + 1] = bf2f((unsigned short)(uu[q] >> 16)); }
                        } else { const bf16* p = BCO + (size_t)row * 3072; const u32x4 gc = *(const u32x4*)(p + 1024 + ch), xt = *(const u32x4*)(p + 2048 + ch);
#pragma unroll
                            for (int q = 0; q < 4; ++q) { u[2 * q] = bf2f((unsigned short)(gc[q] & 0xffffu)) * bf2f((unsigned short)(xt[q] & 0xffffu)); u[2 * q + 1] = bf2f((unsigned short)(gc[q] >> 16)) * bf2f((unsigned short)(xt[q] >> 16)); } } };
                    load_u(row0 - 1, up); load_u(row0, uc);
                    for (int r = 0; r < 16; ++r) { const int row = row0 + r; load_u(row + 1, un);
                        const u32x4 gb = *(const u32x4*)(BCO + (size_t)row * (CONV_FUSE_U ? 1024 : 3072) + ch); float z[8];
#pragma unroll
                        for (int q = 0; q < 8; ++q) { const float gbv = bf2f((unsigned short)((q & 1) ? (gb[q >> 1] >> 16) : (gb[q >> 1] & 0xffffu))); z[q] = gbv * (w0[q] * up[q] + w1[q] * uc[q] + w2[q] * un[q]); }
                        if (FP8_CONV) { u32x2 o; o.x = pack_fp8x4(4.f * z[0], 4.f * z[1], 4.f * z[2], 4.f * z[3]); o.y = pack_fp8x4(4.f * z[4], 4.f * z[5], 4.f * z[6], 4.f * z[7]); *(u32x2*)((unsigned char*)Ob + (size_t)row * 1024 + ch) = o; }
                        else { u32x4 o; o.x = cvt_pk_bf16(z[0], z[1]); o.y = cvt_pk_bf16(z[2], z[3]); o.z = cvt_pk_bf16(z[4], z[5]); o.w = cvt_pk_bf16(z[6], z[7]);
                        *(u32x4*)(Ob + (size_t)row * 1024 + ch) = o; }
#pragma unroll
                        for (int q = 0; q < 8; ++q) { up[q] = uc[q]; uc[q] = un[q]; } } }
            }
        }
        SEAM(pb + 1);

        if (PS(6) && IN(pb + 2)) { PHASE_IDS
            float* X = WSP(float, WS_X);
            EpiResid E{X, X, MV() + 2 * 1024, l == 0 ? INP(I_X) : nullptr, l == 0 ? INP(I_CTX) : nullptr};
            if (attn) { constexpr int RBX = FP8_ATT_O ? 1024 : 2048; constexpr int SCX = FP8_ATT_O ? 0x79797979 : 0;
                typedef SchedPlain<RBX, SCX> SP;
                SP S{(const char*)WSP(bf16, WS_O), (const char*)WSP(bf16, WS_WO) + (size_t)j2 * 1024 * RBX, 4, lat_only};
                pg8::gemm_phase<EpiResid, SP, 6>(lds, S, E, tid, STAG(1500));
            } else { constexpr int RBX = FP8_CONV ? 1024 : 2048; constexpr int SCX = FP8_CONV ? 0x79797979 : 0;
                typedef SchedPlain<RBX, SCX> SP;
                SP S{(const char*)WSP(bf16, WS_O), (const char*)WSP(bf16, WS_WOUT) + (size_t)j2 * 1024 * RBX, 4, lat_only};
                pg8::gemm_phase<EpiResid, SP, 6>(lds, S, E, tid, STAG(1500));
            }
        }
        SEAM(pb + 2);

        if (PS(7) && IN(pb + 3)) { PHASE_IDS
            LAS int* lcnt = (LAS int*)(lds + LX_LCNT); LAS int* lbase = (LAS int*)(lds + LX_LBASE); LAS int* asg = (LAS int*)(lds + LX_ASG);
            LAS float* wsc = (LAS float*)(lds + LX_WSC + wave * 1024);
            LAS unsigned char* tile = lds;
            LAS float* part = (LAS float*)(lds + 65536);
            float* X = WSP(float, WS_X); bf16* H = WSP(bf16, WS_H); const float* mv = MV(); int* topE = WSP(int, WS_TOPE); float* topG = WSP(float, WS_TOPG); int* topP = WSP(int, WS_TOPP); int* list = WSP(int, WS_LIST);
            const int r32 = lane & 31, hi = lane >> 5;
            bf16x8 wf[8];
            { const float* rw = WSP(float, WS_RW) + (size_t)l * 32 * 1024 + r32 * 1024 + wave * 128 + hi * 8;
#pragma unroll
              for (int s8 = 0; s8 < 8; ++s8) { const f32x4 a = *(const f32x4*)(rw + 16 * s8), b = *(const f32x4*)(rw + 16 * s8 + 4); wf[s8] = __builtin_bit_cast(bf16x8, pack8(a, b)); } }
            __syncthreads();
            if (tid < 32) lcnt[tid] = 0;
            __syncthreads();
            const int nact = lat_only ? 32768 : M; const int rpb = (nact + G - 1) / G; const int a0 = bid * rpb; int nr = nact - a0; nr = nr < 0 ? 0 : (nr > rpb ? rpb : nr);
            const float* g = INP(I_NORMG) + ((size_t)l * 2 + 1) * 1024; const float* rb_ = INP(I_RB) + l * 32;
            for (int g0 = 0; g0 < nr; g0 += 32) {
                f32x4 v[4][4]; int rowq[4]; bool okq[4];
#pragma unroll
                for (int q = 0; q < 4; ++q) { const int i = g0 + wave + 8 * q; okq[q] = i < nr; rowq[q] = act_row(a0 + (okq[q] ? i : nr - 1), lat_only); load_row_x(X, (size_t)rowq[q], lane, v[q]); }
#pragma unroll
                for (int q = 0; q < 4; ++q) { const int row = rowq[q]; const int rb = row_is_ctx(row) ? 16 : row_batch(row); const int tr = wave + 8 * q;
                    norm_mod_f32(v[q], g, mv + rb * 6144 + 4 * 1024, mv + rb * 6144 + 3 * 1024, lane);
                    if (MOE_FP8) { unsigned char* h8 = WSP(unsigned char, WS_H8) + (size_t)row * 1024;
#pragma unroll
                        for (int j = 0; j < 4; ++j) { const unsigned pk_ = pack_fp8x4(16.f * v[q][j][0], 16.f * v[q][j][1], 16.f * v[q][j][2], 16.f * v[q][j][3]); if (okq[q]) *(unsigned*)(h8 + 256 * j + 4 * lane) = pk_; } }
#pragma unroll
                    for (int j = 0; j < 4; ++j) { u32x2 w; w.x = cvt_pk_bf16(v[q][j][0], v[q][j][1]); w.y = cvt_pk_bf16(v[q][j][2], v[q][j][3]);
                        if (!MOE_FP8 && okq[q]) *(u32x2*)(H + (size_t)row * D + 256 * j + 4 * lane) = w;
                        const int ch = 32 * j + (lane >> 1); *(LAS u32x2*)(tile + tr * 2048 + ((ch ^ (tr & 15)) << 4) + (lane & 1) * 8) = w; } }
                __syncthreads();
                { f32x16 acc = f32x16{};
#pragma unroll
                  for (int s8 = 0; s8 < 8; ++s8) { const int ch = wave * 16 + 2 * s8 + hi; const bf16x8 bfr = *(const LAS bf16x8*)(tile + r32 * 2048 + ((ch ^ (r32 & 15)) << 4));
                      acc = __builtin_amdgcn_mfma_f32_32x32x16_bf16(wf[s8], bfr, acc, 0, 0, 0); }
#pragma unroll
                  for (int r = 0; r < 16; ++r) { const int e = (r & 3) + 8 * (r >> 2) + 4 * hi; part[(wave * 32 + e) * 33 + r32] = acc[r]; } }
                __syncthreads();
#pragma unroll 1
                for (int q = 0; q < 4; ++q) { const int tr = wave + 8 * q; const int i = g0 + tr; const int row = rowq[q]; const int my_e = r32;
                    float lg = rb_[my_e];
#pragma unroll
                    for (int w8 = 0; w8 < 8; ++w8) lg += part[(w8 * 32 + my_e) * 33 + tr];
                    if (lane < 32) wsc[my_e] = lg;
                    asm volatile("s_waitcnt lgkmcnt(0)" ::: "memory");
                    int rank = 0;
#pragma unroll
                    for (int e = 0; e < 32; ++e) { const float o = wsc[e]; rank += (o > lg || (o == lg && e < my_e)) ? 1 : 0; }
                    asm volatile("s_waitcnt lgkmcnt(0)" ::: "memory");
                    if (lane < 32 && rank < 4) { wsc[64 + rank] = lg; ((LAS int*)wsc)[72 + rank] = my_e; }
                    asm volatile("s_waitcnt lgkmcnt(0)" ::: "memory");
                    const float t0 = wsc[64], t1 = wsc[65], t2 = wsc[66], t3 = wsc[67];
                    const float p0 = 1.f, p1 = __expf(t1 - t0), p2 = __expf(t2 - t0), p3 = __expf(t3 - t0); const float inv = 1.f / (p0 + p1 + p2 + p3);
                    if (lane < 4 && okq[q]) { const int e = ((LAS int*)wsc)[72 + lane]; const float p = lane == 0 ? p0 : lane == 1 ? p1 : lane == 2 ? p2 : p3;
                        const int lp = __hip_atomic_fetch_add(lcnt + e, 1, __ATOMIC_RELAXED, __HIP_MEMORY_SCOPE_WORKGROUP);
                        topE[row * 4 + lane] = e; topG[row * 4 + lane] = p * inv; asg[i * 4 + lane] = (lp << 5) | e; }
                    asm volatile("s_waitcnt lgkmcnt(0)" ::: "memory");
                }
            }
            __syncthreads();
            if (tid < 32) lbase[tid] = (int)__hip_atomic_fetch_add((unsigned*)gcnt + tid, (unsigned)lcnt[tid], RLX_AGENT);
            __syncthreads();
            for (int i = tid; i < nr * 4; i += NTHREADS) { const int av = asg[i], e = av & 31, pos = lbase[e] + (av >> 5); const int row = act_row(a0 + (i >> 2), lat_only);
                list[(size_t)e * CAP + pos] = row; topP[row * 4 + (i & 3)] = pos; }
            __syncthreads();
        }
        SEAM(pb + 3);

        if (PS(8) && IN(pb + 4)) { PHASE_IDS
            moe_table(lds, gcnt, tid);
            constexpr int RBM = MOE_FP8 ? 1024 : 2048;
            typedef SchedMoe<true, RBM, 0x78787878, 0x78787878> SG;
            SG S{(const char*)(MOE_FP8 ? (void*)WSP(unsigned char, WS_H8) : (void*)WSP(bf16, WS_H)), (const char*)WSP(bf16, WS_WGU) + (size_t)l * 32 * 2048 * RBM, WSP(int, WS_LIST), 8, (size_t)2048 * RBM,
                 (LAS const int*)(lds + LX_TSTART), (LAS const int*)(lds + LX_ECNT), (LAS const int*)(lds + LX_TILEE)};
            EpiSwiglu<MOE_FP8 != 0> E{WSP(bf16, WS_ACT), INP(I_BGU) + (size_t)l * 32 * 2048, lds + LX_EPI};
            pg8::gemm_phase<EpiSwiglu<MOE_FP8 != 0>, SG, 8>(lds, S, E, tid, STAG(900));
        }
        SEAM(pb + 4);

        if (PS(9) && IN(pb + 5)) { PHASE_IDS
            if (MK_PER_PHASE || lo == pb + 5) moe_table(lds, gcnt, tid);
            constexpr int RBM = MOE_FP8 ? 1024 : 2048;
            typedef SchedMoe<false, RBM, 0x79797979, 0x79797979> SD;
            SD S{(const char*)WSP(bf16, WS_ACT), (const char*)WSP(bf16, WS_WD) + (size_t)l * 32 * 1024 * RBM, WSP(int, WS_LIST), 4, (size_t)1024 * RBM,
                 (LAS const int*)(lds + LX_TSTART), (LAS const int*)(lds + LX_ECNT), (LAS const int*)(lds + LX_TILEE)};
            EpiDown E{WSP(bf16, WS_Y), INP(I_BD) + (size_t)l * 32 * 1024, lds + LX_EPI};
            pg8::gemm_phase<EpiDown, SD, 9>(lds, S, E, tid, STAG(1100));
            if (PROBE_T && l == DEPTH - 1 && bid == (PROBE_T == 10 ? PROBE_BID : 0) && tid == 0) { unsigned long long acc_ = *(LAS unsigned long long*)(lds + LX_MISC + 64); unsigned long long tot_ = __builtin_amdgcn_s_memtime() - pt_start;
                if (PROBE_T == 9) { acc_ = tot_; tot_ = (__builtin_amdgcn_s_memrealtime() - pt_rstart) * 30ull; }
                WSP(float, WS_MISC)[16] = floorf((float)((double)acc_ / (double)tot_) * PROBE_TQ + 0.5f) / PROBE_TQ; }
        }
        SEAM(pb + 5);

        if (PS(10) && IN(pb + 6)) { PHASE_IDS
            if (MK_PER_PHASE || lo >= pb + 5) moe_table(lds, gcnt, tid);
            LAS const int* tstart = (LAS const int*)(lds + LX_TSTART);
            const int nact = lat_only ? 32768 : M;
            const float* gn = (l + 1 < DEPTH) ? INP(I_NORMG) + (size_t)(l + 1) * 2 * 1024 : INP(I_FINALG);
            const float* mv = MV(); const float* mvn = mv + 17 * 6144; float* X = WSP(float, WS_X); bf16* H = WSP(bf16, WS_H); const bf16* Yb = WSP(bf16, WS_Y);
            const int* topE = WSP(int, WS_TOPE); const float* topG = WSP(float, WS_TOPG); const int* topP = WSP(int, WS_TOPP);
            for (int ai = gw; ai < nact; ai += 2 * NGW) {
                int row[2]; bool ok[2]; int4 ev[2], pv[2]; f32x4 gv[2];
#pragma unroll
                for (int u = 0; u < 2; ++u) { const int a2 = ai + u * NGW; ok[u] = a2 < nact; row[u] = act_row(ok[u] ? a2 : ai, lat_only);
                    ev[u] = *(const int4*)(topE + row[u] * 4); pv[u] = *(const int4*)(topP + row[u] * 4); gv[u] = *(const f32x4*)(topG + row[u] * 4); }
                f32x4 v[2][4]; u32x2 yw[2][4][4];
#pragma unroll
                for (int u = 0; u < 2; ++u) { load_row_x(X, (size_t)row[u], lane, v[u]);
                    const int ee[4] = {ev[u].x, ev[u].y, ev[u].z, ev[u].w}, pp[4] = {pv[u].x, pv[u].y, pv[u].z, pv[u].w};
#pragma unroll
                    for (int k = 0; k < 4; ++k) { const size_t yrow = (size_t)(tstart[ee[k]] * 256 + pp[k]);
#pragma unroll
                        for (int j = 0; j < 4; ++j) { if (Y_FP8) { yw[u][k][j].x = *(const unsigned*)((const unsigned char*)Yb + yrow * 1024 + 256 * j + 4 * lane); yw[u][k][j].y = 0u; }
                            else yw[u][k][j] = *(const u32x2*)(Yb + yrow * 1024 + 256 * j + 4 * lane); } } }
#pragma unroll
                for (int u = 0; u < 2; ++u) { if (!ok[u]) continue;
                    const int rw_ = row[u]; const bool cx = row_is_ctx(rw_); const int rb = cx ? 16 : row_batch(rw_);
                    f32x4 acc4[4];
#pragma unroll
                    for (int j = 0; j < 4; ++j) acc4[j] = (f32x4){0.f, 0.f, 0.f, 0.f};
#pragma unroll
                    for (int k = 0; k < 4; ++k) { const float gk = gv[u][k];
#pragma unroll
                        for (int j = 0; j < 4; ++j) { const u32x2 w = yw[u][k][j];
                            if (Y_FP8) { const f32x2 lo = __builtin_amdgcn_cvt_pk_f32_fp8((int)w.x, false), hi2 = __builtin_amdgcn_cvt_pk_f32_fp8((int)w.x, true); const float g16 = gk * (1.f / 16.f);
                                acc4[j][0] += g16 * lo[0]; acc4[j][1] += g16 * lo[1]; acc4[j][2] += g16 * hi2[0]; acc4[j][3] += g16 * hi2[1]; }
                            else { acc4[j][0] += gk * bf2f((unsigned short)(w.x & 0xffffu)); acc4[j][1] += gk * bf2f((unsigned short)(w.x >> 16)); acc4[j][2] += gk * bf2f((unsigned short)(w.y & 0xffffu)); acc4[j][3] += gk * bf2f((unsigned short)(w.y >> 16)); } } }
                    const float* g2 = mv + rb * 6144 + 5 * 1024;
#pragma unroll
                    for (int j = 0; j < 4; ++j) { const f32x4 gg = *(const f32x4*)(g2 + 256 * j + 4 * lane); v[u][j] = v[u][j] + gg * acc4[j]; }
                    if (l + 1 < DEPTH) {
                        store_row_x(X, (size_t)rw_, lane, v[u]);
                        if (!(l + 1 == DEPTH - 1 && cx))
                            norm_mod_store_mix(((l + 1) & 1) ? (FP8_CONV != 0) : (FP8_ATT != 0), v[u], gn, mvn + rb * 6144 + 1024, mvn + rb * 6144, lane, H + (size_t)rw_ * D, WSP(unsigned char, WS_H8) + (size_t)rw_ * 1024);
                    } else {
                        float rstd = row_rstd(v[u]); if (PROBE_T) rstd *= 1.f + sqrtf(WSP(float, WS_MISC)[16]); float* op = OUTP() + ((size_t)row_batch(rw_) * SEQ + (rw_ % RPB - CTXL)) * D;
#pragma unroll
                        for (int j = 0; j < 4; ++j) { const f32x4 gg = *(const f32x4*)(gn + 256 * j + 4 * lane); *(f32x4*)(op + 256 * j + 4 * lane) = (v[u][j] * rstd) * gg; }
                    }
                }
            }
        }
        if (l + 1 < DEPTH) SEAM(pb + 6);
    }
#undef IN
#undef SEAM
#undef MV
}

extern "C" void kernel_launch(void* const* d_in, const int* in_sizes, int n_in, void* d_out, int out_size, void* d_ws, size_t ws_size, hipStream_t stream) {
    static int grid = 0;
    if (grid == 0) {
        if (n_in != 21 || out_size != NB * SEQ * D || ws_size < WS_END) { fprintf(stderr, "kernel_launch: unexpected shapes (n_in %d, out %d, ws %zu)\n", n_in, out_size, ws_size); grid = -1; return; }
        int dev = 0, cus = 0, per_cu = 0;
        if (hipGetDevice(&dev) != hipSuccess || hipDeviceGetAttribute(&cus, hipDeviceAttributeMultiprocessorCount, dev) != hipSuccess) { grid = -1; return; }
        if (hipFuncSetAttribute((const void*)fwd, hipFuncAttributeMaxDynamicSharedMemorySize, LDS_BYTES) != hipSuccess) { fprintf(stderr, "kernel_launch: hipFuncSetAttribute failed\n"); grid = -1; return; }
        if (hipOccupancyMaxActiveBlocksPerMultiprocessor(&per_cu, (const void*)fwd, NTHREADS, LDS_BYTES) != hipSuccess || per_cu < 1) { fprintf(stderr, "kernel_launch: occupancy query says %d\n", per_cu); }
        (void)hipGetLastError();
        if (cus < 160) { fprintf(stderr, "kernel_launch: needs >= 160 CUs\n"); grid = -1; return; }
        grid = cus;
    }
    if (grid < 0) return;
    if (hipMemsetAsync((char*)d_ws + WS_CTL, 0, CTL_ZERO_BYTES, stream) != hipSuccess) return;
    Args a{};
    for (int i = 0; i < 21; ++i) a.in[i] = (const float*)d_in[i];
    a.out = (float*)d_out; a.ws = (unsigned char*)d_ws;
#if MK_PER_PHASE
    for (int p = 0; p < NPHASE; ++p) { a.ph_lo = p; a.ph_hi = p + 1; hipLaunchKernelGGL(fwd, dim3(grid), dim3(NTHREADS), LDS_BYTES, stream, a); }
#else
    a.ph_lo = 0; a.ph_hi = NPHASE;
    hipLaunchKernelGGL(fwd, dim3(grid), dim3(NTHREADS), LDS_BYTES, stream, a);
#endif
    const hipError_t le = hipPeekAtLastError();
    if (le != hipSuccess) fprintf(stderr, "kernel_launch: launch failed: %s\n", hipGetErrorName(le));
}
```

```cpp
#include <hip/hip_runtime.h>
#include <cstdio>
#include <cstdint>

#ifndef MK_PER_PHASE
#define MK_PER_PHASE 0
#endif

#ifndef MOE_FP8
#define MOE_FP8 1
#endif
#ifndef STAGGER
#define STAGGER 0
#endif
#define STAG(t) (STAGGER ? (t) : 0)
#ifndef PROBE_T
#define PROBE_T 0
#endif
#ifndef PROBE_TQ
#define PROBE_TQ 30.f
#endif
#ifndef ATT_PROBE_TID
#define ATT_PROBE_TID 0
#endif
#ifndef PROBE_BID
#define PROBE_BID 0
#endif
#ifndef PROBE_TPH
#define PROBE_TPH 8
#endif
#ifndef FP8_ATT
#define FP8_ATT 1
#endif
#ifndef FP8_ATT_O
#define FP8_ATT_O 1
#endif
#ifndef FP8_WOUT
#define FP8_WOUT 1
#endif
#ifndef FP8_CONV
#define FP8_CONV 0
#endif
#ifndef X_BF16
#define X_BF16 1
#endif
#ifndef Y_FP8
#define Y_FP8 1
#endif
#ifndef CONV_FUSE_U
#define CONV_FUSE_U 1
#endif
#ifndef ATT_FP8
#define ATT_FP8 1
#endif
#ifndef PHSEL
#define PHSEL 0xffff
#endif
#define PS(k) ((PHSEL >> (k)) & 1)
#ifndef PROBE_REP
#define MOE_XCD_RANGE 1
#define PROBE_REP 0
#endif
#define NREP(k) (1 + ((PROBE_REP >> (k)) & 1))
#ifndef PROBE_NOST
#define PROBE_NOST 0
#endif
#define GAS __attribute__((address_space(1)))
#define LAS __attribute__((address_space(3)))
typedef unsigned short bf16;
typedef short bf16x8 __attribute__((ext_vector_type(8)));
typedef float f32x4 __attribute__((ext_vector_type(4)));
typedef float f32x2 __attribute__((ext_vector_type(2)));
typedef float f32x16 __attribute__((ext_vector_type(16)));
typedef unsigned u32x4 __attribute__((ext_vector_type(4)));
typedef unsigned u32x2 __attribute__((ext_vector_type(2)));
typedef GAS unsigned gu32;

constexpr int D = 1024, NB = 16, SEQ = 2048, CTXL = 256, RPB = SEQ + CTXL, M = NB * RPB, DEPTH = 4;
constexpr int NE = 32, TOPK = 4, NMOD = 6;
constexpr int CAP = M;
constexpr int ACT_ROWS = M * TOPK + NE * 256;
constexpr float EPS = 1e-5f;
constexpr float C2 = 0.125f * 1.4426950408889634f;
constexpr int NPHASE = 2 + 7 * DEPTH;
static_assert(!(FP8_CONV && CONV_FUSE_U), "the fused u epilogue needs the (bf16) interleaved copy of conv_w_in");

constexpr size_t MiB = 1u << 20;
constexpr size_t WS_CTL = 0, CTL_ZERO_BYTES = 1 * MiB;
constexpr size_t WS_MODV = 1 * MiB;
constexpr size_t WS_ROPE = 3 * MiB;
constexpr size_t WS_RW = 4 * MiB;
constexpr size_t WS_MISC = 5 * MiB;
constexpr size_t WS_TOPE = 6 * MiB;
constexpr size_t WS_TOPG = 7 * MiB;
constexpr size_t WS_TOPP = 8 * MiB;
constexpr size_t WS_LIST = 9 * MiB;
constexpr size_t WS_WQKV = 16 * MiB;
constexpr size_t WS_WIN = 28 * MiB;
constexpr size_t WS_WO = 40 * MiB;
constexpr size_t WS_WOUT = 44 * MiB;
constexpr size_t WS_WGU = 48 * MiB;
constexpr size_t WS_WD = 560 * MiB;
constexpr size_t WS_X = 816 * MiB;
constexpr size_t WS_H = 960 * MiB;
constexpr size_t WS_Q = 1032 * MiB;
constexpr size_t WS_K = 1104 * MiB;
constexpr size_t WS_VT = 1176 * MiB;
constexpr size_t WS_BCO = WS_Q;
constexpr size_t WS_O = 1248 * MiB;
constexpr size_t WS_ACT = 1320 * MiB;
constexpr size_t WS_Y = 1624 * MiB;
constexpr size_t WS_H8 = 1928 * MiB;
constexpr size_t WS_END = 1964 * MiB;
static_assert((size_t)M * 3072 * 2 == 216 * MiB && (size_t)ACT_ROWS * 2048 == 304 * MiB && (size_t)M * 4096 == 144 * MiB, "ws map");

constexpr int CW_TMO = 0;
constexpr int CW_BAR = 4096;
constexpr int CW_CNT = 16384;

constexpr int RING_BYTES = 131072;
constexpr int LX = RING_BYTES;
constexpr int LX_MISC = LX + 0;
constexpr int LX_TSTART = LX + 256;
constexpr int LX_ECNT = LX + 512;
constexpr int LX_LCNT = LX + 640;
constexpr int LX_LBASE = LX + 768;
constexpr int LX_TILEE = LX + 1024;
constexpr int LX_WSC = LX + 4096;
constexpr int LX_ASG = LX + 12288;
constexpr int LX_EPI = LX + 16384;
constexpr int LDS_BYTES = LX + 32768;
constexpr int NWAVES = 8, NTHREADS = 512;

#define RLX_AGENT __ATOMIC_RELAXED, __HIP_MEMORY_SCOPE_AGENT
__device__ __forceinline__ unsigned f2bf(float f) { unsigned u = __builtin_bit_cast(unsigned, f); return (u + 0x7fffu + ((u >> 16) & 1u)) >> 16; }
typedef __bf16 bf16x2_t __attribute__((ext_vector_type(2)));
__device__ __forceinline__ unsigned cvt_pk_bf16(float lo, float hi) { const f32x2 v = {lo, hi}; const bf16x2_t b = __builtin_convertvector(v, bf16x2_t); return __builtin_bit_cast(unsigned, b); }
__device__ __forceinline__ float bf2f(unsigned short b) { return __builtin_bit_cast(float, (unsigned)b << 16); }
__device__ __forceinline__ float wave_sum(float v) {
    v += __builtin_bit_cast(float, __builtin_amdgcn_update_dpp(0, __builtin_bit_cast(int, v), 0xB1, 0xF, 0xF, true));
    v += __builtin_bit_cast(float, __builtin_amdgcn_update_dpp(0, __builtin_bit_cast(int, v), 0x4E, 0xF, 0xF, true));
    v += __builtin_bit_cast(float, __builtin_amdgcn_update_dpp(0, __builtin_bit_cast(int, v), 0x124, 0xF, 0xF, true));
    v += __builtin_bit_cast(float, __builtin_amdgcn_update_dpp(0, __builtin_bit_cast(int, v), 0x128, 0xF, 0xF, true));
    v += __shfl_xor(v, 16);
    auto rr = __builtin_amdgcn_permlane32_swap(__float_as_uint(v), __float_as_uint(v), false, false);
    return __uint_as_float(rr[0]) + __uint_as_float(rr[1]);
}

#define XB_TMO      128
#define XB_XCNT(j)  (256  + 64 * (j))
#define XB_XSUB(j)  (1280 + 64 * (j))
#define XB_XGEN(j)  (2304 + 64 * (j))
#define XB_TOP      3328
#define XB_TOPGEN   3392
#define XCD_BAR_WORDS 3456
#define XB_SPIN_CAP (1u << 18)
__device__ __forceinline__ unsigned xb_ld(unsigned* p)              { return __hip_atomic_load(p, __ATOMIC_RELAXED, __HIP_MEMORY_SCOPE_AGENT); }
__device__ __forceinline__ unsigned xb_add(unsigned* p, unsigned v) { return __hip_atomic_fetch_add(p, v, __ATOMIC_RELAXED, __HIP_MEMORY_SCOPE_AGENT); }
__device__ __forceinline__ unsigned xb_xcc_id() { return (unsigned)__builtin_amdgcn_s_getreg((3 << 11) | 20) & 0xFu; }
#define XB_SPIN(cond, bar) do { unsigned _sp = 0; while (cond) { __builtin_amdgcn_s_sleep(1); \
    if ((++_sp & 255u) == 0u) { if (xb_ld(&(bar)[XB_TMO])) break; if (_sp > XB_SPIN_CAP) { atomicAdd(&(bar)[XB_TMO], 1u); break; } } } } while (0)
struct XcdBarrier { unsigned* bar; unsigned x; volatile LAS unsigned* st; };
__device__ __forceinline__ XcdBarrier xcd_barrier_post(unsigned* bar, volatile LAS unsigned* st) {
    XcdBarrier b; b.bar = bar; b.x = xb_xcc_id(); b.st = st;
    if (threadIdx.x == 0) (void)xb_add(&bar[XB_XCNT(b.x)], 1u);
    return b;
}
__device__ __forceinline__ void xcd_barrier_complete(unsigned* bar, unsigned x, unsigned& nloc, unsigned& nx) {
    const unsigned G = gridDim.x * gridDim.y * gridDim.z;
    unsigned sum, cnt, mine, sp = 0u;
    for (;;) {
        sum = 0u; cnt = 0u; mine = 0u;
#pragma unroll
        for (unsigned j = 0; j < 16; ++j) { const unsigned c = xb_ld(&bar[XB_XCNT(j)]); sum += c; cnt += (c > 0u) ? 1u : 0u; mine = (j == x) ? c : mine; }
        if (sum == G) break;
        __builtin_amdgcn_s_sleep(1);
        if ((++sp & 255u) == 0u) { if (xb_ld(&bar[XB_TMO])) break; if (sp > XB_SPIN_CAP) { atomicAdd(&bar[XB_TMO], 1u); break; } }
    }
    nloc = mine > 0u ? mine : 1u; nx = cnt > 0u ? cnt : 1u;
}
__device__ __forceinline__ void xcd_barrier(const XcdBarrier& b) {
    asm volatile("s_waitcnt vmcnt(0)" ::: "memory");
    __syncthreads();
    if (threadIdx.x == 0) {
        unsigned* bar = b.bar; unsigned bx = b.x;
        asm volatile("" : "+s"(bar), "+s"(bx));
        __builtin_amdgcn_s_waitcnt(0);
        unsigned nloc = b.st[0], nx = b.st[1];
        if (nloc == 0u) { xcd_barrier_complete(bar, bx, nloc, nx); b.st[0] = nloc; b.st[1] = nx; }
        const unsigned old = xb_add(&bar[XB_XSUB(bx)], 1u);
        const unsigned gen = old / nloc;
        if (old + 1u == (gen + 1u) * nloc) {
            __builtin_amdgcn_fence(__ATOMIC_RELEASE, "agent");
            asm volatile("s_waitcnt vmcnt(0)" ::: "memory");
            const unsigned og = xb_add(&bar[XB_TOP], 1u);
            const unsigned tg = og / nx;
            if (og + 1u == (tg + 1u) * nx) xb_add(&bar[XB_TOPGEN], 1u);
            else XB_SPIN(xb_ld(&bar[XB_TOPGEN]) == tg, bar);
            __builtin_amdgcn_fence(__ATOMIC_ACQUIRE, "agent");
            xb_add(&bar[XB_XGEN(bx)], 1u);
            asm volatile("s_waitcnt vmcnt(0)" ::: "memory");
        } else {
            XB_SPIN(xb_ld(&bar[XB_XGEN(bx)]) == gen, bar);
            __builtin_amdgcn_fence(__ATOMIC_ACQUIRE, "agent");
            asm volatile("s_waitcnt vmcnt(0)" ::: "memory");
        }
    }
    __syncthreads();
}

namespace pg8 {
constexpr int BM = 256, BK = 64, HALF = 128, HTB = HALF * BK * 2, STAGE_BYTES = 8 * HTB, KD = 1024;
__host__ __device__ __forceinline__ int lds_byte(int r, int c) { const int st = (r >> 4) * 2 + (c >> 5), rr = r & 15, cc = c & 31, ob = rr * 64 + cc * 2; return st * 1024 + (ob ^ (((ob >> 9) & 1) << 5)); }
__host__ __device__ __forceinline__ void stage_rc(int b, int& R, int& C) { const int st = b / 1024, sb = b % 1024, swz = sb ^ (((sb >> 9) & 1) << 5); R = (st >> 1) * 16 + swz / 64; C = (st & 1) * 32 + (swz % 64) / 2; }
__host__ __device__ __forceinline__ int perm32(int rho) { const int n = rho >> 4, i = rho & 15; return 8 * (i >> 2) + 4 * n + (i & 3); }

struct Unit { int pm, pn, e, kind; };
typedef int v8i __attribute__((ext_vector_type(8)));
typedef int v4i __attribute__((ext_vector_type(4)));
__device__ __forceinline__ v8i cat8(bf16x8 lo, bf16x8 hi) { const v4i a = __builtin_bit_cast(v4i, lo), b = __builtin_bit_cast(v4i, hi); return __builtin_shufflevector(a, b, 0, 1, 2, 3, 4, 5, 6, 7); }

__device__ __forceinline__ bool deal(int i, int npu, int ntiles, int& mt, int& r) {
    const int G = gridDim.x, c = blockIdx.x;
    if ((G & 7) == 0) { const int x = c & 7, q = i * (G >> 3) + (c >> 3); mt = (q / npu) * 8 + x; r = q % npu; }
    else { const int L = i * G + c; mt = L / npu; r = L % npu; }
    return mt < ntiles;
}

__device__ __forceinline__ void mfma8(f32x4& acc, const v8i a, const v8i b, int sc) {
    asm volatile("v_mfma_scale_f32_16x16x128_f8f6f4 %0, %1, %2, %0, %3, %3 op_sel_hi:[0,0,0]" : "+v"(acc) : "v"(a), "v"(b), "v"(sc)); }
__device__ __forceinline__ void glds16s(const char* sbase, unsigned voff, unsigned lds_dst) { unsigned keep;
    asm volatile("s_mov_b32 %0, m0\n\ts_mov_b32 m0, %3\n\ts_nop 0\n\tglobal_load_lds_dwordx4 %1, %2\n\ts_mov_b32 m0, %0" : "=&s"(keep) : "v"(voff), "s"(sbase), "s"(lds_dst) : "memory"); }
template <class Epi, class Sched, int PH = 0>
__device__ __forceinline__ void gemm_phase(LAS unsigned char* lds, const Sched& S, const Epi& E, const int tid, const int stagger_ticks = 0) {
    const int wid = __builtin_amdgcn_readfirstlane(tid >> 6), lane = tid & 63, wr = wid >> 2, wc = wid & 3, fr = lane & 15, fq = lane >> 4;
    constexpr int RB = Sched::RB, nt = RB / 128;
    constexpr bool F8 = (RB == 1024);
    unsigned voffB[2];
#pragma unroll
    for (int i = 0; i < 2; ++i) { int R_, C_; stage_rc(tid * 16 + i * 8192, R_, C_); const int Rb = (R_ & ~31) + perm32(R_ & 31); voffB[i] = (unsigned)(Rb * RB + C_ * 2); }
    constexpr bool GA = Sched::GATHER;
    constexpr int NH = GA ? 2 : 1;
    constexpr size_t kstep = (size_t)(BK * 2);
    constexpr size_t hstep = (size_t)HALF * RB, bstep = hstep;
    const unsigned ldsw = (unsigned)wid * 1024u, lds0 = (unsigned)(uintptr_t)lds;
    const int aoff = lds_byte(wr * 64 + fr, fq * 8), boff = lds_byte(wc * 32 + fr, fq * 8);
#define PG8_SA(b, h) (((b) * 2 + (h)) * HTB)
#define PG8_SB(b, h) ((4 + (b) * 2 + (h)) * HTB)
#define PG8_STAGE(bufoff, gbase, voff) do { _Pragma("unroll") for (int _i = 0; _i < 2; ++_i) \
        glds16s((const char*)(gbase), (voff)[_i], (unsigned)__builtin_amdgcn_readfirstlane(lds0 + (unsigned)(bufoff) + ldsw + _i * 8192u)); } while (0)
#define PG8_LDA(dst, b, h) do { _Pragma("unroll") for (int m = 0; m < 4; ++m) _Pragma("unroll") for (int k = 0; k < 2; ++k) dst[m][k] = *(const LAS bf16x8*)(lds + PG8_SA(b, h) + aoff + m * 2048 + k * 1024); } while (0)
#define PG8_LDB(dst, b, h) do { _Pragma("unroll") for (int n = 0; n < 2; ++n) _Pragma("unroll") for (int k = 0; k < 2; ++k) dst[n][k] = *(const LAS bf16x8*)(lds + PG8_SB(b, h) + boff + n * 2048 + k * 1024); } while (0)
#define PG8_MMA(ai, bj, At, Bt) do { __builtin_amdgcn_s_setprio(1); _Pragma("unroll") for (int m = 0; m < 4; ++m) _Pragma("unroll") for (int n = 0; n < 2; ++n) { \
        if constexpr (F8) mfma8(acc[ai][bj][m][n], cat8(Bt[n][0], Bt[n][1]), cat8(At[m][0], At[m][1]), sc8); \
        else { _Pragma("unroll") for (int k = 0; k < 2; ++k) acc[ai][bj][m][n] = __builtin_amdgcn_mfma_f32_16x16x32_bf16(Bt[n][k], At[m][k], acc[ai][bj][m][n], 0, 0, 0); } } __builtin_amdgcn_s_setprio(0); } while (0)
#define PG8_WAIT_V(n) asm volatile("s_waitcnt vmcnt(" #n ")" ::: "memory")
#define PG8_WAIT_VF do { if (fe) { if constexpr (Epi::NST == 16 && !PROBE_NOST) PG8_WAIT_V(24); else if constexpr (Epi::NST == 4 && !PROBE_NOST) PG8_WAIT_V(12); else if constexpr (Epi::NST == 8 && !PROBE_NOST) PG8_WAIT_V(16); else PG8_WAIT_V(8); } else PG8_WAIT_V(8); } while (0)
#define PG8_WAIT_L(n) asm volatile("s_waitcnt lgkmcnt(" #n ")" ::: "memory")
#define PG8_BAR __builtin_amdgcn_s_barrier()
#define PG8_SCHED __builtin_amdgcn_sched_barrier(0)
    Unit cur, nxt; int ui = 0;
    if (!S.next(0, cur)) return;
#define PT_ON(r) (PROBE_T == (r) && PH == PROBE_TPH)
#define PT_BEG(r) do { if (PT_ON(r)) pt0_ = __builtin_amdgcn_s_memtime(); } while (0)
#define PT_END(r) do { if (PT_ON(r)) { const unsigned long long d_ = __builtin_amdgcn_s_memtime() - pt0_; if (blockIdx.x == 0 && tid == 0) *(LAS unsigned long long*)(lds + LX_MISC + 64) += d_; } } while (0)
    unsigned long long pt0_ = 0; (void)pt0_;
    PT_BEG(3);
    if (stagger_ticks > 0 && (int)(blockIdx.x >> 3) >= (int)(gridDim.x >> 4)) { const unsigned long long t0_ = __builtin_amdgcn_s_memrealtime(); while ((long long)(__builtin_amdgcn_s_memrealtime() - t0_) < (long long)stagger_ticks) __builtin_amdgcn_s_sleep(16); }
    static_assert(Sched::SCALE_A == Sched::SCALE_B, "one scale register");
    int sc8 = Sched::SCALE_A; asm volatile("" : "+v"(sc8));
    f32x4 acc[2][2][4][2];
#pragma unroll
    for (int a = 0; a < 2; ++a)
#pragma unroll
        for (int b = 0; b < 2; ++b)
#pragma unroll
            for (int m = 0; m < 4; ++m)
#pragma unroll
                for (int n = 0; n < 2; ++n) acc[a][b][m][n] = (f32x4){0.f, 0.f, 0.f, 0.f};
    bf16x8 At[4][2], B0[2][2], B1[2][2];
    constexpr int NI = GA ? 1 : 2;
    unsigned vC[NH][NI], vN[NH][NI];
    unsigned cb2[2];
#pragma unroll
    for (int i = 0; i < 2; ++i) { int R_, C_; stage_rc(tid * 16 + i * 8192, R_, C_); cb2[i] = (unsigned)(C_ * 2); }
    const unsigned idx_slot = (unsigned)__builtin_amdgcn_readfirstlane((unsigned)(uintptr_t)(lds + LX_WSC) + (unsigned)wid * 1024u);
    if constexpr (GA) { S.idx_dma(cur, lane, idx_slot); asm volatile("s_waitcnt vmcnt(0)" ::: "memory"); S.a_offs_lds(cur, tid, vC, (LAS const int*)(lds + LX_WSC + wid * 1024)); }
    else S.a_offs(cur, tid, vC);
    const unsigned bias_slot0 = (unsigned)(uintptr_t)(lds + LX_ASG);
    if constexpr (Epi::BIAS_DMA) { Unit n1_; const bool h1_ = S.next(1, n1_);
        if (wid == 0) { glds16s((const char*)E.bias_src(cur), (unsigned)lane * 16u, (unsigned)__builtin_amdgcn_readfirstlane(bias_slot0));
            if (h1_) glds16s((const char*)E.bias_src(n1_), (unsigned)lane * 16u, (unsigned)__builtin_amdgcn_readfirstlane(bias_slot0 + 1024u)); } }
    auto acc_init = [&](int slot) {
        if constexpr (Epi::BIAS_DMA) { int fq2 = fq; asm volatile("" : "+v"(fq2)); LAS const float* bl_ = (LAS const float*)(lds + LX_ASG + slot * 1024); f32x4 bv_[2][2];
            _Pragma("unroll") for (int bj = 0; bj < 2; ++bj) { const int col = bj * 128 + wc * 32 + fq2 * 8; bv_[bj][0] = *(const LAS f32x4*)(bl_ + col); bv_[bj][1] = *(const LAS f32x4*)(bl_ + col + 4);
                if constexpr (Epi::BIAS_MUL != 1.f) { bv_[bj][0] *= Epi::BIAS_MUL; bv_[bj][1] *= Epi::BIAS_MUL; }
                if constexpr (Epi::GATE_COLS) { bv_[bj][0][0] *= Epi::GATE_MUL; bv_[bj][0][2] *= Epi::GATE_MUL; bv_[bj][1][0] *= Epi::GATE_MUL; bv_[bj][1][2] *= Epi::GATE_MUL; } }
            _Pragma("unroll") for (int a = 0; a < 2; ++a) _Pragma("unroll") for (int b = 0; b < 2; ++b) _Pragma("unroll") for (int m = 0; m < 4; ++m) _Pragma("unroll") for (int n = 0; n < 2; ++n) acc[a][b][m][n] = bv_[b][n]; }
        else { _Pragma("unroll") for (int a = 0; a < 2; ++a) _Pragma("unroll") for (int b = 0; b < 2; ++b) _Pragma("unroll") for (int m = 0; m < 4; ++m) _Pragma("unroll") for (int n = 0; n < 2; ++n) acc[a][b][m][n] = (f32x4){0.f, 0.f, 0.f, 0.f}; } };
#define PG8_HA(h) (GA ? 0 : (h) * hstep)
#define PG8_VH(v, h) (v)[GA ? (h) : 0]
#define PG8_STAGE_A(bufoff, gbase, vv) do { _Pragma("unroll") for (int _i = 0; _i < 2; ++_i) { unsigned o_; if constexpr (GA) o_ = (((vv)[0] >> (16 * _i)) & 0xffffu) * (unsigned)RB + cb2[_i]; else o_ = (vv)[NI - 2 + _i]; \
        glds16s((const char*)(gbase), o_, (unsigned)__builtin_amdgcn_readfirstlane(lds0 + (unsigned)(bufoff) + ldsw + _i * 8192u)); } } while (0)
    const char* cA = S.a_base(cur); const char* cB = S.b_base(cur);
    PG8_STAGE(PG8_SB(0, 0), cB, voffB); PG8_STAGE(PG8_SB(0, 1), cB + bstep, voffB); PG8_STAGE_A(PG8_SA(0, 0), cA, vC[0]); PG8_STAGE_A(PG8_SA(0, 1), cA + PG8_HA(1), PG8_VH(vC, 1));
    if (wr == 1) PG8_BAR;
    PG8_WAIT_V(2); PG8_BAR;
    PG8_STAGE(PG8_SB(1, 0), cB + kstep, voffB); PG8_STAGE_A(PG8_SA(1, 0), cA + kstep, vC[0]); PG8_STAGE(PG8_SB(1, 1), cB + bstep + kstep, voffB);
    PG8_WAIT_V(6); PG8_BAR;
    if constexpr (Epi::BIAS_DMA) acc_init(0);
    for (;;) {
        const bool has_next = S.next(ui + 1, nxt);
        const char* nA = cA; const char* nB = cB;
#pragma unroll
        for (int h = 0; h < NH; ++h)
#pragma unroll
            for (int i = 0; i < NI; ++i) vN[h][i] = vC[h][i];
        if (has_next) { if constexpr (GA) S.idx_dma(nxt, lane, idx_slot); else S.a_offs(nxt, tid, vN); nA = S.a_base(nxt); nB = S.b_base(nxt); }
        if constexpr (Epi::BIAS_DMA) { if (ui > 0 && has_next && wid == 0) glds16s((const char*)E.bias_src(nxt), (unsigned)lane * 16u, (unsigned)__builtin_amdgcn_readfirstlane(bias_slot0 + (unsigned)((ui + 1) & 1) * 1024u)); }
        PT_BEG(2);
#pragma unroll 1
        for (int t = 0; t < nt; t += 2) {
            const bool last = (t == nt - 2);
            const char* a1 = cA + (size_t)(t + 1) * kstep;
            const char* a2 = last ? nA : cA + (size_t)(t + 2) * kstep; const char* b2 = last ? nB : cB + (size_t)(t + 2) * kstep;
            const char* a3 = a2 + kstep; const char* b3 = b2 + kstep;
            if constexpr (GA) { if (last && has_next) S.a_offs_lds(nxt, tid, vN, (LAS const int*)(lds + LX_WSC + wid * 1024)); }
            unsigned w0[NI], w1[NI];
#pragma unroll
            for (int i = 0; i < NI; ++i) { w0[i] = last ? vN[0][i] : vC[0][i]; w1[i] = last ? PG8_VH(vN, 1)[i] : PG8_VH(vC, 1)[i]; }
            const bool fe = (t == 0) && (ui > 0);
            PG8_LDB(B0, 0, 0); PG8_LDB(B1, 0, 1); PG8_SCHED; PG8_LDA(At, 0, 0); if (!fe) PG8_STAGE_A(PG8_SA(1, 1), a1 + PG8_HA(1), PG8_VH(vC, 1));
            PG8_WAIT_VF; PG8_WAIT_L(0); PG8_BAR; PG8_MMA(0, 0, At, B0); PG8_MMA(0, 1, At, B1); PG8_BAR; PG8_SCHED;
            PG8_LDA(At, 0, 1); PG8_STAGE(PG8_SB(0, 0), b2, voffB); PG8_STAGE(PG8_SB(0, 1), b2 + bstep, voffB); PG8_STAGE_A(PG8_SA(0, 0), a2, w0);
            PG8_WAIT_VF; PG8_WAIT_L(0); PG8_BAR; PG8_MMA(1, 0, At, B0); PG8_MMA(1, 1, At, B1); PG8_BAR; PG8_SCHED;
            PG8_LDB(B0, 1, 0); PG8_LDB(B1, 1, 1); PG8_SCHED; PG8_LDA(At, 1, 0); PG8_STAGE_A(PG8_SA(0, 1), a2 + PG8_HA(1), w1);
            PG8_WAIT_VF; PG8_WAIT_L(0); PG8_BAR; PG8_MMA(0, 0, At, B0); PG8_MMA(0, 1, At, B1); PG8_BAR; PG8_SCHED;
            PG8_LDA(At, 1, 1); PG8_STAGE(PG8_SB(1, 0), b3, voffB); PG8_STAGE(PG8_SB(1, 1), b3 + bstep, voffB); PG8_STAGE_A(PG8_SA(1, 0), a3, w0);
            PG8_WAIT_V(8); PG8_WAIT_L(0); PG8_BAR; PG8_MMA(1, 0, At, B0); PG8_MMA(1, 1, At, B1); PG8_BAR; PG8_SCHED;
        }
        PT_END(2);
        if (has_next) PG8_STAGE_A(PG8_SA(1, 1), nA + kstep + PG8_HA(1), PG8_VH(vN, 1));
        if (wr == 0) PG8_BAR;
        PT_BEG(1);
        if constexpr (Epi::BIAS_DMA) E(acc, cur, wr, wc, fr, fq, (LAS const float*)(lds + LX_ASG + (ui & 1) * 1024)); else E(acc, cur, wr, wc, fr, fq);
        PT_END(1);
        if (!has_next) break;
        acc_init((ui + 1) & 1);
        cur = nxt; cA = nA; cB = nB; ++ui;
#pragma unroll
        for (int h = 0; h < NH; ++h)
#pragma unroll
            for (int i = 0; i < NI; ++i) vC[h][i] = vN[h][i];
        if (wr == 1) PG8_BAR;
    }
    PG8_WAIT_V(0);
    PG8_BAR;
    PT_END(3);
#undef PT_ON
#undef PT_BEG
#undef PT_END
#undef PG8_SA
#undef PG8_HA
#undef PG8_VH
#undef PG8_SB
#undef PG8_STAGE
#undef PG8_STAGE_A
#undef PG8_LDA
#undef PG8_LDB
#undef PG8_MMA
#undef PG8_WAIT_V
#undef PG8_WAIT_VF
#undef PG8_WAIT_L
#undef PG8_BAR
#undef PG8_SCHED
}
}
using pg8::Unit;

__device__ __forceinline__ int tile_row0(int mt, bool lat_only) { return lat_only ? ((mt >> 3) * 9 + 1 + (mt & 7)) * 256 : mt * 256; }

template <int RB_, int SC_> struct SchedQKV {
    static constexpr int RB = RB_, SCALE_A = SC_, SCALE_B = SC_;
    const char* H; const char* Wt;
    __device__ __forceinline__ bool next(int i, Unit& u) const { int mt, r; if (!pg8::deal(i, 12, M / 256, mt, r)) return false;
        if (r < 8) { u.kind = 0; u.pm = mt; u.pn = r; } else { u.kind = 1; u.pm = r - 8; u.pn = mt; } u.e = 0; return true; }
    static constexpr bool GATHER = false;
    __device__ __forceinline__ void a_offs(const Unit& u, int tid, unsigned (&v)[1][2]) const {
#pragma unroll
        for (int i = 0; i < 2; ++i) { int R, C; pg8::stage_rc(tid * 16 + i * 8192, R, C); v[0][i] = (unsigned)((u.pm * 256 + R) * RB + C * 2); } }
    __device__ __forceinline__ const char* a_base(const Unit& u) const { return u.kind == 0 ? H : Wt + (size_t)2048 * RB; }
    __device__ __forceinline__ const char* b_base(const Unit& u) const { return (u.kind == 0 ? Wt : H) + (size_t)u.pn * 256 * RB; }
};
template <int RB_, int SC_> struct SchedPlain {
    static constexpr int RB = RB_, SCALE_A = SC_, SCALE_B = SC_;
    const char* A; const char* Bt; int npu; bool lat_only;
    __device__ __forceinline__ bool next(int i, Unit& u) const { int mt, r; if (!pg8::deal(i, npu, lat_only ? 128 : 144, mt, r)) return false;
        u.pm = tile_row0(mt, lat_only) >> 8; u.pn = r; u.e = 0; u.kind = 0; return true; }
    static constexpr bool GATHER = false;
    __device__ __forceinline__ void a_offs(const Unit& u, int tid, unsigned (&v)[1][2]) const {
#pragma unroll
        for (int i = 0; i < 2; ++i) { int R, C; pg8::stage_rc(tid * 16 + i * 8192, R, C); v[0][i] = (unsigned)((u.pm * 256 + R) * RB + C * 2); } }
    __device__ __forceinline__ const char* a_base(const Unit&) const { return A; }
    __device__ __forceinline__ const char* b_base(const Unit& u) const { return Bt + (size_t)u.pn * 256 * RB; }
};
template <bool GATHER_, int RB_, int SA_, int SB_> struct SchedMoe {
    static constexpr bool GATHER = GATHER_;
    static constexpr int RB = RB_, SCALE_A = SA_, SCALE_B = SB_;
    const char* A; const char* Wt; const int* list; int npu; size_t estride;
    LAS const int* tstart; LAS const int* ecnt; LAS const int* tile_e;
    __device__ __forceinline__ bool mdeal(int i, int ntl, int& mt, int& r) const {
        const int G = gridDim.x, c = blockIdx.x;
        if (MOE_XCD_RANGE && (G & 7) == 0) { const int x = c & 7, q = i * (G >> 3) + (c >> 3); const int lo = (x * ntl) >> 3, hi = ((x + 1) * ntl) >> 3; mt = lo + q / npu; r = q % npu; return mt < hi; }
        return pg8::deal(i, npu, ntl, mt, r); }
    __device__ __forceinline__ bool next(int i, Unit& u) const { int mt, r; const int ntl = __builtin_amdgcn_readfirstlane(tstart[32]);
        int xp = 0;
        if (!mdeal(i, ntl, mt, r)) { if (!(PROBE_REP & (GATHER_ ? 0x100 : 0x200))) return false; int n_i = 0; while (mdeal(n_i, ntl, mt, r)) ++n_i; if (i >= 2 * n_i || !mdeal(i - n_i, ntl, mt, r)) return false; xp = 1; }
        u.pm = mt; u.pn = r; u.e = __builtin_amdgcn_readfirstlane(tile_e[mt]); u.kind = xp; return true; }
    __device__ __forceinline__ void idx_dma(const Unit& u, int lane, unsigned slot) const {
        const int j0 = (u.pm - __builtin_amdgcn_readfirstlane(tstart[u.e])) * 256;
        pg8::glds16s((const char*)(list + (size_t)u.e * CAP + j0), (unsigned)lane * 16u, slot); }
    __device__ __forceinline__ void a_offs_lds(const Unit& u, int tid, unsigned (&v)[2][1], LAS const int* slot) const {
        const int j0 = (u.pm - __builtin_amdgcn_readfirstlane(tstart[u.e])) * 256, cnt = __builtin_amdgcn_readfirstlane(ecnt[u.e]);
#pragma unroll
        for (int h = 0; h < 2; ++h) { unsigned pk = 0;
#pragma unroll
            for (int i = 0; i < 2; ++i) { int R, C; pg8::stage_rc(tid * 16 + i * 8192, R, C); const int r = h * 128 + R; const unsigned tok = (j0 + r) < cnt ? (unsigned)slot[r] : 0u; pk |= tok << (16 * i); }
            v[h][0] = pk; }
    }
    __device__ __forceinline__ void a_offs(const Unit& u, int tid, unsigned (&v)[GATHER_ ? 2 : 1][GATHER_ ? 1 : 2]) const {
        if constexpr (GATHER_) { const int j0 = (u.pm - __builtin_amdgcn_readfirstlane(tstart[u.e])) * 256, cnt = __builtin_amdgcn_readfirstlane(ecnt[u.e]); const int* lp = list + (size_t)u.e * CAP;
#pragma unroll
            for (int h = 0; h < 2; ++h) { unsigned pk = 0;
#pragma unroll
                for (int i = 0; i < 2; ++i) { int R, C; pg8::stage_rc(tid * 16 + i * 8192, R, C); const int idx = j0 + h * 128 + R; const unsigned tok = idx < cnt ? (unsigned)lp[idx] : 0u; pk |= tok << (16 * i); }
                v[h][0] = pk; }
        } else {
#pragma unroll
            for (int i = 0; i < 2; ++i) { int R, C; pg8::stage_rc(tid * 16 + i * 8192, R, C); v[0][i] = (unsigned)((u.pm * 256 + R) * RB + C * 2); } }
    }
    __device__ __forceinline__ const char* a_base(const Unit&) const { return A; }
    __device__ __forceinline__ const char* b_base(const Unit& u) const { return Wt + (size_t)u.e * estride + (size_t)u.pn * 256 * RB; }
};

#define EPI_LOOP_ROWS for (int ai = 0; ai < 2; ++ai) _Pragma("unroll") for (int m = 0; m < 4; ++m)
__device__ __forceinline__ u32x4 pack8(const f32x4& v0, const f32x4& v1) { u32x4 w; w.x = cvt_pk_bf16(v0[0], v0[1]); w.y = cvt_pk_bf16(v0[2], v0[3]); w.z = cvt_pk_bf16(v1[0], v1[1]); w.w = cvt_pk_bf16(v1[2], v1[3]); return w; }

__device__ __forceinline__ float clamp8(float v) { return __builtin_amdgcn_fmed3f(v, -448.f, 448.f); }
__device__ __forceinline__ unsigned pack_fp8x4(float a, float b, float c, float d) {
    const float ca = clamp8(a); int w = __builtin_bit_cast(int, ca);
    w = __builtin_amdgcn_cvt_pk_fp8_f32(ca, clamp8(b), w, false); w = __builtin_amdgcn_cvt_pk_fp8_f32(clamp8(c), clamp8(d), w, true); return (unsigned)w; }
struct EpiQKV {
    static constexpr bool BIAS_DMA = false;
    static constexpr int NST = ATT_FP8 ? 8 : 16;
    bf16* Q; bf16* Kb; bf16* Vt; const float* cosT; const float* sinT; bool dost; LAS unsigned char* stg;
    __device__ __forceinline__ void operator()(const f32x4 (&acc)[2][2][4][2], const Unit& u, int wr, int wc, int fr, int fq) const {
        asm volatile("" : "+v"(fr), "+v"(fq));
        if constexpr (ATT_FP8 != 0) {
            const bool isq = u.pn < 4, k0 = (u.kind == 0); const bool lat = k0 && (u.pm % 9) != 0;
            unsigned char* base8 = (unsigned char*)Q + (k0 ? (isq ? (size_t)0 : WS_K - WS_Q) : WS_VT - WS_Q); const size_t ld = k0 ? 1024 : (size_t)M; const int colbase = k0 ? (u.pn & 3) * 256 : u.pn * 256;
            const float sc = k0 ? (isq ? C2 * 64.f : 16.f) : 16.f;
            LAS unsigned char* sw = stg + (wr * 4 + wc) * 2048; const int lane = fq * 16 + fr; const int jp0 = 16 * (wc & 1) + 4 * fq;
#pragma unroll
            for (int ai = 0; ai < 2; ++ai) {
                f32x4 cs[4], sn[4];
#pragma unroll
                for (int m = 0; m < 4; ++m) { const int row = u.pm * 256 + ai * 128 + wr * 64 + m * 16 + fr; const int t = lat ? (row % RPB) - CTXL : 0;
                    const f32x4 cv = *(const f32x4*)(cosT + t * 32 + jp0), sv = *(const f32x4*)(cosT + 2048 * 32 + t * 32 + jp0);
#pragma unroll
                    for (int j = 0; j < 4; ++j) { cs[m][j] = lat ? cv[j] : 1.f; sn[m][j] = lat ? sv[j] : 0.f; } }
#pragma unroll
                for (int bj = 0; bj < 2; ++bj) {
#pragma unroll
                    for (int m = 0; m < 4; ++m) { const f32x4 a = acc[ai][bj][m][0], b = acc[ai][bj][m][1]; const f32x4 c_ = cs[m], s_ = sn[m];
                        u32x2 w8;
                        w8.x = pack_fp8x4((a[0] * c_[0] - a[1] * s_[0]) * sc, (a[1] * c_[0] + a[0] * s_[0]) * sc, (a[2] * c_[1] - a[3] * s_[1]) * sc, (a[3] * c_[1] + a[2] * s_[1]) * sc);
                        w8.y = pack_fp8x4((b[0] * c_[2] - b[1] * s_[2]) * sc, (b[1] * c_[2] + b[0] * s_[2]) * sc, (b[2] * c_[3] - b[3] * s_[3]) * sc, (b[3] * c_[3] + b[2] * s_[3]) * sc);
                        *(LAS u32x2*)(sw + (16 * m + fr) * 32 + fq * 8) = w8; }
                    asm volatile("s_waitcnt lgkmcnt(0)" ::: "memory");
#pragma unroll
                    for (int k = 0; k < 2; ++k) { const int p = lane + 64 * k, rr = p >> 1, hf = p & 1; const u32x4 v = *(const LAS u32x4*)(sw + p * 16);
                        const int row = u.pm * 256 + ai * 128 + wr * 64 + rr; const int col = colbase + bj * 128 + wc * 32 + hf * 16;
                        if (dost) *(u32x4*)(base8 + (size_t)row * ld + col) = v; }
                    asm volatile("s_waitcnt lgkmcnt(0)" ::: "memory");
                }
            }
        } else if (u.kind == 0) {
            const bool isq = u.pn < 4; bf16* base = isq ? Q : Kb; const float sc = isq ? C2 : 1.f;
            const bool lat = (u.pm % 9) != 0;
#pragma unroll
            EPI_LOOP_ROWS { const int row = u.pm * 256 + ai * 128 + wr * 64 + m * 16 + fr; const int t = (row % RPB) - CTXL;
#pragma unroll
                for (int bj = 0; bj < 2; ++bj) { const f32x4 a = acc[ai][bj][m][0], b = acc[ai][bj][m][1]; f32x4 o0, o1;
                    f32x4 cs = {1.f, 1.f, 1.f, 1.f}, sn = {0.f, 0.f, 0.f, 0.f}; const int jp0 = 16 * (wc & 1) + 4 * fq;
                    if (lat) { cs = *(const f32x4*)(cosT + t * 32 + jp0); sn = *(const f32x4*)(sinT + t * 32 + jp0); }
                    o0[0] = (a[0] * cs[0] - a[1] * sn[0]) * sc; o0[1] = (a[1] * cs[0] + a[0] * sn[0]) * sc; o0[2] = (a[2] * cs[1] - a[3] * sn[1]) * sc; o0[3] = (a[3] * cs[1] + a[2] * sn[1]) * sc;
                    o1[0] = (b[0] * cs[2] - b[1] * sn[2]) * sc; o1[1] = (b[1] * cs[2] + b[0] * sn[2]) * sc; o1[2] = (b[2] * cs[3] - b[3] * sn[3]) * sc; o1[3] = (b[3] * cs[3] + b[2] * sn[3]) * sc;
                    const int col = (u.pn & 3) * 256 + bj * 128 + wc * 32 + fq * 8;
                    if (ATT_FP8) { const float s8 = isq ? 64.f : 16.f; u32x2 w8; w8.x = pack_fp8x4(s8 * o0[0], s8 * o0[1], s8 * o0[2], s8 * o0[3]); w8.y = pack_fp8x4(s8 * o1[0], s8 * o1[1], s8 * o1[2], s8 * o1[3]);
                        if (dost) *(u32x2*)((unsigned char*)base + (size_t)row * 1024 + col) = w8; }
                    else { const u32x4 pk_ = pack8(o0, o1); if (dost) *(u32x4*)(base + (size_t)row * 1024 + col) = pk_; } } }
        } else {
#pragma unroll
            EPI_LOOP_ROWS { const int row = u.pm * 256 + ai * 128 + wr * 64 + m * 16 + fr;
#pragma unroll
                for (int bj = 0; bj < 2; ++bj) { const int col = u.pn * 256 + bj * 128 + wc * 32 + fq * 8;
                    if (ATT_FP8) { const f32x4 a_ = acc[ai][bj][m][0], b_ = acc[ai][bj][m][1]; u32x2 w8; w8.x = pack_fp8x4(16.f * a_[0], 16.f * a_[1], 16.f * a_[2], 16.f * a_[3]); w8.y = pack_fp8x4(16.f * b_[0], 16.f * b_[1], 16.f * b_[2], 16.f * b_[3]);
                        if (dost) *(u32x2*)((unsigned char*)Vt + (size_t)row * M + col) = w8; }
                    else { const u32x4 pk_ = pack8(acc[ai][bj][m][0], acc[ai][bj][m][1]); if (dost) *(u32x4*)(Vt + (size_t)row * M + col) = pk_; } } }
        }
    }
};
struct EpiPlain {
    static constexpr bool BIAS_DMA = false;
    static constexpr int NST = 16;
    bf16* O; int ldc;
    __device__ __forceinline__ void operator()(const f32x4 (&acc)[2][2][4][2], const Unit& u, int wr, int wc, int fr, int fq) const {
        asm volatile("" : "+v"(fr), "+v"(fq));
#pragma unroll
        EPI_LOOP_ROWS { const int row = u.pm * 256 + ai * 128 + wr * 64 + m * 16 + fr;
#pragma unroll
            for (int bj = 0; bj < 2; ++bj) { const int col = u.pn * 256 + bj * 128 + wc * 32 + fq * 8;
                *(u32x4*)(O + (size_t)row * ldc + col) = pack8(acc[ai][bj][m][0], acc[ai][bj][m][1]); } }
    }
};
struct EpiConvIn {
    static constexpr bool BIAS_DMA = false;
    static constexpr int NST = 16;
    bf16* Bb; bf16* Ub;
    __device__ __forceinline__ void operator()(const f32x4 (&acc)[2][2][4][2], const Unit& u, int wr, int wc, int fr, int fq) const {
        asm volatile("" : "+v"(fr), "+v"(fq));
        if (u.pn < 4) {
#pragma unroll
            EPI_LOOP_ROWS { const int row = u.pm * 256 + ai * 128 + wr * 64 + m * 16 + fr;
#pragma unroll
                for (int bj = 0; bj < 2; ++bj) { const int col = u.pn * 256 + bj * 128 + wc * 32 + fq * 8;
                    *(u32x4*)(Bb + (size_t)row * 1024 + col) = pack8(acc[ai][bj][m][0], acc[ai][bj][m][1]); } }
        } else {
#pragma unroll
            EPI_LOOP_ROWS { const int row = u.pm * 256 + ai * 128 + wr * 64 + m * 16 + fr;
#pragma unroll
                for (int bj = 0; bj < 2; ++bj) { const f32x4 a = acc[ai][bj][m][0], b = acc[ai][bj][m][1]; const int col = (u.pn - 4) * 128 + bj * 64 + wc * 16 + fq * 4;
                    u32x2 w; w.x = cvt_pk_bf16(a[0] * a[1], a[2] * a[3]); w.y = cvt_pk_bf16(b[0] * b[1], b[2] * b[3]);
                    *(u32x2*)(Ub + (size_t)row * 1024 + col) = w; } }
        }
    }
};
struct EpiResid {
    static constexpr bool BIAS_DMA = false;
    static constexpr int NST = X_BF16 ? 16 : 0;
    const void* Xin; void* X; const float* gate;
    const float* in_x; const float* in_ctx;
    __device__ __forceinline__ void operator()(const f32x4 (&acc)[2][2][4][2], const Unit& u, int wr, int wc, int fr, int fq) const {
        asm volatile("" : "+v"(fr), "+v"(fq));
        const int rb = (u.pm % 9) == 0 ? 16 : u.pm / 9; const float* gp = gate + rb * 6144;
        f32x4 gv[2][2];
#pragma unroll
        for (int bj = 0; bj < 2; ++bj) { const int col = u.pn * 256 + bj * 128 + wc * 32 + fq * 8; gv[bj][0] = *(const f32x4*)(gp + col); gv[bj][1] = *(const f32x4*)(gp + col + 4); }
        if (X_BF16 && !in_x) {
#pragma unroll
            for (int ai = 0; ai < 2; ++ai) { u32x4 xw[4][2];
#pragma unroll
                for (int m = 0; m < 4; ++m)
#pragma unroll
                    for (int bj = 0; bj < 2; ++bj) xw[m][bj] = *(const u32x4*)((const bf16*)Xin + (size_t)(u.pm * 256 + ai * 128 + wr * 64 + m * 16 + fr) * 1024 + u.pn * 256 + bj * 128 + wc * 32 + fq * 8);
#pragma unroll
                for (int m = 0; m < 4; ++m)
#pragma unroll
                    for (int bj = 0; bj < 2; ++bj) { const u32x4 w = xw[m][bj];
                        const f32x4 x0 = {bf2f((unsigned short)(w.x & 0xffffu)), bf2f((unsigned short)(w.x >> 16)), bf2f((unsigned short)(w.y & 0xffffu)), bf2f((unsigned short)(w.y >> 16))};
                        const f32x4 x1 = {bf2f((unsigned short)(w.z & 0xffffu)), bf2f((unsigned short)(w.z >> 16)), bf2f((unsigned short)(w.w & 0xffffu)), bf2f((unsigned short)(w.w >> 16))};
                        *(u32x4*)((bf16*)X + (size_t)(u.pm * 256 + ai * 128 + wr * 64 + m * 16 + fr) * 1024 + u.pn * 256 + bj * 128 + wc * 32 + fq * 8) = pack8(x0 + gv[bj][0] * acc[ai][bj][m][0], x1 + gv[bj][1] * acc[ai][bj][m][1]); } }
        } else {
#pragma unroll
            EPI_LOOP_ROWS { const int row = u.pm * 256 + ai * 128 + wr * 64 + m * 16 + fr;
#pragma unroll
                for (int bj = 0; bj < 2; ++bj) { const int col = u.pn * 256 + bj * 128 + wc * 32 + fq * 8; const size_t o = (size_t)row * 1024 + col;
                    const float* xs = (const float*)Xin + o;
                    if (in_x) { const int b_ = u.pm / 9, jt_ = u.pm % 9; const size_t ro = (size_t)(row - u.pm * 256) * 1024 + col;
                        xs = jt_ == 0 ? in_ctx + (size_t)b_ * CTXL * 1024 + ro : in_x + ((size_t)b_ * SEQ + (jt_ - 1) * 256) * 1024 + ro; }
                    const f32x4 x0 = *(const f32x4*)(xs), x1 = *(const f32x4*)(xs + 4);
                    const f32x4 r0 = x0 + gv[bj][0] * acc[ai][bj][m][0], r1 = x1 + gv[bj][1] * acc[ai][bj][m][1];
                    if (X_BF16) *(u32x4*)((bf16*)X + o) = pack8(r0, r1);
                    else { *(f32x4*)((float*)X + o) = r0; *(f32x4*)((float*)X + o + 4) = r1; } } }
        }
    }
};
__device__ __forceinline__ float swiglu1(float g, float l) {
    g = fminf(g, 7.f); l = fminf(fmaxf(l, -7.f), 7.f);
    const float s = __builtin_amdgcn_rcpf(1.f + __builtin_amdgcn_exp2f(-1.702f * 1.4426950408889634f * g));
    return g * s * (l + 1.f);
}
constexpr float GATE_PRE = -1.702f * 1.4426950408889634f;
__device__ __forceinline__ float swiglu4(float t, float l) {
    t = __builtin_amdgcn_fmed3f(t, 7.f * GATE_PRE, 3.0e38f); l = __builtin_amdgcn_fmed3f(l, -7.f, 7.f);
    const float r = __builtin_amdgcn_rcpf(1.f + __builtin_amdgcn_exp2f(t));
    return (t * r) * __builtin_fmaf(l, 4.f / GATE_PRE, 4.f / GATE_PRE);
}
template <bool F8> struct EpiSwiglu {
    static constexpr bool BIAS_DMA = true, GATE_COLS = F8; static constexpr float GATE_MUL = -1.702f * 1.4426950408889634f, BIAS_MUL = 1.f;
    static constexpr int NST = F8 ? 4 : 16;
    bf16* ACT; const float* bgu; LAS unsigned char* stg;
    __device__ __forceinline__ const float* bias_src(const Unit& u) const { return bgu + u.e * 2048 + u.pn * 256; }
    __device__ __forceinline__ void operator()(const f32x4 (&acc)[2][2][4][2], const Unit& u, int wr, int wc, int fr, int fq, LAS const float* bl) const {
        asm volatile("" : "+v"(fr), "+v"(fq));
        (void)bl;
        if constexpr (F8) {
            LAS unsigned* sw = (LAS unsigned*)(stg + (wr * 4 + wc) * 2048); const int lane = fq * 16 + fr;
#pragma unroll
            for (int ai = 0; ai < 2; ++ai) {
#pragma unroll
                for (int m = 0; m < 4; ++m)
#pragma unroll
                    for (int bj = 0; bj < 2; ++bj) { const f32x4 a = acc[ai][bj][m][0], b = acc[ai][bj][m][1];
                        const float s0_ = swiglu4(a[0], a[1]); int w = __builtin_bit_cast(int, s0_);
                        w = __builtin_amdgcn_cvt_pk_fp8_f32(s0_, swiglu4(a[2], a[3]), w, false); w = __builtin_amdgcn_cvt_pk_fp8_f32(swiglu4(b[0], b[1]), swiglu4(b[2], b[3]), w, true);
                        sw[((16 * m + fr) * 2 + bj) * 4 + fq] = (unsigned)w; }
                asm volatile("s_waitcnt lgkmcnt(0)" ::: "memory");
#pragma unroll
                for (int k = 0; k < 2; ++k) { const int p = lane + 64 * k, rr = p >> 1, bj = p & 1; const u32x4 v = *(const LAS u32x4*)(sw + p * 4);
                    const int row = u.pm * 256 + ai * 128 + wr * 64 + rr; const int col = u.pn * 128 + bj * 64 + wc * 16;
                    if (!(PROBE_NOST && u.kind)) *(u32x4*)((unsigned char*)ACT + (size_t)row * 1024 + col) = v; }
                asm volatile("s_waitcnt lgkmcnt(0)" ::: "memory");
            }
        } else {
#pragma unroll
            EPI_LOOP_ROWS { const int row = u.pm * 256 + ai * 128 + wr * 64 + m * 16 + fr;
#pragma unroll
                for (int bj = 0; bj < 2; ++bj) { const f32x4 a = acc[ai][bj][m][0], b = acc[ai][bj][m][1];
                    const int col = u.pn * 128 + bj * 64 + wc * 16 + fq * 4;
                    u32x2 w; w.x = cvt_pk_bf16(swiglu1(a[0], a[1]), swiglu1(a[2], a[3])); w.y = cvt_pk_bf16(swiglu1(b[0], b[1]), swiglu1(b[2], b[3]));
                    *(u32x2*)(ACT + (size_t)row * 1024 + col) = w; } }
        }
    }
};
struct EpiDown {
    static constexpr bool BIAS_DMA = true, GATE_COLS = false; static constexpr float GATE_MUL = 1.f, BIAS_MUL = Y_FP8 ? 16.f : 1.f;
    static constexpr int NST = Y_FP8 ? 8 : 16;
    bf16* Y; const float* bd; LAS unsigned char* stg;
    __device__ __forceinline__ const float* bias_src(const Unit& u) const { return bd + u.e * 1024 + u.pn * 256; }
    __device__ __forceinline__ void operator()(const f32x4 (&acc)[2][2][4][2], const Unit& u, int wr, int wc, int fr, int fq, LAS const float* bl) const {
        asm volatile("" : "+v"(fr), "+v"(fq));
        (void)bl;
        if constexpr (Y_FP8 != 0) {
            LAS unsigned char* sw = stg + (wr * 4 + wc) * 2048; const int lane = fq * 16 + fr;
#pragma unroll
            for (int ai = 0; ai < 2; ++ai)
#pragma unroll
                for (int bj = 0; bj < 2; ++bj) {
#pragma unroll
                    for (int m = 0; m < 4; ++m) { const f32x4 y0 = acc[ai][bj][m][0], y1 = acc[ai][bj][m][1];
                        u32x2 w; w.x = pack_fp8x4(y0[0], y0[1], y0[2], y0[3]); w.y = pack_fp8x4(y1[0], y1[1], y1[2], y1[3]);
                        *(LAS u32x2*)(sw + (16 * m + fr) * 32 + fq * 8) = w; }
                    asm volatile("s_waitcnt lgkmcnt(0)" ::: "memory");
#pragma unroll
                    for (int k = 0; k < 2; ++k) { const int p = lane + 64 * k, rr = p >> 1, hf = p & 1; const u32x4 v = *(const LAS u32x4*)(sw + p * 16);
                        const int row = u.pm * 256 + ai * 128 + wr * 64 + rr; const int col = u.pn * 256 + bj * 128 + wc * 32 + hf * 16;
                        if (!(PROBE_NOST && u.kind)) *(u32x4*)((unsigned char*)Y + (size_t)row * 1024 + col) = v; }
                    asm volatile("s_waitcnt lgkmcnt(0)" ::: "memory");
                }
        } else {
#pragma unroll
            EPI_LOOP_ROWS { const int row = u.pm * 256 + ai * 128 + wr * 64 + m * 16 + fr;
#pragma unroll
                for (int bj = 0; bj < 2; ++bj) { const int col = u.pn * 256 + bj * 128 + wc * 32 + fq * 8;
                    const u32x4 pk_ = pack8(acc[ai][bj][m][0], acc[ai][bj][m][1]); if (!(PROBE_NOST && u.kind)) *(u32x4*)(Y + (size_t)row * 1024 + col) = pk_; } }
        }
    }
};

namespace att {
constexpr int SLOT = 32768, VOFF = 16384;
__device__ __forceinline__ void glds16(const void* gsrc, unsigned lds_dst) { unsigned keep;
    asm volatile("s_mov_b32 %0, m0\n\ts_mov_b32 m0, %2\n\ts_nop 0\n\tglobal_load_lds_dwordx4 %1, off\n\ts_mov_b32 m0, %0" : "=&s"(keep) : "v"(gsrc), "s"(lds_dst) : "memory"); }
#define ATT_WAIT_BAR(N) asm volatile("s_waitcnt vmcnt(" #N ") lgkmcnt(0)\n\ts_barrier" ::: "memory")
__device__ __forceinline__ float half_swap_max(float m) { auto rr = __builtin_amdgcn_permlane32_swap(__float_as_uint(m), __float_as_uint(m), false, false); return fmaxf(__uint_as_float(rr[0]), __uint_as_float(rr[1])); }
__device__ __forceinline__ float half_swap_sum(float m) { auto rr = __builtin_amdgcn_permlane32_swap(__float_as_uint(m), __float_as_uint(m), false, false); return __uint_as_float(rr[0]) + __uint_as_float(rr[1]); }
__device__ __forceinline__ int crow(int r, int hi) { return (r & 3) + 8 * (r >> 2) + 4 * hi; }
__device__ __forceinline__ float max3f(float a, float b, float c) { float r; asm("v_max3_f32 %0, %1, %2, %3" : "=v"(r) : "v"(a), "v"(b), "v"(c)); return r; }

__device__ __forceinline__ void attn_unit(LAS unsigned char* lds, LAS float* wsc  , const bf16* Q, const bf16* Kb, const bf16* Vt, bf16* O,
                                          int krow0, int h, int qrow0, int NT, float lam, float osc, const float* subg, const int tid) {
    const int lane = tid & 63, r32 = lane & 31, hi = lane >> 5; const int wid = __builtin_amdgcn_readfirstlane(tid >> 6);
    const int qg = wid >> 1, c = wid & 1;
    const unsigned lds0 = (unsigned)(uintptr_t)lds;
    const bf16* ksrc[2]; const bf16* vsrc[2];
#pragma unroll
    for (int i = 0; i < 2; ++i) { const int p = 2 * wid + i;
        { const int row = 4 * p + (lane >> 4), ch = (lane & 15) ^ (row & 15); ksrc[i] = Kb + (size_t)(krow0 + row) * 1024 + h * 128 + ch * 8; }
        { const int row = 8 * p + (lane >> 3), ch = (lane & 7) ^ ((row >> 1) & 7); vsrc[i] = Vt + (size_t)(h * 128 + row) * M + krow0 + ch * 8; } }
    const unsigned kdst = lds0 + (unsigned)wid * 2048u, vdst = lds0 + VOFF + (unsigned)wid * 2048u;
#define ATT_DMA(t, slot) do { const unsigned so_ = (unsigned)(slot) * SLOT; \
        glds16(ksrc[0] + (size_t)(t) * 64 * 1024, (unsigned)__builtin_amdgcn_readfirstlane(kdst + so_)); glds16(ksrc[1] + (size_t)(t) * 64 * 1024, (unsigned)__builtin_amdgcn_readfirstlane(kdst + so_ + 1024u)); \
        glds16(vsrc[0] + (size_t)(t) * 64, (unsigned)__builtin_amdgcn_readfirstlane(vdst + so_)); glds16(vsrc[1] + (size_t)(t) * 64, (unsigned)__builtin_amdgcn_readfirstlane(vdst + so_ + 1024u)); } while (0)
    const int key0 = (r32 & 0x13) | ((r32 & 4) << 1) | ((r32 & 8) >> 1);
    const int kx = key0 & 15, vx = (r32 >> 1) & 7;
    bf16x8 qf[4];
    { const bf16* qp = Q + (size_t)(qrow0 + qg * 32 + r32) * 1024 + h * 128 + c * 64 + hi * 8;
#pragma unroll
      for (int d0 = 0; d0 < 4; ++d0) qf[d0] = *(const bf16x8*)(qp + d0 * 16); }
    float sg[4];
#pragma unroll
    for (int d0 = 0; d0 < 4; ++d0) sg[d0] = subg[d0 * 32 + r32] * osc;
    f32x16 o[4];
#pragma unroll
    for (int d0 = 0; d0 < 4; ++d0) o[d0] = f32x16{};
    float mref = 0.f, lsum = 0.f; f32x16 negm = f32x16{};
    asm volatile("s_waitcnt vmcnt(0)" ::: "memory");
#define AT_BEG(r) do { if (PROBE_T == (r)) at0_ = __builtin_amdgcn_s_memtime(); } while (0)
#define AT_END(r) do { if (PROBE_T == (r)) { const unsigned long long d_ = __builtin_amdgcn_s_memtime() - at0_; if (blockIdx.x == 0 && tid == ATT_PROBE_TID) *(LAS unsigned long long*)(lds + LX_MISC + 64) += d_; } } while (0)
    unsigned long long at0_ = 0; (void)at0_;
    AT_BEG(7);
    AT_BEG(13);
    ATT_DMA(0, 0);
    if (NT > 1) ATT_DMA(1, 1);
    for (int t = 0; t < NT; ++t) {
        const int slot = t & 3;
        AT_BEG(4);
        if (t + 1 < NT) { ATT_WAIT_BAR(4); } else { ATT_WAIT_BAR(0); }
        AT_END(4);
        if (t == 0) AT_END(13);
        if (t + 2 < NT) ATT_DMA(t + 2, (t + 2) & 3);
        AT_BEG(5);
        const LAS unsigned char* kb_ = lds + slot * SLOT; const LAS unsigned char* vb_ = kb_ + VOFF;
        f32x16 s0, s1;
        bf16x8 kf[8];
#pragma unroll
        for (int d0 = 0; d0 < 4; ++d0) { const int ch = (c * 8 + d0 * 2 + hi) ^ kx;
            kf[d0] = *(const LAS bf16x8*)(kb_ + key0 * 256 + ch * 16); kf[4 + d0] = *(const LAS bf16x8*)(kb_ + (key0 + 32) * 256 + ch * 16); }
        bf16x8 vA[8], vB[8];
#pragma unroll
        for (int ks = 0; ks < 2; ++ks) { const int ch = (2 * ks + hi) ^ vx;
#pragma unroll
            for (int d0 = 0; d0 < 4; ++d0) vA[ks * 4 + d0] = *(const LAS bf16x8*)(vb_ + (d0 * 32 + r32) * 128 + ch * 16); }
#pragma unroll
        for (int d0 = 0; d0 < 4; ++d0) s0 = __builtin_amdgcn_mfma_f32_32x32x16_bf16(kf[d0], qf[d0], d0 == 0 ? negm : s0, 0, 0, 0);
#pragma unroll
        for (int d0 = 0; d0 < 4; ++d0) s1 = __builtin_amdgcn_mfma_f32_32x32x16_bf16(kf[4 + d0], qf[d0], d0 == 0 ? negm : s1, 0, 0, 0);
        float rm = s0[0];
#pragma unroll
        for (int r = 1; r < 16; ++r) rm = fmaxf(rm, s0[r]);
        float sa = 0.f;
#pragma unroll
        for (int r = 0; r < 16; ++r) { s0[r] = __builtin_amdgcn_exp2f(s0[r]); sa += s0[r]; }
        bf16x8 pa[4];
#pragma unroll
        for (int s = 0; s < 2; ++s) { u32x4 w0;
            w0.x = cvt_pk_bf16(s0[8 * s + 0], s0[8 * s + 1]); w0.y = cvt_pk_bf16(s0[8 * s + 2], s0[8 * s + 3]); w0.z = cvt_pk_bf16(s0[8 * s + 4], s0[8 * s + 5]); w0.w = cvt_pk_bf16(s0[8 * s + 6], s0[8 * s + 7]);
            pa[s] = __builtin_bit_cast(bf16x8, w0); }
#pragma unroll
        for (int ks = 2; ks < 4; ++ks) { const int ch = (2 * ks + hi) ^ vx;
#pragma unroll
            for (int d0 = 0; d0 < 4; ++d0) vB[(ks - 2) * 4 + d0] = *(const LAS bf16x8*)(vb_ + (d0 * 32 + r32) * 128 + ch * 16); }
#pragma unroll
        for (int ks = 0; ks < 2; ++ks)
#pragma unroll
            for (int d0 = 0; d0 < 4; ++d0) o[d0] = __builtin_amdgcn_mfma_f32_32x32x16_bf16(pa[ks], vA[ks * 4 + d0], o[d0], 0, 0, 0);
#pragma unroll
        for (int r = 0; r < 16; ++r) rm = fmaxf(rm, s1[r]);
#pragma unroll
        for (int r = 0; r < 16; ++r) { s1[r] = __builtin_amdgcn_exp2f(s1[r]); sa += s1[r]; }
        lsum += sa;
#pragma unroll
        for (int s = 0; s < 2; ++s) { u32x4 w1;
            w1.x = cvt_pk_bf16(s1[8 * s + 0], s1[8 * s + 1]); w1.y = cvt_pk_bf16(s1[8 * s + 2], s1[8 * s + 3]); w1.z = cvt_pk_bf16(s1[8 * s + 4], s1[8 * s + 5]); w1.w = cvt_pk_bf16(s1[8 * s + 6], s1[8 * s + 7]);
            pa[2 + s] = __builtin_bit_cast(bf16x8, w1); }
#pragma unroll
        for (int ks = 2; ks < 4; ++ks)
#pragma unroll
            for (int d0 = 0; d0 < 4; ++d0) o[d0] = __builtin_amdgcn_mfma_f32_32x32x16_bf16(pa[ks], vB[(ks - 2) * 4 + d0], o[d0], 0, 0, 0);
        AT_END(5);
        rm = half_swap_max(rm);
        const bool need = (t == 0) || (rm > 8.f);
        if (__any(need)) {
            const float dl = need ? rm : 0.f; mref += dl;
#pragma unroll
            for (int r = 0; r < 16; ++r) negm[r] = -mref;
            const float f = __builtin_amdgcn_exp2f(-dl); lsum *= f;
            if (hi == 0) wsc[r32] = f;
            asm volatile("s_waitcnt lgkmcnt(0)" ::: "memory");
#pragma unroll
            for (int r = 0; r < 16; ++r) { const float fr_ = wsc[crow(r, hi)];
#pragma unroll
                for (int d0 = 0; d0 < 4; ++d0) o[d0][r] *= fr_; }
            asm volatile("s_waitcnt lgkmcnt(0)" ::: "memory");
        }
    }
    AT_BEG(14);
    const float lt = half_swap_sum(lsum);
    if (hi == 0) wsc[64 + r32] = (c ? -lam : 1.f) * __builtin_amdgcn_rcpf(lt);
    asm volatile("s_waitcnt lgkmcnt(0)\n\ts_barrier" ::: "memory");
    LAS float* xch = (LAS float*)(lds + qg * 16384);
#pragma unroll
    for (int r = 0; r < 16; ++r) { const float a = wsc[64 + crow(r, hi)];
#pragma unroll
        for (int d0 = 0; d0 < 4; ++d0) o[d0][r] *= a; }
    if (c == 1) {
#pragma unroll
        for (int d0 = 0; d0 < 4; ++d0)
#pragma unroll
            for (int r = 0; r < 16; ++r) xch[(d0 * 16 + r) * 64 + lane] = o[d0][r];
    }
    asm volatile("s_waitcnt lgkmcnt(0)\n\ts_barrier" ::: "memory");
    if (c == 0) {
        constexpr int OB = FP8_ATT_O ? 1 : 2;
        LAS unsigned char* stg = lds + 65536 + qg * 8192;
#pragma unroll
        for (int d0 = 0; d0 < 4; ++d0)
#pragma unroll
            for (int r = 0; r < 16; ++r) o[d0][r] += xch[(d0 * 16 + r) * 64 + lane];
        float ss[16], tt[16];
#pragma unroll
        for (int r = 0; r < 16; ++r) { float x = (o[0][r] * o[0][r] + o[1][r] * o[1][r]) + (o[2][r] * o[2][r] + o[3][r] * o[3][r]);
            x += __builtin_bit_cast(float, __builtin_amdgcn_update_dpp(0, __builtin_bit_cast(int, x), 0xB1, 0xF, 0xF, true));
            x += __builtin_bit_cast(float, __builtin_amdgcn_update_dpp(0, __builtin_bit_cast(int, x), 0x4E, 0xF, 0xF, true));
            x += __builtin_bit_cast(float, __builtin_amdgcn_update_dpp(0, __builtin_bit_cast(int, x), 0x124, 0xF, 0xF, true));
            x += __builtin_bit_cast(float, __builtin_amdgcn_update_dpp(0, __builtin_bit_cast(int, x), 0x128, 0xF, 0xF, true));
            ss[r] = x; }
#pragma unroll
        for (int r = 0; r < 16; ++r) tt[r] = __shfl_xor(ss[r], 16);
#pragma unroll
        for (int r = 0; r < 16; ++r) { const int qr = crow(r, hi); const float rn = __builtin_amdgcn_rsqf((ss[r] + tt[r]) * (1.f / 128.f) + EPS);
#pragma unroll
            for (int d0 = 0; d0 < 4; ++d0) { const float ov = o[d0][r] * rn * sg[d0];
                if (FP8_ATT_O) { const float o4 = clamp8(4.f * ov); *(LAS unsigned char*)(stg + qr * 128 + d0 * 32 + r32) = (unsigned char)(__builtin_amdgcn_cvt_pk_fp8_f32(o4, o4, 0, false) & 0xff); }
                else *(LAS unsigned short*)(stg + (qr * 128 + d0 * 32 + r32) * 2) = (unsigned short)f2bf(ov); } }
        asm volatile("s_waitcnt lgkmcnt(0)" ::: "memory");
        unsigned char* Ob = (unsigned char*)O + ((size_t)(qrow0 + qg * 32) * 1024 + h * 128) * OB;
#pragma unroll
        for (int k = 0; k < 4 * OB; ++k) { const int off = lane * 16 + 1024 * k, row = off / (128 * OB), cb = off % (128 * OB);
            *(u32x4*)(Ob + (size_t)row * 1024 * OB + cb) = *(const LAS u32x4*)(stg + off); }
    }
    asm volatile("s_waitcnt lgkmcnt(0)\n\ts_barrier" ::: "memory");
    AT_END(7);
    AT_END(14);
#undef AT_BEG
#undef AT_END
#undef ATT_DMA
}

typedef int v8i __attribute__((ext_vector_type(8)));
typedef int v4i_ __attribute__((ext_vector_type(4)));
__device__ __forceinline__ v8i cat16(u32x4 lo, u32x4 hi2) { const v4i_ a = __builtin_bit_cast(v4i_, lo), b = __builtin_bit_cast(v4i_, hi2); return __builtin_shufflevector(a, b, 0, 1, 2, 3, 4, 5, 6, 7); }
constexpr float ATT_TGT = 2.f;
__device__ __forceinline__ void attn_unit8(LAS unsigned char* lds, LAS float* wsc, const unsigned char* Q8, const unsigned char* K8, const unsigned char* V8t, bf16* O,
                                           int krow0, int h, int qrow0, int NT, float lam, float osc, const float* subg, const int tid) {
    constexpr int SL = 16384, VO = 8192;
    const int lane = tid & 63, r32 = lane & 31, hi = lane >> 5; const int wid = __builtin_amdgcn_readfirstlane(tid >> 6);
    const int qg = wid >> 1, c = wid & 1;
    const unsigned lds0 = (unsigned)(uintptr_t)lds;
    const unsigned char* ksrc; const unsigned char* vsrc;
    { const int key = 8 * wid + (lane >> 3), ch = (lane & 7) ^ ((key >> 1) & 7); ksrc = K8 + (size_t)(krow0 + key) * 1024 + h * 128 + ch * 16; }
    { const int dv = 16 * wid + (lane >> 2), ch = (lane & 3) ^ ((dv >> 2) & 3); vsrc = V8t + (size_t)(h * 128 + dv) * M + krow0 + ch * 16; }
    const unsigned kdst = lds0 + (unsigned)wid * 1024u, vdst = lds0 + VO + (unsigned)wid * 1024u;
#define ATT_DMA8(t, slot) do { const unsigned so_ = (unsigned)(slot) * SL; \
        glds16(ksrc + (size_t)(t) * 64 * 1024, (unsigned)__builtin_amdgcn_readfirstlane(kdst + so_)); glds16(vsrc + (size_t)(t) * 64, (unsigned)__builtin_amdgcn_readfirstlane(vdst + so_)); } while (0)
    const int key0 = 32 * ((r32 >> 2) & 1) + (r32 & 3) + 4 * (r32 >> 3);
    const int kx = (key0 >> 1) & 7, vx = (r32 >> 2) & 3;
    const int kc0 = ((c * 4 + 2 * hi) ^ kx) * 16, kc1 = ((c * 4 + 2 * hi + 1) ^ kx) * 16;
    const int vc0 = ((2 * hi) ^ vx) * 16, vc1 = ((2 * hi + 1) ^ vx) * 16;
    v8i qf;
    { const unsigned char* qp = Q8 + (size_t)(qrow0 + qg * 32 + r32) * 1024 + h * 128 + c * 64 + hi * 32;
      qf = cat16(*(const u32x4*)qp, *(const u32x4*)(qp + 16)); }
    float sg[4];
#pragma unroll
    for (int d0 = 0; d0 < 4; ++d0) sg[d0] = subg[d0 * 32 + r32] * osc;
    f32x16 o[4];
#pragma unroll
    for (int d0 = 0; d0 < 4; ++d0) o[d0] = f32x16{};
    float mref = 0.f, lsum = 0.f; f32x16 negm;
#pragma unroll
    for (int r = 0; r < 16; ++r) negm[r] = ATT_TGT;
    const int NS = NT >> 2;
    asm volatile("s_waitcnt vmcnt(0)" ::: "memory");
#pragma unroll
    for (int j = 0; j < 4; ++j) ATT_DMA8(j, j);
    ATT_WAIT_BAR(0);
    if (NS > 1) {
#pragma unroll
        for (int j = 0; j < 4; ++j) ATT_DMA8(4 + j, 4 + j);
    }
#define ATT_KFRAG(kb_, kk) cat16(*(const LAS u32x4*)((kb_) + (key0 + (kk)) * 128 + kc0), *(const LAS u32x4*)((kb_) + (key0 + (kk)) * 128 + kc1))
#define ATT_VFRAG(vb_, d0) cat16(*(const LAS u32x4*)((vb_) + ((d0) * 32 + r32) * 64 + vc0), *(const LAS u32x4*)((vb_) + ((d0) * 32 + r32) * 64 + vc1))
#define ATT_QK(kb_, kk) __builtin_amdgcn_mfma_scale_f32_32x32x64_f8f6f4(ATT_KFRAG(kb_, kk), qf, negm, 0, 0, 0, 0x7A7A7A7A, 0, 0x7A7A7A7A)
    {
        const f32x16 s0 = ATT_QK(lds, 0), s1 = ATT_QK(lds, 16);
        float rm = s0[0];
#pragma unroll
        for (int r = 1; r < 16; ++r) rm = fmaxf(rm, s0[r]);
#pragma unroll
        for (int r = 0; r < 16; ++r) rm = fmaxf(rm, s1[r]);
        mref = half_swap_max(rm) - ATT_TGT;
#pragma unroll
        for (int r = 0; r < 16; ++r) negm[r] = ATT_TGT - mref;
    }
    for (int st = 0; st < NS; ++st) {
        if (st > 0) {
            ATT_WAIT_BAR(0);
            if (st + 1 < NS) {
#pragma unroll
                for (int j = 0; j < 4; ++j) ATT_DMA8(4 * (st + 1) + j, ((st + 1) & 1) * 4 + j);
            }
        }
        const LAS unsigned char* sb_ = lds + (st & 1) * 4 * SL;
        v8i pfp = {0, 0, 0, 0, 0, 0, 0, 0};
#pragma unroll
        for (int j = 0; j < 4; ++j) {
            const LAS unsigned char* kb_ = sb_ + j * SL;
            f32x16 s0 = ATT_QK(kb_, 0), s1 = ATT_QK(kb_, 16);
            if (j > 0) { const LAS unsigned char* vp_ = kb_ - SL + VO;
#pragma unroll
                for (int d0 = 0; d0 < 4; ++d0) o[d0] = __builtin_amdgcn_mfma_scale_f32_32x32x64_f8f6f4(pfp, ATT_VFRAG(vp_, d0), o[d0], 0, 0, 0, 0x7F7F7F7F, 0, 0x7F7F7F7F); }
#pragma unroll
            for (int r = 0; r < 16; ++r) { s0[r] = __builtin_amdgcn_exp2f(s0[r]); s1[r] = __builtin_amdgcn_exp2f(s1[r]); }
            float sa = 0.f, sb = 0.f;
#pragma unroll
            for (int r = 0; r < 16; ++r) { sa += s0[r]; sb += s1[r]; }
            sa += sb;
            if (__any(!(sa <= 448.f))) {
                unsigned ko_ = (unsigned)(uintptr_t)kb_; asm volatile("" : "+v"(ko_));
                const LAS unsigned char* kr_ = (const LAS unsigned char*)(uintptr_t)ko_;
                s0 = ATT_QK(kr_, 0); s1 = ATT_QK(kr_, 16);
                float rm = s0[0];
#pragma unroll
                for (int r = 1; r < 16; ++r) rm = fmaxf(rm, s0[r]);
#pragma unroll
                for (int r = 0; r < 16; ++r) rm = fmaxf(rm, s1[r]);
                rm = half_swap_max(rm);
                const float dl = fmaxf(rm - ATT_TGT, 0.f); mref += dl;
#pragma unroll
                for (int r = 0; r < 16; ++r) negm[r] = ATT_TGT - mref;
                const float f = __builtin_amdgcn_exp2f(-dl); lsum *= f;
                if (hi == 0) wsc[r32] = f;
                asm volatile("s_waitcnt lgkmcnt(0)" ::: "memory");
#pragma unroll
                for (int r = 0; r < 16; ++r) { const float fr_ = wsc[crow(r, hi)];
#pragma unroll
                    for (int d0 = 0; d0 < 4; ++d0) o[d0][r] *= fr_; }
                asm volatile("s_waitcnt lgkmcnt(0)" ::: "memory");
#pragma unroll
                for (int r = 0; r < 16; ++r) { s0[r] = __builtin_amdgcn_exp2f(s0[r] - dl); s1[r] = __builtin_amdgcn_exp2f(s1[r] - dl); }
                sa = 0.f; sb = 0.f;
#pragma unroll
                for (int r = 0; r < 16; ++r) { sa += s0[r]; sb += s1[r]; }
                sa += sb;
            }
            lsum += sa;
#pragma unroll
            for (int jj = 0; jj < 4; ++jj) { int w = __builtin_bit_cast(int, s0[4 * jj]); w = __builtin_amdgcn_cvt_pk_fp8_f32(s0[4 * jj], s0[4 * jj + 1], w, false); w = __builtin_amdgcn_cvt_pk_fp8_f32(s0[4 * jj + 2], s0[4 * jj + 3], w, true); pfp[jj] = w;
                int w2 = __builtin_bit_cast(int, s1[4 * jj]); w2 = __builtin_amdgcn_cvt_pk_fp8_f32(s1[4 * jj], s1[4 * jj + 1], w2, false); w2 = __builtin_amdgcn_cvt_pk_fp8_f32(s1[4 * jj + 2], s1[4 * jj + 3], w2, true); pfp[4 + jj] = w2; }
        }
        {
            const LAS unsigned char* vl_ = sb_ + 3 * SL + VO;
#pragma unroll
            for (int d0 = 0; d0 < 4; ++d0) o[d0] = __builtin_amdgcn_mfma_scale_f32_32x32x64_f8f6f4(pfp, ATT_VFRAG(vl_, d0), o[d0], 0, 0, 0, 0x7F7F7F7F, 0, 0x7F7F7F7F);
        }
    }
#undef ATT_KFRAG
#undef ATT_VFRAG
#undef ATT_QK
    const float lt = half_swap_sum(lsum);
    if (hi == 0) wsc[64 + r32] = (c ? -lam : 1.f) * __builtin_amdgcn_rcpf(16.f * lt);
    asm volatile("s_waitcnt lgkmcnt(0)\n\ts_barrier" ::: "memory");
    LAS float* xch = (LAS float*)(lds + qg * 16384);
#pragma unroll
    for (int r = 0; r < 16; ++r) { const float a = wsc[64 + crow(r, hi)];
#pragma unroll
        for (int d0 = 0; d0 < 4; ++d0) o[d0][r] *= a; }
    if (c == 1) {
#pragma unroll
        for (int d0 = 0; d0 < 4; ++d0)
#pragma unroll
            for (int r = 0; r < 16; ++r) xch[(d0 * 16 + r) * 64 + lane] = o[d0][r];
    }
    asm volatile("s_waitcnt lgkmcnt(0)\n\ts_barrier" ::: "memory");
    if (c == 0) {
        constexpr int OB = FP8_ATT_O ? 1 : 2;
        LAS unsigned char* stg = lds + 65536 + qg * 8192;
#pragma unroll
        for (int d0 = 0; d0 < 4; ++d0)
#pragma unroll
            for (int r = 0; r < 16; ++r) o[d0][r] += xch[(d0 * 16 + r) * 64 + lane];
        float ss[16], tt[16];
#pragma unroll
        for (int r = 0; r < 16; ++r) { float x = (o[0][r] * o[0][r] + o[1][r] * o[1][r]) + (o[2][r] * o[2][r] + o[3][r] * o[3][r]);
            x += __builtin_bit_cast(float, __builtin_amdgcn_update_dpp(0, __builtin_bit_cast(int, x), 0xB1, 0xF, 0xF, true));
            x += __builtin_bit_cast(float, __builtin_amdgcn_update_dpp(0, __builtin_bit_cast(int, x), 0x4E, 0xF, 0xF, true));
            x += __builtin_bit_cast(float, __builtin_amdgcn_update_dpp(0, __builtin_bit_cast(int, x), 0x124, 0xF, 0xF, true));
            x += __builtin_bit_cast(float, __builtin_amdgcn_update_dpp(0, __builtin_bit_cast(int, x), 0x128, 0xF, 0xF, true));
            ss[r] = x; }
#pragma unroll
        for (int r = 0; r < 16; ++r) tt[r] = __shfl_xor(ss[r], 16);
#pragma unroll
        for (int r = 0; r < 16; ++r) { const int qr = crow(r, hi); const float rn = __builtin_amdgcn_rsqf((ss[r] + tt[r]) * (1.f / 128.f) + EPS);
#pragma unroll
            for (int d0 = 0; d0 < 4; ++d0) { const float ov = o[d0][r] * rn * sg[d0];
                if (FP8_ATT_O) { const float o4 = clamp8(4.f * ov); *(LAS unsigned char*)(stg + qr * 128 + d0 * 32 + r32) = (unsigned char)(__builtin_amdgcn_cvt_pk_fp8_f32(o4, o4, 0, false) & 0xff); }
                else *(LAS unsigned short*)(stg + (qr * 128 + d0 * 32 + r32) * 2) = (unsigned short)f2bf(ov); } }
        asm volatile("s_waitcnt lgkmcnt(0)" ::: "memory");
        unsigned char* Ob = (unsigned char*)O + ((size_t)(qrow0 + qg * 32) * 1024 + h * 128) * OB;
#pragma unroll
        for (int k = 0; k < 4 * OB; ++k) { const int off = lane * 16 + 1024 * k, row = off / (128 * OB), cb = off % (128 * OB);
            *(u32x4*)(Ob + (size_t)row * 1024 * OB + cb) = *(const LAS u32x4*)(stg + off); }
    }
    asm volatile("s_waitcnt lgkmcnt(0)\n\ts_barrier" ::: "memory");
#undef ATT_DMA8
}
}

#if ATT_FP8
#define ATT_CALL(l_, w_, q_, k_, v_, o_, ...) att::attn_unit8(l_, w_, (const unsigned char*)(q_), (const unsigned char*)(k_), (const unsigned char*)(v_), o_, __VA_ARGS__)
#else
#define ATT_CALL att::attn_unit
#endif
__device__ __forceinline__ void load_row_f32(const float* p, int lane, f32x4 (&v)[4]) {
#pragma unroll
    for (int j = 0; j < 4; ++j) v[j] = *(const f32x4*)(p + 256 * j + 4 * lane);
}
__device__ __forceinline__ void load_row_x(const void* Xb, size_t row, int lane, f32x4 (&v)[4]) {
    if (X_BF16) { const bf16* p = (const bf16*)Xb + row * D;
#pragma unroll
        for (int j = 0; j < 4; ++j) { const u32x2 w = *(const u32x2*)(p + 256 * j + 4 * lane);
            v[j] = (f32x4){bf2f((unsigned short)(w.x & 0xffffu)), bf2f((unsigned short)(w.x >> 16)), bf2f((unsigned short)(w.y & 0xffffu)), bf2f((unsigned short)(w.y >> 16))}; } }
    else load_row_f32((const float*)Xb + row * D, lane, v);
}
__device__ __forceinline__ void store_row_x(void* Xb, size_t row, int lane, const f32x4 (&v)[4]) {
    if (X_BF16) { bf16* p = (bf16*)Xb + row * D;
#pragma unroll
        for (int j = 0; j < 4; ++j) { u32x2 w; w.x = cvt_pk_bf16(v[j][0], v[j][1]); w.y = cvt_pk_bf16(v[j][2], v[j][3]); *(u32x2*)(p + 256 * j + 4 * lane) = w; } }
    else { float* p = (float*)Xb + row * D;
#pragma unroll
        for (int j = 0; j < 4; ++j) *(f32x4*)(p + 256 * j + 4 * lane) = v[j]; }
}
__device__ __forceinline__ float row_rstd(const f32x4 (&v)[4]) {
    float s = 0.f;
#pragma unroll
    for (int j = 0; j < 4; ++j) s += (v[j][0] * v[j][0] + v[j][1] * v[j][1]) + (v[j][2] * v[j][2] + v[j][3] * v[j][3]);
    return 1.0f / sqrtf(wave_sum(s) * (1.f / D) + EPS);
}
__device__ __forceinline__ void norm_mod_store(f32x4 (&v)[4], const float* g, const float* sc, const float* sh, int lane, bf16* hrow) {
    const float rstd = row_rstd(v);
#pragma unroll
    for (int j = 0; j < 4; ++j) { const int c = 256 * j + 4 * lane; const f32x4 gg = *(const f32x4*)(g + c), ss = *(const f32x4*)(sc + c), hh = *(const f32x4*)(sh + c);
        v[j] = (v[j] * rstd) * gg * (ss + 1.f) + hh;
        u32x2 w; w.x = cvt_pk_bf16(v[j][0], v[j][1]); w.y = cvt_pk_bf16(v[j][2], v[j][3]); *(u32x2*)(hrow + c) = w; }
}
__device__ __forceinline__ void norm_mod_f32(f32x4 (&v)[4], const float* g, const float* sc, const float* sh, int lane) {
    const float rstd = row_rstd(v);
#pragma unroll
    for (int j = 0; j < 4; ++j) { const int c = 256 * j + 4 * lane; const f32x4 gg = *(const f32x4*)(g + c), ss = *(const f32x4*)(sc + c), hh = *(const f32x4*)(sh + c);
        v[j] = (v[j] * rstd) * gg * (ss + 1.f) + hh; }
}
__device__ __forceinline__ void norm_mod_store_mix(bool f8, f32x4 (&v)[4], const float* g, const float* sc, const float* sh, int lane, bf16* hrow, unsigned char* h8row) {
    if (f8) { norm_mod_f32(v, g, sc, sh, lane);
#pragma unroll
        for (int j = 0; j < 4; ++j) *(unsigned*)(h8row + 256 * j + 4 * lane) = pack_fp8x4(16.f * v[j][0], 16.f * v[j][1], 16.f * v[j][2], 16.f * v[j][3]); }
    else norm_mod_store(v, g, sc, sh, lane, hrow);
}
__device__ __forceinline__ int row_batch(int row) { return row / RPB; }
__device__ __forceinline__ bool row_is_ctx(int row) { return (row % RPB) < CTXL; }
__device__ __forceinline__ int act_row(int ai, bool lat_only) { return lat_only ? (ai >> 11) * RPB + CTXL + (ai & 2047) : ai; }

template <int MODE>
__device__ __forceinline__ void transpose_item(const float* W, int K, int N, bf16* WT, LAS float* scr, int item, int lane) {
    const int nblk = N / 32, kb = item / nblk, nb = item % nblk, k0 = 64 * kb, n0 = 32 * nb;
#pragma unroll 8
    for (int i = 0; i < 32; ++i) { const int kk = 2 * i + (lane >> 5); scr[kk * 33 + (lane & 31)] = W[(size_t)(k0 + kk) * N + n0 + (lane & 31)]; }
    asm volatile("s_waitcnt lgkmcnt(0)" ::: "memory");
    const int c = lane & 7;
#pragma unroll
    for (int j = 0; j < 4; ++j) { const int n = (lane >> 3) + 8 * j; const LAS float* s = scr + (8 * c) * 33 + n;
        u32x4 o; o.x = cvt_pk_bf16(s[0 * 33], s[1 * 33]); o.y = cvt_pk_bf16(s[2 * 33], s[3 * 33]); o.z = cvt_pk_bf16(s[4 * 33], s[5 * 33]); o.w = cvt_pk_bf16(s[6 * 33], s[7 * 33]);
        int nn = n0 + n;
        if (MODE == 1 && nn < 2048) { const int i6 = nn & 63; nn = (nn & ~63) + (i6 < 32 ? 2 * i6 : 2 * (i6 - 32) + 1); }
        if (MODE == 2 && nn >= 1024) nn = nn < 2048 ? 1024 + 2 * (nn - 1024) : 1024 + 2 * (nn - 2048) + 1;
        *(u32x4*)(WT + (size_t)nn * K + k0 + 8 * c) = o; }
    asm volatile("s_waitcnt lgkmcnt(0)" ::: "memory");
}

template <int MODE = 0>
__device__ __forceinline__ void transpose_item8(const float* W, int K, int N, unsigned char* WT, LAS float* scr, int item, int lane) {
    const int nblk = N / 16, kb = item / nblk, nb = item % nblk, k0 = 128 * kb, n0 = 16 * nb;
    f32x4 v[8];
#pragma unroll
    for (int i = 0; i < 8; ++i) v[i] = *(const f32x4*)(W + (size_t)(k0 + 16 * i + (lane >> 2)) * N + n0 + 4 * (lane & 3));
#pragma unroll
    for (int i = 0; i < 8; ++i) *(LAS f32x4*)(scr + (16 * i + (lane >> 2)) * 20 + 4 * (lane & 3)) = v[i] * 1024.f;
    asm volatile("s_waitcnt lgkmcnt(0)" ::: "memory");
    const int kc = lane & 7;
#pragma unroll
    for (int j = 0; j < 2; ++j) { const int n = (lane >> 3) + 8 * j; const LAS float* s = scr + (16 * kc) * 20 + n;
        u32x4 o;
        o.x = pack_fp8x4(s[0 * 20], s[1 * 20], s[2 * 20], s[3 * 20]); o.y = pack_fp8x4(s[4 * 20], s[5 * 20], s[6 * 20], s[7 * 20]);
        o.z = pack_fp8x4(s[8 * 20], s[9 * 20], s[10 * 20], s[11 * 20]); o.w = pack_fp8x4(s[12 * 20], s[13 * 20], s[14 * 20], s[15 * 20]);
        int nn = n0 + n;
        if (MODE == 1 && nn < 2048) { const int i6 = nn & 63; nn = (nn & ~63) + (i6 < 32 ? 2 * i6 : 2 * (i6 - 32) + 1); }
        *(u32x4*)(WT + (size_t)nn * K + k0 + 16 * kc) = o; }
    asm volatile("s_waitcnt lgkmcnt(0)" ::: "memory");
}

__device__ __forceinline__ void item8_load(const float* W, int N, int item, int lane, f32x4 (&v)[8]) {
    const int nblk = N / 16, kb = item / nblk, nb = item % nblk, k0 = 128 * kb, n0 = 16 * nb;
#pragma unroll
    for (int i = 0; i < 8; ++i) v[i] = *(const f32x4*)(W + (size_t)(k0 + 16 * i + (lane >> 2)) * N + n0 + 4 * (lane & 3));
}
__device__ __forceinline__ void item8_store(const f32x4 (&v)[8], int K, int N, unsigned char* WT, LAS float* scr, int item, int lane) {
    const int nblk = N / 16, kb = item / nblk, nb = item % nblk, k0 = 128 * kb, n0 = 16 * nb;
    const float ge = (N == 2048) ? 1024.f * GATE_PRE : 1024.f; const f32x4 mulv = {ge, 1024.f, ge, 1024.f};
#pragma unroll
    for (int i = 0; i < 8; ++i) *(LAS f32x4*)(scr + (16 * i + (lane >> 2)) * 20 + 4 * (lane & 3)) = v[i] * mulv;
    asm volatile("s_waitcnt lgkmcnt(0)" ::: "memory");
    const int kc = lane & 7;
#pragma unroll
    for (int j = 0; j < 2; ++j) { const int n = (lane >> 3) + 8 * j; const LAS float* s = scr + (16 * kc) * 20 + n;
        u32x4 o;
        o.x = pack_fp8x4(s[0 * 20], s[1 * 20], s[2 * 20], s[3 * 20]); o.y = pack_fp8x4(s[4 * 20], s[5 * 20], s[6 * 20], s[7 * 20]);
        o.z = pack_fp8x4(s[8 * 20], s[9 * 20], s[10 * 20], s[11 * 20]); o.w = pack_fp8x4(s[12 * 20], s[13 * 20], s[14 * 20], s[15 * 20]);
        *(u32x4*)(WT + (size_t)(n0 + n) * K + k0 + 16 * kc) = o; }
    asm volatile("s_waitcnt lgkmcnt(0)" ::: "memory");
}

struct Args { const float* in[21]; float* out; unsigned char* ws; int ph_lo, ph_hi; };
enum { I_X = 0, I_C, I_CTX, I_CCTX, I_MODW, I_MODB, I_NORMG, I_WQKV, I_WO, I_LAM, I_SUBG, I_WIN, I_CONVW, I_WOUT, I_RW, I_RB, I_WGU, I_BGU, I_WD, I_BD, I_FINALG };

__device__ __forceinline__ void moe_table(LAS unsigned char* lds, const unsigned* gcnt, int tid) {
    LAS int* ecnt = (LAS int*)(lds + LX_ECNT); LAS int* tstart = (LAS int*)(lds + LX_TSTART); LAS int* tile_e = (LAS int*)(lds + LX_TILEE);
    __syncthreads();
    if (tid < 32) ecnt[tid] = (int)__hip_atomic_load(gcnt + tid, RLX_AGENT);
    __syncthreads();
    if (tid == 0) { int ts = 0; for (int e = 0; e < 32; ++e) { tstart[e] = ts; ts += (ecnt[e] + 255) >> 8; } tstart[32] = ts; }
    __syncthreads();
    { const int e = tid >> 4, l16 = tid & 15; const int t0 = tstart[e], n = tstart[e + 1] - t0; for (int j = l16; j < n; j += 16) tile_e[t0 + j] = e; }
    __syncthreads();
}

typedef const __attribute__((address_space(4))) unsigned char* kptr_t;
__device__ __forceinline__ kptr_t kargs() { kptr_t p = (kptr_t)__builtin_amdgcn_kernarg_segment_ptr(); asm volatile("" : "+s"(p)); return p; }
#define INP(k) (*(const float* const __attribute__((address_space(4)))*)(kargs() + 8 * (k)))
#define OUTP() (*(float* const __attribute__((address_space(4)))*)(kargs() + 168))
#define WSB() (*(unsigned char* const __attribute__((address_space(4)))*)(kargs() + 176))
#define WSP(T, off) ((T*)(WSB() + (off)))
static_assert(sizeof(Args) == 192, "kernarg layout");
__global__ void __launch_bounds__(NTHREADS, 2) fwd(Args args) {
    extern __shared__ __attribute__((aligned(16))) unsigned char lds_raw[];
    LAS unsigned char* lds = (LAS unsigned char*)lds_raw;
    const int tid = threadIdx.x, lane = tid & 63, wave = __builtin_amdgcn_readfirstlane(tid >> 6);
    const int G = gridDim.x, bid = blockIdx.x;
    const int gw = bid * NWAVES + wave, NGW = G * NWAVES;
    gu32* ctl = (gu32*)WSP(unsigned, WS_CTL);
    for (int u = tid; u < (LDS_BYTES - LX) / 4; u += NTHREADS) ((LAS unsigned*)(lds + LX))[u] = 0u;
    __syncthreads();
    volatile LAS unsigned* MISC = (volatile LAS unsigned*)(lds + LX_MISC);
    XcdBarrier bar; bar.bar = (unsigned*)(ctl + CW_BAR); bar.x = 0; bar.st = nullptr;
    if (!MK_PER_PHASE) bar = xcd_barrier_post((unsigned*)(ctl + CW_BAR), MISC + 8);
    (void)args;
    const unsigned long long pt_start = PROBE_T ? __builtin_amdgcn_s_memtime() : 0ull; (void)pt_start;
    const unsigned long long pt_rstart = PROBE_T ? __builtin_amdgcn_s_memrealtime() : 0ull; (void)pt_rstart;
    const int lo = *(const int __attribute__((address_space(4)))*)(kargs() + 184), hi = *(const int __attribute__((address_space(4)))*)(kargs() + 188);
#define IN(k) (lo <= (k) && (k) < hi)
#define PHASE_IDS int tid = threadIdx.x; asm volatile("" : "+v"(tid)); const int lane = tid & 63, wave = __builtin_amdgcn_readfirstlane(tid >> 6); const int gw = bid * NWAVES + wave; (void)lane; (void)gw;
#define SEAM(k) do { if (IN(k) && IN((k) + 1)) { if (MK_PER_PHASE) { if (tid == 0) __hip_atomic_store(ctl + CW_TMO, 0xBADu, RLX_AGENT); } else { unsigned long long b0_ = 0; if (PROBE_T == 10) b0_ = __builtin_amdgcn_s_memtime(); xcd_barrier(bar); if (PROBE_REP & 0x10000) xcd_barrier(bar); if (PROBE_T == 10 && bid == PROBE_BID && threadIdx.x == 0) *(LAS unsigned long long*)(lds + LX_MISC + 64) += __builtin_amdgcn_s_memtime() - b0_; } } } while (0)

    if (PS(0) && IN(0)) { PHASE_IDS
        float* modv = WSP(float, WS_MODV);
        unsigned long long p0t_ = (PROBE_T == 11 || PROBE_T == 12) ? __builtin_amdgcn_s_memtime() : 0ull; (void)p0t_;
        { LAS float* sil = (LAS float*)lds;
          LAS float* red = (LAS float*)(lds + 69632);
          for (int i = tid; i < 17 * 1024; i += NTHREADS) { const int r = i >> 10, k = i & 1023; const float cv = r < 16 ? INP(I_C)[r * 1024 + k] : INP(I_CCTX)[k]; sil[i] = cv / (1.f + __expf(-cv)); }
          __syncthreads();
          for (int it = bid; it < 4 * 96; it += G) { const int l = it / 96, nb = it % 96; const float* W = INP(I_MODW) + (size_t)l * 1024 * 6144 + nb * 64 + lane;
            float a[17];
#pragma unroll
            for (int r = 0; r < 17; ++r) a[r] = 0.f;
            for (int k = wave * 128; k < wave * 128 + 128; k += 4) { float w[4];
#pragma unroll
                for (int q = 0; q < 4; ++q) w[q] = W[(size_t)(k + q) * 6144];
#pragma unroll
                for (int r = 0; r < 17; ++r) { const f32x4 s = *(const LAS f32x4*)(sil + r * 1024 + k); a[r] += s[0] * w[0] + s[1] * w[1] + s[2] * w[2] + s[3] * w[3]; } }
#pragma unroll
            for (int r = 0; r < 17; ++r) red[(wave * 17 + r) * 64 + lane] = a[r];
            __syncthreads();
            for (int i = tid; i < 17 * 64; i += NTHREADS) { const int r = i >> 6, n = i & 63; float s = INP(I_MODB)[l * 6144 + nb * 64 + n];
#pragma unroll
                for (int w8 = 0; w8 < 8; ++w8) s += red[(w8 * 17 + r) * 64 + n];
                modv[((size_t)l * 17 + r) * 6144 + nb * 64 + n] = s; }
            __syncthreads(); }
        }
        if (PROBE_T == 11 && bid == 0 && tid == 0) *(LAS unsigned long long*)(lds + LX_MISC + 64) += __builtin_amdgcn_s_memtime() - p0t_;
        { float* cosT = WSP(float, WS_ROPE); float* sinT = cosT + 2048 * 32; float* rwT = WSP(float, WS_RW); float* lamv = WSP(float, WS_MISC);
        for (int i = bid * NTHREADS + tid; i < 2048 * 32; i += G * NTHREADS) { const int t = i >> 5, j = i & 31; const float pos = (float)(j < 16 ? (t >> 6) : (t & 63));
            const float inv = powf(10000.f, -(float)(2 * (j & 15)) / 32.f); const float ang = pos * inv; cosT[i] = cosf(ang); sinT[i] = sinf(ang); }
        if (bid == 0 && tid < 2) { const float* lp = INP(I_LAM) + tid * 256; float s1 = 0.f, s2 = 0.f; for (int d = 0; d < 64; ++d) { s1 += lp[d] * lp[64 + d]; s2 += lp[128 + d] * lp[192 + d]; }
            const float lam_init = 0.8f - 0.6f * expf(-0.3f * (float)(2 * tid)); lamv[tid] = expf(s1) - expf(s2) + lam_init; lamv[2 + tid] = 1.f - lam_init; }
        for (int i = bid * NTHREADS + tid; i < 4 * 32 * 1024; i += G * NTHREADS) { const int l = i >> 15, e = (i >> 10) & 31, k = i & 1023; rwT[i] = INP(I_RW)[((size_t)l * 1024 + k) * 32 + e]; } }
        if (PROBE_T == 12) p0t_ = __builtin_amdgcn_s_memtime();
        { LAS float* scr = (LAS float*)(lds + wave * 10240);
          bf16* Wqkv_t = WSP(bf16, WS_WQKV); bf16* Win_t = WSP(bf16, WS_WIN); bf16* Wo_t = WSP(bf16, WS_WO); bf16* Wout_t = WSP(bf16, WS_WOUT); bf16* Wgu_t = WSP(bf16, WS_WGU); bf16* Wd_t = WSP(bf16, WS_WD);
          constexpr int I_QKV = 16 * 96, I_SQ = 16 * 32, I_GU = 16 * 64, I_D = 16 * 32;
          constexpr int T0 = 2 * I_QKV, T1 = T0 + 2 * I_QKV, T2 = T1 + 2 * I_SQ, T3 = T2 + 2 * I_SQ, T4 = T3 + 128 * I_GU, T5 = T4 + 128 * I_D;
          for (int rep = 0; rep < NREP(0); ++rep) {
          for (int it = gw; it < (MOE_FP8 ? T3 : T5); it += NGW) {
            if (it < T0) { const int j = it / I_QKV; if (FP8_ATT) transpose_item8<1>(INP(I_WQKV) + (size_t)j * 1024 * 3072, 1024, 3072, (unsigned char*)Wqkv_t + (size_t)j * 3072 * 1024, scr, it % I_QKV, lane); else transpose_item<1>(INP(I_WQKV) + (size_t)j * 1024 * 3072, 1024, 3072, Wqkv_t + (size_t)j * 3072 * 1024, scr, it % I_QKV, lane); }
            else if (it < T1) { const int r = it - T0, j = r / I_QKV; if (FP8_CONV) transpose_item8<0>(INP(I_WIN) + (size_t)j * 1024 * 3072, 1024, 3072, (unsigned char*)Win_t + (size_t)j * 3072 * 1024, scr, r % I_QKV, lane); else transpose_item<CONV_FUSE_U ? 2 : 0>(INP(I_WIN) + (size_t)j * 1024 * 3072, 1024, 3072, Win_t + (size_t)j * 3072 * 1024, scr, r % I_QKV, lane); }
            else if (it < T2) { const int r = it - T1, j = r / I_SQ; if (FP8_ATT_O) transpose_item8<0>(INP(I_WO) + (size_t)j * 1024 * 1024, 1024, 1024, (unsigned char*)Wo_t + (size_t)j * 1024 * 1024, scr, r % I_SQ, lane); else transpose_item<0>(INP(I_WO) + (size_t)j * 1024 * 1024, 1024, 1024, Wo_t + (size_t)j * 1024 * 1024, scr, r % I_SQ, lane); }
            else if (it < T3) { const int r = it - T2, j = r / I_SQ; if (FP8_WOUT) transpose_item8<0>(INP(I_WOUT) + (size_t)j * 1024 * 1024, 1024, 1024, (unsigned char*)Wout_t + (size_t)j * 1024 * 1024, scr, r % I_SQ, lane); else transpose_item<0>(INP(I_WOUT) + (size_t)j * 1024 * 1024, 1024, 1024, Wout_t + (size_t)j * 1024 * 1024, scr, r % I_SQ, lane); }
            else if (it < T4) { const int r = it - T3, j = r / I_GU; transpose_item<0>(INP(I_WGU) + (size_t)j * 1024 * 2048, 1024, 2048, Wgu_t + (size_t)j * 2048 * 1024, scr, r % I_GU, lane); }
            else { const int r = it - T4, j = r / I_D; transpose_item<0>(INP(I_WD) + (size_t)j * 1024 * 1024, 1024, 1024, Wd_t + (size_t)j * 1024 * 1024, scr, r % I_D, lane); }
          }
          if (MOE_FP8) {
            constexpr int NGUI = 128 * I_GU, NMOE = NGUI + 128 * I_D;
            const float* wgu = INP(I_WGU); const float* wd = INP(I_WD);
#define MOE_DEC(r_, W_, N_, WT_, IT_) do { if ((r_) < NGUI) { const int j_ = (r_) / I_GU; W_ = wgu + (size_t)j_ * 1024 * 2048; N_ = 2048; WT_ = (unsigned char*)Wgu_t + (size_t)j_ * 2048 * 1024; IT_ = (r_) % I_GU; } \
              else { const int q_ = (r_) - NGUI, j_ = q_ / I_D; W_ = wd + (size_t)j_ * 1024 * 1024; N_ = 1024; WT_ = (unsigned char*)Wd_t + (size_t)j_ * 1024 * 1024; IT_ = q_ % I_D; } } while (0)
            f32x4 vc[8], vn[8]; const float* Wc = nullptr; int Nc = 0, itc = 0; unsigned char* WTc = nullptr;
            int r = gw;
            if (r < NMOE) { MOE_DEC(r, Wc, Nc, WTc, itc); item8_load(Wc, Nc, itc, lane, vc); }
            for (; r < NMOE; r += NGW) { const int rn = r + NGW; const bool hn = rn < NMOE; const float* Wn = Wc; int Nn = Nc, itn = itc; unsigned char* WTn = WTc;
                if (hn) { MOE_DEC(rn, Wn, Nn, WTn, itn); item8_load(Wn, Nn, itn, lane, vn); }
                item8_store(vc, 1024, Nc, WTc, scr, itc, lane);
                if (hn) { Wc = Wn; Nc = Nn; itc = itn; WTc = WTn;
#pragma unroll
                    for (int i = 0; i < 8; ++i) vc[i] = vn[i]; } }
#undef MOE_DEC
          }
          }
        }
        if (PROBE_T == 12 && bid == 0 && tid == 0) *(LAS unsigned long long*)(lds + LX_MISC + 64) += __builtin_amdgcn_s_memtime() - p0t_;
        __syncthreads();
    }
    SEAM(0);

    if (PS(1) && IN(1)) { PHASE_IDS
        const float* g = INP(I_NORMG); const float* modv = WSP(float, WS_MODV); float* X = WSP(float, WS_X); bf16* H = WSP(bf16, WS_H);
        for (int row = gw; row < M; row += NGW) { const int b = row_batch(row), jj = row % RPB; const bool cx = jj < CTXL; const int rb = cx ? 16 : b;
            const float* src = cx ? INP(I_CTX) + ((size_t)b * CTXL + jj) * D : INP(I_X) + ((size_t)b * SEQ + (jj - CTXL)) * D;
            f32x4 v[4]; load_row_f32(src, lane, v);
            norm_mod_store_mix(FP8_ATT != 0, v, g, modv + rb * 6144 + 1024, modv + rb * 6144, lane, H + (size_t)row * D, WSP(unsigned char, WS_H8) + (size_t)row * 1024); }
    }
    SEAM(1);

    for (int l = 0; l < DEPTH; ++l) {
        const int pb = 2 + 7 * l; const bool attn = (l & 1) == 0; const int j2 = l >> 1; const bool lat_only = (l == DEPTH - 1);
#define MV() (WSP(float, WS_MODV) + (size_t)l * 17 * 6144)
        const unsigned* gcnt = (const unsigned*)(ctl + CW_CNT) + l * 32;

        if (IN(pb)) { PHASE_IDS
            if (PS(2) && attn) {
                constexpr int RBX = FP8_ATT ? 1024 : 2048; constexpr int SCX = FP8_ATT ? 0x78787878 : 0;
                typedef SchedQKV<RBX, SCX> SQ;
                SQ S{FP8_ATT ? (const char*)WSP(unsigned char, WS_H8) : (const char*)WSP(bf16, WS_H), (const char*)WSP(bf16, WS_WQKV) + (size_t)j2 * 3072 * RBX};
                EpiQKV E{WSP(bf16, WS_Q), WSP(bf16, WS_K), WSP(bf16, WS_VT), WSP(float, WS_ROPE), WSP(float, WS_ROPE) + 2048 * 32, true, lds + LX_EPI};
                for (int rep = 0; rep < NREP(2); ++rep) { int z_ = rep; asm volatile("" : "+s"(z_)); E.dost = !PROBE_NOST || (z_ == NREP(2) - 1); pg8::gemm_phase<EpiQKV, SQ, 2>(lds, S, E, tid, STAG(1500)); }
            } else if (PS(3)) {
                constexpr int RBX = FP8_CONV ? 1024 : 2048; constexpr int SCX = FP8_CONV ? 0x78787878 : 0;
                typedef SchedPlain<RBX, SCX> SP;
                SP S{FP8_CONV ? (const char*)WSP(unsigned char, WS_H8) : (const char*)WSP(bf16, WS_H), (const char*)WSP(bf16, WS_WIN) + (size_t)j2 * 3072 * RBX, 12, lat_only};
                if (CONV_FUSE_U) { EpiConvIn E{WSP(bf16, WS_BCO), WSP(bf16, WS_BCO) + (size_t)M * 1024};
                    for (int rep = 0; rep < NREP(3); ++rep) pg8::gemm_phase<EpiConvIn, SP, 3>(lds, S, E, tid, STAG(1500)); }
                else { EpiPlain E{WSP(bf16, WS_BCO), 3072};
                    for (int rep = 0; rep < NREP(3); ++rep) pg8::gemm_phase<EpiPlain, SP, 3>(lds, S, E, tid, STAG(1500)); }
            }
        }
        SEAM(pb);

        if (IN(pb + 1)) { PHASE_IDS
            if (PS(4) && attn) {
                const float* lamv = WSP(float, WS_MISC); const float lam = lamv[j2], osc = lamv[2 + j2]; const float* subg = INP(I_SUBG) + j2 * 128;
                const bf16* Qb = WSP(bf16, WS_Q); const bf16* Kb = WSP(bf16, WS_K); const bf16* Vt = WSP(bf16, WS_VT); bf16* Ob = WSP(bf16, WS_O);
                LAS float* wsc = (LAS float*)(lds + LX_WSC + wave * 1024);
                const int vcu = (G % 8 == 0) ? (bid % 8) * (G / 8) + bid / 8 : bid;
                for (int rep = 0; rep < NREP(4); ++rep)
                if (G == 256) {
                    const int xc = bid & 7, j = bid >> 3;
                    for (int sstep = 0; sstep < 8; ++sstep) { const int bh = xc * 16 + 2 * sstep + (j >> 4), b = bh >> 3, h = bh & 7;
                        ATT_CALL(lds, wsc, Qb, Kb, Vt, Ob, b * RPB, h, b * RPB + CTXL + (j & 15) * 128, 36, lam, osc, subg, tid); }
                    { const int bh = xc * 16 + (j >> 1), b = bh >> 3, h = bh & 7;
                      ATT_CALL(lds, wsc, Qb, Kb, Vt, Ob, b * RPB, h, b * RPB + (j & 1) * 128, 4, lam, osc, subg, tid); }
                } else {
                    for (int u = bid; u < 128 * 18; u += G) { const int bh = u / 18, k = u % 18, b = bh >> 3, h = bh & 7;
                        ATT_CALL(lds, wsc, Qb, Kb, Vt, Ob, b * RPB, h, k < 16 ? b * RPB + CTXL + k * 128 : b * RPB + (k - 16) * 128, k < 16 ? 36 : 4, lam, osc, subg, tid); }
                }
            } else if (PS(5)) {
                const float* cw = INP(I_CONVW) + (size_t)j2 * 3 * 1024; const bf16* BCO = WSP(bf16, WS_BCO); bf16* Ob = WSP(bf16, WS_O);
                const int nact = lat_only ? 32768 : M; const int nitems = (nact / 16) * 2;
                for (int it = gw; it < nitems; it += NGW) { const int strip = it >> 1, ch = (it & 1) * 512 + lane * 8; const int row0 = act_row(strip * 16, lat_only);
                    const int jj = row0 % RPB; const int seq_lo = jj < CTXL ? row0 - jj : row0 - jj + CTXL, seq_hi = jj < CTXL ? row0 - jj + CTXL : row0 - jj + RPB;
                    float w0[8], w1[8], w2[8];
#pragma unroll
                    for (int q = 0; q < 8; ++q) { w0[q] = cw[ch + q]; w1[q] = cw[1024 + ch + q]; w2[q] = cw[2048 + ch + q]; }
                    float up[8], uc[8], un[8];
                    auto load_u = [&](int row, float (&u)[8]) {
                        if (row < seq_lo || row >= seq_hi) {
#pragma unroll
                            for (int q = 0; q < 8; ++q) u[q] = 0.f;
                        } else if (CONV_FUSE_U) { const u32x4 uu = *(const u32x4*)(BCO + (size_t)M * 1024 + (size_t)row * 1024 + ch);
#pragma unroll
                            for (int q = 0; q < 4; ++q) { u[2 * q] = bf2f((unsigned short)(uu[q] & 0xffffu)); u[2 * q + 1] = bf2f((unsigned short)(uu[q] >> 16)); }
                        } else { const bf16* p = BCO + (size_t)row * 3072; const u32x4 gc = *(const u32x4*)(p + 1024 + ch), xt = *(const u32x4*)(p + 2048 + ch);
#pragma unroll
                            for (int q = 0; q < 4; ++q) { u[2 * q] = bf2f((unsigned short)(gc[q] & 0xffffu)) * bf2f((unsigned short)(xt[q] & 0xffffu)); u[2 * q + 1] = bf2f((unsigned short)(gc[q] >> 16)) * bf2f((unsigned short)(xt[q] >> 16)); } } };
                    load_u(row0 - 1, up); load_u(row0, uc);
                    for (int r = 0; r < 16; ++r) { const int row = row0 + r; load_u(row + 1, un);
                        const u32x4 gb = *(const u32x4*)(BCO + (size_t)row * (CONV_FUSE_U ? 1024 : 3072) + ch); float z[8];
#pragma unroll
                        for (int q = 0; q < 8; ++q) { const float gbv = bf2f((unsigned short)((q & 1) ? (gb[q >> 1] >> 16) : (gb[q >> 1] & 0xffffu))); z[q] = gbv * (w0[q] * up[q] + w1[q] * uc[q] + w2[q] * un[q]); }
                        if (FP8_WOUT) { u32x2 o; o.x = pack_fp8x4(4.f * z[0], 4.f * z[1], 4.f * z[2], 4.f * z[3]); o.y = pack_fp8x4(4.f * z[4], 4.f * z[5], 4.f * z[6], 4.f * z[7]); *(u32x2*)((unsigned char*)Ob + (size_t)row * 1024 + ch) = o; }
                        else { u32x4 o; o.x = cvt_pk_bf16(z[0], z[1]); o.y = cvt_pk_bf16(z[2], z[3]); o.z = cvt_pk_bf16(z[4], z[5]); o.w = cvt_pk_bf16(z[6], z[7]);
                        *(u32x4*)(Ob + (size_t)row * 1024 + ch) = o; }
#pragma unroll
                        for (int q = 0; q < 8; ++q) { up[q] = uc[q]; uc[q] = un[q]; } } }
            }
        }
        SEAM(pb + 1);

        if (PS(6) && IN(pb + 2)) { PHASE_IDS
            float* X = WSP(float, WS_X);
            EpiResid E{X, X, MV() + 2 * 1024, l == 0 ? INP(I_X) : nullptr, l == 0 ? INP(I_CTX) : nullptr};
            if (attn) { constexpr int RBX = FP8_ATT_O ? 1024 : 2048; constexpr int SCX = FP8_ATT_O ? 0x79797979 : 0;
                typedef SchedPlain<RBX, SCX> SP;
                SP S{(const char*)WSP(bf16, WS_O), (const char*)WSP(bf16, WS_WO) + (size_t)j2 * 1024 * RBX, 4, lat_only};
                pg8::gemm_phase<EpiResid, SP, 6>(lds, S, E, tid, STAG(1500));
            } else { constexpr int RBX = FP8_WOUT ? 1024 : 2048; constexpr int SCX = FP8_WOUT ? 0x79797979 : 0;
                typedef SchedPlain<RBX, SCX> SP;
                SP S{(const char*)WSP(bf16, WS_O), (const char*)WSP(bf16, WS_WOUT) + (size_t)j2 * 1024 * RBX, 4, lat_only};
                pg8::gemm_phase<EpiResid, SP, 6>(lds, S, E, tid, STAG(1500));
            }
        }
        SEAM(pb + 2);

        if (PS(7) && IN(pb + 3)) { PHASE_IDS
            LAS int* lcnt = (LAS int*)(lds + LX_LCNT); LAS int* lbase = (LAS int*)(lds + LX_LBASE); LAS int* asg = (LAS int*)(lds + LX_ASG);
            LAS float* wsc = (LAS float*)(lds + LX_WSC + wave * 1024);
            LAS unsigned char* tile = lds;
            LAS float* part = (LAS float*)(lds + 65536);
            float* X = WSP(float, WS_X); bf16* H = WSP(bf16, WS_H); const float* mv = MV(); int* topE = WSP(int, WS_TOPE); float* topG = WSP(float, WS_TOPG); int* topP = WSP(int, WS_TOPP); int* list = WSP(int, WS_LIST);
            const int r32 = lane & 31, hi = lane >> 5;
            bf16x8 wf[8];
            { const float* rw = WSP(float, WS_RW) + (size_t)l * 32 * 1024 + r32 * 1024 + wave * 128 + hi * 8;
#pragma unroll
              for (int s8 = 0; s8 < 8; ++s8) { const f32x4 a = *(const f32x4*)(rw + 16 * s8), b = *(const f32x4*)(rw + 16 * s8 + 4); wf[s8] = __builtin_bit_cast(bf16x8, pack8(a, b)); } }
            __syncthreads();
            if (tid < 32) lcnt[tid] = 0;
            __syncthreads();
            const int nact = lat_only ? 32768 : M; const int rpb = (nact + G - 1) / G; const int a0 = bid * rpb; int nr = nact - a0; nr = nr < 0 ? 0 : (nr > rpb ? rpb : nr);
            const float* g = INP(I_NORMG) + ((size_t)l * 2 + 1) * 1024; const float* rb_ = INP(I_RB) + l * 32;
            for (int g0 = 0; g0 < nr; g0 += 32) {
                f32x4 v[4][4]; int rowq[4]; bool okq[4];
#pragma unroll
                for (int q = 0; q < 4; ++q) { const int i = g0 + wave + 8 * q; okq[q] = i < nr; rowq[q] = act_row(a0 + (okq[q] ? i : nr - 1), lat_only); load_row_x(X, (size_t)rowq[q], lane, v[q]); }
#pragma unroll
                for (int q = 0; q < 4; ++q) { const int row = rowq[q]; const int rb = row_is_ctx(row) ? 16 : row_batch(row); const int tr = wave + 8 * q;
                    norm_mod_f32(v[q], g, mv + rb * 6144 + 4 * 1024, mv + rb * 6144 + 3 * 1024, lane);
                    if (MOE_FP8) { unsigned char* h8 = WSP(unsigned char, WS_H8) + (size_t)row * 1024;
#pragma unroll
                        for (int j = 0; j < 4; ++j) { const unsigned pk_ = pack_fp8x4(16.f * v[q][j][0], 16.f * v[q][j][1], 16.f * v[q][j][2], 16.f * v[q][j][3]); if (okq[q]) *(unsigned*)(h8 + 256 * j + 4 * lane) = pk_; } }
#pragma unroll
                    for (int j = 0; j < 4; ++j) { u32x2 w; w.x = cvt_pk_bf16(v[q][j][0], v[q][j][1]); w.y = cvt_pk_bf16(v[q][j][2], v[q][j][3]);
                        if (!MOE_FP8 && okq[q]) *(u32x2*)(H + (size_t)row * D + 256 * j + 4 * lane) = w;
                        const int ch = 32 * j + (lane >> 1); *(LAS u32x2*)(tile + tr * 2048 + ((ch ^ (tr & 15)) << 4) + (lane & 1) * 8) = w; } }
                __syncthreads();
                { f32x16 acc = f32x16{};
#pragma unroll
                  for (int s8 = 0; s8 < 8; ++s8) { const int ch = wave * 16 + 2 * s8 + hi; const bf16x8 bfr = *(const LAS bf16x8*)(tile + r32 * 2048 + ((ch ^ (r32 & 15)) << 4));
                      acc = __builtin_amdgcn_mfma_f32_32x32x16_bf16(wf[s8], bfr, acc, 0, 0, 0); }
#pragma unroll
                  for (int r = 0; r < 16; ++r) { const int e = (r & 3) + 8 * (r >> 2) + 4 * hi; part[(wave * 32 + e) * 33 + r32] = acc[r]; } }
                __syncthreads();
#pragma unroll 1
                for (int q = 0; q < 4; ++q) { const int tr = wave + 8 * q; const int i = g0 + tr; const int row = rowq[q]; const int my_e = r32;
                    float lg = rb_[my_e];
#pragma unroll
                    for (int w8 = 0; w8 < 8; ++w8) lg += part[(w8 * 32 + my_e) * 33 + tr];
                    if (lane < 32) wsc[my_e] = lg;
                    asm volatile("s_waitcnt lgkmcnt(0)" ::: "memory");
                    int rank = 0;
#pragma unroll
                    for (int e = 0; e < 32; ++e) { const float o = wsc[e]; rank += (o > lg || (o == lg && e < my_e)) ? 1 : 0; }
                    asm volatile("s_waitcnt lgkmcnt(0)" ::: "memory");
                    if (lane < 32 && rank < 4) { wsc[64 + rank] = lg; ((LAS int*)wsc)[72 + rank] = my_e; }
                    asm volatile("s_waitcnt lgkmcnt(0)" ::: "memory");
                    const float t0 = wsc[64], t1 = wsc[65], t2 = wsc[66], t3 = wsc[67];
                    const float p0 = 1.f, p1 = __expf(t1 - t0), p2 = __expf(t2 - t0), p3 = __expf(t3 - t0); const float inv = 1.f / (p0 + p1 + p2 + p3);
                    if (lane < 4 && okq[q]) { const int e = ((LAS int*)wsc)[72 + lane]; const float p = lane == 0 ? p0 : lane == 1 ? p1 : lane == 2 ? p2 : p3;
                        const int lp = __hip_atomic_fetch_add(lcnt + e, 1, __ATOMIC_RELAXED, __HIP_MEMORY_SCOPE_WORKGROUP);
                        topE[row * 4 + lane] = e; topG[row * 4 + lane] = p * inv; asg[i * 4 + lane] = (lp << 5) | e; }
                    asm volatile("s_waitcnt lgkmcnt(0)" ::: "memory");
                }
            }
            __syncthreads();
            if (tid < 32) lbase[tid] = (int)__hip_atomic_fetch_add((unsigned*)gcnt + tid, (unsigned)lcnt[tid], RLX_AGENT);
            __syncthreads();
            for (int i = tid; i < nr * 4; i += NTHREADS) { const int av = asg[i], e = av & 31, pos = lbase[e] + (av >> 5); const int row = act_row(a0 + (i >> 2), lat_only);
                list[(size_t)e * CAP + pos] = row; topP[row * 4 + (i & 3)] = pos; }
            __syncthreads();
        }
        SEAM(pb + 3);

        if (PS(8) && IN(pb + 4)) { PHASE_IDS
            moe_table(lds, gcnt, tid);
            constexpr int RBM = MOE_FP8 ? 1024 : 2048;
            typedef SchedMoe<true, RBM, 0x78787878, 0x78787878> SG;
            SG S{(const char*)(MOE_FP8 ? (void*)WSP(unsigned char, WS_H8) : (void*)WSP(bf16, WS_H)), (const char*)WSP(bf16, WS_WGU) + (size_t)l * 32 * 2048 * RBM, WSP(int, WS_LIST), 8, (size_t)2048 * RBM,
                 (LAS const int*)(lds + LX_TSTART), (LAS const int*)(lds + LX_ECNT), (LAS const int*)(lds + LX_TILEE)};
            EpiSwiglu<MOE_FP8 != 0> E{WSP(bf16, WS_ACT), INP(I_BGU) + (size_t)l * 32 * 2048, lds + LX_EPI};
            pg8::gemm_phase<EpiSwiglu<MOE_FP8 != 0>, SG, 8>(lds, S, E, tid, STAG(900));
        }
        SEAM(pb + 4);

        if (PS(9) && IN(pb + 5)) { PHASE_IDS
            if (MK_PER_PHASE || lo == pb + 5) moe_table(lds, gcnt, tid);
            constexpr int RBM = MOE_FP8 ? 1024 : 2048;
            typedef SchedMoe<false, RBM, Y_FP8 ? 0x7B7B7B7B : 0x79797979, Y_FP8 ? 0x7B7B7B7B : 0x79797979> SD;
            SD S{(const char*)WSP(bf16, WS_ACT), (const char*)WSP(bf16, WS_WD) + (size_t)l * 32 * 1024 * RBM, WSP(int, WS_LIST), 4, (size_t)1024 * RBM,
                 (LAS const int*)(lds + LX_TSTART), (LAS const int*)(lds + LX_ECNT), (LAS const int*)(lds + LX_TILEE)};
            EpiDown E{WSP(bf16, WS_Y), INP(I_BD) + (size_t)l * 32 * 1024, lds + LX_EPI};
            pg8::gemm_phase<EpiDown, SD, 9>(lds, S, E, tid, STAG(1100));
            if (PROBE_T && l == DEPTH - 1 && bid == (PROBE_T == 10 ? PROBE_BID : 0) && tid == 0) { unsigned long long acc_ = *(LAS unsigned long long*)(lds + LX_MISC + 64); unsigned long long tot_ = __builtin_amdgcn_s_memtime() - pt_start;
                if (PROBE_T == 9) { acc_ = tot_; tot_ = (__builtin_amdgcn_s_memrealtime() - pt_rstart) * 30ull; }
                WSP(float, WS_MISC)[16] = floorf((float)((double)acc_ / (double)tot_) * PROBE_TQ + 0.5f) / PROBE_TQ; }
        }
        SEAM(pb + 5);

        if (PS(10) && IN(pb + 6)) { PHASE_IDS
            if (MK_PER_PHASE || lo >= pb + 5) moe_table(lds, gcnt, tid);
            LAS const int* tstart = (LAS const int*)(lds + LX_TSTART);
            const int nact = lat_only ? 32768 : M;
            const float* gn = (l + 1 < DEPTH) ? INP(I_NORMG) + (size_t)(l + 1) * 2 * 1024 : INP(I_FINALG);
            const float* mv = MV(); const float* mvn = mv + 17 * 6144; float* X = WSP(float, WS_X); bf16* H = WSP(bf16, WS_H); const bf16* Yb = WSP(bf16, WS_Y);
            const int* topE = WSP(int, WS_TOPE); const float* topG = WSP(float, WS_TOPG); const int* topP = WSP(int, WS_TOPP);
            for (int ai = gw; ai < nact; ai += 2 * NGW) {
                int row[2]; bool ok[2]; int4 ev[2], pv[2]; f32x4 gv[2];
#pragma unroll
                for (int u = 0; u < 2; ++u) { const int a2 = ai + u * NGW; ok[u] = a2 < nact; row[u] = act_row(ok[u] ? a2 : ai, lat_only);
                    ev[u] = *(const int4*)(topE + row[u] * 4); pv[u] = *(const int4*)(topP + row[u] * 4); gv[u] = *(const f32x4*)(topG + row[u] * 4); }
                f32x4 v[2][4]; u32x2 yw[2][4][4];
#pragma unroll
                for (int u = 0; u < 2; ++u) { load_row_x(X, (size_t)row[u], lane, v[u]);
                    const int ee[4] = {ev[u].x, ev[u].y, ev[u].z, ev[u].w}, pp[4] = {pv[u].x, pv[u].y, pv[u].z, pv[u].w};
#pragma unroll
                    for (int k = 0; k < 4; ++k) { const size_t yrow = (size_t)(tstart[ee[k]] * 256 + pp[k]);
#pragma unroll
                        for (int j = 0; j < 4; ++j) { if (Y_FP8) { yw[u][k][j].x = *(const unsigned*)((const unsigned char*)Yb + yrow * 1024 + 256 * j + 4 * lane); yw[u][k][j].y = 0u; }
                            else yw[u][k][j] = *(const u32x2*)(Yb + yrow * 1024 + 256 * j + 4 * lane); } } }
#pragma unroll
                for (int u = 0; u < 2; ++u) { if (!ok[u]) continue;
                    const int rw_ = row[u]; const bool cx = row_is_ctx(rw_); const int rb = cx ? 16 : row_batch(rw_);
                    f32x4 acc4[4];
#pragma unroll
                    for (int j = 0; j < 4; ++j) acc4[j] = (f32x4){0.f, 0.f, 0.f, 0.f};
#pragma unroll
                    for (int k = 0; k < 4; ++k) { const float gk = gv[u][k];
#pragma unroll
                        for (int j = 0; j < 4; ++j) { const u32x2 w = yw[u][k][j];
                            if (Y_FP8) { const f32x2 lo = __builtin_amdgcn_cvt_pk_f32_fp8((int)w.x, false), hi2 = __builtin_amdgcn_cvt_pk_f32_fp8((int)w.x, true); const float g16 = gk * (1.f / 16.f);
                                acc4[j][0] += g16 * lo[0]; acc4[j][1] += g16 * lo[1]; acc4[j][2] += g16 * hi2[0]; acc4[j][3] += g16 * hi2[1]; }
                            else { acc4[j][0] += gk * bf2f((unsigned short)(w.x & 0xffffu)); acc4[j][1] += gk * bf2f((unsigned short)(w.x >> 16)); acc4[j][2] += gk * bf2f((unsigned short)(w.y & 0xffffu)); acc4[j][3] += gk * bf2f((unsigned short)(w.y >> 16)); } } }
                    const float* g2 = mv + rb * 6144 + 5 * 1024;
#pragma unroll
                    for (int j = 0; j < 4; ++j) { const f32x4 gg = *(const f32x4*)(g2 + 256 * j + 4 * lane); v[u][j] = v[u][j] + gg * acc4[j]; }
                    if (l + 1 < DEPTH) {
                        store_row_x(X, (size_t)rw_, lane, v[u]);
                        if (!(l + 1 == DEPTH - 1 && cx))
                            norm_mod_store_mix(((l + 1) & 1) ? (FP8_CONV != 0) : (FP8_ATT != 0), v[u], gn, mvn + rb * 6144 + 1024, mvn + rb * 6144, lane, H + (size_t)rw_ * D, WSP(unsigned char, WS_H8) + (size_t)rw_ * 1024);
                    } else {
                        float rstd = row_rstd(v[u]); if (PROBE_T) rstd *= 1.f + sqrtf(WSP(float, WS_MISC)[16]); float* op = OUTP() + ((size_t)row_batch(rw_) * SEQ + (rw_ % RPB - CTXL)) * D;
#pragma unroll
                        for (int j = 0; j < 4; ++j) { const f32x4 gg = *(const f32x4*)(gn + 256 * j + 4 * lane); *(f32x4*)(op + 256 * j + 4 * lane) = (v[u][j] * rstd) * gg; }
                    }
                }
            }
        }
        if (l + 1 < DEPTH) SEAM(pb + 6);
    }
#undef IN
#undef SEAM
#undef MV
}

extern "C" void kernel_launch(void* const* d_in, const int* in_sizes, int n_in, void* d_out, int out_size, void* d_ws, size_t ws_size, hipStream_t stream) {
    static int grid = 0;
    if (grid == 0) {
        if (n_in != 21 || out_size != NB * SEQ * D || ws_size < WS_END) { fprintf(stderr, "kernel_launch: unexpected shapes (n_in %d, out %d, ws %zu)\n", n_in, out_size, ws_size); grid = -1; return; }
        int dev = 0, cus = 0, per_cu = 0;
        if (hipGetDevice(&dev) != hipSuccess || hipDeviceGetAttribute(&cus, hipDeviceAttributeMultiprocessorCount, dev) != hipSuccess) { grid = -1; return; }
        if (hipFuncSetAttribute((const void*)fwd, hipFuncAttributeMaxDynamicSharedMemorySize, LDS_BYTES) != hipSuccess) { fprintf(stderr, "kernel_launch: hipFuncSetAttribute failed\n"); grid = -1; return; }
        if (hipOccupancyMaxActiveBlocksPerMultiprocessor(&per_cu, (const void*)fwd, NTHREADS, LDS_BYTES) != hipSuccess || per_cu < 1) { fprintf(stderr, "kernel_launch: occupancy query says %d\n", per_cu); }
        (void)hipGetLastError();
        if (cus < 160) { fprintf(stderr, "kernel_launch: needs >= 160 CUs\n"); grid = -1; return; }
        grid = cus;
    }
    if (grid < 0) return;
    if (hipMemsetAsync((char*)d_ws + WS_CTL, 0, CTL_ZERO_BYTES, stream) != hipSuccess) return;
    Args a{};
    for (int i = 0; i < 21; ++i) a.in[i] = (const float*)d_in[i];
    a.out = (float*)d_out; a.ws = (unsigned char*)d_ws;
#if MK_PER_PHASE
    for (int p = 0; p < NPHASE; ++p) { a.ph_lo = p; a.ph_hi = p + 1; hipLaunchKernelGGL(fwd, dim3(grid), dim3(NTHREADS), LDS_BYTES, stream, a); }
#else
    a.ph_lo = 0; a.ph_hi = NPHASE;
    hipLaunchKernelGGL(fwd, dim3(grid), dim3(NTHREADS), LDS_BYTES, stream, a);
#endif
    const hipError_t le = hipPeekAtLastError();
    if (le != hipSuccess) fprintf(stderr, "kernel_launch: launch failed: %s\n", hipGetErrorName(le));
}
```

```cpp
#include <hip/hip_runtime.h>
#include <cstdio>
#include <cstdint>

#ifndef MK_PER_PHASE
#define MK_PER_PHASE 0
#endif

#ifndef MOE_FP8
#define MOE_FP8 1
#endif
#ifndef STAGGER
#define STAGGER 0
#endif
#define STAG(t) (STAGGER ? (t) : 0)
#ifndef PROBE_T
#define PROBE_T 0
#endif
#ifndef PROBE_TQ
#define PROBE_TQ 30.f
#endif
#ifndef ATT_PROBE_TID
#define ATT_PROBE_TID 0
#endif
#ifndef PROBE_BID
#define PROBE_BID 0
#endif
#ifndef PROBE_TPH
#define PROBE_TPH 8
#endif
#ifndef FP8_ATT
#define FP8_ATT 1
#endif
#ifndef FP8_ATT_O
#define FP8_ATT_O 1
#endif
#ifndef FP8_WOUT
#define FP8_WOUT 1
#endif
#ifndef FP8_CONV
#define FP8_CONV 0
#endif
#ifndef X_BF16
#define X_BF16 1
#endif
#ifndef Y_FP8
#define Y_FP8 1
#endif
#ifndef CONV_FUSE_U
#define CONV_FUSE_U 1
#endif
#ifndef ATT_FP8
#define ATT_FP8 1
#endif
#ifndef PHSEL
#define PHSEL 0xffff
#endif
#define PS(k) ((PHSEL >> (k)) & 1)
#ifndef PROBE_REP
#define MOE_XCD_RANGE 1
#define PROBE_REP 0
#endif
#define NREP(k) (1 + ((PROBE_REP >> (k)) & 1))
#ifndef PROBE_NOST
#define PROBE_NOST 0
#endif
#define GAS __attribute__((address_space(1)))
#define LAS __attribute__((address_space(3)))
typedef unsigned short bf16;
typedef short bf16x8 __attribute__((ext_vector_type(8)));
typedef float f32x4 __attribute__((ext_vector_type(4)));
typedef float f32x2 __attribute__((ext_vector_type(2)));
typedef float f32x16 __attribute__((ext_vector_type(16)));
typedef unsigned u32x4 __attribute__((ext_vector_type(4)));
typedef unsigned u32x2 __attribute__((ext_vector_type(2)));
typedef GAS unsigned gu32;

constexpr int D = 1024, NB = 16, SEQ = 2048, CTXL = 256, RPB = SEQ + CTXL, M = NB * RPB, DEPTH = 4;
constexpr int NE = 32, TOPK = 4, NMOD = 6;
constexpr int CAP = M;
constexpr int ACT_ROWS = M * TOPK + NE * 256;
constexpr float EPS = 1e-5f;
constexpr float C2 = 0.125f * 1.4426950408889634f;
constexpr int NPHASE = 2 + 7 * DEPTH;
static_assert(!(FP8_CONV && CONV_FUSE_U), "the fused u epilogue needs the (bf16) interleaved copy of conv_w_in");

constexpr size_t MiB = 1u << 20;
constexpr size_t WS_CTL = 0, CTL_ZERO_BYTES = 1 * MiB;
constexpr size_t WS_MODV = 1 * MiB;
constexpr size_t WS_ROPE = 3 * MiB;
constexpr size_t WS_RW = 4 * MiB;
constexpr size_t WS_MISC = 5 * MiB;
constexpr size_t WS_TOPE = 6 * MiB;
constexpr size_t WS_TOPG = 7 * MiB;
constexpr size_t WS_TOPP = 8 * MiB;
constexpr size_t WS_LIST = 9 * MiB;
constexpr size_t WS_WQKV = 16 * MiB;
constexpr size_t WS_WIN = 28 * MiB;
constexpr size_t WS_WO = 40 * MiB;
constexpr size_t WS_WOUT = 44 * MiB;
constexpr size_t WS_WGU = 48 * MiB;
constexpr size_t WS_WD = 560 * MiB;
constexpr size_t WS_X = 816 * MiB;
constexpr size_t WS_H = 960 * MiB;
constexpr size_t WS_Q = 1032 * MiB;
constexpr size_t WS_K = 1104 * MiB;
constexpr size_t WS_VT = 1176 * MiB;
constexpr size_t WS_BCO = WS_Q;
constexpr size_t WS_O = 1248 * MiB;
constexpr size_t WS_ACT = 1320 * MiB;
constexpr size_t WS_Y = 1624 * MiB;
constexpr size_t WS_H8 = 1928 * MiB;
constexpr size_t WS_END = 1964 * MiB;
static_assert((size_t)M * 3072 * 2 == 216 * MiB && (size_t)ACT_ROWS * 2048 == 304 * MiB && (size_t)M * 4096 == 144 * MiB, "ws map");

constexpr int CW_TMO = 0;
constexpr int CW_BAR = 4096;
constexpr int CW_CNT = 16384;

constexpr int RING_BYTES = 131072;
constexpr int LX = RING_BYTES;
constexpr int LX_MISC = LX + 0;
constexpr int LX_TSTART = LX + 256;
constexpr int LX_ECNT = LX + 512;
constexpr int LX_LCNT = LX + 640;
constexpr int LX_LBASE = LX + 768;
constexpr int LX_TILEE = LX + 1024;
constexpr int LX_WSC = LX + 4096;
constexpr int LX_ASG = LX + 12288;
constexpr int LX_EPI = LX + 16384;
constexpr int LDS_BYTES = LX + 32768;
constexpr int NWAVES = 8, NTHREADS = 512;

#define RLX_AGENT __ATOMIC_RELAXED, __HIP_MEMORY_SCOPE_AGENT
__device__ __forceinline__ unsigned f2bf(float f) { unsigned u = __builtin_bit_cast(unsigned, f); return (u + 0x7fffu + ((u >> 16) & 1u)) >> 16; }
typedef __bf16 bf16x2_t __attribute__((ext_vector_type(2)));
__device__ __forceinline__ unsigned cvt_pk_bf16(float lo, float hi) { const f32x2 v = {lo, hi}; const bf16x2_t b = __builtin_convertvector(v, bf16x2_t); return __builtin_bit_cast(unsigned, b); }
__device__ __forceinline__ float bf2f(unsigned short b) { return __builtin_bit_cast(float, (unsigned)b << 16); }
__device__ __forceinline__ float wave_sum(float v) {
    v += __builtin_bit_cast(float, __builtin_amdgcn_update_dpp(0, __builtin_bit_cast(int, v), 0xB1, 0xF, 0xF, true));
    v += __builtin_bit_cast(float, __builtin_amdgcn_update_dpp(0, __builtin_bit_cast(int, v), 0x4E, 0xF, 0xF, true));
    v += __builtin_bit_cast(float, __builtin_amdgcn_update_dpp(0, __builtin_bit_cast(int, v), 0x124, 0xF, 0xF, true));
    v += __builtin_bit_cast(float, __builtin_amdgcn_update_dpp(0, __builtin_bit_cast(int, v), 0x128, 0xF, 0xF, true));
    v += __shfl_xor(v, 16);
    auto rr = __builtin_amdgcn_permlane32_swap(__float_as_uint(v), __float_as_uint(v), false, false);
    return __uint_as_float(rr[0]) + __uint_as_float(rr[1]);
}

#define XB_TMO      128
#define XB_XCNT(j)  (256  + 64 * (j))
#define XB_XSUB(j)  (1280 + 64 * (j))
#define XB_XGEN(j)  (2304 + 64 * (j))
#define XB_TOP      3328
#define XB_TOPGEN   3392
#define XCD_BAR_WORDS 3456
#define XB_SPIN_CAP (1u << 18)
__device__ __forceinline__ unsigned xb_ld(unsigned* p)              { return __hip_atomic_load(p, __ATOMIC_RELAXED, __HIP_MEMORY_SCOPE_AGENT); }
__device__ __forceinline__ unsigned xb_add(unsigned* p, unsigned v) { return __hip_atomic_fetch_add(p, v, __ATOMIC_RELAXED, __HIP_MEMORY_SCOPE_AGENT); }
__device__ __forceinline__ unsigned xb_xcc_id() { return (unsigned)__builtin_amdgcn_s_getreg((3 << 11) | 20) & 0xFu; }
#define XB_SPIN(cond, bar) do { unsigned _sp = 0; while (cond) { __builtin_amdgcn_s_sleep(1); \
    if ((++_sp & 255u) == 0u) { if (xb_ld(&(bar)[XB_TMO])) break; if (_sp > XB_SPIN_CAP) { atomicAdd(&(bar)[XB_TMO], 1u); break; } } } } while (0)
struct XcdBarrier { unsigned* bar; unsigned x; volatile LAS unsigned* st; };
__device__ __forceinline__ XcdBarrier xcd_barrier_post(unsigned* bar, volatile LAS unsigned* st) {
    XcdBarrier b; b.bar = bar; b.x = xb_xcc_id(); b.st = st;
    if (threadIdx.x == 0) (void)xb_add(&bar[XB_XCNT(b.x)], 1u);
    return b;
}
__device__ __forceinline__ void xcd_barrier_complete(unsigned* bar, unsigned x, unsigned& nloc, unsigned& nx) {
    const unsigned G = gridDim.x * gridDim.y * gridDim.z;
    unsigned sum, cnt, mine, sp = 0u;
    for (;;) {
        sum = 0u; cnt = 0u; mine = 0u;
#pragma unroll
        for (unsigned j = 0; j < 16; ++j) { const unsigned c = xb_ld(&bar[XB_XCNT(j)]); sum += c; cnt += (c > 0u) ? 1u : 0u; mine = (j == x) ? c : mine; }
        if (sum == G) break;
        __builtin_amdgcn_s_sleep(1);
        if ((++sp & 255u) == 0u) { if (xb_ld(&bar[XB_TMO])) break; if (sp > XB_SPIN_CAP) { atomicAdd(&bar[XB_TMO], 1u); break; } }
    }
    nloc = mine > 0u ? mine : 1u; nx = cnt > 0u ? cnt : 1u;
}
__device__ __forceinline__ void xcd_barrier(const XcdBarrier& b) {
    asm volatile("s_waitcnt vmcnt(0)" ::: "memory");
    __syncthreads();
    if (threadIdx.x == 0) {
        unsigned* bar = b.bar; unsigned bx = b.x;
        asm volatile("" : "+s"(bar), "+s"(bx));
        __builtin_amdgcn_s_waitcnt(0);
        unsigned nloc = b.st[0], nx = b.st[1];
        if (nloc == 0u) { xcd_barrier_complete(bar, bx, nloc, nx); b.st[0] = nloc; b.st[1] = nx; }
        const unsigned old = xb_add(&bar[XB_XSUB(bx)], 1u);
        const unsigned gen = old / nloc;
        if (old + 1u == (gen + 1u) * nloc) {
            __builtin_amdgcn_fence(__ATOMIC_RELEASE, "agent");
            asm volatile("s_waitcnt vmcnt(0)" ::: "memory");
            const unsigned og = xb_add(&bar[XB_TOP], 1u);
            const unsigned tg = og / nx;
            if (og + 1u == (tg + 1u) * nx) xb_add(&bar[XB_TOPGEN], 1u);
            else XB_SPIN(xb_ld(&bar[XB_TOPGEN]) == tg, bar);
            __builtin_amdgcn_fence(__ATOMIC_ACQUIRE, "agent");
            xb_add(&bar[XB_XGEN(bx)], 1u);
            asm volatile("s_waitcnt vmcnt(0)" ::: "memory");
        } else {
            XB_SPIN(xb_ld(&bar[XB_XGEN(bx)]) == gen, bar);
            __builtin_amdgcn_fence(__ATOMIC_ACQUIRE, "agent");
            asm volatile("s_waitcnt vmcnt(0)" ::: "memory");
        }
    }
    __syncthreads();
}

namespace pg8 {
constexpr int BM = 256, BK = 64, HALF = 128, HTB = HALF * BK * 2, STAGE_BYTES = 8 * HTB, KD = 1024;
__host__ __device__ __forceinline__ int lds_byte(int r, int c) { const int st = (r >> 4) * 2 + (c >> 5), rr = r & 15, cc = c & 31, ob = rr * 64 + cc * 2; return st * 1024 + (ob ^ (((ob >> 9) & 1) << 5)); }
__host__ __device__ __forceinline__ void stage_rc(int b, int& R, int& C) { const int st = b / 1024, sb = b % 1024, swz = sb ^ (((sb >> 9) & 1) << 5); R = (st >> 1) * 16 + swz / 64; C = (st & 1) * 32 + (swz % 64) / 2; }
__host__ __device__ __forceinline__ int perm32(int rho) { const int n = rho >> 4, i = rho & 15; return 8 * (i >> 2) + 4 * n + (i & 3); }

struct Unit { int pm, pn, e, kind; };
typedef int v8i __attribute__((ext_vector_type(8)));
typedef int v4i __attribute__((ext_vector_type(4)));
__device__ __forceinline__ v8i cat8(bf16x8 lo, bf16x8 hi) { const v4i a = __builtin_bit_cast(v4i, lo), b = __builtin_bit_cast(v4i, hi); return __builtin_shufflevector(a, b, 0, 1, 2, 3, 4, 5, 6, 7); }

__device__ __forceinline__ bool deal(int i, int npu, int ntiles, int& mt, int& r) {
    const int G = gridDim.x, c = blockIdx.x;
    if ((G & 7) == 0) { const int x = c & 7, q = i * (G >> 3) + (c >> 3); mt = (q / npu) * 8 + x; r = q % npu; }
    else { const int L = i * G + c; mt = L / npu; r = L % npu; }
    return mt < ntiles;
}

__device__ __forceinline__ void mfma8(f32x4& acc, const v8i a, const v8i b, int sc) {
    asm volatile("v_mfma_scale_f32_16x16x128_f8f6f4 %0, %1, %2, %0, %3, %3 op_sel_hi:[0,0,0]" : "+v"(acc) : "v"(a), "v"(b), "v"(sc)); }
__device__ __forceinline__ void glds16s(const char* sbase, unsigned voff, unsigned lds_dst) { unsigned keep;
    asm volatile("s_mov_b32 %0, m0\n\ts_mov_b32 m0, %3\n\ts_nop 0\n\tglobal_load_lds_dwordx4 %1, %2\n\ts_mov_b32 m0, %0" : "=&s"(keep) : "v"(voff), "s"(sbase), "s"(lds_dst) : "memory"); }
template <class Epi, class Sched, int PH = 0>
__device__ __forceinline__ void gemm_phase(LAS unsigned char* lds, const Sched& S, const Epi& E, const int tid, const int stagger_ticks = 0) {
    const int wid = __builtin_amdgcn_readfirstlane(tid >> 6), lane = tid & 63, wr = wid >> 2, wc = wid & 3, fr = lane & 15, fq = lane >> 4;
    constexpr int RB = Sched::RB, nt = RB / 128;
    constexpr bool F8 = (RB == 1024);
    unsigned voffB[2];
#pragma unroll
    for (int i = 0; i < 2; ++i) { int R_, C_; stage_rc(tid * 16 + i * 8192, R_, C_); const int Rb = (R_ & ~31) + perm32(R_ & 31); voffB[i] = (unsigned)(Rb * RB + C_ * 2); }
    constexpr bool GA = Sched::GATHER;
    constexpr int NH = GA ? 2 : 1;
    constexpr size_t kstep = (size_t)(BK * 2);
    constexpr size_t hstep = (size_t)HALF * RB, bstep = hstep;
    const unsigned ldsw = (unsigned)wid * 1024u, lds0 = (unsigned)(uintptr_t)lds;
    const int aoff = lds_byte(wr * 64 + fr, fq * 8), boff = lds_byte(wc * 32 + fr, fq * 8);
#define PG8_SA(b, h) (((b) * 2 + (h)) * HTB)
#define PG8_SB(b, h) ((4 + (b) * 2 + (h)) * HTB)
#define PG8_STAGE(bufoff, gbase, voff) do { _Pragma("unroll") for (int _i = 0; _i < 2; ++_i) \
        glds16s((const char*)(gbase), (voff)[_i], (unsigned)__builtin_amdgcn_readfirstlane(lds0 + (unsigned)(bufoff) + ldsw + _i * 8192u)); } while (0)
#define PG8_LDA(dst, b, h) do { _Pragma("unroll") for (int m = 0; m < 4; ++m) _Pragma("unroll") for (int k = 0; k < 2; ++k) dst[m][k] = *(const LAS bf16x8*)(lds + PG8_SA(b, h) + aoff + m * 2048 + k * 1024); } while (0)
#define PG8_LDB(dst, b, h) do { _Pragma("unroll") for (int n = 0; n < 2; ++n) _Pragma("unroll") for (int k = 0; k < 2; ++k) dst[n][k] = *(const LAS bf16x8*)(lds + PG8_SB(b, h) + boff + n * 2048 + k * 1024); } while (0)
#define PG8_MMA(ai, bj, At, Bt) do { __builtin_amdgcn_s_setprio(1); _Pragma("unroll") for (int m = 0; m < 4; ++m) _Pragma("unroll") for (int n = 0; n < 2; ++n) { \
        if constexpr (F8) mfma8(acc[ai][bj][m][n], cat8(Bt[n][0], Bt[n][1]), cat8(At[m][0], At[m][1]), sc8); \
        else { _Pragma("unroll") for (int k = 0; k < 2; ++k) acc[ai][bj][m][n] = __builtin_amdgcn_mfma_f32_16x16x32_bf16(Bt[n][k], At[m][k], acc[ai][bj][m][n], 0, 0, 0); } } __builtin_amdgcn_s_setprio(0); } while (0)
#define PG8_WAIT_V(n) asm volatile("s_waitcnt vmcnt(" #n ")" ::: "memory")
#define PG8_WAIT_VF do { if (fe) { if constexpr (Epi::NST == 16 && !PROBE_NOST) PG8_WAIT_V(24); else if constexpr (Epi::NST == 4 && !PROBE_NOST) PG8_WAIT_V(12); else if constexpr (Epi::NST == 8 && !PROBE_NOST) PG8_WAIT_V(16); else PG8_WAIT_V(8); } else PG8_WAIT_V(8); } while (0)
#define PG8_WAIT_L(n) asm volatile("s_waitcnt lgkmcnt(" #n ")" ::: "memory")
#define PG8_BAR __builtin_amdgcn_s_barrier()
#define PG8_SCHED __builtin_amdgcn_sched_barrier(0)
    Unit cur, nxt; int ui = 0;
    if (!S.next(0, cur)) return;
#define PT_ON(r) (PROBE_T == (r) && PH == PROBE_TPH)
#define PT_BEG(r) do { if (PT_ON(r)) pt0_ = __builtin_amdgcn_s_memtime(); } while (0)
#define PT_END(r) do { if (PT_ON(r)) { const unsigned long long d_ = __builtin_amdgcn_s_memtime() - pt0_; if (blockIdx.x == 0 && tid == 0) *(LAS unsigned long long*)(lds + LX_MISC + 64) += d_; } } while (0)
    unsigned long long pt0_ = 0; (void)pt0_;
    PT_BEG(3);
    if (stagger_ticks > 0 && (int)(blockIdx.x >> 3) >= (int)(gridDim.x >> 4)) { const unsigned long long t0_ = __builtin_amdgcn_s_memrealtime(); while ((long long)(__builtin_amdgcn_s_memrealtime() - t0_) < (long long)stagger_ticks) __builtin_amdgcn_s_sleep(16); }
    static_assert(Sched::SCALE_A == Sched::SCALE_B, "one scale register");
    int sc8 = Sched::SCALE_A; asm volatile("" : "+v"(sc8));
    f32x4 acc[2][2][4][2];
#pragma unroll
    for (int a = 0; a < 2; ++a)
#pragma unroll
        for (int b = 0; b < 2; ++b)
#pragma unroll
            for (int m = 0; m < 4; ++m)
#pragma unroll
                for (int n = 0; n < 2; ++n) acc[a][b][m][n] = (f32x4){0.f, 0.f, 0.f, 0.f};
    bf16x8 At[4][2], B0[2][2], B1[2][2];
    constexpr int NI = GA ? 1 : 2;
    unsigned vC[NH][NI], vN[NH][NI];
    unsigned cb2[2];
#pragma unroll
    for (int i = 0; i < 2; ++i) { int R_, C_; stage_rc(tid * 16 + i * 8192, R_, C_); cb2[i] = (unsigned)(C_ * 2); }
    const unsigned idx_slot = (unsigned)__builtin_amdgcn_readfirstlane((unsigned)(uintptr_t)(lds + LX_WSC) + (unsigned)wid * 1024u);
    if constexpr (GA) { S.idx_dma(cur, lane, idx_slot); asm volatile("s_waitcnt vmcnt(0)" ::: "memory"); S.a_offs_lds(cur, tid, vC, (LAS const int*)(lds + LX_WSC + wid * 1024)); }
    else S.a_offs(cur, tid, vC);
    const unsigned bias_slot0 = (unsigned)(uintptr_t)(lds + LX_ASG);
    if constexpr (Epi::BIAS_DMA) { Unit n1_; const bool h1_ = S.next(1, n1_);
        if (wid == 0) { glds16s((const char*)E.bias_src(cur), (unsigned)lane * 16u, (unsigned)__builtin_amdgcn_readfirstlane(bias_slot0));
            if (h1_) glds16s((const char*)E.bias_src(n1_), (unsigned)lane * 16u, (unsigned)__builtin_amdgcn_readfirstlane(bias_slot0 + 1024u)); } }
    auto acc_init = [&](int slot) {
        if constexpr (Epi::BIAS_DMA) { int fq2 = fq; asm volatile("" : "+v"(fq2)); LAS const float* bl_ = (LAS const float*)(lds + LX_ASG + slot * 1024); f32x4 bv_[2][2];
            _Pragma("unroll") for (int bj = 0; bj < 2; ++bj) { const int col = bj * 128 + wc * 32 + fq2 * 8; bv_[bj][0] = *(const LAS f32x4*)(bl_ + col); bv_[bj][1] = *(const LAS f32x4*)(bl_ + col + 4);
                if constexpr (Epi::BIAS_MUL != 1.f) { bv_[bj][0] *= Epi::BIAS_MUL; bv_[bj][1] *= Epi::BIAS_MUL; }
                if constexpr (Epi::GATE_COLS) { bv_[bj][0][0] *= Epi::GATE_MUL; bv_[bj][0][2] *= Epi::GATE_MUL; bv_[bj][1][0] *= Epi::GATE_MUL; bv_[bj][1][2] *= Epi::GATE_MUL; } }
            _Pragma("unroll") for (int a = 0; a < 2; ++a) _Pragma("unroll") for (int b = 0; b < 2; ++b) _Pragma("unroll") for (int m = 0; m < 4; ++m) _Pragma("unroll") for (int n = 0; n < 2; ++n) acc[a][b][m][n] = bv_[b][n]; }
        else { _Pragma("unroll") for (int a = 0; a < 2; ++a) _Pragma("unroll") for (int b = 0; b < 2; ++b) _Pragma("unroll") for (int m = 0; m < 4; ++m) _Pragma("unroll") for (int n = 0; n < 2; ++n) acc[a][b][m][n] = (f32x4){0.f, 0.f, 0.f, 0.f}; } };
#define PG8_HA(h) (GA ? 0 : (h) * hstep)
#define PG8_VH(v, h) (v)[GA ? (h) : 0]
#define PG8_STAGE_A(bufoff, gbase, vv) do { _Pragma("unroll") for (int _i = 0; _i < 2; ++_i) { unsigned o_; if constexpr (GA) o_ = (((vv)[0] >> (16 * _i)) & 0xffffu) * (unsigned)RB + cb2[_i]; else o_ = (vv)[NI - 2 + _i]; \
        glds16s((const char*)(gbase), o_, (unsigned)__builtin_amdgcn_readfirstlane(lds0 + (unsigned)(bufoff) + ldsw + _i * 8192u)); } } while (0)
    const char* cA = S.a_base(cur); const char* cB = S.b_base(cur);
    PG8_STAGE(PG8_SB(0, 0), cB, voffB); PG8_STAGE(PG8_SB(0, 1), cB + bstep, voffB); PG8_STAGE_A(PG8_SA(0, 0), cA, vC[0]); PG8_STAGE_A(PG8_SA(0, 1), cA + PG8_HA(1), PG8_VH(vC, 1));
    if (wr == 1) PG8_BAR;
    PG8_WAIT_V(2); PG8_BAR;
    PG8_STAGE(PG8_SB(1, 0), cB + kstep, voffB); PG8_STAGE_A(PG8_SA(1, 0), cA + kstep, vC[0]); PG8_STAGE(PG8_SB(1, 1), cB + bstep + kstep, voffB);
    PG8_WAIT_V(6); PG8_BAR;
    if constexpr (Epi::BIAS_DMA) acc_init(0);
    for (;;) {
        const bool has_next = S.next(ui + 1, nxt);
        const char* nA = cA; const char* nB = cB;
#pragma unroll
        for (int h = 0; h < NH; ++h)
#pragma unroll
            for (int i = 0; i < NI; ++i) vN[h][i] = vC[h][i];
        if (has_next) { if constexpr (GA) S.idx_dma(nxt, lane, idx_slot); else S.a_offs(nxt, tid, vN); nA = S.a_base(nxt); nB = S.b_base(nxt); }
        if constexpr (Epi::BIAS_DMA) { if (ui > 0 && has_next && wid == 0) glds16s((const char*)E.bias_src(nxt), (unsigned)lane * 16u, (unsigned)__builtin_amdgcn_readfirstlane(bias_slot0 + (unsigned)((ui + 1) & 1) * 1024u)); }
        PT_BEG(2);
#pragma unroll 1
        for (int t = 0; t < nt; t += 2) {
            const bool last = (t == nt - 2);
            const char* a1 = cA + (size_t)(t + 1) * kstep;
            const char* a2 = last ? nA : cA + (size_t)(t + 2) * kstep; const char* b2 = last ? nB : cB + (size_t)(t + 2) * kstep;
            const char* a3 = a2 + kstep; const char* b3 = b2 + kstep;
            if constexpr (GA) { if (last && has_next) S.a_offs_lds(nxt, tid, vN, (LAS const int*)(lds + LX_WSC + wid * 1024)); }
            unsigned w0[NI], w1[NI];
#pragma unroll
            for (int i = 0; i < NI; ++i) { w0[i] = last ? vN[0][i] : vC[0][i]; w1[i] = last ? PG8_VH(vN, 1)[i] : PG8_VH(vC, 1)[i]; }
            const bool fe = (t == 0) && (ui > 0);
            PG8_LDB(B0, 0, 0); PG8_LDB(B1, 0, 1); PG8_SCHED; PG8_LDA(At, 0, 0); if (!fe) PG8_STAGE_A(PG8_SA(1, 1), a1 + PG8_HA(1), PG8_VH(vC, 1));
            PG8_WAIT_VF; PG8_WAIT_L(0); PG8_BAR; PG8_MMA(0, 0, At, B0); PG8_MMA(0, 1, At, B1); PG8_BAR; PG8_SCHED;
            PG8_LDA(At, 0, 1); PG8_STAGE(PG8_SB(0, 0), b2, voffB); PG8_STAGE(PG8_SB(0, 1), b2 + bstep, voffB); PG8_STAGE_A(PG8_SA(0, 0), a2, w0);
            PG8_WAIT_VF; PG8_WAIT_L(0); PG8_BAR; PG8_MMA(1, 0, At, B0); PG8_MMA(1, 1, At, B1); PG8_BAR; PG8_SCHED;
            PG8_LDB(B0, 1, 0); PG8_LDB(B1, 1, 1); PG8_SCHED; PG8_LDA(At, 1, 0); PG8_STAGE_A(PG8_SA(0, 1), a2 + PG8_HA(1), w1);
            PG8_WAIT_VF; PG8_WAIT_L(0); PG8_BAR; PG8_MMA(0, 0, At, B0); PG8_MMA(0, 1, At, B1); PG8_BAR; PG8_SCHED;
            PG8_LDA(At, 1, 1); PG8_STAGE(PG8_SB(1, 0), b3, voffB); PG8_STAGE(PG8_SB(1, 1), b3 + bstep, voffB); PG8_STAGE_A(PG8_SA(1, 0), a3, w0);
            PG8_WAIT_V(8); PG8_WAIT_L(0); PG8_BAR; PG8_MMA(1, 0, At, B0); PG8_MMA(1, 1, At, B1); PG8_BAR; PG8_SCHED;
        }
        PT_END(2);
        if (has_next) PG8_STAGE_A(PG8_SA(1, 1), nA + kstep + PG8_HA(1), PG8_VH(vN, 1));
        if (wr == 0) PG8_BAR;
        PT_BEG(1);
        if constexpr (Epi::BIAS_DMA) E(acc, cur, wr, wc, fr, fq, (LAS const float*)(lds + LX_ASG + (ui & 1) * 1024)); else E(acc, cur, wr, wc, fr, fq);
        PT_END(1);
        if (!has_next) break;
        acc_init((ui + 1) & 1);
        cur = nxt; cA = nA; cB = nB; ++ui;
#pragma unroll
        for (int h = 0; h < NH; ++h)
#pragma unroll
            for (int i = 0; i < NI; ++i) vC[h][i] = vN[h][i];
        if (wr == 1) PG8_BAR;
    }
    PG8_WAIT_V(0);
    PG8_BAR;
    PT_END(3);
#undef PT_ON
#undef PT_BEG
#undef PT_END
#undef PG8_SA
#undef PG8_HA
#undef PG8_VH
#undef PG8_SB
#undef PG8_STAGE
#undef PG8_STAGE_A
#undef PG8_LDA
#undef PG8_LDB
#undef PG8_MMA
#undef PG8_WAIT_V
#undef PG8_WAIT_VF
#undef PG8_WAIT_L
#undef PG8_BAR
#undef PG8_SCHED
}
}
using pg8::Unit;

__device__ __forceinline__ int tile_row0(int mt, bool lat_only) { return lat_only ? ((mt >> 3) * 9 + 1 + (mt & 7)) * 256 : mt * 256; }

template <int RB_, int SC_> struct SchedQKV {
    static constexpr int RB = RB_, SCALE_A = SC_, SCALE_B = SC_;
    const char* H; const char* Wt;
    __device__ __forceinline__ bool next(int i, Unit& u) const { int mt, r; if (!pg8::deal(i, 12, M / 256, mt, r)) return false;
        if (r < 8) { u.kind = 0; u.pm = mt; u.pn = r; } else { u.kind = 1; u.pm = r - 8; u.pn = mt; } u.e = 0; return true; }
    static constexpr bool GATHER = false;
    __device__ __forceinline__ void a_offs(const Unit& u, int tid, unsigned (&v)[1][2]) const {
#pragma unroll
        for (int i = 0; i < 2; ++i) { int R, C; pg8::stage_rc(tid * 16 + i * 8192, R, C); v[0][i] = (unsigned)((u.pm * 256 + R) * RB + C * 2); } }
    __device__ __forceinline__ const char* a_base(const Unit& u) const { return u.kind == 0 ? H : Wt + (size_t)2048 * RB; }
    __device__ __forceinline__ const char* b_base(const Unit& u) const { return (u.kind == 0 ? Wt : H) + (size_t)u.pn * 256 * RB; }
};
template <int RB_, int SC_> struct SchedPlain {
    static constexpr int RB = RB_, SCALE_A = SC_, SCALE_B = SC_;
    const char* A; const char* Bt; int npu; bool lat_only;
    __device__ __forceinline__ bool next(int i, Unit& u) const { int mt, r; if (!pg8::deal(i, npu, lat_only ? 128 : 144, mt, r)) return false;
        u.pm = tile_row0(mt, lat_only) >> 8; u.pn = r; u.e = 0; u.kind = 0; return true; }
    static constexpr bool GATHER = false;
    __device__ __forceinline__ void a_offs(const Unit& u, int tid, unsigned (&v)[1][2]) const {
#pragma unroll
        for (int i = 0; i < 2; ++i) { int R, C; pg8::stage_rc(tid * 16 + i * 8192, R, C); v[0][i] = (unsigned)((u.pm * 256 + R) * RB + C * 2); } }
    __device__ __forceinline__ const char* a_base(const Unit&) const { return A; }
    __device__ __forceinline__ const char* b_base(const Unit& u) const { return Bt + (size_t)u.pn * 256 * RB; }
};
template <bool GATHER_, int RB_, int SA_, int SB_> struct SchedMoe {
    static constexpr bool GATHER = GATHER_;
    static constexpr int RB = RB_, SCALE_A = SA_, SCALE_B = SB_;
    const char* A; const char* Wt; const int* list; int npu; size_t estride;
    LAS const int* tstart; LAS const int* ecnt; LAS const int* tile_e;
    __device__ __forceinline__ bool mdeal(int i, int ntl, int& mt, int& r) const {
        const int G = gridDim.x, c = blockIdx.x;
        if (MOE_XCD_RANGE && (G & 7) == 0) { const int x = c & 7, q = i * (G >> 3) + (c >> 3); const int lo = (x * ntl) >> 3, hi = ((x + 1) * ntl) >> 3; mt = lo + q / npu; r = q % npu; return mt < hi; }
        return pg8::deal(i, npu, ntl, mt, r); }
    __device__ __forceinline__ bool next(int i, Unit& u) const { int mt, r; const int ntl = __builtin_amdgcn_readfirstlane(tstart[32]);
        int xp = 0;
        if (!mdeal(i, ntl, mt, r)) { if (!(PROBE_REP & (GATHER_ ? 0x100 : 0x200))) return false; int n_i = 0; while (mdeal(n_i, ntl, mt, r)) ++n_i; if (i >= 2 * n_i || !mdeal(i - n_i, ntl, mt, r)) return false; xp = 1; }
        u.pm = mt; u.pn = r; u.e = __builtin_amdgcn_readfirstlane(tile_e[mt]); u.kind = xp; return true; }
    __device__ __forceinline__ void idx_dma(const Unit& u, int lane, unsigned slot) const {
        const int j0 = (u.pm - __builtin_amdgcn_readfirstlane(tstart[u.e])) * 256;
        pg8::glds16s((const char*)(list + (size_t)u.e * CAP + j0), (unsigned)lane * 16u, slot); }
    __device__ __forceinline__ void a_offs_lds(const Unit& u, int tid, unsigned (&v)[2][1], LAS const int* slot) const {
        const int j0 = (u.pm - __builtin_amdgcn_readfirstlane(tstart[u.e])) * 256, cnt = __builtin_amdgcn_readfirstlane(ecnt[u.e]);
#pragma unroll
        for (int h = 0; h < 2; ++h) { unsigned pk = 0;
#pragma unroll
            for (int i = 0; i < 2; ++i) { int R, C; pg8::stage_rc(tid * 16 + i * 8192, R, C); const int r = h * 128 + R; const unsigned tok = (j0 + r) < cnt ? (unsigned)slot[r] : 0u; pk |= tok << (16 * i); }
            v[h][0] = pk; }
    }
    __device__ __forceinline__ void a_offs(const Unit& u, int tid, unsigned (&v)[GATHER_ ? 2 : 1][GATHER_ ? 1 : 2]) const {
        if constexpr (GATHER_) { const int j0 = (u.pm - __builtin_amdgcn_readfirstlane(tstart[u.e])) * 256, cnt = __builtin_amdgcn_readfirstlane(ecnt[u.e]); const int* lp = list + (size_t)u.e * CAP;
#pragma unroll
            for (int h = 0; h < 2; ++h) { unsigned pk = 0;
#pragma unroll
                for (int i = 0; i < 2; ++i) { int R, C; pg8::stage_rc(tid * 16 + i * 8192, R, C); const int idx = j0 + h * 128 + R; const unsigned tok = idx < cnt ? (unsigned)lp[idx] : 0u; pk |= tok << (16 * i); }
                v[h][0] = pk; }
        } else {
#pragma unroll
            for (int i = 0; i < 2; ++i) { int R, C; pg8::stage_rc(tid * 16 + i * 8192, R, C); v[0][i] = (unsigned)((u.pm * 256 + R) * RB + C * 2); } }
    }
    __device__ __forceinline__ const char* a_base(const Unit&) const { return A; }
    __device__ __forceinline__ const char* b_base(const Unit& u) const { return Wt + (size_t)u.e * estride + (size_t)u.pn * 256 * RB; }
};

#define EPI_LOOP_ROWS for (int ai = 0; ai < 2; ++ai) _Pragma("unroll") for (int m = 0; m < 4; ++m)
__device__ __forceinline__ u32x4 pack8(const f32x4& v0, const f32x4& v1) { u32x4 w; w.x = cvt_pk_bf16(v0[0], v0[1]); w.y = cvt_pk_bf16(v0[2], v0[3]); w.z = cvt_pk_bf16(v1[0], v1[1]); w.w = cvt_pk_bf16(v1[2], v1[3]); return w; }

__device__ __forceinline__ float clamp8(float v) { return __builtin_amdgcn_fmed3f(v, -448.f, 448.f); }
__device__ __forceinline__ unsigned pack_fp8x4(float a, float b, float c, float d) {
    const float ca = clamp8(a); int w = __builtin_bit_cast(int, ca);
    w = __builtin_amdgcn_cvt_pk_fp8_f32(ca, clamp8(b), w, false); w = __builtin_amdgcn_cvt_pk_fp8_f32(clamp8(c), clamp8(d), w, true); return (unsigned)w; }
struct EpiQKV {
    static constexpr bool BIAS_DMA = false;
    static constexpr int NST = ATT_FP8 ? 8 : 16;
    bf16* Q; bf16* Kb; bf16* Vt; const float* cosT; const float* sinT; bool dost; LAS unsigned char* stg;
    __device__ __forceinline__ void operator()(const f32x4 (&acc)[2][2][4][2], const Unit& u, int wr, int wc, int fr, int fq) const {
        asm volatile("" : "+v"(fr), "+v"(fq));
        if constexpr (ATT_FP8 != 0) {
            const bool isq = u.pn < 4, k0 = (u.kind == 0); const bool lat = k0 && (u.pm % 9) != 0;
            unsigned char* base8 = (unsigned char*)Q + (k0 ? (isq ? (size_t)0 : WS_K - WS_Q) : WS_VT - WS_Q); const size_t ld = k0 ? 1024 : (size_t)M; const int colbase = k0 ? (u.pn & 3) * 256 : u.pn * 256;
            const float sc = k0 ? (isq ? C2 * 64.f : 16.f) : 16.f;
            LAS unsigned char* sw = stg + (wr * 4 + wc) * 2048; const int lane = fq * 16 + fr; const int jp0 = 16 * (wc & 1) + 4 * fq;
#pragma unroll
            for (int ai = 0; ai < 2; ++ai) {
                f32x4 cs[4], sn[4];
#pragma unroll
                for (int m = 0; m < 4; ++m) { const int row = u.pm * 256 + ai * 128 + wr * 64 + m * 16 + fr; const int t = lat ? (row % RPB) - CTXL : 0;
                    const f32x4 cv = *(const f32x4*)(cosT + t * 32 + jp0), sv = *(const f32x4*)(cosT + 2048 * 32 + t * 32 + jp0);
#pragma unroll
                    for (int j = 0; j < 4; ++j) { cs[m][j] = lat ? cv[j] : 1.f; sn[m][j] = lat ? sv[j] : 0.f; } }
#pragma unroll
                for (int bj = 0; bj < 2; ++bj) {
#pragma unroll
                    for (int m = 0; m < 4; ++m) { const f32x4 a = acc[ai][bj][m][0], b = acc[ai][bj][m][1]; const f32x4 c_ = cs[m], s_ = sn[m];
                        u32x2 w8;
                        w8.x = pack_fp8x4((a[0] * c_[0] - a[1] * s_[0]) * sc, (a[1] * c_[0] + a[0] * s_[0]) * sc, (a[2] * c_[1] - a[3] * s_[1]) * sc, (a[3] * c_[1] + a[2] * s_[1]) * sc);
                        w8.y = pack_fp8x4((b[0] * c_[2] - b[1] * s_[2]) * sc, (b[1] * c_[2] + b[0] * s_[2]) * sc, (b[2] * c_[3] - b[3] * s_[3]) * sc, (b[3] * c_[3] + b[2] * s_[3]) * sc);
                        *(LAS u32x2*)(sw + (16 * m + fr) * 32 + fq * 8) = w8; }
                    asm volatile("s_waitcnt lgkmcnt(0)" ::: "memory");
#pragma unroll
                    for (int k = 0; k < 2; ++k) { const int p = lane + 64 * k, rr = p >> 1, hf = p & 1; const u32x4 v = *(const LAS u32x4*)(sw + p * 16);
                        const int row = u.pm * 256 + ai * 128 + wr * 64 + rr; const int col = colbase + bj * 128 + wc * 32 + hf * 16;
                        if (dost) *(u32x4*)(base8 + (size_t)row * ld + col) = v; }
                    asm volatile("s_waitcnt lgkmcnt(0)" ::: "memory");
                }
            }
        } else if (u.kind == 0) {
            const bool isq = u.pn < 4; bf16* base = isq ? Q : Kb; const float sc = isq ? C2 : 1.f;
            const bool lat = (u.pm % 9) != 0;
#pragma unroll
            EPI_LOOP_ROWS { const int row = u.pm * 256 + ai * 128 + wr * 64 + m * 16 + fr; const int t = (row % RPB) - CTXL;
#pragma unroll
                for (int bj = 0; bj < 2; ++bj) { const f32x4 a = acc[ai][bj][m][0], b = acc[ai][bj][m][1]; f32x4 o0, o1;
                    f32x4 cs = {1.f, 1.f, 1.f, 1.f}, sn = {0.f, 0.f, 0.f, 0.f}; const int jp0 = 16 * (wc & 1) + 4 * fq;
                    if (lat) { cs = *(const f32x4*)(cosT + t * 32 + jp0); sn = *(const f32x4*)(sinT + t * 32 + jp0); }
                    o0[0] = (a[0] * cs[0] - a[1] * sn[0]) * sc; o0[1] = (a[1] * cs[0] + a[0] * sn[0]) * sc; o0[2] = (a[2] * cs[1] - a[3] * sn[1]) * sc; o0[3] = (a[3] * cs[1] + a[2] * sn[1]) * sc;
                    o1[0] = (b[0] * cs[2] - b[1] * sn[2]) * sc; o1[1] = (b[1] * cs[2] + b[0] * sn[2]) * sc; o1[2] = (b[2] * cs[3] - b[3] * sn[3]) * sc; o1[3] = (b[3] * cs[3] + b[2] * sn[3]) * sc;
                    const int col = (u.pn & 3) * 256 + bj * 128 + wc * 32 + fq * 8;
                    if (ATT_FP8) { const float s8 = isq ? 64.f : 16.f; u32x2 w8; w8.x = pack_fp8x4(s8 * o0[0], s8 * o0[1], s8 * o0[2], s8 * o0[3]); w8.y = pack_fp8x4(s8 * o1[0], s8 * o1[1], s8 * o1[2], s8 * o1[3]);
                        if (dost) *(u32x2*)((unsigned char*)base + (size_t)row * 1024 + col) = w8; }
                    else { const u32x4 pk_ = pack8(o0, o1); if (dost) *(u32x4*)(base + (size_t)row * 1024 + col) = pk_; } } }
        } else {
#pragma unroll
            EPI_LOOP_ROWS { const int row = u.pm * 256 + ai * 128 + wr * 64 + m * 16 + fr;
#pragma unroll
                for (int bj = 0; bj < 2; ++bj) { const int col = u.pn * 256 + bj * 128 + wc * 32 + fq * 8;
                    if (ATT_FP8) { const f32x4 a_ = acc[ai][bj][m][0], b_ = acc[ai][bj][m][1]; u32x2 w8; w8.x = pack_fp8x4(16.f * a_[0], 16.f * a_[1], 16.f * a_[2], 16.f * a_[3]); w8.y = pack_fp8x4(16.f * b_[0], 16.f * b_[1], 16.f * b_[2], 16.f * b_[3]);
                        if (dost) *(u32x2*)((unsigned char*)Vt + (size_t)row * M + col) = w8; }
                    else { const u32x4 pk_ = pack8(acc[ai][bj][m][0], acc[ai][bj][m][1]); if (dost) *(u32x4*)(Vt + (size_t)row * M + col) = pk_; } } }
        }
    }
};
struct EpiPlain {
    static constexpr bool BIAS_DMA = false;
    static constexpr int NST = 16;
    bf16* O; int ldc;
    __device__ __forceinline__ void operator()(const f32x4 (&acc)[2][2][4][2], const Unit& u, int wr, int wc, int fr, int fq) const {
        asm volatile("" : "+v"(fr), "+v"(fq));
#pragma unroll
        EPI_LOOP_ROWS { const int row = u.pm * 256 + ai * 128 + wr * 64 + m * 16 + fr;
#pragma unroll
            for (int bj = 0; bj < 2; ++bj) { const int col = u.pn * 256 + bj * 128 + wc * 32 + fq * 8;
                *(u32x4*)(O + (size_t)row * ldc + col) = pack8(acc[ai][bj][m][0], acc[ai][bj][m][1]); } }
    }
};
struct EpiConvIn {
    static constexpr bool BIAS_DMA = false;
    static constexpr int NST = 16;
    bf16* Bb; bf16* Ub;
    __device__ __forceinline__ void operator()(const f32x4 (&acc)[2][2][4][2], const Unit& u, int wr, int wc, int fr, int fq) const {
        asm volatile("" : "+v"(fr), "+v"(fq));
        if (u.pn < 4) {
#pragma unroll
            EPI_LOOP_ROWS { const int row = u.pm * 256 + ai * 128 + wr * 64 + m * 16 + fr;
#pragma unroll
                for (int bj = 0; bj < 2; ++bj) { const int col = u.pn * 256 + bj * 128 + wc * 32 + fq * 8;
                    *(u32x4*)(Bb + (size_t)row * 1024 + col) = pack8(acc[ai][bj][m][0], acc[ai][bj][m][1]); } }
        } else {
#pragma unroll
            EPI_LOOP_ROWS { const int row = u.pm * 256 + ai * 128 + wr * 64 + m * 16 + fr;
#pragma unroll
                for (int bj = 0; bj < 2; ++bj) { const f32x4 a = acc[ai][bj][m][0], b = acc[ai][bj][m][1]; const int col = (u.pn - 4) * 128 + bj * 64 + wc * 16 + fq * 4;
                    u32x2 w; w.x = cvt_pk_bf16(a[0] * a[1], a[2] * a[3]); w.y = cvt_pk_bf16(b[0] * b[1], b[2] * b[3]);
                    *(u32x2*)(Ub + (size_t)row * 1024 + col) = w; } }
        }
    }
};
struct EpiResid {
    static constexpr bool BIAS_DMA = false;
    static constexpr int NST = X_BF16 ? 16 : 0;
    const void* Xin; void* X; const float* gate;
    const float* in_x; const float* in_ctx;
    __device__ __forceinline__ void operator()(const f32x4 (&acc)[2][2][4][2], const Unit& u, int wr, int wc, int fr, int fq) const {
        asm volatile("" : "+v"(fr), "+v"(fq));
        const int rb = (u.pm % 9) == 0 ? 16 : u.pm / 9; const float* gp = gate + rb * 6144;
        f32x4 gv[2][2];
#pragma unroll
        for (int bj = 0; bj < 2; ++bj) { const int col = u.pn * 256 + bj * 128 + wc * 32 + fq * 8; gv[bj][0] = *(const f32x4*)(gp + col); gv[bj][1] = *(const f32x4*)(gp + col + 4); }
        if (X_BF16 && !in_x) {
#pragma unroll
            for (int ai = 0; ai < 2; ++ai) { u32x4 xw[4][2];
#pragma unroll
                for (int m = 0; m < 4; ++m)
#pragma unroll
                    for (int bj = 0; bj < 2; ++bj) xw[m][bj] = *(const u32x4*)((const bf16*)Xin + (size_t)(u.pm * 256 + ai * 128 + wr * 64 + m * 16 + fr) * 1024 + u.pn * 256 + bj * 128 + wc * 32 + fq * 8);
#pragma unroll
                for (int m = 0; m < 4; ++m)
#pragma unroll
                    for (int bj = 0; bj < 2; ++bj) { const u32x4 w = xw[m][bj];
                        const f32x4 x0 = {bf2f((unsigned short)(w.x & 0xffffu)), bf2f((unsigned short)(w.x >> 16)), bf2f((unsigned short)(w.y & 0xffffu)), bf2f((unsigned short)(w.y >> 16))};
                        const f32x4 x1 = {bf2f((unsigned short)(w.z & 0xffffu)), bf2f((unsigned short)(w.z >> 16)), bf2f((unsigned short)(w.w & 0xffffu)), bf2f((unsigned short)(w.w >> 16))};
                        *(u32x4*)((bf16*)X + (size_t)(u.pm * 256 + ai * 128 + wr * 64 + m * 16 + fr) * 1024 + u.pn * 256 + bj * 128 + wc * 32 + fq * 8) = pack8(x0 + gv[bj][0] * acc[ai][bj][m][0], x1 + gv[bj][1] * acc[ai][bj][m][1]); } }
        } else {
#pragma unroll
            EPI_LOOP_ROWS { const int row = u.pm * 256 + ai * 128 + wr * 64 + m * 16 + fr;
#pragma unroll
                for (int bj = 0; bj < 2; ++bj) { const int col = u.pn * 256 + bj * 128 + wc * 32 + fq * 8; const size_t o = (size_t)row * 1024 + col;
                    const float* xs = (const float*)Xin + o;
                    if (in_x) { const int b_ = u.pm / 9, jt_ = u.pm % 9; const size_t ro = (size_t)(row - u.pm * 256) * 1024 + col;
                        xs = jt_ == 0 ? in_ctx + (size_t)b_ * CTXL * 1024 + ro : in_x + ((size_t)b_ * SEQ + (jt_ - 1) * 256) * 1024 + ro; }
                    const f32x4 x0 = *(const f32x4*)(xs), x1 = *(const f32x4*)(xs + 4);
                    const f32x4 r0 = x0 + gv[bj][0] * acc[ai][bj][m][0], r1 = x1 + gv[bj][1] * acc[ai][bj][m][1];
                    if (X_BF16) *(u32x4*)((bf16*)X + o) = pack8(r0, r1);
                    else { *(f32x4*)((float*)X + o) = r0; *(f32x4*)((float*)X + o + 4) = r1; } } }
        }
    }
};
__device__ __forceinline__ float swiglu1(float g, float l) {
    g = fminf(g, 7.f); l = fminf(fmaxf(l, -7.f), 7.f);
    const float s = __builtin_amdgcn_rcpf(1.f + __builtin_amdgcn_exp2f(-1.702f * 1.4426950408889634f * g));
    return g * s * (l + 1.f);
}
constexpr float GATE_PRE = -1.702f * 1.4426950408889634f;
__device__ __forceinline__ float swiglu4(float t, float l) {
    t = __builtin_amdgcn_fmed3f(t, 7.f * GATE_PRE, 3.0e38f); l = __builtin_amdgcn_fmed3f(l, -7.f, 7.f);
    const float r = __builtin_amdgcn_rcpf(1.f + __builtin_amdgcn_exp2f(t));
    return (t * r) * __builtin_fmaf(l, 4.f / GATE_PRE, 4.f / GATE_PRE);
}
template <bool F8> struct EpiSwiglu {
    static constexpr bool BIAS_DMA = true, GATE_COLS = F8; static constexpr float GATE_MUL = -1.702f * 1.4426950408889634f, BIAS_MUL = 1.f;
    static constexpr int NST = F8 ? 4 : 16;
    bf16* ACT; const float* bgu; LAS unsigned char* stg;
    __device__ __forceinline__ const float* bias_src(const Unit& u) const { return bgu + u.e * 2048 + u.pn * 256; }
    __device__ __forceinline__ void operator()(const f32x4 (&acc)[2][2][4][2], const Unit& u, int wr, int wc, int fr, int fq, LAS const float* bl) const {
        asm volatile("" : "+v"(fr), "+v"(fq));
        (void)bl;
        if constexpr (F8) {
            LAS unsigned* sw = (LAS unsigned*)(stg + (wr * 4 + wc) * 2048); const int lane = fq * 16 + fr;
#pragma unroll
            for (int ai = 0; ai < 2; ++ai) {
#pragma unroll
                for (int m = 0; m < 4; ++m)
#pragma unroll
                    for (int bj = 0; bj < 2; ++bj) { const f32x4 a = acc[ai][bj][m][0], b = acc[ai][bj][m][1];
                        const float s0_ = swiglu4(a[0], a[1]); int w = __builtin_bit_cast(int, s0_);
                        w = __builtin_amdgcn_cvt_pk_fp8_f32(s0_, swiglu4(a[2], a[3]), w, false); w = __builtin_amdgcn_cvt_pk_fp8_f32(swiglu4(b[0], b[1]), swiglu4(b[2], b[3]), w, true);
                        sw[((16 * m + fr) * 2 + bj) * 4 + fq] = (unsigned)w; }
                asm volatile("s_waitcnt lgkmcnt(0)" ::: "memory");
#pragma unroll
                for (int k = 0; k < 2; ++k) { const int p = lane + 64 * k, rr = p >> 1, bj = p & 1; const u32x4 v = *(const LAS u32x4*)(sw + p * 4);
                    const int row = u.pm * 256 + ai * 128 + wr * 64 + rr; const int col = u.pn * 128 + bj * 64 + wc * 16;
                    if (!(PROBE_NOST && u.kind)) *(u32x4*)((unsigned char*)ACT + (size_t)row * 1024 + col) = v; }
                asm volatile("s_waitcnt lgkmcnt(0)" ::: "memory");
            }
        } else {
#pragma unroll
            EPI_LOOP_ROWS { const int row = u.pm * 256 + ai * 128 + wr * 64 + m * 16 + fr;
#pragma unroll
                for (int bj = 0; bj < 2; ++bj) { const f32x4 a = acc[ai][bj][m][0], b = acc[ai][bj][m][1];
                    const int col = u.pn * 128 + bj * 64 + wc * 16 + fq * 4;
                    u32x2 w; w.x = cvt_pk_bf16(swiglu1(a[0], a[1]), swiglu1(a[2], a[3])); w.y = cvt_pk_bf16(swiglu1(b[0], b[1]), swiglu1(b[2], b[3]));
                    *(u32x2*)(ACT + (size_t)row * 1024 + col) = w; } }
        }
    }
};
struct EpiDown {
    static constexpr bool BIAS_DMA = true, GATE_COLS = false; static constexpr float GATE_MUL = 1.f, BIAS_MUL = Y_FP8 ? 16.f : 1.f;
    static constexpr int NST = Y_FP8 ? 8 : 16;
    bf16* Y; const float* bd; LAS unsigned char* stg;
    __device__ __forceinline__ const float* bias_src(const Unit& u) const { return bd + u.e * 1024 + u.pn * 256; }
    __device__ __forceinline__ void operator()(const f32x4 (&acc)[2][2][4][2], const Unit& u, int wr, int wc, int fr, int fq, LAS const float* bl) const {
        asm volatile("" : "+v"(fr), "+v"(fq));
        (void)bl;
        if constexpr (Y_FP8 != 0) {
            LAS unsigned char* sw = stg + (wr * 4 + wc) * 2048; const int lane = fq * 16 + fr;
#pragma unroll
            for (int ai = 0; ai < 2; ++ai)
#pragma unroll
                for (int bj = 0; bj < 2; ++bj) {
#pragma unroll
                    for (int m = 0; m < 4; ++m) { const f32x4 y0 = acc[ai][bj][m][0], y1 = acc[ai][bj][m][1];
                        u32x2 w; w.x = pack_fp8x4(y0[0], y0[1], y0[2], y0[3]); w.y = pack_fp8x4(y1[0], y1[1], y1[2], y1[3]);
                        *(LAS u32x2*)(sw + (16 * m + fr) * 32 + fq * 8) = w; }
                    asm volatile("s_waitcnt lgkmcnt(0)" ::: "memory");
#pragma unroll
                    for (int k = 0; k < 2; ++k) { const int p = lane + 64 * k, rr = p >> 1, hf = p & 1; const u32x4 v = *(const LAS u32x4*)(sw + p * 16);
                        const int row = u.pm * 256 + ai * 128 + wr * 64 + rr; const int col = u.pn * 256 + bj * 128 + wc * 32 + hf * 16;
                        if (!(PROBE_NOST && u.kind)) *(u32x4*)((unsigned char*)Y + (size_t)row * 1024 + col) = v; }
                    asm volatile("s_waitcnt lgkmcnt(0)" ::: "memory");
                }
        } else {
#pragma unroll
            EPI_LOOP_ROWS { const int row = u.pm * 256 + ai * 128 + wr * 64 + m * 16 + fr;
#pragma unroll
                for (int bj = 0; bj < 2; ++bj) { const int col = u.pn * 256 + bj * 128 + wc * 32 + fq * 8;
                    const u32x4 pk_ = pack8(acc[ai][bj][m][0], acc[ai][bj][m][1]); if (!(PROBE_NOST && u.kind)) *(u32x4*)(Y + (size_t)row * 1024 + col) = pk_; } }
        }
    }
};

namespace att {
constexpr int SLOT = 32768, VOFF = 16384;
__device__ __forceinline__ void glds16(const void* gsrc, unsigned lds_dst) { unsigned keep;
    asm volatile("s_mov_b32 %0, m0\n\ts_mov_b32 m0, %2\n\ts_nop 0\n\tglobal_load_lds_dwordx4 %1, off\n\ts_mov_b32 m0, %0" : "=&s"(keep) : "v"(gsrc), "s"(lds_dst) : "memory"); }
#define ATT_WAIT_BAR(N) asm volatile("s_waitcnt vmcnt(" #N ") lgkmcnt(0)\n\ts_barrier" ::: "memory")
__device__ __forceinline__ float half_swap_max(float m) { auto rr = __builtin_amdgcn_permlane32_swap(__float_as_uint(m), __float_as_uint(m), false, false); return fmaxf(__uint_as_float(rr[0]), __uint_as_float(rr[1])); }
__device__ __forceinline__ float half_swap_sum(float m) { auto rr = __builtin_amdgcn_permlane32_swap(__float_as_uint(m), __float_as_uint(m), false, false); return __uint_as_float(rr[0]) + __uint_as_float(rr[1]); }
__device__ __forceinline__ int crow(int r, int hi) { return (r & 3) + 8 * (r >> 2) + 4 * hi; }
__device__ __forceinline__ float max3f(float a, float b, float c) { float r; asm("v_max3_f32 %0, %1, %2, %3" : "=v"(r) : "v"(a), "v"(b), "v"(c)); return r; }

__device__ __forceinline__ void attn_unit(LAS unsigned char* lds, LAS float* wsc  , const bf16* Q, const bf16* Kb, const bf16* Vt, bf16* O,
                                          int krow0, int h, int qrow0, int NT, float lam, float osc, const float* subg, const int tid) {
    const int lane = tid & 63, r32 = lane & 31, hi = lane >> 5; const int wid = __builtin_amdgcn_readfirstlane(tid >> 6);
    const int qg = wid >> 1, c = wid & 1;
    const unsigned lds0 = (unsigned)(uintptr_t)lds;
    const bf16* ksrc[2]; const bf16* vsrc[2];
#pragma unroll
    for (int i = 0; i < 2; ++i) { const int p = 2 * wid + i;
        { const int row = 4 * p + (lane >> 4), ch = (lane & 15) ^ (row & 15); ksrc[i] = Kb + (size_t)(krow0 + row) * 1024 + h * 128 + ch * 8; }
        { const int row = 8 * p + (lane >> 3), ch = (lane & 7) ^ ((row >> 1) & 7); vsrc[i] = Vt + (size_t)(h * 128 + row) * M + krow0 + ch * 8; } }
    const unsigned kdst = lds0 + (unsigned)wid * 2048u, vdst = lds0 + VOFF + (unsigned)wid * 2048u;
#define ATT_DMA(t, slot) do { const unsigned so_ = (unsigned)(slot) * SLOT; \
        glds16(ksrc[0] + (size_t)(t) * 64 * 1024, (unsigned)__builtin_amdgcn_readfirstlane(kdst + so_)); glds16(ksrc[1] + (size_t)(t) * 64 * 1024, (unsigned)__builtin_amdgcn_readfirstlane(kdst + so_ + 1024u)); \
        glds16(vsrc[0] + (size_t)(t) * 64, (unsigned)__builtin_amdgcn_readfirstlane(vdst + so_)); glds16(vsrc[1] + (size_t)(t) * 64, (unsigned)__builtin_amdgcn_readfirstlane(vdst + so_ + 1024u)); } while (0)
    const int key0 = (r32 & 0x13) | ((r32 & 4) << 1) | ((r32 & 8) >> 1);
    const int kx = key0 & 15, vx = (r32 >> 1) & 7;
    bf16x8 qf[4];
    { const bf16* qp = Q + (size_t)(qrow0 + qg * 32 + r32) * 1024 + h * 128 + c * 64 + hi * 8;
#pragma unroll
      for (int d0 = 0; d0 < 4; ++d0) qf[d0] = *(const bf16x8*)(qp + d0 * 16); }
    float sg[4];
#pragma unroll
    for (int d0 = 0; d0 < 4; ++d0) sg[d0] = subg[d0 * 32 + r32] * osc;
    f32x16 o[4];
#pragma unroll
    for (int d0 = 0; d0 < 4; ++d0) o[d0] = f32x16{};
    float mref = 0.f, lsum = 0.f; f32x16 negm = f32x16{};
    asm volatile("s_waitcnt vmcnt(0)" ::: "memory");
#define AT_BEG(r) do { if (PROBE_T == (r)) at0_ = __builtin_amdgcn_s_memtime(); } while (0)
#define AT_END(r) do { if (PROBE_T == (r)) { const unsigned long long d_ = __builtin_amdgcn_s_memtime() - at0_; if (blockIdx.x == 0 && tid == ATT_PROBE_TID) *(LAS unsigned long long*)(lds + LX_MISC + 64) += d_; } } while (0)
    unsigned long long at0_ = 0; (void)at0_;
    AT_BEG(7);
    AT_BEG(13);
    ATT_DMA(0, 0);
    if (NT > 1) ATT_DMA(1, 1);
    for (int t = 0; t < NT; ++t) {
        const int slot = t & 3;
        AT_BEG(4);
        if (t + 1 < NT) { ATT_WAIT_BAR(4); } else { ATT_WAIT_BAR(0); }
        AT_END(4);
        if (t == 0) AT_END(13);
        if (t + 2 < NT) ATT_DMA(t + 2, (t + 2) & 3);
        AT_BEG(5);
        const LAS unsigned char* kb_ = lds + slot * SLOT; const LAS unsigned char* vb_ = kb_ + VOFF;
        f32x16 s0, s1;
        bf16x8 kf[8];
#pragma unroll
        for (int d0 = 0; d0 < 4; ++d0) { const int ch = (c * 8 + d0 * 2 + hi) ^ kx;
            kf[d0] = *(const LAS bf16x8*)(kb_ + key0 * 256 + ch * 16); kf[4 + d0] = *(const LAS bf16x8*)(kb_ + (key0 + 32) * 256 + ch * 16); }
        bf16x8 vA[8], vB[8];
#pragma unroll
        for (int ks = 0; ks < 2; ++ks) { const int ch = (2 * ks + hi) ^ vx;
#pragma unroll
            for (int d0 = 0; d0 < 4; ++d0) vA[ks * 4 + d0] = *(const LAS bf16x8*)(vb_ + (d0 * 32 + r32) * 128 + ch * 16); }
#pragma unroll
        for (int d0 = 0; d0 < 4; ++d0) s0 = __builtin_amdgcn_mfma_f32_32x32x16_bf16(kf[d0], qf[d0], d0 == 0 ? negm : s0, 0, 0, 0);
#pragma unroll
        for (int d0 = 0; d0 < 4; ++d0) s1 = __builtin_amdgcn_mfma_f32_32x32x16_bf16(kf[4 + d0], qf[d0], d0 == 0 ? negm : s1, 0, 0, 0);
        float rm = s0[0];
#pragma unroll
        for (int r = 1; r < 16; ++r) rm = fmaxf(rm, s0[r]);
        float sa = 0.f;
#pragma unroll
        for (int r = 0; r < 16; ++r) { s0[r] = __builtin_amdgcn_exp2f(s0[r]); sa += s0[r]; }
        bf16x8 pa[4];
#pragma unroll
        for (int s = 0; s < 2; ++s) { u32x4 w0;
            w0.x = cvt_pk_bf16(s0[8 * s + 0], s0[8 * s + 1]); w0.y = cvt_pk_bf16(s0[8 * s + 2], s0[8 * s + 3]); w0.z = cvt_pk_bf16(s0[8 * s + 4], s0[8 * s + 5]); w0.w = cvt_pk_bf16(s0[8 * s + 6], s0[8 * s + 7]);
            pa[s] = __builtin_bit_cast(bf16x8, w0); }
#pragma unroll
        for (int ks = 2; ks < 4; ++ks) { const int ch = (2 * ks + hi) ^ vx;
#pragma unroll
            for (int d0 = 0; d0 < 4; ++d0) vB[(ks - 2) * 4 + d0] = *(const LAS bf16x8*)(vb_ + (d0 * 32 + r32) * 128 + ch * 16); }
#pragma unroll
        for (int ks = 0; ks < 2; ++ks)
#pragma unroll
            for (int d0 = 0; d0 < 4; ++d0) o[d0] = __builtin_amdgcn_mfma_f32_32x32x16_bf16(pa[ks], vA[ks * 4 + d0], o[d0], 0, 0, 0);
#pragma unroll
        for (int r = 0; r < 16; ++r) rm = fmaxf(rm, s1[r]);
#pragma unroll
        for (int r = 0; r < 16; ++r) { s1[r] = __builtin_amdgcn_exp2f(s1[r]); sa += s1[r]; }
        lsum += sa;
#pragma unroll
        for (int s = 0; s < 2; ++s) { u32x4 w1;
            w1.x = cvt_pk_bf16(s1[8 * s + 0], s1[8 * s + 1]); w1.y = cvt_pk_bf16(s1[8 * s + 2], s1[8 * s + 3]); w1.z = cvt_pk_bf16(s1[8 * s + 4], s1[8 * s + 5]); w1.w = cvt_pk_bf16(s1[8 * s + 6], s1[8 * s + 7]);
            pa[2 + s] = __builtin_bit_cast(bf16x8, w1); }
#pragma unroll
        for (int ks = 2; ks < 4; ++ks)
#pragma unroll
            for (int d0 = 0; d0 < 4; ++d0) o[d0] = __builtin_amdgcn_mfma_f32_32x32x16_bf16(pa[ks], vB[(ks - 2) * 4 + d0], o[d0], 0, 0, 0);
        AT_END(5);
        rm = half_swap_max(rm);
        const bool need = (t == 0) || (rm > 8.f);
        if (__any(need)) {
            const float dl = need ? rm : 0.f; mref += dl;
#pragma unroll
            for (int r = 0; r < 16; ++r) negm[r] = -mref;
            const float f = __builtin_amdgcn_exp2f(-dl); lsum *= f;
            if (hi == 0) wsc[r32] = f;
            asm volatile("s_waitcnt lgkmcnt(0)" ::: "memory");
#pragma unroll
            for (int r = 0; r < 16; ++r) { const float fr_ = wsc[crow(r, hi)];
#pragma unroll
                for (int d0 = 0; d0 < 4; ++d0) o[d0][r] *= fr_; }
            asm volatile("s_waitcnt lgkmcnt(0)" ::: "memory");
        }
    }
    AT_BEG(14);
    const float lt = half_swap_sum(lsum);
    if (hi == 0) wsc[64 + r32] = (c ? -lam : 1.f) * __builtin_amdgcn_rcpf(lt);
    asm volatile("s_waitcnt lgkmcnt(0)\n\ts_barrier" ::: "memory");
    LAS float* xch = (LAS float*)(lds + qg * 16384);
#pragma unroll
    for (int r = 0; r < 16; ++r) { const float a = wsc[64 + crow(r, hi)];
#pragma unroll
        for (int d0 = 0; d0 < 4; ++d0) o[d0][r] *= a; }
    if (c == 1) {
#pragma unroll
        for (int d0 = 0; d0 < 4; ++d0)
#pragma unroll
            for (int r = 0; r < 16; ++r) xch[(d0 * 16 + r) * 64 + lane] = o[d0][r];
    }
    asm volatile("s_waitcnt lgkmcnt(0)\n\ts_barrier" ::: "memory");
    if (c == 0) {
        constexpr int OB = FP8_ATT_O ? 1 : 2;
        LAS unsigned char* stg = lds + 65536 + qg * 8192;
#pragma unroll
        for (int d0 = 0; d0 < 4; ++d0)
#pragma unroll
            for (int r = 0; r < 16; ++r) o[d0][r] += xch[(d0 * 16 + r) * 64 + lane];
        float ss[16], tt[16];
#pragma unroll
        for (int r = 0; r < 16; ++r) { float x = (o[0][r] * o[0][r] + o[1][r] * o[1][r]) + (o[2][r] * o[2][r] + o[3][r] * o[3][r]);
            x += __builtin_bit_cast(float, __builtin_amdgcn_update_dpp(0, __builtin_bit_cast(int, x), 0xB1, 0xF, 0xF, true));
            x += __builtin_bit_cast(float, __builtin_amdgcn_update_dpp(0, __builtin_bit_cast(int, x), 0x4E, 0xF, 0xF, true));
            x += __builtin_bit_cast(float, __builtin_amdgcn_update_dpp(0, __builtin_bit_cast(int, x), 0x124, 0xF, 0xF, true));
            x += __builtin_bit_cast(float, __builtin_amdgcn_update_dpp(0, __builtin_bit_cast(int, x), 0x128, 0xF, 0xF, true));
            ss[r] = x; }
#pragma unroll
        for (int r = 0; r < 16; ++r) tt[r] = __shfl_xor(ss[r], 16);
#pragma unroll
        for (int r = 0; r < 16; ++r) { const int qr = crow(r, hi); const float rn = __builtin_amdgcn_rsqf((ss[r] + tt[r]) * (1.f / 128.f) + EPS);
#pragma unroll
            for (int d0 = 0; d0 < 4; ++d0) { const float ov = o[d0][r] * rn * sg[d0];
                if (FP8_ATT_O) { const float o4 = clamp8(4.f * ov); *(LAS unsigned char*)(stg + qr * 128 + d0 * 32 + r32) = (unsigned char)(__builtin_amdgcn_cvt_pk_fp8_f32(o4, o4, 0, false) & 0xff); }
                else *(LAS unsigned short*)(stg + (qr * 128 + d0 * 32 + r32) * 2) = (unsigned short)f2bf(ov); } }
        asm volatile("s_waitcnt lgkmcnt(0)" ::: "memory");
        unsigned char* Ob = (unsigned char*)O + ((size_t)(qrow0 + qg * 32) * 1024 + h * 128) * OB;
#pragma unroll
        for (int k = 0; k < 4 * OB; ++k) { const int off = lane * 16 + 1024 * k, row = off / (128 * OB), cb = off % (128 * OB);
            *(u32x4*)(Ob + (size_t)row * 1024 * OB + cb) = *(const LAS u32x4*)(stg + off); }
    }
    asm volatile("s_waitcnt lgkmcnt(0)\n\ts_barrier" ::: "memory");
    AT_END(7);
    AT_END(14);
#undef AT_BEG
#undef AT_END
#undef ATT_DMA
}

typedef int v8i __attribute__((ext_vector_type(8)));
typedef int v4i_ __attribute__((ext_vector_type(4)));
__device__ __forceinline__ v8i cat16(u32x4 lo, u32x4 hi2) { const v4i_ a = __builtin_bit_cast(v4i_, lo), b = __builtin_bit_cast(v4i_, hi2); return __builtin_shufflevector(a, b, 0, 1, 2, 3, 4, 5, 6, 7); }
constexpr float ATT_TGT = 2.f;
__device__ __forceinline__ void attn_unit8(LAS unsigned char* lds, LAS float* wsc, const unsigned char* Q8, const unsigned char* K8, const unsigned char* V8t, bf16* O,
                                           int krow0, int h, int qrow0, int NT, float lam, float osc, const float* subg, const int tid, const int par, const bool pre, const int nkrow0, const int nh) {
    static_assert(FP8_ATT_O != 0, "the output staging area (LX_EPI) holds fp8 rows");
    constexpr int SL = 16384, VO = 8192;
    const int lane = tid & 63, r32 = lane & 31, hi = lane >> 5; const int wid = __builtin_amdgcn_readfirstlane(tid >> 6);
    const int qg = wid >> 1, c = wid & 1;
    const unsigned lds0 = (unsigned)(uintptr_t)lds;
    unsigned ksrc, vsrc;
    { const int key = 8 * wid + (lane >> 3), ch = (lane & 7) ^ ((key >> 1) & 7); ksrc = (unsigned)((krow0 + key) * 1024 + h * 128 + ch * 16); }
    { const int dv = 16 * wid + (lane >> 2), ch = (lane & 3) ^ ((dv >> 2) & 3); vsrc = (unsigned)((h * 128 + dv) * M + krow0 + ch * 16); }
    const unsigned kdst = lds0 + (unsigned)wid * 1024u, vdst = lds0 + VO + (unsigned)wid * 1024u;
#define ATT_DMA8(t, slot) do { const unsigned so_ = (unsigned)(slot) * SL; \
        pg8::glds16s((const char*)K8, ksrc + (unsigned)(t) * 65536u, (unsigned)__builtin_amdgcn_readfirstlane(kdst + so_)); pg8::glds16s((const char*)V8t, vsrc + (unsigned)(t) * 64u, (unsigned)__builtin_amdgcn_readfirstlane(vdst + so_)); } while (0)
#define ATT_DMA8_NEXT(pb) do { if (nkrow0 >= 0) { const unsigned nks_ = ksrc + (unsigned)((nkrow0 - krow0) * 1024 + (nh - h) * 128); const unsigned nvs_ = vsrc + (unsigned)((nh - h) * 128 * M + (nkrow0 - krow0)); \
        _Pragma("unroll") for (int j_ = 0; j_ < 4; ++j_) { const unsigned so_ = (unsigned)((pb) * 4 + j_) * SL; \
            pg8::glds16s((const char*)K8, nks_ + (unsigned)j_ * 65536u, (unsigned)__builtin_amdgcn_readfirstlane(kdst + so_)); pg8::glds16s((const char*)V8t, nvs_ + (unsigned)j_ * 64u, (unsigned)__builtin_amdgcn_readfirstlane(vdst + so_)); } } } while (0)
    const int key0 = 32 * ((r32 >> 2) & 1) + (r32 & 3) + 4 * (r32 >> 3);
    const int kx = (key0 >> 1) & 7, vx = (r32 >> 2) & 3;
    const int kc0 = ((c * 4 + 2 * hi) ^ kx) * 16, kc1 = ((c * 4 + 2 * hi + 1) ^ kx) * 16;
    const int vc0 = ((2 * hi) ^ vx) * 16, vc1 = ((2 * hi + 1) ^ vx) * 16;
    v8i qf;
    { const unsigned char* qp = Q8 + (size_t)(qrow0 + qg * 32 + r32) * 1024 + h * 128 + c * 64 + hi * 32;
      qf = cat16(*(const u32x4*)qp, *(const u32x4*)(qp + 16)); }
    (void)subg; (void)osc;
    f32x16 o[4];
#pragma unroll
    for (int d0 = 0; d0 < 4; ++d0) o[d0] = f32x16{};
    float mref = 0.f, lsum = 0.f; f32x16 negm;
#pragma unroll
    for (int r = 0; r < 16; ++r) negm[r] = ATT_TGT;
    const int NS = NT >> 2;
    if (!pre) { asm volatile("s_waitcnt vmcnt(0)" ::: "memory");
#pragma unroll
        for (int j = 0; j < 4; ++j) ATT_DMA8(j, par * 4 + j); }
    ATT_WAIT_BAR(0);
    asm volatile("" :: "v"(qf));
    if (NS > 1) {
#pragma unroll
        for (int j = 0; j < 4; ++j) ATT_DMA8(4 + j, (par ^ 1) * 4 + j);
    } else ATT_DMA8_NEXT(par ^ 1);
#define ATT_KFRAG(kb_, kk) cat16(*(const LAS u32x4*)((kb_) + (key0 + (kk)) * 128 + kc0), *(const LAS u32x4*)((kb_) + (key0 + (kk)) * 128 + kc1))
#define ATT_VFRAG(vb_, d0) cat16(*(const LAS u32x4*)((vb_) + ((d0) * 32 + r32) * 64 + vc0), *(const LAS u32x4*)((vb_) + ((d0) * 32 + r32) * 64 + vc1))
#define ATT_QK(kb_, kk) __builtin_amdgcn_mfma_scale_f32_32x32x64_f8f6f4(ATT_KFRAG(kb_, kk), qf, negm, 0, 0, 0, 0x7A7A7A7A, 0, 0x7A7A7A7A)
    {
        const LAS unsigned char* p0_ = lds + par * 4 * SL; const f32x16 s0 = ATT_QK(p0_, 0), s1 = ATT_QK(p0_, 16);
        float rm = s0[0];
#pragma unroll
        for (int r = 1; r < 16; ++r) rm = fmaxf(rm, s0[r]);
#pragma unroll
        for (int r = 0; r < 16; ++r) rm = fmaxf(rm, s1[r]);
        mref = half_swap_max(rm) - ATT_TGT;
#pragma unroll
        for (int r = 0; r < 16; ++r) negm[r] = ATT_TGT - mref;
    }
    for (int st = 0; st < NS; ++st) {
        if (st > 0) {
            ATT_WAIT_BAR(0);
            if (st + 1 < NS) {
#pragma unroll
                for (int j = 0; j < 4; ++j) ATT_DMA8(4 * (st + 1) + j, ((par + st + 1) & 1) * 4 + j);
            } else ATT_DMA8_NEXT((par + NS) & 1);
        }
        const LAS unsigned char* sb_ = lds + ((par + st) & 1) * 4 * SL;
        v8i pfp = {0, 0, 0, 0, 0, 0, 0, 0};
#pragma unroll
        for (int j = 0; j < 4; ++j) {
            const LAS unsigned char* kb_ = sb_ + j * SL;
            f32x16 s0 = ATT_QK(kb_, 0), s1 = ATT_QK(kb_, 16);
            if (j > 0) { const LAS unsigned char* vp_ = kb_ - SL + VO;
#pragma unroll
                for (int d0 = 0; d0 < 4; ++d0) o[d0] = __builtin_amdgcn_mfma_scale_f32_32x32x64_f8f6f4(pfp, ATT_VFRAG(vp_, d0), o[d0], 0, 0, 0, 0x7F7F7F7F, 0, 0x7F7F7F7F); }
#pragma unroll
            for (int r = 0; r < 16; ++r) { s0[r] = __builtin_amdgcn_exp2f(s0[r]); s1[r] = __builtin_amdgcn_exp2f(s1[r]); }
            float sa = 0.f, sb = 0.f;
#pragma unroll
            for (int r = 0; r < 16; ++r) { sa += s0[r]; sb += s1[r]; }
            sa += sb;
            if (__any(!(sa <= 448.f))) {
                unsigned ko_ = (unsigned)(uintptr_t)kb_; asm volatile("" : "+v"(ko_));
                const LAS unsigned char* kr_ = (const LAS unsigned char*)(uintptr_t)ko_;
                s0 = ATT_QK(kr_, 0); s1 = ATT_QK(kr_, 16);
                float rm = s0[0];
#pragma unroll
                for (int r = 1; r < 16; ++r) rm = fmaxf(rm, s0[r]);
#pragma unroll
                for (int r = 0; r < 16; ++r) rm = fmaxf(rm, s1[r]);
                rm = half_swap_max(rm);
                const float dl = fmaxf(rm - ATT_TGT, 0.f); mref += dl;
#pragma unroll
                for (int r = 0; r < 16; ++r) negm[r] = ATT_TGT - mref;
                const float f = __builtin_amdgcn_exp2f(-dl); lsum *= f;
                if (hi == 0) wsc[r32] = f;
                asm volatile("s_waitcnt lgkmcnt(0)" ::: "memory");
#pragma unroll
                for (int r = 0; r < 16; ++r) { const float fr_ = wsc[crow(r, hi)];
#pragma unroll
                    for (int d0 = 0; d0 < 4; ++d0) o[d0][r] *= fr_; }
                asm volatile("s_waitcnt lgkmcnt(0)" ::: "memory");
#pragma unroll
                for (int r = 0; r < 16; ++r) { s0[r] = __builtin_amdgcn_exp2f(s0[r] - dl); s1[r] = __builtin_amdgcn_exp2f(s1[r] - dl); }
                sa = 0.f; sb = 0.f;
#pragma unroll
                for (int r = 0; r < 16; ++r) { sa += s0[r]; sb += s1[r]; }
                sa += sb;
            }
            lsum += sa;
#pragma unroll
            for (int jj = 0; jj < 4; ++jj) { int w = __builtin_bit_cast(int, s0[4 * jj]); w = __builtin_amdgcn_cvt_pk_fp8_f32(s0[4 * jj], s0[4 * jj + 1], w, false); w = __builtin_amdgcn_cvt_pk_fp8_f32(s0[4 * jj + 2], s0[4 * jj + 3], w, true); pfp[jj] = w;
                int w2 = __builtin_bit_cast(int, s1[4 * jj]); w2 = __builtin_amdgcn_cvt_pk_fp8_f32(s1[4 * jj], s1[4 * jj + 1], w2, false); w2 = __builtin_amdgcn_cvt_pk_fp8_f32(s1[4 * jj + 2], s1[4 * jj + 3], w2, true); pfp[4 + jj] = w2; }
        }
        {
            const LAS unsigned char* vl_ = sb_ + 3 * SL + VO;
#pragma unroll
            for (int d0 = 0; d0 < 4; ++d0) o[d0] = __builtin_amdgcn_mfma_scale_f32_32x32x64_f8f6f4(pfp, ATT_VFRAG(vl_, d0), o[d0], 0, 0, 0, 0x7F7F7F7F, 0, 0x7F7F7F7F);
        }
    }
#undef ATT_KFRAG
#undef ATT_VFRAG
#undef ATT_QK
    const float lt = half_swap_sum(lsum);
    if (hi == 0) wsc[64 + r32] = (c ? -lam : 1.f) * __builtin_amdgcn_rcpf(16.f * lt);
    asm volatile("s_waitcnt lgkmcnt(0)\n\ts_barrier" ::: "memory");
    LAS float* xch = (LAS float*)(lds + ((par + NS - 1) & 1) * 65536 + qg * 16384);
#pragma unroll
    for (int r = 0; r < 16; ++r) { const float a = wsc[64 + crow(r, hi)];
#pragma unroll
        for (int d0 = 0; d0 < 4; ++d0) o[d0][r] *= a; }
    if (c == 1) {
#pragma unroll
        for (int d0 = 0; d0 < 4; ++d0)
#pragma unroll
            for (int r = 0; r < 16; ++r) xch[(d0 * 16 + r) * 64 + lane] = o[d0][r];
    }
    asm volatile("s_waitcnt lgkmcnt(0)\n\ts_barrier" ::: "memory");
    if (c == 0) {
        constexpr int OB = FP8_ATT_O ? 1 : 2;
        LAS unsigned char* stg = lds + LX_EPI + qg * 4096;
#pragma unroll
        for (int d0 = 0; d0 < 4; ++d0)
#pragma unroll
            for (int r = 0; r < 16; ++r) o[d0][r] += xch[(d0 * 16 + r) * 64 + lane];
        float sgl[4];
#pragma unroll
        for (int d0 = 0; d0 < 4; ++d0) sgl[d0] = wsc[96 + d0 * 32 + r32];
        float ss[16], tt[16];
#pragma unroll
        for (int r = 0; r < 16; ++r) { float x = (o[0][r] * o[0][r] + o[1][r] * o[1][r]) + (o[2][r] * o[2][r] + o[3][r] * o[3][r]);
            x += __builtin_bit_cast(float, __builtin_amdgcn_update_dpp(0, __builtin_bit_cast(int, x), 0xB1, 0xF, 0xF, true));
            x += __builtin_bit_cast(float, __builtin_amdgcn_update_dpp(0, __builtin_bit_cast(int, x), 0x4E, 0xF, 0xF, true));
            x += __builtin_bit_cast(float, __builtin_amdgcn_update_dpp(0, __builtin_bit_cast(int, x), 0x124, 0xF, 0xF, true));
            x += __builtin_bit_cast(float, __builtin_amdgcn_update_dpp(0, __builtin_bit_cast(int, x), 0x128, 0xF, 0xF, true));
            ss[r] = x; }
#pragma unroll
        for (int r = 0; r < 16; ++r) tt[r] = __shfl_xor(ss[r], 16);
#pragma unroll
        for (int r = 0; r < 16; ++r) { const int qr = crow(r, hi); const float rn = __builtin_amdgcn_rsqf((ss[r] + tt[r]) * (1.f / 128.f) + EPS);
#pragma unroll
            for (int d0 = 0; d0 < 4; ++d0) { const float ov = o[d0][r] * rn * sgl[d0];
                if (FP8_ATT_O) { const float o4 = clamp8(4.f * ov); *(LAS unsigned char*)(stg + qr * 128 + d0 * 32 + r32) = (unsigned char)(__builtin_amdgcn_cvt_pk_fp8_f32(o4, o4, 0, false) & 0xff); }
                else *(LAS unsigned short*)(stg + (qr * 128 + d0 * 32 + r32) * 2) = (unsigned short)f2bf(ov); } }
        asm volatile("s_waitcnt lgkmcnt(0)" ::: "memory");
        unsigned char* Ob = (unsigned char*)O + ((size_t)(qrow0 + qg * 32) * 1024 + h * 128) * OB;
#pragma unroll
        for (int k = 0; k < 4 * OB; ++k) { const int off = lane * 16 + 1024 * k, row = off / (128 * OB), cb = off % (128 * OB);
            *(u32x4*)(Ob + (size_t)row * 1024 * OB + cb) = *(const LAS u32x4*)(stg + off); }
    }
    asm volatile("s_waitcnt lgkmcnt(0)\n\ts_barrier" ::: "memory");
#undef ATT_DMA8
}
}

#if ATT_FP8
#define ATT_CALL(l_, w_, q_, k_, v_, o_, ...) att::attn_unit8(l_, w_, (const unsigned char*)(q_), (const unsigned char*)(k_), (const unsigned char*)(v_), o_, __VA_ARGS__)
#else
#define ATT_CALL att::attn_unit
#endif
__device__ __forceinline__ void load_row_f32(const float* p, int lane, f32x4 (&v)[4]) {
#pragma unroll
    for (int j = 0; j < 4; ++j) v[j] = *(const f32x4*)(p + 256 * j + 4 * lane);
}
__device__ __forceinline__ void load_row_x(const void* Xb, size_t row, int lane, f32x4 (&v)[4]) {
    if (X_BF16) { const bf16* p = (const bf16*)Xb + row * D;
#pragma unroll
        for (int j = 0; j < 4; ++j) { const u32x2 w = *(const u32x2*)(p + 256 * j + 4 * lane);
            v[j] = (f32x4){bf2f((unsigned short)(w.x & 0xffffu)), bf2f((unsigned short)(w.x >> 16)), bf2f((unsigned short)(w.y & 0xffffu)), bf2f((unsigned short)(w.y >> 16))}; } }
    else load_row_f32((const float*)Xb + row * D, lane, v);
}
__device__ __forceinline__ void store_row_x(void* Xb, size_t row, int lane, const f32x4 (&v)[4]) {
    if (X_BF16) { bf16* p = (bf16*)Xb + row * D;
#pragma unroll
        for (int j = 0; j < 4; ++j) { u32x2 w; w.x = cvt_pk_bf16(v[j][0], v[j][1]); w.y = cvt_pk_bf16(v[j][2], v[j][3]); *(u32x2*)(p + 256 * j + 4 * lane) = w; } }
    else { float* p = (float*)Xb + row * D;
#pragma unroll
        for (int j = 0; j < 4; ++j) *(f32x4*)(p + 256 * j + 4 * lane) = v[j]; }
}
__device__ __forceinline__ float row_rstd(const f32x4 (&v)[4]) {
    float s = 0.f;
#pragma unroll
    for (int j = 0; j < 4; ++j) s += (v[j][0] * v[j][0] + v[j][1] * v[j][1]) + (v[j][2] * v[j][2] + v[j][3] * v[j][3]);
    return 1.0f / sqrtf(wave_sum(s) * (1.f / D) + EPS);
}
__device__ __forceinline__ void norm_mod_store(f32x4 (&v)[4], const float* g, const float* sc, const float* sh, int lane, bf16* hrow) {
    const float rstd = row_rstd(v);
#pragma unroll
    for (int j = 0; j < 4; ++j) { const int c = 256 * j + 4 * lane; const f32x4 gg = *(const f32x4*)(g + c), ss = *(const f32x4*)(sc + c), hh = *(const f32x4*)(sh + c);
        v[j] = (v[j] * rstd) * gg * (ss + 1.f) + hh;
        u32x2 w; w.x = cvt_pk_bf16(v[j][0], v[j][1]); w.y = cvt_pk_bf16(v[j][2], v[j][3]); *(u32x2*)(hrow + c) = w; }
}
__device__ __forceinline__ void norm_mod_f32(f32x4 (&v)[4], const float* g, const float* sc, const float* sh, int lane) {
    const float rstd = row_rstd(v);
#pragma unroll
    for (int j = 0; j < 4; ++j) { const int c = 256 * j + 4 * lane; const f32x4 gg = *(const f32x4*)(g + c), ss = *(const f32x4*)(sc + c), hh = *(const f32x4*)(sh + c);
        v[j] = (v[j] * rstd) * gg * (ss + 1.f) + hh; }
}
__device__ __forceinline__ void norm_mod_store_mix(bool f8, f32x4 (&v)[4], const float* g, const float* sc, const float* sh, int lane, bf16* hrow, unsigned char* h8row) {
    if (f8) { norm_mod_f32(v, g, sc, sh, lane);
#pragma unroll
        for (int j = 0; j < 4; ++j) *(unsigned*)(h8row + 256 * j + 4 * lane) = pack_fp8x4(16.f * v[j][0], 16.f * v[j][1], 16.f * v[j][2], 16.f * v[j][3]); }
    else norm_mod_store(v, g, sc, sh, lane, hrow);
}
__device__ __forceinline__ int row_batch(int row) { return row / RPB; }
__device__ __forceinline__ bool row_is_ctx(int row) { return (row % RPB) < CTXL; }
__device__ __forceinline__ int act_row(int ai, bool lat_only) { return lat_only ? (ai >> 11) * RPB + CTXL + (ai & 2047) : ai; }

template <int MODE>
__device__ __forceinline__ void transpose_item(const float* W, int K, int N, bf16* WT, LAS float* scr, int item, int lane) {
    const int nblk = N / 32, kb = item / nblk, nb = item % nblk, k0 = 64 * kb, n0 = 32 * nb;
#pragma unroll 8
    for (int i = 0; i < 32; ++i) { const int kk = 2 * i + (lane >> 5); scr[kk * 33 + (lane & 31)] = W[(size_t)(k0 + kk) * N + n0 + (lane & 31)]; }
    asm volatile("s_waitcnt lgkmcnt(0)" ::: "memory");
    const int c = lane & 7;
#pragma unroll
    for (int j = 0; j < 4; ++j) { const int n = (lane >> 3) + 8 * j; const LAS float* s = scr + (8 * c) * 33 + n;
        u32x4 o; o.x = cvt_pk_bf16(s[0 * 33], s[1 * 33]); o.y = cvt_pk_bf16(s[2 * 33], s[3 * 33]); o.z = cvt_pk_bf16(s[4 * 33], s[5 * 33]); o.w = cvt_pk_bf16(s[6 * 33], s[7 * 33]);
        int nn = n0 + n;
        if (MODE == 1 && nn < 2048) { const int i6 = nn & 63; nn = (nn & ~63) + (i6 < 32 ? 2 * i6 : 2 * (i6 - 32) + 1); }
        if (MODE == 2 && nn >= 1024) nn = nn < 2048 ? 1024 + 2 * (nn - 1024) : 1024 + 2 * (nn - 2048) + 1;
        *(u32x4*)(WT + (size_t)nn * K + k0 + 8 * c) = o; }
    asm volatile("s_waitcnt lgkmcnt(0)" ::: "memory");
}

template <int MODE = 0>
__device__ __forceinline__ void transpose_item8(const float* W, int K, int N, unsigned char* WT, LAS float* scr, int item, int lane) {
    const int nblk = N / 16, kb = item / nblk, nb = item % nblk, k0 = 128 * kb, n0 = 16 * nb;
    f32x4 v[8];
#pragma unroll
    for (int i = 0; i < 8; ++i) v[i] = *(const f32x4*)(W + (size_t)(k0 + 16 * i + (lane >> 2)) * N + n0 + 4 * (lane & 3));
#pragma unroll
    for (int i = 0; i < 8; ++i) *(LAS f32x4*)(scr + (16 * i + (lane >> 2)) * 20 + 4 * (lane & 3)) = v[i] * 1024.f;
    asm volatile("s_waitcnt lgkmcnt(0)" ::: "memory");
    const int kc = lane & 7;
#pragma unroll
    for (int j = 0; j < 2; ++j) { const int n = (lane >> 3) + 8 * j; const LAS float* s = scr + (16 * kc) * 20 + n;
        u32x4 o;
        o.x = pack_fp8x4(s[0 * 20], s[1 * 20], s[2 * 20], s[3 * 20]); o.y = pack_fp8x4(s[4 * 20], s[5 * 20], s[6 * 20], s[7 * 20]);
        o.z = pack_fp8x4(s[8 * 20], s[9 * 20], s[10 * 20], s[11 * 20]); o.w = pack_fp8x4(s[12 * 20], s[13 * 20], s[14 * 20], s[15 * 20]);
        int nn = n0 + n;
        if (MODE == 1 && nn < 2048) { const int i6 = nn & 63; nn = (nn & ~63) + (i6 < 32 ? 2 * i6 : 2 * (i6 - 32) + 1); }
        *(u32x4*)(WT + (size_t)nn * K + k0 + 16 * kc) = o; }
    asm volatile("s_waitcnt lgkmcnt(0)" ::: "memory");
}

__device__ __forceinline__ void item8_load(const float* W, int N, int item, int lane, f32x4 (&v)[8]) {
    const int nblk = N / 16, kb = item / nblk, nb = item % nblk, k0 = 128 * kb, n0 = 16 * nb;
#pragma unroll
    for (int i = 0; i < 8; ++i) v[i] = *(const f32x4*)(W + (size_t)(k0 + 16 * i + (lane >> 2)) * N + n0 + 4 * (lane & 3));
}
__device__ __forceinline__ void item8_store(const f32x4 (&v)[8], int K, int N, unsigned char* WT, LAS float* scr, int item, int lane) {
    const int nblk = N / 16, kb = item / nblk, nb = item % nblk, k0 = 128 * kb, n0 = 16 * nb;
    const float ge = (N == 2048) ? 1024.f * GATE_PRE : 1024.f; const f32x4 mulv = {ge, 1024.f, ge, 1024.f};
#pragma unroll
    for (int i = 0; i < 8; ++i) *(LAS f32x4*)(scr + (16 * i + (lane >> 2)) * 20 + 4 * (lane & 3)) = v[i] * mulv;
    asm volatile("s_waitcnt lgkmcnt(0)" ::: "memory");
    const int kc = lane & 7;
#pragma unroll
    for (int j = 0; j < 2; ++j) { const int n = (lane >> 3) + 8 * j; const LAS float* s = scr + (16 * kc) * 20 + n;
        u32x4 o;
        o.x = pack_fp8x4(s[0 * 20], s[1 * 20], s[2 * 20], s[3 * 20]); o.y = pack_fp8x4(s[4 * 20], s[5 * 20], s[6 * 20], s[7 * 20]);
        o.z = pack_fp8x4(s[8 * 20], s[9 * 20], s[10 * 20], s[11 * 20]); o.w = pack_fp8x4(s[12 * 20], s[13 * 20], s[14 * 20], s[15 * 20]);
        *(u32x4*)(WT + (size_t)(n0 + n) * K + k0 + 16 * kc) = o; }
    asm volatile("s_waitcnt lgkmcnt(0)" ::: "memory");
}

struct Args { const float* in[21]; float* out; unsigned char* ws; int ph_lo, ph_hi; };
enum { I_X = 0, I_C, I_CTX, I_CCTX, I_MODW, I_MODB, I_NORMG, I_WQKV, I_WO, I_LAM, I_SUBG, I_WIN, I_CONVW, I_WOUT, I_RW, I_RB, I_WGU, I_BGU, I_WD, I_BD, I_FINALG };

__device__ __forceinline__ void moe_table(LAS unsigned char* lds, const unsigned* gcnt, int tid) {
    LAS int* ecnt = (LAS int*)(lds + LX_ECNT); LAS int* tstart = (LAS int*)(lds + LX_TSTART); LAS int* tile_e = (LAS int*)(lds + LX_TILEE);
    __syncthreads();
    if (tid < 32) ecnt[tid] = (int)__hip_atomic_load(gcnt + tid, RLX_AGENT);
    __syncthreads();
    if (tid == 0) { int ts = 0; for (int e = 0; e < 32; ++e) { tstart[e] = ts; ts += (ecnt[e] + 255) >> 8; } tstart[32] = ts; }
    __syncthreads();
    { const int e = tid >> 4, l16 = tid & 15; const int t0 = tstart[e], n = tstart[e + 1] - t0; for (int j = l16; j < n; j += 16) tile_e[t0 + j] = e; }
    __syncthreads();
}

typedef const __attribute__((address_space(4))) unsigned char* kptr_t;
__device__ __forceinline__ kptr_t kargs() { kptr_t p = (kptr_t)__builtin_amdgcn_kernarg_segment_ptr(); asm volatile("" : "+s"(p)); return p; }
#define INP(k) (*(const float* const __attribute__((address_space(4)))*)(kargs() + 8 * (k)))
#define OUTP() (*(float* const __attribute__((address_space(4)))*)(kargs() + 168))
#define WSB() (*(unsigned char* const __attribute__((address_space(4)))*)(kargs() + 176))
#define WSP(T, off) ((T*)(WSB() + (off)))
static_assert(sizeof(Args) == 192, "kernarg layout");
__global__ void __launch_bounds__(NTHREADS, 2) fwd(Args args) {
    extern __shared__ __attribute__((aligned(16))) unsigned char lds_raw[];
    LAS unsigned char* lds = (LAS unsigned char*)lds_raw;
    const int tid = threadIdx.x, lane = tid & 63, wave = __builtin_amdgcn_readfirstlane(tid >> 6);
    const int G = gridDim.x, bid = blockIdx.x;
    const int gw = bid * NWAVES + wave, NGW = G * NWAVES;
    gu32* ctl = (gu32*)WSP(unsigned, WS_CTL);
    for (int u = tid; u < (LDS_BYTES - LX) / 4; u += NTHREADS) ((LAS unsigned*)(lds + LX))[u] = 0u;
    __syncthreads();
    volatile LAS unsigned* MISC = (volatile LAS unsigned*)(lds + LX_MISC);
    XcdBarrier bar; bar.bar = (unsigned*)(ctl + CW_BAR); bar.x = 0; bar.st = nullptr;
    if (!MK_PER_PHASE) bar = xcd_barrier_post((unsigned*)(ctl + CW_BAR), MISC + 8);
    (void)args;
    const unsigned long long pt_start = PROBE_T ? __builtin_amdgcn_s_memtime() : 0ull; (void)pt_start;
    const unsigned long long pt_rstart = PROBE_T ? __builtin_amdgcn_s_memrealtime() : 0ull; (void)pt_rstart;
    const int lo = *(const int __attribute__((address_space(4)))*)(kargs() + 184), hi = *(const int __attribute__((address_space(4)))*)(kargs() + 188);
#define IN(k) (lo <= (k) && (k) < hi)
#define PHASE_IDS int tid = threadIdx.x; asm volatile("" : "+v"(tid)); const int lane = tid & 63, wave = __builtin_amdgcn_readfirstlane(tid >> 6); const int gw = bid * NWAVES + wave; (void)lane; (void)gw;
#define SEAM(k) do { if (IN(k) && IN((k) + 1)) { if (MK_PER_PHASE) { if (tid == 0) __hip_atomic_store(ctl + CW_TMO, 0xBADu, RLX_AGENT); } else { unsigned long long b0_ = 0; if (PROBE_T == 10) b0_ = __builtin_amdgcn_s_memtime(); xcd_barrier(bar); if (PROBE_REP & 0x10000) xcd_barrier(bar); if (PROBE_T == 10 && bid == PROBE_BID && threadIdx.x == 0) *(LAS unsigned long long*)(lds + LX_MISC + 64) += __builtin_amdgcn_s_memtime() - b0_; } } } while (0)

    if (PS(0) && IN(0)) { PHASE_IDS
        float* modv = WSP(float, WS_MODV);
        unsigned long long p0t_ = (PROBE_T == 11 || PROBE_T == 12) ? __builtin_amdgcn_s_memtime() : 0ull; (void)p0t_;
        { LAS float* sil = (LAS float*)lds;
          LAS float* red = (LAS float*)(lds + 69632);
          for (int i = tid; i < 17 * 1024; i += NTHREADS) { const int r = i >> 10, k = i & 1023; const float cv = r < 16 ? INP(I_C)[r * 1024 + k] : INP(I_CCTX)[k]; sil[i] = cv / (1.f + __expf(-cv)); }
          __syncthreads();
          for (int it = bid; it < 4 * 96; it += G) { const int l = it / 96, nb = it % 96; const float* W = INP(I_MODW) + (size_t)l * 1024 * 6144 + nb * 64 + lane;
            float a[17];
#pragma unroll
            for (int r = 0; r < 17; ++r) a[r] = 0.f;
            for (int k = wave * 128; k < wave * 128 + 128; k += 4) { float w[4];
#pragma unroll
                for (int q = 0; q < 4; ++q) w[q] = W[(size_t)(k + q) * 6144];
#pragma unroll
                for (int r = 0; r < 17; ++r) { const f32x4 s = *(const LAS f32x4*)(sil + r * 1024 + k); a[r] += s[0] * w[0] + s[1] * w[1] + s[2] * w[2] + s[3] * w[3]; } }
#pragma unroll
            for (int r = 0; r < 17; ++r) red[(wave * 17 + r) * 64 + lane] = a[r];
            __syncthreads();
            for (int i = tid; i < 17 * 64; i += NTHREADS) { const int r = i >> 6, n = i & 63; float s = INP(I_MODB)[l * 6144 + nb * 64 + n];
#pragma unroll
                for (int w8 = 0; w8 < 8; ++w8) s += red[(w8 * 17 + r) * 64 + n];
                modv[((size_t)l * 17 + r) * 6144 + nb * 64 + n] = s; }
            __syncthreads(); }
        }
        if (PROBE_T == 11 && bid == 0 && tid == 0) *(LAS unsigned long long*)(lds + LX_MISC + 64) += __builtin_amdgcn_s_memtime() - p0t_;
        { float* cosT = WSP(float, WS_ROPE); float* sinT = cosT + 2048 * 32; float* rwT = WSP(float, WS_RW); float* lamv = WSP(float, WS_MISC);
        for (int i = bid * NTHREADS + tid; i < 2048 * 32; i += G * NTHREADS) { const int t = i >> 5, j = i & 31; const float pos = (float)(j < 16 ? (t >> 6) : (t & 63));
            const float inv = powf(10000.f, -(float)(2 * (j & 15)) / 32.f); const float ang = pos * inv; cosT[i] = cosf(ang); sinT[i] = sinf(ang); }
        if (bid == 0 && tid < 2) { const float* lp = INP(I_LAM) + tid * 256; float s1 = 0.f, s2 = 0.f; for (int d = 0; d < 64; ++d) { s1 += lp[d] * lp[64 + d]; s2 += lp[128 + d] * lp[192 + d]; }
            const float lam_init = 0.8f - 0.6f * expf(-0.3f * (float)(2 * tid)); lamv[tid] = expf(s1) - expf(s2) + lam_init; lamv[2 + tid] = 1.f - lam_init; }
        for (int i = bid * NTHREADS + tid; i < 4 * 32 * 1024; i += G * NTHREADS) { const int l = i >> 15, e = (i >> 10) & 31, k = i & 1023; rwT[i] = INP(I_RW)[((size_t)l * 1024 + k) * 32 + e]; } }
        if (PROBE_T == 12) p0t_ = __builtin_amdgcn_s_memtime();
        { LAS float* scr = (LAS float*)(lds + wave * 10240);
          bf16* Wqkv_t = WSP(bf16, WS_WQKV); bf16* Win_t = WSP(bf16, WS_WIN); bf16* Wo_t = WSP(bf16, WS_WO); bf16* Wout_t = WSP(bf16, WS_WOUT); bf16* Wgu_t = WSP(bf16, WS_WGU); bf16* Wd_t = WSP(bf16, WS_WD);
          constexpr int I_QKV = 16 * 96, I_SQ = 16 * 32, I_GU = 16 * 64, I_D = 16 * 32;
          constexpr int T0 = 2 * I_QKV, T1 = T0 + 2 * I_QKV, T2 = T1 + 2 * I_SQ, T3 = T2 + 2 * I_SQ, T4 = T3 + 128 * I_GU, T5 = T4 + 128 * I_D;
          for (int rep = 0; rep < NREP(0); ++rep) {
          for (int it = gw; it < (MOE_FP8 ? T3 : T5); it += NGW) {
            if (it < T0) { const int j = it / I_QKV; if (FP8_ATT) transpose_item8<1>(INP(I_WQKV) + (size_t)j * 1024 * 3072, 1024, 3072, (unsigned char*)Wqkv_t + (size_t)j * 3072 * 1024, scr, it % I_QKV, lane); else transpose_item<1>(INP(I_WQKV) + (size_t)j * 1024 * 3072, 1024, 3072, Wqkv_t + (size_t)j * 3072 * 1024, scr, it % I_QKV, lane); }
            else if (it < T1) { const int r = it - T0, j = r / I_QKV; if (FP8_CONV) transpose_item8<0>(INP(I_WIN) + (size_t)j * 1024 * 3072, 1024, 3072, (unsigned char*)Win_t + (size_t)j * 3072 * 1024, scr, r % I_QKV, lane); else transpose_item<CONV_FUSE_U ? 2 : 0>(INP(I_WIN) + (size_t)j * 1024 * 3072, 1024, 3072, Win_t + (size_t)j * 3072 * 1024, scr, r % I_QKV, lane); }
            else if (it < T2) { const int r = it - T1, j = r / I_SQ; if (FP8_ATT_O) transpose_item8<0>(INP(I_WO) + (size_t)j * 1024 * 1024, 1024, 1024, (unsigned char*)Wo_t + (size_t)j * 1024 * 1024, scr, r % I_SQ, lane); else transpose_item<0>(INP(I_WO) + (size_t)j * 1024 * 1024, 1024, 1024, Wo_t + (size_t)j * 1024 * 1024, scr, r % I_SQ, lane); }
            else if (it < T3) { const int r = it - T2, j = r / I_SQ; if (FP8_WOUT) transpose_item8<0>(INP(I_WOUT) + (size_t)j * 1024 * 1024, 1024, 1024, (unsigned char*)Wout_t + (size_t)j * 1024 * 1024, scr, r % I_SQ, lane); else transpose_item<0>(INP(I_WOUT) + (size_t)j * 1024 * 1024, 1024, 1024, Wout_t + (size_t)j * 1024 * 1024, scr, r % I_SQ, lane); }
            else if (it < T4) { const int r = it - T3, j = r / I_GU; transpose_item<0>(INP(I_WGU) + (size_t)j * 1024 * 2048, 1024, 2048, Wgu_t + (size_t)j * 2048 * 1024, scr, r % I_GU, lane); }
            else { const int r = it - T4, j = r / I_D; transpose_item<0>(INP(I_WD) + (size_t)j * 1024 * 1024, 1024, 1024, Wd_t + (size_t)j * 1024 * 1024, scr, r % I_D, lane); }
          }
          if (MOE_FP8) {
            constexpr int NGUI = 128 * I_GU, NMOE = NGUI + 128 * I_D;
            const float* wgu = INP(I_WGU); const float* wd = INP(I_WD);
#define MOE_DEC(r_, W_, N_, WT_, IT_) do { if ((r_) < NGUI) { const int j_ = (r_) / I_GU; W_ = wgu + (size_t)j_ * 1024 * 2048; N_ = 2048; WT_ = (unsigned char*)Wgu_t + (size_t)j_ * 2048 * 1024; IT_ = (r_) % I_GU; } \
              else { const int q_ = (r_) - NGUI, j_ = q_ / I_D; W_ = wd + (size_t)j_ * 1024 * 1024; N_ = 1024; WT_ = (unsigned char*)Wd_t + (size_t)j_ * 1024 * 1024; IT_ = q_ % I_D; } } while (0)
            f32x4 vc[8], vn[8]; const float* Wc = nullptr; int Nc = 0, itc = 0; unsigned char* WTc = nullptr;
            int r = gw;
            if (r < NMOE) { MOE_DEC(r, Wc, Nc, WTc, itc); item8_load(Wc, Nc, itc, lane, vc); }
            for (; r < NMOE; r += NGW) { const int rn = r + NGW; const bool hn = rn < NMOE; const float* Wn = Wc; int Nn = Nc, itn = itc; unsigned char* WTn = WTc;
                if (hn) { MOE_DEC(rn, Wn, Nn, WTn, itn); item8_load(Wn, Nn, itn, lane, vn); }
                item8_store(vc, 1024, Nc, WTc, scr, itc, lane);
                if (hn) { Wc = Wn; Nc = Nn; itc = itn; WTc = WTn;
#pragma unroll
                    for (int i = 0; i < 8; ++i) vc[i] = vn[i]; } }
#undef MOE_DEC
          }
          }
        }
        if (PROBE_T == 12 && bid == 0 && tid == 0) *(LAS unsigned long long*)(lds + LX_MISC + 64) += __builtin_amdgcn_s_memtime() - p0t_;
        __syncthreads();
    }
    SEAM(0);

    if (PS(1) && IN(1)) { PHASE_IDS
        const float* g = INP(I_NORMG); const float* modv = WSP(float, WS_MODV); float* X = WSP(float, WS_X); bf16* H = WSP(bf16, WS_H);
        for (int row = gw; row < M; row += NGW) { const int b = row_batch(row), jj = row % RPB; const bool cx = jj < CTXL; const int rb = cx ? 16 : b;
            const float* src = cx ? INP(I_CTX) + ((size_t)b * CTXL + jj) * D : INP(I_X) + ((size_t)b * SEQ + (jj - CTXL)) * D;
            f32x4 v[4]; load_row_f32(src, lane, v);
            norm_mod_store_mix(FP8_ATT != 0, v, g, modv + rb * 6144 + 1024, modv + rb * 6144, lane, H + (size_t)row * D, WSP(unsigned char, WS_H8) + (size_t)row * 1024); }
    }
    SEAM(1);

    for (int l = 0; l < DEPTH; ++l) {
        const int pb = 2 + 7 * l; const bool attn = (l & 1) == 0; const int j2 = l >> 1; const bool lat_only = (l == DEPTH - 1);
#define MV() (WSP(float, WS_MODV) + (size_t)l * 17 * 6144)
        const unsigned* gcnt = (const unsigned*)(ctl + CW_CNT) + l * 32;

        if (IN(pb)) { PHASE_IDS
            if (PS(2) && attn) {
                constexpr int RBX = FP8_ATT ? 1024 : 2048; constexpr int SCX = FP8_ATT ? 0x78787878 : 0;
                typedef SchedQKV<RBX, SCX> SQ;
                SQ S{FP8_ATT ? (const char*)WSP(unsigned char, WS_H8) : (const char*)WSP(bf16, WS_H), (const char*)WSP(bf16, WS_WQKV) + (size_t)j2 * 3072 * RBX};
                EpiQKV E{WSP(bf16, WS_Q), WSP(bf16, WS_K), WSP(bf16, WS_VT), WSP(float, WS_ROPE), WSP(float, WS_ROPE) + 2048 * 32, true, lds + LX_EPI};
                for (int rep = 0; rep < NREP(2); ++rep) { int z_ = rep; asm volatile("" : "+s"(z_)); E.dost = !PROBE_NOST || (z_ == NREP(2) - 1); pg8::gemm_phase<EpiQKV, SQ, 2>(lds, S, E, tid, STAG(1500)); }
            } else if (PS(3)) {
                constexpr int RBX = FP8_CONV ? 1024 : 2048; constexpr int SCX = FP8_CONV ? 0x78787878 : 0;
                typedef SchedPlain<RBX, SCX> SP;
                SP S{FP8_CONV ? (const char*)WSP(unsigned char, WS_H8) : (const char*)WSP(bf16, WS_H), (const char*)WSP(bf16, WS_WIN) + (size_t)j2 * 3072 * RBX, 12, lat_only};
                if (CONV_FUSE_U) { EpiConvIn E{WSP(bf16, WS_BCO), WSP(bf16, WS_BCO) + (size_t)M * 1024};
                    for (int rep = 0; rep < NREP(3); ++rep) pg8::gemm_phase<EpiConvIn, SP, 3>(lds, S, E, tid, STAG(1500)); }
                else { EpiPlain E{WSP(bf16, WS_BCO), 3072};
                    for (int rep = 0; rep < NREP(3); ++rep) pg8::gemm_phase<EpiPlain, SP, 3>(lds, S, E, tid, STAG(1500)); }
            }
        }
        SEAM(pb);

        if (IN(pb + 1)) { PHASE_IDS
            if (PS(4) && attn) {
                const float* lamv = WSP(float, WS_MISC); const float lam = lamv[j2], osc = lamv[2 + j2]; const float* subg = INP(I_SUBG) + j2 * 128;
                const bf16* Qb = WSP(bf16, WS_Q); const bf16* Kb = WSP(bf16, WS_K); const bf16* Vt = WSP(bf16, WS_VT); bf16* Ob = WSP(bf16, WS_O);
                LAS float* wsc = (LAS float*)(lds + LX_WSC + wave * 1024);
                if (ATT_FP8) { wsc[96 + lane] = subg[lane] * osc; wsc[160 + lane] = subg[64 + lane] * osc; }
                const int vcu = (G % 8 == 0) ? (bid % 8) * (G / 8) + bid / 8 : bid;
                for (int rep = 0; rep < NREP(4); ++rep)
                if (G == 256) {
                    const int xc = bid & 7, j = bid >> 3;
                    const int bhc = xc * 16 + (j >> 1);
                    for (int sstep = 0; sstep < 8; ++sstep) { const int bh = xc * 16 + 2 * sstep + (j >> 4), b = bh >> 3, h = bh & 7;
                        const int bhn = sstep < 7 ? bh + 2 : bhc;
                        ATT_CALL(lds, wsc, Qb, Kb, Vt, Ob, b * RPB, h, b * RPB + CTXL + (j & 15) * 128, 36, lam, osc, subg, tid, sstep & 1, sstep > 0, (bhn >> 3) * RPB, bhn & 7); }
                    { const int b = bhc >> 3, h = bhc & 7;
                      ATT_CALL(lds, wsc, Qb, Kb, Vt, Ob, b * RPB, h, b * RPB + (j & 1) * 128, 4, lam, osc, subg, tid, 0, true, -1, 0); }
                } else {
                    for (int u = bid; u < 128 * 18; u += G) { const int bh = u / 18, k = u % 18, b = bh >> 3, h = bh & 7;
                        ATT_CALL(lds, wsc, Qb, Kb, Vt, Ob, b * RPB, h, k < 16 ? b * RPB + CTXL + k * 128 : b * RPB + (k - 16) * 128, k < 16 ? 36 : 4, lam, osc, subg, tid, 0, false, -1, 0); }
                }
            } else if (PS(5)) {
                const float* cw = INP(I_CONVW) + (size_t)j2 * 3 * 1024; const bf16* BCO = WSP(bf16, WS_BCO); bf16* Ob = WSP(bf16, WS_O);
                const int nact = lat_only ? 32768 : M; const int nitems = (nact / 16) * 2;
                for (int it = gw; it < nitems; it += NGW) { const int strip = it >> 1, ch = (it & 1) * 512 + lane * 8; const int row0 = act_row(strip * 16, lat_only);
                    const int jj = row0 % RPB; const int seq_lo = jj < CTXL ? row0 - jj : row0 - jj + CTXL, seq_hi = jj < CTXL ? row0 - jj + CTXL : row0 - jj + RPB;
                    float w0[8], w1[8], w2[8];
#pragma unroll
                    for (int q = 0; q < 8; ++q) { w0[q] = cw[ch + q]; w1[q] = cw[1024 + ch + q]; w2[q] = cw[2048 + ch + q]; }
                    float up[8], uc[8], un[8];
                    auto load_u = [&](int row, float (&u)[8]) {
                        if (row < seq_lo || row >= seq_hi) {
#pragma unroll
                            for (int q = 0; q < 8; ++q) u[q] = 0.f;
                        } else if (CONV_FUSE_U) { const u32x4 uu = *(const u32x4*)(BCO + (size_t)M * 1024 + (size_t)row * 1024 + ch);
#pragma unroll
                            for (int q = 0; q < 4; ++q) { u[2 * q] = bf2f((unsigned short)(uu[q] & 0xffffu)); u[2 * q + 1] = bf2f((unsigned short)(uu[q] >> 16)); }
                        } else { const bf16* p = BCO + (size_t)row * 3072; const u32x4 gc = *(const u32x4*)(p + 1024 + ch), xt = *(const u32x4*)(p + 2048 + ch);
#pragma unroll
                            for (int q = 0; q < 4; ++q) { u[2 * q] = bf2f((unsigned short)(gc[q] & 0xffffu)) * bf2f((unsigned short)(xt[q] & 0xffffu)); u[2 * q + 1] = bf2f((unsigned short)(gc[q] >> 16)) * bf2f((unsigned short)(xt[q] >> 16)); } } };
                    load_u(row0 - 1, up); load_u(row0, uc);
                    for (int r = 0; r < 16; ++r) { const int row = row0 + r; load_u(row + 1, un);
                        const u32x4 gb = *(const u32x4*)(BCO + (size_t)row * (CONV_FUSE_U ? 1024 : 3072) + ch); float z[8];
#pragma unroll
                        for (int q = 0; q < 8; ++q) { const float gbv = bf2f((unsigned short)((q & 1) ? (gb[q >> 1] >> 16) : (gb[q >> 1] & 0xffffu))); z[q] = gbv * (w0[q] * up[q] + w1[q] * uc[q] + w2[q] * un[q]); }
                        if (FP8_WOUT) { u32x2 o; o.x = pack_fp8x4(4.f * z[0], 4.f * z[1], 4.f * z[2], 4.f * z[3]); o.y = pack_fp8x4(4.f * z[4], 4.f * z[5], 4.f * z[6], 4.f * z[7]); *(u32x2*)((unsigned char*)Ob + (size_t)row * 1024 + ch) = o; }
                        else { u32x4 o; o.x = cvt_pk_bf16(z[0], z[1]); o.y = cvt_pk_bf16(z[2], z[3]); o.z = cvt_pk_bf16(z[4], z[5]); o.w = cvt_pk_bf16(z[6], z[7]);
                        *(u32x4*)(Ob + (size_t)row * 1024 + ch) = o; }
#pragma unroll
                        for (int q = 0; q < 8; ++q) { up[q] = uc[q]; uc[q] = un[q]; } } }
            }
        }
        SEAM(pb + 1);

        if (PS(6) && IN(pb + 2)) { PHASE_IDS
            float* X = WSP(float, WS_X);
            EpiResid E{X, X, MV() + 2 * 1024, l == 0 ? INP(I_X) : nullptr, l == 0 ? INP(I_CTX) : nullptr};
            if (attn) { constexpr int RBX = FP8_ATT_O ? 1024 : 2048; constexpr int SCX = FP8_ATT_O ? 0x79797979 : 0;
                typedef SchedPlain<RBX, SCX> SP;
                SP S{(const char*)WSP(bf16, WS_O), (const char*)WSP(bf16, WS_WO) + (size_t)j2 * 1024 * RBX, 4, lat_only};
                pg8::gemm_phase<EpiResid, SP, 6>(lds, S, E, tid, STAG(1500));
            } else { constexpr int RBX = FP8_WOUT ? 1024 : 2048; constexpr int SCX = FP8_WOUT ? 0x79797979 : 0;
                typedef SchedPlain<RBX, SCX> SP;
                SP S{(const char*)WSP(bf16, WS_O), (const char*)WSP(bf16, WS_WOUT) + (size_t)j2 * 1024 * RBX, 4, lat_only};
                pg8::gemm_phase<EpiResid, SP, 6>(lds, S, E, tid, STAG(1500));
            }
        }
        SEAM(pb + 2);

        if (PS(7) && IN(pb + 3)) { PHASE_IDS
            LAS int* lcnt = (LAS int*)(lds + LX_LCNT); LAS int* lbase = (LAS int*)(lds + LX_LBASE); LAS int* asg = (LAS int*)(lds + LX_ASG);
            LAS float* wsc = (LAS float*)(lds + LX_WSC + wave * 1024);
            LAS unsigned char* tile = lds;
            LAS float* part = (LAS float*)(lds + 65536);
            float* X = WSP(float, WS_X); bf16* H = WSP(bf16, WS_H); const float* mv = MV(); int* topE = WSP(int, WS_TOPE); float* topG = WSP(float, WS_TOPG); int* topP = WSP(int, WS_TOPP); int* list = WSP(int, WS_LIST);
            const int r32 = lane & 31, hi = lane >> 5;
            bf16x8 wf[8];
            { const float* rw = WSP(float, WS_RW) + (size_t)l * 32 * 1024 + r32 * 1024 + wave * 128 + hi * 8;
#pragma unroll
              for (int s8 = 0; s8 < 8; ++s8) { const f32x4 a = *(const f32x4*)(rw + 16 * s8), b = *(const f32x4*)(rw + 16 * s8 + 4); wf[s8] = __builtin_bit_cast(bf16x8, pack8(a, b)); } }
            __syncthreads();
            if (tid < 32) lcnt[tid] = 0;
            __syncthreads();
            const int nact = lat_only ? 32768 : M; const int rpb = (nact + G - 1) / G; const int a0 = bid * rpb; int nr = nact - a0; nr = nr < 0 ? 0 : (nr > rpb ? rpb : nr);
            const float* g = INP(I_NORMG) + ((size_t)l * 2 + 1) * 1024; const float* rb_ = INP(I_RB) + l * 32;
            for (int g0 = 0; g0 < nr; g0 += 32) {
                f32x4 v[4][4]; int rowq[4]; bool okq[4];
#pragma unroll
                for (int q = 0; q < 4; ++q) { const int i = g0 + wave + 8 * q; okq[q] = i < nr; rowq[q] = act_row(a0 + (okq[q] ? i : nr - 1), lat_only); load_row_x(X, (size_t)rowq[q], lane, v[q]); }
#pragma unroll
                for (int q = 0; q < 4; ++q) { const int row = rowq[q]; const int rb = row_is_ctx(row) ? 16 : row_batch(row); const int tr = wave + 8 * q;
                    norm_mod_f32(v[q], g, mv + rb * 6144 + 4 * 1024, mv + rb * 6144 + 3 * 1024, lane);
                    if (MOE_FP8) { unsigned char* h8 = WSP(unsigned char, WS_H8) + (size_t)row * 1024;
#pragma unroll
                        for (int j = 0; j < 4; ++j) { const unsigned pk_ = pack_fp8x4(16.f * v[q][j][0], 16.f * v[q][j][1], 16.f * v[q][j][2], 16.f * v[q][j][3]); if (okq[q]) *(unsigned*)(h8 + 256 * j + 4 * lane) = pk_; } }
#pragma unroll
                    for (int j = 0; j < 4; ++j) { u32x2 w; w.x = cvt_pk_bf16(v[q][j][0], v[q][j][1]); w.y = cvt_pk_bf16(v[q][j][2], v[q][j][3]);
                        if (!MOE_FP8 && okq[q]) *(u32x2*)(H + (size_t)row * D + 256 * j + 4 * lane) = w;
                        const int ch = 32 * j + (lane >> 1); *(LAS u32x2*)(tile + tr * 2048 + ((ch ^ (tr & 15)) << 4) + (lane & 1) * 8) = w; } }
                __syncthreads();
                { f32x16 acc = f32x16{};
#pragma unroll
                  for (int s8 = 0; s8 < 8; ++s8) { const int ch = wave * 16 + 2 * s8 + hi; const bf16x8 bfr = *(const LAS bf16x8*)(tile + r32 * 2048 + ((ch ^ (r32 & 15)) << 4));
                      acc = __builtin_amdgcn_mfma_f32_32x32x16_bf16(wf[s8], bfr, acc, 0, 0, 0); }
#pragma unroll
                  for (int r = 0; r < 16; ++r) { const int e = (r & 3) + 8 * (r >> 2) + 4 * hi; part[(wave * 32 + e) * 33 + r32] = acc[r]; } }
                __syncthreads();
#pragma unroll 1
                for (int q = 0; q < 4; ++q) { const int tr = wave + 8 * q; const int i = g0 + tr; const int row = rowq[q]; const int my_e = r32;
                    float lg = rb_[my_e];
#pragma unroll
                    for (int w8 = 0; w8 < 8; ++w8) lg += part[(w8 * 32 + my_e) * 33 + tr];
                    if (lane < 32) wsc[my_e] = lg;
                    asm volatile("s_waitcnt lgkmcnt(0)" ::: "memory");
                    int rank = 0;
#pragma unroll
                    for (int e = 0; e < 32; ++e) { const float o = wsc[e]; rank += (o > lg || (o == lg && e < my_e)) ? 1 : 0; }
                    asm volatile("s_waitcnt lgkmcnt(0)" ::: "memory");
                    if (lane < 32 && rank < 4) { wsc[64 + rank] = lg; ((LAS int*)wsc)[72 + rank] = my_e; }
                    asm volatile("s_waitcnt lgkmcnt(0)" ::: "memory");
                    const float t0 = wsc[64], t1 = wsc[65], t2 = wsc[66], t3 = wsc[67];
                    const float p0 = 1.f, p1 = __expf(t1 - t0), p2 = __expf(t2 - t0), p3 = __expf(t3 - t0); const float inv = 1.f / (p0 + p1 + p2 + p3);
                    if (lane < 4 && okq[q]) { const int e = ((LAS int*)wsc)[72 + lane]; const float p = lane == 0 ? p0 : lane == 1 ? p1 : lane == 2 ? p2 : p3;
                        const int lp = __hip_atomic_fetch_add(lcnt + e, 1, __ATOMIC_RELAXED, __HIP_MEMORY_SCOPE_WORKGROUP);
                        topE[row * 4 + lane] = e; topG[row * 4 + lane] = p * inv; asg[i * 4 + lane] = (lp << 5) | e; }
                    asm volatile("s_waitcnt lgkmcnt(0)" ::: "memory");
                }
            }
            __syncthreads();
            if (tid < 32) lbase[tid] = (int)__hip_atomic_fetch_add((unsigned*)gcnt + tid, (unsigned)lcnt[tid], RLX_AGENT);
            __syncthreads();
            for (int i = tid; i < nr * 4; i += NTHREADS) { const int av = asg[i], e = av & 31, pos = lbase[e] + (av >> 5); const int row = act_row(a0 + (i >> 2), lat_only);
                list[(size_t)e * CAP + pos] = row; topP[row * 4 + (i & 3)] = pos; }
            __syncthreads();
        }
        SEAM(pb + 3);

        if (PS(8) && IN(pb + 4)) { PHASE_IDS
            moe_table(lds, gcnt, tid);
            constexpr int RBM = MOE_FP8 ? 1024 : 2048;
            typedef SchedMoe<true, RBM, 0x78787878, 0x78787878> SG;
            SG S{(const char*)(MOE_FP8 ? (void*)WSP(unsigned char, WS_H8) : (void*)WSP(bf16, WS_H)), (const char*)WSP(bf16, WS_WGU) + (size_t)l * 32 * 2048 * RBM, WSP(int, WS_LIST), 8, (size_t)2048 * RBM,
                 (LAS const int*)(lds + LX_TSTART), (LAS const int*)(lds + LX_ECNT), (LAS const int*)(lds + LX_TILEE)};
            EpiSwiglu<MOE_FP8 != 0> E{WSP(bf16, WS_ACT), INP(I_BGU) + (size_t)l * 32 * 2048, lds + LX_EPI};
            pg8::gemm_phase<EpiSwiglu<MOE_FP8 != 0>, SG, 8>(lds, S, E, tid, STAG(900));
        }
        SEAM(pb + 4);

        if (PS(9) && IN(pb + 5)) { PHASE_IDS
            if (MK_PER_PHASE || lo == pb + 5) moe_table(lds, gcnt, tid);
            constexpr int RBM = MOE_FP8 ? 1024 : 2048;
            typedef SchedMoe<false, RBM, Y_FP8 ? 0x7B7B7B7B : 0x79797979, Y_FP8 ? 0x7B7B7B7B : 0x79797979> SD;
            SD S{(const char*)WSP(bf16, WS_ACT), (const char*)WSP(bf16, WS_WD) + (size_t)l * 32 * 1024 * RBM, WSP(int, WS_LIST), 4, (size_t)1024 * RBM,
                 (LAS const int*)(lds + LX_TSTART), (LAS const int*)(lds + LX_ECNT), (LAS const int*)(lds + LX_TILEE)};
            EpiDown E{WSP(bf16, WS_Y), INP(I_BD) + (size_t)l * 32 * 1024, lds + LX_EPI};
            pg8::gemm_phase<EpiDown, SD, 9>(lds, S, E, tid, STAG(1100));
            if (PROBE_T && l == DEPTH - 1 && bid == (PROBE_T == 10 ? PROBE_BID : 0) && tid == 0) { unsigned long long acc_ = *(LAS unsigned long long*)(lds + LX_MISC + 64); unsigned long long tot_ = __builtin_amdgcn_s_memtime() - pt_start;
                if (PROBE_T == 9) { acc_ = tot_; tot_ = (__builtin_amdgcn_s_memrealtime() - pt_rstart) * 30ull; }
                WSP(float, WS_MISC)[16] = floorf((float)((double)acc_ / (double)tot_) * PROBE_TQ + 0.5f) / PROBE_TQ; }
        }
        SEAM(pb + 5);

        if (PS(10) && IN(pb + 6)) { PHASE_IDS
            if (MK_PER_PHASE || lo >= pb + 5) moe_table(lds, gcnt, tid);
            LAS const int* tstart = (LAS const int*)(lds + LX_TSTART);
            const int nact = lat_only ? 32768 : M;
            const float* gn = (l + 1 < DEPTH) ? INP(I_NORMG) + (size_t)(l + 1) * 2 * 1024 : INP(I_FINALG);
            const float* mv = MV(); const float* mvn = mv + 17 * 6144; float* X = WSP(float, WS_X); bf16* H = WSP(bf16, WS_H); const bf16* Yb = WSP(bf16, WS_Y);
            const int* topE = WSP(int, WS_TOPE); const float* topG = WSP(float, WS_TOPG); const int* topP = WSP(int, WS_TOPP);
            for (int ai = gw; ai < nact; ai += 2 * NGW) {
                int row[2]; bool ok[2]; int4 ev[2], pv[2]; f32x4 gv[2];
#pragma unroll
                for (int u = 0; u < 2; ++u) { const int a2 = ai + u * NGW; ok[u] = a2 < nact; row[u] = act_row(ok[u] ? a2 : ai, lat_only);
                    ev[u] = *(const int4*)(topE + row[u] * 4); pv[u] = *(const int4*)(topP + row[u] * 4); gv[u] = *(const f32x4*)(topG + row[u] * 4); }
                f32x4 v[2][4]; u32x2 yw[2][4][4];
#pragma unroll
                for (int u = 0; u < 2; ++u) { load_row_x(X, (size_t)row[u], lane, v[u]);
                    const int ee[4] = {ev[u].x, ev[u].y, ev[u].z, ev[u].w}, pp[4] = {pv[u].x, pv[u].y, pv[u].z, pv[u].w};
#pragma unroll
                    for (int k = 0; k < 4; ++k) { const size_t yrow = (size_t)(tstart[ee[k]] * 256 + pp[k]);
#pragma unroll
                        for (int j = 0; j < 4; ++j) { if (Y_FP8) { yw[u][k][j].x = *(const unsigned*)((const unsigned char*)Yb + yrow * 1024 + 256 * j + 4 * lane); yw[u][k][j].y = 0u; }
                            else yw[u][k][j] = *(const u32x2*)(Yb + yrow * 1024 + 256 * j + 4 * lane); } } }
#pragma unroll
                for (int u = 0; u < 2; ++u) { if (!ok[u]) continue;
                    const int rw_ = row[u]; const bool cx = row_is_ctx(rw_); const int rb = cx ? 16 : row_batch(rw_);
                    f32x4 acc4[4];
#pragma unroll
                    for (int j = 0; j < 4; ++j) acc4[j] = (f32x4){0.f, 0.f, 0.f, 0.f};
#pragma unroll
                    for (int k = 0; k < 4; ++k) { const float gk = gv[u][k];
#pragma unroll
                        for (int j = 0; j < 4; ++j) { const u32x2 w = yw[u][k][j];
                            if (Y_FP8) { const f32x2 lo = __builtin_amdgcn_cvt_pk_f32_fp8((int)w.x, false), hi2 = __builtin_amdgcn_cvt_pk_f32_fp8((int)w.x, true); const float g16 = gk * (1.f / 16.f);
                                acc4[j][0] += g16 * lo[0]; acc4[j][1] += g16 * lo[1]; acc4[j][2] += g16 * hi2[0]; acc4[j][3] += g16 * hi2[1]; }
                            else { acc4[j][0] += gk * bf2f((unsigned short)(w.x & 0xffffu)); acc4[j][1] += gk * bf2f((unsigned short)(w.x >> 16)); acc4[j][2] += gk * bf2f((unsigned short)(w.y & 0xffffu)); acc4[j][3] += gk * bf2f((unsigned short)(w.y >> 16)); } } }
                    const float* g2 = mv + rb * 6144 + 5 * 1024;
#pragma unroll
                    for (int j = 0; j < 4; ++j) { const f32x4 gg = *(const f32x4*)(g2 + 256 * j + 4 * lane); v[u][j] = v[u][j] + gg * acc4[j]; }
                    if (l + 1 < DEPTH) {
                        store_row_x(X, (size_t)rw_, lane, v[u]);
                        if (!(l + 1 == DEPTH - 1 && cx))
                            norm_mod_store_mix(((l + 1) & 1) ? (FP8_CONV != 0) : (FP8_ATT != 0), v[u], gn, mvn + rb * 6144 + 1024, mvn + rb * 6144, lane, H + (size_t)rw_ * D, WSP(unsigned char, WS_H8) + (size_t)rw_ * 1024);
                    } else {
                        float rstd = row_rstd(v[u]); if (PROBE_T) rstd *= 1.f + sqrtf(WSP(float, WS_MISC)[16]); float* op = OUTP() + ((size_t)row_batch(rw_) * SEQ + (rw_ % RPB - CTXL)) * D;
#pragma unroll
                        for (int j = 0; j < 4; ++j) { const f32x4 gg = *(const f32x4*)(gn + 256 * j + 4 * lane); *(f32x4*)(op + 256 * j + 4 * lane) = (v[u][j] * rstd) * gg; }
                    }
                }
            }
        }
        if (l + 1 < DEPTH) SEAM(pb + 6);
    }
#undef IN
#undef SEAM
#undef MV
}

extern "C" void kernel_launch(void* const* d_in, const int* in_sizes, int n_in, void* d_out, int out_size, void* d_ws, size_t ws_size, hipStream_t stream) {
    static int grid = 0;
    if (grid == 0) {
        if (n_in != 21 || out_size != NB * SEQ * D || ws_size < WS_END) { fprintf(stderr, "kernel_launch: unexpected shapes (n_in %d, out %d, ws %zu)\n", n_in, out_size, ws_size); grid = -1; return; }
        int dev = 0, cus = 0, per_cu = 0;
        if (hipGetDevice(&dev) != hipSuccess || hipDeviceGetAttribute(&cus, hipDeviceAttributeMultiprocessorCount, dev) != hipSuccess) { grid = -1; return; }
        if (hipFuncSetAttribute((const void*)fwd, hipFuncAttributeMaxDynamicSharedMemorySize, LDS_BYTES) != hipSuccess) { fprintf(stderr, "kernel_launch: hipFuncSetAttribute failed\n"); grid = -1; return; }
        if (hipOccupancyMaxActiveBlocksPerMultiprocessor(&per_cu, (const void*)fwd, NTHREADS, LDS_BYTES) != hipSuccess || per_cu < 1) { fprintf(stderr, "kernel_launch: occupancy query says %d\n", per_cu); }
        (void)hipGetLastError();
        if (cus < 160) { fprintf(stderr, "kernel_launch: needs >= 160 CUs\n"); grid = -1; return; }
        grid = cus;
    }
    if (grid < 0) return;
    if (hipMemsetAsync((char*)d_ws + WS_CTL, 0, CTL_ZERO_BYTES, stream) != hipSuccess) return;
    Args a{};
    for (int i = 0; i < 21; ++i) a.in[i] = (const float*)d_in[i];
    a.out = (float*)d_out; a.ws = (unsigned char*)d_ws;
#if MK_PER_PHASE
    for (int p = 0; p < NPHASE; ++p) { a.ph_lo = p; a.ph_hi = p + 1; hipLaunchKernelGGL(fwd, dim3(grid), dim3(NTHREADS), LDS_BYTES, stream, a); }
#else
    a.ph_lo = 0; a.ph_hi = NPHASE;
    hipLaunchKernelGGL(fwd, dim3(grid), dim3(NTHREADS), LDS_BYTES, stream, a);
#endif
    const hipError_t le = hipPeekAtLastError();
    if (le != hipSuccess) fprintf(stderr, "kernel_launch: launch failed: %s\n", hipGetErrorName(le));
}
```

```cpp
#include <hip/hip_runtime.h>
#include <cstdio>
#include <cstdint>

#ifndef MK_PER_PHASE
#define MK_PER_PHASE 0
#endif

#ifndef MOE_FP8
#define MOE_FP8 1
#endif
#ifndef STAGGER
#define STAGGER 0
#endif
#define STAG(t) (STAGGER ? (t) : 0)
#ifndef PROBE_T
#define PROBE_T 0
#endif
#ifndef PROBE_TQ
#define PROBE_TQ 30.f
#endif
#ifndef ATT_PROBE_TID
#define ATT_PROBE_TID 0
#endif
#ifndef PROBE_BID
#define PROBE_BID 0
#endif
#ifndef PROBE_TPH
#define PROBE_TPH 8
#endif
#ifndef FP8_ATT
#define FP8_ATT 1
#endif
#ifndef FP8_ATT_O
#define FP8_ATT_O 1
#endif
#ifndef FP8_WOUT
#define FP8_WOUT 1
#endif
#ifndef FP8_CONV
#define FP8_CONV 0
#endif
#ifndef X_BF16
#define X_BF16 1
#endif
#ifndef Y_FP8
#define Y_FP8 1
#endif
#ifndef CONV_FUSE_U
#define CONV_FUSE_U 1
#endif
#ifndef ATT_FP8
#define ATT_FP8 1
#endif
#ifndef PHSEL
#define PHSEL 0xffff
#endif
#define PS(k) ((PHSEL >> (k)) & 1)
#ifndef PROBE_REP
#define MOE_XCD_RANGE 1
#define PROBE_REP 0
#endif
#define NREP(k) (1 + ((PROBE_REP >> (k)) & 1))
#ifndef PROBE_NOST
#define PROBE_NOST 0
#endif
#define GAS __attribute__((address_space(1)))
#define LAS __attribute__((address_space(3)))
typedef unsigned short bf16;
typedef short bf16x8 __attribute__((ext_vector_type(8)));
typedef float f32x4 __attribute__((ext_vector_type(4)));
typedef float f32x2 __attribute__((ext_vector_type(2)));
typedef float f32x16 __attribute__((ext_vector_type(16)));
typedef unsigned u32x4 __attribute__((ext_vector_type(4)));
typedef unsigned u32x2 __attribute__((ext_vector_type(2)));
typedef GAS unsigned gu32;

constexpr int D = 1024, NB = 16, SEQ = 2048, CTXL = 256, RPB = SEQ + CTXL, M = NB * RPB, DEPTH = 4;
constexpr int NE = 32, TOPK = 4, NMOD = 6;
constexpr int CAP = M;
constexpr int ACT_ROWS = M * TOPK + NE * 256;
constexpr float EPS = 1e-5f;
constexpr float C2 = 0.125f * 1.4426950408889634f;
constexpr int NPHASE = 2 + 7 * DEPTH;
static_assert(!(FP8_CONV && CONV_FUSE_U), "the fused u epilogue needs the (bf16) interleaved copy of conv_w_in");

constexpr size_t MiB = 1u << 20;
constexpr size_t WS_CTL = 0, CTL_ZERO_BYTES = 1 * MiB;
constexpr size_t WS_MODV = 1 * MiB;
constexpr size_t WS_ROPE = 3 * MiB;
constexpr size_t WS_RW = 4 * MiB;
constexpr size_t WS_MISC = 5 * MiB;
constexpr size_t WS_TOPE = 6 * MiB;
constexpr size_t WS_TOPG = 7 * MiB;
constexpr size_t WS_TOPP = 8 * MiB;
constexpr size_t WS_LIST = 9 * MiB;
constexpr size_t WS_WQKV = 16 * MiB;
constexpr size_t WS_WIN = 28 * MiB;
constexpr size_t WS_WO = 40 * MiB;
constexpr size_t WS_WOUT = 44 * MiB;
constexpr size_t WS_WGU = 48 * MiB;
constexpr size_t WS_WD = 560 * MiB;
constexpr size_t WS_X = 816 * MiB;
constexpr size_t WS_H = 960 * MiB;
constexpr size_t WS_Q = 1032 * MiB;
constexpr size_t WS_K = 1104 * MiB;
constexpr size_t WS_VT = 1176 * MiB;
constexpr size_t WS_BCO = WS_Q;
constexpr size_t WS_O = 1248 * MiB;
constexpr size_t WS_ACT = 1320 * MiB;
constexpr size_t WS_Y = 1624 * MiB;
constexpr size_t WS_H8 = 1928 * MiB;
constexpr size_t WS_END = 1964 * MiB;
static_assert((size_t)M * 3072 * 2 == 216 * MiB && (size_t)ACT_ROWS * 2048 == 304 * MiB && (size_t)M * 4096 == 144 * MiB, "ws map");

constexpr int CW_TMO = 0;
constexpr int CW_BAR = 4096;
constexpr int CW_CNT = 16384;

constexpr int RING_BYTES = 131072;
constexpr int LX = RING_BYTES;
constexpr int LX_MISC = LX + 0;
constexpr int LX_TSTART = LX + 256;
constexpr int LX_ECNT = LX + 512;
constexpr int LX_LCNT = LX + 640;
constexpr int LX_LBASE = LX + 768;
constexpr int LX_TILEE = LX + 1024;
constexpr int LX_WSC = LX + 4096;
constexpr int LX_ASG = LX + 12288;
constexpr int LX_EPI = LX + 16384;
constexpr int LDS_BYTES = LX + 32768;
constexpr int NWAVES = 8, NTHREADS = 512;

#define RLX_AGENT __ATOMIC_RELAXED, __HIP_MEMORY_SCOPE_AGENT
__device__ __forceinline__ unsigned f2bf(float f) { unsigned u = __builtin_bit_cast(unsigned, f); return (u + 0x7fffu + ((u >> 16) & 1u)) >> 16; }
typedef __bf16 bf16x2_t __attribute__((ext_vector_type(2)));
__device__ __forceinline__ unsigned cvt_pk_bf16(float lo, float hi) { const f32x2 v = {lo, hi}; const bf16x2_t b = __builtin_convertvector(v, bf16x2_t); return __builtin_bit_cast(unsigned, b); }
__device__ __forceinline__ float bf2f(unsigned short b) { return __builtin_bit_cast(float, (unsigned)b << 16); }
__device__ __forceinline__ float wave_sum(float v) {
    v += __builtin_bit_cast(float, __builtin_amdgcn_update_dpp(0, __builtin_bit_cast(int, v), 0xB1, 0xF, 0xF, true));
    v += __builtin_bit_cast(float, __builtin_amdgcn_update_dpp(0, __builtin_bit_cast(int, v), 0x4E, 0xF, 0xF, true));
    v += __builtin_bit_cast(float, __builtin_amdgcn_update_dpp(0, __builtin_bit_cast(int, v), 0x124, 0xF, 0xF, true));
    v += __builtin_bit_cast(float, __builtin_amdgcn_update_dpp(0, __builtin_bit_cast(int, v), 0x128, 0xF, 0xF, true));
    v += __shfl_xor(v, 16);
    auto rr = __builtin_amdgcn_permlane32_swap(__float_as_uint(v), __float_as_uint(v), false, false);
    return __uint_as_float(rr[0]) + __uint_as_float(rr[1]);
}

#define XB_TMO      128
#define XB_XCNT(j)  (256  + 64 * (j))
#define XB_XSUB(j)  (1280 + 64 * (j))
#define XB_XGEN(j)  (2304 + 64 * (j))
#define XB_TOP      3328
#define XB_TOPGEN   3392
#define XCD_BAR_WORDS 3456
#define XB_SPIN_CAP (1u << 18)
__device__ __forceinline__ unsigned xb_ld(unsigned* p)              { return __hip_atomic_load(p, __ATOMIC_RELAXED, __HIP_MEMORY_SCOPE_AGENT); }
__device__ __forceinline__ unsigned xb_add(unsigned* p, unsigned v) { return __hip_atomic_fetch_add(p, v, __ATOMIC_RELAXED, __HIP_MEMORY_SCOPE_AGENT); }
__device__ __forceinline__ unsigned xb_xcc_id() { return (unsigned)__builtin_amdgcn_s_getreg((3 << 11) | 20) & 0xFu; }
#define XB_SPIN(cond, bar) do { unsigned _sp = 0; while (cond) { __builtin_amdgcn_s_sleep(1); \
    if ((++_sp & 255u) == 0u) { if (xb_ld(&(bar)[XB_TMO])) break; if (_sp > XB_SPIN_CAP) { atomicAdd(&(bar)[XB_TMO], 1u); break; } } } } while (0)
struct XcdBarrier { unsigned* bar; unsigned x; volatile LAS unsigned* st; };
__device__ __forceinline__ XcdBarrier xcd_barrier_post(unsigned* bar, volatile LAS unsigned* st) {
    XcdBarrier b; b.bar = bar; b.x = xb_xcc_id(); b.st = st;
    if (threadIdx.x == 0) (void)xb_add(&bar[XB_XCNT(b.x)], 1u);
    return b;
}
__device__ __forceinline__ void xcd_barrier_complete(unsigned* bar, unsigned x, unsigned& nloc, unsigned& nx) {
    const unsigned G = gridDim.x * gridDim.y * gridDim.z;
    unsigned sum, cnt, mine, sp = 0u;
    for (;;) {
        sum = 0u; cnt = 0u; mine = 0u;
#pragma unroll
        for (unsigned j = 0; j < 16; ++j) { const unsigned c = xb_ld(&bar[XB_XCNT(j)]); sum += c; cnt += (c > 0u) ? 1u : 0u; mine = (j == x) ? c : mine; }
        if (sum == G) break;
        __builtin_amdgcn_s_sleep(1);
        if ((++sp & 255u) == 0u) { if (xb_ld(&bar[XB_TMO])) break; if (sp > XB_SPIN_CAP) { atomicAdd(&bar[XB_TMO], 1u); break; } }
    }
    nloc = mine > 0u ? mine : 1u; nx = cnt > 0u ? cnt : 1u;
}
__device__ __forceinline__ void xcd_barrier(const XcdBarrier& b) {
    asm volatile("s_waitcnt vmcnt(0)" ::: "memory");
    __syncthreads();
    if (threadIdx.x == 0) {
        unsigned* bar = b.bar; unsigned bx = b.x;
        asm volatile("" : "+s"(bar), "+s"(bx));
        __builtin_amdgcn_s_waitcnt(0);
        unsigned nloc = b.st[0], nx = b.st[1];
        if (nloc == 0u) { xcd_barrier_complete(bar, bx, nloc, nx); b.st[0] = nloc; b.st[1] = nx; }
        const unsigned old = xb_add(&bar[XB_XSUB(bx)], 1u);
        const unsigned gen = old / nloc;
        if (old + 1u == (gen + 1u) * nloc) {
            __builtin_amdgcn_fence(__ATOMIC_RELEASE, "agent");
            asm volatile("s_waitcnt vmcnt(0)" ::: "memory");
            const unsigned og = xb_add(&bar[XB_TOP], 1u);
            const unsigned tg = og / nx;
            if (og + 1u == (tg + 1u) * nx) xb_add(&bar[XB_TOPGEN], 1u);
            else XB_SPIN(xb_ld(&bar[XB_TOPGEN]) == tg, bar);
            __builtin_amdgcn_fence(__ATOMIC_ACQUIRE, "agent");
            xb_add(&bar[XB_XGEN(bx)], 1u);
            asm volatile("s_waitcnt vmcnt(0)" ::: "memory");
        } else {
            XB_SPIN(xb_ld(&bar[XB_XGEN(bx)]) == gen, bar);
            __builtin_amdgcn_fence(__ATOMIC_ACQUIRE, "agent");
            asm volatile("s_waitcnt vmcnt(0)" ::: "memory");
        }
    }
    __syncthreads();
}

namespace pg8 {
constexpr int BM = 256, BK = 64, HALF = 128, HTB = HALF * BK * 2, STAGE_BYTES = 8 * HTB, KD = 1024;
__host__ __device__ __forceinline__ int lds_byte(int r, int c) { const int st = (r >> 4) * 2 + (c >> 5), rr = r & 15, cc = c & 31, ob = rr * 64 + cc * 2; return st * 1024 + (ob ^ (((ob >> 9) & 1) << 5)); }
__host__ __device__ __forceinline__ void stage_rc(int b, int& R, int& C) { const int st = b / 1024, sb = b % 1024, swz = sb ^ (((sb >> 9) & 1) << 5); R = (st >> 1) * 16 + swz / 64; C = (st & 1) * 32 + (swz % 64) / 2; }
__host__ __device__ __forceinline__ int perm32(int rho) { const int n = rho >> 4, i = rho & 15; return 8 * (i >> 2) + 4 * n + (i & 3); }

struct Unit { int pm, pn, e, kind; };
typedef int v8i __attribute__((ext_vector_type(8)));
typedef int v4i __attribute__((ext_vector_type(4)));
__device__ __forceinline__ v8i cat8(bf16x8 lo, bf16x8 hi) { const v4i a = __builtin_bit_cast(v4i, lo), b = __builtin_bit_cast(v4i, hi); return __builtin_shufflevector(a, b, 0, 1, 2, 3, 4, 5, 6, 7); }

__device__ __forceinline__ bool deal(int i, int npu, int ntiles, int& mt, int& r) {
    const int G = gridDim.x, c = blockIdx.x;
    if ((G & 7) == 0) { const int x = c & 7, q = i * (G >> 3) + (c >> 3); mt = (q / npu) * 8 + x; r = q % npu; }
    else { const int L = i * G + c; mt = L / npu; r = L % npu; }
    return mt < ntiles;
}

__device__ __forceinline__ void mfma8(f32x4& acc, const v8i a, const v8i b, int sc) {
    asm volatile("v_mfma_scale_f32_16x16x128_f8f6f4 %0, %1, %2, %0, %3, %3 op_sel_hi:[0,0,0]" : "+v"(acc) : "v"(a), "v"(b), "v"(sc)); }
__device__ __forceinline__ void glds16s(const char* sbase, unsigned voff, unsigned lds_dst) { unsigned keep;
    asm volatile("s_mov_b32 %0, m0\n\ts_mov_b32 m0, %3\n\ts_nop 0\n\tglobal_load_lds_dwordx4 %1, %2\n\ts_mov_b32 m0, %0" : "=&s"(keep) : "v"(voff), "s"(sbase), "s"(lds_dst) : "memory"); }
template <class Epi, class Sched, int PH = 0>
__device__ __forceinline__ void gemm_phase(LAS unsigned char* lds, const Sched& S, const Epi& E, const int tid, const int stagger_ticks = 0) {
    const int wid = __builtin_amdgcn_readfirstlane(tid >> 6), lane = tid & 63, wr = wid >> 2, wc = wid & 3, fr = lane & 15, fq = lane >> 4;
    constexpr int RB = Sched::RB, nt = RB / 128;
    constexpr bool F8 = (RB == 1024);
    unsigned voffB[2];
#pragma unroll
    for (int i = 0; i < 2; ++i) { int R_, C_; stage_rc(tid * 16 + i * 8192, R_, C_); const int Rb = (R_ & ~31) + perm32(R_ & 31); voffB[i] = (unsigned)(Rb * RB + C_ * 2); }
    constexpr bool GA = Sched::GATHER;
    constexpr int NH = GA ? 2 : 1;
    constexpr size_t kstep = (size_t)(BK * 2);
    constexpr size_t hstep = (size_t)HALF * RB, bstep = hstep;
    const unsigned ldsw = (unsigned)wid * 1024u, lds0 = (unsigned)(uintptr_t)lds;
    const int aoff = lds_byte(wr * 64 + fr, fq * 8), boff = lds_byte(wc * 32 + fr, fq * 8);
#define PG8_SA(b, h) (((b) * 2 + (h)) * HTB)
#define PG8_SB(b, h) ((4 + (b) * 2 + (h)) * HTB)
#define PG8_STAGE(bufoff, gbase, voff) do { _Pragma("unroll") for (int _i = 0; _i < 2; ++_i) \
        glds16s((const char*)(gbase), (voff)[_i], (unsigned)__builtin_amdgcn_readfirstlane(lds0 + (unsigned)(bufoff) + ldsw + _i * 8192u)); } while (0)
#define PG8_LDA(dst, b, h) do { _Pragma("unroll") for (int m = 0; m < 4; ++m) _Pragma("unroll") for (int k = 0; k < 2; ++k) dst[m][k] = *(const LAS bf16x8*)(lds + PG8_SA(b, h) + aoff + m * 2048 + k * 1024); } while (0)
#define PG8_LDB(dst, b, h) do { _Pragma("unroll") for (int n = 0; n < 2; ++n) _Pragma("unroll") for (int k = 0; k < 2; ++k) dst[n][k] = *(const LAS bf16x8*)(lds + PG8_SB(b, h) + boff + n * 2048 + k * 1024); } while (0)
#define PG8_MMA(ai, bj, At, Bt) do { __builtin_amdgcn_s_setprio(1); _Pragma("unroll") for (int m = 0; m < 4; ++m) _Pragma("unroll") for (int n = 0; n < 2; ++n) { \
        if constexpr (F8) mfma8(acc[ai][bj][m][n], cat8(Bt[n][0], Bt[n][1]), cat8(At[m][0], At[m][1]), sc8); \
        else { _Pragma("unroll") for (int k = 0; k < 2; ++k) acc[ai][bj][m][n] = __builtin_amdgcn_mfma_f32_16x16x32_bf16(Bt[n][k], At[m][k], acc[ai][bj][m][n], 0, 0, 0); } } __builtin_amdgcn_s_setprio(0); } while (0)
#define PG8_WAIT_V(n) asm volatile("s_waitcnt vmcnt(" #n ")" ::: "memory")
#define PG8_WAIT_VF do { if (fe) { if constexpr (Epi::NST == 16 && !PROBE_NOST) PG8_WAIT_V(24); else if constexpr (Epi::NST == 4 && !PROBE_NOST) PG8_WAIT_V(12); else if constexpr (Epi::NST == 8 && !PROBE_NOST) PG8_WAIT_V(16); else PG8_WAIT_V(8); } else PG8_WAIT_V(8); } while (0)
#define PG8_WAIT_L(n) asm volatile("s_waitcnt lgkmcnt(" #n ")" ::: "memory")
#define PG8_BAR __builtin_amdgcn_s_barrier()
#define PG8_SCHED __builtin_amdgcn_sched_barrier(0)
    Unit cur, nxt; int ui = 0;
    if (!S.next(0, cur)) return;
#define PT_ON(r) (PROBE_T == (r) && PH == PROBE_TPH)
#define PT_BEG(r) do { if (PT_ON(r)) pt0_ = __builtin_amdgcn_s_memtime(); } while (0)
#define PT_END(r) do { if (PT_ON(r)) { const unsigned long long d_ = __builtin_amdgcn_s_memtime() - pt0_; if (blockIdx.x == 0 && tid == 0) *(LAS unsigned long long*)(lds + LX_MISC + 64) += d_; } } while (0)
    unsigned long long pt0_ = 0; (void)pt0_;
    PT_BEG(3);
    if (stagger_ticks > 0 && (int)(blockIdx.x >> 3) >= (int)(gridDim.x >> 4)) { const unsigned long long t0_ = __builtin_amdgcn_s_memrealtime(); while ((long long)(__builtin_amdgcn_s_memrealtime() - t0_) < (long long)stagger_ticks) __builtin_amdgcn_s_sleep(16); }
    static_assert(Sched::SCALE_A == Sched::SCALE_B, "one scale register");
    int sc8 = Sched::SCALE_A; asm volatile("" : "+v"(sc8));
    f32x4 acc[2][2][4][2];
#pragma unroll
    for (int a = 0; a < 2; ++a)
#pragma unroll
        for (int b = 0; b < 2; ++b)
#pragma unroll
            for (int m = 0; m < 4; ++m)
#pragma unroll
                for (int n = 0; n < 2; ++n) acc[a][b][m][n] = (f32x4){0.f, 0.f, 0.f, 0.f};
    bf16x8 At[4][2], B0[2][2], B1[2][2];
    constexpr int NI = GA ? 1 : 2;
    unsigned vC[NH][NI], vN[NH][NI];
    unsigned cb2[2];
#pragma unroll
    for (int i = 0; i < 2; ++i) { int R_, C_; stage_rc(tid * 16 + i * 8192, R_, C_); cb2[i] = (unsigned)(C_ * 2); }
    const unsigned idx_slot = (unsigned)__builtin_amdgcn_readfirstlane((unsigned)(uintptr_t)(lds + LX_WSC) + (unsigned)wid * 1024u);
    if constexpr (GA) { S.idx_dma(cur, lane, idx_slot); asm volatile("s_waitcnt vmcnt(0)" ::: "memory"); S.a_offs_lds(cur, tid, vC, (LAS const int*)(lds + LX_WSC + wid * 1024)); }
    else S.a_offs(cur, tid, vC);
    const unsigned bias_slot0 = (unsigned)(uintptr_t)(lds + LX_ASG);
    if constexpr (Epi::BIAS_DMA) { Unit n1_; const bool h1_ = S.next(1, n1_);
        if (wid == 0) { glds16s((const char*)E.bias_src(cur), (unsigned)lane * 16u, (unsigned)__builtin_amdgcn_readfirstlane(bias_slot0));
            if (h1_) glds16s((const char*)E.bias_src(n1_), (unsigned)lane * 16u, (unsigned)__builtin_amdgcn_readfirstlane(bias_slot0 + 1024u)); } }
    auto acc_init = [&](int slot) {
        if constexpr (Epi::BIAS_DMA) { int fq2 = fq; asm volatile("" : "+v"(fq2)); LAS const float* bl_ = (LAS const float*)(lds + LX_ASG + slot * 1024); f32x4 bv_[2][2];
            _Pragma("unroll") for (int bj = 0; bj < 2; ++bj) { const int col = bj * 128 + wc * 32 + fq2 * 8; bv_[bj][0] = *(const LAS f32x4*)(bl_ + col); bv_[bj][1] = *(const LAS f32x4*)(bl_ + col + 4);
                if constexpr (Epi::BIAS_MUL != 1.f) { bv_[bj][0] *= Epi::BIAS_MUL; bv_[bj][1] *= Epi::BIAS_MUL; }
                if constexpr (Epi::GATE_COLS) { bv_[bj][0][0] *= Epi::GATE_MUL; bv_[bj][0][2] *= Epi::GATE_MUL; bv_[bj][1][0] *= Epi::GATE_MUL; bv_[bj][1][2] *= Epi::GATE_MUL; } }
            _Pragma("unroll") for (int a = 0; a < 2; ++a) _Pragma("unroll") for (int b = 0; b < 2; ++b) _Pragma("unroll") for (int m = 0; m < 4; ++m) _Pragma("unroll") for (int n = 0; n < 2; ++n) acc[a][b][m][n] = bv_[b][n]; }
        else { _Pragma("unroll") for (int a = 0; a < 2; ++a) _Pragma("unroll") for (int b = 0; b < 2; ++b) _Pragma("unroll") for (int m = 0; m < 4; ++m) _Pragma("unroll") for (int n = 0; n < 2; ++n) acc[a][b][m][n] = (f32x4){0.f, 0.f, 0.f, 0.f}; } };
#define PG8_HA(h) (GA ? 0 : (h) * hstep)
#define PG8_VH(v, h) (v)[GA ? (h) : 0]
#define PG8_STAGE_A(bufoff, gbase, vv) do { _Pragma("unroll") for (int _i = 0; _i < 2; ++_i) { unsigned o_; if constexpr (GA) o_ = (((vv)[0] >> (16 * _i)) & 0xffffu) * (unsigned)RB + cb2[_i]; else o_ = (vv)[NI - 2 + _i]; \
        glds16s((const char*)(gbase), o_, (unsigned)__builtin_amdgcn_readfirstlane(lds0 + (unsigned)(bufoff) + ldsw + _i * 8192u)); } } while (0)
    const char* cA = S.a_base(cur); const char* cB = S.b_base(cur);
    PG8_STAGE(PG8_SB(0, 0), cB, voffB); PG8_STAGE(PG8_SB(0, 1), cB + bstep, voffB); PG8_STAGE_A(PG8_SA(0, 0), cA, vC[0]); PG8_STAGE_A(PG8_SA(0, 1), cA + PG8_HA(1), PG8_VH(vC, 1));
    if (wr == 1) PG8_BAR;
    PG8_WAIT_V(2); PG8_BAR;
    PG8_STAGE(PG8_SB(1, 0), cB + kstep, voffB); PG8_STAGE_A(PG8_SA(1, 0), cA + kstep, vC[0]); PG8_STAGE(PG8_SB(1, 1), cB + bstep + kstep, voffB);
    PG8_WAIT_V(6); PG8_BAR;
    if constexpr (Epi::BIAS_DMA) acc_init(0);
    for (;;) {
        const bool has_next = S.next(ui + 1, nxt);
        const char* nA = cA; const char* nB = cB;
#pragma unroll
        for (int h = 0; h < NH; ++h)
#pragma unroll
            for (int i = 0; i < NI; ++i) vN[h][i] = vC[h][i];
        if (has_next) { if constexpr (GA) S.idx_dma(nxt, lane, idx_slot); else S.a_offs(nxt, tid, vN); nA = S.a_base(nxt); nB = S.b_base(nxt); }
        if constexpr (Epi::BIAS_DMA) { if (ui > 0 && has_next && wid == 0) glds16s((const char*)E.bias_src(nxt), (unsigned)lane * 16u, (unsigned)__builtin_amdgcn_readfirstlane(bias_slot0 + (unsigned)((ui + 1) & 1) * 1024u)); }
        PT_BEG(2);
#pragma unroll 1
        for (int t = 0; t < nt; t += 2) {
            const bool last = (t == nt - 2);
            const char* a1 = cA + (size_t)(t + 1) * kstep;
            const char* a2 = last ? nA : cA + (size_t)(t + 2) * kstep; const char* b2 = last ? nB : cB + (size_t)(t + 2) * kstep;
            const char* a3 = a2 + kstep; const char* b3 = b2 + kstep;
            if constexpr (GA) { if (last && has_next) S.a_offs_lds(nxt, tid, vN, (LAS const int*)(lds + LX_WSC + wid * 1024)); }
            unsigned w0[NI], w1[NI];
#pragma unroll
            for (int i = 0; i < NI; ++i) { w0[i] = last ? vN[0][i] : vC[0][i]; w1[i] = last ? PG8_VH(vN, 1)[i] : PG8_VH(vC, 1)[i]; }
            const bool fe = (t == 0) && (ui > 0);
            PG8_LDB(B0, 0, 0); PG8_LDB(B1, 0, 1); PG8_SCHED; PG8_LDA(At, 0, 0); if (!fe) PG8_STAGE_A(PG8_SA(1, 1), a1 + PG8_HA(1), PG8_VH(vC, 1));
            PG8_WAIT_VF; PG8_WAIT_L(0); PG8_BAR; PG8_MMA(0, 0, At, B0); PG8_MMA(0, 1, At, B1); PG8_BAR; PG8_SCHED;
            PG8_LDA(At, 0, 1); PG8_STAGE(PG8_SB(0, 0), b2, voffB); PG8_STAGE(PG8_SB(0, 1), b2 + bstep, voffB); PG8_STAGE_A(PG8_SA(0, 0), a2, w0);
            PG8_WAIT_VF; PG8_WAIT_L(0); PG8_BAR; PG8_MMA(1, 0, At, B0); PG8_MMA(1, 1, At, B1); PG8_BAR; PG8_SCHED;
            PG8_LDB(B0, 1, 0); PG8_LDB(B1, 1, 1); PG8_SCHED; PG8_LDA(At, 1, 0); PG8_STAGE_A(PG8_SA(0, 1), a2 + PG8_HA(1), w1);
            PG8_WAIT_VF; PG8_WAIT_L(0); PG8_BAR; PG8_MMA(0, 0, At, B0); PG8_MMA(0, 1, At, B1); PG8_BAR; PG8_SCHED;
            PG8_LDA(At, 1, 1); PG8_STAGE(PG8_SB(1, 0), b3, voffB); PG8_STAGE(PG8_SB(1, 1), b3 + bstep, voffB); PG8_STAGE_A(PG8_SA(1, 0), a3, w0);
            PG8_WAIT_V(8); PG8_WAIT_L(0); PG8_BAR; PG8_MMA(1, 0, At, B0); PG8_MMA(1, 1, At, B1); PG8_BAR; PG8_SCHED;
        }
        PT_END(2);
        if (has_next) PG8_STAGE_A(PG8_SA(1, 1), nA + kstep + PG8_HA(1), PG8_VH(vN, 1));
        if (wr == 0) PG8_BAR;
        PT_BEG(1);
        if constexpr (Epi::BIAS_DMA) E(acc, cur, wr, wc, fr, fq, (LAS const float*)(lds + LX_ASG + (ui & 1) * 1024)); else E(acc, cur, wr, wc, fr, fq);
        PT_END(1);
        if (!has_next) break;
        acc_init((ui + 1) & 1);
        cur = nxt; cA = nA; cB = nB; ++ui;
#pragma unroll
        for (int h = 0; h < NH; ++h)
#pragma unroll
            for (int i = 0; i < NI; ++i) vC[h][i] = vN[h][i];
        if (wr == 1) PG8_BAR;
    }
    PG8_WAIT_V(0);
    PG8_BAR;
    PT_END(3);
#undef PT_ON
#undef PT_BEG
#undef PT_END
#undef PG8_SA
#undef PG8_HA
#undef PG8_VH
#undef PG8_SB
#undef PG8_STAGE
#undef PG8_STAGE_A
#undef PG8_LDA
#undef PG8_LDB
#undef PG8_MMA
#undef PG8_WAIT_V
#undef PG8_WAIT_VF
#undef PG8_WAIT_L
#undef PG8_BAR
#undef PG8_SCHED
}
}
using pg8::Unit;

__device__ __forceinline__ int tile_row0(int mt, bool lat_only) { return lat_only ? ((mt >> 3) * 9 + 1 + (mt & 7)) * 256 : mt * 256; }

template <int RB_, int SC_> struct SchedQKV {
    static constexpr int RB = RB_, SCALE_A = SC_, SCALE_B = SC_;
    const char* H; const char* Wt;
    __device__ __forceinline__ bool next(int i, Unit& u) const { int mt, r; if (!pg8::deal(i, 12, M / 256, mt, r)) return false;
        if (r < 8) { u.kind = 0; u.pm = mt; u.pn = r; } else { u.kind = 1; u.pm = r - 8; u.pn = mt; } u.e = 0; return true; }
    static constexpr bool GATHER = false;
    __device__ __forceinline__ void a_offs(const Unit& u, int tid, unsigned (&v)[1][2]) const {
#pragma unroll
        for (int i = 0; i < 2; ++i) { int R, C; pg8::stage_rc(tid * 16 + i * 8192, R, C); v[0][i] = (unsigned)((u.pm * 256 + R) * RB + C * 2); } }
    __device__ __forceinline__ const char* a_base(const Unit& u) const { return u.kind == 0 ? H : Wt + (size_t)2048 * RB; }
    __device__ __forceinline__ const char* b_base(const Unit& u) const { return (u.kind == 0 ? Wt : H) + (size_t)u.pn * 256 * RB; }
};
template <int RB_, int SC_> struct SchedPlain {
    static constexpr int RB = RB_, SCALE_A = SC_, SCALE_B = SC_;
    const char* A; const char* Bt; int npu; bool lat_only;
    __device__ __forceinline__ bool next(int i, Unit& u) const { int mt, r; if (!pg8::deal(i, npu, lat_only ? 128 : 144, mt, r)) return false;
        u.pm = tile_row0(mt, lat_only) >> 8; u.pn = r; u.e = 0; u.kind = 0; return true; }
    static constexpr bool GATHER = false;
    __device__ __forceinline__ void a_offs(const Unit& u, int tid, unsigned (&v)[1][2]) const {
#pragma unroll
        for (int i = 0; i < 2; ++i) { int R, C; pg8::stage_rc(tid * 16 + i * 8192, R, C); v[0][i] = (unsigned)((u.pm * 256 + R) * RB + C * 2); } }
    __device__ __forceinline__ const char* a_base(const Unit&) const { return A; }
    __device__ __forceinline__ const char* b_base(const Unit& u) const { return Bt + (size_t)u.pn * 256 * RB; }
};
template <bool GATHER_, int RB_, int SA_, int SB_> struct SchedMoe {
    static constexpr bool GATHER = GATHER_;
    static constexpr int RB = RB_, SCALE_A = SA_, SCALE_B = SB_;
    const char* A; const char* Wt; const int* list; int npu; size_t estride;
    LAS const int* tstart; LAS const int* ecnt; LAS const int* tile_e;
    __device__ __forceinline__ bool mdeal(int i, int ntl, int& mt, int& r) const {
        const int G = gridDim.x, c = blockIdx.x;
        if (MOE_XCD_RANGE && (G & 7) == 0) { const int x = c & 7, q = i * (G >> 3) + (c >> 3); const int lo = (x * ntl) >> 3, hi = ((x + 1) * ntl) >> 3; mt = lo + q / npu; r = q % npu; return mt < hi; }
        return pg8::deal(i, npu, ntl, mt, r); }
    __device__ __forceinline__ bool next(int i, Unit& u) const { int mt, r; const int ntl = __builtin_amdgcn_readfirstlane(tstart[32]);
        int xp = 0;
        if (!mdeal(i, ntl, mt, r)) { if (!(PROBE_REP & (GATHER_ ? 0x100 : 0x200))) return false; int n_i = 0; while (mdeal(n_i, ntl, mt, r)) ++n_i; if (i >= 2 * n_i || !mdeal(i - n_i, ntl, mt, r)) return false; xp = 1; }
        u.pm = mt; u.pn = r; u.e = __builtin_amdgcn_readfirstlane(tile_e[mt]); u.kind = xp; return true; }
    __device__ __forceinline__ void idx_dma(const Unit& u, int lane, unsigned slot) const {
        const int j0 = (u.pm - __builtin_amdgcn_readfirstlane(tstart[u.e])) * 256;
        pg8::glds16s((const char*)(list + (size_t)u.e * CAP + j0), (unsigned)lane * 16u, slot); }
    __device__ __forceinline__ void a_offs_lds(const Unit& u, int tid, unsigned (&v)[2][1], LAS const int* slot) const {
        const int j0 = (u.pm - __builtin_amdgcn_readfirstlane(tstart[u.e])) * 256, cnt = __builtin_amdgcn_readfirstlane(ecnt[u.e]);
#pragma unroll
        for (int h = 0; h < 2; ++h) { unsigned pk = 0;
#pragma unroll
            for (int i = 0; i < 2; ++i) { int R, C; pg8::stage_rc(tid * 16 + i * 8192, R, C); const int r = h * 128 + R; const unsigned tok = (j0 + r) < cnt ? (unsigned)slot[r] : 0u; pk |= tok << (16 * i); }
            v[h][0] = pk; }
    }
    __device__ __forceinline__ void a_offs(const Unit& u, int tid, unsigned (&v)[GATHER_ ? 2 : 1][GATHER_ ? 1 : 2]) const {
        if constexpr (GATHER_) { const int j0 = (u.pm - __builtin_amdgcn_readfirstlane(tstart[u.e])) * 256, cnt = __builtin_amdgcn_readfirstlane(ecnt[u.e]); const int* lp = list + (size_t)u.e * CAP;
#pragma unroll
            for (int h = 0; h < 2; ++h) { unsigned pk = 0;
#pragma unroll
                for (int i = 0; i < 2; ++i) { int R, C; pg8::stage_rc(tid * 16 + i * 8192, R, C); const int idx = j0 + h * 128 + R; const unsigned tok = idx < cnt ? (unsigned)lp[idx] : 0u; pk |= tok << (16 * i); }
                v[h][0] = pk; }
        } else {
#pragma unroll
            for (int i = 0; i < 2; ++i) { int R, C; pg8::stage_rc(tid * 16 + i * 8192, R, C); v[0][i] = (unsigned)((u.pm * 256 + R) * RB + C * 2); } }
    }
    __device__ __forceinline__ const char* a_base(const Unit&) const { return A; }
    __device__ __forceinline__ const char* b_base(const Unit& u) const { return Wt + (size_t)u.e * estride + (size_t)u.pn * 256 * RB; }
};

#define EPI_LOOP_ROWS for (int ai = 0; ai < 2; ++ai) _Pragma("unroll") for (int m = 0; m < 4; ++m)
__device__ __forceinline__ u32x4 pack8(const f32x4& v0, const f32x4& v1) { u32x4 w; w.x = cvt_pk_bf16(v0[0], v0[1]); w.y = cvt_pk_bf16(v0[2], v0[3]); w.z = cvt_pk_bf16(v1[0], v1[1]); w.w = cvt_pk_bf16(v1[2], v1[3]); return w; }

__device__ __forceinline__ float clamp8(float v) { return __builtin_amdgcn_fmed3f(v, -448.f, 448.f); }
__device__ __forceinline__ unsigned pack_fp8x4(float a, float b, float c, float d) {
    const float ca = clamp8(a); int w = __builtin_bit_cast(int, ca);
    w = __builtin_amdgcn_cvt_pk_fp8_f32(ca, clamp8(b), w, false); w = __builtin_amdgcn_cvt_pk_fp8_f32(clamp8(c), clamp8(d), w, true); return (unsigned)w; }
struct EpiQKV {
    static constexpr bool BIAS_DMA = false;
    static constexpr int NST = ATT_FP8 ? 8 : 16;
    bf16* Q; bf16* Kb; bf16* Vt; const float* cosT; const float* sinT; bool dost; LAS unsigned char* stg;
    __device__ __forceinline__ void operator()(const f32x4 (&acc)[2][2][4][2], const Unit& u, int wr, int wc, int fr, int fq) const {
        asm volatile("" : "+v"(fr), "+v"(fq));
        if constexpr (ATT_FP8 != 0) {
            const bool isq = u.pn < 4, k0 = (u.kind == 0); const bool lat = k0 && (u.pm % 9) != 0;
            unsigned char* base8 = (unsigned char*)Q + (k0 ? (isq ? (size_t)0 : WS_K - WS_Q) : WS_VT - WS_Q); const size_t ld = k0 ? 1024 : (size_t)M; const int colbase = k0 ? (u.pn & 3) * 256 : u.pn * 256;
            const float sc = k0 ? (isq ? C2 * 64.f : 16.f) : 16.f;
            LAS unsigned char* sw = stg + (wr * 4 + wc) * 2048; const int lane = fq * 16 + fr; const int jp0 = 16 * (wc & 1) + 4 * fq;
#pragma unroll
            for (int ai = 0; ai < 2; ++ai) {
                f32x4 cs[4], sn[4];
#pragma unroll
                for (int m = 0; m < 4; ++m) { const int row = u.pm * 256 + ai * 128 + wr * 64 + m * 16 + fr; const int t = lat ? (row % RPB) - CTXL : 0;
                    const f32x4 cv = *(const f32x4*)(cosT + t * 32 + jp0), sv = *(const f32x4*)(cosT + 2048 * 32 + t * 32 + jp0);
#pragma unroll
                    for (int j = 0; j < 4; ++j) { cs[m][j] = lat ? cv[j] : 1.f; sn[m][j] = lat ? sv[j] : 0.f; } }
#pragma unroll
                for (int bj = 0; bj < 2; ++bj) {
#pragma unroll
                    for (int m = 0; m < 4; ++m) { const f32x4 a = acc[ai][bj][m][0], b = acc[ai][bj][m][1]; const f32x4 c_ = cs[m], s_ = sn[m];
                        u32x2 w8;
                        w8.x = pack_fp8x4((a[0] * c_[0] - a[1] * s_[0]) * sc, (a[1] * c_[0] + a[0] * s_[0]) * sc, (a[2] * c_[1] - a[3] * s_[1]) * sc, (a[3] * c_[1] + a[2] * s_[1]) * sc);
                        w8.y = pack_fp8x4((b[0] * c_[2] - b[1] * s_[2]) * sc, (b[1] * c_[2] + b[0] * s_[2]) * sc, (b[2] * c_[3] - b[3] * s_[3]) * sc, (b[3] * c_[3] + b[2] * s_[3]) * sc);
                        *(LAS u32x2*)(sw + (16 * m + fr) * 32 + fq * 8) = w8; }
                    asm volatile("s_waitcnt lgkmcnt(0)" ::: "memory");
#pragma unroll
                    for (int k = 0; k < 2; ++k) { const int p = lane + 64 * k, rr = p >> 1, hf = p & 1; const u32x4 v = *(const LAS u32x4*)(sw + p * 16);
                        const int row = u.pm * 256 + ai * 128 + wr * 64 + rr; const int col = colbase + bj * 128 + wc * 32 + hf * 16;
                        if (dost) *(u32x4*)(base8 + (size_t)row * ld + col) = v; }
                    asm volatile("s_waitcnt lgkmcnt(0)" ::: "memory");
                }
            }
        } else if (u.kind == 0) {
            const bool isq = u.pn < 4; bf16* base = isq ? Q : Kb; const float sc = isq ? C2 : 1.f;
            const bool lat = (u.pm % 9) != 0;
#pragma unroll
            EPI_LOOP_ROWS { const int row = u.pm * 256 + ai * 128 + wr * 64 + m * 16 + fr; const int t = (row % RPB) - CTXL;
#pragma unroll
                for (int bj = 0; bj < 2; ++bj) { const f32x4 a = acc[ai][bj][m][0], b = acc[ai][bj][m][1]; f32x4 o0, o1;
                    f32x4 cs = {1.f, 1.f, 1.f, 1.f}, sn = {0.f, 0.f, 0.f, 0.f}; const int jp0 = 16 * (wc & 1) + 4 * fq;
                    if (lat) { cs = *(const f32x4*)(cosT + t * 32 + jp0); sn = *(const f32x4*)(sinT + t * 32 + jp0); }
                    o0[0] = (a[0] * cs[0] - a[1] * sn[0]) * sc; o0[1] = (a[1] * cs[0] + a[0] * sn[0]) * sc; o0[2] = (a[2] * cs[1] - a[3] * sn[1]) * sc; o0[3] = (a[3] * cs[1] + a[2] * sn[1]) * sc;
                    o1[0] = (b[0] * cs[2] - b[1] * sn[2]) * sc; o1[1] = (b[1] * cs[2] + b[0] * sn[2]) * sc; o1[2] = (b[2] * cs[3] - b[3] * sn[3]) * sc; o1[3] = (b[3] * cs[3] + b[2] * sn[3]) * sc;
                    const int col = (u.pn & 3) * 256 + bj * 128 + wc * 32 + fq * 8;
                    if (ATT_FP8) { const float s8 = isq ? 64.f : 16.f; u32x2 w8; w8.x = pack_fp8x4(s8 * o0[0], s8 * o0[1], s8 * o0[2], s8 * o0[3]); w8.y = pack_fp8x4(s8 * o1[0], s8 * o1[1], s8 * o1[2], s8 * o1[3]);
                        if (dost) *(u32x2*)((unsigned char*)base + (size_t)row * 1024 + col) = w8; }
                    else { const u32x4 pk_ = pack8(o0, o1); if (dost) *(u32x4*)(base + (size_t)row * 1024 + col) = pk_; } } }
        } else {
#pragma unroll
            EPI_LOOP_ROWS { const int row = u.pm * 256 + ai * 128 + wr * 64 + m * 16 + fr;
#pragma unroll
                for (int bj = 0; bj < 2; ++bj) { const int col = u.pn * 256 + bj * 128 + wc * 32 + fq * 8;
                    if (ATT_FP8) { const f32x4 a_ = acc[ai][bj][m][0], b_ = acc[ai][bj][m][1]; u32x2 w8; w8.x = pack_fp8x4(16.f * a_[0], 16.f * a_[1], 16.f * a_[2], 16.f * a_[3]); w8.y = pack_fp8x4(16.f * b_[0], 16.f * b_[1], 16.f * b_[2], 16.f * b_[3]);
                        if (dost) *(u32x2*)((unsigned char*)Vt + (size_t)row * M + col) = w8; }
                    else { const u32x4 pk_ = pack8(acc[ai][bj][m][0], acc[ai][bj][m][1]); if (dost) *(u32x4*)(Vt + (size_t)row * M + col) = pk_; } } }
        }
    }
};
struct EpiPlain {
    static constexpr bool BIAS_DMA = false;
    static constexpr int NST = 16;
    bf16* O; int ldc;
    __device__ __forceinline__ void operator()(const f32x4 (&acc)[2][2][4][2], const Unit& u, int wr, int wc, int fr, int fq) const {
        asm volatile("" : "+v"(fr), "+v"(fq));
#pragma unroll
        EPI_LOOP_ROWS { const int row = u.pm * 256 + ai * 128 + wr * 64 + m * 16 + fr;
#pragma unroll
            for (int bj = 0; bj < 2; ++bj) { const int col = u.pn * 256 + bj * 128 + wc * 32 + fq * 8;
                *(u32x4*)(O + (size_t)row * ldc + col) = pack8(acc[ai][bj][m][0], acc[ai][bj][m][1]); } }
    }
};
struct EpiConvIn {
    static constexpr bool BIAS_DMA = false;
    static constexpr int NST = 16;
    bf16* Bb; bf16* Ub;
    __device__ __forceinline__ void operator()(const f32x4 (&acc)[2][2][4][2], const Unit& u, int wr, int wc, int fr, int fq) const {
        asm volatile("" : "+v"(fr), "+v"(fq));
        if (u.pn < 4) {
#pragma unroll
            EPI_LOOP_ROWS { const int row = u.pm * 256 + ai * 128 + wr * 64 + m * 16 + fr;
#pragma unroll
                for (int bj = 0; bj < 2; ++bj) { const int col = u.pn * 256 + bj * 128 + wc * 32 + fq * 8;
                    *(u32x4*)(Bb + (size_t)row * 1024 + col) = pack8(acc[ai][bj][m][0], acc[ai][bj][m][1]); } }
        } else {
#pragma unroll
            EPI_LOOP_ROWS { const int row = u.pm * 256 + ai * 128 + wr * 64 + m * 16 + fr;
#pragma unroll
                for (int bj = 0; bj < 2; ++bj) { const f32x4 a = acc[ai][bj][m][0], b = acc[ai][bj][m][1]; const int col = (u.pn - 4) * 128 + bj * 64 + wc * 16 + fq * 4;
                    u32x2 w; w.x = cvt_pk_bf16(a[0] * a[1], a[2] * a[3]); w.y = cvt_pk_bf16(b[0] * b[1], b[2] * b[3]);
                    *(u32x2*)(Ub + (size_t)row * 1024 + col) = w; } }
        }
    }
};
struct EpiResid {
    static constexpr bool BIAS_DMA = false;
    static constexpr int NST = X_BF16 ? 16 : 0;
    const void* Xin; void* X; const float* gate;
    const float* in_x; const float* in_ctx;
    __device__ __forceinline__ void operator()(const f32x4 (&acc)[2][2][4][2], const Unit& u, int wr, int wc, int fr, int fq) const {
        asm volatile("" : "+v"(fr), "+v"(fq));
        const int rb = (u.pm % 9) == 0 ? 16 : u.pm / 9; const float* gp = gate + rb * 6144;
        f32x4 gv[2][2];
#pragma unroll
        for (int bj = 0; bj < 2; ++bj) { const int col = u.pn * 256 + bj * 128 + wc * 32 + fq * 8; gv[bj][0] = *(const f32x4*)(gp + col); gv[bj][1] = *(const f32x4*)(gp + col + 4); }
        if (X_BF16 && !in_x) {
#pragma unroll
            for (int ai = 0; ai < 2; ++ai) { u32x4 xw[4][2];
#pragma unroll
                for (int m = 0; m < 4; ++m)
#pragma unroll
                    for (int bj = 0; bj < 2; ++bj) xw[m][bj] = *(const u32x4*)((const bf16*)Xin + (size_t)(u.pm * 256 + ai * 128 + wr * 64 + m * 16 + fr) * 1024 + u.pn * 256 + bj * 128 + wc * 32 + fq * 8);
#pragma unroll
                for (int m = 0; m < 4; ++m)
#pragma unroll
                    for (int bj = 0; bj < 2; ++bj) { const u32x4 w = xw[m][bj];
                        const f32x4 x0 = {bf2f((unsigned short)(w.x & 0xffffu)), bf2f((unsigned short)(w.x >> 16)), bf2f((unsigned short)(w.y & 0xffffu)), bf2f((unsigned short)(w.y >> 16))};
                        const f32x4 x1 = {bf2f((unsigned short)(w.z & 0xffffu)), bf2f((unsigned short)(w.z >> 16)), bf2f((unsigned short)(w.w & 0xffffu)), bf2f((unsigned short)(w.w >> 16))};
                        *(u32x4*)((bf16*)X + (size_t)(u.pm * 256 + ai * 128 + wr * 64 + m * 16 + fr) * 1024 + u.pn * 256 + bj * 128 + wc * 32 + fq * 8) = pack8(x0 + gv[bj][0] * acc[ai][bj][m][0], x1 + gv[bj][1] * acc[ai][bj][m][1]); } }
        } else {
#pragma unroll
            EPI_LOOP_ROWS { const int row = u.pm * 256 + ai * 128 + wr * 64 + m * 16 + fr;
#pragma unroll
                for (int bj = 0; bj < 2; ++bj) { const int col = u.pn * 256 + bj * 128 + wc * 32 + fq * 8; const size_t o = (size_t)row * 1024 + col;
                    const float* xs = (const float*)Xin + o;
                    if (in_x) { const int b_ = u.pm / 9, jt_ = u.pm % 9; const size_t ro = (size_t)(row - u.pm * 256) * 1024 + col;
                        xs = jt_ == 0 ? in_ctx + (size_t)b_ * CTXL * 1024 + ro : in_x + ((size_t)b_ * SEQ + (jt_ - 1) * 256) * 1024 + ro; }
                    const f32x4 x0 = *(const f32x4*)(xs), x1 = *(const f32x4*)(xs + 4);
                    const f32x4 r0 = x0 + gv[bj][0] * acc[ai][bj][m][0], r1 = x1 + gv[bj][1] * acc[ai][bj][m][1];
                    if (X_BF16) *(u32x4*)((bf16*)X + o) = pack8(r0, r1);
                    else { *(f32x4*)((float*)X + o) = r0; *(f32x4*)((float*)X + o + 4) = r1; } } }
        }
    }
};
__device__ __forceinline__ float swiglu1(float g, float l) {
    g = fminf(g, 7.f); l = fminf(fmaxf(l, -7.f), 7.f);
    const float s = __builtin_amdgcn_rcpf(1.f + __builtin_amdgcn_exp2f(-1.702f * 1.4426950408889634f * g));
    return g * s * (l + 1.f);
}
constexpr float GATE_PRE = -1.702f * 1.4426950408889634f;
__device__ __forceinline__ float swiglu4(float t, float l) {
    t = __builtin_amdgcn_fmed3f(t, 7.f * GATE_PRE, 3.0e38f); l = __builtin_amdgcn_fmed3f(l, -7.f, 7.f);
    const float r = __builtin_amdgcn_rcpf(1.f + __builtin_amdgcn_exp2f(t));
    return (t * r) * __builtin_fmaf(l, 4.f / GATE_PRE, 4.f / GATE_PRE);
}
template <bool F8> struct EpiSwiglu {
    static constexpr bool BIAS_DMA = true, GATE_COLS = F8; static constexpr float GATE_MUL = -1.702f * 1.4426950408889634f, BIAS_MUL = 1.f;
    static constexpr int NST = F8 ? 4 : 16;
    bf16* ACT; const float* bgu; LAS unsigned char* stg;
    __device__ __forceinline__ const float* bias_src(const Unit& u) const { return bgu + u.e * 2048 + u.pn * 256; }
    __device__ __forceinline__ void operator()(const f32x4 (&acc)[2][2][4][2], const Unit& u, int wr, int wc, int fr, int fq, LAS const float* bl) const {
        asm volatile("" : "+v"(fr), "+v"(fq));
        (void)bl;
        if constexpr (F8) {
            LAS unsigned* sw = (LAS unsigned*)(stg + (wr * 4 + wc) * 2048); const int lane = fq * 16 + fr;
#pragma unroll
            for (int ai = 0; ai < 2; ++ai) {
#pragma unroll
                for (int m = 0; m < 4; ++m)
#pragma unroll
                    for (int bj = 0; bj < 2; ++bj) { const f32x4 a = acc[ai][bj][m][0], b = acc[ai][bj][m][1];
                        const float s0_ = swiglu4(a[0], a[1]); int w = __builtin_bit_cast(int, s0_);
                        w = __builtin_amdgcn_cvt_pk_fp8_f32(s0_, swiglu4(a[2], a[3]), w, false); w = __builtin_amdgcn_cvt_pk_fp8_f32(swiglu4(b[0], b[1]), swiglu4(b[2], b[3]), w, true);
                        sw[((16 * m + fr) * 2 + bj) * 4 + fq] = (unsigned)w; }
                asm volatile("s_waitcnt lgkmcnt(0)" ::: "memory");
#pragma unroll
                for (int k = 0; k < 2; ++k) { const int p = lane + 64 * k, rr = p >> 1, bj = p & 1; const u32x4 v = *(const LAS u32x4*)(sw + p * 4);
                    const int row = u.pm * 256 + ai * 128 + wr * 64 + rr; const int col = u.pn * 128 + bj * 64 + wc * 16;
                    if (!(PROBE_NOST && u.kind)) *(u32x4*)((unsigned char*)ACT + (size_t)row * 1024 + col) = v; }
                asm volatile("s_waitcnt lgkmcnt(0)" ::: "memory");
            }
        } else {
#pragma unroll
            EPI_LOOP_ROWS { const int row = u.pm * 256 + ai * 128 + wr * 64 + m * 16 + fr;
#pragma unroll
                for (int bj = 0; bj < 2; ++bj) { const f32x4 a = acc[ai][bj][m][0], b = acc[ai][bj][m][1];
                    const int col = u.pn * 128 + bj * 64 + wc * 16 + fq * 4;
                    u32x2 w; w.x = cvt_pk_bf16(swiglu1(a[0], a[1]), swiglu1(a[2], a[3])); w.y = cvt_pk_bf16(swiglu1(b[0], b[1]), swiglu1(b[2], b[3]));
                    *(u32x2*)(ACT + (size_t)row * 1024 + col) = w; } }
        }
    }
};
struct EpiDown {
    static constexpr bool BIAS_DMA = true, GATE_COLS = false; static constexpr float GATE_MUL = 1.f, BIAS_MUL = Y_FP8 ? 16.f : 1.f;
    static constexpr int NST = Y_FP8 ? 8 : 16;
    bf16* Y; const float* bd; LAS unsigned char* stg;
    __device__ __forceinline__ const float* bias_src(const Unit& u) const { return bd + u.e * 1024 + u.pn * 256; }
    __device__ __forceinline__ void operator()(const f32x4 (&acc)[2][2][4][2], const Unit& u, int wr, int wc, int fr, int fq, LAS const float* bl) const {
        asm volatile("" : "+v"(fr), "+v"(fq));
        (void)bl;
        if constexpr (Y_FP8 != 0) {
            LAS unsigned char* sw = stg + (wr * 4 + wc) * 2048; const int lane = fq * 16 + fr;
#pragma unroll
            for (int ai = 0; ai < 2; ++ai)
#pragma unroll
                for (int bj = 0; bj < 2; ++bj) {
#pragma unroll
                    for (int m = 0; m < 4; ++m) { const f32x4 y0 = acc[ai][bj][m][0], y1 = acc[ai][bj][m][1];
                        u32x2 w; w.x = pack_fp8x4(y0[0], y0[1], y0[2], y0[3]); w.y = pack_fp8x4(y1[0], y1[1], y1[2], y1[3]);
                        *(LAS u32x2*)(sw + (16 * m + fr) * 32 + fq * 8) = w; }
                    asm volatile("s_waitcnt lgkmcnt(0)" ::: "memory");
#pragma unroll
                    for (int k = 0; k < 2; ++k) { const int p = lane + 64 * k, rr = p >> 1, hf = p & 1; const u32x4 v = *(const LAS u32x4*)(sw + p * 16);
                        const int row = u.pm * 256 + ai * 128 + wr * 64 + rr; const int col = u.pn * 256 + bj * 128 + wc * 32 + hf * 16;
                        if (!(PROBE_NOST && u.kind)) *(u32x4*)((unsigned char*)Y + (size_t)row * 1024 + col) = v; }
                    asm volatile("s_waitcnt lgkmcnt(0)" ::: "memory");
                }
        } else {
#pragma unroll
            EPI_LOOP_ROWS { const int row = u.pm * 256 + ai * 128 + wr * 64 + m * 16 + fr;
#pragma unroll
                for (int bj = 0; bj < 2; ++bj) { const int col = u.pn * 256 + bj * 128 + wc * 32 + fq * 8;
                    const u32x4 pk_ = pack8(acc[ai][bj][m][0], acc[ai][bj][m][1]); if (!(PROBE_NOST && u.kind)) *(u32x4*)(Y + (size_t)row * 1024 + col) = pk_; } }
        }
    }
};

namespace att {
constexpr int SLOT = 32768, VOFF = 16384;
__device__ __forceinline__ void glds16(const void* gsrc, unsigned lds_dst) { unsigned keep;
    asm volatile("s_mov_b32 %0, m0\n\ts_mov_b32 m0, %2\n\ts_nop 0\n\tglobal_load_lds_dwordx4 %1, off\n\ts_mov_b32 m0, %0" : "=&s"(keep) : "v"(gsrc), "s"(lds_dst) : "memory"); }
#define ATT_WAIT_BAR(N) asm volatile("s_waitcnt vmcnt(" #N ") lgkmcnt(0)\n\ts_barrier" ::: "memory")
__device__ __forceinline__ float half_swap_max(float m) { auto rr = __builtin_amdgcn_permlane32_swap(__float_as_uint(m), __float_as_uint(m), false, false); return fmaxf(__uint_as_float(rr[0]), __uint_as_float(rr[1])); }
__device__ __forceinline__ float half_swap_sum(float m) { auto rr = __builtin_amdgcn_permlane32_swap(__float_as_uint(m), __float_as_uint(m), false, false); return __uint_as_float(rr[0]) + __uint_as_float(rr[1]); }
__device__ __forceinline__ int crow(int r, int hi) { return (r & 3) + 8 * (r >> 2) + 4 * hi; }
__device__ __forceinline__ float max3f(float a, float b, float c) { float r; asm("v_max3_f32 %0, %1, %2, %3" : "=v"(r) : "v"(a), "v"(b), "v"(c)); return r; }

__device__ __forceinline__ void attn_unit(LAS unsigned char* lds, LAS float* wsc  , const bf16* Q, const bf16* Kb, const bf16* Vt, bf16* O,
                                          int krow0, int h, int qrow0, int NT, float lam, float osc, const float* subg, const int tid) {
    const int lane = tid & 63, r32 = lane & 31, hi = lane >> 5; const int wid = __builtin_amdgcn_readfirstlane(tid >> 6);
    const int qg = wid >> 1, c = wid & 1;
    const unsigned lds0 = (unsigned)(uintptr_t)lds;
    const bf16* ksrc[2]; const bf16* vsrc[2];
#pragma unroll
    for (int i = 0; i < 2; ++i) { const int p = 2 * wid + i;
        { const int row = 4 * p + (lane >> 4), ch = (lane & 15) ^ (row & 15); ksrc[i] = Kb + (size_t)(krow0 + row) * 1024 + h * 128 + ch * 8; }
        { const int row = 8 * p + (lane >> 3), ch = (lane & 7) ^ ((row >> 1) & 7); vsrc[i] = Vt + (size_t)(h * 128 + row) * M + krow0 + ch * 8; } }
    const unsigned kdst = lds0 + (unsigned)wid * 2048u, vdst = lds0 + VOFF + (unsigned)wid * 2048u;
#define ATT_DMA(t, slot) do { const unsigned so_ = (unsigned)(slot) * SLOT; \
        glds16(ksrc[0] + (size_t)(t) * 64 * 1024, (unsigned)__builtin_amdgcn_readfirstlane(kdst + so_)); glds16(ksrc[1] + (size_t)(t) * 64 * 1024, (unsigned)__builtin_amdgcn_readfirstlane(kdst + so_ + 1024u)); \
        glds16(vsrc[0] + (size_t)(t) * 64, (unsigned)__builtin_amdgcn_readfirstlane(vdst + so_)); glds16(vsrc[1] + (size_t)(t) * 64, (unsigned)__builtin_amdgcn_readfirstlane(vdst + so_ + 1024u)); } while (0)
    const int key0 = (r32 & 0x13) | ((r32 & 4) << 1) | ((r32 & 8) >> 1);
    const int kx = key0 & 15, vx = (r32 >> 1) & 7;
    bf16x8 qf[4];
    { const bf16* qp = Q + (size_t)(qrow0 + qg * 32 + r32) * 1024 + h * 128 + c * 64 + hi * 8;
#pragma unroll
      for (int d0 = 0; d0 < 4; ++d0) qf[d0] = *(const bf16x8*)(qp + d0 * 16); }
    float sg[4];
#pragma unroll
    for (int d0 = 0; d0 < 4; ++d0) sg[d0] = subg[d0 * 32 + r32] * osc;
    f32x16 o[4];
#pragma unroll
    for (int d0 = 0; d0 < 4; ++d0) o[d0] = f32x16{};
    float mref = 0.f, lsum = 0.f; f32x16 negm = f32x16{};
    asm volatile("s_waitcnt vmcnt(0)" ::: "memory");
#define AT_BEG(r) do { if (PROBE_T == (r)) at0_ = __builtin_amdgcn_s_memtime(); } while (0)
#define AT_END(r) do { if (PROBE_T == (r)) { const unsigned long long d_ = __builtin_amdgcn_s_memtime() - at0_; if (blockIdx.x == 0 && tid == ATT_PROBE_TID) *(LAS unsigned long long*)(lds + LX_MISC + 64) += d_; } } while (0)
    unsigned long long at0_ = 0; (void)at0_;
    AT_BEG(7);
    AT_BEG(13);
    ATT_DMA(0, 0);
    if (NT > 1) ATT_DMA(1, 1);
    for (int t = 0; t < NT; ++t) {
        const int slot = t & 3;
        AT_BEG(4);
        if (t + 1 < NT) { ATT_WAIT_BAR(4); } else { ATT_WAIT_BAR(0); }
        AT_END(4);
        if (t == 0) AT_END(13);
        if (t + 2 < NT) ATT_DMA(t + 2, (t + 2) & 3);
        AT_BEG(5);
        const LAS unsigned char* kb_ = lds + slot * SLOT; const LAS unsigned char* vb_ = kb_ + VOFF;
        f32x16 s0, s1;
        bf16x8 kf[8];
#pragma unroll
        for (int d0 = 0; d0 < 4; ++d0) { const int ch = (c * 8 + d0 * 2 + hi) ^ kx;
            kf[d0] = *(const LAS bf16x8*)(kb_ + key0 * 256 + ch * 16); kf[4 + d0] = *(const LAS bf16x8*)(kb_ + (key0 + 32) * 256 + ch * 16); }
        bf16x8 vA[8], vB[8];
#pragma unroll
        for (int ks = 0; ks < 2; ++ks) { const int ch = (2 * ks + hi) ^ vx;
#pragma unroll
            for (int d0 = 0; d0 < 4; ++d0) vA[ks * 4 + d0] = *(const LAS bf16x8*)(vb_ + (d0 * 32 + r32) * 128 + ch * 16); }
#pragma unroll
        for (int d0 = 0; d0 < 4; ++d0) s0 = __builtin_amdgcn_mfma_f32_32x32x16_bf16(kf[d0], qf[d0], d0 == 0 ? negm : s0, 0, 0, 0);
#pragma unroll
        for (int d0 = 0; d0 < 4; ++d0) s1 = __builtin_amdgcn_mfma_f32_32x32x16_bf16(kf[4 + d0], qf[d0], d0 == 0 ? negm : s1, 0, 0, 0);
        float rm = s0[0];
#pragma unroll
        for (int r = 1; r < 16; ++r) rm = fmaxf(rm, s0[r]);
        float sa = 0.f;
#pragma unroll
        for (int r = 0; r < 16; ++r) { s0[r] = __builtin_amdgcn_exp2f(s0[r]); sa += s0[r]; }
        bf16x8 pa[4];
#pragma unroll
        for (int s = 0; s < 2; ++s) { u32x4 w0;
            w0.x = cvt_pk_bf16(s0[8 * s + 0], s0[8 * s + 1]); w0.y = cvt_pk_bf16(s0[8 * s + 2], s0[8 * s + 3]); w0.z = cvt_pk_bf16(s0[8 * s + 4], s0[8 * s + 5]); w0.w = cvt_pk_bf16(s0[8 * s + 6], s0[8 * s + 7]);
            pa[s] = __builtin_bit_cast(bf16x8, w0); }
#pragma unroll
        for (int ks = 2; ks < 4; ++ks) { const int ch = (2 * ks + hi) ^ vx;
#pragma unroll
            for (int d0 = 0; d0 < 4; ++d0) vB[(ks - 2) * 4 + d0] = *(const LAS bf16x8*)(vb_ + (d0 * 32 + r32) * 128 + ch * 16); }
#pragma unroll
        for (int ks = 0; ks < 2; ++ks)
#pragma unroll
            for (int d0 = 0; d0 < 4; ++d0) o[d0] = __builtin_amdgcn_mfma_f32_32x32x16_bf16(pa[ks], vA[ks * 4 + d0], o[d0], 0, 0, 0);
#pragma unroll
        for (int r = 0; r < 16; ++r) rm = fmaxf(rm, s1[r]);
#pragma unroll
        for (int r = 0; r < 16; ++r) { s1[r] = __builtin_amdgcn_exp2f(s1[r]); sa += s1[r]; }
        lsum += sa;
#pragma unroll
        for (int s = 0; s < 2; ++s) { u32x4 w1;
            w1.x = cvt_pk_bf16(s1[8 * s + 0], s1[8 * s + 1]); w1.y = cvt_pk_bf16(s1[8 * s + 2], s1[8 * s + 3]); w1.z = cvt_pk_bf16(s1[8 * s + 4], s1[8 * s + 5]); w1.w = cvt_pk_bf16(s1[8 * s + 6], s1[8 * s + 7]);
            pa[2 + s] = __builtin_bit_cast(bf16x8, w1); }
#pragma unroll
        for (int ks = 2; ks < 4; ++ks)
#pragma unroll
            for (int d0 = 0; d0 < 4; ++d0) o[d0] = __builtin_amdgcn_mfma_f32_32x32x16_bf16(pa[ks], vB[(ks - 2) * 4 + d0], o[d0], 0, 0, 0);
        AT_END(5);
        rm = half_swap_max(rm);
        const bool need = (t == 0) || (rm > 8.f);
        if (__any(need)) {
            const float dl = need ? rm : 0.f; mref += dl;
#pragma unroll
            for (int r = 0; r < 16; ++r) negm[r] = -mref;
            const float f = __builtin_amdgcn_exp2f(-dl); lsum *= f;
            if (hi == 0) wsc[r32] = f;
            asm volatile("s_waitcnt lgkmcnt(0)" ::: "memory");
#pragma unroll
            for (int r = 0; r < 16; ++r) { const float fr_ = wsc[crow(r, hi)];
#pragma unroll
                for (int d0 = 0; d0 < 4; ++d0) o[d0][r] *= fr_; }
            asm volatile("s_waitcnt lgkmcnt(0)" ::: "memory");
        }
    }
    AT_BEG(14);
    const float lt = half_swap_sum(lsum);
    if (hi == 0) wsc[64 + r32] = (c ? -lam : 1.f) * __builtin_amdgcn_rcpf(lt);
    asm volatile("s_waitcnt lgkmcnt(0)\n\ts_barrier" ::: "memory");
    LAS float* xch = (LAS float*)(lds + qg * 16384);
#pragma unroll
    for (int r = 0; r < 16; ++r) { const float a = wsc[64 + crow(r, hi)];
#pragma unroll
        for (int d0 = 0; d0 < 4; ++d0) o[d0][r] *= a; }
    if (c == 1) {
#pragma unroll
        for (int d0 = 0; d0 < 4; ++d0)
#pragma unroll
            for (int r = 0; r < 16; ++r) xch[(d0 * 16 + r) * 64 + lane] = o[d0][r];
    }
    asm volatile("s_waitcnt lgkmcnt(0)\n\ts_barrier" ::: "memory");
    if (c == 0) {
        constexpr int OB = FP8_ATT_O ? 1 : 2;
        LAS unsigned char* stg = lds + 65536 + qg * 8192;
#pragma unroll
        for (int d0 = 0; d0 < 4; ++d0)
#pragma unroll
            for (int r = 0; r < 16; ++r) o[d0][r] += xch[(d0 * 16 + r) * 64 + lane];
        float ss[16], tt[16];
#pragma unroll
        for (int r = 0; r < 16; ++r) { float x = (o[0][r] * o[0][r] + o[1][r] * o[1][r]) + (o[2][r] * o[2][r] + o[3][r] * o[3][r]);
            x += __builtin_bit_cast(float, __builtin_amdgcn_update_dpp(0, __builtin_bit_cast(int, x), 0xB1, 0xF, 0xF, true));
            x += __builtin_bit_cast(float, __builtin_amdgcn_update_dpp(0, __builtin_bit_cast(int, x), 0x4E, 0xF, 0xF, true));
            x += __builtin_bit_cast(float, __builtin_amdgcn_update_dpp(0, __builtin_bit_cast(int, x), 0x124, 0xF, 0xF, true));
            x += __builtin_bit_cast(float, __builtin_amdgcn_update_dpp(0, __builtin_bit_cast(int, x), 0x128, 0xF, 0xF, true));
            ss[r] = x; }
#pragma unroll
        for (int r = 0; r < 16; ++r) tt[r] = __shfl_xor(ss[r], 16);
#pragma unroll
        for (int r = 0; r < 16; ++r) { const int qr = crow(r, hi); const float rn = __builtin_amdgcn_rsqf((ss[r] + tt[r]) * (1.f / 128.f) + EPS);
#pragma unroll
            for (int d0 = 0; d0 < 4; ++d0) { const float ov = o[d0][r] * rn * sg[d0];
                if (FP8_ATT_O) { const float o4 = clamp8(4.f * ov); *(LAS unsigned char*)(stg + qr * 128 + d0 * 32 + r32) = (unsigned char)(__builtin_amdgcn_cvt_pk_fp8_f32(o4, o4, 0, false) & 0xff); }
                else *(LAS unsigned short*)(stg + (qr * 128 + d0 * 32 + r32) * 2) = (unsigned short)f2bf(ov); } }
        asm volatile("s_waitcnt lgkmcnt(0)" ::: "memory");
        unsigned char* Ob = (unsigned char*)O + ((size_t)(qrow0 + qg * 32) * 1024 + h * 128) * OB;
#pragma unroll
        for (int k = 0; k < 4 * OB; ++k) { const int off = lane * 16 + 1024 * k, row = off / (128 * OB), cb = off % (128 * OB);
            *(u32x4*)(Ob + (size_t)row * 1024 * OB + cb) = *(const LAS u32x4*)(stg + off); }
    }
    asm volatile("s_waitcnt lgkmcnt(0)\n\ts_barrier" ::: "memory");
    AT_END(7);
    AT_END(14);
#undef AT_BEG
#undef AT_END
#undef ATT_DMA
}

typedef int v8i __attribute__((ext_vector_type(8)));
typedef int v4i_ __attribute__((ext_vector_type(4)));
__device__ __forceinline__ v8i cat16(u32x4 lo, u32x4 hi2) { const v4i_ a = __builtin_bit_cast(v4i_, lo), b = __builtin_bit_cast(v4i_, hi2); return __builtin_shufflevector(a, b, 0, 1, 2, 3, 4, 5, 6, 7); }
constexpr float ATT_TGT = 2.f;
__device__ __forceinline__ void attn_unit8(LAS unsigned char* lds, LAS float* wsc, const unsigned char* Q8, const unsigned char* K8, const unsigned char* V8t, bf16* O,
                                           int krow0, int h, int qrow0, int NT, float lam, float osc, const float* subg, const int tid, const int par, const bool pre, const int nkrow0, const int nh) {
    static_assert(FP8_ATT_O != 0, "the output staging area (LX_EPI) holds fp8 rows");
    constexpr int SL = 16384, VO = 8192;
    const int lane = tid & 63, r32 = lane & 31, hi = lane >> 5; const int wid = __builtin_amdgcn_readfirstlane(tid >> 6);
    const int qg = wid >> 1, c = wid & 1;
    const unsigned lds0 = (unsigned)(uintptr_t)lds;
    unsigned ksrc, vsrc;
    { const int key = 8 * wid + (lane >> 3), ch = (lane & 7) ^ ((key >> 1) & 7); ksrc = (unsigned)((krow0 + key) * 1024 + h * 128 + ch * 16); }
    { const int dv = 16 * wid + (lane >> 2), ch = (lane & 3) ^ ((dv >> 2) & 3); vsrc = (unsigned)((h * 128 + dv) * M + krow0 + ch * 16); }
    const unsigned kdst = lds0 + (unsigned)wid * 1024u, vdst = lds0 + VO + (unsigned)wid * 1024u;
#define ATT_DMA8(t, slot) do { const unsigned so_ = (unsigned)(slot) * SL; \
        pg8::glds16s((const char*)K8, ksrc + (unsigned)(t) * 65536u, (unsigned)__builtin_amdgcn_readfirstlane(kdst + so_)); pg8::glds16s((const char*)V8t, vsrc + (unsigned)(t) * 64u, (unsigned)__builtin_amdgcn_readfirstlane(vdst + so_)); } while (0)
#define ATT_DMA8_NEXT(pb) do { if (nkrow0 >= 0) { const unsigned nks_ = ksrc + (unsigned)((nkrow0 - krow0) * 1024 + (nh - h) * 128); const unsigned nvs_ = vsrc + (unsigned)((nh - h) * 128 * M + (nkrow0 - krow0)); \
        _Pragma("unroll") for (int j_ = 0; j_ < 4; ++j_) { const unsigned so_ = (unsigned)((pb) * 4 + j_) * SL; \
            pg8::glds16s((const char*)K8, nks_ + (unsigned)j_ * 65536u, (unsigned)__builtin_amdgcn_readfirstlane(kdst + so_)); pg8::glds16s((const char*)V8t, nvs_ + (unsigned)j_ * 64u, (unsigned)__builtin_amdgcn_readfirstlane(vdst + so_)); } } } while (0)
    const int key0 = 32 * ((r32 >> 2) & 1) + (r32 & 3) + 4 * (r32 >> 3);
    const int kx = (key0 >> 1) & 7, vx = (r32 >> 2) & 3;
    const int kc0 = ((c * 4 + 2 * hi) ^ kx) * 16, kc1 = ((c * 4 + 2 * hi + 1) ^ kx) * 16;
    const int vc0 = ((2 * hi) ^ vx) * 16, vc1 = ((2 * hi + 1) ^ vx) * 16;
    v8i qf;
    { const unsigned char* qp = Q8 + (size_t)(qrow0 + qg * 32 + r32) * 1024 + h * 128 + c * 64 + hi * 32;
      qf = cat16(*(const u32x4*)qp, *(const u32x4*)(qp + 16)); }
    (void)subg; (void)osc;
    f32x16 o[4];
#pragma unroll
    for (int d0 = 0; d0 < 4; ++d0) o[d0] = f32x16{};
    float mref = 0.f, lsum = 0.f; f32x16 negm;
#pragma unroll
    for (int r = 0; r < 16; ++r) negm[r] = ATT_TGT;
    const int NS = NT >> 2;
    if (!pre) { asm volatile("s_waitcnt vmcnt(0)" ::: "memory");
#pragma unroll
        for (int j = 0; j < 4; ++j) ATT_DMA8(j, par * 4 + j); }
    ATT_WAIT_BAR(0);
    asm volatile("" :: "v"(qf));
    if (NS > 1) {
#pragma unroll
        for (int j = 0; j < 4; ++j) ATT_DMA8(4 + j, (par ^ 1) * 4 + j);
    } else ATT_DMA8_NEXT(par ^ 1);
#define ATT_KFRAG(kb_, kk) cat16(*(const LAS u32x4*)((kb_) + (key0 + (kk)) * 128 + kc0), *(const LAS u32x4*)((kb_) + (key0 + (kk)) * 128 + kc1))
#define ATT_VFRAG(vb_, d0) cat16(*(const LAS u32x4*)((vb_) + ((d0) * 32 + r32) * 64 + vc0), *(const LAS u32x4*)((vb_) + ((d0) * 32 + r32) * 64 + vc1))
#define ATT_QK(kb_, kk) __builtin_amdgcn_mfma_scale_f32_32x32x64_f8f6f4(ATT_KFRAG(kb_, kk), qf, negm, 0, 0, 0, 0x7A7A7A7A, 0, 0x7A7A7A7A)
    {
        const LAS unsigned char* p0_ = lds + par * 4 * SL; const f32x16 s0 = ATT_QK(p0_, 0), s1 = ATT_QK(p0_, 16);
        float rm = s0[0];
#pragma unroll
        for (int r = 1; r < 16; ++r) rm = fmaxf(rm, s0[r]);
#pragma unroll
        for (int r = 0; r < 16; ++r) rm = fmaxf(rm, s1[r]);
        mref = half_swap_max(rm) - ATT_TGT;
#pragma unroll
        for (int r = 0; r < 16; ++r) negm[r] = ATT_TGT - mref;
    }
    for (int st = 0; st < NS; ++st) {
        if (st > 0) {
            ATT_WAIT_BAR(0);
            if (st + 1 < NS) {
#pragma unroll
                for (int j = 0; j < 4; ++j) ATT_DMA8(4 * (st + 1) + j, ((par + st + 1) & 1) * 4 + j);
            } else ATT_DMA8_NEXT((par + NS) & 1);
        }
        const LAS unsigned char* sb_ = lds + ((par + st) & 1) * 4 * SL;
        v8i pfp = {0, 0, 0, 0, 0, 0, 0, 0};
#pragma unroll
        for (int j = 0; j < 4; ++j) {
            const LAS unsigned char* kb_ = sb_ + j * SL;
            f32x16 s0 = ATT_QK(kb_, 0), s1 = ATT_QK(kb_, 16);
            if (j > 0) { const LAS unsigned char* vp_ = kb_ - SL + VO;
#pragma unroll
                for (int d0 = 0; d0 < 4; ++d0) o[d0] = __builtin_amdgcn_mfma_scale_f32_32x32x64_f8f6f4(pfp, ATT_VFRAG(vp_, d0), o[d0], 0, 0, 0, 0x7F7F7F7F, 0, 0x7F7F7F7F); }
#pragma unroll
            for (int r = 0; r < 16; ++r) { s0[r] = __builtin_amdgcn_exp2f(s0[r]); s1[r] = __builtin_amdgcn_exp2f(s1[r]); }
            float sa = 0.f, sb = 0.f;
#pragma unroll
            for (int r = 0; r < 16; ++r) { sa += s0[r]; sb += s1[r]; }
            sa += sb;
            if (__any(!(sa <= 448.f))) {
                unsigned ko_ = (unsigned)(uintptr_t)kb_; asm volatile("" : "+v"(ko_));
                const LAS unsigned char* kr_ = (const LAS unsigned char*)(uintptr_t)ko_;
                s0 = ATT_QK(kr_, 0); s1 = ATT_QK(kr_, 16);
                float rm = s0[0];
#pragma unroll
                for (int r = 1; r < 16; ++r) rm = fmaxf(rm, s0[r]);
#pragma unroll
                for (int r = 0; r < 16; ++r) rm = fmaxf(rm, s1[r]);
                rm = half_swap_max(rm);
                const float dl = fmaxf(rm - ATT_TGT, 0.f); mref += dl;
#pragma unroll
                for (int r = 0; r < 16; ++r) negm[r] = ATT_TGT - mref;
                const float f = __builtin_amdgcn_exp2f(-dl); lsum *= f;
                if (hi == 0) wsc[r32] = f;
                asm volatile("s_waitcnt lgkmcnt(0)" ::: "memory");
#pragma unroll
                for (int r = 0; r < 16; ++r) { const float fr_ = wsc[crow(r, hi)];
#pragma unroll
                    for (int d0 = 0; d0 < 4; ++d0) o[d0][r] *= fr_; }
                asm volatile("s_waitcnt lgkmcnt(0)" ::: "memory");
#pragma unroll
                for (int r = 0; r < 16; ++r) { s0[r] = __builtin_amdgcn_exp2f(s0[r] - dl); s1[r] = __builtin_amdgcn_exp2f(s1[r] - dl); }
                sa = 0.f; sb = 0.f;
#pragma unroll
                for (int r = 0; r < 16; ++r) { sa += s0[r]; sb += s1[r]; }
                sa += sb;
            }
            lsum += sa;
#pragma unroll
            for (int jj = 0; jj < 4; ++jj) { int w = __builtin_bit_cast(int, s0[4 * jj]); w = __builtin_amdgcn_cvt_pk_fp8_f32(s0[4 * jj], s0[4 * jj + 1], w, false); w = __builtin_amdgcn_cvt_pk_fp8_f32(s0[4 * jj + 2], s0[4 * jj + 3], w, true); pfp[jj] = w;
                int w2 = __builtin_bit_cast(int, s1[4 * jj]); w2 = __builtin_amdgcn_cvt_pk_fp8_f32(s1[4 * jj], s1[4 * jj + 1], w2, false); w2 = __builtin_amdgcn_cvt_pk_fp8_f32(s1[4 * jj + 2], s1[4 * jj + 3], w2, true); pfp[4 + jj] = w2; }
        }
        {
            const LAS unsigned char* vl_ = sb_ + 3 * SL + VO;
#pragma unroll
            for (int d0 = 0; d0 < 4; ++d0) o[d0] = __builtin_amdgcn_mfma_scale_f32_32x32x64_f8f6f4(pfp, ATT_VFRAG(vl_, d0), o[d0], 0, 0, 0, 0x7F7F7F7F, 0, 0x7F7F7F7F);
        }
    }
#undef ATT_KFRAG
#undef ATT_VFRAG
#undef ATT_QK
    const float lt = half_swap_sum(lsum);
    if (hi == 0) wsc[64 + r32] = (c ? -lam : 1.f) * __builtin_amdgcn_rcpf(16.f * lt);
    asm volatile("s_waitcnt lgkmcnt(0)\n\ts_barrier" ::: "memory");
    LAS float* xch = (LAS float*)(lds + ((par + NS - 1) & 1) * 65536 + qg * 16384);
#pragma unroll
    for (int r = 0; r < 16; ++r) { const float a = wsc[64 + crow(r, hi)];
#pragma unroll
        for (int d0 = 0; d0 < 4; ++d0) o[d0][r] *= a; }
    if (c == 1) {
#pragma unroll
        for (int d0 = 0; d0 < 4; ++d0)
#pragma unroll
            for (int r = 0; r < 16; ++r) xch[(d0 * 16 + r) * 64 + lane] = o[d0][r];
    }
    asm volatile("s_waitcnt lgkmcnt(0)\n\ts_barrier" ::: "memory");
    if (c == 0) {
        constexpr int OB = FP8_ATT_O ? 1 : 2;
        LAS unsigned char* stg = lds + LX_EPI + qg * 4096;
#pragma unroll
        for (int d0 = 0; d0 < 4; ++d0)
#pragma unroll
            for (int r = 0; r < 16; ++r) o[d0][r] += xch[(d0 * 16 + r) * 64 + lane];
        float sgl[4];
#pragma unroll
        for (int d0 = 0; d0 < 4; ++d0) sgl[d0] = wsc[96 + d0 * 32 + r32];
        float ss[16], tt[16];
#pragma unroll
        for (int r = 0; r < 16; ++r) { float x = (o[0][r] * o[0][r] + o[1][r] * o[1][r]) + (o[2][r] * o[2][r] + o[3][r] * o[3][r]);
            x += __builtin_bit_cast(float, __builtin_amdgcn_update_dpp(0, __builtin_bit_cast(int, x), 0xB1, 0xF, 0xF, true));
            x += __builtin_bit_cast(float, __builtin_amdgcn_update_dpp(0, __builtin_bit_cast(int, x), 0x4E, 0xF, 0xF, true));
            x += __builtin_bit_cast(float, __builtin_amdgcn_update_dpp(0, __builtin_bit_cast(int, x), 0x124, 0xF, 0xF, true));
            x += __builtin_bit_cast(float, __builtin_amdgcn_update_dpp(0, __builtin_bit_cast(int, x), 0x128, 0xF, 0xF, true));
            ss[r] = x; }
#pragma unroll
        for (int r = 0; r < 16; ++r) tt[r] = __shfl_xor(ss[r], 16);
#pragma unroll
        for (int r = 0; r < 16; ++r) { const int qr = crow(r, hi); const float rn = __builtin_amdgcn_rsqf((ss[r] + tt[r]) * (1.f / 128.f) + EPS);
#pragma unroll
            for (int d0 = 0; d0 < 4; ++d0) { const float ov = o[d0][r] * rn * sgl[d0];
                if (FP8_ATT_O) { const float o4 = clamp8(4.f * ov); *(LAS unsigned char*)(stg + qr * 128 + d0 * 32 + r32) = (unsigned char)(__builtin_amdgcn_cvt_pk_fp8_f32(o4, o4, 0, false) & 0xff); }
                else *(LAS unsigned short*)(stg + (qr * 128 + d0 * 32 + r32) * 2) = (unsigned short)f2bf(ov); } }
        asm volatile("s_waitcnt lgkmcnt(0)" ::: "memory");
        unsigned char* Ob = (unsigned char*)O + ((size_t)(qrow0 + qg * 32) * 1024 + h * 128) * OB;
#pragma unroll
        for (int k = 0; k < 4 * OB; ++k) { const int off = lane * 16 + 1024 * k, row = off / (128 * OB), cb = off % (128 * OB);
            *(u32x4*)(Ob + (size_t)row * 1024 * OB + cb) = *(const LAS u32x4*)(stg + off); }
    }
    asm volatile("s_waitcnt lgkmcnt(0)\n\ts_barrier" ::: "memory");
#undef ATT_DMA8
}
}

#if ATT_FP8
#define ATT_CALL(l_, w_, q_, k_, v_, o_, ...) att::attn_unit8(l_, w_, (const unsigned char*)(q_), (const unsigned char*)(k_), (const unsigned char*)(v_), o_, __VA_ARGS__)
#else
#define ATT_CALL att::attn_unit
#endif
__device__ __forceinline__ void load_row_f32(const float* p, int lane, f32x4 (&v)[4]) {
#pragma unroll
    for (int j = 0; j < 4; ++j) v[j] = *(const f32x4*)(p + 256 * j + 4 * lane);
}
__device__ __forceinline__ void load_row_x(const void* Xb, size_t row, int lane, f32x4 (&v)[4]) {
    if (X_BF16) { const bf16* p = (const bf16*)Xb + row * D;
#pragma unroll
        for (int j = 0; j < 4; ++j) { const u32x2 w = *(const u32x2*)(p + 256 * j + 4 * lane);
            v[j] = (f32x4){bf2f((unsigned short)(w.x & 0xffffu)), bf2f((unsigned short)(w.x >> 16)), bf2f((unsigned short)(w.y & 0xffffu)), bf2f((unsigned short)(w.y >> 16))}; } }
    else load_row_f32((const float*)Xb + row * D, lane, v);
}
__device__ __forceinline__ void store_row_x(void* Xb, size_t row, int lane, const f32x4 (&v)[4]) {
    if (X_BF16) { bf16* p = (bf16*)Xb + row * D;
#pragma unroll
        for (int j = 0; j < 4; ++j) { u32x2 w; w.x = cvt_pk_bf16(v[j][0], v[j][1]); w.y = cvt_pk_bf16(v[j][2], v[j][3]); *(u32x2*)(p + 256 * j + 4 * lane) = w; } }
    else { float* p = (float*)Xb + row * D;
#pragma unroll
        for (int j = 0; j < 4; ++j) *(f32x4*)(p + 256 * j + 4 * lane) = v[j]; }
}
__device__ __forceinline__ float row_rstd(const f32x4 (&v)[4]) {
    float s = 0.f;
#pragma unroll
    for (int j = 0; j < 4; ++j) s += (v[j][0] * v[j][0] + v[j][1] * v[j][1]) + (v[j][2] * v[j][2] + v[j][3] * v[j][3]);
    return 1.0f / sqrtf(wave_sum(s) * (1.f / D) + EPS);
}
__device__ __forceinline__ void norm_mod_store(f32x4 (&v)[4], const float* g, const float* sc, const float* sh, int lane, bf16* hrow) {
    const float rstd = row_rstd(v);
#pragma unroll
    for (int j = 0; j < 4; ++j) { const int c = 256 * j + 4 * lane; const f32x4 gg = *(const f32x4*)(g + c), ss = *(const f32x4*)(sc + c), hh = *(const f32x4*)(sh + c);
        v[j] = (v[j] * rstd) * gg * (ss + 1.f) + hh;
        u32x2 w; w.x = cvt_pk_bf16(v[j][0], v[j][1]); w.y = cvt_pk_bf16(v[j][2], v[j][3]); *(u32x2*)(hrow + c) = w; }
}
__device__ __forceinline__ void norm_mod_f32(f32x4 (&v)[4], const float* g, const float* sc, const float* sh, int lane) {
    const float rstd = row_rstd(v);
#pragma unroll
    for (int j = 0; j < 4; ++j) { const int c = 256 * j + 4 * lane; const f32x4 gg = *(const f32x4*)(g + c), ss = *(const f32x4*)(sc + c), hh = *(const f32x4*)(sh + c);
        v[j] = (v[j] * rstd) * gg * (ss + 1.f) + hh; }
}
__device__ __forceinline__ void norm_mod_store_mix(bool f8, f32x4 (&v)[4], const float* g, const float* sc, const float* sh, int lane, bf16* hrow, unsigned char* h8row) {
    if (f8) { norm_mod_f32(v, g, sc, sh, lane);
#pragma unroll
        for (int j = 0; j < 4; ++j) *(unsigned*)(h8row + 256 * j + 4 * lane) = pack_fp8x4(16.f * v[j][0], 16.f * v[j][1], 16.f * v[j][2], 16.f * v[j][3]); }
    else norm_mod_store(v, g, sc, sh, lane, hrow);
}
__device__ __forceinline__ int row_batch(int row) { return row / RPB; }
__device__ __forceinline__ bool row_is_ctx(int row) { return (row % RPB) < CTXL; }
__device__ __forceinline__ int act_row(int ai, bool lat_only) { return lat_only ? (ai >> 11) * RPB + CTXL + (ai & 2047) : ai; }

template <int MODE>
__device__ __forceinline__ void transpose_item(const float* W, int K, int N, bf16* WT, LAS float* scr, int item, int lane) {
    const int nblk = N / 32, kb = item / nblk, nb = item % nblk, k0 = 64 * kb, n0 = 32 * nb;
#pragma unroll 8
    for (int i = 0; i < 32; ++i) { const int kk = 2 * i + (lane >> 5); scr[kk * 33 + (lane & 31)] = W[(size_t)(k0 + kk) * N + n0 + (lane & 31)]; }
    asm volatile("s_waitcnt lgkmcnt(0)" ::: "memory");
    const int c = lane & 7;
#pragma unroll
    for (int j = 0; j < 4; ++j) { const int n = (lane >> 3) + 8 * j; const LAS float* s = scr + (8 * c) * 33 + n;
        u32x4 o; o.x = cvt_pk_bf16(s[0 * 33], s[1 * 33]); o.y = cvt_pk_bf16(s[2 * 33], s[3 * 33]); o.z = cvt_pk_bf16(s[4 * 33], s[5 * 33]); o.w = cvt_pk_bf16(s[6 * 33], s[7 * 33]);
        int nn = n0 + n;
        if (MODE == 1 && nn < 2048) { const int i6 = nn & 63; nn = (nn & ~63) + (i6 < 32 ? 2 * i6 : 2 * (i6 - 32) + 1); }
        if (MODE == 2 && nn >= 1024) nn = nn < 2048 ? 1024 + 2 * (nn - 1024) : 1024 + 2 * (nn - 2048) + 1;
        *(u32x4*)(WT + (size_t)nn * K + k0 + 8 * c) = o; }
    asm volatile("s_waitcnt lgkmcnt(0)" ::: "memory");
}

template <int MODE = 0>
__device__ __forceinline__ void transpose_item8(const float* W, int K, int N, unsigned char* WT, LAS float* scr, int item, int lane) {
    const int nblk = N / 16, kb = item / nblk, nb = item % nblk, k0 = 128 * kb, n0 = 16 * nb;
    f32x4 v[8];
#pragma unroll
    for (int i = 0; i < 8; ++i) v[i] = *(const f32x4*)(W + (size_t)(k0 + 16 * i + (lane >> 2)) * N + n0 + 4 * (lane & 3));
#pragma unroll
    for (int i = 0; i < 8; ++i) *(LAS f32x4*)(scr + (16 * i + (lane >> 2)) * 20 + 4 * (lane & 3)) = v[i] * 1024.f;
    asm volatile("s_waitcnt lgkmcnt(0)" ::: "memory");
    const int kc = lane & 7;
#pragma unroll
    for (int j = 0; j < 2; ++j) { const int n = (lane >> 3) + 8 * j; const LAS float* s = scr + (16 * kc) * 20 + n;
        u32x4 o;
        o.x = pack_fp8x4(s[0 * 20], s[1 * 20], s[2 * 20], s[3 * 20]); o.y = pack_fp8x4(s[4 * 20], s[5 * 20], s[6 * 20], s[7 * 20]);
        o.z = pack_fp8x4(s[8 * 20], s[9 * 20], s[10 * 20], s[11 * 20]); o.w = pack_fp8x4(s[12 * 20], s[13 * 20], s[14 * 20], s[15 * 20]);
        int nn = n0 + n;
        if (MODE == 1 && nn < 2048) { const int i6 = nn & 63; nn = (nn & ~63) + (i6 < 32 ? 2 * i6 : 2 * (i6 - 32) + 1); }
        *(u32x4*)(WT + (size_t)nn * K + k0 + 16 * kc) = o; }
    asm volatile("s_waitcnt lgkmcnt(0)" ::: "memory");
}

__device__ __forceinline__ void item8_load(const float* W, int N, int item, int lane, f32x4 (&v)[8]) {
    const int nblk = N / 16, kb = item / nblk, nb = item % nblk, k0 = 128 * kb, n0 = 16 * nb;
#pragma unroll
    for (int i = 0; i < 8; ++i) v[i] = *(const f32x4*)(W + (size_t)(k0 + 16 * i + (lane >> 2)) * N + n0 + 4 * (lane & 3));
}
__device__ __forceinline__ void item8_store(const f32x4 (&v)[8], int K, int N, unsigned char* WT, LAS float* scr, int item, int lane) {
    const int nblk = N / 16, kb = item / nblk, nb = item % nblk, k0 = 128 * kb, n0 = 16 * nb;
    const float ge = (N == 2048) ? 1024.f * GATE_PRE : 1024.f; const f32x4 mulv = {ge, 1024.f, ge, 1024.f};
#pragma unroll
    for (int i = 0; i < 8; ++i) *(LAS f32x4*)(scr + (16 * i + (lane >> 2)) * 20 + 4 * (lane & 3)) = v[i] * mulv;
    asm volatile("s_waitcnt lgkmcnt(0)" ::: "memory");
    const int kc = lane & 7;
#pragma unroll
    for (int j = 0; j < 2; ++j) { const int n = (lane >> 3) + 8 * j; const LAS float* s = scr + (16 * kc) * 20 + n;
        u32x4 o;
        o.x = pack_fp8x4(s[0 * 20], s[1 * 20], s[2 * 20], s[3 * 20]); o.y = pack_fp8x4(s[4 * 20], s[5 * 20], s[6 * 20], s[7 * 20]);
        o.z = pack_fp8x4(s[8 * 20], s[9 * 20], s[10 * 20], s[11 * 20]); o.w = pack_fp8x4(s[12 * 20], s[13 * 20], s[14 * 20], s[15 * 20]);
        *(u32x4*)(WT + (size_t)(n0 + n) * K + k0 + 16 * kc) = o; }
    asm volatile("s_waitcnt lgkmcnt(0)" ::: "memory");
}

struct Args { const float* in[21]; float* out; unsigned char* ws; int ph_lo, ph_hi; };
enum { I_X = 0, I_C, I_CTX, I_CCTX, I_MODW, I_MODB, I_NORMG, I_WQKV, I_WO, I_LAM, I_SUBG, I_WIN, I_CONVW, I_WOUT, I_RW, I_RB, I_WGU, I_BGU, I_WD, I_BD, I_FINALG };

__device__ __forceinline__ void moe_table(LAS unsigned char* lds, const unsigned* gcnt, int tid) {
    LAS int* ecnt = (LAS int*)(lds + LX_ECNT); LAS int* tstart = (LAS int*)(lds + LX_TSTART); LAS int* tile_e = (LAS int*)(lds + LX_TILEE);
    __syncthreads();
    if (tid < 32) ecnt[tid] = (int)__hip_atomic_load(gcnt + tid, RLX_AGENT);
    __syncthreads();
    if (tid == 0) { int ts = 0; for (int e = 0; e < 32; ++e) { tstart[e] = ts; ts += (ecnt[e] + 255) >> 8; } tstart[32] = ts; }
    __syncthreads();
    { const int e = tid >> 4, l16 = tid & 15; const int t0 = tstart[e], n = tstart[e + 1] - t0; for (int j = l16; j < n; j += 16) tile_e[t0 + j] = e; }
    __syncthreads();
}

typedef const __attribute__((address_space(4))) unsigned char* kptr_t;
__device__ __forceinline__ kptr_t kargs() { kptr_t p = (kptr_t)__builtin_amdgcn_kernarg_segment_ptr(); asm volatile("" : "+s"(p)); return p; }
#define INP(k) (*(const float* const __attribute__((address_space(4)))*)(kargs() + 8 * (k)))
#define OUTP() (*(float* const __attribute__((address_space(4)))*)(kargs() + 168))
#define WSB() (*(unsigned char* const __attribute__((address_space(4)))*)(kargs() + 176))
#define WSP(T, off) ((T*)(WSB() + (off)))
static_assert(sizeof(Args) == 192, "kernarg layout");
__global__ void __launch_bounds__(NTHREADS, 2) fwd(Args args) {
    extern __shared__ __attribute__((aligned(16))) unsigned char lds_raw[];
    LAS unsigned char* lds = (LAS unsigned char*)lds_raw;
    const int tid = threadIdx.x, lane = tid & 63, wave = __builtin_amdgcn_readfirstlane(tid >> 6);
    const int G = gridDim.x, bid = blockIdx.x;
    const int gw = bid * NWAVES + wave, NGW = G * NWAVES;
    gu32* ctl = (gu32*)WSP(unsigned, WS_CTL);
    for (int u = tid; u < (LDS_BYTES - LX) / 4; u += NTHREADS) ((LAS unsigned*)(lds + LX))[u] = 0u;
    __syncthreads();
    volatile LAS unsigned* MISC = (volatile LAS unsigned*)(lds + LX_MISC);
    XcdBarrier bar; bar.bar = (unsigned*)(ctl + CW_BAR); bar.x = 0; bar.st = nullptr;
    if (!MK_PER_PHASE) bar = xcd_barrier_post((unsigned*)(ctl + CW_BAR), MISC + 8);
    (void)args;
    const unsigned long long pt_start = PROBE_T ? __builtin_amdgcn_s_memtime() : 0ull; (void)pt_start;
    const unsigned long long pt_rstart = PROBE_T ? __builtin_amdgcn_s_memrealtime() : 0ull; (void)pt_rstart;
    const int lo = *(const int __attribute__((address_space(4)))*)(kargs() + 184), hi = *(const int __attribute__((address_space(4)))*)(kargs() + 188);
#define IN(k) (lo <= (k) && (k) < hi)
#define PHASE_IDS int tid = threadIdx.x; asm volatile("" : "+v"(tid)); const int lane = tid & 63, wave = __builtin_amdgcn_readfirstlane(tid >> 6); const int gw = bid * NWAVES + wave; (void)lane; (void)gw;
#define SEAM(k) do { if (IN(k) && IN((k) + 1)) { if (MK_PER_PHASE) { if (tid == 0) __hip_atomic_store(ctl + CW_TMO, 0xBADu, RLX_AGENT); } else { unsigned long long b0_ = 0; if (PROBE_T == 10) b0_ = __builtin_amdgcn_s_memtime(); xcd_barrier(bar); if (PROBE_REP & 0x10000) xcd_barrier(bar); if (PROBE_T == 10 && bid == PROBE_BID && threadIdx.x == 0) *(LAS unsigned long long*)(lds + LX_MISC + 64) += __builtin_amdgcn_s_memtime() - b0_; } } } while (0)

    if (PS(0) && IN(0)) { PHASE_IDS
        float* modv = WSP(float, WS_MODV);
        unsigned long long p0t_ = (PROBE_T == 11 || PROBE_T == 12) ? __builtin_amdgcn_s_memtime() : 0ull; (void)p0t_;
        { LAS float* sil = (LAS float*)lds;
          LAS float* red = (LAS float*)(lds + 69632);
          for (int i = tid; i < 17 * 1024; i += NTHREADS) { const int r = i >> 10, k = i & 1023; const float cv = r < 16 ? INP(I_C)[r * 1024 + k] : INP(I_CCTX)[k]; sil[i] = cv / (1.f + __expf(-cv)); }
          __syncthreads();
          for (int it = bid; it < 4 * 96; it += G) { const int l = it / 96, nb = it % 96; const float* W = INP(I_MODW) + (size_t)l * 1024 * 6144 + nb * 64 + lane;
            float a[17];
#pragma unroll
            for (int r = 0; r < 17; ++r) a[r] = 0.f;
            for (int k = wave * 128; k < wave * 128 + 128; k += 4) { float w[4];
#pragma unroll
                for (int q = 0; q < 4; ++q) w[q] = W[(size_t)(k + q) * 6144];
#pragma unroll
                for (int r = 0; r < 17; ++r) { const f32x4 s = *(const LAS f32x4*)(sil + r * 1024 + k); a[r] += s[0] * w[0] + s[1] * w[1] + s[2] * w[2] + s[3] * w[3]; } }
#pragma unroll
            for (int r = 0; r < 17; ++r) red[(wave * 17 + r) * 64 + lane] = a[r];
            __syncthreads();
            for (int i = tid; i < 17 * 64; i += NTHREADS) { const int r = i >> 6, n = i & 63; float s = INP(I_MODB)[l * 6144 + nb * 64 + n];
#pragma unroll
                for (int w8 = 0; w8 < 8; ++w8) s += red[(w8 * 17 + r) * 64 + n];
                modv[((size_t)l * 17 + r) * 6144 + nb * 64 + n] = s; }
            __syncthreads(); }
        }
        if (PROBE_T == 11 && bid == 0 && tid == 0) *(LAS unsigned long long*)(lds + LX_MISC + 64) += __builtin_amdgcn_s_memtime() - p0t_;
        { float* cosT = WSP(float, WS_ROPE); float* sinT = cosT + 2048 * 32; float* rwT = WSP(float, WS_RW); float* lamv = WSP(float, WS_MISC);
        for (int i = bid * NTHREADS + tid; i < 2048 * 32; i += G * NTHREADS) { const int t = i >> 5, j = i & 31; const float pos = (float)(j < 16 ? (t >> 6) : (t & 63));
            const float inv = powf(10000.f, -(float)(2 * (j & 15)) / 32.f); const float ang = pos * inv; cosT[i] = cosf(ang); sinT[i] = sinf(ang); }
        if (bid == 0 && tid < 2) { const float* lp = INP(I_LAM) + tid * 256; float s1 = 0.f, s2 = 0.f; for (int d = 0; d < 64; ++d) { s1 += lp[d] * lp[64 + d]; s2 += lp[128 + d] * lp[192 + d]; }
            const float lam_init = 0.8f - 0.6f * expf(-0.3f * (float)(2 * tid)); lamv[tid] = expf(s1) - expf(s2) + lam_init; lamv[2 + tid] = 1.f - lam_init; }
        for (int i = bid * NTHREADS + tid; i < 4 * 32 * 1024; i += G * NTHREADS) { const int l = i >> 15, e = (i >> 10) & 31, k = i & 1023; rwT[i] = INP(I_RW)[((size_t)l * 1024 + k) * 32 + e]; } }
        if (PROBE_T == 12) p0t_ = __builtin_amdgcn_s_memtime();
        { LAS float* scr = (LAS float*)(lds + wave * 10240);
          bf16* Wqkv_t = WSP(bf16, WS_WQKV); bf16* Win_t = WSP(bf16, WS_WIN); bf16* Wo_t = WSP(bf16, WS_WO); bf16* Wout_t = WSP(bf16, WS_WOUT); bf16* Wgu_t = WSP(bf16, WS_WGU); bf16* Wd_t = WSP(bf16, WS_WD);
          constexpr int I_QKV = 16 * 96, I_SQ = 16 * 32, I_GU = 16 * 64, I_D = 16 * 32;
          constexpr int T0 = 2 * I_QKV, T1 = T0 + 2 * I_QKV, T2 = T1 + 2 * I_SQ, T3 = T2 + 2 * I_SQ, T4 = T3 + 128 * I_GU, T5 = T4 + 128 * I_D;
          for (int rep = 0; rep < NREP(0); ++rep) {
          for (int it = gw; it < (MOE_FP8 ? T3 : T5); it += NGW) {
            if (it < T0) { const int j = it / I_QKV; if (FP8_ATT) transpose_item8<1>(INP(I_WQKV) + (size_t)j * 1024 * 3072, 1024, 3072, (unsigned char*)Wqkv_t + (size_t)j * 3072 * 1024, scr, it % I_QKV, lane); else transpose_item<1>(INP(I_WQKV) + (size_t)j * 1024 * 3072, 1024, 3072, Wqkv_t + (size_t)j * 3072 * 1024, scr, it % I_QKV, lane); }
            else if (it < T1) { const int r = it - T0, j = r / I_QKV; if (FP8_CONV) transpose_item8<0>(INP(I_WIN) + (size_t)j * 1024 * 3072, 1024, 3072, (unsigned char*)Win_t + (size_t)j * 3072 * 1024, scr, r % I_QKV, lane); else transpose_item<CONV_FUSE_U ? 2 : 0>(INP(I_WIN) + (size_t)j * 1024 * 3072, 1024, 3072, Win_t + (size_t)j * 3072 * 1024, scr, r % I_QKV, lane); }
            else if (it < T2) { const int r = it - T1, j = r / I_SQ; if (FP8_ATT_O) transpose_item8<0>(INP(I_WO) + (size_t)j * 1024 * 1024, 1024, 1024, (unsigned char*)Wo_t + (size_t)j * 1024 * 1024, scr, r % I_SQ, lane); else transpose_item<0>(INP(I_WO) + (size_t)j * 1024 * 1024, 1024, 1024, Wo_t + (size_t)j * 1024 * 1024, scr, r % I_SQ, lane); }
            else if (it < T3) { const int r = it - T2, j = r / I_SQ; if (FP8_WOUT) transpose_item8<0>(INP(I_WOUT) + (size_t)j * 1024 * 1024, 1024, 1024, (unsigned char*)Wout_t + (size_t)j * 1024 * 1024, scr, r % I_SQ, lane); else transpose_item<0>(INP(I_WOUT) + (size_t)j * 1024 * 1024, 1024, 1024, Wout_t + (size_t)j * 1024 * 1024, scr, r % I_SQ, lane); }
            else if (it < T4) { const int r = it - T3, j = r / I_GU; transpose_item<0>(INP(I_WGU) + (size_t)j * 1024 * 2048, 1024, 2048, Wgu_t + (size_t)j * 2048 * 1024, scr, r % I_GU, lane); }
            else { const int r = it - T4, j = r / I_D; transpose_item<0>(INP(I_WD) + (size_t)j * 1024 * 1024, 1024, 1024, Wd_t + (size_t)j * 1024 * 1024, scr, r % I_D, lane); }
          }
          if (MOE_FP8) {
            constexpr int NGUI = 128 * I_GU, NMOE = NGUI + 128 * I_D;
            const float* wgu = INP(I_WGU); const float* wd = INP(I_WD);
#define MOE_DEC(r_, W_, N_, WT_, IT_) do { if ((r_) < NGUI) { const int j_ = (r_) / I_GU; W_ = wgu + (size_t)j_ * 1024 * 2048; N_ = 2048; WT_ = (unsigned char*)Wgu_t + (size_t)j_ * 2048 * 1024; IT_ = (r_) % I_GU; } \
              else { const int q_ = (r_) - NGUI, j_ = q_ / I_D; W_ = wd + (size_t)j_ * 1024 * 1024; N_ = 1024; WT_ = (unsigned char*)Wd_t + (size_t)j_ * 1024 * 1024; IT_ = q_ % I_D; } } while (0)
            f32x4 vc[8], vn[8]; const float* Wc = nullptr; int Nc = 0, itc = 0; unsigned char* WTc = nullptr;
            int r = gw;
            if (r < NMOE) { MOE_DEC(r, Wc, Nc, WTc, itc); item8_load(Wc, Nc, itc, lane, vc); }
            for (; r < NMOE; r += NGW) { const int rn = r + NGW; const bool hn = rn < NMOE; const float* Wn = Wc; int Nn = Nc, itn = itc; unsigned char* WTn = WTc;
                if (hn) { MOE_DEC(rn, Wn, Nn, WTn, itn); item8_load(Wn, Nn, itn, lane, vn); }
                item8_store(vc, 1024, Nc, WTc, scr, itc, lane);
                if (hn) { Wc = Wn; Nc = Nn; itc = itn; WTc = WTn;
#pragma unroll
                    for (int i = 0; i < 8; ++i) vc[i] = vn[i]; } }
#undef MOE_DEC
          }
          }
        }
        if (PROBE_T == 12 && bid == 0 && tid == 0) *(LAS unsigned long long*)(lds + LX_MISC + 64) += __builtin_amdgcn_s_memtime() - p0t_;
        __syncthreads();
    }
    SEAM(0);

    if (PS(1) && IN(1)) { PHASE_IDS
        const float* g = INP(I_NORMG); const float* modv = WSP(float, WS_MODV); float* X = WSP(float, WS_X); bf16* H = WSP(bf16, WS_H);
        for (int row = gw; row < M; row += NGW) { const int b = row_batch(row), jj = row % RPB; const bool cx = jj < CTXL; const int rb = cx ? 16 : b;
            const float* src = cx ? INP(I_CTX) + ((size_t)b * CTXL + jj) * D : INP(I_X) + ((size_t)b * SEQ + (jj - CTXL)) * D;
            f32x4 v[4]; load_row_f32(src, lane, v);
            norm_mod_store_mix(FP8_ATT != 0, v, g, modv + rb * 6144 + 1024, modv + rb * 6144, lane, H + (size_t)row * D, WSP(unsigned char, WS_H8) + (size_t)row * 1024); }
    }
    SEAM(1);

    for (int l = 0; l < DEPTH; ++l) {
        const int pb = 2 + 7 * l; const bool attn = (l & 1) == 0; const int j2 = l >> 1; const bool lat_only = (l == DEPTH - 1);
#define MV() (WSP(float, WS_MODV) + (size_t)l * 17 * 6144)
        const unsigned* gcnt = (const unsigned*)(ctl + CW_CNT) + l * 32;

        if (IN(pb)) { PHASE_IDS
            if (PS(2) && attn) {
                constexpr int RBX = FP8_ATT ? 1024 : 2048; constexpr int SCX = FP8_ATT ? 0x78787878 : 0;
                typedef SchedQKV<RBX, SCX> SQ;
                SQ S{FP8_ATT ? (const char*)WSP(unsigned char, WS_H8) : (const char*)WSP(bf16, WS_H), (const char*)WSP(bf16, WS_WQKV) + (size_t)j2 * 3072 * RBX};
                EpiQKV E{WSP(bf16, WS_Q), WSP(bf16, WS_K), WSP(bf16, WS_VT), WSP(float, WS_ROPE), WSP(float, WS_ROPE) + 2048 * 32, true, lds + LX_EPI};
                for (int rep = 0; rep < NREP(2); ++rep) { int z_ = rep; asm volatile("" : "+s"(z_)); E.dost = !PROBE_NOST || (z_ == NREP(2) - 1); pg8::gemm_phase<EpiQKV, SQ, 2>(lds, S, E, tid, STAG(1500)); }
            } else if (PS(3)) {
                constexpr int RBX = FP8_CONV ? 1024 : 2048; constexpr int SCX = FP8_CONV ? 0x78787878 : 0;
                typedef SchedPlain<RBX, SCX> SP;
                SP S{FP8_CONV ? (const char*)WSP(unsigned char, WS_H8) : (const char*)WSP(bf16, WS_H), (const char*)WSP(bf16, WS_WIN) + (size_t)j2 * 3072 * RBX, 12, lat_only};
                if (CONV_FUSE_U) { EpiConvIn E{WSP(bf16, WS_BCO), WSP(bf16, WS_BCO) + (size_t)M * 1024};
                    for (int rep = 0; rep < NREP(3); ++rep) pg8::gemm_phase<EpiConvIn, SP, 3>(lds, S, E, tid, STAG(1500)); }
                else { EpiPlain E{WSP(bf16, WS_BCO), 3072};
                    for (int rep = 0; rep < NREP(3); ++rep) pg8::gemm_phase<EpiPlain, SP, 3>(lds, S, E, tid, STAG(1500)); }
            }
        }
        SEAM(pb);

        if (IN(pb + 1)) { PHASE_IDS
            if (PS(4) && attn) {
                const float* lamv = WSP(float, WS_MISC); const float lam = lamv[j2], osc = lamv[2 + j2]; const float* subg = INP(I_SUBG) + j2 * 128;
                const bf16* Qb = WSP(bf16, WS_Q); const bf16* Kb = WSP(bf16, WS_K); const bf16* Vt = WSP(bf16, WS_VT); bf16* Ob = WSP(bf16, WS_O);
                LAS float* wsc = (LAS float*)(lds + LX_WSC + wave * 1024);
                if (ATT_FP8) { wsc[96 + lane] = subg[lane] * osc; wsc[160 + lane] = subg[64 + lane] * osc; }
                const int vcu = (G % 8 == 0) ? (bid % 8) * (G / 8) + bid / 8 : bid;
                for (int rep = 0; rep < NREP(4); ++rep)
                if (G == 256) {
                    const int xc = bid & 7, j = bid >> 3;
                    const int bhc = xc * 16 + (j >> 1);
                    for (int sstep = 0; sstep < 8; ++sstep) { const int bh = xc * 16 + 2 * sstep + (j >> 4), b = bh >> 3, h = bh & 7;
                        const int bhn = sstep < 7 ? bh + 2 : bhc;
                        ATT_CALL(lds, wsc, Qb, Kb, Vt, Ob, b * RPB, h, b * RPB + CTXL + (j & 15) * 128, 36, lam, osc, subg, tid, sstep & 1, sstep > 0, (bhn >> 3) * RPB, bhn & 7); }
                    { const int b = bhc >> 3, h = bhc & 7;
                      ATT_CALL(lds, wsc, Qb, Kb, Vt, Ob, b * RPB, h, b * RPB + (j & 1) * 128, 4, lam, osc, subg, tid, 0, true, -1, 0); }
                } else {
                    for (int u = bid; u < 128 * 18; u += G) { const int bh = u / 18, k = u % 18, b = bh >> 3, h = bh & 7;
                        ATT_CALL(lds, wsc, Qb, Kb, Vt, Ob, b * RPB, h, k < 16 ? b * RPB + CTXL + k * 128 : b * RPB + (k - 16) * 128, k < 16 ? 36 : 4, lam, osc, subg, tid, 0, false, -1, 0); }
                }
            } else if (PS(5)) {
                const float* cw = INP(I_CONVW) + (size_t)j2 * 3 * 1024; const bf16* BCO = WSP(bf16, WS_BCO); bf16* Ob = WSP(bf16, WS_O);
                const int nact = lat_only ? 32768 : M; const int nitems = (nact / 16) * 2;
                for (int it = gw; it < nitems; it += NGW) { const int strip = it >> 1, ch = (it & 1) * 512 + lane * 8; const int row0 = act_row(strip * 16, lat_only);
                    const int jj = row0 % RPB; const int seq_lo = jj < CTXL ? row0 - jj : row0 - jj + CTXL, seq_hi = jj < CTXL ? row0 - jj + CTXL : row0 - jj + RPB;
                    float w0[8], w1[8], w2[8];
#pragma unroll
                    for (int q = 0; q < 8; ++q) { w0[q] = cw[ch + q]; w1[q] = cw[1024 + ch + q]; w2[q] = cw[2048 + ch + q]; }
                    static_assert(CONV_FUSE_U != 0, "u = gate_c * x~ comes from the in-projection's epilogue");
                    const bf16* Ub = BCO + (size_t)M * 1024 + ch; const bf16* Gb = BCO + ch;
                    u32x4 ur[18], gr[16];
#pragma unroll
                    for (int k = 0; k < 18; ++k) { const int row = row0 - 1 + k; const bool in = (k != 0 && k != 17) || (row >= seq_lo && row < seq_hi);
                        ur[k] = *(const u32x4*)(Ub + (size_t)(in ? row : row0) * 1024); if (!in) ur[k] = u32x4{0u, 0u, 0u, 0u}; }
#pragma unroll
                    for (int r = 0; r < 16; ++r) gr[r] = *(const u32x4*)(Gb + (size_t)(row0 + r) * 1024);
                    float up[8], uc[8], un[8];
#define CONV_UNPACK(u_, w_) do { _Pragma("unroll") for (int q = 0; q < 4; ++q) { u_[2 * q] = bf2f((unsigned short)((w_)[q] & 0xffffu)); u_[2 * q + 1] = bf2f((unsigned short)((w_)[q] >> 16)); } } while (0)
                    CONV_UNPACK(up, ur[0]); CONV_UNPACK(uc, ur[1]);
#pragma unroll
                    for (int r = 0; r < 16; ++r) { const int row = row0 + r; CONV_UNPACK(un, ur[r + 2]);
                        const u32x4 gb = gr[r]; float z[8];
#pragma unroll
                        for (int q = 0; q < 8; ++q) { const float gbv = bf2f((unsigned short)((q & 1) ? (gb[q >> 1] >> 16) : (gb[q >> 1] & 0xffffu))); z[q] = gbv * (w0[q] * up[q] + w1[q] * uc[q] + w2[q] * un[q]); }
                        if (FP8_WOUT) { u32x2 o; o.x = pack_fp8x4(4.f * z[0], 4.f * z[1], 4.f * z[2], 4.f * z[3]); o.y = pack_fp8x4(4.f * z[4], 4.f * z[5], 4.f * z[6], 4.f * z[7]); *(u32x2*)((unsigned char*)Ob + (size_t)row * 1024 + ch) = o; }
                        else { u32x4 o; o.x = cvt_pk_bf16(z[0], z[1]); o.y = cvt_pk_bf16(z[2], z[3]); o.z = cvt_pk_bf16(z[4], z[5]); o.w = cvt_pk_bf16(z[6], z[7]);
                        *(u32x4*)(Ob + (size_t)row * 1024 + ch) = o; }
#pragma unroll
                        for (int q = 0; q < 8; ++q) { up[q] = uc[q]; uc[q] = un[q]; } }
#undef CONV_UNPACK
                }
            }
        }
        SEAM(pb + 1);

        if (PS(6) && IN(pb + 2)) { PHASE_IDS
            float* X = WSP(float, WS_X);
            EpiResid E{X, X, MV() + 2 * 1024, l == 0 ? INP(I_X) : nullptr, l == 0 ? INP(I_CTX) : nullptr};
            if (attn) { constexpr int RBX = FP8_ATT_O ? 1024 : 2048; constexpr int SCX = FP8_ATT_O ? 0x79797979 : 0;
                typedef SchedPlain<RBX, SCX> SP;
                SP S{(const char*)WSP(bf16, WS_O), (const char*)WSP(bf16, WS_WO) + (size_t)j2 * 1024 * RBX, 4, lat_only};
                pg8::gemm_phase<EpiResid, SP, 6>(lds, S, E, tid, STAG(1500));
            } else { constexpr int RBX = FP8_WOUT ? 1024 : 2048; constexpr int SCX = FP8_WOUT ? 0x79797979 : 0;
                typedef SchedPlain<RBX, SCX> SP;
                SP S{(const char*)WSP(bf16, WS_O), (const char*)WSP(bf16, WS_WOUT) + (size_t)j2 * 1024 * RBX, 4, lat_only};
                pg8::gemm_phase<EpiResid, SP, 6>(lds, S, E, tid, STAG(1500));
            }
        }
        SEAM(pb + 2);

        if (PS(7) && IN(pb + 3)) { PHASE_IDS
            LAS int* lcnt = (LAS int*)(lds + LX_LCNT); LAS int* lbase = (LAS int*)(lds + LX_LBASE); LAS int* asg = (LAS int*)(lds + LX_ASG);
            LAS float* wsc = (LAS float*)(lds + LX_WSC + wave * 1024);
            LAS unsigned char* tile = lds;
            LAS float* part = (LAS float*)(lds + 65536);
            float* X = WSP(float, WS_X); bf16* H = WSP(bf16, WS_H); const float* mv = MV(); int* topE = WSP(int, WS_TOPE); float* topG = WSP(float, WS_TOPG); int* topP = WSP(int, WS_TOPP); int* list = WSP(int, WS_LIST);
            const int r32 = lane & 31, hi = lane >> 5;
            bf16x8 wf[8];
            { const float* rw = WSP(float, WS_RW) + (size_t)l * 32 * 1024 + r32 * 1024 + wave * 128 + hi * 8;
#pragma unroll
              for (int s8 = 0; s8 < 8; ++s8) { const f32x4 a = *(const f32x4*)(rw + 16 * s8), b = *(const f32x4*)(rw + 16 * s8 + 4); wf[s8] = __builtin_bit_cast(bf16x8, pack8(a, b)); } }
            __syncthreads();
            if (tid < 32) lcnt[tid] = 0;
            __syncthreads();
            const int nact = lat_only ? 32768 : M; const int rpb = (nact + G - 1) / G; const int a0 = bid * rpb; int nr = nact - a0; nr = nr < 0 ? 0 : (nr > rpb ? rpb : nr);
            const float* g = INP(I_NORMG) + ((size_t)l * 2 + 1) * 1024; const float* rb_ = INP(I_RB) + l * 32;
            for (int g0 = 0; g0 < nr; g0 += 32) {
                f32x4 v[4][4]; int rowq[4]; bool okq[4];
#pragma unroll
                for (int q = 0; q < 4; ++q) { const int i = g0 + wave + 8 * q; okq[q] = i < nr; rowq[q] = act_row(a0 + (okq[q] ? i : nr - 1), lat_only); load_row_x(X, (size_t)rowq[q], lane, v[q]); }
#pragma unroll
                for (int q = 0; q < 4; ++q) { const int row = rowq[q]; const int rb = row_is_ctx(row) ? 16 : row_batch(row); const int tr = wave + 8 * q;
                    norm_mod_f32(v[q], g, mv + rb * 6144 + 4 * 1024, mv + rb * 6144 + 3 * 1024, lane);
                    if (MOE_FP8) { unsigned char* h8 = WSP(unsigned char, WS_H8) + (size_t)row * 1024;
#pragma unroll
                        for (int j = 0; j < 4; ++j) { const unsigned pk_ = pack_fp8x4(16.f * v[q][j][0], 16.f * v[q][j][1], 16.f * v[q][j][2], 16.f * v[q][j][3]); if (okq[q]) *(unsigned*)(h8 + 256 * j + 4 * lane) = pk_; } }
#pragma unroll
                    for (int j = 0; j < 4; ++j) { u32x2 w; w.x = cvt_pk_bf16(v[q][j][0], v[q][j][1]); w.y = cvt_pk_bf16(v[q][j][2], v[q][j][3]);
                        if (!MOE_FP8 && okq[q]) *(u32x2*)(H + (size_t)row * D + 256 * j + 4 * lane) = w;
                        const int ch = 32 * j + (lane >> 1); *(LAS u32x2*)(tile + tr * 2048 + ((ch ^ (tr & 15)) << 4) + (lane & 1) * 8) = w; } }
                __syncthreads();
                { f32x16 acc = f32x16{};
#pragma unroll
                  for (int s8 = 0; s8 < 8; ++s8) { const int ch = wave * 16 + 2 * s8 + hi; const bf16x8 bfr = *(const LAS bf16x8*)(tile + r32 * 2048 + ((ch ^ (r32 & 15)) << 4));
                      acc = __builtin_amdgcn_mfma_f32_32x32x16_bf16(wf[s8], bfr, acc, 0, 0, 0); }
#pragma unroll
                  for (int r = 0; r < 16; ++r) { const int e = (r & 3) + 8 * (r >> 2) + 4 * hi; part[(wave * 32 + e) * 33 + r32] = acc[r]; } }
                __syncthreads();
#pragma unroll 1
                for (int q = 0; q < 4; ++q) { const int tr = wave + 8 * q; const int i = g0 + tr; const int row = rowq[q]; const int my_e = r32;
                    float lg = rb_[my_e];
#pragma unroll
                    for (int w8 = 0; w8 < 8; ++w8) lg += part[(w8 * 32 + my_e) * 33 + tr];
                    if (lane < 32) wsc[my_e] = lg;
                    asm volatile("s_waitcnt lgkmcnt(0)" ::: "memory");
                    int rank = 0;
#pragma unroll
                    for (int e = 0; e < 32; ++e) { const float o = wsc[e]; rank += (o > lg || (o == lg && e < my_e)) ? 1 : 0; }
                    asm volatile("s_waitcnt lgkmcnt(0)" ::: "memory");
                    if (lane < 32 && rank < 4) { wsc[64 + rank] = lg; ((LAS int*)wsc)[72 + rank] = my_e; }
                    asm volatile("s_waitcnt lgkmcnt(0)" ::: "memory");
                    const float t0 = wsc[64], t1 = wsc[65], t2 = wsc[66], t3 = wsc[67];
                    const float p0 = 1.f, p1 = __expf(t1 - t0), p2 = __expf(t2 - t0), p3 = __expf(t3 - t0); const float inv = 1.f / (p0 + p1 + p2 + p3);
                    if (lane < 4 && okq[q]) { const int e = ((LAS int*)wsc)[72 + lane]; const float p = lane == 0 ? p0 : lane == 1 ? p1 : lane == 2 ? p2 : p3;
                        const int lp = __hip_atomic_fetch_add(lcnt + e, 1, __ATOMIC_RELAXED, __HIP_MEMORY_SCOPE_WORKGROUP);
                        topE[row * 4 + lane] = e; topG[row * 4 + lane] = p * inv; asg[i * 4 + lane] = (lp << 5) | e; }
                    asm volatile("s_waitcnt lgkmcnt(0)" ::: "memory");
                }
            }
            __syncthreads();
            if (tid < 32) lbase[tid] = (int)__hip_atomic_fetch_add((unsigned*)gcnt + tid, (unsigned)lcnt[tid], RLX_AGENT);
            __syncthreads();
            for (int i = tid; i < nr * 4; i += NTHREADS) { const int av = asg[i], e = av & 31, pos = lbase[e] + (av >> 5); const int row = act_row(a0 + (i >> 2), lat_only);
                list[(size_t)e * CAP + pos] = row; topP[row * 4 + (i & 3)] = pos; }
            __syncthreads();
        }
        SEAM(pb + 3);

        if (PS(8) && IN(pb + 4)) { PHASE_IDS
            moe_table(lds, gcnt, tid);
            constexpr int RBM = MOE_FP8 ? 1024 : 2048;
            typedef SchedMoe<true, RBM, 0x78787878, 0x78787878> SG;
            SG S{(const char*)(MOE_FP8 ? (void*)WSP(unsigned char, WS_H8) : (void*)WSP(bf16, WS_H)), (const char*)WSP(bf16, WS_WGU) + (size_t)l * 32 * 2048 * RBM, WSP(int, WS_LIST), 8, (size_t)2048 * RBM,
                 (LAS const int*)(lds + LX_TSTART), (LAS const int*)(lds + LX_ECNT), (LAS const int*)(lds + LX_TILEE)};
            EpiSwiglu<MOE_FP8 != 0> E{WSP(bf16, WS_ACT), INP(I_BGU) + (size_t)l * 32 * 2048, lds + LX_EPI};
            pg8::gemm_phase<EpiSwiglu<MOE_FP8 != 0>, SG, 8>(lds, S, E, tid, STAG(900));
        }
        SEAM(pb + 4);

        if (PS(9) && IN(pb + 5)) { PHASE_IDS
            if (MK_PER_PHASE || lo == pb + 5) moe_table(lds, gcnt, tid);
            constexpr int RBM = MOE_FP8 ? 1024 : 2048;
            typedef SchedMoe<false, RBM, Y_FP8 ? 0x7B7B7B7B : 0x79797979, Y_FP8 ? 0x7B7B7B7B : 0x79797979> SD;
            SD S{(const char*)WSP(bf16, WS_ACT), (const char*)WSP(bf16, WS_WD) + (size_t)l * 32 * 1024 * RBM, WSP(int, WS_LIST), 4, (size_t)1024 * RBM,
                 (LAS const int*)(lds + LX_TSTART), (LAS const int*)(lds + LX_ECNT), (LAS const int*)(lds + LX_TILEE)};
            EpiDown E{WSP(bf16, WS_Y), INP(I_BD) + (size_t)l * 32 * 1024, lds + LX_EPI};
            pg8::gemm_phase<EpiDown, SD, 9>(lds, S, E, tid, STAG(1100));
            if (PROBE_T && l == DEPTH - 1 && bid == (PROBE_T == 10 ? PROBE_BID : 0) && tid == 0) { unsigned long long acc_ = *(LAS unsigned long long*)(lds + LX_MISC + 64); unsigned long long tot_ = __builtin_amdgcn_s_memtime() - pt_start;
                if (PROBE_T == 9) { acc_ = tot_; tot_ = (__builtin_amdgcn_s_memrealtime() - pt_rstart) * 30ull; }
                WSP(float, WS_MISC)[16] = floorf((float)((double)acc_ / (double)tot_) * PROBE_TQ + 0.5f) / PROBE_TQ; }
        }
        SEAM(pb + 5);

        if (PS(10) && IN(pb + 6)) { PHASE_IDS
            if (MK_PER_PHASE || lo >= pb + 5) moe_table(lds, gcnt, tid);
            LAS const int* tstart = (LAS const int*)(lds + LX_TSTART);
            const int nact = lat_only ? 32768 : M;
            const float* gn = (l + 1 < DEPTH) ? INP(I_NORMG) + (size_t)(l + 1) * 2 * 1024 : INP(I_FINALG);
            const float* mv = MV(); const float* mvn = mv + 17 * 6144; float* X = WSP(float, WS_X); bf16* H = WSP(bf16, WS_H); const bf16* Yb = WSP(bf16, WS_Y);
            const int* topE = WSP(int, WS_TOPE); const float* topG = WSP(float, WS_TOPG); const int* topP = WSP(int, WS_TOPP);
            for (int ai = gw; ai < nact; ai += 2 * NGW) {
                int row[2]; bool ok[2]; int4 ev[2], pv[2]; f32x4 gv[2];
#pragma unroll
                for (int u = 0; u < 2; ++u) { const int a2 = ai + u * NGW; ok[u] = a2 < nact; row[u] = act_row(ok[u] ? a2 : ai, lat_only);
                    ev[u] = *(const int4*)(topE + row[u] * 4); pv[u] = *(const int4*)(topP + row[u] * 4); gv[u] = *(const f32x4*)(topG + row[u] * 4); }
                f32x4 v[2][4]; u32x2 yw[2][4][4];
#pragma unroll
                for (int u = 0; u < 2; ++u) { load_row_x(X, (size_t)row[u], lane, v[u]);
                    const int ee[4] = {ev[u].x, ev[u].y, ev[u].z, ev[u].w}, pp[4] = {pv[u].x, pv[u].y, pv[u].z, pv[u].w};
#pragma unroll
                    for (int k = 0; k < 4; ++k) { const size_t yrow = (size_t)(tstart[ee[k]] * 256 + pp[k]);
#pragma unroll
                        for (int j = 0; j < 4; ++j) { if (Y_FP8) { yw[u][k][j].x = *(const unsigned*)((const unsigned char*)Yb + yrow * 1024 + 256 * j + 4 * lane); yw[u][k][j].y = 0u; }
                            else yw[u][k][j] = *(const u32x2*)(Yb + yrow * 1024 + 256 * j + 4 * lane); } } }
#pragma unroll
                for (int u = 0; u < 2; ++u) { if (!ok[u]) continue;
                    const int rw_ = row[u]; const bool cx = row_is_ctx(rw_); const int rb = cx ? 16 : row_batch(rw_);
                    f32x4 acc4[4];
#pragma unroll
                    for (int j = 0; j < 4; ++j) acc4[j] = (f32x4){0.f, 0.f, 0.f, 0.f};
#pragma unroll
                    for (int k = 0; k < 4; ++k) { const float gk = gv[u][k];
#pragma unroll
                        for (int j = 0; j < 4; ++j) { const u32x2 w = yw[u][k][j];
                            if (Y_FP8) { const f32x2 lo = __builtin_amdgcn_cvt_pk_f32_fp8((int)w.x, false), hi2 = __builtin_amdgcn_cvt_pk_f32_fp8((int)w.x, true); const float g16 = gk * (1.f / 16.f);
                                acc4[j][0] += g16 * lo[0]; acc4[j][1] += g16 * lo[1]; acc4[j][2] += g16 * hi2[0]; acc4[j][3] += g16 * hi2[1]; }
                            else { acc4[j][0] += gk * bf2f((unsigned short)(w.x & 0xffffu)); acc4[j][1] += gk * bf2f((unsigned short)(w.x >> 16)); acc4[j][2] += gk * bf2f((unsigned short)(w.y & 0xffffu)); acc4[j][3] += gk * bf2f((unsigned short)(w.y >> 16)); } } }
                    const float* g2 = mv + rb * 6144 + 5 * 1024;
#pragma unroll
                    for (int j = 0; j < 4; ++j) { const f32x4 gg = *(const f32x4*)(g2 + 256 * j + 4 * lane); v[u][j] = v[u][j] + gg * acc4[j]; }
                    if (l + 1 < DEPTH) {
                        store_row_x(X, (size_t)rw_, lane, v[u]);
                        if (!(l + 1 == DEPTH - 1 && cx))
                            norm_mod_store_mix(((l + 1) & 1) ? (FP8_CONV != 0) : (FP8_ATT != 0), v[u], gn, mvn + rb * 6144 + 1024, mvn + rb * 6144, lane, H + (size_t)rw_ * D, WSP(unsigned char, WS_H8) + (size_t)rw_ * 1024);
                    } else {
                        float rstd = row_rstd(v[u]); if (PROBE_T) rstd *= 1.f + sqrtf(WSP(float, WS_MISC)[16]); float* op = OUTP() + ((size_t)row_batch(rw_) * SEQ + (rw_ % RPB - CTXL)) * D;
#pragma unroll
                        for (int j = 0; j < 4; ++j) { const f32x4 gg = *(const f32x4*)(gn + 256 * j + 4 * lane); *(f32x4*)(op + 256 * j + 4 * lane) = (v[u][j] * rstd) * gg; }
                    }
                }
            }
        }
        if (l + 1 < DEPTH) SEAM(pb + 6);
    }
#undef IN
#undef SEAM
#undef MV
}

extern "C" void kernel_launch(void* const* d_in, const int* in_sizes, int n_in, void* d_out, int out_size, void* d_ws, size_t ws_size, hipStream_t stream) {
    static int grid = 0;
    if (grid == 0) {
        if (n_in != 21 || out_size != NB * SEQ * D || ws_size < WS_END) { fprintf(stderr, "kernel_launch: unexpected shapes (n_in %d, out %d, ws %zu)\n", n_in, out_size, ws_size); grid = -1; return; }
        int dev = 0, cus = 0, per_cu = 0;
        if (hipGetDevice(&dev) != hipSuccess || hipDeviceGetAttribute(&cus, hipDeviceAttributeMultiprocessorCount, dev) != hipSuccess) { grid = -1; return; }
        if (hipFuncSetAttribute((const void*)fwd, hipFuncAttributeMaxDynamicSharedMemorySize, LDS_BYTES) != hipSuccess) { fprintf(stderr, "kernel_launch: hipFuncSetAttribute failed\n"); grid = -1; return; }
        if (hipOccupancyMaxActiveBlocksPerMultiprocessor(&per_cu, (const void*)fwd, NTHREADS, LDS_BYTES) != hipSuccess || per_cu < 1) { fprintf(stderr, "kernel_launch: occupancy query says %d\n", per_cu); }
        (void)hipGetLastError();
        if (cus < 160) { fprintf(stderr, "kernel_launch: needs >= 160 CUs\n"); grid = -1; return; }
        grid = cus;
    }
    if (grid < 0) return;
    if (hipMemsetAsync((char*)d_ws + WS_CTL, 0, CTL_ZERO_BYTES, stream) != hipSuccess) return;
    Args a{};
    for (int i = 0; i < 21; ++i) a.in[i] = (const float*)d_in[i];
    a.out = (float*)d_out; a.ws = (unsigned char*)d_ws;
#if MK_PER_PHASE
    for (int p = 0; p < NPHASE; ++p) { a.ph_lo = p; a.ph_hi = p + 1; hipLaunchKernelGGL(fwd, dim3(grid), dim3(NTHREADS), LDS_BYTES, stream, a); }
#else
    a.ph_lo = 0; a.ph_hi = NPHASE;
    hipLaunchKernelGGL(fwd, dim3(grid), dim3(NTHREADS), LDS_BYTES, stream, a);
#endif
    const hipError_t le = hipPeekAtLastError();
    if (le != hipSuccess) fprintf(stderr, "kernel_launch: launch failed: %s\n", hipGetErrorName(le));
}
```

```cpp
#include <hip/hip_runtime.h>
#include <cstdio>
#include <cstdint>

#ifndef MK_PER_PHASE
#define MK_PER_PHASE 0
#endif

#ifndef MOE_FP8
#define MOE_FP8 1
#endif
#ifndef STAGGER
#define STAGGER 0
#endif
#define STAG(t) (STAGGER ? (t) : 0)
#ifndef PROBE_T
#define PROBE_T 0
#endif
#ifndef PROBE_TQ
#define PROBE_TQ 30.f
#endif
#ifndef ATT_PROBE_TID
#define ATT_PROBE_TID 0
#endif
#ifndef PROBE_BID
#define PROBE_BID 0
#endif
#ifndef PROBE_TPH
#define PROBE_TPH 8
#endif
#ifndef FP8_ATT
#define FP8_ATT 1
#endif
#ifndef FP8_ATT_O
#define FP8_ATT_O 1
#endif
#ifndef FP8_WOUT
#define FP8_WOUT 1
#endif
#ifndef FP8_CONV
#define FP8_CONV 0
#endif
#ifndef X_BF16
#define X_BF16 1
#endif
#ifndef Y_FP8
#define Y_FP8 1
#endif
#ifndef CONV_FUSE_U
#define CONV_FUSE_U 1
#endif
#ifndef ATT_FP8
#define ATT_FP8 1
#endif
#ifndef PHSEL
#define PHSEL 0xffff
#endif
#define PS(k) ((PHSEL >> (k)) & 1)
#ifndef PROBE_REP
#define MOE_XCD_RANGE 1
#define PROBE_REP 0
#endif
#define NREP(k) (1 + ((PROBE_REP >> (k)) & 1))
#ifndef PROBE_NOST
#define PROBE_NOST 0
#endif
#define GAS __attribute__((address_space(1)))
#define LAS __attribute__((address_space(3)))
typedef unsigned short bf16;
typedef short bf16x8 __attribute__((ext_vector_type(8)));
typedef float f32x4 __attribute__((ext_vector_type(4)));
typedef float f32x2 __attribute__((ext_vector_type(2)));
typedef float f32x16 __attribute__((ext_vector_type(16)));
typedef unsigned u32x4 __attribute__((ext_vector_type(4)));
typedef unsigned u32x2 __attribute__((ext_vector_type(2)));
typedef GAS unsigned gu32;

constexpr int D = 1024, NB = 16, SEQ = 2048, CTXL = 256, RPB = SEQ + CTXL, M = NB * RPB, DEPTH = 4;
constexpr int NE = 32, TOPK = 4, NMOD = 6;
constexpr int CAP = M;
constexpr int ACT_ROWS = M * TOPK + NE * 256;
constexpr float EPS = 1e-5f;
constexpr float C2 = 0.125f * 1.4426950408889634f;
constexpr int NPHASE = 2 + 7 * DEPTH;
static_assert(!(FP8_CONV && CONV_FUSE_U), "the fused u epilogue needs the (bf16) interleaved copy of conv_w_in");

constexpr size_t MiB = 1u << 20;
constexpr size_t WS_CTL = 0, CTL_ZERO_BYTES = 1 * MiB;
constexpr size_t WS_MODV = 1 * MiB;
constexpr size_t WS_ROPE = 3 * MiB;
constexpr size_t WS_RW = 4 * MiB;
constexpr size_t WS_MISC = 5 * MiB;
constexpr size_t WS_TOPE = 6 * MiB;
constexpr size_t WS_TOPG = 7 * MiB;
constexpr size_t WS_TOPP = 8 * MiB;
constexpr size_t WS_LIST = 9 * MiB;
constexpr size_t WS_WQKV = 16 * MiB;
constexpr size_t WS_WIN = 28 * MiB;
constexpr size_t WS_WO = 40 * MiB;
constexpr size_t WS_WOUT = 44 * MiB;
constexpr size_t WS_WGU = 48 * MiB;
constexpr size_t WS_WD = 560 * MiB;
constexpr size_t WS_X = 816 * MiB;
constexpr size_t WS_H = 960 * MiB;
constexpr size_t WS_Q = 1032 * MiB;
constexpr size_t WS_K = 1104 * MiB;
constexpr size_t WS_VT = 1176 * MiB;
constexpr size_t WS_BCO = WS_Q;
constexpr size_t WS_O = 1248 * MiB;
constexpr size_t WS_ACT = 1320 * MiB;
constexpr size_t WS_Y = 1624 * MiB;
constexpr size_t WS_H8 = 1928 * MiB;
constexpr size_t WS_END = 1964 * MiB;
static_assert((size_t)M * 3072 * 2 == 216 * MiB && (size_t)ACT_ROWS * 2048 == 304 * MiB && (size_t)M * 4096 == 144 * MiB, "ws map");

constexpr int CW_TMO = 0;
constexpr int CW_BAR = 4096;
constexpr int CW_CNT = 16384;

constexpr int RING_BYTES = 131072;
constexpr int LX = RING_BYTES;
constexpr int LX_MISC = LX + 0;
constexpr int LX_TSTART = LX + 256;
constexpr int LX_ECNT = LX + 512;
constexpr int LX_LCNT = LX + 640;
constexpr int LX_LBASE = LX + 768;
constexpr int LX_TILEE = LX + 1024;
constexpr int LX_WSC = LX + 4096;
constexpr int LX_ASG = LX + 12288;
constexpr int LX_EPI = LX + 16384;
constexpr int LDS_BYTES = LX + 32768;
constexpr int NWAVES = 8, NTHREADS = 512;

#define RLX_AGENT __ATOMIC_RELAXED, __HIP_MEMORY_SCOPE_AGENT
__device__ __forceinline__ unsigned f2bf(float f) { unsigned u = __builtin_bit_cast(unsigned, f); return (u + 0x7fffu + ((u >> 16) & 1u)) >> 16; }
typedef __bf16 bf16x2_t __attribute__((ext_vector_type(2)));
__device__ __forceinline__ unsigned cvt_pk_bf16(float lo, float hi) { const f32x2 v = {lo, hi}; const bf16x2_t b = __builtin_convertvector(v, bf16x2_t); return __builtin_bit_cast(unsigned, b); }
__device__ __forceinline__ float bf2f(unsigned short b) { return __builtin_bit_cast(float, (unsigned)b << 16); }
__device__ __forceinline__ float wave_sum(float v) {
    v += __builtin_bit_cast(float, __builtin_amdgcn_update_dpp(0, __builtin_bit_cast(int, v), 0xB1, 0xF, 0xF, true));
    v += __builtin_bit_cast(float, __builtin_amdgcn_update_dpp(0, __builtin_bit_cast(int, v), 0x4E, 0xF, 0xF, true));
    v += __builtin_bit_cast(float, __builtin_amdgcn_update_dpp(0, __builtin_bit_cast(int, v), 0x124, 0xF, 0xF, true));
    v += __builtin_bit_cast(float, __builtin_amdgcn_update_dpp(0, __builtin_bit_cast(int, v), 0x128, 0xF, 0xF, true));
    v += __shfl_xor(v, 16);
    auto rr = __builtin_amdgcn_permlane32_swap(__float_as_uint(v), __float_as_uint(v), false, false);
    return __uint_as_float(rr[0]) + __uint_as_float(rr[1]);
}

#define XB_TMO      128
#define XB_XCNT(j)  (256  + 64 * (j))
#define XB_XSUB(j)  (1280 + 64 * (j))
#define XB_XGEN(j)  (2304 + 64 * (j))
#define XB_TOP      3328
#define XB_TOPGEN   3392
#define XCD_BAR_WORDS 3456
#define XB_SPIN_CAP (1u << 18)
__device__ __forceinline__ unsigned xb_ld(unsigned* p)              { return __hip_atomic_load(p, __ATOMIC_RELAXED, __HIP_MEMORY_SCOPE_AGENT); }
__device__ __forceinline__ unsigned xb_add(unsigned* p, unsigned v) { return __hip_atomic_fetch_add(p, v, __ATOMIC_RELAXED, __HIP_MEMORY_SCOPE_AGENT); }
__device__ __forceinline__ unsigned xb_xcc_id() { return (unsigned)__builtin_amdgcn_s_getreg((3 << 11) | 20) & 0xFu; }
#define XB_SPIN(cond, bar) do { unsigned _sp = 0; while (cond) { __builtin_amdgcn_s_sleep(1); \
    if ((++_sp & 255u) == 0u) { if (xb_ld(&(bar)[XB_TMO])) break; if (_sp > XB_SPIN_CAP) { atomicAdd(&(bar)[XB_TMO], 1u); break; } } } } while (0)
struct XcdBarrier { unsigned* bar; unsigned x; volatile LAS unsigned* st; };
__device__ __forceinline__ XcdBarrier xcd_barrier_post(unsigned* bar, volatile LAS unsigned* st) {
    XcdBarrier b; b.bar = bar; b.x = xb_xcc_id(); b.st = st;
    if (threadIdx.x == 0) (void)xb_add(&bar[XB_XCNT(b.x)], 1u);
    return b;
}
__device__ __forceinline__ void xcd_barrier_complete(unsigned* bar, unsigned x, unsigned& nloc, unsigned& nx) {
    const unsigned G = gridDim.x * gridDim.y * gridDim.z;
    unsigned sum, cnt, mine, sp = 0u;
    for (;;) {
        sum = 0u; cnt = 0u; mine = 0u;
#pragma unroll
        for (unsigned j = 0; j < 16; ++j) { const unsigned c = xb_ld(&bar[XB_XCNT(j)]); sum += c; cnt += (c > 0u) ? 1u : 0u; mine = (j == x) ? c : mine; }
        if (sum == G) break;
        __builtin_amdgcn_s_sleep(1);
        if ((++sp & 255u) == 0u) { if (xb_ld(&bar[XB_TMO])) break; if (sp > XB_SPIN_CAP) { atomicAdd(&bar[XB_TMO], 1u); break; } }
    }
    nloc = mine > 0u ? mine : 1u; nx = cnt > 0u ? cnt : 1u;
}
__device__ __forceinline__ void xcd_barrier(const XcdBarrier& b) {
    asm volatile("s_waitcnt vmcnt(0)" ::: "memory");
    __syncthreads();
    if (threadIdx.x == 0) {
        unsigned* bar = b.bar; unsigned bx = b.x;
        asm volatile("" : "+s"(bar), "+s"(bx));
        __builtin_amdgcn_s_waitcnt(0);
        unsigned nloc = b.st[0], nx = b.st[1];
        if (nloc == 0u) { xcd_barrier_complete(bar, bx, nloc, nx); b.st[0] = nloc; b.st[1] = nx; }
        const unsigned old = xb_add(&bar[XB_XSUB(bx)], 1u);
        const unsigned gen = old / nloc;
        if (old + 1u == (gen + 1u) * nloc) {
            __builtin_amdgcn_fence(__ATOMIC_RELEASE, "agent");
            asm volatile("s_waitcnt vmcnt(0)" ::: "memory");
            const unsigned og = xb_add(&bar[XB_TOP], 1u);
            const unsigned tg = og / nx;
            if (og + 1u == (tg + 1u) * nx) xb_add(&bar[XB_TOPGEN], 1u);
            else XB_SPIN(xb_ld(&bar[XB_TOPGEN]) == tg, bar);
            __builtin_amdgcn_fence(__ATOMIC_ACQUIRE, "agent");
            xb_add(&bar[XB_XGEN(bx)], 1u);
            asm volatile("s_waitcnt vmcnt(0)" ::: "memory");
        } else {
            XB_SPIN(xb_ld(&bar[XB_XGEN(bx)]) == gen, bar);
            __builtin_amdgcn_fence(__ATOMIC_ACQUIRE, "agent");
            asm volatile("s_waitcnt vmcnt(0)" ::: "memory");
        }
    }
    __syncthreads();
}

namespace pg8 {
constexpr int BM = 256, BK = 64, HALF = 128, HTB = HALF * BK * 2, STAGE_BYTES = 8 * HTB, KD = 1024;
__host__ __device__ __forceinline__ int lds_byte(int r, int c) { const int st = (r >> 4) * 2 + (c >> 5), rr = r & 15, cc = c & 31, ob = rr * 64 + cc * 2; return st * 1024 + (ob ^ (((ob >> 9) & 1) << 5)); }
__host__ __device__ __forceinline__ void stage_rc(int b, int& R, int& C) { const int st = b / 1024, sb = b % 1024, swz = sb ^ (((sb >> 9) & 1) << 5); R = (st >> 1) * 16 + swz / 64; C = (st & 1) * 32 + (swz % 64) / 2; }
__host__ __device__ __forceinline__ int perm32(int rho) { const int n = rho >> 4, i = rho & 15; return 8 * (i >> 2) + 4 * n + (i & 3); }

struct Unit { int pm, pn, e, kind; };
typedef int v8i __attribute__((ext_vector_type(8)));
typedef int v4i __attribute__((ext_vector_type(4)));
__device__ __forceinline__ v8i cat8(bf16x8 lo, bf16x8 hi) { const v4i a = __builtin_bit_cast(v4i, lo), b = __builtin_bit_cast(v4i, hi); return __builtin_shufflevector(a, b, 0, 1, 2, 3, 4, 5, 6, 7); }

__device__ __forceinline__ bool deal(int i, int npu, int ntiles, int& mt, int& r) {
    const int G = gridDim.x, c = blockIdx.x;
    if ((G & 7) == 0) { const int x = c & 7, q = i * (G >> 3) + (c >> 3); mt = (q / npu) * 8 + x; r = q % npu; }
    else { const int L = i * G + c; mt = L / npu; r = L % npu; }
    return mt < ntiles;
}

__device__ __forceinline__ void mfma8(f32x4& acc, const v8i a, const v8i b, int sc) {
    asm volatile("v_mfma_scale_f32_16x16x128_f8f6f4 %0, %1, %2, %0, %3, %3 op_sel_hi:[0,0,0]" : "+v"(acc) : "v"(a), "v"(b), "v"(sc)); }
__device__ __forceinline__ void glds16s(const char* sbase, unsigned voff, unsigned lds_dst) { unsigned keep;
    asm volatile("s_mov_b32 %0, m0\n\ts_mov_b32 m0, %3\n\ts_nop 0\n\tglobal_load_lds_dwordx4 %1, %2\n\ts_mov_b32 m0, %0" : "=&s"(keep) : "v"(voff), "s"(sbase), "s"(lds_dst) : "memory"); }
template <class Epi, class Sched, int PH = 0>
__device__ __forceinline__ void gemm_phase(LAS unsigned char* lds, const Sched& S, const Epi& E, const int tid, const int stagger_ticks = 0) {
    const int wid = __builtin_amdgcn_readfirstlane(tid >> 6), lane = tid & 63, wr = wid >> 2, wc = wid & 3, fr = lane & 15, fq = lane >> 4;
    constexpr int RB = Sched::RB, nt = RB / 128;
    constexpr bool F8 = (RB == 1024);
    unsigned voffB[2];
#pragma unroll
    for (int i = 0; i < 2; ++i) { int R_, C_; stage_rc(tid * 16 + i * 8192, R_, C_); const int Rb = (R_ & ~31) + perm32(R_ & 31); voffB[i] = (unsigned)(Rb * RB + C_ * 2); }
    constexpr bool GA = Sched::GATHER;
    constexpr int NH = GA ? 2 : 1;
    constexpr size_t kstep = (size_t)(BK * 2);
    constexpr size_t hstep = (size_t)HALF * RB, bstep = hstep;
    const unsigned ldsw = (unsigned)wid * 1024u, lds0 = (unsigned)(uintptr_t)lds;
    const int aoff = lds_byte(wr * 64 + fr, fq * 8), boff = lds_byte(wc * 32 + fr, fq * 8);
#define PG8_SA(b, h) (((b) * 2 + (h)) * HTB)
#define PG8_SB(b, h) ((4 + (b) * 2 + (h)) * HTB)
#define PG8_STAGE(bufoff, gbase, voff) do { _Pragma("unroll") for (int _i = 0; _i < 2; ++_i) \
        glds16s((const char*)(gbase), (voff)[_i], (unsigned)__builtin_amdgcn_readfirstlane(lds0 + (unsigned)(bufoff) + ldsw + _i * 8192u)); } while (0)
#define PG8_LDA(dst, b, h) do { _Pragma("unroll") for (int m = 0; m < 4; ++m) _Pragma("unroll") for (int k = 0; k < 2; ++k) dst[m][k] = *(const LAS bf16x8*)(lds + PG8_SA(b, h) + aoff + m * 2048 + k * 1024); } while (0)
#define PG8_LDB(dst, b, h) do { _Pragma("unroll") for (int n = 0; n < 2; ++n) _Pragma("unroll") for (int k = 0; k < 2; ++k) dst[n][k] = *(const LAS bf16x8*)(lds + PG8_SB(b, h) + boff + n * 2048 + k * 1024); } while (0)
#define PG8_MMA(ai, bj, At, Bt) do { __builtin_amdgcn_s_setprio(1); _Pragma("unroll") for (int m = 0; m < 4; ++m) _Pragma("unroll") for (int n = 0; n < 2; ++n) { \
        if constexpr (F8) mfma8(acc[ai][bj][m][n], cat8(Bt[n][0], Bt[n][1]), cat8(At[m][0], At[m][1]), sc8); \
        else { _Pragma("unroll") for (int k = 0; k < 2; ++k) acc[ai][bj][m][n] = __builtin_amdgcn_mfma_f32_16x16x32_bf16(Bt[n][k], At[m][k], acc[ai][bj][m][n], 0, 0, 0); } } __builtin_amdgcn_s_setprio(0); } while (0)
#define PG8_WAIT_V(n) asm volatile("s_waitcnt vmcnt(" #n ")" ::: "memory")
#define PG8_WAIT_VF do { if (fe) { if constexpr (Epi::NST == 16 && !PROBE_NOST) PG8_WAIT_V(24); else if constexpr (Epi::NST == 4 && !PROBE_NOST) PG8_WAIT_V(12); else if constexpr (Epi::NST == 8 && !PROBE_NOST) PG8_WAIT_V(16); else PG8_WAIT_V(8); } else PG8_WAIT_V(8); } while (0)
#define PG8_WAIT_L(n) asm volatile("s_waitcnt lgkmcnt(" #n ")" ::: "memory")
#define PG8_BAR __builtin_amdgcn_s_barrier()
#define PG8_SCHED __builtin_amdgcn_sched_barrier(0)
    Unit cur, nxt; int ui = 0;
    if (!S.next(0, cur)) return;
#define PT_ON(r) (PROBE_T == (r) && PH == PROBE_TPH)
#define PT_BEG(r) do { if (PT_ON(r)) pt0_ = __builtin_amdgcn_s_memtime(); } while (0)
#define PT_END(r) do { if (PT_ON(r)) { const unsigned long long d_ = __builtin_amdgcn_s_memtime() - pt0_; if (blockIdx.x == 0 && tid == 0) *(LAS unsigned long long*)(lds + LX_MISC + 64) += d_; } } while (0)
    unsigned long long pt0_ = 0; (void)pt0_;
    PT_BEG(3);
    if (stagger_ticks > 0 && (int)(blockIdx.x >> 3) >= (int)(gridDim.x >> 4)) { const unsigned long long t0_ = __builtin_amdgcn_s_memrealtime(); while ((long long)(__builtin_amdgcn_s_memrealtime() - t0_) < (long long)stagger_ticks) __builtin_amdgcn_s_sleep(16); }
    static_assert(Sched::SCALE_A == Sched::SCALE_B, "one scale register");
    int sc8 = Sched::SCALE_A; asm volatile("" : "+v"(sc8));
    f32x4 acc[2][2][4][2];
#pragma unroll
    for (int a = 0; a < 2; ++a)
#pragma unroll
        for (int b = 0; b < 2; ++b)
#pragma unroll
            for (int m = 0; m < 4; ++m)
#pragma unroll
                for (int n = 0; n < 2; ++n) acc[a][b][m][n] = (f32x4){0.f, 0.f, 0.f, 0.f};
    bf16x8 At[4][2], B0[2][2], B1[2][2];
    constexpr int NI = GA ? 1 : 2;
    unsigned vC[NH][NI], vN[NH][NI];
    unsigned cb2[2];
#pragma unroll
    for (int i = 0; i < 2; ++i) { int R_, C_; stage_rc(tid * 16 + i * 8192, R_, C_); cb2[i] = (unsigned)(C_ * 2); }
    const unsigned idx_slot = (unsigned)__builtin_amdgcn_readfirstlane((unsigned)(uintptr_t)(lds + LX_WSC) + (unsigned)wid * 1024u);
    if constexpr (GA) { S.idx_dma(cur, lane, idx_slot); asm volatile("s_waitcnt vmcnt(0)" ::: "memory"); S.a_offs_lds(cur, tid, vC, (LAS const int*)(lds + LX_WSC + wid * 1024)); }
    else S.a_offs(cur, tid, vC);
    const unsigned bias_slot0 = (unsigned)(uintptr_t)(lds + LX_ASG);
    if constexpr (Epi::BIAS_DMA) { Unit n1_; const bool h1_ = S.next(1, n1_);
        if (wid == 0) { glds16s((const char*)E.bias_src(cur), (unsigned)lane * 16u, (unsigned)__builtin_amdgcn_readfirstlane(bias_slot0));
            if (h1_) glds16s((const char*)E.bias_src(n1_), (unsigned)lane * 16u, (unsigned)__builtin_amdgcn_readfirstlane(bias_slot0 + 1024u)); } }
    auto acc_init = [&](int slot) {
        if constexpr (Epi::BIAS_DMA) { int fq2 = fq; asm volatile("" : "+v"(fq2)); LAS const float* bl_ = (LAS const float*)(lds + LX_ASG + slot * 1024); f32x4 bv_[2][2];
            _Pragma("unroll") for (int bj = 0; bj < 2; ++bj) { const int col = bj * 128 + wc * 32 + fq2 * 8; bv_[bj][0] = *(const LAS f32x4*)(bl_ + col); bv_[bj][1] = *(const LAS f32x4*)(bl_ + col + 4);
                if constexpr (Epi::BIAS_MUL != 1.f) { bv_[bj][0] *= Epi::BIAS_MUL; bv_[bj][1] *= Epi::BIAS_MUL; }
                if constexpr (Epi::GATE_COLS) { bv_[bj][0][0] *= Epi::GATE_MUL; bv_[bj][0][2] *= Epi::GATE_MUL; bv_[bj][1][0] *= Epi::GATE_MUL; bv_[bj][1][2] *= Epi::GATE_MUL; } }
            _Pragma("unroll") for (int a = 0; a < 2; ++a) _Pragma("unroll") for (int b = 0; b < 2; ++b) _Pragma("unroll") for (int m = 0; m < 4; ++m) _Pragma("unroll") for (int n = 0; n < 2; ++n) acc[a][b][m][n] = bv_[b][n]; }
        else { _Pragma("unroll") for (int a = 0; a < 2; ++a) _Pragma("unroll") for (int b = 0; b < 2; ++b) _Pragma("unroll") for (int m = 0; m < 4; ++m) _Pragma("unroll") for (int n = 0; n < 2; ++n) acc[a][b][m][n] = (f32x4){0.f, 0.f, 0.f, 0.f}; } };
#define PG8_HA(h) (GA ? 0 : (h) * hstep)
#define PG8_VH(v, h) (v)[GA ? (h) : 0]
#define PG8_STAGE_A(bufoff, gbase, vv) do { _Pragma("unroll") for (int _i = 0; _i < 2; ++_i) { unsigned o_; if constexpr (GA) o_ = (((vv)[0] >> (16 * _i)) & 0xffffu) * (unsigned)RB + cb2[_i]; else o_ = (vv)[NI - 2 + _i]; \
        glds16s((const char*)(gbase), o_, (unsigned)__builtin_amdgcn_readfirstlane(lds0 + (unsigned)(bufoff) + ldsw + _i * 8192u)); } } while (0)
    const char* cA = S.a_base(cur); const char* cB = S.b_base(cur);
    PG8_STAGE(PG8_SB(0, 0), cB, voffB); PG8_STAGE(PG8_SB(0, 1), cB + bstep, voffB); PG8_STAGE_A(PG8_SA(0, 0), cA, vC[0]); PG8_STAGE_A(PG8_SA(0, 1), cA + PG8_HA(1), PG8_VH(vC, 1));
    if (wr == 1) PG8_BAR;
    PG8_WAIT_V(2); PG8_BAR;
    PG8_STAGE(PG8_SB(1, 0), cB + kstep, voffB); PG8_STAGE_A(PG8_SA(1, 0), cA + kstep, vC[0]); PG8_STAGE(PG8_SB(1, 1), cB + bstep + kstep, voffB);
    PG8_WAIT_V(6); PG8_BAR;
    if constexpr (Epi::BIAS_DMA) acc_init(0);
    for (;;) {
        const bool has_next = S.next(ui + 1, nxt);
        const char* nA = cA; const char* nB = cB;
#pragma unroll
        for (int h = 0; h < NH; ++h)
#pragma unroll
            for (int i = 0; i < NI; ++i) vN[h][i] = vC[h][i];
        if (has_next) { if constexpr (GA) S.idx_dma(nxt, lane, idx_slot); else S.a_offs(nxt, tid, vN); nA = S.a_base(nxt); nB = S.b_base(nxt); }
        if constexpr (Epi::BIAS_DMA) { if (ui > 0 && has_next && wid == 0) glds16s((const char*)E.bias_src(nxt), (unsigned)lane * 16u, (unsigned)__builtin_amdgcn_readfirstlane(bias_slot0 + (unsigned)((ui + 1) & 1) * 1024u)); }
        PT_BEG(2);
#pragma unroll 1
        for (int t = 0; t < nt; t += 2) {
            const bool last = (t == nt - 2);
            const char* a1 = cA + (size_t)(t + 1) * kstep;
            const char* a2 = last ? nA : cA + (size_t)(t + 2) * kstep; const char* b2 = last ? nB : cB + (size_t)(t + 2) * kstep;
            const char* a3 = a2 + kstep; const char* b3 = b2 + kstep;
            if constexpr (GA) { if (last && has_next) S.a_offs_lds(nxt, tid, vN, (LAS const int*)(lds + LX_WSC + wid * 1024)); }
            unsigned w0[NI], w1[NI];
#pragma unroll
            for (int i = 0; i < NI; ++i) { w0[i] = last ? vN[0][i] : vC[0][i]; w1[i] = last ? PG8_VH(vN, 1)[i] : PG8_VH(vC, 1)[i]; }
            const bool fe = (t == 0) && (ui > 0);
            PG8_LDB(B0, 0, 0); PG8_LDB(B1, 0, 1); PG8_SCHED; PG8_LDA(At, 0, 0); if (!fe) PG8_STAGE_A(PG8_SA(1, 1), a1 + PG8_HA(1), PG8_VH(vC, 1));
            PG8_WAIT_VF; PG8_WAIT_L(0); PG8_BAR; PG8_MMA(0, 0, At, B0); PG8_MMA(0, 1, At, B1); PG8_BAR; PG8_SCHED;
            PG8_LDA(At, 0, 1); PG8_STAGE(PG8_SB(0, 0), b2, voffB); PG8_STAGE(PG8_SB(0, 1), b2 + bstep, voffB); PG8_STAGE_A(PG8_SA(0, 0), a2, w0);
            PG8_WAIT_VF; PG8_WAIT_L(0); PG8_BAR; PG8_MMA(1, 0, At, B0); PG8_MMA(1, 1, At, B1); PG8_BAR; PG8_SCHED;
            PG8_LDB(B0, 1, 0); PG8_LDB(B1, 1, 1); PG8_SCHED; PG8_LDA(At, 1, 0); PG8_STAGE_A(PG8_SA(0, 1), a2 + PG8_HA(1), w1);
            PG8_WAIT_VF; PG8_WAIT_L(0); PG8_BAR; PG8_MMA(0, 0, At, B0); PG8_MMA(0, 1, At, B1); PG8_BAR; PG8_SCHED;
            PG8_LDA(At, 1, 1); PG8_STAGE(PG8_SB(1, 0), b3, voffB); PG8_STAGE(PG8_SB(1, 1), b3 + bstep, voffB); PG8_STAGE_A(PG8_SA(1, 0), a3, w0);
            PG8_WAIT_V(8); PG8_WAIT_L(0); PG8_BAR; PG8_MMA(1, 0, At, B0); PG8_MMA(1, 1, At, B1); PG8_BAR; PG8_SCHED;
        }
        PT_END(2);
        if (has_next) PG8_STAGE_A(PG8_SA(1, 1), nA + kstep + PG8_HA(1), PG8_VH(vN, 1));
        if (wr == 0) PG8_BAR;
        PT_BEG(1);
        if constexpr (Epi::BIAS_DMA) E(acc, cur, wr, wc, fr, fq, (LAS const float*)(lds + LX_ASG + (ui & 1) * 1024)); else E(acc, cur, wr, wc, fr, fq);
        PT_END(1);
        if (!has_next) break;
        acc_init((ui + 1) & 1);
        cur = nxt; cA = nA; cB = nB; ++ui;
#pragma unroll
        for (int h = 0; h < NH; ++h)
#pragma unroll
            for (int i = 0; i < NI; ++i) vC[h][i] = vN[h][i];
        if (wr == 1) PG8_BAR;
    }
    PG8_WAIT_V(0);
    PG8_BAR;
    PT_END(3);
#undef PT_ON
#undef PT_BEG
#undef PT_END
#undef PG8_SA
#undef PG8_HA
#undef PG8_VH
#undef PG8_SB
#undef PG8_STAGE
#undef PG8_STAGE_A
#undef PG8_LDA
#undef PG8_LDB
#undef PG8_MMA
#undef PG8_WAIT_V
#undef PG8_WAIT_VF
#undef PG8_WAIT_L
#undef PG8_BAR
#undef PG8_SCHED
}
}
using pg8::Unit;

__device__ __forceinline__ int tile_row0(int mt, bool lat_only) { return lat_only ? ((mt >> 3) * 9 + 1 + (mt & 7)) * 256 : mt * 256; }

template <int RB_, int SC_> struct SchedQKV {
    static constexpr int RB = RB_, SCALE_A = SC_, SCALE_B = SC_;
    const char* H; const char* Wt;
    __device__ __forceinline__ bool next(int i, Unit& u) const { int mt, r; if (!pg8::deal(i, 12, M / 256, mt, r)) return false;
        if (r < 8) { u.kind = 0; u.pm = mt; u.pn = r; } else { u.kind = 1; u.pm = r - 8; u.pn = mt; } u.e = 0; return true; }
    static constexpr bool GATHER = false;
    __device__ __forceinline__ void a_offs(const Unit& u, int tid, unsigned (&v)[1][2]) const {
#pragma unroll
        for (int i = 0; i < 2; ++i) { int R, C; pg8::stage_rc(tid * 16 + i * 8192, R, C); v[0][i] = (unsigned)((u.pm * 256 + R) * RB + C * 2); } }
    __device__ __forceinline__ const char* a_base(const Unit& u) const { return u.kind == 0 ? H : Wt + (size_t)2048 * RB; }
    __device__ __forceinline__ const char* b_base(const Unit& u) const { return (u.kind == 0 ? Wt : H) + (size_t)u.pn * 256 * RB; }
};
template <int RB_, int SC_> struct SchedPlain {
    static constexpr int RB = RB_, SCALE_A = SC_, SCALE_B = SC_;
    const char* A; const char* Bt; int npu; bool lat_only;
    __device__ __forceinline__ bool next(int i, Unit& u) const { int mt, r; if (!pg8::deal(i, npu, lat_only ? 128 : 144, mt, r)) return false;
        u.pm = tile_row0(mt, lat_only) >> 8; u.pn = r; u.e = 0; u.kind = 0; return true; }
    static constexpr bool GATHER = false;
    __device__ __forceinline__ void a_offs(const Unit& u, int tid, unsigned (&v)[1][2]) const {
#pragma unroll
        for (int i = 0; i < 2; ++i) { int R, C; pg8::stage_rc(tid * 16 + i * 8192, R, C); v[0][i] = (unsigned)((u.pm * 256 + R) * RB + C * 2); } }
    __device__ __forceinline__ const char* a_base(const Unit&) const { return A; }
    __device__ __forceinline__ const char* b_base(const Unit& u) const { return Bt + (size_t)u.pn * 256 * RB; }
};
template <bool GATHER_, int RB_, int SA_, int SB_> struct SchedMoe {
    static constexpr bool GATHER = GATHER_;
    static constexpr int RB = RB_, SCALE_A = SA_, SCALE_B = SB_;
    const char* A; const char* Wt; const int* list; int npu; size_t estride;
    LAS const int* tstart; LAS const int* ecnt; LAS const int* tile_e;
    __device__ __forceinline__ bool mdeal(int i, int ntl, int& mt, int& r) const {
        const int G = gridDim.x, c = blockIdx.x;
        if (MOE_XCD_RANGE && (G & 7) == 0) { const int x = c & 7, q = i * (G >> 3) + (c >> 3); const int lo = (x * ntl) >> 3, hi = ((x + 1) * ntl) >> 3; mt = lo + q / npu; r = q % npu; return mt < hi; }
        return pg8::deal(i, npu, ntl, mt, r); }
    __device__ __forceinline__ bool next(int i, Unit& u) const { int mt, r; const int ntl = __builtin_amdgcn_readfirstlane(tstart[32]);
        int xp = 0;
        if (!mdeal(i, ntl, mt, r)) { if (!(PROBE_REP & (GATHER_ ? 0x100 : 0x200))) return false; int n_i = 0; while (mdeal(n_i, ntl, mt, r)) ++n_i; if (i >= 2 * n_i || !mdeal(i - n_i, ntl, mt, r)) return false; xp = 1; }
        u.pm = mt; u.pn = r; u.e = __builtin_amdgcn_readfirstlane(tile_e[mt]); u.kind = xp; return true; }
    __device__ __forceinline__ void idx_dma(const Unit& u, int lane, unsigned slot) const {
        const int j0 = (u.pm - __builtin_amdgcn_readfirstlane(tstart[u.e])) * 256;
        pg8::glds16s((const char*)(list + (size_t)u.e * CAP + j0), (unsigned)lane * 16u, slot); }
    __device__ __forceinline__ void a_offs_lds(const Unit& u, int tid, unsigned (&v)[2][1], LAS const int* slot) const {
        const int j0 = (u.pm - __builtin_amdgcn_readfirstlane(tstart[u.e])) * 256, cnt = __builtin_amdgcn_readfirstlane(ecnt[u.e]);
#pragma unroll
        for (int h = 0; h < 2; ++h) { unsigned pk = 0;
#pragma unroll
            for (int i = 0; i < 2; ++i) { int R, C; pg8::stage_rc(tid * 16 + i * 8192, R, C); const int r = h * 128 + R; const unsigned tok = (j0 + r) < cnt ? (unsigned)slot[r] : 0u; pk |= tok << (16 * i); }
            v[h][0] = pk; }
    }
    __device__ __forceinline__ void a_offs(const Unit& u, int tid, unsigned (&v)[GATHER_ ? 2 : 1][GATHER_ ? 1 : 2]) const {
        if constexpr (GATHER_) { const int j0 = (u.pm - __builtin_amdgcn_readfirstlane(tstart[u.e])) * 256, cnt = __builtin_amdgcn_readfirstlane(ecnt[u.e]); const int* lp = list + (size_t)u.e * CAP;
#pragma unroll
            for (int h = 0; h < 2; ++h) { unsigned pk = 0;
#pragma unroll
                for (int i = 0; i < 2; ++i) { int R, C; pg8::stage_rc(tid * 16 + i * 8192, R, C); const int idx = j0 + h * 128 + R; const unsigned tok = idx < cnt ? (unsigned)lp[idx] : 0u; pk |= tok << (16 * i); }
                v[h][0] = pk; }
        } else {
#pragma unroll
            for (int i = 0; i < 2; ++i) { int R, C; pg8::stage_rc(tid * 16 + i * 8192, R, C); v[0][i] = (unsigned)((u.pm * 256 + R) * RB + C * 2); } }
    }
    __device__ __forceinline__ const char* a_base(const Unit&) const { return A; }
    __device__ __forceinline__ const char* b_base(const Unit& u) const { return Wt + (size_t)u.e * estride + (size_t)u.pn * 256 * RB; }
};

#define EPI_LOOP_ROWS for (int ai = 0; ai < 2; ++ai) _Pragma("unroll") for (int m = 0; m < 4; ++m)
__device__ __forceinline__ u32x4 pack8(const f32x4& v0, const f32x4& v1) { u32x4 w; w.x = cvt_pk_bf16(v0[0], v0[1]); w.y = cvt_pk_bf16(v0[2], v0[3]); w.z = cvt_pk_bf16(v1[0], v1[1]); w.w = cvt_pk_bf16(v1[2], v1[3]); return w; }

__device__ __forceinline__ float clamp8(float v) { return __builtin_amdgcn_fmed3f(v, -448.f, 448.f); }
__device__ __forceinline__ unsigned pack_fp8x4(float a, float b, float c, float d) {
    const float ca = clamp8(a); int w = __builtin_bit_cast(int, ca);
    w = __builtin_amdgcn_cvt_pk_fp8_f32(ca, clamp8(b), w, false); w = __builtin_amdgcn_cvt_pk_fp8_f32(clamp8(c), clamp8(d), w, true); return (unsigned)w; }
struct EpiQKV {
    static constexpr bool BIAS_DMA = false;
    static constexpr int NST = ATT_FP8 ? 8 : 16;
    bf16* Q; bf16* Kb; bf16* Vt; const float* cosT; const float* sinT; bool dost; LAS unsigned char* stg;
    __device__ __forceinline__ void operator()(const f32x4 (&acc)[2][2][4][2], const Unit& u, int wr, int wc, int fr, int fq) const {
        asm volatile("" : "+v"(fr), "+v"(fq));
        if constexpr (ATT_FP8 != 0) {
            const bool isq = u.pn < 4, k0 = (u.kind == 0); const bool lat = k0 && (u.pm % 9) != 0;
            unsigned char* base8 = (unsigned char*)Q + (k0 ? (isq ? (size_t)0 : WS_K - WS_Q) : WS_VT - WS_Q); const size_t ld = k0 ? 1024 : (size_t)M; const int colbase = k0 ? (u.pn & 3) * 256 : u.pn * 256;
            const float sc = k0 ? (isq ? C2 * 64.f : 16.f) : 16.f;
            LAS unsigned char* sw = stg + (wr * 4 + wc) * 2048; const int lane = fq * 16 + fr; const int jp0 = 16 * (wc & 1) + 4 * fq;
#pragma unroll
            for (int ai = 0; ai < 2; ++ai) {
                f32x4 cs[4], sn[4];
#pragma unroll
                for (int m = 0; m < 4; ++m) { const int row = u.pm * 256 + ai * 128 + wr * 64 + m * 16 + fr; const int t = lat ? (row % RPB) - CTXL : 0;
                    const f32x4 cv = *(const f32x4*)(cosT + t * 32 + jp0), sv = *(const f32x4*)(cosT + 2048 * 32 + t * 32 + jp0);
#pragma unroll
                    for (int j = 0; j < 4; ++j) { cs[m][j] = lat ? cv[j] : 1.f; sn[m][j] = lat ? sv[j] : 0.f; } }
#pragma unroll
                for (int bj = 0; bj < 2; ++bj) {
#pragma unroll
                    for (int m = 0; m < 4; ++m) { const f32x4 a = acc[ai][bj][m][0], b = acc[ai][bj][m][1]; const f32x4 c_ = cs[m], s_ = sn[m];
                        u32x2 w8;
                        w8.x = pack_fp8x4((a[0] * c_[0] - a[1] * s_[0]) * sc, (a[1] * c_[0] + a[0] * s_[0]) * sc, (a[2] * c_[1] - a[3] * s_[1]) * sc, (a[3] * c_[1] + a[2] * s_[1]) * sc);
                        w8.y = pack_fp8x4((b[0] * c_[2] - b[1] * s_[2]) * sc, (b[1] * c_[2] + b[0] * s_[2]) * sc, (b[2] * c_[3] - b[3] * s_[3]) * sc, (b[3] * c_[3] + b[2] * s_[3]) * sc);
                        *(LAS u32x2*)(sw + (16 * m + fr) * 32 + ((fq ^ (((fr >> 2) & 1) << 1)) << 3)) = w8; }
                    asm volatile("s_waitcnt lgkmcnt(0)" ::: "memory");
#pragma unroll
                    for (int k = 0; k < 2; ++k) { const int p = lane + 64 * k, rr = p >> 1, hf = p & 1; const u32x4 v = *(const LAS u32x4*)(sw + rr * 32 + ((hf ^ ((rr >> 2) & 1)) << 4));
                        const int row = u.pm * 256 + ai * 128 + wr * 64 + rr; const int col = colbase + bj * 128 + wc * 32 + hf * 16;
                        if (dost) *(u32x4*)(base8 + (size_t)row * ld + col) = v; }
                    asm volatile("s_waitcnt lgkmcnt(0)" ::: "memory");
                }
            }
        } else if (u.kind == 0) {
            const bool isq = u.pn < 4; bf16* base = isq ? Q : Kb; const float sc = isq ? C2 : 1.f;
            const bool lat = (u.pm % 9) != 0;
#pragma unroll
            EPI_LOOP_ROWS { const int row = u.pm * 256 + ai * 128 + wr * 64 + m * 16 + fr; const int t = (row % RPB) - CTXL;
#pragma unroll
                for (int bj = 0; bj < 2; ++bj) { const f32x4 a = acc[ai][bj][m][0], b = acc[ai][bj][m][1]; f32x4 o0, o1;
                    f32x4 cs = {1.f, 1.f, 1.f, 1.f}, sn = {0.f, 0.f, 0.f, 0.f}; const int jp0 = 16 * (wc & 1) + 4 * fq;
                    if (lat) { cs = *(const f32x4*)(cosT + t * 32 + jp0); sn = *(const f32x4*)(sinT + t * 32 + jp0); }
                    o0[0] = (a[0] * cs[0] - a[1] * sn[0]) * sc; o0[1] = (a[1] * cs[0] + a[0] * sn[0]) * sc; o0[2] = (a[2] * cs[1] - a[3] * sn[1]) * sc; o0[3] = (a[3] * cs[1] + a[2] * sn[1]) * sc;
                    o1[0] = (b[0] * cs[2] - b[1] * sn[2]) * sc; o1[1] = (b[1] * cs[2] + b[0] * sn[2]) * sc; o1[2] = (b[2] * cs[3] - b[3] * sn[3]) * sc; o1[3] = (b[3] * cs[3] + b[2] * sn[3]) * sc;
                    const int col = (u.pn & 3) * 256 + bj * 128 + wc * 32 + fq * 8;
                    if (ATT_FP8) { const float s8 = isq ? 64.f : 16.f; u32x2 w8; w8.x = pack_fp8x4(s8 * o0[0], s8 * o0[1], s8 * o0[2], s8 * o0[3]); w8.y = pack_fp8x4(s8 * o1[0], s8 * o1[1], s8 * o1[2], s8 * o1[3]);
                        if (dost) *(u32x2*)((unsigned char*)base + (size_t)row * 1024 + col) = w8; }
                    else { const u32x4 pk_ = pack8(o0, o1); if (dost) *(u32x4*)(base + (size_t)row * 1024 + col) = pk_; } } }
        } else {
#pragma unroll
            EPI_LOOP_ROWS { const int row = u.pm * 256 + ai * 128 + wr * 64 + m * 16 + fr;
#pragma unroll
                for (int bj = 0; bj < 2; ++bj) { const int col = u.pn * 256 + bj * 128 + wc * 32 + fq * 8;
                    if (ATT_FP8) { const f32x4 a_ = acc[ai][bj][m][0], b_ = acc[ai][bj][m][1]; u32x2 w8; w8.x = pack_fp8x4(16.f * a_[0], 16.f * a_[1], 16.f * a_[2], 16.f * a_[3]); w8.y = pack_fp8x4(16.f * b_[0], 16.f * b_[1], 16.f * b_[2], 16.f * b_[3]);
                        if (dost) *(u32x2*)((unsigned char*)Vt + (size_t)row * M + col) = w8; }
                    else { const u32x4 pk_ = pack8(acc[ai][bj][m][0], acc[ai][bj][m][1]); if (dost) *(u32x4*)(Vt + (size_t)row * M + col) = pk_; } } }
        }
    }
};
struct EpiPlain {
    static constexpr bool BIAS_DMA = false;
    static constexpr int NST = 16;
    bf16* O; int ldc;
    __device__ __forceinline__ void operator()(const f32x4 (&acc)[2][2][4][2], const Unit& u, int wr, int wc, int fr, int fq) const {
        asm volatile("" : "+v"(fr), "+v"(fq));
#pragma unroll
        EPI_LOOP_ROWS { const int row = u.pm * 256 + ai * 128 + wr * 64 + m * 16 + fr;
#pragma unroll
            for (int bj = 0; bj < 2; ++bj) { const int col = u.pn * 256 + bj * 128 + wc * 32 + fq * 8;
                *(u32x4*)(O + (size_t)row * ldc + col) = pack8(acc[ai][bj][m][0], acc[ai][bj][m][1]); } }
    }
};
struct EpiConvIn {
    static constexpr bool BIAS_DMA = false;
    static constexpr int NST = 16;
    bf16* Bb; bf16* Ub;
    __device__ __forceinline__ void operator()(const f32x4 (&acc)[2][2][4][2], const Unit& u, int wr, int wc, int fr, int fq) const {
        asm volatile("" : "+v"(fr), "+v"(fq));
        if (u.pn < 4) {
#pragma unroll
            EPI_LOOP_ROWS { const int row = u.pm * 256 + ai * 128 + wr * 64 + m * 16 + fr;
#pragma unroll
                for (int bj = 0; bj < 2; ++bj) { const int col = u.pn * 256 + bj * 128 + wc * 32 + fq * 8;
                    *(u32x4*)(Bb + (size_t)row * 1024 + col) = pack8(acc[ai][bj][m][0], acc[ai][bj][m][1]); } }
        } else {
#pragma unroll
            EPI_LOOP_ROWS { const int row = u.pm * 256 + ai * 128 + wr * 64 + m * 16 + fr;
#pragma unroll
                for (int bj = 0; bj < 2; ++bj) { const f32x4 a = acc[ai][bj][m][0], b = acc[ai][bj][m][1]; const int col = (u.pn - 4) * 128 + bj * 64 + wc * 16 + fq * 4;
                    u32x2 w; w.x = cvt_pk_bf16(a[0] * a[1], a[2] * a[3]); w.y = cvt_pk_bf16(b[0] * b[1], b[2] * b[3]);
                    *(u32x2*)(Ub + (size_t)row * 1024 + col) = w; } }
        }
    }
};
struct EpiResid {
    static constexpr bool BIAS_DMA = false;
    static constexpr int NST = X_BF16 ? 16 : 0;
    const void* Xin; void* X; const float* gate;
    const float* in_x; const float* in_ctx;
    __device__ __forceinline__ void operator()(const f32x4 (&acc)[2][2][4][2], const Unit& u, int wr, int wc, int fr, int fq) const {
        asm volatile("" : "+v"(fr), "+v"(fq));
        const int rb = (u.pm % 9) == 0 ? 16 : u.pm / 9; const float* gp = gate + rb * 6144;
        f32x4 gv[2][2];
#pragma unroll
        for (int bj = 0; bj < 2; ++bj) { const int col = u.pn * 256 + bj * 128 + wc * 32 + fq * 8; gv[bj][0] = *(const f32x4*)(gp + col); gv[bj][1] = *(const f32x4*)(gp + col + 4); }
        if (X_BF16 && !in_x) {
#pragma unroll
            for (int ai = 0; ai < 2; ++ai) { u32x4 xw[4][2];
#pragma unroll
                for (int m = 0; m < 4; ++m)
#pragma unroll
                    for (int bj = 0; bj < 2; ++bj) xw[m][bj] = *(const u32x4*)((const bf16*)Xin + (size_t)(u.pm * 256 + ai * 128 + wr * 64 + m * 16 + fr) * 1024 + u.pn * 256 + bj * 128 + wc * 32 + fq * 8);
#pragma unroll
                for (int m = 0; m < 4; ++m)
#pragma unroll
                    for (int bj = 0; bj < 2; ++bj) { const u32x4 w = xw[m][bj];
                        const f32x4 x0 = {bf2f((unsigned short)(w.x & 0xffffu)), bf2f((unsigned short)(w.x >> 16)), bf2f((unsigned short)(w.y & 0xffffu)), bf2f((unsigned short)(w.y >> 16))};
                        const f32x4 x1 = {bf2f((unsigned short)(w.z & 0xffffu)), bf2f((unsigned short)(w.z >> 16)), bf2f((unsigned short)(w.w & 0xffffu)), bf2f((unsigned short)(w.w >> 16))};
                        *(u32x4*)((bf16*)X + (size_t)(u.pm * 256 + ai * 128 + wr * 64 + m * 16 + fr) * 1024 + u.pn * 256 + bj * 128 + wc * 32 + fq * 8) = pack8(x0 + gv[bj][0] * acc[ai][bj][m][0], x1 + gv[bj][1] * acc[ai][bj][m][1]); } }
        } else {
#pragma unroll
            EPI_LOOP_ROWS { const int row = u.pm * 256 + ai * 128 + wr * 64 + m * 16 + fr;
#pragma unroll
                for (int bj = 0; bj < 2; ++bj) { const int col = u.pn * 256 + bj * 128 + wc * 32 + fq * 8; const size_t o = (size_t)row * 1024 + col;
                    const float* xs = (const float*)Xin + o;
                    if (in_x) { const int b_ = u.pm / 9, jt_ = u.pm % 9; const size_t ro = (size_t)(row - u.pm * 256) * 1024 + col;
                        xs = jt_ == 0 ? in_ctx + (size_t)b_ * CTXL * 1024 + ro : in_x + ((size_t)b_ * SEQ + (jt_ - 1) * 256) * 1024 + ro; }
                    const f32x4 x0 = *(const f32x4*)(xs), x1 = *(const f32x4*)(xs + 4);
                    const f32x4 r0 = x0 + gv[bj][0] * acc[ai][bj][m][0], r1 = x1 + gv[bj][1] * acc[ai][bj][m][1];
                    if (X_BF16) *(u32x4*)((bf16*)X + o) = pack8(r0, r1);
                    else { *(f32x4*)((float*)X + o) = r0; *(f32x4*)((float*)X + o + 4) = r1; } } }
        }
    }
};
__device__ __forceinline__ float swiglu1(float g, float l) {
    g = fminf(g, 7.f); l = fminf(fmaxf(l, -7.f), 7.f);
    const float s = __builtin_amdgcn_rcpf(1.f + __builtin_amdgcn_exp2f(-1.702f * 1.4426950408889634f * g));
    return g * s * (l + 1.f);
}
constexpr float GATE_PRE = -1.702f * 1.4426950408889634f;
__device__ __forceinline__ float swiglu4(float t, float l) {
    t = __builtin_amdgcn_fmed3f(t, 7.f * GATE_PRE, 3.0e38f); l = __builtin_amdgcn_fmed3f(l, -7.f, 7.f);
    const float r = __builtin_amdgcn_rcpf(1.f + __builtin_amdgcn_exp2f(t));
    return (t * r) * __builtin_fmaf(l, 4.f / GATE_PRE, 4.f / GATE_PRE);
}
template <bool F8> struct EpiSwiglu {
    static constexpr bool BIAS_DMA = true, GATE_COLS = F8; static constexpr float GATE_MUL = -1.702f * 1.4426950408889634f, BIAS_MUL = 1.f;
    static constexpr int NST = F8 ? 4 : 16;
    bf16* ACT; const float* bgu; LAS unsigned char* stg;
    __device__ __forceinline__ const float* bias_src(const Unit& u) const { return bgu + u.e * 2048 + u.pn * 256; }
    __device__ __forceinline__ void operator()(const f32x4 (&acc)[2][2][4][2], const Unit& u, int wr, int wc, int fr, int fq, LAS const float* bl) const {
        asm volatile("" : "+v"(fr), "+v"(fq));
        (void)bl;
        if constexpr (F8) {
            LAS unsigned* sw = (LAS unsigned*)(stg + (wr * 4 + wc) * 2048); const int lane = fq * 16 + fr;
#pragma unroll
            for (int ai = 0; ai < 2; ++ai) {
#pragma unroll
                for (int m = 0; m < 4; ++m)
#pragma unroll
                    for (int bj = 0; bj < 2; ++bj) { const f32x4 a = acc[ai][bj][m][0], b = acc[ai][bj][m][1];
                        const float s0_ = swiglu4(a[0], a[1]); int w = __builtin_bit_cast(int, s0_);
                        w = __builtin_amdgcn_cvt_pk_fp8_f32(s0_, swiglu4(a[2], a[3]), w, false); w = __builtin_amdgcn_cvt_pk_fp8_f32(swiglu4(b[0], b[1]), swiglu4(b[2], b[3]), w, true);
                        sw[((16 * m + fr) * 2 + (bj ^ ((fr >> 2) & 1))) * 4 + fq] = (unsigned)w; }
                asm volatile("s_waitcnt lgkmcnt(0)" ::: "memory");
#pragma unroll
                for (int k = 0; k < 2; ++k) { const int p = lane + 64 * k, rr = p >> 1, bj = p & 1; const u32x4 v = *(const LAS u32x4*)(sw + (rr * 2 + (bj ^ ((rr >> 2) & 1))) * 4);
                    const int row = u.pm * 256 + ai * 128 + wr * 64 + rr; const int col = u.pn * 128 + bj * 64 + wc * 16;
                    if (!(PROBE_NOST && u.kind)) *(u32x4*)((unsigned char*)ACT + (size_t)row * 1024 + col) = v; }
                asm volatile("s_waitcnt lgkmcnt(0)" ::: "memory");
            }
        } else {
#pragma unroll
            EPI_LOOP_ROWS { const int row = u.pm * 256 + ai * 128 + wr * 64 + m * 16 + fr;
#pragma unroll
                for (int bj = 0; bj < 2; ++bj) { const f32x4 a = acc[ai][bj][m][0], b = acc[ai][bj][m][1];
                    const int col = u.pn * 128 + bj * 64 + wc * 16 + fq * 4;
                    u32x2 w; w.x = cvt_pk_bf16(swiglu1(a[0], a[1]), swiglu1(a[2], a[3])); w.y = cvt_pk_bf16(swiglu1(b[0], b[1]), swiglu1(b[2], b[3]));
                    *(u32x2*)(ACT + (size_t)row * 1024 + col) = w; } }
        }
    }
};
struct EpiDown {
    static constexpr bool BIAS_DMA = true, GATE_COLS = false; static constexpr float GATE_MUL = 1.f, BIAS_MUL = Y_FP8 ? 16.f : 1.f;
    static constexpr int NST = Y_FP8 ? 8 : 16;
    bf16* Y; const float* bd; LAS unsigned char* stg;
    __device__ __forceinline__ const float* bias_src(const Unit& u) const { return bd + u.e * 1024 + u.pn * 256; }
    __device__ __forceinline__ void operator()(const f32x4 (&acc)[2][2][4][2], const Unit& u, int wr, int wc, int fr, int fq, LAS const float* bl) const {
        asm volatile("" : "+v"(fr), "+v"(fq));
        (void)bl;
        if constexpr (Y_FP8 != 0) {
            LAS unsigned char* sw = stg + (wr * 4 + wc) * 2048; const int lane = fq * 16 + fr;
#pragma unroll
            for (int ai = 0; ai < 2; ++ai)
#pragma unroll
                for (int bj = 0; bj < 2; ++bj) {
#pragma unroll
                    for (int m = 0; m < 4; ++m) { const f32x4 y0 = acc[ai][bj][m][0], y1 = acc[ai][bj][m][1];
                        u32x2 w; w.x = pack_fp8x4(y0[0], y0[1], y0[2], y0[3]); w.y = pack_fp8x4(y1[0], y1[1], y1[2], y1[3]);
                        *(LAS u32x2*)(sw + (16 * m + fr) * 32 + ((fq ^ (((fr >> 2) & 1) << 1)) << 3)) = w; }
                    asm volatile("s_waitcnt lgkmcnt(0)" ::: "memory");
#pragma unroll
                    for (int k = 0; k < 2; ++k) { const int p = lane + 64 * k, rr = p >> 1, hf = p & 1; const u32x4 v = *(const LAS u32x4*)(sw + rr * 32 + ((hf ^ ((rr >> 2) & 1)) << 4));
                        const int row = u.pm * 256 + ai * 128 + wr * 64 + rr; const int col = u.pn * 256 + bj * 128 + wc * 32 + hf * 16;
                        if (!(PROBE_NOST && u.kind)) *(u32x4*)((unsigned char*)Y + (size_t)row * 1024 + col) = v; }
                    asm volatile("s_waitcnt lgkmcnt(0)" ::: "memory");
                }
        } else {
#pragma unroll
            EPI_LOOP_ROWS { const int row = u.pm * 256 + ai * 128 + wr * 64 + m * 16 + fr;
#pragma unroll
                for (int bj = 0; bj < 2; ++bj) { const int col = u.pn * 256 + bj * 128 + wc * 32 + fq * 8;
                    const u32x4 pk_ = pack8(acc[ai][bj][m][0], acc[ai][bj][m][1]); if (!(PROBE_NOST && u.kind)) *(u32x4*)(Y + (size_t)row * 1024 + col) = pk_; } }
        }
    }
};

namespace att {
constexpr int SLOT = 32768, VOFF = 16384;
__device__ __forceinline__ void glds16(const void* gsrc, unsigned lds_dst) { unsigned keep;
    asm volatile("s_mov_b32 %0, m0\n\ts_mov_b32 m0, %2\n\ts_nop 0\n\tglobal_load_lds_dwordx4 %1, off\n\ts_mov_b32 m0, %0" : "=&s"(keep) : "v"(gsrc), "s"(lds_dst) : "memory"); }
#define ATT_WAIT_BAR(N) asm volatile("s_waitcnt vmcnt(" #N ") lgkmcnt(0)\n\ts_barrier" ::: "memory")
__device__ __forceinline__ float half_swap_max(float m) { auto rr = __builtin_amdgcn_permlane32_swap(__float_as_uint(m), __float_as_uint(m), false, false); return fmaxf(__uint_as_float(rr[0]), __uint_as_float(rr[1])); }
__device__ __forceinline__ float half_swap_sum(float m) { auto rr = __builtin_amdgcn_permlane32_swap(__float_as_uint(m), __float_as_uint(m), false, false); return __uint_as_float(rr[0]) + __uint_as_float(rr[1]); }
__device__ __forceinline__ int crow(int r, int hi) { return (r & 3) + 8 * (r >> 2) + 4 * hi; }
__device__ __forceinline__ float max3f(float a, float b, float c) { float r; asm("v_max3_f32 %0, %1, %2, %3" : "=v"(r) : "v"(a), "v"(b), "v"(c)); return r; }

__device__ __forceinline__ void attn_unit(LAS unsigned char* lds, LAS float* wsc  , const bf16* Q, const bf16* Kb, const bf16* Vt, bf16* O,
                                          int krow0, int h, int qrow0, int NT, float lam, float osc, const float* subg, const int tid) {
    const int lane = tid & 63, r32 = lane & 31, hi = lane >> 5; const int wid = __builtin_amdgcn_readfirstlane(tid >> 6);
    const int qg = wid >> 1, c = wid & 1;
    const unsigned lds0 = (unsigned)(uintptr_t)lds;
    const bf16* ksrc[2]; const bf16* vsrc[2];
#pragma unroll
    for (int i = 0; i < 2; ++i) { const int p = 2 * wid + i;
        { const int row = 4 * p + (lane >> 4), ch = (lane & 15) ^ (row & 15); ksrc[i] = Kb + (size_t)(krow0 + row) * 1024 + h * 128 + ch * 8; }
        { const int row = 8 * p + (lane >> 3), ch = (lane & 7) ^ ((row >> 1) & 7); vsrc[i] = Vt + (size_t)(h * 128 + row) * M + krow0 + ch * 8; } }
    const unsigned kdst = lds0 + (unsigned)wid * 2048u, vdst = lds0 + VOFF + (unsigned)wid * 2048u;
#define ATT_DMA(t, slot) do { const unsigned so_ = (unsigned)(slot) * SLOT; \
        glds16(ksrc[0] + (size_t)(t) * 64 * 1024, (unsigned)__builtin_amdgcn_readfirstlane(kdst + so_)); glds16(ksrc[1] + (size_t)(t) * 64 * 1024, (unsigned)__builtin_amdgcn_readfirstlane(kdst + so_ + 1024u)); \
        glds16(vsrc[0] + (size_t)(t) * 64, (unsigned)__builtin_amdgcn_readfirstlane(vdst + so_)); glds16(vsrc[1] + (size_t)(t) * 64, (unsigned)__builtin_amdgcn_readfirstlane(vdst + so_ + 1024u)); } while (0)
    const int key0 = (r32 & 0x13) | ((r32 & 4) << 1) | ((r32 & 8) >> 1);
    const int kx = key0 & 15, vx = (r32 >> 1) & 7;
    bf16x8 qf[4];
    { const bf16* qp = Q + (size_t)(qrow0 + qg * 32 + r32) * 1024 + h * 128 + c * 64 + hi * 8;
#pragma unroll
      for (int d0 = 0; d0 < 4; ++d0) qf[d0] = *(const bf16x8*)(qp + d0 * 16); }
    float sg[4];
#pragma unroll
    for (int d0 = 0; d0 < 4; ++d0) sg[d0] = subg[d0 * 32 + r32] * osc;
    f32x16 o[4];
#pragma unroll
    for (int d0 = 0; d0 < 4; ++d0) o[d0] = f32x16{};
    float mref = 0.f, lsum = 0.f; f32x16 negm = f32x16{};
    asm volatile("s_waitcnt vmcnt(0)" ::: "memory");
#define AT_BEG(r) do { if (PROBE_T == (r)) at0_ = __builtin_amdgcn_s_memtime(); } while (0)
#define AT_END(r) do { if (PROBE_T == (r)) { const unsigned long long d_ = __builtin_amdgcn_s_memtime() - at0_; if (blockIdx.x == 0 && tid == ATT_PROBE_TID) *(LAS unsigned long long*)(lds + LX_MISC + 64) += d_; } } while (0)
    unsigned long long at0_ = 0; (void)at0_;
    AT_BEG(7);
    AT_BEG(13);
    ATT_DMA(0, 0);
    if (NT > 1) ATT_DMA(1, 1);
    for (int t = 0; t < NT; ++t) {
        const int slot = t & 3;
        AT_BEG(4);
        if (t + 1 < NT) { ATT_WAIT_BAR(4); } else { ATT_WAIT_BAR(0); }
        AT_END(4);
        if (t == 0) AT_END(13);
        if (t + 2 < NT) ATT_DMA(t + 2, (t + 2) & 3);
        AT_BEG(5);
        const LAS unsigned char* kb_ = lds + slot * SLOT; const LAS unsigned char* vb_ = kb_ + VOFF;
        f32x16 s0, s1;
        bf16x8 kf[8];
#pragma unroll
        for (int d0 = 0; d0 < 4; ++d0) { const int ch = (c * 8 + d0 * 2 + hi) ^ kx;
            kf[d0] = *(const LAS bf16x8*)(kb_ + key0 * 256 + ch * 16); kf[4 + d0] = *(const LAS bf16x8*)(kb_ + (key0 + 32) * 256 + ch * 16); }
        bf16x8 vA[8], vB[8];
#pragma unroll
        for (int ks = 0; ks < 2; ++ks) { const int ch = (2 * ks + hi) ^ vx;
#pragma unroll
            for (int d0 = 0; d0 < 4; ++d0) vA[ks * 4 + d0] = *(const LAS bf16x8*)(vb_ + (d0 * 32 + r32) * 128 + ch * 16); }
#pragma unroll
        for (int d0 = 0; d0 < 4; ++d0) s0 = __builtin_amdgcn_mfma_f32_32x32x16_bf16(kf[d0], qf[d0], d0 == 0 ? negm : s0, 0, 0, 0);
#pragma unroll
        for (int d0 = 0; d0 < 4; ++d0) s1 = __builtin_amdgcn_mfma_f32_32x32x16_bf16(kf[4 + d0], qf[d0], d0 == 0 ? negm : s1, 0, 0, 0);
        float rm = s0[0];
#pragma unroll
        for (int r = 1; r < 16; ++r) rm = fmaxf(rm, s0[r]);
        float sa = 0.f;
#pragma unroll
        for (int r = 0; r < 16; ++r) { s0[r] = __builtin_amdgcn_exp2f(s0[r]); sa += s0[r]; }
        bf16x8 pa[4];
#pragma unroll
        for (int s = 0; s < 2; ++s) { u32x4 w0;
            w0.x = cvt_pk_bf16(s0[8 * s + 0], s0[8 * s + 1]); w0.y = cvt_pk_bf16(s0[8 * s + 2], s0[8 * s + 3]); w0.z = cvt_pk_bf16(s0[8 * s + 4], s0[8 * s + 5]); w0.w = cvt_pk_bf16(s0[8 * s + 6], s0[8 * s + 7]);
            pa[s] = __builtin_bit_cast(bf16x8, w0); }
#pragma unroll
        for (int ks = 2; ks < 4; ++ks) { const int ch = (2 * ks + hi) ^ vx;
#pragma unroll
            for (int d0 = 0; d0 < 4; ++d0) vB[(ks - 2) * 4 + d0] = *(const LAS bf16x8*)(vb_ + (d0 * 32 + r32) * 128 + ch * 16); }
#pragma unroll
        for (int ks = 0; ks < 2; ++ks)
#pragma unroll
            for (int d0 = 0; d0 < 4; ++d0) o[d0] = __builtin_amdgcn_mfma_f32_32x32x16_bf16(pa[ks], vA[ks * 4 + d0], o[d0], 0, 0, 0);
#pragma unroll
        for (int r = 0; r < 16; ++r) rm = fmaxf(rm, s1[r]);
#pragma unroll
        for (int r = 0; r < 16; ++r) { s1[r] = __builtin_amdgcn_exp2f(s1[r]); sa += s1[r]; }
        lsum += sa;
#pragma unroll
        for (int s = 0; s < 2; ++s) { u32x4 w1;
            w1.x = cvt_pk_bf16(s1[8 * s + 0], s1[8 * s + 1]); w1.y = cvt_pk_bf16(s1[8 * s + 2], s1[8 * s + 3]); w1.z = cvt_pk_bf16(s1[8 * s + 4], s1[8 * s + 5]); w1.w = cvt_pk_bf16(s1[8 * s + 6], s1[8 * s + 7]);
            pa[2 + s] = __builtin_bit_cast(bf16x8, w1); }
#pragma unroll
        for (int ks = 2; ks < 4; ++ks)
#pragma unroll
            for (int d0 = 0; d0 < 4; ++d0) o[d0] = __builtin_amdgcn_mfma_f32_32x32x16_bf16(pa[ks], vB[(ks - 2) * 4 + d0], o[d0], 0, 0, 0);
        AT_END(5);
        rm = half_swap_max(rm);
        const bool need = (t == 0) || (rm > 8.f);
        if (__any(need)) {
            const float dl = need ? rm : 0.f; mref += dl;
#pragma unroll
            for (int r = 0; r < 16; ++r) negm[r] = -mref;
            const float f = __builtin_amdgcn_exp2f(-dl); lsum *= f;
            if (hi == 0) wsc[r32] = f;
            asm volatile("s_waitcnt lgkmcnt(0)" ::: "memory");
#pragma unroll
            for (int r = 0; r < 16; ++r) { const float fr_ = wsc[crow(r, hi)];
#pragma unroll
                for (int d0 = 0; d0 < 4; ++d0) o[d0][r] *= fr_; }
            asm volatile("s_waitcnt lgkmcnt(0)" ::: "memory");
        }
    }
    AT_BEG(14);
    const float lt = half_swap_sum(lsum);
    if (hi == 0) wsc[64 + r32] = (c ? -lam : 1.f) * __builtin_amdgcn_rcpf(lt);
    asm volatile("s_waitcnt lgkmcnt(0)\n\ts_barrier" ::: "memory");
    LAS float* xch = (LAS float*)(lds + qg * 16384);
#pragma unroll
    for (int r = 0; r < 16; ++r) { const float a = wsc[64 + crow(r, hi)];
#pragma unroll
        for (int d0 = 0; d0 < 4; ++d0) o[d0][r] *= a; }
    if (c == 1) {
#pragma unroll
        for (int d0 = 0; d0 < 4; ++d0)
#pragma unroll
            for (int r = 0; r < 16; ++r) xch[(d0 * 16 + r) * 64 + lane] = o[d0][r];
    }
    asm volatile("s_waitcnt lgkmcnt(0)\n\ts_barrier" ::: "memory");
    if (c == 0) {
        constexpr int OB = FP8_ATT_O ? 1 : 2;
        LAS unsigned char* stg = lds + 65536 + qg * 8192;
#pragma unroll
        for (int d0 = 0; d0 < 4; ++d0)
#pragma unroll
            for (int r = 0; r < 16; ++r) o[d0][r] += xch[(d0 * 16 + r) * 64 + lane];
        float ss[16], tt[16];
#pragma unroll
        for (int r = 0; r < 16; ++r) { float x = (o[0][r] * o[0][r] + o[1][r] * o[1][r]) + (o[2][r] * o[2][r] + o[3][r] * o[3][r]);
            x += __builtin_bit_cast(float, __builtin_amdgcn_update_dpp(0, __builtin_bit_cast(int, x), 0xB1, 0xF, 0xF, true));
            x += __builtin_bit_cast(float, __builtin_amdgcn_update_dpp(0, __builtin_bit_cast(int, x), 0x4E, 0xF, 0xF, true));
            x += __builtin_bit_cast(float, __builtin_amdgcn_update_dpp(0, __builtin_bit_cast(int, x), 0x124, 0xF, 0xF, true));
            x += __builtin_bit_cast(float, __builtin_amdgcn_update_dpp(0, __builtin_bit_cast(int, x), 0x128, 0xF, 0xF, true));
            ss[r] = x; }
#pragma unroll
        for (int r = 0; r < 16; ++r) tt[r] = __shfl_xor(ss[r], 16);
#pragma unroll
        for (int r = 0; r < 16; ++r) { const int qr = crow(r, hi); const float rn = __builtin_amdgcn_rsqf((ss[r] + tt[r]) * (1.f / 128.f) + EPS);
#pragma unroll
            for (int d0 = 0; d0 < 4; ++d0) { const float ov = o[d0][r] * rn * sg[d0];
                if (FP8_ATT_O) { const float o4 = clamp8(4.f * ov); *(LAS unsigned char*)(stg + qr * 128 + d0 * 32 + r32) = (unsigned char)(__builtin_amdgcn_cvt_pk_fp8_f32(o4, o4, 0, false) & 0xff); }
                else *(LAS unsigned short*)(stg + (qr * 128 + d0 * 32 + r32) * 2) = (unsigned short)f2bf(ov); } }
        asm volatile("s_waitcnt lgkmcnt(0)" ::: "memory");
        unsigned char* Ob = (unsigned char*)O + ((size_t)(qrow0 + qg * 32) * 1024 + h * 128) * OB;
#pragma unroll
        for (int k = 0; k < 4 * OB; ++k) { const int off = lane * 16 + 1024 * k, row = off / (128 * OB), cb = off % (128 * OB);
            *(u32x4*)(Ob + (size_t)row * 1024 * OB + cb) = *(const LAS u32x4*)(stg + off); }
    }
    asm volatile("s_waitcnt lgkmcnt(0)\n\ts_barrier" ::: "memory");
    AT_END(7);
    AT_END(14);
#undef AT_BEG
#undef AT_END
#undef ATT_DMA
}

typedef int v8i __attribute__((ext_vector_type(8)));
typedef int v4i_ __attribute__((ext_vector_type(4)));
__device__ __forceinline__ v8i cat16(u32x4 lo, u32x4 hi2) { const v4i_ a = __builtin_bit_cast(v4i_, lo), b = __builtin_bit_cast(v4i_, hi2); return __builtin_shufflevector(a, b, 0, 1, 2, 3, 4, 5, 6, 7); }
constexpr float ATT_TGT = 2.f;
__device__ __forceinline__ void attn_unit8(LAS unsigned char* lds, LAS float* wsc, const unsigned char* Q8, const unsigned char* K8, const unsigned char* V8t, bf16* O,
                                           int krow0, int h, int qrow0, int NT, float lam, float osc, const float* subg, const int tid, const int par, const bool pre, const int nkrow0, const int nh) {
    static_assert(FP8_ATT_O != 0, "the output staging area (LX_EPI) holds fp8 rows");
    constexpr int SL = 16384, VO = 8192;
    const int lane = tid & 63, r32 = lane & 31, hi = lane >> 5; const int wid = __builtin_amdgcn_readfirstlane(tid >> 6);
    const int qg = wid >> 1, c = wid & 1;
    const unsigned lds0 = (unsigned)(uintptr_t)lds;
    unsigned ksrc, vsrc;
    { const int key = 8 * wid + (lane >> 3), ch = (lane & 7) ^ ((key >> 1) & 7); ksrc = (unsigned)((krow0 + key) * 1024 + h * 128 + ch * 16); }
    { const int dv = 16 * wid + (lane >> 2), ch = (lane & 3) ^ ((dv >> 2) & 3); vsrc = (unsigned)((h * 128 + dv) * M + krow0 + ch * 16); }
    const unsigned kdst = lds0 + (unsigned)wid * 1024u, vdst = lds0 + VO + (unsigned)wid * 1024u;
#define ATT_DMA8(t, slot) do { const unsigned so_ = (unsigned)(slot) * SL; \
        pg8::glds16s((const char*)K8, ksrc + (unsigned)(t) * 65536u, (unsigned)__builtin_amdgcn_readfirstlane(kdst + so_)); pg8::glds16s((const char*)V8t, vsrc + (unsigned)(t) * 64u, (unsigned)__builtin_amdgcn_readfirstlane(vdst + so_)); } while (0)
#define ATT_DMA8_NEXT(pb) do { if (nkrow0 >= 0) { const unsigned nks_ = ksrc + (unsigned)((nkrow0 - krow0) * 1024 + (nh - h) * 128); const unsigned nvs_ = vsrc + (unsigned)((nh - h) * 128 * M + (nkrow0 - krow0)); \
        _Pragma("unroll") for (int j_ = 0; j_ < 4; ++j_) { const unsigned so_ = (unsigned)((pb) * 4 + j_) * SL; \
            pg8::glds16s((const char*)K8, nks_ + (unsigned)j_ * 65536u, (unsigned)__builtin_amdgcn_readfirstlane(kdst + so_)); pg8::glds16s((const char*)V8t, nvs_ + (unsigned)j_ * 64u, (unsigned)__builtin_amdgcn_readfirstlane(vdst + so_)); } } } while (0)
    const int key0 = 32 * ((r32 >> 2) & 1) + (r32 & 3) + 4 * (r32 >> 3);
    const int kx = (key0 >> 1) & 7, vx = (r32 >> 2) & 3;
    const int kc0 = ((c * 4 + 2 * hi) ^ kx) * 16, kc1 = ((c * 4 + 2 * hi + 1) ^ kx) * 16;
    const int vc0 = ((2 * hi) ^ vx) * 16, vc1 = ((2 * hi + 1) ^ vx) * 16;
    v8i qf;
    { const unsigned char* qp = Q8 + (size_t)(qrow0 + qg * 32 + r32) * 1024 + h * 128 + c * 64 + hi * 32;
      qf = cat16(*(const u32x4*)qp, *(const u32x4*)(qp + 16)); }
    (void)subg; (void)osc;
    f32x16 o[4];
#pragma unroll
    for (int d0 = 0; d0 < 4; ++d0) o[d0] = f32x16{};
    float mref = 0.f, lsum = 0.f; f32x16 negm;
#pragma unroll
    for (int r = 0; r < 16; ++r) negm[r] = ATT_TGT;
    const int NS = NT >> 2;
    if (!pre) { asm volatile("s_waitcnt vmcnt(0)" ::: "memory");
#pragma unroll
        for (int j = 0; j < 4; ++j) ATT_DMA8(j, par * 4 + j); }
    ATT_WAIT_BAR(0);
    asm volatile("" :: "v"(qf));
    if (NS > 1) {
#pragma unroll
        for (int j = 0; j < 4; ++j) ATT_DMA8(4 + j, (par ^ 1) * 4 + j);
    } else ATT_DMA8_NEXT(par ^ 1);
#define ATT_KFRAG(kb_, kk) cat16(*(const LAS u32x4*)((kb_) + (key0 + (kk)) * 128 + kc0), *(const LAS u32x4*)((kb_) + (key0 + (kk)) * 128 + kc1))
#define ATT_VFRAG(vb_, d0) cat16(*(const LAS u32x4*)((vb_) + ((d0) * 32 + r32) * 64 + vc0), *(const LAS u32x4*)((vb_) + ((d0) * 32 + r32) * 64 + vc1))
#define ATT_QK(kb_, kk) __builtin_amdgcn_mfma_scale_f32_32x32x64_f8f6f4(ATT_KFRAG(kb_, kk), qf, negm, 0, 0, 0, 0x7A7A7A7A, 0, 0x7A7A7A7A)
    {
        const LAS unsigned char* p0_ = lds + par * 4 * SL; const f32x16 s0 = ATT_QK(p0_, 0), s1 = ATT_QK(p0_, 16);
        float rm = s0[0];
#pragma unroll
        for (int r = 1; r < 16; ++r) rm = fmaxf(rm, s0[r]);
#pragma unroll
        for (int r = 0; r < 16; ++r) rm = fmaxf(rm, s1[r]);
        mref = half_swap_max(rm) - ATT_TGT;
#pragma unroll
        for (int r = 0; r < 16; ++r) negm[r] = ATT_TGT - mref;
    }
    for (int st = 0; st < NS; ++st) {
        if (st > 0) {
            ATT_WAIT_BAR(0);
            if (st + 1 < NS) {
#pragma unroll
                for (int j = 0; j < 4; ++j) ATT_DMA8(4 * (st + 1) + j, ((par + st + 1) & 1) * 4 + j);
            } else ATT_DMA8_NEXT((par + NS) & 1);
        }
        const LAS unsigned char* sb_ = lds + ((par + st) & 1) * 4 * SL;
        v8i pfp = {0, 0, 0, 0, 0, 0, 0, 0};
#pragma unroll
        for (int j = 0; j < 4; ++j) {
            const LAS unsigned char* kb_ = sb_ + j * SL;
            f32x16 s0 = ATT_QK(kb_, 0), s1 = ATT_QK(kb_, 16);
            if (j > 0) { const LAS unsigned char* vp_ = kb_ - SL + VO;
#pragma unroll
                for (int d0 = 0; d0 < 4; ++d0) o[d0] = __builtin_amdgcn_mfma_scale_f32_32x32x64_f8f6f4(pfp, ATT_VFRAG(vp_, d0), o[d0], 0, 0, 0, 0x7F7F7F7F, 0, 0x7F7F7F7F); }
#pragma unroll
            for (int r = 0; r < 16; ++r) { s0[r] = __builtin_amdgcn_exp2f(s0[r]); s1[r] = __builtin_amdgcn_exp2f(s1[r]); }
            float sa = 0.f, sb = 0.f;
#pragma unroll
            for (int r = 0; r < 16; ++r) { sa += s0[r]; sb += s1[r]; }
            sa += sb;
            if (__any(!(sa <= 448.f))) {
                unsigned ko_ = (unsigned)(uintptr_t)kb_; asm volatile("" : "+v"(ko_));
                const LAS unsigned char* kr_ = (const LAS unsigned char*)(uintptr_t)ko_;
                s0 = ATT_QK(kr_, 0); s1 = ATT_QK(kr_, 16);
                float rm = s0[0];
#pragma unroll
                for (int r = 1; r < 16; ++r) rm = fmaxf(rm, s0[r]);
#pragma unroll
                for (int r = 0; r < 16; ++r) rm = fmaxf(rm, s1[r]);
                rm = half_swap_max(rm);
                const float dl = fmaxf(rm - ATT_TGT, 0.f); mref += dl;
#pragma unroll
                for (int r = 0; r < 16; ++r) negm[r] = ATT_TGT - mref;
                const float f = __builtin_amdgcn_exp2f(-dl); lsum *= f;
                if (hi == 0) wsc[r32] = f;
                asm volatile("s_waitcnt lgkmcnt(0)" ::: "memory");
#pragma unroll
                for (int r = 0; r < 16; ++r) { const float fr_ = wsc[crow(r, hi)];
#pragma unroll
                    for (int d0 = 0; d0 < 4; ++d0) o[d0][r] *= fr_; }
                asm volatile("s_waitcnt lgkmcnt(0)" ::: "memory");
#pragma unroll
                for (int r = 0; r < 16; ++r) { s0[r] = __builtin_amdgcn_exp2f(s0[r] - dl); s1[r] = __builtin_amdgcn_exp2f(s1[r] - dl); }
                sa = 0.f; sb = 0.f;
#pragma unroll
                for (int r = 0; r < 16; ++r) { sa += s0[r]; sb += s1[r]; }
                sa += sb;
            }
            lsum += sa;
#pragma unroll
            for (int jj = 0; jj < 4; ++jj) { int w = __builtin_bit_cast(int, s0[4 * jj]); w = __builtin_amdgcn_cvt_pk_fp8_f32(s0[4 * jj], s0[4 * jj + 1], w, false); w = __builtin_amdgcn_cvt_pk_fp8_f32(s0[4 * jj + 2], s0[4 * jj + 3], w, true); pfp[jj] = w;
                int w2 = __builtin_bit_cast(int, s1[4 * jj]); w2 = __builtin_amdgcn_cvt_pk_fp8_f32(s1[4 * jj], s1[4 * jj + 1], w2, false); w2 = __builtin_amdgcn_cvt_pk_fp8_f32(s1[4 * jj + 2], s1[4 * jj + 3], w2, true); pfp[4 + jj] = w2; }
        }
        {
            const LAS unsigned char* vl_ = sb_ + 3 * SL + VO;
#pragma unroll
            for (int d0 = 0; d0 < 4; ++d0) o[d0] = __builtin_amdgcn_mfma_scale_f32_32x32x64_f8f6f4(pfp, ATT_VFRAG(vl_, d0), o[d0], 0, 0, 0, 0x7F7F7F7F, 0, 0x7F7F7F7F);
        }
    }
#undef ATT_KFRAG
#undef ATT_VFRAG
#undef ATT_QK
    const float lt = half_swap_sum(lsum);
    if (hi == 0) wsc[64 + r32] = (c ? -lam : 1.f) * __builtin_amdgcn_rcpf(16.f * lt);
    asm volatile("s_waitcnt lgkmcnt(0)\n\ts_barrier" ::: "memory");
    LAS float* xch = (LAS float*)(lds + ((par + NS - 1) & 1) * 65536 + qg * 16384);
#pragma unroll
    for (int r = 0; r < 16; ++r) { const float a = wsc[64 + crow(r, hi)];
#pragma unroll
        for (int d0 = 0; d0 < 4; ++d0) o[d0][r] *= a; }
    if (c == 1) {
#pragma unroll
        for (int d0 = 0; d0 < 4; ++d0)
#pragma unroll
            for (int r = 0; r < 16; ++r) xch[(d0 * 16 + r) * 64 + lane] = o[d0][r];
    }
    asm volatile("s_waitcnt lgkmcnt(0)\n\ts_barrier" ::: "memory");
    if (c == 0) {
        constexpr int OB = FP8_ATT_O ? 1 : 2;
        LAS unsigned char* stg = lds + LX_EPI + qg * 4096;
#pragma unroll
        for (int d0 = 0; d0 < 4; ++d0)
#pragma unroll
            for (int r = 0; r < 16; ++r) o[d0][r] += xch[(d0 * 16 + r) * 64 + lane];
        float sgl[4];
#pragma unroll
        for (int d0 = 0; d0 < 4; ++d0) sgl[d0] = wsc[96 + d0 * 32 + r32];
        float ss[16], tt[16];
#pragma unroll
        for (int r = 0; r < 16; ++r) { float x = (o[0][r] * o[0][r] + o[1][r] * o[1][r]) + (o[2][r] * o[2][r] + o[3][r] * o[3][r]);
            x += __builtin_bit_cast(float, __builtin_amdgcn_update_dpp(0, __builtin_bit_cast(int, x), 0xB1, 0xF, 0xF, true));
            x += __builtin_bit_cast(float, __builtin_amdgcn_update_dpp(0, __builtin_bit_cast(int, x), 0x4E, 0xF, 0xF, true));
            x += __builtin_bit_cast(float, __builtin_amdgcn_update_dpp(0, __builtin_bit_cast(int, x), 0x124, 0xF, 0xF, true));
            x += __builtin_bit_cast(float, __builtin_amdgcn_update_dpp(0, __builtin_bit_cast(int, x), 0x128, 0xF, 0xF, true));
            ss[r] = x; }
#pragma unroll
        for (int r = 0; r < 16; ++r) tt[r] = __shfl_xor(ss[r], 16);
#pragma unroll
        for (int r = 0; r < 16; ++r) { const int qr = crow(r, hi); const float rn = __builtin_amdgcn_rsqf((ss[r] + tt[r]) * (1.f / 128.f) + EPS);
#pragma unroll
            for (int d0 = 0; d0 < 4; ++d0) { const float ov = o[d0][r] * rn * sgl[d0];
                if (FP8_ATT_O) { const float o4 = clamp8(4.f * ov); *(LAS unsigned char*)(stg + qr * 128 + d0 * 32 + r32) = (unsigned char)(__builtin_amdgcn_cvt_pk_fp8_f32(o4, o4, 0, false) & 0xff); }
                else *(LAS unsigned short*)(stg + (qr * 128 + d0 * 32 + r32) * 2) = (unsigned short)f2bf(ov); } }
        asm volatile("s_waitcnt lgkmcnt(0)" ::: "memory");
        unsigned char* Ob = (unsigned char*)O + ((size_t)(qrow0 + qg * 32) * 1024 + h * 128) * OB;
#pragma unroll
        for (int k = 0; k < 4 * OB; ++k) { const int off = lane * 16 + 1024 * k, row = off / (128 * OB), cb = off % (128 * OB);
            *(u32x4*)(Ob + (size_t)row * 1024 * OB + cb) = *(const LAS u32x4*)(stg + off); }
    }
    asm volatile("s_waitcnt lgkmcnt(0)\n\ts_barrier" ::: "memory");
#undef ATT_DMA8
}
}

#if ATT_FP8
#define ATT_CALL(l_, w_, q_, k_, v_, o_, ...) att::attn_unit8(l_, w_, (const unsigned char*)(q_), (const unsigned char*)(k_), (const unsigned char*)(v_), o_, __VA_ARGS__)
#else
#define ATT_CALL att::attn_unit
#endif
__device__ __forceinline__ void load_row_f32(const float* p, int lane, f32x4 (&v)[4]) {
#pragma unroll
    for (int j = 0; j < 4; ++j) v[j] = *(const f32x4*)(p + 256 * j + 4 * lane);
}
__device__ __forceinline__ void load_row_x(const void* Xb, size_t row, int lane, f32x4 (&v)[4]) {
    if (X_BF16) { const bf16* p = (const bf16*)Xb + row * D;
#pragma unroll
        for (int j = 0; j < 4; ++j) { const u32x2 w = *(const u32x2*)(p + 256 * j + 4 * lane);
            v[j] = (f32x4){bf2f((unsigned short)(w.x & 0xffffu)), bf2f((unsigned short)(w.x >> 16)), bf2f((unsigned short)(w.y & 0xffffu)), bf2f((unsigned short)(w.y >> 16))}; } }
    else load_row_f32((const float*)Xb + row * D, lane, v);
}
__device__ __forceinline__ void store_row_x(void* Xb, size_t row, int lane, const f32x4 (&v)[4]) {
    if (X_BF16) { bf16* p = (bf16*)Xb + row * D;
#pragma unroll
        for (int j = 0; j < 4; ++j) { u32x2 w; w.x = cvt_pk_bf16(v[j][0], v[j][1]); w.y = cvt_pk_bf16(v[j][2], v[j][3]); *(u32x2*)(p + 256 * j + 4 * lane) = w; } }
    else { float* p = (float*)Xb + row * D;
#pragma unroll
        for (int j = 0; j < 4; ++j) *(f32x4*)(p + 256 * j + 4 * lane) = v[j]; }
}
__device__ __forceinline__ float row_rstd(const f32x4 (&v)[4]) {
    float s = 0.f;
#pragma unroll
    for (int j = 0; j < 4; ++j) s += (v[j][0] * v[j][0] + v[j][1] * v[j][1]) + (v[j][2] * v[j][2] + v[j][3] * v[j][3]);
    return 1.0f / sqrtf(wave_sum(s) * (1.f / D) + EPS);
}
__device__ __forceinline__ void norm_mod_store(f32x4 (&v)[4], const float* g, const float* sc, const float* sh, int lane, bf16* hrow) {
    const float rstd = row_rstd(v);
#pragma unroll
    for (int j = 0; j < 4; ++j) { const int c = 256 * j + 4 * lane; const f32x4 gg = *(const f32x4*)(g + c), ss = *(const f32x4*)(sc + c), hh = *(const f32x4*)(sh + c);
        v[j] = (v[j] * rstd) * gg * (ss + 1.f) + hh;
        u32x2 w; w.x = cvt_pk_bf16(v[j][0], v[j][1]); w.y = cvt_pk_bf16(v[j][2], v[j][3]); *(u32x2*)(hrow + c) = w; }
}
__device__ __forceinline__ void norm_mod_f32(f32x4 (&v)[4], const float* g, const float* sc, const float* sh, int lane) {
    const float rstd = row_rstd(v);
#pragma unroll
    for (int j = 0; j < 4; ++j) { const int c = 256 * j + 4 * lane; const f32x4 gg = *(const f32x4*)(g + c), ss = *(const f32x4*)(sc + c), hh = *(const f32x4*)(sh + c);
        v[j] = (v[j] * rstd) * gg * (ss + 1.f) + hh; }
}
__device__ __forceinline__ void norm_mod_store_mix(bool f8, f32x4 (&v)[4], const float* g, const float* sc, const float* sh, int lane, bf16* hrow, unsigned char* h8row) {
    if (f8) { norm_mod_f32(v, g, sc, sh, lane);
#pragma unroll
        for (int j = 0; j < 4; ++j) *(unsigned*)(h8row + 256 * j + 4 * lane) = pack_fp8x4(16.f * v[j][0], 16.f * v[j][1], 16.f * v[j][2], 16.f * v[j][3]); }
    else norm_mod_store(v, g, sc, sh, lane, hrow);
}
__device__ __forceinline__ int row_batch(int row) { return row / RPB; }
__device__ __forceinline__ bool row_is_ctx(int row) { return (row % RPB) < CTXL; }
__device__ __forceinline__ int act_row(int ai, bool lat_only) { return lat_only ? (ai >> 11) * RPB + CTXL + (ai & 2047) : ai; }

template <int MODE>
__device__ __forceinline__ void transpose_item(const float* W, int K, int N, bf16* WT, LAS float* scr, int item, int lane) {
    const int nblk = N / 32, kb = item / nblk, nb = item % nblk, k0 = 64 * kb, n0 = 32 * nb;
#pragma unroll 8
    for (int i = 0; i < 32; ++i) { const int kk = 2 * i + (lane >> 5); scr[kk * 33 + (lane & 31)] = W[(size_t)(k0 + kk) * N + n0 + (lane & 31)]; }
    asm volatile("s_waitcnt lgkmcnt(0)" ::: "memory");
    const int c = lane & 7;
#pragma unroll
    for (int j = 0; j < 4; ++j) { const int n = (lane >> 3) + 8 * j; const LAS float* s = scr + (8 * c) * 33 + n;
        u32x4 o; o.x = cvt_pk_bf16(s[0 * 33], s[1 * 33]); o.y = cvt_pk_bf16(s[2 * 33], s[3 * 33]); o.z = cvt_pk_bf16(s[4 * 33], s[5 * 33]); o.w = cvt_pk_bf16(s[6 * 33], s[7 * 33]);
        int nn = n0 + n;
        if (MODE == 1 && nn < 2048) { const int i6 = nn & 63; nn = (nn & ~63) + (i6 < 32 ? 2 * i6 : 2 * (i6 - 32) + 1); }
        if (MODE == 2 && nn >= 1024) nn = nn < 2048 ? 1024 + 2 * (nn - 1024) : 1024 + 2 * (nn - 2048) + 1;
        *(u32x4*)(WT + (size_t)nn * K + k0 + 8 * c) = o; }
    asm volatile("s_waitcnt lgkmcnt(0)" ::: "memory");
}

template <int MODE = 0>
__device__ __forceinline__ void transpose_item8(const float* W, int K, int N, unsigned char* WT, LAS float* scr, int item, int lane) {
    const int nblk = N / 16, kb = item / nblk, nb = item % nblk, k0 = 128 * kb, n0 = 16 * nb;
    f32x4 v[8];
#pragma unroll
    for (int i = 0; i < 8; ++i) v[i] = *(const f32x4*)(W + (size_t)(k0 + 16 * i + (lane >> 2)) * N + n0 + 4 * (lane & 3));
#pragma unroll
    for (int i = 0; i < 8; ++i) *(LAS f32x4*)(scr + (16 * i + (lane >> 2)) * 20 + 4 * (lane & 3)) = v[i] * 1024.f;
    asm volatile("s_waitcnt lgkmcnt(0)" ::: "memory");
    const int kc = lane & 7;
#pragma unroll
    for (int j = 0; j < 2; ++j) { const int n = (lane >> 3) + 8 * j; const LAS float* s = scr + (16 * kc) * 20 + n;
        u32x4 o;
        o.x = pack_fp8x4(s[0 * 20], s[1 * 20], s[2 * 20], s[3 * 20]); o.y = pack_fp8x4(s[4 * 20], s[5 * 20], s[6 * 20], s[7 * 20]);
        o.z = pack_fp8x4(s[8 * 20], s[9 * 20], s[10 * 20], s[11 * 20]); o.w = pack_fp8x4(s[12 * 20], s[13 * 20], s[14 * 20], s[15 * 20]);
        int nn = n0 + n;
        if (MODE == 1 && nn < 2048) { const int i6 = nn & 63; nn = (nn & ~63) + (i6 < 32 ? 2 * i6 : 2 * (i6 - 32) + 1); }
        *(u32x4*)(WT + (size_t)nn * K + k0 + 16 * kc) = o; }
    asm volatile("s_waitcnt lgkmcnt(0)" ::: "memory");
}

__device__ __forceinline__ void item8_load(const float* W, int N, int item, int lane, f32x4 (&v)[8]) {
    const int nblk = N / 16, kb = item / nblk, nb = item % nblk, k0 = 128 * kb, n0 = 16 * nb;
#pragma unroll
    for (int i = 0; i < 8; ++i) v[i] = *(const f32x4*)(W + (size_t)(k0 + 16 * i + (lane >> 2)) * N + n0 + 4 * (lane & 3));
}
__device__ __forceinline__ void item8_store(const f32x4 (&v)[8], int K, int N, unsigned char* WT, LAS float* scr, int item, int lane) {
    const int nblk = N / 16, kb = item / nblk, nb = item % nblk, k0 = 128 * kb, n0 = 16 * nb;
    const float ge = (N == 2048) ? 1024.f * GATE_PRE : 1024.f; const f32x4 mulv = {ge, 1024.f, ge, 1024.f};
#pragma unroll
    for (int i = 0; i < 8; ++i) *(LAS f32x4*)(scr + (16 * i + (lane >> 2)) * 20 + 4 * (lane & 3)) = v[i] * mulv;
    asm volatile("s_waitcnt lgkmcnt(0)" ::: "memory");
    const int kc = lane & 7;
#pragma unroll
    for (int j = 0; j < 2; ++j) { const int n = (lane >> 3) + 8 * j; const LAS float* s = scr + (16 * kc) * 20 + n;
        u32x4 o;
        o.x = pack_fp8x4(s[0 * 20], s[1 * 20], s[2 * 20], s[3 * 20]); o.y = pack_fp8x4(s[4 * 20], s[5 * 20], s[6 * 20], s[7 * 20]);
        o.z = pack_fp8x4(s[8 * 20], s[9 * 20], s[10 * 20], s[11 * 20]); o.w = pack_fp8x4(s[12 * 20], s[13 * 20], s[14 * 20], s[15 * 20]);
        *(u32x4*)(WT + (size_t)(n0 + n) * K + k0 + 16 * kc) = o; }
    asm volatile("s_waitcnt lgkmcnt(0)" ::: "memory");
}

struct Args { const float* in[21]; float* out; unsigned char* ws; int ph_lo, ph_hi; };
enum { I_X = 0, I_C, I_CTX, I_CCTX, I_MODW, I_MODB, I_NORMG, I_WQKV, I_WO, I_LAM, I_SUBG, I_WIN, I_CONVW, I_WOUT, I_RW, I_RB, I_WGU, I_BGU, I_WD, I_BD, I_FINALG };

__device__ __forceinline__ void moe_table(LAS unsigned char* lds, const unsigned* gcnt, int tid) {
    LAS int* ecnt = (LAS int*)(lds + LX_ECNT); LAS int* tstart = (LAS int*)(lds + LX_TSTART); LAS int* tile_e = (LAS int*)(lds + LX_TILEE);
    __syncthreads();
    if (tid < 32) ecnt[tid] = (int)__hip_atomic_load(gcnt + tid, RLX_AGENT);
    __syncthreads();
    if (tid == 0) { int ts = 0; for (int e = 0; e < 32; ++e) { tstart[e] = ts; ts += (ecnt[e] + 255) >> 8; } tstart[32] = ts; }
    __syncthreads();
    { const int e = tid >> 4, l16 = tid & 15; const int t0 = tstart[e], n = tstart[e + 1] - t0; for (int j = l16; j < n; j += 16) tile_e[t0 + j] = e; }
    __syncthreads();
}

typedef const __attribute__((address_space(4))) unsigned char* kptr_t;
__device__ __forceinline__ kptr_t kargs() { kptr_t p = (kptr_t)__builtin_amdgcn_kernarg_segment_ptr(); asm volatile("" : "+s"(p)); return p; }
#define INP(k) (*(const float* const __attribute__((address_space(4)))*)(kargs() + 8 * (k)))
#define OUTP() (*(float* const __attribute__((address_space(4)))*)(kargs() + 168))
#define WSB() (*(unsigned char* const __attribute__((address_space(4)))*)(kargs() + 176))
#define WSP(T, off) ((T*)(WSB() + (off)))
static_assert(sizeof(Args) == 192, "kernarg layout");
__global__ void __launch_bounds__(NTHREADS, 2) fwd(Args args) {
    extern __shared__ __attribute__((aligned(16))) unsigned char lds_raw[];
    LAS unsigned char* lds = (LAS unsigned char*)lds_raw;
    const int tid = threadIdx.x, lane = tid & 63, wave = __builtin_amdgcn_readfirstlane(tid >> 6);
    const int G = gridDim.x, bid = blockIdx.x;
    const int gw = bid * NWAVES + wave, NGW = G * NWAVES;
    gu32* ctl = (gu32*)WSP(unsigned, WS_CTL);
    for (int u = tid; u < (LDS_BYTES - LX) / 4; u += NTHREADS) ((LAS unsigned*)(lds + LX))[u] = 0u;
    __syncthreads();
    volatile LAS unsigned* MISC = (volatile LAS unsigned*)(lds + LX_MISC);
    XcdBarrier bar; bar.bar = (unsigned*)(ctl + CW_BAR); bar.x = 0; bar.st = nullptr;
    if (!MK_PER_PHASE) bar = xcd_barrier_post((unsigned*)(ctl + CW_BAR), MISC + 8);
    (void)args;
    const unsigned long long pt_start = PROBE_T ? __builtin_amdgcn_s_memtime() : 0ull; (void)pt_start;
    const unsigned long long pt_rstart = PROBE_T ? __builtin_amdgcn_s_memrealtime() : 0ull; (void)pt_rstart;
    const int lo = *(const int __attribute__((address_space(4)))*)(kargs() + 184), hi = *(const int __attribute__((address_space(4)))*)(kargs() + 188);
#define IN(k) (lo <= (k) && (k) < hi)
#define PHASE_IDS int tid = threadIdx.x; asm volatile("" : "+v"(tid)); const int lane = tid & 63, wave = __builtin_amdgcn_readfirstlane(tid >> 6); const int gw = bid * NWAVES + wave; (void)lane; (void)gw;
#define SEAM(k) do { if (IN(k) && IN((k) + 1)) { if (MK_PER_PHASE) { if (tid == 0) __hip_atomic_store(ctl + CW_TMO, 0xBADu, RLX_AGENT); } else { unsigned long long b0_ = 0; if (PROBE_T == 10) b0_ = __builtin_amdgcn_s_memtime(); xcd_barrier(bar); if (PROBE_REP & 0x10000) xcd_barrier(bar); if (PROBE_T == 10 && bid == PROBE_BID && threadIdx.x == 0) *(LAS unsigned long long*)(lds + LX_MISC + 64) += __builtin_amdgcn_s_memtime() - b0_; } } } while (0)

    if (PS(0) && IN(0)) { PHASE_IDS
        float* modv = WSP(float, WS_MODV);
        unsigned long long p0t_ = (PROBE_T == 11 || PROBE_T == 12) ? __builtin_amdgcn_s_memtime() : 0ull; (void)p0t_;
        { LAS float* sil = (LAS float*)lds;
          LAS float* red = (LAS float*)(lds + 69632);
          for (int i = tid; i < 17 * 1024; i += NTHREADS) { const int r = i >> 10, k = i & 1023; const float cv = r < 16 ? INP(I_C)[r * 1024 + k] : INP(I_CCTX)[k]; sil[i] = cv / (1.f + __expf(-cv)); }
          __syncthreads();
          for (int it = bid; it < 4 * 96; it += G) { const int l = it / 96, nb = it % 96; const float* W = INP(I_MODW) + (size_t)l * 1024 * 6144 + nb * 64 + lane;
            float a[17];
#pragma unroll
            for (int r = 0; r < 17; ++r) a[r] = 0.f;
            for (int k = wave * 128; k < wave * 128 + 128; k += 4) { float w[4];
#pragma unroll
                for (int q = 0; q < 4; ++q) w[q] = W[(size_t)(k + q) * 6144];
#pragma unroll
                for (int r = 0; r < 17; ++r) { const f32x4 s = *(const LAS f32x4*)(sil + r * 1024 + k); a[r] += s[0] * w[0] + s[1] * w[1] + s[2] * w[2] + s[3] * w[3]; } }
#pragma unroll
            for (int r = 0; r < 17; ++r) red[(wave * 17 + r) * 64 + lane] = a[r];
            __syncthreads();
            for (int i = tid; i < 17 * 64; i += NTHREADS) { const int r = i >> 6, n = i & 63; float s = INP(I_MODB)[l * 6144 + nb * 64 + n];
#pragma unroll
                for (int w8 = 0; w8 < 8; ++w8) s += red[(w8 * 17 + r) * 64 + n];
                modv[((size_t)l * 17 + r) * 6144 + nb * 64 + n] = s; }
            __syncthreads(); }
        }
        if (PROBE_T == 11 && bid == 0 && tid == 0) *(LAS unsigned long long*)(lds + LX_MISC + 64) += __builtin_amdgcn_s_memtime() - p0t_;
        { float* cosT = WSP(float, WS_ROPE); float* sinT = cosT + 2048 * 32; float* rwT = WSP(float, WS_RW); float* lamv = WSP(float, WS_MISC);
        for (int i = bid * NTHREADS + tid; i < 2048 * 32; i += G * NTHREADS) { const int t = i >> 5, j = i & 31; const float pos = (float)(j < 16 ? (t >> 6) : (t & 63));
            const float inv = powf(10000.f, -(float)(2 * (j & 15)) / 32.f); const float ang = pos * inv; cosT[i] = cosf(ang); sinT[i] = sinf(ang); }
        if (bid == 0 && tid < 2) { const float* lp = INP(I_LAM) + tid * 256; float s1 = 0.f, s2 = 0.f; for (int d = 0; d < 64; ++d) { s1 += lp[d] * lp[64 + d]; s2 += lp[128 + d] * lp[192 + d]; }
            const float lam_init = 0.8f - 0.6f * expf(-0.3f * (float)(2 * tid)); lamv[tid] = expf(s1) - expf(s2) + lam_init; lamv[2 + tid] = 1.f - lam_init; }
        for (int i = bid * NTHREADS + tid; i < 4 * 32 * 1024; i += G * NTHREADS) { const int l = i >> 15, e = (i >> 10) & 31, k = i & 1023; rwT[i] = INP(I_RW)[((size_t)l * 1024 + k) * 32 + e]; } }
        if (PROBE_T == 12) p0t_ = __builtin_amdgcn_s_memtime();
        { LAS float* scr = (LAS float*)(lds + wave * 10240);
          bf16* Wqkv_t = WSP(bf16, WS_WQKV); bf16* Win_t = WSP(bf16, WS_WIN); bf16* Wo_t = WSP(bf16, WS_WO); bf16* Wout_t = WSP(bf16, WS_WOUT); bf16* Wgu_t = WSP(bf16, WS_WGU); bf16* Wd_t = WSP(bf16, WS_WD);
          constexpr int I_QKV = 16 * 96, I_SQ = 16 * 32, I_GU = 16 * 64, I_D = 16 * 32;
          constexpr int T0 = 2 * I_QKV, T1 = T0 + 2 * I_QKV, T2 = T1 + 2 * I_SQ, T3 = T2 + 2 * I_SQ, T4 = T3 + 128 * I_GU, T5 = T4 + 128 * I_D;
          for (int rep = 0; rep < NREP(0); ++rep) {
          for (int it = gw; it < (MOE_FP8 ? T3 : T5); it += NGW) {
            if (it < T0) { const int j = it / I_QKV; if (FP8_ATT) transpose_item8<1>(INP(I_WQKV) + (size_t)j * 1024 * 3072, 1024, 3072, (unsigned char*)Wqkv_t + (size_t)j * 3072 * 1024, scr, it % I_QKV, lane); else transpose_item<1>(INP(I_WQKV) + (size_t)j * 1024 * 3072, 1024, 3072, Wqkv_t + (size_t)j * 3072 * 1024, scr, it % I_QKV, lane); }
            else if (it < T1) { const int r = it - T0, j = r / I_QKV; if (FP8_CONV) transpose_item8<0>(INP(I_WIN) + (size_t)j * 1024 * 3072, 1024, 3072, (unsigned char*)Win_t + (size_t)j * 3072 * 1024, scr, r % I_QKV, lane); else transpose_item<CONV_FUSE_U ? 2 : 0>(INP(I_WIN) + (size_t)j * 1024 * 3072, 1024, 3072, Win_t + (size_t)j * 3072 * 1024, scr, r % I_QKV, lane); }
            else if (it < T2) { const int r = it - T1, j = r / I_SQ; if (FP8_ATT_O) transpose_item8<0>(INP(I_WO) + (size_t)j * 1024 * 1024, 1024, 1024, (unsigned char*)Wo_t + (size_t)j * 1024 * 1024, scr, r % I_SQ, lane); else transpose_item<0>(INP(I_WO) + (size_t)j * 1024 * 1024, 1024, 1024, Wo_t + (size_t)j * 1024 * 1024, scr, r % I_SQ, lane); }
            else if (it < T3) { const int r = it - T2, j = r / I_SQ; if (FP8_WOUT) transpose_item8<0>(INP(I_WOUT) + (size_t)j * 1024 * 1024, 1024, 1024, (unsigned char*)Wout_t + (size_t)j * 1024 * 1024, scr, r % I_SQ, lane); else transpose_item<0>(INP(I_WOUT) + (size_t)j * 1024 * 1024, 1024, 1024, Wout_t + (size_t)j * 1024 * 1024, scr, r % I_SQ, lane); }
            else if (it < T4) { const int r = it - T3, j = r / I_GU; transpose_item<0>(INP(I_WGU) + (size_t)j * 1024 * 2048, 1024, 2048, Wgu_t + (size_t)j * 2048 * 1024, scr, r % I_GU, lane); }
            else { const int r = it - T4, j = r / I_D; transpose_item<0>(INP(I_WD) + (size_t)j * 1024 * 1024, 1024, 1024, Wd_t + (size_t)j * 1024 * 1024, scr, r % I_D, lane); }
          }
          if (MOE_FP8) {
            constexpr int NGUI = 128 * I_GU, NMOE = NGUI + 128 * I_D;
            const float* wgu = INP(I_WGU); const float* wd = INP(I_WD);
#define MOE_DEC(r_, W_, N_, WT_, IT_) do { if ((r_) < NGUI) { const int j_ = (r_) / I_GU; W_ = wgu + (size_t)j_ * 1024 * 2048; N_ = 2048; WT_ = (unsigned char*)Wgu_t + (size_t)j_ * 2048 * 1024; IT_ = (r_) % I_GU; } \
              else { const int q_ = (r_) - NGUI, j_ = q_ / I_D; W_ = wd + (size_t)j_ * 1024 * 1024; N_ = 1024; WT_ = (unsigned char*)Wd_t + (size_t)j_ * 1024 * 1024; IT_ = q_ % I_D; } } while (0)
            f32x4 vc[8], vn[8]; const float* Wc = nullptr; int Nc = 0, itc = 0; unsigned char* WTc = nullptr;
            int r = gw;
            if (r < NMOE) { MOE_DEC(r, Wc, Nc, WTc, itc); item8_load(Wc, Nc, itc, lane, vc); }
            for (; r < NMOE; r += NGW) { const int rn = r + NGW; const bool hn = rn < NMOE; const float* Wn = Wc; int Nn = Nc, itn = itc; unsigned char* WTn = WTc;
                if (hn) { MOE_DEC(rn, Wn, Nn, WTn, itn); item8_load(Wn, Nn, itn, lane, vn); }
                item8_store(vc, 1024, Nc, WTc, scr, itc, lane);
                if (hn) { Wc = Wn; Nc = Nn; itc = itn; WTc = WTn;
#pragma unroll
                    for (int i = 0; i < 8; ++i) vc[i] = vn[i]; } }
#undef MOE_DEC
          }
          }
        }
        if (PROBE_T == 12 && bid == 0 && tid == 0) *(LAS unsigned long long*)(lds + LX_MISC + 64) += __builtin_amdgcn_s_memtime() - p0t_;
        __syncthreads();
    }
    SEAM(0);

    if (PS(1) && IN(1)) { PHASE_IDS
        const float* g = INP(I_NORMG); const float* modv = WSP(float, WS_MODV); float* X = WSP(float, WS_X); bf16* H = WSP(bf16, WS_H);
        for (int row = gw; row < M; row += NGW) { const int b = row_batch(row), jj = row % RPB; const bool cx = jj < CTXL; const int rb = cx ? 16 : b;
            const float* src = cx ? INP(I_CTX) + ((size_t)b * CTXL + jj) * D : INP(I_X) + ((size_t)b * SEQ + (jj - CTXL)) * D;
            f32x4 v[4]; load_row_f32(src, lane, v);
            norm_mod_store_mix(FP8_ATT != 0, v, g, modv + rb * 6144 + 1024, modv + rb * 6144, lane, H + (size_t)row * D, WSP(unsigned char, WS_H8) + (size_t)row * 1024); }
    }
    SEAM(1);

    for (int l = 0; l < DEPTH; ++l) {
        const int pb = 2 + 7 * l; const bool attn = (l & 1) == 0; const int j2 = l >> 1; const bool lat_only = (l == DEPTH - 1);
#define MV() (WSP(float, WS_MODV) + (size_t)l * 17 * 6144)
        const unsigned* gcnt = (const unsigned*)(ctl + CW_CNT) + l * 32;

        if (IN(pb)) { PHASE_IDS
            if (PS(2) && attn) {
                constexpr int RBX = FP8_ATT ? 1024 : 2048; constexpr int SCX = FP8_ATT ? 0x78787878 : 0;
                typedef SchedQKV<RBX, SCX> SQ;
                SQ S{FP8_ATT ? (const char*)WSP(unsigned char, WS_H8) : (const char*)WSP(bf16, WS_H), (const char*)WSP(bf16, WS_WQKV) + (size_t)j2 * 3072 * RBX};
                EpiQKV E{WSP(bf16, WS_Q), WSP(bf16, WS_K), WSP(bf16, WS_VT), WSP(float, WS_ROPE), WSP(float, WS_ROPE) + 2048 * 32, true, lds + LX_EPI};
                for (int rep = 0; rep < NREP(2); ++rep) { int z_ = rep; asm volatile("" : "+s"(z_)); E.dost = !PROBE_NOST || (z_ == NREP(2) - 1); pg8::gemm_phase<EpiQKV, SQ, 2>(lds, S, E, tid, STAG(1500)); }
            } else if (PS(3)) {
                constexpr int RBX = FP8_CONV ? 1024 : 2048; constexpr int SCX = FP8_CONV ? 0x78787878 : 0;
                typedef SchedPlain<RBX, SCX> SP;
                SP S{FP8_CONV ? (const char*)WSP(unsigned char, WS_H8) : (const char*)WSP(bf16, WS_H), (const char*)WSP(bf16, WS_WIN) + (size_t)j2 * 3072 * RBX, 12, lat_only};
                if (CONV_FUSE_U) { EpiConvIn E{WSP(bf16, WS_BCO), WSP(bf16, WS_BCO) + (size_t)M * 1024};
                    for (int rep = 0; rep < NREP(3); ++rep) pg8::gemm_phase<EpiConvIn, SP, 3>(lds, S, E, tid, STAG(1500)); }
                else { EpiPlain E{WSP(bf16, WS_BCO), 3072};
                    for (int rep = 0; rep < NREP(3); ++rep) pg8::gemm_phase<EpiPlain, SP, 3>(lds, S, E, tid, STAG(1500)); }
            }
        }
        SEAM(pb);

        if (IN(pb + 1)) { PHASE_IDS
            if (PS(4) && attn) {
                const float* lamv = WSP(float, WS_MISC); const float lam = lamv[j2], osc = lamv[2 + j2]; const float* subg = INP(I_SUBG) + j2 * 128;
                const bf16* Qb = WSP(bf16, WS_Q); const bf16* Kb = WSP(bf16, WS_K); const bf16* Vt = WSP(bf16, WS_VT); bf16* Ob = WSP(bf16, WS_O);
                LAS float* wsc = (LAS float*)(lds + LX_WSC + wave * 1024);
                if (ATT_FP8) { wsc[96 + lane] = subg[lane] * osc; wsc[160 + lane] = subg[64 + lane] * osc; }
                const int vcu = (G % 8 == 0) ? (bid % 8) * (G / 8) + bid / 8 : bid;
                for (int rep = 0; rep < NREP(4); ++rep)
                if (G == 256) {
                    const int xc = bid & 7, j = bid >> 3;
                    const int bhc = xc * 16 + (j >> 1);
                    for (int sstep = 0; sstep < 8; ++sstep) { const int bh = xc * 16 + 2 * sstep + (j >> 4), b = bh >> 3, h = bh & 7;
                        const int bhn = sstep < 7 ? bh + 2 : bhc;
                        ATT_CALL(lds, wsc, Qb, Kb, Vt, Ob, b * RPB, h, b * RPB + CTXL + (j & 15) * 128, 36, lam, osc, subg, tid, sstep & 1, sstep > 0, (bhn >> 3) * RPB, bhn & 7); }
                    { const int b = bhc >> 3, h = bhc & 7;
                      ATT_CALL(lds, wsc, Qb, Kb, Vt, Ob, b * RPB, h, b * RPB + (j & 1) * 128, 4, lam, osc, subg, tid, 0, true, -1, 0); }
                } else {
                    for (int u = bid; u < 128 * 18; u += G) { const int bh = u / 18, k = u % 18, b = bh >> 3, h = bh & 7;
                        ATT_CALL(lds, wsc, Qb, Kb, Vt, Ob, b * RPB, h, k < 16 ? b * RPB + CTXL + k * 128 : b * RPB + (k - 16) * 128, k < 16 ? 36 : 4, lam, osc, subg, tid, 0, false, -1, 0); }
                }
            } else if (PS(5)) {
                const float* cw = INP(I_CONVW) + (size_t)j2 * 3 * 1024; const bf16* BCO = WSP(bf16, WS_BCO); bf16* Ob = WSP(bf16, WS_O);
                const int nact = lat_only ? 32768 : M; const int nitems = (nact / 16) * 2;
                for (int it = gw; it < nitems; it += NGW) { const int strip = it >> 1, ch = (it & 1) * 512 + lane * 8; const int row0 = act_row(strip * 16, lat_only);
                    const int jj = row0 % RPB; const int seq_lo = jj < CTXL ? row0 - jj : row0 - jj + CTXL, seq_hi = jj < CTXL ? row0 - jj + CTXL : row0 - jj + RPB;
                    float w0[8], w1[8], w2[8];
#pragma unroll
                    for (int q = 0; q < 8; ++q) { w0[q] = cw[ch + q]; w1[q] = cw[1024 + ch + q]; w2[q] = cw[2048 + ch + q]; }
                    static_assert(CONV_FUSE_U != 0, "u = gate_c * x~ comes from the in-projection's epilogue");
                    const bf16* Ub = BCO + (size_t)M * 1024 + ch; const bf16* Gb = BCO + ch;
                    u32x4 ur[18], gr[16];
#pragma unroll
                    for (int k = 0; k < 18; ++k) { const int row = row0 - 1 + k; const bool in = (k != 0 && k != 17) || (row >= seq_lo && row < seq_hi);
                        ur[k] = *(const u32x4*)(Ub + (size_t)(in ? row : row0) * 1024); if (!in) ur[k] = u32x4{0u, 0u, 0u, 0u}; }
#pragma unroll
                    for (int r = 0; r < 16; ++r) gr[r] = *(const u32x4*)(Gb + (size_t)(row0 + r) * 1024);
                    float up[8], uc[8], un[8];
#define CONV_UNPACK(u_, w_) do { _Pragma("unroll") for (int q = 0; q < 4; ++q) { u_[2 * q] = bf2f((unsigned short)((w_)[q] & 0xffffu)); u_[2 * q + 1] = bf2f((unsigned short)((w_)[q] >> 16)); } } while (0)
                    CONV_UNPACK(up, ur[0]); CONV_UNPACK(uc, ur[1]);
#pragma unroll
                    for (int r = 0; r < 16; ++r) { const int row = row0 + r; CONV_UNPACK(un, ur[r + 2]);
                        const u32x4 gb = gr[r]; float z[8];
#pragma unroll
                        for (int q = 0; q < 8; ++q) { const float gbv = bf2f((unsigned short)((q & 1) ? (gb[q >> 1] >> 16) : (gb[q >> 1] & 0xffffu))); z[q] = gbv * (w0[q] * up[q] + w1[q] * uc[q] + w2[q] * un[q]); }
                        if (FP8_WOUT) { u32x2 o; o.x = pack_fp8x4(4.f * z[0], 4.f * z[1], 4.f * z[2], 4.f * z[3]); o.y = pack_fp8x4(4.f * z[4], 4.f * z[5], 4.f * z[6], 4.f * z[7]); *(u32x2*)((unsigned char*)Ob + (size_t)row * 1024 + ch) = o; }
                        else { u32x4 o; o.x = cvt_pk_bf16(z[0], z[1]); o.y = cvt_pk_bf16(z[2], z[3]); o.z = cvt_pk_bf16(z[4], z[5]); o.w = cvt_pk_bf16(z[6], z[7]);
                        *(u32x4*)(Ob + (size_t)row * 1024 + ch) = o; }
#pragma unroll
                        for (int q = 0; q < 8; ++q) { up[q] = uc[q]; uc[q] = un[q]; } }
#undef CONV_UNPACK
                }
            }
        }
        SEAM(pb + 1);

        if (PS(6) && IN(pb + 2)) { PHASE_IDS
            float* X = WSP(float, WS_X);
            EpiResid E{X, X, MV() + 2 * 1024, l == 0 ? INP(I_X) : nullptr, l == 0 ? INP(I_CTX) : nullptr};
            if (attn) { constexpr int RBX = FP8_ATT_O ? 1024 : 2048; constexpr int SCX = FP8_ATT_O ? 0x79797979 : 0;
                typedef SchedPlain<RBX, SCX> SP;
                SP S{(const char*)WSP(bf16, WS_O), (const char*)WSP(bf16, WS_WO) + (size_t)j2 * 1024 * RBX, 4, lat_only};
                pg8::gemm_phase<EpiResid, SP, 6>(lds, S, E, tid, STAG(1500));
            } else { constexpr int RBX = FP8_WOUT ? 1024 : 2048; constexpr int SCX = FP8_WOUT ? 0x79797979 : 0;
                typedef SchedPlain<RBX, SCX> SP;
                SP S{(const char*)WSP(bf16, WS_O), (const char*)WSP(bf16, WS_WOUT) + (size_t)j2 * 1024 * RBX, 4, lat_only};
                pg8::gemm_phase<EpiResid, SP, 6>(lds, S, E, tid, STAG(1500));
            }
        }
        SEAM(pb + 2);

        if (PS(7) && IN(pb + 3)) { PHASE_IDS
            LAS int* lcnt = (LAS int*)(lds + LX_LCNT); LAS int* lbase = (LAS int*)(lds + LX_LBASE); LAS int* asg = (LAS int*)(lds + LX_ASG);
            LAS float* wsc = (LAS float*)(lds + LX_WSC + wave * 1024);
            LAS unsigned char* tile = lds;
            LAS float* part = (LAS float*)(lds + 65536);
            float* X = WSP(float, WS_X); bf16* H = WSP(bf16, WS_H); const float* mv = MV(); int* topE = WSP(int, WS_TOPE); float* topG = WSP(float, WS_TOPG); int* topP = WSP(int, WS_TOPP); int* list = WSP(int, WS_LIST);
            const int r32 = lane & 31, hi = lane >> 5;
            bf16x8 wf[8];
            { const float* rw = WSP(float, WS_RW) + (size_t)l * 32 * 1024 + r32 * 1024 + wave * 128 + hi * 8;
#pragma unroll
              for (int s8 = 0; s8 < 8; ++s8) { const f32x4 a = *(const f32x4*)(rw + 16 * s8), b = *(const f32x4*)(rw + 16 * s8 + 4); wf[s8] = __builtin_bit_cast(bf16x8, pack8(a, b)); } }
            __syncthreads();
            if (tid < 32) lcnt[tid] = 0;
            __syncthreads();
            const int nact = lat_only ? 32768 : M; const int rpb = (nact + G - 1) / G; const int a0 = bid * rpb; int nr = nact - a0; nr = nr < 0 ? 0 : (nr > rpb ? rpb : nr);
            const float* g = INP(I_NORMG) + ((size_t)l * 2 + 1) * 1024; const float* rb_ = INP(I_RB) + l * 32;
            for (int g0 = 0; g0 < nr; g0 += 32) {
                f32x4 v[4][4]; int rowq[4]; bool okq[4];
#pragma unroll
                for (int q = 0; q < 4; ++q) { const int i = g0 + wave + 8 * q; okq[q] = i < nr; rowq[q] = act_row(a0 + (okq[q] ? i : nr - 1), lat_only); load_row_x(X, (size_t)rowq[q], lane, v[q]); }
#pragma unroll
                for (int q = 0; q < 4; ++q) { const int row = rowq[q]; const int rb = row_is_ctx(row) ? 16 : row_batch(row); const int tr = wave + 8 * q;
                    norm_mod_f32(v[q], g, mv + rb * 6144 + 4 * 1024, mv + rb * 6144 + 3 * 1024, lane);
                    if (MOE_FP8) { unsigned char* h8 = WSP(unsigned char, WS_H8) + (size_t)row * 1024;
#pragma unroll
                        for (int j = 0; j < 4; ++j) { const unsigned pk_ = pack_fp8x4(16.f * v[q][j][0], 16.f * v[q][j][1], 16.f * v[q][j][2], 16.f * v[q][j][3]); if (okq[q]) *(unsigned*)(h8 + 256 * j + 4 * lane) = pk_; } }
#pragma unroll
                    for (int j = 0; j < 4; ++j) { u32x2 w; w.x = cvt_pk_bf16(v[q][j][0], v[q][j][1]); w.y = cvt_pk_bf16(v[q][j][2], v[q][j][3]);
                        if (!MOE_FP8 && okq[q]) *(u32x2*)(H + (size_t)row * D + 256 * j + 4 * lane) = w;
                        const int ch = 32 * j + (lane >> 1); *(LAS u32x2*)(tile + tr * 2048 + ((ch ^ (tr & 15)) << 4) + (lane & 1) * 8) = w; } }
                __syncthreads();
                { f32x16 acc = f32x16{};
#pragma unroll
                  for (int s8 = 0; s8 < 8; ++s8) { const int ch = wave * 16 + 2 * s8 + hi; const bf16x8 bfr = *(const LAS bf16x8*)(tile + r32 * 2048 + ((ch ^ (r32 & 15)) << 4));
                      acc = __builtin_amdgcn_mfma_f32_32x32x16_bf16(wf[s8], bfr, acc, 0, 0, 0); }
#pragma unroll
                  for (int r = 0; r < 16; ++r) { const int e = (r & 3) + 8 * (r >> 2) + 4 * hi; part[(wave * 32 + e) * 33 + r32] = acc[r]; } }
                __syncthreads();
#pragma unroll 1
                for (int q = 0; q < 4; ++q) { const int tr = wave + 8 * q; const int i = g0 + tr; const int row = rowq[q]; const int my_e = r32;
                    float lg = rb_[my_e];
#pragma unroll
                    for (int w8 = 0; w8 < 8; ++w8) lg += part[(w8 * 32 + my_e) * 33 + tr];
                    if (lane < 32) wsc[my_e] = lg;
                    asm volatile("s_waitcnt lgkmcnt(0)" ::: "memory");
                    int rank = 0;
#pragma unroll
                    for (int e = 0; e < 32; ++e) { const float o = wsc[e]; rank += (o > lg || (o == lg && e < my_e)) ? 1 : 0; }
                    asm volatile("s_waitcnt lgkmcnt(0)" ::: "memory");
                    if (lane < 32 && rank < 4) { wsc[64 + rank] = lg; ((LAS int*)wsc)[72 + rank] = my_e; }
                    asm volatile("s_waitcnt lgkmcnt(0)" ::: "memory");
                    const float t0 = wsc[64], t1 = wsc[65], t2 = wsc[66], t3 = wsc[67];
                    const float p0 = 1.f, p1 = __expf(t1 - t0), p2 = __expf(t2 - t0), p3 = __expf(t3 - t0); const float inv = 1.f / (p0 + p1 + p2 + p3);
                    if (lane < 4 && okq[q]) { const int e = ((LAS int*)wsc)[72 + lane]; const float p = lane == 0 ? p0 : lane == 1 ? p1 : lane == 2 ? p2 : p3;
                        const int lp = __hip_atomic_fetch_add(lcnt + e, 1, __ATOMIC_RELAXED, __HIP_MEMORY_SCOPE_WORKGROUP);
                        topE[row * 4 + lane] = e; topG[row * 4 + lane] = p * inv; asg[i * 4 + lane] = (lp << 5) | e; }
                    asm volatile("s_waitcnt lgkmcnt(0)" ::: "memory");
                }
            }
            __syncthreads();
            if (tid < 32) lbase[tid] = (int)__hip_atomic_fetch_add((unsigned*)gcnt + tid, (unsigned)lcnt[tid], RLX_AGENT);
            __syncthreads();
            for (int i = tid; i < nr * 4; i += NTHREADS) { const int av = asg[i], e = av & 31, pos = lbase[e] + (av >> 5); const int row = act_row(a0 + (i >> 2), lat_only);
                list[(size_t)e * CAP + pos] = row; topP[row * 4 + (i & 3)] = pos; }
            __syncthreads();
        }
        SEAM(pb + 3);

        if (PS(8) && IN(pb + 4)) { PHASE_IDS
            moe_table(lds, gcnt, tid);
            constexpr int RBM = MOE_FP8 ? 1024 : 2048;
            typedef SchedMoe<true, RBM, 0x78787878, 0x78787878> SG;
            SG S{(const char*)(MOE_FP8 ? (void*)WSP(unsigned char, WS_H8) : (void*)WSP(bf16, WS_H)), (const char*)WSP(bf16, WS_WGU) + (size_t)l * 32 * 2048 * RBM, WSP(int, WS_LIST), 8, (size_t)2048 * RBM,
                 (LAS const int*)(lds + LX_TSTART), (LAS const int*)(lds + LX_ECNT), (LAS const int*)(lds + LX_TILEE)};
            EpiSwiglu<MOE_FP8 != 0> E{WSP(bf16, WS_ACT), INP(I_BGU) + (size_t)l * 32 * 2048, lds + LX_EPI};
            pg8::gemm_phase<EpiSwiglu<MOE_FP8 != 0>, SG, 8>(lds, S, E, tid, STAG(900));
        }
        SEAM(pb + 4);

        if (PS(9) && IN(pb + 5)) { PHASE_IDS
            if (MK_PER_PHASE || lo == pb + 5) moe_table(lds, gcnt, tid);
            constexpr int RBM = MOE_FP8 ? 1024 : 2048;
            typedef SchedMoe<false, RBM, Y_FP8 ? 0x7B7B7B7B : 0x79797979, Y_FP8 ? 0x7B7B7B7B : 0x79797979> SD;
            SD S{(const char*)WSP(bf16, WS_ACT), (const char*)WSP(bf16, WS_WD) + (size_t)l * 32 * 1024 * RBM, WSP(int, WS_LIST), 4, (size_t)1024 * RBM,
                 (LAS const int*)(lds + LX_TSTART), (LAS const int*)(lds + LX_ECNT), (LAS const int*)(lds + LX_TILEE)};
            EpiDown E{WSP(bf16, WS_Y), INP(I_BD) + (size_t)l * 32 * 1024, lds + LX_EPI};
            pg8::gemm_phase<EpiDown, SD, 9>(lds, S, E, tid, STAG(1100));
            if (PROBE_T && l == DEPTH - 1 && bid == (PROBE_T == 10 ? PROBE_BID : 0) && tid == 0) { unsigned long long acc_ = *(LAS unsigned long long*)(lds + LX_MISC + 64); unsigned long long tot_ = __builtin_amdgcn_s_memtime() - pt_start;
                if (PROBE_T == 9) { acc_ = tot_; tot_ = (__builtin_amdgcn_s_memrealtime() - pt_rstart) * 30ull; }
                WSP(float, WS_MISC)[16] = floorf((float)((double)acc_ / (double)tot_) * PROBE_TQ + 0.5f) / PROBE_TQ; }
        }
        SEAM(pb + 5);

        if (PS(10) && IN(pb + 6)) { PHASE_IDS
            if (MK_PER_PHASE || lo >= pb + 5) moe_table(lds, gcnt, tid);
            LAS const int* tstart = (LAS const int*)(lds + LX_TSTART);
            const int nact = lat_only ? 32768 : M;
            const float* gn = (l + 1 < DEPTH) ? INP(I_NORMG) + (size_t)(l + 1) * 2 * 1024 : INP(I_FINALG);
            const float* mv = MV(); const float* mvn = mv + 17 * 6144; float* X = WSP(float, WS_X); bf16* H = WSP(bf16, WS_H); const bf16* Yb = WSP(bf16, WS_Y);
            const int* topE = WSP(int, WS_TOPE); const float* topG = WSP(float, WS_TOPG); const int* topP = WSP(int, WS_TOPP);
            for (int ai = gw; ai < nact; ai += 2 * NGW) {
                int row[2]; bool ok[2]; int4 ev[2], pv[2]; f32x4 gv[2];
#pragma unroll
                for (int u = 0; u < 2; ++u) { const int a2 = ai + u * NGW; ok[u] = a2 < nact; row[u] = act_row(ok[u] ? a2 : ai, lat_only);
                    ev[u] = *(const int4*)(topE + row[u] * 4); pv[u] = *(const int4*)(topP + row[u] * 4); gv[u] = *(const f32x4*)(topG + row[u] * 4); }
                f32x4 v[2][4]; u32x2 yw[2][4][4];
#pragma unroll
                for (int u = 0; u < 2; ++u) { load_row_x(X, (size_t)row[u], lane, v[u]);
                    const int ee[4] = {ev[u].x, ev[u].y, ev[u].z, ev[u].w}, pp[4] = {pv[u].x, pv[u].y, pv[u].z, pv[u].w};
#pragma unroll
                    for (int k = 0; k < 4; ++k) { const size_t yrow = (size_t)(tstart[ee[k]] * 256 + pp[k]);
#pragma unroll
                        for (int j = 0; j < 4; ++j) { if (Y_FP8) { yw[u][k][j].x = *(const unsigned*)((const unsigned char*)Yb + yrow * 1024 + 256 * j + 4 * lane); yw[u][k][j].y = 0u; }
                            else yw[u][k][j] = *(const u32x2*)(Yb + yrow * 1024 + 256 * j + 4 * lane); } } }
#pragma unroll
                for (int u = 0; u < 2; ++u) { if (!ok[u]) continue;
                    const int rw_ = row[u]; const bool cx = row_is_ctx(rw_); const int rb = cx ? 16 : row_batch(rw_);
                    f32x4 acc4[4];
#pragma unroll
                    for (int j = 0; j < 4; ++j) acc4[j] = (f32x4){0.f, 0.f, 0.f, 0.f};
#pragma unroll
                    for (int k = 0; k < 4; ++k) { const float gk = gv[u][k];
#pragma unroll
                        for (int j = 0; j < 4; ++j) { const u32x2 w = yw[u][k][j];
                            if (Y_FP8) { const f32x2 lo = __builtin_amdgcn_cvt_pk_f32_fp8((int)w.x, false), hi2 = __builtin_amdgcn_cvt_pk_f32_fp8((int)w.x, true); const float g16 = gk * (1.f / 16.f);
                                acc4[j][0] += g16 * lo[0]; acc4[j][1] += g16 * lo[1]; acc4[j][2] += g16 * hi2[0]; acc4[j][3] += g16 * hi2[1]; }
                            else { acc4[j][0] += gk * bf2f((unsigned short)(w.x & 0xffffu)); acc4[j][1] += gk * bf2f((unsigned short)(w.x >> 16)); acc4[j][2] += gk * bf2f((unsigned short)(w.y & 0xffffu)); acc4[j][3] += gk * bf2f((unsigned short)(w.y >> 16)); } } }
                    const float* g2 = mv + rb * 6144 + 5 * 1024;
#pragma unroll
                    for (int j = 0; j < 4; ++j) { const f32x4 gg = *(const f32x4*)(g2 + 256 * j + 4 * lane); v[u][j] = v[u][j] + gg * acc4[j]; }
                    if (l + 1 < DEPTH) {
                        store_row_x(X, (size_t)rw_, lane, v[u]);
                        if (!(l + 1 == DEPTH - 1 && cx))
                            norm_mod_store_mix(((l + 1) & 1) ? (FP8_CONV != 0) : (FP8_ATT != 0), v[u], gn, mvn + rb * 6144 + 1024, mvn + rb * 6144, lane, H + (size_t)rw_ * D, WSP(unsigned char, WS_H8) + (size_t)rw_ * 1024);
                    } else {
                        float rstd = row_rstd(v[u]); if (PROBE_T) rstd *= 1.f + sqrtf(WSP(float, WS_MISC)[16]); float* op = OUTP() + ((size_t)row_batch(rw_) * SEQ + (rw_ % RPB - CTXL)) * D;
#pragma unroll
                        for (int j = 0; j < 4; ++j) { const f32x4 gg = *(const f32x4*)(gn + 256 * j + 4 * lane); *(f32x4*)(op + 256 * j + 4 * lane) = (v[u][j] * rstd) * gg; }
                    }
                }
            }
        }
        if (l + 1 < DEPTH) SEAM(pb + 6);
    }
#undef IN
#undef SEAM
#undef MV
}

extern "C" void kernel_launch(void* const* d_in, const int* in_sizes, int n_in, void* d_out, int out_size, void* d_ws, size_t ws_size, hipStream_t stream) {
    static int grid = 0;
    if (grid == 0) {
        if (n_in != 21 || out_size != NB * SEQ * D || ws_size < WS_END) { fprintf(stderr, "kernel_launch: unexpected shapes (n_in %d, out %d, ws %zu)\n", n_in, out_size, ws_size); grid = -1; return; }
        int dev = 0, cus = 0, per_cu = 0;
        if (hipGetDevice(&dev) != hipSuccess || hipDeviceGetAttribute(&cus, hipDeviceAttributeMultiprocessorCount, dev) != hipSuccess) { grid = -1; return; }
        if (hipFuncSetAttribute((const void*)fwd, hipFuncAttributeMaxDynamicSharedMemorySize, LDS_BYTES) != hipSuccess) { fprintf(stderr, "kernel_launch: hipFuncSetAttribute failed\n"); grid = -1; return; }
        if (hipOccupancyMaxActiveBlocksPerMultiprocessor(&per_cu, (const void*)fwd, NTHREADS, LDS_BYTES) != hipSuccess || per_cu < 1) { fprintf(stderr, "kernel_launch: occupancy query says %d\n", per_cu); }
        (void)hipGetLastError();
        if (cus < 160) { fprintf(stderr, "kernel_launch: needs >= 160 CUs\n"); grid = -1; return; }
        grid = cus;
    }
    if (grid < 0) return;
    if (hipMemsetAsync((char*)d_ws + WS_CTL, 0, CTL_ZERO_BYTES, stream) != hipSuccess) return;
    Args a{};
    for (int i = 0; i < 21; ++i) a.in[i] = (const float*)d_in[i];
    a.out = (float*)d_out; a.ws = (unsigned char*)d_ws;
#if MK_PER_PHASE
    for (int p = 0; p < NPHASE; ++p) { a.ph_lo = p; a.ph_hi = p + 1; hipLaunchKernelGGL(fwd, dim3(grid), dim3(NTHREADS), LDS_BYTES, stream, a); }
#else
    a.ph_lo = 0; a.ph_hi = NPHASE;
    hipLaunchKernelGGL(fwd, dim3(grid), dim3(NTHREADS), LDS_BYTES, stream, a);
#endif
    const hipError_t le = hipPeekAtLastError();
    if (le != hipSuccess) fprintf(stderr, "kernel_launch: launch failed: %s\n", hipGetErrorName(le));
}
```

```cpp
#include <hip/hip_runtime.h>
#include <cstdio>
#include <cstdint>

#ifndef MK_PER_PHASE
#define MK_PER_PHASE 0
#endif

#ifndef MOE_FP8
#define MOE_FP8 1
#endif
#ifndef STAGGER
#define STAGGER 0
#endif
#define STAG(t) (STAGGER ? (t) : 0)
#ifndef PROBE_T
#define PROBE_T 0
#endif
#ifndef PROBE_TQ
#define PROBE_TQ 30.f
#endif
#ifndef ATT_PROBE_TID
#define ATT_PROBE_TID 0
#endif
#ifndef PROBE_BID
#define PROBE_BID 0
#endif
#ifndef PROBE_TPH
#define PROBE_TPH 8
#endif
#ifndef FP8_ATT
#define FP8_ATT 1
#endif
#ifndef FP8_ATT_O
#define FP8_ATT_O 1
#endif
#ifndef FP8_WOUT
#define FP8_WOUT 1
#endif
#ifndef FP8_CONV
#define FP8_CONV 0
#endif
#ifndef X_BF16
#define X_BF16 1
#endif
#ifndef Y_FP8
#define Y_FP8 1
#endif
#ifndef CONV_FUSE_U
#define CONV_FUSE_U 1
#endif
#ifndef ATT_FP8
#define ATT_FP8 1
#endif
#ifndef PHSEL
#define PHSEL 0xffff
#endif
#define PS(k) ((PHSEL >> (k)) & 1)
#ifndef PROBE_REP
#define MOE_XCD_RANGE 1
#define PROBE_REP 0
#endif
#define NREP(k) (1 + ((PROBE_REP >> (k)) & 1))
#ifndef PROBE_NOST
#define PROBE_NOST 0
#endif
#define GAS __attribute__((address_space(1)))
#define LAS __attribute__((address_space(3)))
typedef unsigned short bf16;
typedef short bf16x8 __attribute__((ext_vector_type(8)));
typedef float f32x4 __attribute__((ext_vector_type(4)));
typedef float f32x2 __attribute__((ext_vector_type(2)));
typedef float f32x16 __attribute__((ext_vector_type(16)));
typedef unsigned u32x4 __attribute__((ext_vector_type(4)));
typedef unsigned u32x2 __attribute__((ext_vector_type(2)));
typedef GAS unsigned gu32;

constexpr int D = 1024, NB = 16, SEQ = 2048, CTXL = 256, RPB = SEQ + CTXL, M = NB * RPB, DEPTH = 4;
constexpr int NE = 32, TOPK = 4, NMOD = 6;
constexpr int CAP = M;
constexpr int ACT_ROWS = M * TOPK + NE * 256;
constexpr float EPS = 1e-5f;
constexpr float C2 = 0.125f * 1.4426950408889634f;
constexpr int NPHASE = 2 + 7 * DEPTH;
static_assert(!(FP8_CONV && CONV_FUSE_U), "the fused u epilogue needs the (bf16) interleaved copy of conv_w_in");

constexpr size_t MiB = 1u << 20;
constexpr size_t WS_CTL = 0, CTL_ZERO_BYTES = 1 * MiB;
constexpr size_t WS_MODV = 1 * MiB;
constexpr size_t WS_ROPE = 3 * MiB;
constexpr size_t WS_RW = 4 * MiB;
constexpr size_t WS_MISC = 5 * MiB;
constexpr size_t WS_TOPE = 6 * MiB;
constexpr size_t WS_TOPG = 7 * MiB;
constexpr size_t WS_TOPP = 8 * MiB;
constexpr size_t WS_LIST = 9 * MiB;
constexpr size_t WS_WQKV = 16 * MiB;
constexpr size_t WS_WIN = 28 * MiB;
constexpr size_t WS_WO = 40 * MiB;
constexpr size_t WS_WOUT = 44 * MiB;
constexpr size_t WS_WGU = 48 * MiB;
constexpr size_t WS_WD = 560 * MiB;
constexpr size_t WS_X = 816 * MiB;
constexpr size_t WS_H = 960 * MiB;
constexpr size_t WS_Q = 1032 * MiB;
constexpr size_t WS_K = 1104 * MiB;
constexpr size_t WS_VT = 1176 * MiB;
constexpr size_t WS_BCO = WS_Q;
constexpr size_t WS_O = 1248 * MiB;
constexpr size_t WS_ACT = 1320 * MiB;
constexpr size_t WS_Y = 1624 * MiB;
constexpr size_t WS_H8 = 1928 * MiB;
constexpr size_t WS_END = 1964 * MiB;
static_assert((size_t)M * 3072 * 2 == 216 * MiB && (size_t)ACT_ROWS * 2048 == 304 * MiB && (size_t)M * 4096 == 144 * MiB, "ws map");

constexpr int CW_TMO = 0;
constexpr int CW_BAR = 4096;
constexpr int CW_CNT = 16384;

constexpr int RING_BYTES = 131072;
constexpr int LX = RING_BYTES;
constexpr int LX_MISC = LX + 0;
constexpr int LX_TSTART = LX + 256;
constexpr int LX_ECNT = LX + 512;
constexpr int LX_LCNT = LX + 640;
constexpr int LX_LBASE = LX + 768;
constexpr int LX_TILEE = LX + 1024;
constexpr int LX_WSC = LX + 4096;
constexpr int LX_ASG = LX + 12288;
constexpr int LX_EPI = LX + 16384;
constexpr int LDS_BYTES = LX + 32768;
constexpr int NWAVES = 8, NTHREADS = 512;

#define RLX_AGENT __ATOMIC_RELAXED, __HIP_MEMORY_SCOPE_AGENT
__device__ __forceinline__ unsigned f2bf(float f) { unsigned u = __builtin_bit_cast(unsigned, f); return (u + 0x7fffu + ((u >> 16) & 1u)) >> 16; }
typedef __bf16 bf16x2_t __attribute__((ext_vector_type(2)));
__device__ __forceinline__ unsigned cvt_pk_bf16(float lo, float hi) { const f32x2 v = {lo, hi}; const bf16x2_t b = __builtin_convertvector(v, bf16x2_t); return __builtin_bit_cast(unsigned, b); }
__device__ __forceinline__ float bf2f(unsigned short b) { return __builtin_bit_cast(float, (unsigned)b << 16); }
__device__ __forceinline__ float wave_sum(float v) {
    v += __builtin_bit_cast(float, __builtin_amdgcn_update_dpp(0, __builtin_bit_cast(int, v), 0xB1, 0xF, 0xF, true));
    v += __builtin_bit_cast(float, __builtin_amdgcn_update_dpp(0, __builtin_bit_cast(int, v), 0x4E, 0xF, 0xF, true));
    v += __builtin_bit_cast(float, __builtin_amdgcn_update_dpp(0, __builtin_bit_cast(int, v), 0x124, 0xF, 0xF, true));
    v += __builtin_bit_cast(float, __builtin_amdgcn_update_dpp(0, __builtin_bit_cast(int, v), 0x128, 0xF, 0xF, true));
    v += __shfl_xor(v, 16);
    auto rr = __builtin_amdgcn_permlane32_swap(__float_as_uint(v), __float_as_uint(v), false, false);
    return __uint_as_float(rr[0]) + __uint_as_float(rr[1]);
}

#define XB_TMO      128
#define XB_XCNT(j)  (256  + 64 * (j))
#define XB_XSUB(j)  (1280 + 64 * (j))
#define XB_XGEN(j)  (2304 + 64 * (j))
#define XB_TOP      3328
#define XB_TOPGEN   3392
#define XCD_BAR_WORDS 3456
#define XB_SPIN_CAP (1u << 18)
__device__ __forceinline__ unsigned xb_ld(unsigned* p)              { return __hip_atomic_load(p, __ATOMIC_RELAXED, __HIP_MEMORY_SCOPE_AGENT); }
__device__ __forceinline__ unsigned xb_add(unsigned* p, unsigned v) { return __hip_atomic_fetch_add(p, v, __ATOMIC_RELAXED, __HIP_MEMORY_SCOPE_AGENT); }
__device__ __forceinline__ unsigned xb_xcc_id() { return (unsigned)__builtin_amdgcn_s_getreg((3 << 11) | 20) & 0xFu; }
#define XB_SPIN(cond, bar) do { unsigned _sp = 0; while (cond) { __builtin_amdgcn_s_sleep(1); \
    if ((++_sp & 255u) == 0u) { if (xb_ld(&(bar)[XB_TMO])) break; if (_sp > XB_SPIN_CAP) { atomicAdd(&(bar)[XB_TMO], 1u); break; } } } } while (0)
struct XcdBarrier { unsigned* bar; unsigned x; volatile LAS unsigned* st; };
__device__ __forceinline__ XcdBarrier xcd_barrier_post(unsigned* bar, volatile LAS unsigned* st) {
    XcdBarrier b; b.bar = bar; b.x = xb_xcc_id(); b.st = st;
    if (threadIdx.x == 0) (void)xb_add(&bar[XB_XCNT(b.x)], 1u);
    return b;
}
__device__ __forceinline__ void xcd_barrier_complete(unsigned* bar, unsigned x, unsigned& nloc, unsigned& nx) {
    const unsigned G = gridDim.x * gridDim.y * gridDim.z;
    unsigned sum, cnt, mine, sp = 0u;
    for (;;) {
        sum = 0u; cnt = 0u; mine = 0u;
#pragma unroll
        for (unsigned j = 0; j < 16; ++j) { const unsigned c = xb_ld(&bar[XB_XCNT(j)]); sum += c; cnt += (c > 0u) ? 1u : 0u; mine = (j == x) ? c : mine; }
        if (sum == G) break;
        __builtin_amdgcn_s_sleep(1);
        if ((++sp & 255u) == 0u) { if (xb_ld(&bar[XB_TMO])) break; if (sp > XB_SPIN_CAP) { atomicAdd(&bar[XB_TMO], 1u); break; } }
    }
    nloc = mine > 0u ? mine : 1u; nx = cnt > 0u ? cnt : 1u;
}
__device__ __forceinline__ void xcd_barrier(const XcdBarrier& b) {
    asm volatile("s_waitcnt vmcnt(0)" ::: "memory");
    __syncthreads();
    if (threadIdx.x == 0) {
        unsigned* bar = b.bar; unsigned bx = b.x;
        asm volatile("" : "+s"(bar), "+s"(bx));
        __builtin_amdgcn_s_waitcnt(0);
        unsigned nloc = b.st[0], nx = b.st[1];
        if (nloc == 0u) { xcd_barrier_complete(bar, bx, nloc, nx); b.st[0] = nloc; b.st[1] = nx; }
        const unsigned old = xb_add(&bar[XB_XSUB(bx)], 1u);
        const unsigned gen = old / nloc;
        if (old + 1u == (gen + 1u) * nloc) {
            __builtin_amdgcn_fence(__ATOMIC_RELEASE, "agent");
            asm volatile("s_waitcnt vmcnt(0)" ::: "memory");
            const unsigned og = xb_add(&bar[XB_TOP], 1u);
            const unsigned tg = og / nx;
            if (og + 1u == (tg + 1u) * nx) xb_add(&bar[XB_TOPGEN], 1u);
            else XB_SPIN(xb_ld(&bar[XB_TOPGEN]) == tg, bar);
            __builtin_amdgcn_fence(__ATOMIC_ACQUIRE, "agent");
            xb_add(&bar[XB_XGEN(bx)], 1u);
            asm volatile("s_waitcnt vmcnt(0)" ::: "memory");
        } else {
            XB_SPIN(xb_ld(&bar[XB_XGEN(bx)]) == gen, bar);
            __builtin_amdgcn_fence(__ATOMIC_ACQUIRE, "agent");
            asm volatile("s_waitcnt vmcnt(0)" ::: "memory");
        }
    }
    __syncthreads();
}

namespace pg8 {
constexpr int BM = 256, BK = 64, HALF = 128, HTB = HALF * BK * 2, STAGE_BYTES = 8 * HTB, KD = 1024;
__host__ __device__ __forceinline__ int lds_byte(int r, int c) { const int st = (r >> 4) * 2 + (c >> 5), rr = r & 15, cc = c & 31, ob = rr * 64 + cc * 2; return st * 1024 + (ob ^ (((ob >> 9) & 1) << 5)); }
__host__ __device__ __forceinline__ void stage_rc(int b, int& R, int& C) { const int st = b / 1024, sb = b % 1024, swz = sb ^ (((sb >> 9) & 1) << 5); R = (st >> 1) * 16 + swz / 64; C = (st & 1) * 32 + (swz % 64) / 2; }
__host__ __device__ __forceinline__ int perm32(int rho) { const int n = rho >> 4, i = rho & 15; return 8 * (i >> 2) + 4 * n + (i & 3); }

struct Unit { int pm, pn, e, kind; };
typedef int v8i __attribute__((ext_vector_type(8)));
typedef int v4i __attribute__((ext_vector_type(4)));
__device__ __forceinline__ v8i cat8(bf16x8 lo, bf16x8 hi) { const v4i a = __builtin_bit_cast(v4i, lo), b = __builtin_bit_cast(v4i, hi); return __builtin_shufflevector(a, b, 0, 1, 2, 3, 4, 5, 6, 7); }

__device__ __forceinline__ bool deal(int i, int npu, int ntiles, int& mt, int& r) {
    const int G = gridDim.x, c = blockIdx.x;
    if ((G & 7) == 0) { const int x = c & 7, q = i * (G >> 3) + (c >> 3); mt = (q / npu) * 8 + x; r = q % npu; }
    else { const int L = i * G + c; mt = L / npu; r = L % npu; }
    return mt < ntiles;
}

__device__ __forceinline__ void mfma8(f32x4& acc, const v8i a, const v8i b, int sc) {
    asm volatile("v_mfma_scale_f32_16x16x128_f8f6f4 %0, %1, %2, %0, %3, %3 op_sel_hi:[0,0,0]" : "+v"(acc) : "v"(a), "v"(b), "v"(sc)); }
__device__ __forceinline__ void glds16s(const char* sbase, unsigned voff, unsigned lds_dst) { unsigned keep;
    asm volatile("s_mov_b32 %0, m0\n\ts_mov_b32 m0, %3\n\ts_nop 0\n\tglobal_load_lds_dwordx4 %1, %2\n\ts_mov_b32 m0, %0" : "=&s"(keep) : "v"(voff), "s"(sbase), "s"(lds_dst) : "memory"); }
template <class Epi, class Sched, int PH = 0>
__device__ __forceinline__ void gemm_phase(LAS unsigned char* lds, const Sched& S, const Epi& E, const int tid, const int stagger_ticks = 0) {
    const int wid = __builtin_amdgcn_readfirstlane(tid >> 6), lane = tid & 63, wr = wid >> 2, wc = wid & 3, fr = lane & 15, fq = lane >> 4;
    constexpr int RB = Sched::RB, nt = RB / 128;
    constexpr bool F8 = (RB == 1024);
    unsigned voffB[2];
#pragma unroll
    for (int i = 0; i < 2; ++i) { int R_, C_; stage_rc(tid * 16 + i * 8192, R_, C_); const int Rb = (R_ & ~31) + perm32(R_ & 31); voffB[i] = (unsigned)(Rb * RB + C_ * 2); }
    constexpr bool GA = Sched::GATHER;
    constexpr int NH = GA ? 2 : 1;
    constexpr size_t kstep = (size_t)(BK * 2);
    constexpr size_t hstep = (size_t)HALF * RB, bstep = hstep;
    const unsigned ldsw = (unsigned)wid * 1024u, lds0 = (unsigned)(uintptr_t)lds;
    const int aoff = lds_byte(wr * 64 + fr, fq * 8), boff = lds_byte(wc * 32 + fr, fq * 8);
#define PG8_SA(b, h) (((b) * 2 + (h)) * HTB)
#define PG8_SB(b, h) ((4 + (b) * 2 + (h)) * HTB)
#define PG8_STAGE(bufoff, gbase, voff) do { _Pragma("unroll") for (int _i = 0; _i < 2; ++_i) \
        glds16s((const char*)(gbase), (voff)[_i], (unsigned)__builtin_amdgcn_readfirstlane(lds0 + (unsigned)(bufoff) + ldsw + _i * 8192u)); } while (0)
#define PG8_LDA(dst, b, h) do { _Pragma("unroll") for (int m = 0; m < 4; ++m) _Pragma("unroll") for (int k = 0; k < 2; ++k) dst[m][k] = *(const LAS bf16x8*)(lds + PG8_SA(b, h) + aoff + m * 2048 + k * 1024); } while (0)
#define PG8_LDB(dst, b, h) do { _Pragma("unroll") for (int n = 0; n < 2; ++n) _Pragma("unroll") for (int k = 0; k < 2; ++k) dst[n][k] = *(const LAS bf16x8*)(lds + PG8_SB(b, h) + boff + n * 2048 + k * 1024); } while (0)
#define PG8_MMA(ai, bj, At, Bt) do { __builtin_amdgcn_s_setprio(1); _Pragma("unroll") for (int m = 0; m < 4; ++m) _Pragma("unroll") for (int n = 0; n < 2; ++n) { \
        if constexpr (F8) mfma8(acc[ai][bj][m][n], cat8(Bt[n][0], Bt[n][1]), cat8(At[m][0], At[m][1]), sc8); \
        else { _Pragma("unroll") for (int k = 0; k < 2; ++k) acc[ai][bj][m][n] = __builtin_amdgcn_mfma_f32_16x16x32_bf16(Bt[n][k], At[m][k], acc[ai][bj][m][n], 0, 0, 0); } } __builtin_amdgcn_s_setprio(0); } while (0)
#define PG8_WAIT_V(n) asm volatile("s_waitcnt vmcnt(" #n ")" ::: "memory")
#define PG8_WAIT_VF do { if (fe) { if constexpr (Epi::NST == 16 && !PROBE_NOST) PG8_WAIT_V(24); else if constexpr (Epi::NST == 4 && !PROBE_NOST) PG8_WAIT_V(12); else if constexpr (Epi::NST == 8 && !PROBE_NOST) PG8_WAIT_V(16); else PG8_WAIT_V(8); } else PG8_WAIT_V(8); } while (0)
#define PG8_WAIT_L(n) asm volatile("s_waitcnt lgkmcnt(" #n ")" ::: "memory")
#define PG8_BAR __builtin_amdgcn_s_barrier()
#define PG8_SCHED __builtin_amdgcn_sched_barrier(0)
    Unit cur, nxt; int ui = 0;
    if (!S.next(0, cur)) return;
#define PT_ON(r) (PROBE_T == (r) && PH == PROBE_TPH)
#define PT_BEG(r) do { if (PT_ON(r)) pt0_ = __builtin_amdgcn_s_memtime(); } while (0)
#define PT_END(r) do { if (PT_ON(r)) { const unsigned long long d_ = __builtin_amdgcn_s_memtime() - pt0_; if (blockIdx.x == 0 && tid == 0) *(LAS unsigned long long*)(lds + LX_MISC + 64) += d_; } } while (0)
    unsigned long long pt0_ = 0; (void)pt0_;
    PT_BEG(3);
    if (stagger_ticks > 0 && (int)(blockIdx.x >> 3) >= (int)(gridDim.x >> 4)) { const unsigned long long t0_ = __builtin_amdgcn_s_memrealtime(); while ((long long)(__builtin_amdgcn_s_memrealtime() - t0_) < (long long)stagger_ticks) __builtin_amdgcn_s_sleep(16); }
    static_assert(Sched::SCALE_A == Sched::SCALE_B, "one scale register");
    int sc8 = Sched::SCALE_A; asm volatile("" : "+v"(sc8));
    f32x4 acc[2][2][4][2];
#pragma unroll
    for (int a = 0; a < 2; ++a)
#pragma unroll
        for (int b = 0; b < 2; ++b)
#pragma unroll
            for (int m = 0; m < 4; ++m)
#pragma unroll
                for (int n = 0; n < 2; ++n) acc[a][b][m][n] = (f32x4){0.f, 0.f, 0.f, 0.f};
    bf16x8 At[4][2], B0[2][2], B1[2][2];
    constexpr int NI = GA ? 1 : 2;
    unsigned vC[NH][NI], vN[NH][NI];
    unsigned cb2[2];
#pragma unroll
    for (int i = 0; i < 2; ++i) { int R_, C_; stage_rc(tid * 16 + i * 8192, R_, C_); cb2[i] = (unsigned)(C_ * 2); }
    const unsigned idx_slot = (unsigned)__builtin_amdgcn_readfirstlane((unsigned)(uintptr_t)(lds + LX_WSC) + (unsigned)wid * 1024u);
    if constexpr (GA) { S.idx_dma(cur, lane, idx_slot); asm volatile("s_waitcnt vmcnt(0)" ::: "memory"); S.a_offs_lds(cur, tid, vC, (LAS const int*)(lds + LX_WSC + wid * 1024)); }
    else S.a_offs(cur, tid, vC);
    const unsigned bias_slot0 = (unsigned)(uintptr_t)(lds + LX_ASG);
    if constexpr (Epi::BIAS_DMA) { Unit n1_; const bool h1_ = S.next(1, n1_);
        if (wid == 0) { glds16s((const char*)E.bias_src(cur), (unsigned)lane * 16u, (unsigned)__builtin_amdgcn_readfirstlane(bias_slot0));
            if (h1_) glds16s((const char*)E.bias_src(n1_), (unsigned)lane * 16u, (unsigned)__builtin_amdgcn_readfirstlane(bias_slot0 + 1024u)); } }
    auto acc_init = [&](int slot) {
        if constexpr (Epi::BIAS_DMA) { int fq2 = fq; asm volatile("" : "+v"(fq2)); LAS const float* bl_ = (LAS const float*)(lds + LX_ASG + slot * 1024); f32x4 bv_[2][2];
            _Pragma("unroll") for (int bj = 0; bj < 2; ++bj) { const int col = bj * 128 + wc * 32 + fq2 * 8; bv_[bj][0] = *(const LAS f32x4*)(bl_ + col); bv_[bj][1] = *(const LAS f32x4*)(bl_ + col + 4);
                if constexpr (Epi::BIAS_MUL != 1.f) { bv_[bj][0] *= Epi::BIAS_MUL; bv_[bj][1] *= Epi::BIAS_MUL; }
                if constexpr (Epi::GATE_COLS) { bv_[bj][0][0] *= Epi::GATE_MUL; bv_[bj][0][2] *= Epi::GATE_MUL; bv_[bj][1][0] *= Epi::GATE_MUL; bv_[bj][1][2] *= Epi::GATE_MUL; } }
            _Pragma("unroll") for (int a = 0; a < 2; ++a) _Pragma("unroll") for (int b = 0; b < 2; ++b) _Pragma("unroll") for (int m = 0; m < 4; ++m) _Pragma("unroll") for (int n = 0; n < 2; ++n) acc[a][b][m][n] = bv_[b][n]; }
        else { _Pragma("unroll") for (int a = 0; a < 2; ++a) _Pragma("unroll") for (int b = 0; b < 2; ++b) _Pragma("unroll") for (int m = 0; m < 4; ++m) _Pragma("unroll") for (int n = 0; n < 2; ++n) acc[a][b][m][n] = (f32x4){0.f, 0.f, 0.f, 0.f}; } };
#define PG8_HA(h) (GA ? 0 : (h) * hstep)
#define PG8_VH(v, h) (v)[GA ? (h) : 0]
#define PG8_STAGE_A(bufoff, gbase, vv) do { _Pragma("unroll") for (int _i = 0; _i < 2; ++_i) { unsigned o_; if constexpr (GA) o_ = (((vv)[0] >> (16 * _i)) & 0xffffu) * (unsigned)RB + cb2[_i]; else o_ = (vv)[NI - 2 + _i]; \
        glds16s((const char*)(gbase), o_, (unsigned)__builtin_amdgcn_readfirstlane(lds0 + (unsigned)(bufoff) + ldsw + _i * 8192u)); } } while (0)
    const char* cA = S.a_base(cur); const char* cB = S.b_base(cur);
    PG8_STAGE(PG8_SB(0, 0), cB, voffB); PG8_STAGE(PG8_SB(0, 1), cB + bstep, voffB); PG8_STAGE_A(PG8_SA(0, 0), cA, vC[0]); PG8_STAGE_A(PG8_SA(0, 1), cA + PG8_HA(1), PG8_VH(vC, 1));
    if (wr == 1) PG8_BAR;
    PG8_WAIT_V(2); PG8_BAR;
    PG8_STAGE(PG8_SB(1, 0), cB + kstep, voffB); PG8_STAGE_A(PG8_SA(1, 0), cA + kstep, vC[0]); PG8_STAGE(PG8_SB(1, 1), cB + bstep + kstep, voffB);
    PG8_WAIT_V(6); PG8_BAR;
    if constexpr (Epi::BIAS_DMA) acc_init(0);
    for (;;) {
        const bool has_next = S.next(ui + 1, nxt);
        const char* nA = cA; const char* nB = cB;
#pragma unroll
        for (int h = 0; h < NH; ++h)
#pragma unroll
            for (int i = 0; i < NI; ++i) vN[h][i] = vC[h][i];
        if (has_next) { if constexpr (GA) S.idx_dma(nxt, lane, idx_slot); else S.a_offs(nxt, tid, vN); nA = S.a_base(nxt); nB = S.b_base(nxt); }
        if constexpr (Epi::BIAS_DMA) { if (ui > 0 && has_next && wid == 0) glds16s((const char*)E.bias_src(nxt), (unsigned)lane * 16u, (unsigned)__builtin_amdgcn_readfirstlane(bias_slot0 + (unsigned)((ui + 1) & 1) * 1024u)); }
        PT_BEG(2);
#pragma unroll 1
        for (int t = 0; t < nt; t += 2) {
            const bool last = (t == nt - 2);
            const char* a1 = cA + (size_t)(t + 1) * kstep;
            const char* a2 = last ? nA : cA + (size_t)(t + 2) * kstep; const char* b2 = last ? nB : cB + (size_t)(t + 2) * kstep;
            const char* a3 = a2 + kstep; const char* b3 = b2 + kstep;
            if constexpr (GA) { if (last && has_next) S.a_offs_lds(nxt, tid, vN, (LAS const int*)(lds + LX_WSC + wid * 1024)); }
            unsigned w0[NI], w1[NI];
#pragma unroll
            for (int i = 0; i < NI; ++i) { w0[i] = last ? vN[0][i] : vC[0][i]; w1[i] = last ? PG8_VH(vN, 1)[i] : PG8_VH(vC, 1)[i]; }
            const bool fe = (t == 0) && (ui > 0);
            PG8_LDB(B0, 0, 0); PG8_LDB(B1, 0, 1); PG8_SCHED; PG8_LDA(At, 0, 0); if (!fe) PG8_STAGE_A(PG8_SA(1, 1), a1 + PG8_HA(1), PG8_VH(vC, 1));
            PG8_WAIT_VF; PG8_WAIT_L(0); PG8_BAR; PG8_MMA(0, 0, At, B0); PG8_MMA(0, 1, At, B1); PG8_BAR; PG8_SCHED;
            PG8_LDA(At, 0, 1); PG8_STAGE(PG8_SB(0, 0), b2, voffB); PG8_STAGE(PG8_SB(0, 1), b2 + bstep, voffB); PG8_STAGE_A(PG8_SA(0, 0), a2, w0);
            PG8_WAIT_VF; PG8_WAIT_L(0); PG8_BAR; PG8_MMA(1, 0, At, B0); PG8_MMA(1, 1, At, B1); PG8_BAR; PG8_SCHED;
            PG8_LDB(B0, 1, 0); PG8_LDB(B1, 1, 1); PG8_SCHED; PG8_LDA(At, 1, 0); PG8_STAGE_A(PG8_SA(0, 1), a2 + PG8_HA(1), w1);
            PG8_WAIT_VF; PG8_WAIT_L(0); PG8_BAR; PG8_MMA(0, 0, At, B0); PG8_MMA(0, 1, At, B1); PG8_BAR; PG8_SCHED;
            PG8_LDA(At, 1, 1); PG8_STAGE(PG8_SB(1, 0), b3, voffB); PG8_STAGE(PG8_SB(1, 1), b3 + bstep, voffB); PG8_STAGE_A(PG8_SA(1, 0), a3, w0);
            PG8_WAIT_V(8); PG8_WAIT_L(0); PG8_BAR; PG8_MMA(1, 0, At, B0); PG8_MMA(1, 1, At, B1); PG8_BAR; PG8_SCHED;
        }
        PT_END(2);
        if (has_next) PG8_STAGE_A(PG8_SA(1, 1), nA + kstep + PG8_HA(1), PG8_VH(vN, 1));
        if (wr == 0) PG8_BAR;
        PT_BEG(1);
        if constexpr (Epi::BIAS_DMA) E(acc, cur, wr, wc, fr, fq, (LAS const float*)(lds + LX_ASG + (ui & 1) * 1024)); else E(acc, cur, wr, wc, fr, fq);
        PT_END(1);
        if (!has_next) break;
        acc_init((ui + 1) & 1);
        cur = nxt; cA = nA; cB = nB; ++ui;
#pragma unroll
        for (int h = 0; h < NH; ++h)
#pragma unroll
            for (int i = 0; i < NI; ++i) vC[h][i] = vN[h][i];
        if (wr == 1) PG8_BAR;
    }
    PG8_WAIT_V(0);
    PG8_BAR;
    PT_END(3);
#undef PT_ON
#undef PT_BEG
#undef PT_END
#undef PG8_SA
#undef PG8_HA
#undef PG8_VH
#undef PG8_SB
#undef PG8_STAGE
#undef PG8_STAGE_A
#undef PG8_LDA
#undef PG8_LDB
#undef PG8_MMA
#undef PG8_WAIT_V
#undef PG8_WAIT_VF
#undef PG8_WAIT_L
#undef PG8_BAR
#undef PG8_SCHED
}
}
using pg8::Unit;

__device__ __forceinline__ int tile_row0(int mt, bool lat_only) { return lat_only ? ((mt >> 3) * 9 + 1 + (mt & 7)) * 256 : mt * 256; }

template <int RB_, int SC_> struct SchedQKV {
    static constexpr int RB = RB_, SCALE_A = SC_, SCALE_B = SC_;
    const char* H; const char* Wt;
    __device__ __forceinline__ bool next(int i, Unit& u) const { int mt, r; if (!pg8::deal(i, 12, M / 256, mt, r)) return false;
        if (r < 8) { u.kind = 0; u.pm = mt; u.pn = r; } else { u.kind = 1; u.pm = r - 8; u.pn = mt; } u.e = 0; return true; }
    static constexpr bool GATHER = false;
    __device__ __forceinline__ void a_offs(const Unit& u, int tid, unsigned (&v)[1][2]) const {
#pragma unroll
        for (int i = 0; i < 2; ++i) { int R, C; pg8::stage_rc(tid * 16 + i * 8192, R, C); v[0][i] = (unsigned)((u.pm * 256 + R) * RB + C * 2); } }
    __device__ __forceinline__ const char* a_base(const Unit& u) const { return u.kind == 0 ? H : Wt + (size_t)2048 * RB; }
    __device__ __forceinline__ const char* b_base(const Unit& u) const { return (u.kind == 0 ? Wt : H) + (size_t)u.pn * 256 * RB; }
};
template <int RB_, int SC_> struct SchedPlain {
    static constexpr int RB = RB_, SCALE_A = SC_, SCALE_B = SC_;
    const char* A; const char* Bt; int npu; bool lat_only;
    __device__ __forceinline__ bool next(int i, Unit& u) const { int mt, r; if (!pg8::deal(i, npu, lat_only ? 128 : 144, mt, r)) return false;
        u.pm = tile_row0(mt, lat_only) >> 8; u.pn = r; u.e = 0; u.kind = 0; return true; }
    static constexpr bool GATHER = false;
    __device__ __forceinline__ void a_offs(const Unit& u, int tid, unsigned (&v)[1][2]) const {
#pragma unroll
        for (int i = 0; i < 2; ++i) { int R, C; pg8::stage_rc(tid * 16 + i * 8192, R, C); v[0][i] = (unsigned)((u.pm * 256 + R) * RB + C * 2); } }
    __device__ __forceinline__ const char* a_base(const Unit&) const { return A; }
    __device__ __forceinline__ const char* b_base(const Unit& u) const { return Bt + (size_t)u.pn * 256 * RB; }
};
template <bool GATHER_, int RB_, int SA_, int SB_> struct SchedMoe {
    static constexpr bool GATHER = GATHER_;
    static constexpr int RB = RB_, SCALE_A = SA_, SCALE_B = SB_;
    const char* A; const char* Wt; const int* list; int npu; size_t estride;
    LAS const int* tstart; LAS const int* ecnt; LAS const int* tile_e;
    __device__ __forceinline__ bool mdeal(int i, int ntl, int& mt, int& r) const {
        const int G = gridDim.x, c = blockIdx.x;
        if (MOE_XCD_RANGE && (G & 7) == 0) { const int x = c & 7, q = i * (G >> 3) + (c >> 3); const int lo = (x * ntl) >> 3, hi = ((x + 1) * ntl) >> 3; mt = lo + q / npu; r = q % npu; return mt < hi; }
        return pg8::deal(i, npu, ntl, mt, r); }
    __device__ __forceinline__ bool next(int i, Unit& u) const { int mt, r; const int ntl = __builtin_amdgcn_readfirstlane(tstart[32]);
        int xp = 0;
        if (!mdeal(i, ntl, mt, r)) { if (!(PROBE_REP & (GATHER_ ? 0x100 : 0x200))) return false; int n_i = 0; while (mdeal(n_i, ntl, mt, r)) ++n_i; if (i >= 2 * n_i || !mdeal(i - n_i, ntl, mt, r)) return false; xp = 1; }
        u.pm = mt; u.pn = r; u.e = __builtin_amdgcn_readfirstlane(tile_e[mt]); u.kind = xp; return true; }
    __device__ __forceinline__ void idx_dma(const Unit& u, int lane, unsigned slot) const {
        const int j0 = (u.pm - __builtin_amdgcn_readfirstlane(tstart[u.e])) * 256;
        pg8::glds16s((const char*)(list + (size_t)u.e * CAP + j0), (unsigned)lane * 16u, slot); }
    __device__ __forceinline__ void a_offs_lds(const Unit& u, int tid, unsigned (&v)[2][1], LAS const int* slot) const {
        const int j0 = (u.pm - __builtin_amdgcn_readfirstlane(tstart[u.e])) * 256, cnt = __builtin_amdgcn_readfirstlane(ecnt[u.e]);
#pragma unroll
        for (int h = 0; h < 2; ++h) { unsigned pk = 0;
#pragma unroll
            for (int i = 0; i < 2; ++i) { int R, C; pg8::stage_rc(tid * 16 + i * 8192, R, C); const int r = h * 128 + R; const unsigned tok = (j0 + r) < cnt ? (unsigned)slot[r] : 0u; pk |= tok << (16 * i); }
            v[h][0] = pk; }
    }
    __device__ __forceinline__ void a_offs(const Unit& u, int tid, unsigned (&v)[GATHER_ ? 2 : 1][GATHER_ ? 1 : 2]) const {
        if constexpr (GATHER_) { const int j0 = (u.pm - __builtin_amdgcn_readfirstlane(tstart[u.e])) * 256, cnt = __builtin_amdgcn_readfirstlane(ecnt[u.e]); const int* lp = list + (size_t)u.e * CAP;
#pragma unroll
            for (int h = 0; h < 2; ++h) { unsigned pk = 0;
#pragma unroll
                for (int i = 0; i < 2; ++i) { int R, C; pg8::stage_rc(tid * 16 + i * 8192, R, C); const int idx = j0 + h * 128 + R; const unsigned tok = idx < cnt ? (unsigned)lp[idx] : 0u; pk |= tok << (16 * i); }
                v[h][0] = pk; }
        } else {
#pragma unroll
            for (int i = 0; i < 2; ++i) { int R, C; pg8::stage_rc(tid * 16 + i * 8192, R, C); v[0][i] = (unsigned)((u.pm * 256 + R) * RB + C * 2); } }
    }
    __device__ __forceinline__ const char* a_base(const Unit&) const { return A; }
    __device__ __forceinline__ const char* b_base(const Unit& u) const { return Wt + (size_t)u.e * estride + (size_t)u.pn * 256 * RB; }
};

#define EPI_LOOP_ROWS for (int ai = 0; ai < 2; ++ai) _Pragma("unroll") for (int m = 0; m < 4; ++m)
__device__ __forceinline__ u32x4 pack8(const f32x4& v0, const f32x4& v1) { u32x4 w; w.x = cvt_pk_bf16(v0[0], v0[1]); w.y = cvt_pk_bf16(v0[2], v0[3]); w.z = cvt_pk_bf16(v1[0], v1[1]); w.w = cvt_pk_bf16(v1[2], v1[3]); return w; }

__device__ __forceinline__ float clamp8(float v) { return __builtin_amdgcn_fmed3f(v, -448.f, 448.f); }
__device__ __forceinline__ unsigned pack_fp8x4(float a, float b, float c, float d) {
    const float ca = clamp8(a); int w = __builtin_bit_cast(int, ca);
    w = __builtin_amdgcn_cvt_pk_fp8_f32(ca, clamp8(b), w, false); w = __builtin_amdgcn_cvt_pk_fp8_f32(clamp8(c), clamp8(d), w, true); return (unsigned)w; }
struct EpiQKV {
    static constexpr bool BIAS_DMA = false;
    static constexpr int NST = ATT_FP8 ? 8 : 16;
    bf16* Q; bf16* Kb; bf16* Vt; const float* cosT; const float* sinT; bool dost; LAS unsigned char* stg;
    __device__ __forceinline__ void operator()(const f32x4 (&acc)[2][2][4][2], const Unit& u, int wr, int wc, int fr, int fq) const {
        asm volatile("" : "+v"(fr), "+v"(fq));
        if constexpr (ATT_FP8 != 0) {
            const bool isq = u.pn < 4, k0 = (u.kind == 0); const bool lat = k0 && (u.pm % 9) != 0;
            unsigned char* base8 = (unsigned char*)Q + (k0 ? (isq ? (size_t)0 : WS_K - WS_Q) : WS_VT - WS_Q); const size_t ld = k0 ? 1024 : (size_t)M; const int colbase = k0 ? (u.pn & 3) * 256 : u.pn * 256;
            const float sc = k0 ? (isq ? C2 * 64.f : 16.f) : 16.f;
            LAS unsigned char* sw = stg + (wr * 4 + wc) * 2048; const int lane = fq * 16 + fr; const int jp0 = 16 * (wc & 1) + 4 * fq;
#pragma unroll
            for (int ai = 0; ai < 2; ++ai) {
                f32x4 cs[4], sn[4];
#pragma unroll
                for (int m = 0; m < 4; ++m) { const int row = u.pm * 256 + ai * 128 + wr * 64 + m * 16 + fr; const int t = lat ? (row % RPB) - CTXL : 0;
                    const f32x4 cv = *(const f32x4*)(cosT + t * 32 + jp0), sv = *(const f32x4*)(cosT + 2048 * 32 + t * 32 + jp0);
#pragma unroll
                    for (int j = 0; j < 4; ++j) { cs[m][j] = lat ? cv[j] : 1.f; sn[m][j] = lat ? sv[j] : 0.f; } }
#pragma unroll
                for (int bj = 0; bj < 2; ++bj) {
#pragma unroll
                    for (int m = 0; m < 4; ++m) { const f32x4 a = acc[ai][bj][m][0], b = acc[ai][bj][m][1]; const f32x4 c_ = cs[m], s_ = sn[m];
                        u32x2 w8;
                        w8.x = pack_fp8x4((a[0] * c_[0] - a[1] * s_[0]) * sc, (a[1] * c_[0] + a[0] * s_[0]) * sc, (a[2] * c_[1] - a[3] * s_[1]) * sc, (a[3] * c_[1] + a[2] * s_[1]) * sc);
                        w8.y = pack_fp8x4((b[0] * c_[2] - b[1] * s_[2]) * sc, (b[1] * c_[2] + b[0] * s_[2]) * sc, (b[2] * c_[3] - b[3] * s_[3]) * sc, (b[3] * c_[3] + b[2] * s_[3]) * sc);
                        *(LAS u32x2*)(sw + (16 * m + fr) * 32 + ((fq ^ (((fr >> 2) & 1) << 1)) << 3)) = w8; }
                    asm volatile("s_waitcnt lgkmcnt(0)" ::: "memory");
#pragma unroll
                    for (int k = 0; k < 2; ++k) { const int p = lane + 64 * k, rr = p >> 1, hf = p & 1; const u32x4 v = *(const LAS u32x4*)(sw + rr * 32 + ((hf ^ ((rr >> 2) & 1)) << 4));
                        const int row = u.pm * 256 + ai * 128 + wr * 64 + rr; const int col = colbase + bj * 128 + wc * 32 + hf * 16;
                        if (dost) *(u32x4*)(base8 + (size_t)row * ld + col) = v; }
                    asm volatile("s_waitcnt lgkmcnt(0)" ::: "memory");
                }
            }
        } else if (u.kind == 0) {
            const bool isq = u.pn < 4; bf16* base = isq ? Q : Kb; const float sc = isq ? C2 : 1.f;
            const bool lat = (u.pm % 9) != 0;
#pragma unroll
            EPI_LOOP_ROWS { const int row = u.pm * 256 + ai * 128 + wr * 64 + m * 16 + fr; const int t = (row % RPB) - CTXL;
#pragma unroll
                for (int bj = 0; bj < 2; ++bj) { const f32x4 a = acc[ai][bj][m][0], b = acc[ai][bj][m][1]; f32x4 o0, o1;
                    f32x4 cs = {1.f, 1.f, 1.f, 1.f}, sn = {0.f, 0.f, 0.f, 0.f}; const int jp0 = 16 * (wc & 1) + 4 * fq;
                    if (lat) { cs = *(const f32x4*)(cosT + t * 32 + jp0); sn = *(const f32x4*)(sinT + t * 32 + jp0); }
                    o0[0] = (a[0] * cs[0] - a[1] * sn[0]) * sc; o0[1] = (a[1] * cs[0] + a[0] * sn[0]) * sc; o0[2] = (a[2] * cs[1] - a[3] * sn[1]) * sc; o0[3] = (a[3] * cs[1] + a[2] * sn[1]) * sc;
                    o1[0] = (b[0] * cs[2] - b[1] * sn[2]) * sc; o1[1] = (b[1] * cs[2] + b[0] * sn[2]) * sc; o1[2] = (b[2] * cs[3] - b[3] * sn[3]) * sc; o1[3] = (b[3] * cs[3] + b[2] * sn[3]) * sc;
                    const int col = (u.pn & 3) * 256 + bj * 128 + wc * 32 + fq * 8;
                    if (ATT_FP8) { const float s8 = isq ? 64.f : 16.f; u32x2 w8; w8.x = pack_fp8x4(s8 * o0[0], s8 * o0[1], s8 * o0[2], s8 * o0[3]); w8.y = pack_fp8x4(s8 * o1[0], s8 * o1[1], s8 * o1[2], s8 * o1[3]);
                        if (dost) *(u32x2*)((unsigned char*)base + (size_t)row * 1024 + col) = w8; }
                    else { const u32x4 pk_ = pack8(o0, o1); if (dost) *(u32x4*)(base + (size_t)row * 1024 + col) = pk_; } } }
        } else {
#pragma unroll
            EPI_LOOP_ROWS { const int row = u.pm * 256 + ai * 128 + wr * 64 + m * 16 + fr;
#pragma unroll
                for (int bj = 0; bj < 2; ++bj) { const int col = u.pn * 256 + bj * 128 + wc * 32 + fq * 8;
                    if (ATT_FP8) { const f32x4 a_ = acc[ai][bj][m][0], b_ = acc[ai][bj][m][1]; u32x2 w8; w8.x = pack_fp8x4(16.f * a_[0], 16.f * a_[1], 16.f * a_[2], 16.f * a_[3]); w8.y = pack_fp8x4(16.f * b_[0], 16.f * b_[1], 16.f * b_[2], 16.f * b_[3]);
                        if (dost) *(u32x2*)((unsigned char*)Vt + (size_t)row * M + col) = w8; }
                    else { const u32x4 pk_ = pack8(acc[ai][bj][m][0], acc[ai][bj][m][1]); if (dost) *(u32x4*)(Vt + (size_t)row * M + col) = pk_; } } }
        }
    }
};
struct EpiPlain {
    static constexpr bool BIAS_DMA = false;
    static constexpr int NST = 16;
    bf16* O; int ldc;
    __device__ __forceinline__ void operator()(const f32x4 (&acc)[2][2][4][2], const Unit& u, int wr, int wc, int fr, int fq) const {
        asm volatile("" : "+v"(fr), "+v"(fq));
#pragma unroll
        EPI_LOOP_ROWS { const int row = u.pm * 256 + ai * 128 + wr * 64 + m * 16 + fr;
#pragma unroll
            for (int bj = 0; bj < 2; ++bj) { const int col = u.pn * 256 + bj * 128 + wc * 32 + fq * 8;
                *(u32x4*)(O + (size_t)row * ldc + col) = pack8(acc[ai][bj][m][0], acc[ai][bj][m][1]); } }
    }
};
struct EpiConvIn {
    static constexpr bool BIAS_DMA = false;
    static constexpr int NST = 16;
    bf16* Bb; bf16* Ub;
    __device__ __forceinline__ void operator()(const f32x4 (&acc)[2][2][4][2], const Unit& u, int wr, int wc, int fr, int fq) const {
        asm volatile("" : "+v"(fr), "+v"(fq));
        if (u.pn < 4) {
#pragma unroll
            EPI_LOOP_ROWS { const int row = u.pm * 256 + ai * 128 + wr * 64 + m * 16 + fr;
#pragma unroll
                for (int bj = 0; bj < 2; ++bj) { const int col = u.pn * 256 + bj * 128 + wc * 32 + fq * 8;
                    *(u32x4*)(Bb + (size_t)row * 1024 + col) = pack8(acc[ai][bj][m][0], acc[ai][bj][m][1]); } }
        } else {
#pragma unroll
            EPI_LOOP_ROWS { const int row = u.pm * 256 + ai * 128 + wr * 64 + m * 16 + fr;
#pragma unroll
                for (int bj = 0; bj < 2; ++bj) { const f32x4 a = acc[ai][bj][m][0], b = acc[ai][bj][m][1]; const int col = (u.pn - 4) * 128 + bj * 64 + wc * 16 + fq * 4;
                    u32x2 w; w.x = cvt_pk_bf16(a[0] * a[1], a[2] * a[3]); w.y = cvt_pk_bf16(b[0] * b[1], b[2] * b[3]);
                    *(u32x2*)(Ub + (size_t)row * 1024 + col) = w; } }
        }
    }
};
struct EpiResid {
    static constexpr bool BIAS_DMA = false;
    static constexpr int NST = X_BF16 ? 16 : 0;
    const void* Xin; void* X; const float* gate;
    const float* in_x; const float* in_ctx;
    __device__ __forceinline__ void operator()(const f32x4 (&acc)[2][2][4][2], const Unit& u, int wr, int wc, int fr, int fq) const {
        asm volatile("" : "+v"(fr), "+v"(fq));
        const int rb = (u.pm % 9) == 0 ? 16 : u.pm / 9; const float* gp = gate + rb * 6144;
        f32x4 gv[2][2];
#pragma unroll
        for (int bj = 0; bj < 2; ++bj) { const int col = u.pn * 256 + bj * 128 + wc * 32 + fq * 8; gv[bj][0] = *(const f32x4*)(gp + col); gv[bj][1] = *(const f32x4*)(gp + col + 4); }
        if (X_BF16 && !in_x) {
#pragma unroll
            for (int ai = 0; ai < 2; ++ai) { u32x4 xw[4][2];
#pragma unroll
                for (int m = 0; m < 4; ++m)
#pragma unroll
                    for (int bj = 0; bj < 2; ++bj) xw[m][bj] = *(const u32x4*)((const bf16*)Xin + (size_t)(u.pm * 256 + ai * 128 + wr * 64 + m * 16 + fr) * 1024 + u.pn * 256 + bj * 128 + wc * 32 + fq * 8);
#pragma unroll
                for (int m = 0; m < 4; ++m)
#pragma unroll
                    for (int bj = 0; bj < 2; ++bj) { const u32x4 w = xw[m][bj];
                        const f32x4 x0 = {bf2f((unsigned short)(w.x & 0xffffu)), bf2f((unsigned short)(w.x >> 16)), bf2f((unsigned short)(w.y & 0xffffu)), bf2f((unsigned short)(w.y >> 16))};
                        const f32x4 x1 = {bf2f((unsigned short)(w.z & 0xffffu)), bf2f((unsigned short)(w.z >> 16)), bf2f((unsigned short)(w.w & 0xffffu)), bf2f((unsigned short)(w.w >> 16))};
                        *(u32x4*)((bf16*)X + (size_t)(u.pm * 256 + ai * 128 + wr * 64 + m * 16 + fr) * 1024 + u.pn * 256 + bj * 128 + wc * 32 + fq * 8) = pack8(x0 + gv[bj][0] * acc[ai][bj][m][0], x1 + gv[bj][1] * acc[ai][bj][m][1]); } }
        } else {
#pragma unroll
            EPI_LOOP_ROWS { const int row = u.pm * 256 + ai * 128 + wr * 64 + m * 16 + fr;
#pragma unroll
                for (int bj = 0; bj < 2; ++bj) { const int col = u.pn * 256 + bj * 128 + wc * 32 + fq * 8; const size_t o = (size_t)row * 1024 + col;
                    const float* xs = (const float*)Xin + o;
                    if (in_x) { const int b_ = u.pm / 9, jt_ = u.pm % 9; const size_t ro = (size_t)(row - u.pm * 256) * 1024 + col;
                        xs = jt_ == 0 ? in_ctx + (size_t)b_ * CTXL * 1024 + ro : in_x + ((size_t)b_ * SEQ + (jt_ - 1) * 256) * 1024 + ro; }
                    const f32x4 x0 = *(const f32x4*)(xs), x1 = *(const f32x4*)(xs + 4);
                    const f32x4 r0 = x0 + gv[bj][0] * acc[ai][bj][m][0], r1 = x1 + gv[bj][1] * acc[ai][bj][m][1];
                    if (X_BF16) *(u32x4*)((bf16*)X + o) = pack8(r0, r1);
                    else { *(f32x4*)((float*)X + o) = r0; *(f32x4*)((float*)X + o + 4) = r1; } } }
        }
    }
};
__device__ __forceinline__ float swiglu1(float g, float l) {
    g = fminf(g, 7.f); l = fminf(fmaxf(l, -7.f), 7.f);
    const float s = __builtin_amdgcn_rcpf(1.f + __builtin_amdgcn_exp2f(-1.702f * 1.4426950408889634f * g));
    return g * s * (l + 1.f);
}
constexpr float GATE_PRE = -1.702f * 1.4426950408889634f;
__device__ __forceinline__ float swiglu4(float t, float l) {
    t = __builtin_amdgcn_fmed3f(t, 7.f * GATE_PRE, 3.0e38f); l = __builtin_amdgcn_fmed3f(l, -7.f, 7.f);
    const float r = __builtin_amdgcn_rcpf(1.f + __builtin_amdgcn_exp2f(t));
    return (t * r) * __builtin_fmaf(l, 4.f / GATE_PRE, 4.f / GATE_PRE);
}
template <bool F8> struct EpiSwiglu {
    static constexpr bool BIAS_DMA = true, GATE_COLS = F8; static constexpr float GATE_MUL = -1.702f * 1.4426950408889634f, BIAS_MUL = 1.f;
    static constexpr int NST = F8 ? 4 : 16;
    bf16* ACT; const float* bgu; LAS unsigned char* stg;
    __device__ __forceinline__ const float* bias_src(const Unit& u) const { return bgu + u.e * 2048 + u.pn * 256; }
    __device__ __forceinline__ void operator()(const f32x4 (&acc)[2][2][4][2], const Unit& u, int wr, int wc, int fr, int fq, LAS const float* bl) const {
        asm volatile("" : "+v"(fr), "+v"(fq));
        (void)bl;
        if constexpr (F8) {
            LAS unsigned* sw = (LAS unsigned*)(stg + (wr * 4 + wc) * 2048); const int lane = fq * 16 + fr;
#pragma unroll
            for (int ai = 0; ai < 2; ++ai) {
#pragma unroll
                for (int m = 0; m < 4; ++m)
#pragma unroll
                    for (int bj = 0; bj < 2; ++bj) { const f32x4 a = acc[ai][bj][m][0], b = acc[ai][bj][m][1];
                        const float s0_ = swiglu4(a[0], a[1]); int w = __builtin_bit_cast(int, s0_);
                        w = __builtin_amdgcn_cvt_pk_fp8_f32(s0_, swiglu4(a[2], a[3]), w, false); w = __builtin_amdgcn_cvt_pk_fp8_f32(swiglu4(b[0], b[1]), swiglu4(b[2], b[3]), w, true);
                        sw[((16 * m + fr) * 2 + (bj ^ ((fr >> 2) & 1))) * 4 + fq] = (unsigned)w; }
                asm volatile("s_waitcnt lgkmcnt(0)" ::: "memory");
#pragma unroll
                for (int k = 0; k < 2; ++k) { const int p = lane + 64 * k, rr = p >> 1, bj = p & 1; const u32x4 v = *(const LAS u32x4*)(sw + (rr * 2 + (bj ^ ((rr >> 2) & 1))) * 4);
                    const int row = u.pm * 256 + ai * 128 + wr * 64 + rr; const int col = u.pn * 128 + bj * 64 + wc * 16;
                    if (!(PROBE_NOST && u.kind)) *(u32x4*)((unsigned char*)ACT + (size_t)row * 1024 + col) = v; }
                asm volatile("s_waitcnt lgkmcnt(0)" ::: "memory");
            }
        } else {
#pragma unroll
            EPI_LOOP_ROWS { const int row = u.pm * 256 + ai * 128 + wr * 64 + m * 16 + fr;
#pragma unroll
                for (int bj = 0; bj < 2; ++bj) { const f32x4 a = acc[ai][bj][m][0], b = acc[ai][bj][m][1];
                    const int col = u.pn * 128 + bj * 64 + wc * 16 + fq * 4;
                    u32x2 w; w.x = cvt_pk_bf16(swiglu1(a[0], a[1]), swiglu1(a[2], a[3])); w.y = cvt_pk_bf16(swiglu1(b[0], b[1]), swiglu1(b[2], b[3]));
                    *(u32x2*)(ACT + (size_t)row * 1024 + col) = w; } }
        }
    }
};
struct EpiDown {
    static constexpr bool BIAS_DMA = true, GATE_COLS = false; static constexpr float GATE_MUL = 1.f, BIAS_MUL = Y_FP8 ? 16.f : 1.f;
    static constexpr int NST = Y_FP8 ? 8 : 16;
    bf16* Y; const float* bd; LAS unsigned char* stg;
    __device__ __forceinline__ const float* bias_src(const Unit& u) const { return bd + u.e * 1024 + u.pn * 256; }
    __device__ __forceinline__ void operator()(const f32x4 (&acc)[2][2][4][2], const Unit& u, int wr, int wc, int fr, int fq, LAS const float* bl) const {
        asm volatile("" : "+v"(fr), "+v"(fq));
        (void)bl;
        if constexpr (Y_FP8 != 0) {
            LAS unsigned char* sw = stg + (wr * 4 + wc) * 2048; const int lane = fq * 16 + fr;
#pragma unroll
            for (int ai = 0; ai < 2; ++ai)
#pragma unroll
                for (int bj = 0; bj < 2; ++bj) {
#pragma unroll
                    for (int m = 0; m < 4; ++m) { const f32x4 y0 = acc[ai][bj][m][0], y1 = acc[ai][bj][m][1];
                        u32x2 w; w.x = pack_fp8x4(y0[0], y0[1], y0[2], y0[3]); w.y = pack_fp8x4(y1[0], y1[1], y1[2], y1[3]);
                        *(LAS u32x2*)(sw + (16 * m + fr) * 32 + ((fq ^ (((fr >> 2) & 1) << 1)) << 3)) = w; }
                    asm volatile("s_waitcnt lgkmcnt(0)" ::: "memory");
#pragma unroll
                    for (int k = 0; k < 2; ++k) { const int p = lane + 64 * k, rr = p >> 1, hf = p & 1; const u32x4 v = *(const LAS u32x4*)(sw + rr * 32 + ((hf ^ ((rr >> 2) & 1)) << 4));
                        const int row = u.pm * 256 + ai * 128 + wr * 64 + rr; const int col = u.pn * 256 + bj * 128 + wc * 32 + hf * 16;
                        if (!(PROBE_NOST && u.kind)) *(u32x4*)((unsigned char*)Y + (size_t)row * 1024 + col) = v; }
                    asm volatile("s_waitcnt lgkmcnt(0)" ::: "memory");
                }
        } else {
#pragma unroll
            EPI_LOOP_ROWS { const int row = u.pm * 256 + ai * 128 + wr * 64 + m * 16 + fr;
#pragma unroll
                for (int bj = 0; bj < 2; ++bj) { const int col = u.pn * 256 + bj * 128 + wc * 32 + fq * 8;
                    const u32x4 pk_ = pack8(acc[ai][bj][m][0], acc[ai][bj][m][1]); if (!(PROBE_NOST && u.kind)) *(u32x4*)(Y + (size_t)row * 1024 + col) = pk_; } }
        }
    }
};

namespace att {
constexpr int SLOT = 32768, VOFF = 16384;
__device__ __forceinline__ void glds16(const void* gsrc, unsigned lds_dst) { unsigned keep;
    asm volatile("s_mov_b32 %0, m0\n\ts_mov_b32 m0, %2\n\ts_nop 0\n\tglobal_load_lds_dwordx4 %1, off\n\ts_mov_b32 m0, %0" : "=&s"(keep) : "v"(gsrc), "s"(lds_dst) : "memory"); }
#define ATT_WAIT_BAR(N) asm volatile("s_waitcnt vmcnt(" #N ") lgkmcnt(0)\n\ts_barrier" ::: "memory")
__device__ __forceinline__ float half_swap_max(float m) { auto rr = __builtin_amdgcn_permlane32_swap(__float_as_uint(m), __float_as_uint(m), false, false); return fmaxf(__uint_as_float(rr[0]), __uint_as_float(rr[1])); }
__device__ __forceinline__ float half_swap_sum(float m) { auto rr = __builtin_amdgcn_permlane32_swap(__float_as_uint(m), __float_as_uint(m), false, false); return __uint_as_float(rr[0]) + __uint_as_float(rr[1]); }
__device__ __forceinline__ int crow(int r, int hi) { return (r & 3) + 8 * (r >> 2) + 4 * hi; }
__device__ __forceinline__ float max3f(float a, float b, float c) { float r; asm("v_max3_f32 %0, %1, %2, %3" : "=v"(r) : "v"(a), "v"(b), "v"(c)); return r; }

__device__ __forceinline__ void attn_unit(LAS unsigned char* lds, LAS float* wsc  , const bf16* Q, const bf16* Kb, const bf16* Vt, bf16* O,
                                          int krow0, int h, int qrow0, int NT, float lam, float osc, const float* subg, const int tid) {
    const int lane = tid & 63, r32 = lane & 31, hi = lane >> 5; const int wid = __builtin_amdgcn_readfirstlane(tid >> 6);
    const int qg = wid >> 1, c = wid & 1;
    const unsigned lds0 = (unsigned)(uintptr_t)lds;
    const bf16* ksrc[2]; const bf16* vsrc[2];
#pragma unroll
    for (int i = 0; i < 2; ++i) { const int p = 2 * wid + i;
        { const int row = 4 * p + (lane >> 4), ch = (lane & 15) ^ (row & 15); ksrc[i] = Kb + (size_t)(krow0 + row) * 1024 + h * 128 + ch * 8; }
        { const int row = 8 * p + (lane >> 3), ch = (lane & 7) ^ ((row >> 1) & 7); vsrc[i] = Vt + (size_t)(h * 128 + row) * M + krow0 + ch * 8; } }
    const unsigned kdst = lds0 + (unsigned)wid * 2048u, vdst = lds0 + VOFF + (unsigned)wid * 2048u;
#define ATT_DMA(t, slot) do { const unsigned so_ = (unsigned)(slot) * SLOT; \
        glds16(ksrc[0] + (size_t)(t) * 64 * 1024, (unsigned)__builtin_amdgcn_readfirstlane(kdst + so_)); glds16(ksrc[1] + (size_t)(t) * 64 * 1024, (unsigned)__builtin_amdgcn_readfirstlane(kdst + so_ + 1024u)); \
        glds16(vsrc[0] + (size_t)(t) * 64, (unsigned)__builtin_amdgcn_readfirstlane(vdst + so_)); glds16(vsrc[1] + (size_t)(t) * 64, (unsigned)__builtin_amdgcn_readfirstlane(vdst + so_ + 1024u)); } while (0)
    const int key0 = (r32 & 0x13) | ((r32 & 4) << 1) | ((r32 & 8) >> 1);
    const int kx = key0 & 15, vx = (r32 >> 1) & 7;
    bf16x8 qf[4];
    { const bf16* qp = Q + (size_t)(qrow0 + qg * 32 + r32) * 1024 + h * 128 + c * 64 + hi * 8;
#pragma unroll
      for (int d0 = 0; d0 < 4; ++d0) qf[d0] = *(const bf16x8*)(qp + d0 * 16); }
    float sg[4];
#pragma unroll
    for (int d0 = 0; d0 < 4; ++d0) sg[d0] = subg[d0 * 32 + r32] * osc;
    f32x16 o[4];
#pragma unroll
    for (int d0 = 0; d0 < 4; ++d0) o[d0] = f32x16{};
    float mref = 0.f, lsum = 0.f; f32x16 negm = f32x16{};
    asm volatile("s_waitcnt vmcnt(0)" ::: "memory");
#define AT_BEG(r) do { if (PROBE_T == (r)) at0_ = __builtin_amdgcn_s_memtime(); } while (0)
#define AT_END(r) do { if (PROBE_T == (r)) { const unsigned long long d_ = __builtin_amdgcn_s_memtime() - at0_; if (blockIdx.x == 0 && tid == ATT_PROBE_TID) *(LAS unsigned long long*)(lds + LX_MISC + 64) += d_; } } while (0)
    unsigned long long at0_ = 0; (void)at0_;
    AT_BEG(7);
    AT_BEG(13);
    ATT_DMA(0, 0);
    if (NT > 1) ATT_DMA(1, 1);
    for (int t = 0; t < NT; ++t) {
        const int slot = t & 3;
        AT_BEG(4);
        if (t + 1 < NT) { ATT_WAIT_BAR(4); } else { ATT_WAIT_BAR(0); }
        AT_END(4);
        if (t == 0) AT_END(13);
        if (t + 2 < NT) ATT_DMA(t + 2, (t + 2) & 3);
        AT_BEG(5);
        const LAS unsigned char* kb_ = lds + slot * SLOT; const LAS unsigned char* vb_ = kb_ + VOFF;
        f32x16 s0, s1;
        bf16x8 kf[8];
#pragma unroll
        for (int d0 = 0; d0 < 4; ++d0) { const int ch = (c * 8 + d0 * 2 + hi) ^ kx;
            kf[d0] = *(const LAS bf16x8*)(kb_ + key0 * 256 + ch * 16); kf[4 + d0] = *(const LAS bf16x8*)(kb_ + (key0 + 32) * 256 + ch * 16); }
        bf16x8 vA[8], vB[8];
#pragma unroll
        for (int ks = 0; ks < 2; ++ks) { const int ch = (2 * ks + hi) ^ vx;
#pragma unroll
            for (int d0 = 0; d0 < 4; ++d0) vA[ks * 4 + d0] = *(const LAS bf16x8*)(vb_ + (d0 * 32 + r32) * 128 + ch * 16); }
#pragma unroll
        for (int d0 = 0; d0 < 4; ++d0) s0 = __builtin_amdgcn_mfma_f32_32x32x16_bf16(kf[d0], qf[d0], d0 == 0 ? negm : s0, 0, 0, 0);
#pragma unroll
        for (int d0 = 0; d0 < 4; ++d0) s1 = __builtin_amdgcn_mfma_f32_32x32x16_bf16(kf[4 + d0], qf[d0], d0 == 0 ? negm : s1, 0, 0, 0);
        float rm = s0[0];
#pragma unroll
        for (int r = 1; r < 16; ++r) rm = fmaxf(rm, s0[r]);
        float sa = 0.f;
#pragma unroll
        for (int r = 0; r < 16; ++r) { s0[r] = __builtin_amdgcn_exp2f(s0[r]); sa += s0[r]; }
        bf16x8 pa[4];
#pragma unroll
        for (int s = 0; s < 2; ++s) { u32x4 w0;
            w0.x = cvt_pk_bf16(s0[8 * s + 0], s0[8 * s + 1]); w0.y = cvt_pk_bf16(s0[8 * s + 2], s0[8 * s + 3]); w0.z = cvt_pk_bf16(s0[8 * s + 4], s0[8 * s + 5]); w0.w = cvt_pk_bf16(s0[8 * s + 6], s0[8 * s + 7]);
            pa[s] = __builtin_bit_cast(bf16x8, w0); }
#pragma unroll
        for (int ks = 2; ks < 4; ++ks) { const int ch = (2 * ks + hi) ^ vx;
#pragma unroll
            for (int d0 = 0; d0 < 4; ++d0) vB[(ks - 2) * 4 + d0] = *(const LAS bf16x8*)(vb_ + (d0 * 32 + r32) * 128 + ch * 16); }
#pragma unroll
        for (int ks = 0; ks < 2; ++ks)
#pragma unroll
            for (int d0 = 0; d0 < 4; ++d0) o[d0] = __builtin_amdgcn_mfma_f32_32x32x16_bf16(pa[ks], vA[ks * 4 + d0], o[d0], 0, 0, 0);
#pragma unroll
        for (int r = 0; r < 16; ++r) rm = fmaxf(rm, s1[r]);
#pragma unroll
        for (int r = 0; r < 16; ++r) { s1[r] = __builtin_amdgcn_exp2f(s1[r]); sa += s1[r]; }
        lsum += sa;
#pragma unroll
        for (int s = 0; s < 2; ++s) { u32x4 w1;
            w1.x = cvt_pk_bf16(s1[8 * s + 0], s1[8 * s + 1]); w1.y = cvt_pk_bf16(s1[8 * s + 2], s1[8 * s + 3]); w1.z = cvt_pk_bf16(s1[8 * s + 4], s1[8 * s + 5]); w1.w = cvt_pk_bf16(s1[8 * s + 6], s1[8 * s + 7]);
            pa[2 + s] = __builtin_bit_cast(bf16x8, w1); }
#pragma unroll
        for (int ks = 2; ks < 4; ++ks)
#pragma unroll
            for (int d0 = 0; d0 < 4; ++d0) o[d0] = __builtin_amdgcn_mfma_f32_32x32x16_bf16(pa[ks], vB[(ks - 2) * 4 + d0], o[d0], 0, 0, 0);
        AT_END(5);
        rm = half_swap_max(rm);
        const bool need = (t == 0) || (rm > 8.f);
        if (__any(need)) {
            const float dl = need ? rm : 0.f; mref += dl;
#pragma unroll
            for (int r = 0; r < 16; ++r) negm[r] = -mref;
            const float f = __builtin_amdgcn_exp2f(-dl); lsum *= f;
            if (hi == 0) wsc[r32] = f;
            asm volatile("s_waitcnt lgkmcnt(0)" ::: "memory");
#pragma unroll
            for (int r = 0; r < 16; ++r) { const float fr_ = wsc[crow(r, hi)];
#pragma unroll
                for (int d0 = 0; d0 < 4; ++d0) o[d0][r] *= fr_; }
            asm volatile("s_waitcnt lgkmcnt(0)" ::: "memory");
        }
    }
    AT_BEG(14);
    const float lt = half_swap_sum(lsum);
    if (hi == 0) wsc[64 + r32] = (c ? -lam : 1.f) * __builtin_amdgcn_rcpf(lt);
    asm volatile("s_waitcnt lgkmcnt(0)\n\ts_barrier" ::: "memory");
    LAS float* xch = (LAS float*)(lds + qg * 16384);
#pragma unroll
    for (int r = 0; r < 16; ++r) { const float a = wsc[64 + crow(r, hi)];
#pragma unroll
        for (int d0 = 0; d0 < 4; ++d0) o[d0][r] *= a; }
    if (c == 1) {
#pragma unroll
        for (int d0 = 0; d0 < 4; ++d0)
#pragma unroll
            for (int r = 0; r < 16; ++r) xch[(d0 * 16 + r) * 64 + lane] = o[d0][r];
    }
    asm volatile("s_waitcnt lgkmcnt(0)\n\ts_barrier" ::: "memory");
    if (c == 0) {
        constexpr int OB = FP8_ATT_O ? 1 : 2;
        LAS unsigned char* stg = lds + 65536 + qg * 8192;
#pragma unroll
        for (int d0 = 0; d0 < 4; ++d0)
#pragma unroll
            for (int r = 0; r < 16; ++r) o[d0][r] += xch[(d0 * 16 + r) * 64 + lane];
        float ss[16], tt[16];
#pragma unroll
        for (int r = 0; r < 16; ++r) { float x = (o[0][r] * o[0][r] + o[1][r] * o[1][r]) + (o[2][r] * o[2][r] + o[3][r] * o[3][r]);
            x += __builtin_bit_cast(float, __builtin_amdgcn_update_dpp(0, __builtin_bit_cast(int, x), 0xB1, 0xF, 0xF, true));
            x += __builtin_bit_cast(float, __builtin_amdgcn_update_dpp(0, __builtin_bit_cast(int, x), 0x4E, 0xF, 0xF, true));
            x += __builtin_bit_cast(float, __builtin_amdgcn_update_dpp(0, __builtin_bit_cast(int, x), 0x124, 0xF, 0xF, true));
            x += __builtin_bit_cast(float, __builtin_amdgcn_update_dpp(0, __builtin_bit_cast(int, x), 0x128, 0xF, 0xF, true));
            ss[r] = x; }
#pragma unroll
        for (int r = 0; r < 16; ++r) tt[r] = __shfl_xor(ss[r], 16);
#pragma unroll
        for (int r = 0; r < 16; ++r) { const int qr = crow(r, hi); const float rn = __builtin_amdgcn_rsqf((ss[r] + tt[r]) * (1.f / 128.f) + EPS);
#pragma unroll
            for (int d0 = 0; d0 < 4; ++d0) { const float ov = o[d0][r] * rn * sg[d0];
                if (FP8_ATT_O) { const float o4 = clamp8(4.f * ov); *(LAS unsigned char*)(stg + qr * 128 + d0 * 32 + r32) = (unsigned char)(__builtin_amdgcn_cvt_pk_fp8_f32(o4, o4, 0, false) & 0xff); }
                else *(LAS unsigned short*)(stg + (qr * 128 + d0 * 32 + r32) * 2) = (unsigned short)f2bf(ov); } }
        asm volatile("s_waitcnt lgkmcnt(0)" ::: "memory");
        unsigned char* Ob = (unsigned char*)O + ((size_t)(qrow0 + qg * 32) * 1024 + h * 128) * OB;
#pragma unroll
        for (int k = 0; k < 4 * OB; ++k) { const int off = lane * 16 + 1024 * k, row = off / (128 * OB), cb = off % (128 * OB);
            *(u32x4*)(Ob + (size_t)row * 1024 * OB + cb) = *(const LAS u32x4*)(stg + off); }
    }
    asm volatile("s_waitcnt lgkmcnt(0)\n\ts_barrier" ::: "memory");
    AT_END(7);
    AT_END(14);
#undef AT_BEG
#undef AT_END
#undef ATT_DMA
}

typedef int v8i __attribute__((ext_vector_type(8)));
typedef int v4i_ __attribute__((ext_vector_type(4)));
__device__ __forceinline__ v8i cat16(u32x4 lo, u32x4 hi2) { const v4i_ a = __builtin_bit_cast(v4i_, lo), b = __builtin_bit_cast(v4i_, hi2); return __builtin_shufflevector(a, b, 0, 1, 2, 3, 4, 5, 6, 7); }
constexpr float ATT_TGT = 2.f;
__device__ __forceinline__ void attn_unit8(LAS unsigned char* lds, LAS float* wsc, const unsigned char* Q8, const unsigned char* K8, const unsigned char* V8t, bf16* O,
                                           int krow0, int h, int qrow0, int NT, float lam, float osc, const float* subg, const int tid, const int par, const bool pre, const int nkrow0, const int nh) {
    static_assert(FP8_ATT_O != 0, "the output staging area (LX_EPI) holds fp8 rows");
    constexpr int SL = 16384, VO = 8192;
    const int lane = tid & 63, r32 = lane & 31, hi = lane >> 5; const int wid = __builtin_amdgcn_readfirstlane(tid >> 6);
    const int qg = wid >> 1, c = wid & 1;
    const unsigned lds0 = (unsigned)(uintptr_t)lds;
    unsigned ksrc, vsrc;
    { const int key = 8 * wid + (lane >> 3), ch = (lane & 7) ^ ((key >> 1) & 7); ksrc = (unsigned)((krow0 + key) * 1024 + h * 128 + ch * 16); }
    { const int dv = 16 * wid + (lane >> 2), ch = (lane & 3) ^ ((dv >> 2) & 3); vsrc = (unsigned)((h * 128 + dv) * M + krow0 + ch * 16); }
    const unsigned kdst = lds0 + (unsigned)wid * 1024u, vdst = lds0 + VO + (unsigned)wid * 1024u;
#define ATT_DMA8(t, slot) do { const unsigned so_ = (unsigned)(slot) * SL; \
        pg8::glds16s((const char*)K8, ksrc + (unsigned)(t) * 65536u, (unsigned)__builtin_amdgcn_readfirstlane(kdst + so_)); pg8::glds16s((const char*)V8t, vsrc + (unsigned)(t) * 64u, (unsigned)__builtin_amdgcn_readfirstlane(vdst + so_)); } while (0)
#define ATT_DMA8_NEXT(pb) do { if (nkrow0 >= 0) { const unsigned nks_ = ksrc + (unsigned)((nkrow0 - krow0) * 1024 + (nh - h) * 128); const unsigned nvs_ = vsrc + (unsigned)((nh - h) * 128 * M + (nkrow0 - krow0)); \
        _Pragma("unroll") for (int j_ = 0; j_ < 4; ++j_) { const unsigned so_ = (unsigned)((pb) * 4 + j_) * SL; \
            pg8::glds16s((const char*)K8, nks_ + (unsigned)j_ * 65536u, (unsigned)__builtin_amdgcn_readfirstlane(kdst + so_)); pg8::glds16s((const char*)V8t, nvs_ + (unsigned)j_ * 64u, (unsigned)__builtin_amdgcn_readfirstlane(vdst + so_)); } } } while (0)
    const int key0 = 32 * ((r32 >> 2) & 1) + (r32 & 3) + 4 * (r32 >> 3);
    const int kx = (key0 >> 1) & 7, vx = (r32 >> 2) & 3;
    const int kc0 = ((c * 4 + 2 * hi) ^ kx) * 16, kc1 = ((c * 4 + 2 * hi + 1) ^ kx) * 16;
    const int vc0 = ((2 * hi) ^ vx) * 16, vc1 = ((2 * hi + 1) ^ vx) * 16;
    v8i qf;
    { const unsigned char* qp = Q8 + (size_t)(qrow0 + qg * 32 + r32) * 1024 + h * 128 + c * 64 + hi * 32;
      qf = cat16(*(const u32x4*)qp, *(const u32x4*)(qp + 16)); }
    (void)subg; (void)osc;
    f32x16 o[4];
#pragma unroll
    for (int d0 = 0; d0 < 4; ++d0) o[d0] = f32x16{};
    float mref = 0.f, lsum = 0.f; f32x16 negm;
#pragma unroll
    for (int r = 0; r < 16; ++r) negm[r] = ATT_TGT;
    const int NS = NT >> 2;
    if (!pre) { asm volatile("s_waitcnt vmcnt(0)" ::: "memory");
#pragma unroll
        for (int j = 0; j < 4; ++j) ATT_DMA8(j, par * 4 + j); }
    ATT_WAIT_BAR(0);
    asm volatile("" :: "v"(qf));
    if (NS > 1) {
#pragma unroll
        for (int j = 0; j < 4; ++j) ATT_DMA8(4 + j, (par ^ 1) * 4 + j);
    } else ATT_DMA8_NEXT(par ^ 1);
#define ATT_KFRAG(kb_, kk) cat16(*(const LAS u32x4*)((kb_) + (key0 + (kk)) * 128 + kc0), *(const LAS u32x4*)((kb_) + (key0 + (kk)) * 128 + kc1))
#define ATT_VFRAG(vb_, d0) cat16(*(const LAS u32x4*)((vb_) + ((d0) * 32 + r32) * 64 + vc0), *(const LAS u32x4*)((vb_) + ((d0) * 32 + r32) * 64 + vc1))
#define ATT_QK(kb_, kk) __builtin_amdgcn_mfma_scale_f32_32x32x64_f8f6f4(ATT_KFRAG(kb_, kk), qf, negm, 0, 0, 0, 0x7A7A7A7A, 0, 0x7A7A7A7A)
    {
        const LAS unsigned char* p0_ = lds + par * 4 * SL; const f32x16 s0 = ATT_QK(p0_, 0), s1 = ATT_QK(p0_, 16);
        float rm = s0[0];
#pragma unroll
        for (int r = 1; r < 16; ++r) rm = fmaxf(rm, s0[r]);
#pragma unroll
        for (int r = 0; r < 16; ++r) rm = fmaxf(rm, s1[r]);
        mref = half_swap_max(rm) - ATT_TGT;
#pragma unroll
        for (int r = 0; r < 16; ++r) negm[r] = ATT_TGT - mref;
    }
    for (int st = 0; st < NS; ++st) {
        if (st > 0) {
            ATT_WAIT_BAR(0);
            if (st + 1 < NS) {
#pragma unroll
                for (int j = 0; j < 4; ++j) ATT_DMA8(4 * (st + 1) + j, ((par + st + 1) & 1) * 4 + j);
            } else ATT_DMA8_NEXT((par + NS) & 1);
        }
        const LAS unsigned char* sb_ = lds + ((par + st) & 1) * 4 * SL;
        v8i pfp = {0, 0, 0, 0, 0, 0, 0, 0};
#pragma unroll
        for (int j = 0; j < 4; ++j) {
            const LAS unsigned char* kb_ = sb_ + j * SL;
            f32x16 s0 = ATT_QK(kb_, 0), s1 = ATT_QK(kb_, 16);
            if (j > 0) { const LAS unsigned char* vp_ = kb_ - SL + VO;
#pragma unroll
                for (int d0 = 0; d0 < 4; ++d0) o[d0] = __builtin_amdgcn_mfma_scale_f32_32x32x64_f8f6f4(ATT_VFRAG(vp_, d0), pfp, o[d0], 0, 0, 0, 0x7F7F7F7F, 0, 0x7F7F7F7F); }
#pragma unroll
            for (int r = 0; r < 16; ++r) { s0[r] = __builtin_amdgcn_exp2f(s0[r]); s1[r] = __builtin_amdgcn_exp2f(s1[r]); }
            float sa = 0.f, sb = 0.f;
#pragma unroll
            for (int r = 0; r < 16; ++r) { sa += s0[r]; sb += s1[r]; }
            sa += sb;
            if (__any(!(sa <= 448.f))) {
                unsigned ko_ = (unsigned)(uintptr_t)kb_; asm volatile("" : "+v"(ko_));
                const LAS unsigned char* kr_ = (const LAS unsigned char*)(uintptr_t)ko_;
                s0 = ATT_QK(kr_, 0); s1 = ATT_QK(kr_, 16);
                float rm = s0[0];
#pragma unroll
                for (int r = 1; r < 16; ++r) rm = fmaxf(rm, s0[r]);
#pragma unroll
                for (int r = 0; r < 16; ++r) rm = fmaxf(rm, s1[r]);
                rm = half_swap_max(rm);
                const float dl = fmaxf(rm - ATT_TGT, 0.f); mref += dl;
#pragma unroll
                for (int r = 0; r < 16; ++r) negm[r] = ATT_TGT - mref;
                const float f = __builtin_amdgcn_exp2f(-dl); lsum *= f;
#pragma unroll
                for (int r = 0; r < 16; ++r)
#pragma unroll
                    for (int d0 = 0; d0 < 4; ++d0) o[d0][r] *= f;
#pragma unroll
                for (int r = 0; r < 16; ++r) { s0[r] = __builtin_amdgcn_exp2f(s0[r] - dl); s1[r] = __builtin_amdgcn_exp2f(s1[r] - dl); }
                sa = 0.f; sb = 0.f;
#pragma unroll
                for (int r = 0; r < 16; ++r) { sa += s0[r]; sb += s1[r]; }
                sa += sb;
            }
            lsum += sa;
#pragma unroll
            for (int jj = 0; jj < 4; ++jj) { int w = __builtin_bit_cast(int, s0[4 * jj]); w = __builtin_amdgcn_cvt_pk_fp8_f32(s0[4 * jj], s0[4 * jj + 1], w, false); w = __builtin_amdgcn_cvt_pk_fp8_f32(s0[4 * jj + 2], s0[4 * jj + 3], w, true); pfp[jj] = w;
                int w2 = __builtin_bit_cast(int, s1[4 * jj]); w2 = __builtin_amdgcn_cvt_pk_fp8_f32(s1[4 * jj], s1[4 * jj + 1], w2, false); w2 = __builtin_amdgcn_cvt_pk_fp8_f32(s1[4 * jj + 2], s1[4 * jj + 3], w2, true); pfp[4 + jj] = w2; }
            __builtin_amdgcn_sched_barrier(0);
        }
        {
            const LAS unsigned char* vl_ = sb_ + 3 * SL + VO;
#pragma unroll
            for (int d0 = 0; d0 < 4; ++d0) o[d0] = __builtin_amdgcn_mfma_scale_f32_32x32x64_f8f6f4(ATT_VFRAG(vl_, d0), pfp, o[d0], 0, 0, 0, 0x7F7F7F7F, 0, 0x7F7F7F7F);
        }
    }
#undef ATT_KFRAG
#undef ATT_VFRAG
#undef ATT_QK
    static_assert(FP8_ATT_O != 0, "fp8 output rows");
    const float lt = half_swap_sum(lsum);
    const float a = (c ? -lam : 1.f) * __builtin_amdgcn_rcpf(16.f * lt);
#pragma unroll
    for (int r = 0; r < 16; ++r)
#pragma unroll
        for (int d0 = 0; d0 < 4; ++d0) o[d0][r] *= a;
    asm volatile("s_waitcnt lgkmcnt(0)\n\ts_barrier" ::: "memory");
    LAS float* xch = (LAS float*)(lds + ((par + NS - 1) & 1) * 65536 + qg * 16384);
    LAS float* xmine = xch + c * 2048; LAS float* xpart = xch + (c ^ 1) * 2048;
    f32x16 k0_, k1_;
    if (c == 0) { k0_ = o[0]; k1_ = o[1];
#pragma unroll
        for (int r = 0; r < 16; ++r) { xmine[r * 64 + lane] = o[2][r]; xmine[(16 + r) * 64 + lane] = o[3][r]; } }
    else { k0_ = o[2]; k1_ = o[3];
#pragma unroll
        for (int r = 0; r < 16; ++r) { xmine[r * 64 + lane] = o[0][r]; xmine[(16 + r) * 64 + lane] = o[1][r]; } }
    asm volatile("s_waitcnt lgkmcnt(0)\n\ts_barrier" ::: "memory");
    float ss = 0.f;
#pragma unroll
    for (int r = 0; r < 16; ++r) { k0_[r] += xpart[r * 64 + lane]; k1_[r] += xpart[(16 + r) * 64 + lane]; ss += k0_[r] * k0_[r] + k1_[r] * k1_[r]; }
    ss = half_swap_sum(ss);
    LAS float* wscp = (LAS float*)(lds + LX_WSC + (wid ^ 1) * 1024);
    if (hi == 0) wsc[64 + r32] = ss;
    asm volatile("s_waitcnt lgkmcnt(0)\n\ts_barrier" ::: "memory");
    const float rn4 = 4.f * __builtin_amdgcn_rsqf((ss + wscp[64 + r32]) * (1.f / 128.f) + EPS);
    LAS unsigned char* stg = lds + LX_EPI + qg * 4096;
#pragma unroll
    for (int dd = 0; dd < 2; ++dd)
#pragma unroll
        for (int i = 0; i < 4; ++i) { const int d0 = 2 * c + dd; const f32x4 g4 = *(const LAS f32x4*)(wsc + 96 + d0 * 32 + 8 * i + 4 * hi) * rn4;
            const f32x16& kk = dd ? k1_ : k0_;
            const unsigned w = pack_fp8x4(kk[4 * i] * g4[0], kk[4 * i + 1] * g4[1], kk[4 * i + 2] * g4[2], kk[4 * i + 3] * g4[3]);
            const int cidx = d0 * 2 + (i >> 1);
            *(LAS unsigned*)(stg + r32 * 128 + ((cidx ^ (r32 & 7)) << 4) + ((i & 1) * 2 + hi) * 4) = w; }
    asm volatile("s_waitcnt lgkmcnt(0)\n\ts_barrier" ::: "memory");
    { unsigned char* Ob = (unsigned char*)O + ((size_t)(qrow0 + qg * 32) * 1024 + h * 128);
#pragma unroll
      for (int k2 = 0; k2 < 2; ++k2) { const int off = lane * 16 + 1024 * (2 * c + k2), row = off >> 7, ch = (off >> 4) & 7;
          *(u32x4*)(Ob + (size_t)row * 1024 + ch * 16) = *(const LAS u32x4*)(stg + row * 128 + ((ch ^ (row & 7)) << 4)); } }
    asm volatile("s_waitcnt lgkmcnt(0)\n\ts_barrier" ::: "memory");
#undef ATT_DMA8
}
}

#if ATT_FP8
#define ATT_CALL(l_, w_, q_, k_, v_, o_, ...) att::attn_unit8(l_, w_, (const unsigned char*)(q_), (const unsigned char*)(k_), (const unsigned char*)(v_), o_, __VA_ARGS__)
#else
#define ATT_CALL att::attn_unit
#endif
__device__ __forceinline__ void load_row_f32(const float* p, int lane, f32x4 (&v)[4]) {
#pragma unroll
    for (int j = 0; j < 4; ++j) v[j] = *(const f32x4*)(p + 256 * j + 4 * lane);
}
__device__ __forceinline__ void load_row_x(const void* Xb, size_t row, int lane, f32x4 (&v)[4]) {
    if (X_BF16) { const bf16* p = (const bf16*)Xb + row * D;
#pragma unroll
        for (int j = 0; j < 4; ++j) { const u32x2 w = *(const u32x2*)(p + 256 * j + 4 * lane);
            v[j] = (f32x4){bf2f((unsigned short)(w.x & 0xffffu)), bf2f((unsigned short)(w.x >> 16)), bf2f((unsigned short)(w.y & 0xffffu)), bf2f((unsigned short)(w.y >> 16))}; } }
    else load_row_f32((const float*)Xb + row * D, lane, v);
}
__device__ __forceinline__ void store_row_x(void* Xb, size_t row, int lane, const f32x4 (&v)[4]) {
    if (X_BF16) { bf16* p = (bf16*)Xb + row * D;
#pragma unroll
        for (int j = 0; j < 4; ++j) { u32x2 w; w.x = cvt_pk_bf16(v[j][0], v[j][1]); w.y = cvt_pk_bf16(v[j][2], v[j][3]); *(u32x2*)(p + 256 * j + 4 * lane) = w; } }
    else { float* p = (float*)Xb + row * D;
#pragma unroll
        for (int j = 0; j < 4; ++j) *(f32x4*)(p + 256 * j + 4 * lane) = v[j]; }
}
__device__ __forceinline__ float row_rstd(const f32x4 (&v)[4]) {
    float s = 0.f;
#pragma unroll
    for (int j = 0; j < 4; ++j) s += (v[j][0] * v[j][0] + v[j][1] * v[j][1]) + (v[j][2] * v[j][2] + v[j][3] * v[j][3]);
    return 1.0f / sqrtf(wave_sum(s) * (1.f / D) + EPS);
}
__device__ __forceinline__ void norm_mod_store(f32x4 (&v)[4], const float* g, const float* sc, const float* sh, int lane, bf16* hrow) {
    const float rstd = row_rstd(v);
#pragma unroll
    for (int j = 0; j < 4; ++j) { const int c = 256 * j + 4 * lane; const f32x4 gg = *(const f32x4*)(g + c), ss = *(const f32x4*)(sc + c), hh = *(const f32x4*)(sh + c);
        v[j] = (v[j] * rstd) * gg * (ss + 1.f) + hh;
        u32x2 w; w.x = cvt_pk_bf16(v[j][0], v[j][1]); w.y = cvt_pk_bf16(v[j][2], v[j][3]); *(u32x2*)(hrow + c) = w; }
}
__device__ __forceinline__ void norm_mod_f32(f32x4 (&v)[4], const float* g, const float* sc, const float* sh, int lane) {
    const float rstd = row_rstd(v);
#pragma unroll
    for (int j = 0; j < 4; ++j) { const int c = 256 * j + 4 * lane; const f32x4 gg = *(const f32x4*)(g + c), ss = *(const f32x4*)(sc + c), hh = *(const f32x4*)(sh + c);
        v[j] = (v[j] * rstd) * gg * (ss + 1.f) + hh; }
}
__device__ __forceinline__ void norm_mod_store_mix(bool f8, f32x4 (&v)[4], const float* g, const float* sc, const float* sh, int lane, bf16* hrow, unsigned char* h8row) {
    if (f8) { norm_mod_f32(v, g, sc, sh, lane);
#pragma unroll
        for (int j = 0; j < 4; ++j) *(unsigned*)(h8row + 256 * j + 4 * lane) = pack_fp8x4(16.f * v[j][0], 16.f * v[j][1], 16.f * v[j][2], 16.f * v[j][3]); }
    else norm_mod_store(v, g, sc, sh, lane, hrow);
}
__device__ __forceinline__ int row_batch(int row) { return row / RPB; }
__device__ __forceinline__ bool row_is_ctx(int row) { return (row % RPB) < CTXL; }
__device__ __forceinline__ int act_row(int ai, bool lat_only) { return lat_only ? (ai >> 11) * RPB + CTXL + (ai & 2047) : ai; }

template <int MODE>
__device__ __forceinline__ void transpose_item(const float* W, int K, int N, bf16* WT, LAS float* scr, int item, int lane) {
    const int nblk = N / 32, kb = item / nblk, nb = item % nblk, k0 = 64 * kb, n0 = 32 * nb;
#pragma unroll 8
    for (int i = 0; i < 32; ++i) { const int kk = 2 * i + (lane >> 5); scr[kk * 33 + (lane & 31)] = W[(size_t)(k0 + kk) * N + n0 + (lane & 31)]; }
    asm volatile("s_waitcnt lgkmcnt(0)" ::: "memory");
    const int c = lane & 7;
#pragma unroll
    for (int j = 0; j < 4; ++j) { const int n = (lane >> 3) + 8 * j; const LAS float* s = scr + (8 * c) * 33 + n;
        u32x4 o; o.x = cvt_pk_bf16(s[0 * 33], s[1 * 33]); o.y = cvt_pk_bf16(s[2 * 33], s[3 * 33]); o.z = cvt_pk_bf16(s[4 * 33], s[5 * 33]); o.w = cvt_pk_bf16(s[6 * 33], s[7 * 33]);
        int nn = n0 + n;
        if (MODE == 1 && nn < 2048) { const int i6 = nn & 63; nn = (nn & ~63) + (i6 < 32 ? 2 * i6 : 2 * (i6 - 32) + 1); }
        if (MODE == 2 && nn >= 1024) nn = nn < 2048 ? 1024 + 2 * (nn - 1024) : 1024 + 2 * (nn - 2048) + 1;
        *(u32x4*)(WT + (size_t)nn * K + k0 + 8 * c) = o; }
    asm volatile("s_waitcnt lgkmcnt(0)" ::: "memory");
}

template <int MODE = 0>
__device__ __forceinline__ void transpose_item8(const float* W, int K, int N, unsigned char* WT, LAS float* scr, int item, int lane) {
    const int nblk = N / 16, kb = item / nblk, nb = item % nblk, k0 = 128 * kb, n0 = 16 * nb;
    f32x4 v[8];
#pragma unroll
    for (int i = 0; i < 8; ++i) v[i] = *(const f32x4*)(W + (size_t)(k0 + 16 * i + (lane >> 2)) * N + n0 + 4 * (lane & 3));
#pragma unroll
    for (int i = 0; i < 8; ++i) *(LAS f32x4*)(scr + (16 * i + (lane >> 2)) * 20 + 4 * (lane & 3)) = v[i] * 1024.f;
    asm volatile("s_waitcnt lgkmcnt(0)" ::: "memory");
    const int kc = lane & 7;
#pragma unroll
    for (int j = 0; j < 2; ++j) { const int n = (lane >> 3) + 8 * j; const LAS float* s = scr + (16 * kc) * 20 + n;
        u32x4 o;
        o.x = pack_fp8x4(s[0 * 20], s[1 * 20], s[2 * 20], s[3 * 20]); o.y = pack_fp8x4(s[4 * 20], s[5 * 20], s[6 * 20], s[7 * 20]);
        o.z = pack_fp8x4(s[8 * 20], s[9 * 20], s[10 * 20], s[11 * 20]); o.w = pack_fp8x4(s[12 * 20], s[13 * 20], s[14 * 20], s[15 * 20]);
        int nn = n0 + n;
        if (MODE == 1 && nn < 2048) { const int i6 = nn & 63; nn = (nn & ~63) + (i6 < 32 ? 2 * i6 : 2 * (i6 - 32) + 1); }
        *(u32x4*)(WT + (size_t)nn * K + k0 + 16 * kc) = o; }
    asm volatile("s_waitcnt lgkmcnt(0)" ::: "memory");
}

__device__ __forceinline__ void item8_load(const float* W, int N, int item, int lane, f32x4 (&v)[8]) {
    const int nblk = N / 16, kb = item / nblk, nb = item % nblk, k0 = 128 * kb, n0 = 16 * nb;
#pragma unroll
    for (int i = 0; i < 8; ++i) v[i] = *(const f32x4*)(W + (size_t)(k0 + 16 * i + (lane >> 2)) * N + n0 + 4 * (lane & 3));
}
__device__ __forceinline__ void item8_store(const f32x4 (&v)[8], int K, int N, unsigned char* WT, LAS float* scr, int item, int lane) {
    const int nblk = N / 16, kb = item / nblk, nb = item % nblk, k0 = 128 * kb, n0 = 16 * nb;
    const float ge = (N == 2048) ? 1024.f * GATE_PRE : 1024.f; const f32x4 mulv = {ge, 1024.f, ge, 1024.f};
#pragma unroll
    for (int i = 0; i < 8; ++i) *(LAS f32x4*)(scr + (16 * i + (lane >> 2)) * 20 + 4 * (lane & 3)) = v[i] * mulv;
    asm volatile("s_waitcnt lgkmcnt(0)" ::: "memory");
    const int kc = lane & 7;
#pragma unroll
    for (int j = 0; j < 2; ++j) { const int n = (lane >> 3) + 8 * j; const LAS float* s = scr + (16 * kc) * 20 + n;
        u32x4 o;
        o.x = pack_fp8x4(s[0 * 20], s[1 * 20], s[2 * 20], s[3 * 20]); o.y = pack_fp8x4(s[4 * 20], s[5 * 20], s[6 * 20], s[7 * 20]);
        o.z = pack_fp8x4(s[8 * 20], s[9 * 20], s[10 * 20], s[11 * 20]); o.w = pack_fp8x4(s[12 * 20], s[13 * 20], s[14 * 20], s[15 * 20]);
        *(u32x4*)(WT + (size_t)(n0 + n) * K + k0 + 16 * kc) = o; }
    asm volatile("s_waitcnt lgkmcnt(0)" ::: "memory");
}

struct Args { const float* in[21]; float* out; unsigned char* ws; int ph_lo, ph_hi; };
enum { I_X = 0, I_C, I_CTX, I_CCTX, I_MODW, I_MODB, I_NORMG, I_WQKV, I_WO, I_LAM, I_SUBG, I_WIN, I_CONVW, I_WOUT, I_RW, I_RB, I_WGU, I_BGU, I_WD, I_BD, I_FINALG };

__device__ __forceinline__ void moe_table(LAS unsigned char* lds, const unsigned* gcnt, int tid) {
    LAS int* ecnt = (LAS int*)(lds + LX_ECNT); LAS int* tstart = (LAS int*)(lds + LX_TSTART); LAS int* tile_e = (LAS int*)(lds + LX_TILEE);
    __syncthreads();
    if (tid < 32) ecnt[tid] = (int)__hip_atomic_load(gcnt + tid, RLX_AGENT);
    __syncthreads();
    if (tid == 0) { int ts = 0; for (int e = 0; e < 32; ++e) { tstart[e] = ts; ts += (ecnt[e] + 255) >> 8; } tstart[32] = ts; }
    __syncthreads();
    { const int e = tid >> 4, l16 = tid & 15; const int t0 = tstart[e], n = tstart[e + 1] - t0; for (int j = l16; j < n; j += 16) tile_e[t0 + j] = e; }
    __syncthreads();
}

typedef const __attribute__((address_space(4))) unsigned char* kptr_t;
__device__ __forceinline__ kptr_t kargs() { kptr_t p = (kptr_t)__builtin_amdgcn_kernarg_segment_ptr(); asm volatile("" : "+s"(p)); return p; }
#define INP(k) (*(const float* const __attribute__((address_space(4)))*)(kargs() + 8 * (k)))
#define OUTP() (*(float* const __attribute__((address_space(4)))*)(kargs() + 168))
#define WSB() (*(unsigned char* const __attribute__((address_space(4)))*)(kargs() + 176))
#define WSP(T, off) ((T*)(WSB() + (off)))
static_assert(sizeof(Args) == 192, "kernarg layout");
__global__ void __launch_bounds__(NTHREADS, 2) fwd(Args args) {
    extern __shared__ __attribute__((aligned(16))) unsigned char lds_raw[];
    LAS unsigned char* lds = (LAS unsigned char*)lds_raw;
    const int tid = threadIdx.x, lane = tid & 63, wave = __builtin_amdgcn_readfirstlane(tid >> 6);
    const int G = gridDim.x, bid = blockIdx.x;
    const int gw = bid * NWAVES + wave, NGW = G * NWAVES;
    gu32* ctl = (gu32*)WSP(unsigned, WS_CTL);
    for (int u = tid; u < (LDS_BYTES - LX) / 4; u += NTHREADS) ((LAS unsigned*)(lds + LX))[u] = 0u;
    __syncthreads();
    volatile LAS unsigned* MISC = (volatile LAS unsigned*)(lds + LX_MISC);
    XcdBarrier bar; bar.bar = (unsigned*)(ctl + CW_BAR); bar.x = 0; bar.st = nullptr;
    if (!MK_PER_PHASE) bar = xcd_barrier_post((unsigned*)(ctl + CW_BAR), MISC + 8);
    (void)args;
    const unsigned long long pt_start = PROBE_T ? __builtin_amdgcn_s_memtime() : 0ull; (void)pt_start;
    const unsigned long long pt_rstart = PROBE_T ? __builtin_amdgcn_s_memrealtime() : 0ull; (void)pt_rstart;
    const int lo = *(const int __attribute__((address_space(4)))*)(kargs() + 184), hi = *(const int __attribute__((address_space(4)))*)(kargs() + 188);
#define IN(k) (lo <= (k) && (k) < hi)
#define PHASE_IDS int tid = threadIdx.x; asm volatile("" : "+v"(tid)); const int lane = tid & 63, wave = __builtin_amdgcn_readfirstlane(tid >> 6); const int gw = bid * NWAVES + wave; (void)lane; (void)gw;
#define SEAM(k) do { if (IN(k) && IN((k) + 1)) { if (MK_PER_PHASE) { if (tid == 0) __hip_atomic_store(ctl + CW_TMO, 0xBADu, RLX_AGENT); } else { unsigned long long b0_ = 0; if (PROBE_T == 10) b0_ = __builtin_amdgcn_s_memtime(); xcd_barrier(bar); if (PROBE_REP & 0x10000) xcd_barrier(bar); if (PROBE_T == 10 && bid == PROBE_BID && threadIdx.x == 0) *(LAS unsigned long long*)(lds + LX_MISC + 64) += __builtin_amdgcn_s_memtime() - b0_; } } } while (0)

    if (PS(0) && IN(0)) { PHASE_IDS
        float* modv = WSP(float, WS_MODV);
        unsigned long long p0t_ = (PROBE_T == 11 || PROBE_T == 12) ? __builtin_amdgcn_s_memtime() : 0ull; (void)p0t_;
        { LAS float* sil = (LAS float*)lds;
          LAS float* red = (LAS float*)(lds + 69632);
          for (int i = tid; i < 17 * 1024; i += NTHREADS) { const int r = i >> 10, k = i & 1023; const float cv = r < 16 ? INP(I_C)[r * 1024 + k] : INP(I_CCTX)[k]; sil[i] = cv / (1.f + __expf(-cv)); }
          __syncthreads();
          for (int it = bid; it < 4 * 96; it += G) { const int l = it / 96, nb = it % 96; const float* W = INP(I_MODW) + (size_t)l * 1024 * 6144 + nb * 64 + lane;
            float a[17];
#pragma unroll
            for (int r = 0; r < 17; ++r) a[r] = 0.f;
            for (int k = wave * 128; k < wave * 128 + 128; k += 4) { float w[4];
#pragma unroll
                for (int q = 0; q < 4; ++q) w[q] = W[(size_t)(k + q) * 6144];
#pragma unroll
                for (int r = 0; r < 17; ++r) { const f32x4 s = *(const LAS f32x4*)(sil + r * 1024 + k); a[r] += s[0] * w[0] + s[1] * w[1] + s[2] * w[2] + s[3] * w[3]; } }
#pragma unroll
            for (int r = 0; r < 17; ++r) red[(wave * 17 + r) * 64 + lane] = a[r];
            __syncthreads();
            for (int i = tid; i < 17 * 64; i += NTHREADS) { const int r = i >> 6, n = i & 63; float s = INP(I_MODB)[l * 6144 + nb * 64 + n];
#pragma unroll
                for (int w8 = 0; w8 < 8; ++w8) s += red[(w8 * 17 + r) * 64 + n];
                modv[((size_t)l * 17 + r) * 6144 + nb * 64 + n] = s; }
            __syncthreads(); }
        }
        if (PROBE_T == 11 && bid == 0 && tid == 0) *(LAS unsigned long long*)(lds + LX_MISC + 64) += __builtin_amdgcn_s_memtime() - p0t_;
        { float* cosT = WSP(float, WS_ROPE); float* sinT = cosT + 2048 * 32; float* rwT = WSP(float, WS_RW); float* lamv = WSP(float, WS_MISC);
        for (int i = bid * NTHREADS + tid; i < 2048 * 32; i += G * NTHREADS) { const int t = i >> 5, j = i & 31; const float pos = (float)(j < 16 ? (t >> 6) : (t & 63));
            const float inv = powf(10000.f, -(float)(2 * (j & 15)) / 32.f); const float ang = pos * inv; cosT[i] = cosf(ang); sinT[i] = sinf(ang); }
        if (bid == 0 && tid < 2) { const float* lp = INP(I_LAM) + tid * 256; float s1 = 0.f, s2 = 0.f; for (int d = 0; d < 64; ++d) { s1 += lp[d] * lp[64 + d]; s2 += lp[128 + d] * lp[192 + d]; }
            const float lam_init = 0.8f - 0.6f * expf(-0.3f * (float)(2 * tid)); lamv[tid] = expf(s1) - expf(s2) + lam_init; lamv[2 + tid] = 1.f - lam_init; }
        for (int i = bid * NTHREADS + tid; i < 4 * 32 * 1024; i += G * NTHREADS) { const int l = i >> 15, e = (i >> 10) & 31, k = i & 1023; rwT[i] = INP(I_RW)[((size_t)l * 1024 + k) * 32 + e]; } }
        if (PROBE_T == 12) p0t_ = __builtin_amdgcn_s_memtime();
        { LAS float* scr = (LAS float*)(lds + wave * 10240);
          bf16* Wqkv_t = WSP(bf16, WS_WQKV); bf16* Win_t = WSP(bf16, WS_WIN); bf16* Wo_t = WSP(bf16, WS_WO); bf16* Wout_t = WSP(bf16, WS_WOUT); bf16* Wgu_t = WSP(bf16, WS_WGU); bf16* Wd_t = WSP(bf16, WS_WD);
          constexpr int I_QKV = 16 * 96, I_SQ = 16 * 32, I_GU = 16 * 64, I_D = 16 * 32;
          constexpr int T0 = 2 * I_QKV, T1 = T0 + 2 * I_QKV, T2 = T1 + 2 * I_SQ, T3 = T2 + 2 * I_SQ, T4 = T3 + 128 * I_GU, T5 = T4 + 128 * I_D;
          for (int rep = 0; rep < NREP(0); ++rep) {
          for (int it = gw; it < (MOE_FP8 ? T3 : T5); it += NGW) {
            if (it < T0) { const int j = it / I_QKV; if (FP8_ATT) transpose_item8<1>(INP(I_WQKV) + (size_t)j * 1024 * 3072, 1024, 3072, (unsigned char*)Wqkv_t + (size_t)j * 3072 * 1024, scr, it % I_QKV, lane); else transpose_item<1>(INP(I_WQKV) + (size_t)j * 1024 * 3072, 1024, 3072, Wqkv_t + (size_t)j * 3072 * 1024, scr, it % I_QKV, lane); }
            else if (it < T1) { const int r = it - T0, j = r / I_QKV; if (FP8_CONV) transpose_item8<0>(INP(I_WIN) + (size_t)j * 1024 * 3072, 1024, 3072, (unsigned char*)Win_t + (size_t)j * 3072 * 1024, scr, r % I_QKV, lane); else transpose_item<CONV_FUSE_U ? 2 : 0>(INP(I_WIN) + (size_t)j * 1024 * 3072, 1024, 3072, Win_t + (size_t)j * 3072 * 1024, scr, r % I_QKV, lane); }
            else if (it < T2) { const int r = it - T1, j = r / I_SQ; if (FP8_ATT_O) transpose_item8<0>(INP(I_WO) + (size_t)j * 1024 * 1024, 1024, 1024, (unsigned char*)Wo_t + (size_t)j * 1024 * 1024, scr, r % I_SQ, lane); else transpose_item<0>(INP(I_WO) + (size_t)j * 1024 * 1024, 1024, 1024, Wo_t + (size_t)j * 1024 * 1024, scr, r % I_SQ, lane); }
            else if (it < T3) { const int r = it - T2, j = r / I_SQ; if (FP8_WOUT) transpose_item8<0>(INP(I_WOUT) + (size_t)j * 1024 * 1024, 1024, 1024, (unsigned char*)Wout_t + (size_t)j * 1024 * 1024, scr, r % I_SQ, lane); else transpose_item<0>(INP(I_WOUT) + (size_t)j * 1024 * 1024, 1024, 1024, Wout_t + (size_t)j * 1024 * 1024, scr, r % I_SQ, lane); }
            else if (it < T4) { const int r = it - T3, j = r / I_GU; transpose_item<0>(INP(I_WGU) + (size_t)j * 1024 * 2048, 1024, 2048, Wgu_t + (size_t)j * 2048 * 1024, scr, r % I_GU, lane); }
            else { const int r = it - T4, j = r / I_D; transpose_item<0>(INP(I_WD) + (size_t)j * 1024 * 1024, 1024, 1024, Wd_t + (size_t)j * 1024 * 1024, scr, r % I_D, lane); }
          }
          if (MOE_FP8) {
            constexpr int NGUI = 128 * I_GU, NMOE = NGUI + 128 * I_D;
            const float* wgu = INP(I_WGU); const float* wd = INP(I_WD);
#define MOE_DEC(r_, W_, N_, WT_, IT_) do { if ((r_) < NGUI) { const int j_ = (r_) / I_GU; W_ = wgu + (size_t)j_ * 1024 * 2048; N_ = 2048; WT_ = (unsigned char*)Wgu_t + (size_t)j_ * 2048 * 1024; IT_ = (r_) % I_GU; } \
              else { const int q_ = (r_) - NGUI, j_ = q_ / I_D; W_ = wd + (size_t)j_ * 1024 * 1024; N_ = 1024; WT_ = (unsigned char*)Wd_t + (size_t)j_ * 1024 * 1024; IT_ = q_ % I_D; } } while (0)
            f32x4 vc[8], vn[8]; const float* Wc = nullptr; int Nc = 0, itc = 0; unsigned char* WTc = nullptr;
            int r = gw;
            if (r < NMOE) { MOE_DEC(r, Wc, Nc, WTc, itc); item8_load(Wc, Nc, itc, lane, vc); }
            for (; r < NMOE; r += NGW) { const int rn = r + NGW; const bool hn = rn < NMOE; const float* Wn = Wc; int Nn = Nc, itn = itc; unsigned char* WTn = WTc;
                if (hn) { MOE_DEC(rn, Wn, Nn, WTn, itn); item8_load(Wn, Nn, itn, lane, vn); }
                item8_store(vc, 1024, Nc, WTc, scr, itc, lane);
                if (hn) { Wc = Wn; Nc = Nn; itc = itn; WTc = WTn;
#pragma unroll
                    for (int i = 0; i < 8; ++i) vc[i] = vn[i]; } }
#undef MOE_DEC
          }
          }
        }
        if (PROBE_T == 12 && bid == 0 && tid == 0) *(LAS unsigned long long*)(lds + LX_MISC + 64) += __builtin_amdgcn_s_memtime() - p0t_;
        __syncthreads();
    }
    SEAM(0);

    if (PS(1) && IN(1)) { PHASE_IDS
        const float* g = INP(I_NORMG); const float* modv = WSP(float, WS_MODV); float* X = WSP(float, WS_X); bf16* H = WSP(bf16, WS_H);
        for (int row = gw; row < M; row += NGW) { const int b = row_batch(row), jj = row % RPB; const bool cx = jj < CTXL; const int rb = cx ? 16 : b;
            const float* src = cx ? INP(I_CTX) + ((size_t)b * CTXL + jj) * D : INP(I_X) + ((size_t)b * SEQ + (jj - CTXL)) * D;
            f32x4 v[4]; load_row_f32(src, lane, v);
            norm_mod_store_mix(FP8_ATT != 0, v, g, modv + rb * 6144 + 1024, modv + rb * 6144, lane, H + (size_t)row * D, WSP(unsigned char, WS_H8) + (size_t)row * 1024); }
    }
    SEAM(1);

    for (int l = 0; l < DEPTH; ++l) {
        const int pb = 2 + 7 * l; const bool attn = (l & 1) == 0; const int j2 = l >> 1; const bool lat_only = (l == DEPTH - 1);
#define MV() (WSP(float, WS_MODV) + (size_t)l * 17 * 6144)
        const unsigned* gcnt = (const unsigned*)(ctl + CW_CNT) + l * 32;

        if (IN(pb)) { PHASE_IDS
            if (PS(2) && attn) {
                constexpr int RBX = FP8_ATT ? 1024 : 2048; constexpr int SCX = FP8_ATT ? 0x78787878 : 0;
                typedef SchedQKV<RBX, SCX> SQ;
                SQ S{FP8_ATT ? (const char*)WSP(unsigned char, WS_H8) : (const char*)WSP(bf16, WS_H), (const char*)WSP(bf16, WS_WQKV) + (size_t)j2 * 3072 * RBX};
                EpiQKV E{WSP(bf16, WS_Q), WSP(bf16, WS_K), WSP(bf16, WS_VT), WSP(float, WS_ROPE), WSP(float, WS_ROPE) + 2048 * 32, true, lds + LX_EPI};
                for (int rep = 0; rep < NREP(2); ++rep) { int z_ = rep; asm volatile("" : "+s"(z_)); E.dost = !PROBE_NOST || (z_ == NREP(2) - 1); pg8::gemm_phase<EpiQKV, SQ, 2>(lds, S, E, tid, STAG(1500)); }
            } else if (PS(3)) {
                constexpr int RBX = FP8_CONV ? 1024 : 2048; constexpr int SCX = FP8_CONV ? 0x78787878 : 0;
                typedef SchedPlain<RBX, SCX> SP;
                SP S{FP8_CONV ? (const char*)WSP(unsigned char, WS_H8) : (const char*)WSP(bf16, WS_H), (const char*)WSP(bf16, WS_WIN) + (size_t)j2 * 3072 * RBX, 12, lat_only};
                if (CONV_FUSE_U) { EpiConvIn E{WSP(bf16, WS_BCO), WSP(bf16, WS_BCO) + (size_t)M * 1024};
                    for (int rep = 0; rep < NREP(3); ++rep) pg8::gemm_phase<EpiConvIn, SP, 3>(lds, S, E, tid, STAG(1500)); }
                else { EpiPlain E{WSP(bf16, WS_BCO), 3072};
                    for (int rep = 0; rep < NREP(3); ++rep) pg8::gemm_phase<EpiPlain, SP, 3>(lds, S, E, tid, STAG(1500)); }
            }
        }
        SEAM(pb);

        if (IN(pb + 1)) { PHASE_IDS
            if (PS(4) && attn) {
                const float* lamv = WSP(float, WS_MISC); const float lam = lamv[j2], osc = lamv[2 + j2]; const float* subg = INP(I_SUBG) + j2 * 128;
                const bf16* Qb = WSP(bf16, WS_Q); const bf16* Kb = WSP(bf16, WS_K); const bf16* Vt = WSP(bf16, WS_VT); bf16* Ob = WSP(bf16, WS_O);
                LAS float* wsc = (LAS float*)(lds + LX_WSC + wave * 1024);
                if (ATT_FP8) { wsc[96 + lane] = subg[lane] * osc; wsc[160 + lane] = subg[64 + lane] * osc; }
                const int vcu = (G % 8 == 0) ? (bid % 8) * (G / 8) + bid / 8 : bid;
                for (int rep = 0; rep < NREP(4); ++rep)
                if (G == 256) {
                    const int xc = bid & 7, j = bid >> 3;
                    const int bhc = xc * 16 + (j >> 1);
                    for (int sstep = 0; sstep < 8; ++sstep) { const int bh = xc * 16 + 2 * sstep + (j >> 4), b = bh >> 3, h = bh & 7;
                        const int bhn = sstep < 7 ? bh + 2 : bhc;
                        ATT_CALL(lds, wsc, Qb, Kb, Vt, Ob, b * RPB, h, b * RPB + CTXL + (j & 15) * 128, 36, lam, osc, subg, tid, sstep & 1, sstep > 0, (bhn >> 3) * RPB, bhn & 7); }
                    { const int b = bhc >> 3, h = bhc & 7;
                      ATT_CALL(lds, wsc, Qb, Kb, Vt, Ob, b * RPB, h, b * RPB + (j & 1) * 128, 4, lam, osc, subg, tid, 0, true, -1, 0); }
                } else {
                    for (int u = bid; u < 128 * 18; u += G) { const int bh = u / 18, k = u % 18, b = bh >> 3, h = bh & 7;
                        ATT_CALL(lds, wsc, Qb, Kb, Vt, Ob, b * RPB, h, k < 16 ? b * RPB + CTXL + k * 128 : b * RPB + (k - 16) * 128, k < 16 ? 36 : 4, lam, osc, subg, tid, 0, false, -1, 0); }
                }
            } else if (PS(5)) {
                const float* cw = INP(I_CONVW) + (size_t)j2 * 3 * 1024; const bf16* BCO = WSP(bf16, WS_BCO); bf16* Ob = WSP(bf16, WS_O);
                const int nact = lat_only ? 32768 : M; const int nitems = (nact / 16) * 2;
                for (int it = gw; it < nitems; it += NGW) { const int strip = it >> 1, ch = (it & 1) * 512 + lane * 8; const int row0 = act_row(strip * 16, lat_only);
                    const int jj = row0 % RPB; const int seq_lo = jj < CTXL ? row0 - jj : row0 - jj + CTXL, seq_hi = jj < CTXL ? row0 - jj + CTXL : row0 - jj + RPB;
                    float w0[8], w1[8], w2[8];
#pragma unroll
                    for (int q = 0; q < 8; ++q) { w0[q] = cw[ch + q]; w1[q] = cw[1024 + ch + q]; w2[q] = cw[2048 + ch + q]; }
                    static_assert(CONV_FUSE_U != 0, "u = gate_c * x~ comes from the in-projection's epilogue");
                    const bf16* Ub = BCO + (size_t)M * 1024 + ch; const bf16* Gb = BCO + ch;
                    u32x4 ur[18], gr[16];
#pragma unroll
                    for (int k = 0; k < 18; ++k) { const int row = row0 - 1 + k; const bool in = (k != 0 && k != 17) || (row >= seq_lo && row < seq_hi);
                        ur[k] = *(const u32x4*)(Ub + (size_t)(in ? row : row0) * 1024); if (!in) ur[k] = u32x4{0u, 0u, 0u, 0u}; }
#pragma unroll
                    for (int r = 0; r < 16; ++r) gr[r] = *(const u32x4*)(Gb + (size_t)(row0 + r) * 1024);
                    float up[8], uc[8], un[8];
#define CONV_UNPACK(u_, w_) do { _Pragma("unroll") for (int q = 0; q < 4; ++q) { u_[2 * q] = bf2f((unsigned short)((w_)[q] & 0xffffu)); u_[2 * q + 1] = bf2f((unsigned short)((w_)[q] >> 16)); } } while (0)
                    CONV_UNPACK(up, ur[0]); CONV_UNPACK(uc, ur[1]);
#pragma unroll
                    for (int r = 0; r < 16; ++r) { const int row = row0 + r; CONV_UNPACK(un, ur[r + 2]);
                        const u32x4 gb = gr[r]; float z[8];
#pragma unroll
                        for (int q = 0; q < 8; ++q) { const float gbv = bf2f((unsigned short)((q & 1) ? (gb[q >> 1] >> 16) : (gb[q >> 1] & 0xffffu))); z[q] = gbv * (w0[q] * up[q] + w1[q] * uc[q] + w2[q] * un[q]); }
                        if (FP8_WOUT) { u32x2 o; o.x = pack_fp8x4(4.f * z[0], 4.f * z[1], 4.f * z[2], 4.f * z[3]); o.y = pack_fp8x4(4.f * z[4], 4.f * z[5], 4.f * z[6], 4.f * z[7]); *(u32x2*)((unsigned char*)Ob + (size_t)row * 1024 + ch) = o; }
                        else { u32x4 o; o.x = cvt_pk_bf16(z[0], z[1]); o.y = cvt_pk_bf16(z[2], z[3]); o.z = cvt_pk_bf16(z[4], z[5]); o.w = cvt_pk_bf16(z[6], z[7]);
                        *(u32x4*)(Ob + (size_t)row * 1024 + ch) = o; }
#pragma unroll
                        for (int q = 0; q < 8; ++q) { up[q] = uc[q]; uc[q] = un[q]; } }
#undef CONV_UNPACK
                }
            }
        }
        SEAM(pb + 1);

        if (PS(6) && IN(pb + 2)) { PHASE_IDS
            float* X = WSP(float, WS_X);
            EpiResid E{X, X, MV() + 2 * 1024, l == 0 ? INP(I_X) : nullptr, l == 0 ? INP(I_CTX) : nullptr};
            if (attn) { constexpr int RBX = FP8_ATT_O ? 1024 : 2048; constexpr int SCX = FP8_ATT_O ? 0x79797979 : 0;
                typedef SchedPlain<RBX, SCX> SP;
                SP S{(const char*)WSP(bf16, WS_O), (const char*)WSP(bf16, WS_WO) + (size_t)j2 * 1024 * RBX, 4, lat_only};
                pg8::gemm_phase<EpiResid, SP, 6>(lds, S, E, tid, STAG(1500));
            } else { constexpr int RBX = FP8_WOUT ? 1024 : 2048; constexpr int SCX = FP8_WOUT ? 0x79797979 : 0;
                typedef SchedPlain<RBX, SCX> SP;
                SP S{(const char*)WSP(bf16, WS_O), (const char*)WSP(bf16, WS_WOUT) + (size_t)j2 * 1024 * RBX, 4, lat_only};
                pg8::gemm_phase<EpiResid, SP, 6>(lds, S, E, tid, STAG(1500));
            }
        }
        SEAM(pb + 2);

        if (PS(7) && IN(pb + 3)) { PHASE_IDS
            LAS int* lcnt = (LAS int*)(lds + LX_LCNT); LAS int* lbase = (LAS int*)(lds + LX_LBASE); LAS int* asg = (LAS int*)(lds + LX_ASG);
            LAS float* wsc = (LAS float*)(lds + LX_WSC + wave * 1024);
            LAS unsigned char* tile = lds;
            LAS float* part = (LAS float*)(lds + 65536);
            float* X = WSP(float, WS_X); bf16* H = WSP(bf16, WS_H); const float* mv = MV(); int* topE = WSP(int, WS_TOPE); float* topG = WSP(float, WS_TOPG); int* topP = WSP(int, WS_TOPP); int* list = WSP(int, WS_LIST);
            const int r32 = lane & 31, hi = lane >> 5;
            bf16x8 wf[8];
            { const float* rw = WSP(float, WS_RW) + (size_t)l * 32 * 1024 + r32 * 1024 + wave * 128 + hi * 8;
#pragma unroll
              for (int s8 = 0; s8 < 8; ++s8) { const f32x4 a = *(const f32x4*)(rw + 16 * s8), b = *(const f32x4*)(rw + 16 * s8 + 4); wf[s8] = __builtin_bit_cast(bf16x8, pack8(a, b)); } }
            __syncthreads();
            if (tid < 32) lcnt[tid] = 0;
            __syncthreads();
            const int nact = lat_only ? 32768 : M; const int rpb = (nact + G - 1) / G; const int a0 = bid * rpb; int nr = nact - a0; nr = nr < 0 ? 0 : (nr > rpb ? rpb : nr);
            const float* g = INP(I_NORMG) + ((size_t)l * 2 + 1) * 1024; const float* rb_ = INP(I_RB) + l * 32;
            for (int g0 = 0; g0 < nr; g0 += 32) {
                f32x4 v[4][4]; int rowq[4]; bool okq[4];
#pragma unroll
                for (int q = 0; q < 4; ++q) { const int i = g0 + wave + 8 * q; okq[q] = i < nr; rowq[q] = act_row(a0 + (okq[q] ? i : nr - 1), lat_only); load_row_x(X, (size_t)rowq[q], lane, v[q]); }
#pragma unroll
                for (int q = 0; q < 4; ++q) { const int row = rowq[q]; const int rb = row_is_ctx(row) ? 16 : row_batch(row); const int tr = wave + 8 * q;
                    norm_mod_f32(v[q], g, mv + rb * 6144 + 4 * 1024, mv + rb * 6144 + 3 * 1024, lane);
                    if (MOE_FP8) { unsigned char* h8 = WSP(unsigned char, WS_H8) + (size_t)row * 1024;
#pragma unroll
                        for (int j = 0; j < 4; ++j) { const unsigned pk_ = pack_fp8x4(16.f * v[q][j][0], 16.f * v[q][j][1], 16.f * v[q][j][2], 16.f * v[q][j][3]); if (okq[q]) *(unsigned*)(h8 + 256 * j + 4 * lane) = pk_; } }
#pragma unroll
                    for (int j = 0; j < 4; ++j) { u32x2 w; w.x = cvt_pk_bf16(v[q][j][0], v[q][j][1]); w.y = cvt_pk_bf16(v[q][j][2], v[q][j][3]);
                        if (!MOE_FP8 && okq[q]) *(u32x2*)(H + (size_t)row * D + 256 * j + 4 * lane) = w;
                        const int ch = 32 * j + (lane >> 1); *(LAS u32x2*)(tile + tr * 2048 + ((ch ^ (tr & 15)) << 4) + (lane & 1) * 8) = w; } }
                __syncthreads();
                { f32x16 acc = f32x16{};
#pragma unroll
                  for (int s8 = 0; s8 < 8; ++s8) { const int ch = wave * 16 + 2 * s8 + hi; const bf16x8 bfr = *(const LAS bf16x8*)(tile + r32 * 2048 + ((ch ^ (r32 & 15)) << 4));
                      acc = __builtin_amdgcn_mfma_f32_32x32x16_bf16(wf[s8], bfr, acc, 0, 0, 0); }
#pragma unroll
                  for (int r = 0; r < 16; ++r) { const int e = (r & 3) + 8 * (r >> 2) + 4 * hi; part[(wave * 32 + e) * 33 + r32] = acc[r]; } }
                __syncthreads();
#pragma unroll 1
                for (int q = 0; q < 4; ++q) { const int tr = wave + 8 * q; const int i = g0 + tr; const int row = rowq[q]; const int my_e = r32;
                    float lg = rb_[my_e];
#pragma unroll
                    for (int w8 = 0; w8 < 8; ++w8) lg += part[(w8 * 32 + my_e) * 33 + tr];
                    if (lane < 32) wsc[my_e] = lg;
                    asm volatile("s_waitcnt lgkmcnt(0)" ::: "memory");
                    int rank = 0;
#pragma unroll
                    for (int e = 0; e < 32; ++e) { const float o = wsc[e]; rank += (o > lg || (o == lg && e < my_e)) ? 1 : 0; }
                    asm volatile("s_waitcnt lgkmcnt(0)" ::: "memory");
                    if (lane < 32 && rank < 4) { wsc[64 + rank] = lg; ((LAS int*)wsc)[72 + rank] = my_e; }
                    asm volatile("s_waitcnt lgkmcnt(0)" ::: "memory");
                    const float t0 = wsc[64], t1 = wsc[65], t2 = wsc[66], t3 = wsc[67];
                    const float p0 = 1.f, p1 = __expf(t1 - t0), p2 = __expf(t2 - t0), p3 = __expf(t3 - t0); const float inv = 1.f / (p0 + p1 + p2 + p3);
                    if (lane < 4 && okq[q]) { const int e = ((LAS int*)wsc)[72 + lane]; const float p = lane == 0 ? p0 : lane == 1 ? p1 : lane == 2 ? p2 : p3;
                        const int lp = __hip_atomic_fetch_add(lcnt + e, 1, __ATOMIC_RELAXED, __HIP_MEMORY_SCOPE_WORKGROUP);
                        topE[row * 4 + lane] = e; topG[row * 4 + lane] = p * inv; asg[i * 4 + lane] = (lp << 5) | e; }
                    asm volatile("s_waitcnt lgkmcnt(0)" ::: "memory");
                }
            }
            __syncthreads();
            if (tid < 32) lbase[tid] = (int)__hip_atomic_fetch_add((unsigned*)gcnt + tid, (unsigned)lcnt[tid], RLX_AGENT);
            __syncthreads();
            for (int i = tid; i < nr * 4; i += NTHREADS) { const int av = asg[i], e = av & 31, pos = lbase[e] + (av >> 5); const int row = act_row(a0 + (i >> 2), lat_only);
                list[(size_t)e * CAP + pos] = row; topP[row * 4 + (i & 3)] = pos; }
            __syncthreads();
        }
        SEAM(pb + 3);

        if (PS(8) && IN(pb + 4)) { PHASE_IDS
            moe_table(lds, gcnt, tid);
            constexpr int RBM = MOE_FP8 ? 1024 : 2048;
            typedef SchedMoe<true, RBM, 0x78787878, 0x78787878> SG;
            SG S{(const char*)(MOE_FP8 ? (void*)WSP(unsigned char, WS_H8) : (void*)WSP(bf16, WS_H)), (const char*)WSP(bf16, WS_WGU) + (size_t)l * 32 * 2048 * RBM, WSP(int, WS_LIST), 8, (size_t)2048 * RBM,
                 (LAS const int*)(lds + LX_TSTART), (LAS const int*)(lds + LX_ECNT), (LAS const int*)(lds + LX_TILEE)};
            EpiSwiglu<MOE_FP8 != 0> E{WSP(bf16, WS_ACT), INP(I_BGU) + (size_t)l * 32 * 2048, lds + LX_EPI};
            pg8::gemm_phase<EpiSwiglu<MOE_FP8 != 0>, SG, 8>(lds, S, E, tid, STAG(900));
        }
        SEAM(pb + 4);

        if (PS(9) && IN(pb + 5)) { PHASE_IDS
            if (MK_PER_PHASE || lo == pb + 5) moe_table(lds, gcnt, tid);
            constexpr int RBM = MOE_FP8 ? 1024 : 2048;
            typedef SchedMoe<false, RBM, Y_FP8 ? 0x7B7B7B7B : 0x79797979, Y_FP8 ? 0x7B7B7B7B : 0x79797979> SD;
            SD S{(const char*)WSP(bf16, WS_ACT), (const char*)WSP(bf16, WS_WD) + (size_t)l * 32 * 1024 * RBM, WSP(int, WS_LIST), 4, (size_t)1024 * RBM,
                 (LAS const int*)(lds + LX_TSTART), (LAS const int*)(lds + LX_ECNT), (LAS const int*)(lds + LX_TILEE)};
            EpiDown E{WSP(bf16, WS_Y), INP(I_BD) + (size_t)l * 32 * 1024, lds + LX_EPI};
            pg8::gemm_phase<EpiDown, SD, 9>(lds, S, E, tid, STAG(1100));
            if (PROBE_T && l == DEPTH - 1 && bid == (PROBE_T == 10 ? PROBE_BID : 0) && tid == 0) { unsigned long long acc_ = *(LAS unsigned long long*)(lds + LX_MISC + 64); unsigned long long tot_ = __builtin_amdgcn_s_memtime() - pt_start;
                if (PROBE_T == 9) { acc_ = tot_; tot_ = (__builtin_amdgcn_s_memrealtime() - pt_rstart) * 30ull; }
                WSP(float, WS_MISC)[16] = floorf((float)((double)acc_ / (double)tot_) * PROBE_TQ + 0.5f) / PROBE_TQ; }
        }
        SEAM(pb + 5);

        if (PS(10) && IN(pb + 6)) { PHASE_IDS
            if (MK_PER_PHASE || lo >= pb + 5) moe_table(lds, gcnt, tid);
            LAS const int* tstart = (LAS const int*)(lds + LX_TSTART);
            const int nact = lat_only ? 32768 : M;
            const float* gn = (l + 1 < DEPTH) ? INP(I_NORMG) + (size_t)(l + 1) * 2 * 1024 : INP(I_FINALG);
            const float* mv = MV(); const float* mvn = mv + 17 * 6144; float* X = WSP(float, WS_X); bf16* H = WSP(bf16, WS_H); const bf16* Yb = WSP(bf16, WS_Y);
            const int* topE = WSP(int, WS_TOPE); const float* topG = WSP(float, WS_TOPG); const int* topP = WSP(int, WS_TOPP);
            for (int ai = gw; ai < nact; ai += 2 * NGW) {
                int row[2]; bool ok[2]; int4 ev[2], pv[2]; f32x4 gv[2];
#pragma unroll
                for (int u = 0; u < 2; ++u) { const int a2 = ai + u * NGW; ok[u] = a2 < nact; row[u] = act_row(ok[u] ? a2 : ai, lat_only);
                    ev[u] = *(const int4*)(topE + row[u] * 4); pv[u] = *(const int4*)(topP + row[u] * 4); gv[u] = *(const f32x4*)(topG + row[u] * 4); }
                f32x4 v[2][4]; u32x2 yw[2][4][4];
#pragma unroll
                for (int u = 0; u < 2; ++u) { load_row_x(X, (size_t)row[u], lane, v[u]);
                    const int ee[4] = {ev[u].x, ev[u].y, ev[u].z, ev[u].w}, pp[4] = {pv[u].x, pv[u].y, pv[u].z, pv[u].w};
#pragma unroll
                    for (int k = 0; k < 4; ++k) { const size_t yrow = (size_t)(tstart[ee[k]] * 256 + pp[k]);
#pragma unroll
                        for (int j = 0; j < 4; ++j) { if (Y_FP8) { yw[u][k][j].x = *(const unsigned*)((const unsigned char*)Yb + yrow * 1024 + 256 * j + 4 * lane); yw[u][k][j].y = 0u; }
                            else yw[u][k][j] = *(const u32x2*)(Yb + yrow * 1024 + 256 * j + 4 * lane); } } }
#pragma unroll
                for (int u = 0; u < 2; ++u) { if (!ok[u]) continue;
                    const int rw_ = row[u]; const bool cx = row_is_ctx(rw_); const int rb = cx ? 16 : row_batch(rw_);
                    f32x4 acc4[4];
#pragma unroll
                    for (int j = 0; j < 4; ++j) acc4[j] = (f32x4){0.f, 0.f, 0.f, 0.f};
#pragma unroll
                    for (int k = 0; k < 4; ++k) { const float gk = gv[u][k];
#pragma unroll
                        for (int j = 0; j < 4; ++j) { const u32x2 w = yw[u][k][j];
                            if (Y_FP8) { const f32x2 lo = __builtin_amdgcn_cvt_pk_f32_fp8((int)w.x, false), hi2 = __builtin_amdgcn_cvt_pk_f32_fp8((int)w.x, true); const float g16 = gk * (1.f / 16.f);
                                acc4[j][0] += g16 * lo[0]; acc4[j][1] += g16 * lo[1]; acc4[j][2] += g16 * hi2[0]; acc4[j][3] += g16 * hi2[1]; }
                            else { acc4[j][0] += gk * bf2f((unsigned short)(w.x & 0xffffu)); acc4[j][1] += gk * bf2f((unsigned short)(w.x >> 16)); acc4[j][2] += gk * bf2f((unsigned short)(w.y & 0xffffu)); acc4[j][3] += gk * bf2f((unsigned short)(w.y >> 16)); } } }
                    const float* g2 = mv + rb * 6144 + 5 * 1024;
#pragma unroll
                    for (int j = 0; j < 4; ++j) { const f32x4 gg = *(const f32x4*)(g2 + 256 * j + 4 * lane); v[u][j] = v[u][j] + gg * acc4[j]; }
                    if (l + 1 < DEPTH) {
                        store_row_x(X, (size_t)rw_, lane, v[u]);
                        if (!(l + 1 == DEPTH - 1 && cx))
                            norm_mod_store_mix(((l + 1) & 1) ? (FP8_CONV != 0) : (FP8_ATT != 0), v[u], gn, mvn + rb * 6144 + 1024, mvn + rb * 6144, lane, H + (size_t)rw_ * D, WSP(unsigned char, WS_H8) + (size_t)rw_ * 1024);
                    } else {
                        float rstd = row_rstd(v[u]); if (PROBE_T) rstd *= 1.f + sqrtf(WSP(float, WS_MISC)[16]); float* op = OUTP() + ((size_t)row_batch(rw_) * SEQ + (rw_ % RPB - CTXL)) * D;
#pragma unroll
                        for (int j = 0; j < 4; ++j) { const f32x4 gg = *(const f32x4*)(gn + 256 * j + 4 * lane); *(f32x4*)(op + 256 * j + 4 * lane) = (v[u][j] * rstd) * gg; }
                    }
                }
            }
        }
        if (l + 1 < DEPTH) SEAM(pb + 6);
    }
#undef IN
#undef SEAM
#undef MV
}

extern "C" void kernel_launch(void* const* d_in, const int* in_sizes, int n_in, void* d_out, int out_size, void* d_ws, size_t ws_size, hipStream_t stream) {
    static int grid = 0;
    if (grid == 0) {
        if (n_in != 21 || out_size != NB * SEQ * D || ws_size < WS_END) { fprintf(stderr, "kernel_launch: unexpected shapes (n_in %d, out %d, ws %zu)\n", n_in, out_size, ws_size); grid = -1; return; }
        int dev = 0, cus = 0, per_cu = 0;
        if (hipGetDevice(&dev) != hipSuccess || hipDeviceGetAttribute(&cus, hipDeviceAttributeMultiprocessorCount, dev) != hipSuccess) { grid = -1; return; }
        if (hipFuncSetAttribute((const void*)fwd, hipFuncAttributeMaxDynamicSharedMemorySize, LDS_BYTES) != hipSuccess) { fprintf(stderr, "kernel_launch: hipFuncSetAttribute failed\n"); grid = -1; return; }
        if (hipOccupancyMaxActiveBlocksPerMultiprocessor(&per_cu, (const void*)fwd, NTHREADS, LDS_BYTES) != hipSuccess || per_cu < 1) { fprintf(stderr, "kernel_launch: occupancy query says %d\n", per_cu); }
        (void)hipGetLastError();
        if (cus < 160) { fprintf(stderr, "kernel_launch: needs >= 160 CUs\n"); grid = -1; return; }
        grid = cus;
    }
    if (grid < 0) return;
    if (hipMemsetAsync((char*)d_ws + WS_CTL, 0, CTL_ZERO_BYTES, stream) != hipSuccess) return;
    Args a{};
    for (int i = 0; i < 21; ++i) a.in[i] = (const float*)d_in[i];
    a.out = (float*)d_out; a.ws = (unsigned char*)d_ws;
#if MK_PER_PHASE
    for (int p = 0; p < NPHASE; ++p) { a.ph_lo = p; a.ph_hi = p + 1; hipLaunchKernelGGL(fwd, dim3(grid), dim3(NTHREADS), LDS_BYTES, stream, a); }
#else
    a.ph_lo = 0; a.ph_hi = NPHASE;
    hipLaunchKernelGGL(fwd, dim3(grid), dim3(NTHREADS), LDS_BYTES, stream, a);
#endif
    const hipError_t le = hipPeekAtLastError();
    if (le != hipSuccess) fprintf(stderr, "kernel_launch: launch failed: %s\n", hipGetErrorName(le));
}
```
